# Optimizing an MI355X kernel written in HIP

```python
import jax, jax.numpy as jnp
from jax import lax
import numpy as np

D_MODEL = 2048
BATCH = 8
SEQ = 2048
DEPTH = 1

CHUNK = 64
NORM_EPS = 1e-6
N_ADA = 6

A_HEADS = 8
A_HEAD_DIM = 128
A_WIDTH = A_HEADS * A_HEAD_DIM
IDX_HEADS = 16
IDX_DIM = 64
TOPK_MAX = 256
Q_BLOCK = 64

B_HEADS = 8
B_HEAD_DIM = 128
B_WIDTH = B_HEADS * B_HEAD_DIM

PEER_HEADS = 8
PEER_N_KEYS = 128
PEER_N_EXPERTS = PEER_N_KEYS * PEER_N_KEYS
PEER_KEY_DIM = 256
PEER_HALF = PEER_KEY_DIM // 2
PEER_TOPK = 16
PEER_TOKEN_BLOCK = 128

IN_WIDTHS = (A_WIDTH, A_WIDTH, A_WIDTH, IDX_HEADS * IDX_DIM, IDX_DIM, IDX_HEADS,
             B_WIDTH, B_WIDTH, B_WIDTH, B_WIDTH, D_MODEL, D_MODEL)
IN_WIDTH = 3 * A_WIDTH + IDX_HEADS * IDX_DIM + IDX_DIM + IDX_HEADS + 4 * B_WIDTH + 2 * D_MODEL

kernel_name = "hybrid_dsa_hgrn2_peer_adaln_block"


def rms_norm(x, gain):
    xf = x.astype(jnp.float32)
    y = xf * lax.rsqrt(jnp.mean(xf * xf, axis=-1, keepdims=True) + NORM_EPS)
    return (y * gain.astype(jnp.float32)).astype(x.dtype)


def modulate(h, shift, scale):
    return h * (1 + scale[:, None, :]) + shift[:, None, :]


def split_columns(a, widths):
    parts, start = [], 0
    for w in widths:
        parts.append(a[..., start:start + w])
        start += w
    return parts


def dsa_attention(q, k, v, q_idx, k_idx, w_idx):
    B, S = q.shape[0], q.shape[1]
    top_k = min(TOPK_MAX, S // 4)
    n_blk = S // Q_BLOCK
    key_chunk = jnp.arange(S) // CHUNK
    idx_scale = (IDX_DIM * IDX_HEADS) ** -0.5
    att_scale = A_HEAD_DIM ** -0.5
    gather = jax.vmap(lambda table, ids: table[ids])

    def to_blocks(a):
        return jnp.moveaxis(a.reshape((B, n_blk, Q_BLOCK) + a.shape[2:]), 1, 0)

    def block(args):
        qb, qib, wb, blk = args
        q_chunk = (blk * Q_BLOCK + jnp.arange(Q_BLOCK)) // CHUNK
        admissible = key_chunk[None, :] <= q_chunk[:, None]
        dots = jnp.einsum('bqhd,bsd->bqhs', qib, k_idx)
        score = jnp.einsum('bqh,bqhs->bqs', wb, jax.nn.relu(dots)).astype(jnp.float32) * idx_scale
        score = jnp.where(admissible[None], score, -jnp.inf)
        _, sel = lax.top_k(score, top_k)
        valid = jnp.take(key_chunk, sel) <= q_chunk[None, :, None]
        k_sel = gather(k, sel)
        v_sel = gather(v, sel)
        logits = jnp.einsum('bqhd,bqkhd->bqhk', qb, k_sel).astype(jnp.float32) * att_scale
        logits = jnp.where(valid[:, :, None, :], logits, -jnp.inf)
        p = jax.nn.softmax(logits, axis=-1).astype(v.dtype)
        return jnp.einsum('bqhk,bqkhd->bqhd', p, v_sel)

    out = lax.map(block, (to_blocks(q), to_blocks(q_idx), to_blocks(w_idx), jnp.arange(n_blk)))
    return jnp.moveaxis(out, 0, 1).reshape(B, S, A_HEADS, A_HEAD_DIM)


def hgrn2(q, f_logit, i, lower_bound):
    B, S, H, D = q.shape
    out_dtype = q.dtype
    n_c = S // CHUNK
    lb = lower_bound.reshape(H, D).astype(jnp.float32)
    f = lb + (1 - lb) * jax.nn.sigmoid(f_logit.astype(jnp.float32))
    log_f = jnp.log(f)
    key = 1 - f
    qf = jax.nn.silu(q.astype(jnp.float32))
    val = i.astype(jnp.float32)
    causal = jnp.tril(jnp.ones((CHUNK, CHUNK), dtype=bool))

    def chunks(a):
        return a.reshape(B, n_c, CHUNK, H, D).transpose(1, 0, 3, 2, 4)

    def step(state, xs):
        qc, kc, vc, lfc = xs
        b = jnp.cumsum(lfc, axis=2)
        b_last = b[:, :, -1:, :]
        o_inter = jnp.einsum('bhtd,bhde->bhte', qc * jnp.exp(b), state)
        diff = b[:, :, :, None, :] - b[:, :, None, :, :]
        decay = jnp.exp(jnp.where(causal[None, None, :, :, None], diff, -jnp.inf))
        attn = jnp.einsum('bhtd,bhsd,bhtsd->bhts', qc, kc, decay)
        o_intra = jnp.einsum('bhts,bhse->bhte', attn, vc)
        k_to_end = kc * jnp.exp(b_last - b)
        new_state = (jnp.exp(b_last)[:, :, 0, :, None] * state
                     + jnp.einsum('bhsd,bhse->bhde', k_to_end, vc))
        return new_state, o_inter + o_intra

    state0 = jnp.zeros((B, H, D, D), jnp.float32)
    _, o = lax.scan(step, state0, (chunks(qf), chunks(key), chunks(val), chunks(log_f)))
    return o.transpose(1, 0, 3, 2, 4).reshape(B, S, H, D).astype(out_dtype)


def peer(h, w_q, sub_keys, u, v):
    B, S, D = h.shape
    T = B * S
    hf = h.reshape(T, D)
    q = (hf @ w_q).reshape(T, PEER_HEADS, 2, PEER_HALF)
    s = jnp.einsum('tphd,phnd->tphn', q, sub_keys).astype(jnp.float32)
    top_s, top_i = lax.top_k(s, PEER_TOPK)
    cand_s = top_s[:, :, 0, :, None] + top_s[:, :, 1, None, :]
    cand_i = top_i[:, :, 0, :, None] * PEER_N_KEYS + top_i[:, :, 1, None, :]
    best_s, best_pos = lax.top_k(cand_s.reshape(T, PEER_HEADS, PEER_TOPK * PEER_TOPK), PEER_TOPK)
    expert = jnp.take_along_axis(cand_i.reshape(T, PEER_HEADS, PEER_TOPK * PEER_TOPK), best_pos, axis=-1)
    gate = jax.nn.softmax(best_s, axis=-1)
    n_blk = T // PEER_TOKEN_BLOCK
    n_sel = PEER_HEADS * PEER_TOPK

    def block(args):
        hb, eb, gb = args
        ub = u[eb]
        vb = v[eb]
        act = jax.nn.gelu(jnp.einsum('td,ted->te', hb, ub).astype(jnp.float32), approximate=False) * gb
        return jnp.einsum('te,ted->td', act.astype(vb.dtype), vb)

    out = lax.map(block, (hf.reshape(n_blk, PEER_TOKEN_BLOCK, D),
                          expert.reshape(n_blk, PEER_TOKEN_BLOCK, n_sel),
                          gate.reshape(n_blk, PEER_TOKEN_BLOCK, n_sel)))
    return out.reshape(B, S, D).astype(h.dtype)


def setup_inputs(seed: int = 0) -> dict:
    key = jax.random.key(seed)
    ks = jax.random.split(key, 20)
    f32 = jnp.float32
    nrm = lambda k, shape, s: jax.random.normal(k, shape, f32) * s
    return {
        "x": nrm(ks[0], (BATCH, SEQ, D_MODEL), 1.0),
        "c": nrm(ks[1], (BATCH, D_MODEL), 1.0),
        "w_ada": nrm(ks[2], (DEPTH, D_MODEL, N_ADA * D_MODEL), 0.5 * D_MODEL ** -0.5),
        "b_ada": nrm(ks[3], (DEPTH, N_ADA * D_MODEL), 0.01),
        "norm_mix": 1.0 + nrm(ks[4], (DEPTH, D_MODEL), 0.01),
        "norm_ffn": 1.0 + nrm(ks[5], (DEPTH, D_MODEL), 0.01),
        "w_in": nrm(ks[6], (DEPTH, D_MODEL, IN_WIDTH), D_MODEL ** -0.5),
        "lb_logits": nrm(ks[7], (DEPTH + 1, B_WIDTH), 0.5),
        "hgrn_gain": 1.0 + nrm(ks[8], (DEPTH, B_HEAD_DIM), 0.01),
        "w_up_a": nrm(ks[9], (DEPTH, A_WIDTH, D_MODEL), A_WIDTH ** -0.5),
        "w_up_b": nrm(ks[10], (DEPTH, B_WIDTH, D_MODEL), B_WIDTH ** -0.5),
        "w_out": nrm(ks[11], (DEPTH, D_MODEL, D_MODEL), D_MODEL ** -0.5),
        "peer_w_q": nrm(ks[12], (DEPTH, D_MODEL, PEER_HEADS * PEER_KEY_DIM), D_MODEL ** -0.5),
        "peer_keys": nrm(ks[13], (DEPTH, PEER_HEADS, 2, PEER_N_KEYS, PEER_HALF), PEER_HALF ** -0.5),
        "peer_u": nrm(ks[14], (DEPTH, PEER_N_EXPERTS, D_MODEL), D_MODEL ** -0.5),
        "peer_v": nrm(ks[15], (DEPTH, PEER_N_EXPERTS, D_MODEL), PEER_HEADS ** -0.5),
        "final_norm": 1.0 + nrm(ks[16], (D_MODEL,), 0.01),
    }


def reference(x, c, w_ada, b_ada, norm_mix, norm_ffn, w_in, lb_logits, hgrn_gain,
              w_up_a, w_up_b, w_out, peer_w_q, peer_keys, peer_u, peer_v, final_norm):
    B, S, _ = x.shape
    lower_bounds = jnp.cumsum(jax.nn.softmax(lb_logits.astype(jnp.float32), axis=0), axis=0)
    cond = jax.nn.silu(c)
    for l in range(DEPTH):
        mod = cond @ w_ada[l] + b_ada[l]
        shift1, scale1, gate1, shift2, scale2, gate2 = jnp.split(mod, N_ADA, axis=-1)

        h = modulate(rms_norm(x, norm_mix[l]), shift1, scale1)
        proj = h @ w_in[l]
        qa, ka, va, qi, ki, wi, qb, fb, ib, gb, g_a, g_b = split_columns(proj, IN_WIDTHS)
        attn = dsa_attention(qa.reshape(B, S, A_HEADS, A_HEAD_DIM),
                             ka.reshape(B, S, A_HEADS, A_HEAD_DIM),
                             va.reshape(B, S, A_HEADS, A_HEAD_DIM),
                             qi.reshape(B, S, IDX_HEADS, IDX_DIM), ki, wi)
        rec = hgrn2(qb.reshape(B, S, B_HEADS, B_HEAD_DIM),
                    fb.reshape(B, S, B_HEADS, B_HEAD_DIM),
                    ib.reshape(B, S, B_HEADS, B_HEAD_DIM), lower_bounds[l])
        rec = rms_norm(rec, hgrn_gain[l]) * jax.nn.silu(gb.reshape(B, S, B_HEADS, B_HEAD_DIM))
        y_a = attn.reshape(B, S, A_WIDTH) @ w_up_a[l]
        y_b = rec.reshape(B, S, B_WIDTH) @ w_up_b[l]
        mixed = jax.nn.sigmoid(g_a) * y_a + jax.nn.sigmoid(g_b) * y_b
        x = x + gate1[:, None, :] * (mixed @ w_out[l])

        h = modulate(rms_norm(x, norm_ffn[l]), shift2, scale2)
        x = x + gate2[:, None, :] * peer(h, peer_w_q[l], peer_keys[l], peer_u[l], peer_v[l])
    return rms_norm(x, final_norm)
```

```cpp
#include <hip/hip_runtime.h>
#include <hip/hip_cooperative_groups.h>
#include <cstdio>
#include <cstdint>
namespace cg = cooperative_groups;

#define LAS __attribute__((address_space(3)))
typedef unsigned short bf16_t;
typedef short bf16x8 __attribute__((ext_vector_type(8)));
typedef short bf16x4 __attribute__((ext_vector_type(4)));
typedef float f32x2 __attribute__((ext_vector_type(2)));
typedef float f32x4 __attribute__((ext_vector_type(4)));
typedef float f32x16 __attribute__((ext_vector_type(16)));
typedef unsigned u32x2 __attribute__((ext_vector_type(2)));
typedef unsigned u32x4 __attribute__((ext_vector_type(4)));

constexpr int T = 16384, D = 2048, SEQ = 2048, NBATCH = 8, NP = 12544;
constexpr int C_QA = 0, C_KA = 1024, C_VA = 2048, C_QI = 3072, C_KI = 4096, C_WI = 4160, C_QB = 4352, C_FB = 5376, C_IB = 6400, C_GB = 7424, C_GA = 8448, C_GG = 10496;
constexpr int NADA = 12288;
constexpr float NORM_EPS = 1e-6f;
constexpr int NTHREADS = 512, NWAVES = 8;
constexpr int LDS_BYTES = 147456;
constexpr size_t MiB = 1u << 20;
constexpr size_t WS_CTL = 0, WS_MOD = 1 * MiB, WS_WUA = 2 * MiB, WS_WUB = 6 * MiB, WS_WOUT = 10 * MiB, WS_WQ = 18 * MiB, WS_KEYS = 26 * MiB, WS_MASK = 27 * MiB;
constexpr size_t WS_MIXED = 32 * MiB;
constexpr size_t WS_VT = 32 * MiB, WS_ORAW = 64 * MiB;
constexpr size_t WS_P = 96 * MiB;
constexpr size_t WS_H2 = 96 * MiB, WS_QP = 160 * MiB, WS_U16 = 224 * MiB, WS_V16 = 288 * MiB, WS_EIDX = 352 * MiB, WS_EGATE = 360 * MiB;
constexpr size_t WS_END = 488 * MiB;
constexpr size_t OUT_H = 0, OUT_WIN = 64 * MiB;

struct Params { const float* in[17]; float* out; unsigned char* ws; int ph_lo, ph_hi; };

__device__ __forceinline__ unsigned f2bf(float f) { unsigned u = __float_as_uint(f); return (u + 0x7fffu + ((u >> 16) & 1u)) >> 16; }
__device__ __forceinline__ float bf2f(unsigned b) { return __uint_as_float(b << 16); }
__device__ __forceinline__ float bflo(unsigned w) { return __uint_as_float(w << 16); }
__device__ __forceinline__ float bfhi(unsigned w) { return __uint_as_float(w & 0xffff0000u); }
__device__ __forceinline__ unsigned pk2(float lo, float hi) { unsigned r; asm volatile("v_cvt_pk_bf16_f32 %0, %1, %2" : "=v"(r) : "v"(lo), "v"(hi)); return r; }
__device__ __forceinline__ float wave_sum(float v) {
#pragma unroll
    for (int o = 1; o < 64; o <<= 1) v += __shfl_xor(v, o);
    return v;
}
__device__ __forceinline__ float sigmoidf_(float v) { return 1.f / (1.f + __expf(-v)); }
__device__ __forceinline__ float siluf_(float v) { return v / (1.f + __expf(-v)); }
#define LDS_WAIT() asm volatile("s_waitcnt lgkmcnt(0)" ::: "memory")

namespace pg8 {
constexpr int BM = 256, BK = 64, HALF = 128, HTB = HALF * BK * 2, STAGE_BYTES = 8 * HTB, NXCD = 8, WGM = 8;
__host__ __device__ __forceinline__ int lds_byte(int r, int c) { const int st = (r >> 4) * 2 + (c >> 5), rr = r & 15, cc = c & 31, ob = rr * 64 + cc * 2; return st * 1024 + (ob ^ (((ob >> 9) & 1) << 5)); }
__host__ __device__ __forceinline__ void stage_rc(int b, int& R, int& C) { const int st = b / 1024, sb = b % 1024, swz = sb ^ (((sb >> 9) & 1) << 5); R = (st >> 1) * 16 + swz / 64; C = (st & 1) * 32 + (swz % 64) / 2; }
__host__ __device__ __forceinline__ int perm32(int rho) { const int n = rho >> 4, i = rho & 15; return 8 * (i >> 2) + 4 * n + (i & 3); }

struct Unit { int pm, pn, z; };
struct Gemm { const bf16_t* A; const bf16_t* Bt; const bf16_t* A2; const bf16_t* Bt2; int lda, ldb, M, N, K; };

template <int NZ> struct StaticOrder {
    int nM, nN, nwg, G, c;
    __device__ void init(int M, int N, int G_, int c_) { nM = M / BM; nN = N / BM; nwg = nM * nN; G = G_; c = c_; }
    __device__ bool next(int i, Unit& u) const {
        const long L = (long)(i / NZ) * G + c; if (L >= nwg) return false;
        int wgid = (int)L; { const int q = nwg / NXCD, r = nwg % NXCD, xcd = wgid % NXCD, off = wgid / NXCD; wgid = (xcd < r ? xcd * (q + 1) : r * (q + 1) + (xcd - r) * q) + off; }
        const int nig = WGM * nN, gid = wgid / nig, fm = gid * WGM, gsz = (nM - fm) < WGM ? (nM - fm) : WGM;
        u.pm = fm + ((wgid % nig) % gsz); u.pn = (wgid % nig) / gsz; u.z = i % NZ; return true;
    }
};

template <class Epi, class Sched>
__device__ __forceinline__ void gemm_phase(LAS unsigned char* lds, const Gemm g, const Sched& S, const Epi& E) {
    const int tid = threadIdx.x, wid = __builtin_amdgcn_readfirstlane(tid >> 6), lane = tid & 63, wr = wid >> 2, wc = wid & 3, fr = lane & 15, fq = lane >> 4;
    const int K = g.K, nt = K / BK;
    unsigned voffA[2], voffB[2];
#pragma unroll
    for (int i = 0; i < 2; ++i) { int R, C; stage_rc(tid * 16 + i * 8192, R, C); const int Rb = Epi::PERM ? ((R & ~31) + perm32(R & 31)) : R;
        voffA[i] = (unsigned)(R * g.lda + C) * 2u; voffB[i] = (unsigned)(Rb * g.ldb + C) * 2u; }
    const size_t kstep = (size_t)(BK * 2);
    const size_t hstepA = (size_t)HALF * g.lda * 2, hstepB = (size_t)HALF * g.ldb * 2;
    const size_t tstepA = 2 * hstepA, tstepB = 2 * hstepB;
    const unsigned ldsw = (unsigned)wid * 1024u;
    const int aoff = lds_byte(wr * 64 + fr, fq * 8), boff = lds_byte(wc * 32 + fr, fq * 8);
#define PG8_SA(b, h) (((b) * 2 + (h)) * HTB)
#define PG8_SB(b, h) ((4 + (b) * 2 + (h)) * HTB)
#define PG8_STAGE(bufoff, gbase, voff) do { _Pragma("unroll") for (int _i = 0; _i < 2; ++_i) \
        __builtin_amdgcn_global_load_lds((const unsigned*)((const char*)(gbase) + (voff)[_i]), (LAS unsigned*)(lds + (bufoff) + ldsw + _i * 8192), 16, 0, 0); } while (0)
#define PG8_LDA(dst, b, h) do { _Pragma("unroll") for (int m = 0; m < 4; ++m) _Pragma("unroll") for (int k = 0; k < 2; ++k) dst[m][k] = *(const LAS bf16x8*)(lds + PG8_SA(b, h) + aoff + m * 2048 + k * 1024); } while (0)
#define PG8_LDB(dst, b, h) do { _Pragma("unroll") for (int n = 0; n < 2; ++n) _Pragma("unroll") for (int k = 0; k < 2; ++k) dst[n][k] = *(const LAS bf16x8*)(lds + PG8_SB(b, h) + boff + n * 2048 + k * 1024); } while (0)
#define PG8_MMA(ai, bj, At, Bt) do { __builtin_amdgcn_s_setprio(1); _Pragma("unroll") for (int m = 0; m < 4; ++m) _Pragma("unroll") for (int n = 0; n < 2; ++n) _Pragma("unroll") for (int k = 0; k < 2; ++k) \
        acc[ai][bj][m][n] = __builtin_amdgcn_mfma_f32_16x16x32_bf16(Bt[n][k], At[m][k], acc[ai][bj][m][n], 0, 0, 0); __builtin_amdgcn_s_setprio(0); } while (0)
#define PG8_WAIT_V(n) asm volatile("s_waitcnt vmcnt(" #n ")" ::: "memory")
#define PG8_WAIT_L(n) asm volatile("s_waitcnt lgkmcnt(" #n ")" ::: "memory")
#define PG8_BAR __builtin_amdgcn_s_barrier()
#define PG8_SCHED __builtin_amdgcn_sched_barrier(0)
#define PG8_ABASE(u) ((const char*)((u).z ? g.A2 : g.A) + (size_t)(u).pm * tstepA)
#define PG8_BBASE(u) ((const char*)((u).z ? g.Bt2 : g.Bt) + (size_t)(u).pn * tstepB)
    Unit cur, nxt; int ui = 0;
    if (!S.next(0, cur)) return;
    f32x4 acc[2][2][4][2];
#pragma unroll
    for (int a = 0; a < 2; ++a)
#pragma unroll
        for (int b = 0; b < 2; ++b)
#pragma unroll
            for (int m = 0; m < 4; ++m)
#pragma unroll
                for (int n = 0; n < 2; ++n) acc[a][b][m][n] = (f32x4){0.f, 0.f, 0.f, 0.f};
    bf16x8 At[4][2], B0[2][2], B1[2][2];
    const char* cA = PG8_ABASE(cur); const char* cB = PG8_BBASE(cur);
    PG8_STAGE(PG8_SB(0, 0), cB, voffB); PG8_STAGE(PG8_SA(0, 0), cA, voffA); PG8_STAGE(PG8_SB(0, 1), cB + hstepB, voffB); PG8_STAGE(PG8_SA(0, 1), cA + hstepA, voffA);
    if (wr == 1) PG8_BAR;
    PG8_WAIT_V(4); PG8_BAR;
    PG8_STAGE(PG8_SB(1, 0), cB + kstep, voffB); PG8_STAGE(PG8_SA(1, 0), cA + kstep, voffA); PG8_STAGE(PG8_SB(1, 1), cB + hstepB + kstep, voffB);
    PG8_WAIT_V(6); PG8_BAR;
    for (;;) {
        const bool has_next = S.next(ui + 1, nxt);
        const char* nA = has_next ? PG8_ABASE(nxt) : cA; const char* nB = has_next ? PG8_BBASE(nxt) : cB;
        for (int t = 0; t < nt; t += 2) {
            const bool last = (t == nt - 2);
            const char* a1 = cA + (size_t)(t + 1) * kstep;
            const char* a2 = last ? nA : cA + (size_t)(t + 2) * kstep; const char* b2 = last ? nB : cB + (size_t)(t + 2) * kstep;
            const char* a3 = a2 + kstep; const char* b3 = b2 + kstep;
            PG8_LDB(B0, 0, 0); PG8_SCHED; PG8_LDA(At, 0, 0); PG8_STAGE(PG8_SA(1, 1), a1 + hstepA, voffA);
            PG8_WAIT_L(8); PG8_BAR; PG8_WAIT_L(0); PG8_MMA(0, 0, At, B0); PG8_BAR; PG8_SCHED;
            PG8_LDB(B1, 0, 1); PG8_STAGE(PG8_SB(0, 0), b2, voffB);
            PG8_BAR; PG8_WAIT_L(0); PG8_MMA(0, 1, At, B1); PG8_BAR;
            PG8_LDA(At, 0, 1); PG8_STAGE(PG8_SA(0, 0), a2, voffA);
            PG8_BAR; PG8_WAIT_L(0); PG8_MMA(1, 0, At, B0); PG8_BAR; PG8_SCHED;
            PG8_STAGE(PG8_SB(0, 1), b2 + hstepB, voffB);
            PG8_WAIT_V(6); PG8_BAR; PG8_MMA(1, 1, At, B1); PG8_BAR;
            PG8_LDB(B0, 1, 0); PG8_SCHED; PG8_LDA(At, 1, 0); PG8_STAGE(PG8_SA(0, 1), a2 + hstepA, voffA);
            PG8_WAIT_L(8); PG8_BAR; PG8_WAIT_L(0); PG8_MMA(0, 0, At, B0); PG8_BAR; PG8_SCHED;
            PG8_LDB(B1, 1, 1); PG8_STAGE(PG8_SB(1, 0), b3, voffB);
            PG8_BAR; PG8_WAIT_L(0); PG8_MMA(0, 1, At, B1); PG8_BAR;
            PG8_LDA(At, 1, 1); PG8_STAGE(PG8_SA(1, 0), a3, voffA);
            PG8_BAR; PG8_WAIT_L(0); PG8_MMA(1, 0, At, B0); PG8_BAR; PG8_SCHED;
            PG8_STAGE(PG8_SB(1, 1), b3 + hstepB, voffB);
            PG8_WAIT_V(6); PG8_BAR; PG8_MMA(1, 1, At, B1); PG8_BAR;
        }
        E(acc, cur, wr, wc, fr, fq);
        if (!has_next) break;
#pragma unroll
        for (int a = 0; a < 2; ++a)
#pragma unroll
            for (int b = 0; b < 2; ++b)
#pragma unroll
                for (int m = 0; m < 4; ++m)
#pragma unroll
                    for (int n = 0; n < 2; ++n) acc[a][b][m][n] = (f32x4){0.f, 0.f, 0.f, 0.f};
        cur = nxt; cA = nA; cB = nB; ++ui;
    }
    PG8_WAIT_V(0);
    if (wr == 0) PG8_BAR;
    PG8_BAR;
#undef PG8_SA
#undef PG8_SB
#undef PG8_STAGE
#undef PG8_LDA
#undef PG8_LDB
#undef PG8_MMA
#undef PG8_WAIT_V
#undef PG8_WAIT_L
#undef PG8_BAR
#undef PG8_SCHED
#undef PG8_ABASE
#undef PG8_BBASE
}

struct EpiBf16 {
    static constexpr bool PERM = true;
    bf16_t* O; int ldc; int sig_from;
    __device__ __forceinline__ void operator()(const f32x4 (&acc)[2][2][4][2], const Unit& u, int wr, int wc, int fr, int fq) const {
        const int row0 = u.pm * BM + wr * 64 + fr, col0 = u.pn * BM + wc * 32 + 8 * fq; const bool sig = u.pn >= sig_from;
#pragma unroll
        for (int ai = 0; ai < 2; ++ai)
#pragma unroll
            for (int m = 0; m < 4; ++m) { bf16_t* rowp = O + (size_t)(row0 + ai * HALF + m * 16) * ldc + col0;
#pragma unroll
                for (int bj = 0; bj < 2; ++bj) { f32x4 v0 = acc[ai][bj][m][0], v1 = acc[ai][bj][m][1];
                    if (sig) {
#pragma unroll
                        for (int j = 0; j < 4; ++j) { v0[j] = sigmoidf_(v0[j]); v1[j] = sigmoidf_(v1[j]); } }
                    u32x4 w; w.x = pk2(v0[0], v0[1]); w.y = pk2(v0[2], v0[3]); w.z = pk2(v1[0], v1[1]); w.w = pk2(v1[2], v1[3]);
                    *(u32x4*)(rowp + bj * HALF) = w; } }
    }
};
struct EpiMix {
    static constexpr bool PERM = true;
    bf16_t* O; const bf16_t* P;
    __device__ __forceinline__ void operator()(const f32x4 (&acc)[2][2][4][2], const Unit& u, int wr, int wc, int fr, int fq) const {
        const int row0 = u.pm * BM + wr * 64 + fr, col0 = u.pn * BM + wc * 32 + 8 * fq; const int gcol = (u.z ? C_GG : C_GA);
#pragma unroll
        for (int ai = 0; ai < 2; ++ai)
#pragma unroll
            for (int m = 0; m < 4; ++m) { const size_t r = (size_t)(row0 + ai * HALF + m * 16);
#pragma unroll
                for (int bj = 0; bj < 2; ++bj) { const f32x4 v0 = acc[ai][bj][m][0], v1 = acc[ai][bj][m][1];
                    const u32x4 gw = *(const u32x4*)(P + r * NP + gcol + col0 + bj * HALF);
                    float o[8] = {v0[0] * bflo(gw.x), v0[1] * bfhi(gw.x), v0[2] * bflo(gw.y), v0[3] * bfhi(gw.y), v1[0] * bflo(gw.z), v1[1] * bfhi(gw.z), v1[2] * bflo(gw.w), v1[3] * bfhi(gw.w)};
                    bf16_t* op = O + r * D + col0 + bj * HALF;
                    if (u.z) { const u32x4 pw = *(const u32x4*)op; o[0] += bflo(pw.x); o[1] += bfhi(pw.x); o[2] += bflo(pw.y); o[3] += bfhi(pw.y); o[4] += bflo(pw.z); o[5] += bfhi(pw.z); o[6] += bflo(pw.w); o[7] += bfhi(pw.w); }
                    u32x4 w; w.x = pk2(o[0], o[1]); w.y = pk2(o[2], o[3]); w.z = pk2(o[4], o[5]); w.w = pk2(o[6], o[7]);
                    *(u32x4*)op = w; } }
    }
};
struct EpiX1 {
    static constexpr bool PERM = false;
    const float* x; float* out; const float* gate;
    __device__ __forceinline__ void operator()(const f32x4 (&acc)[2][2][4][2], const Unit& u, int wr, int wc, int fr, int fq) const {
        const int row0 = u.pm * BM + wr * 64 + fr, col0 = u.pn * BM + wc * 32 + 4 * fq; const int b = (u.pm * BM) >> 11;
        f32x4 gv[2][2];
#pragma unroll
        for (int bj = 0; bj < 2; ++bj)
#pragma unroll
            for (int n = 0; n < 2; ++n) gv[bj][n] = *(const f32x4*)(gate + (size_t)b * NADA + col0 + bj * HALF + n * 16);
#pragma unroll
        for (int ai = 0; ai < 2; ++ai)
#pragma unroll
            for (int m = 0; m < 4; ++m) { const size_t off = (size_t)(row0 + ai * HALF + m * 16) * D + col0;
#pragma unroll
                for (int bj = 0; bj < 2; ++bj)
#pragma unroll
                    for (int n = 0; n < 2; ++n) { const f32x4 xv = *(const f32x4*)(x + off + bj * HALF + n * 16);
                        *(f32x4*)(out + off + bj * HALF + n * 16) = xv + gv[bj][n] * acc[ai][bj][m][n]; } }
    }
};
}

__device__ __forceinline__ void phase_mod(const Params& p, unsigned char* lds) {
    float* sc = (float*)lds;
    float* red = (float*)(lds + 65536);
    const int tid = threadIdx.x, wave = tid >> 6, lane = tid & 63;
    const float* c = p.in[1]; const float* wada = p.in[2]; const float* bada = p.in[3];
    float* mod = (float*)(p.ws + WS_MOD);
    if ((int)blockIdx.x >= 192) return;
    for (int i = tid; i < NBATCH * D; i += NTHREADS) { const int b = i >> 11, k = i & 2047; sc[k * 8 + b] = siluf_(c[i]); }
    __syncthreads();
    const int cgp = tid & 15, rg = tid >> 4;
    for (int item = blockIdx.x; item < 192; item += gridDim.x) {
        const float* w = wada + item * 64 + cgp * 4;
        float acc[8][4];
#pragma unroll
        for (int b = 0; b < 8; ++b)
#pragma unroll
            for (int j = 0; j < 4; ++j) acc[b][j] = 0.f;
#pragma unroll 4
        for (int i = 0; i < 64; ++i) { const int k = rg + 32 * i; const f32x4 wv = *(const f32x4*)(w + (size_t)k * NADA);
            const f32x4 s0 = *(const f32x4*)(sc + k * 8), s1 = *(const f32x4*)(sc + k * 8 + 4);
#pragma unroll
            for (int j = 0; j < 4; ++j) { acc[0][j] += s0[0] * wv[j]; acc[1][j] += s0[1] * wv[j]; acc[2][j] += s0[2] * wv[j]; acc[3][j] += s0[3] * wv[j];
                acc[4][j] += s1[0] * wv[j]; acc[5][j] += s1[1] * wv[j]; acc[6][j] += s1[2] * wv[j]; acc[7][j] += s1[3] * wv[j]; } }
#pragma unroll
        for (int b = 0; b < 8; ++b)
#pragma unroll
            for (int j = 0; j < 4; ++j) { float v = acc[b][j]; v += __shfl_xor(v, 16); v += __shfl_xor(v, 32); acc[b][j] = v; }
        if (lane < 16) {
#pragma unroll
            for (int b = 0; b < 8; ++b)
#pragma unroll
                for (int j = 0; j < 4; ++j) red[(wave * 16 + cgp) * 32 + b * 4 + j] = acc[b][j]; }
        __syncthreads();
        { const int cgo = tid >> 5, b = (tid >> 2) & 7, j = tid & 3; float s = 0.f;
#pragma unroll
          for (int w8 = 0; w8 < 8; ++w8) s += red[(w8 * 16 + cgo) * 32 + (tid & 31)];
          const int col = item * 64 + cgo * 4 + j; mod[b * NADA + col] = s + bada[col]; }
        __syncthreads();
    }
}
__device__ __forceinline__ void transpose_item(const float* W, int K, int N, bf16_t* WT, int nblk, int item, int lane, float* scr, int mode) {
    const int kb = item / nblk, nb = item % nblk, k0 = 64 * kb, n0 = 32 * nb;
    const int nd = n0 + (lane & 31); int ns = nd; bool valid = true;
    if (mode == 1) { if (nd >= C_QB) ns = nd - 176; else if (nd >= 4176) valid = false; }
#pragma unroll 8
    for (int i = 0; i < 32; ++i) { const int kk = 2 * i + (lane >> 5); scr[kk * 33 + (lane & 31)] = valid ? W[(size_t)(k0 + kk) * N + ns] : 0.f; }
    LDS_WAIT();
    const int c = lane & 7;
#pragma unroll
    for (int j = 0; j < 4; ++j) { const int n = (lane >> 3) + 8 * j; const float* s = scr + (8 * c) * 33 + n;
        u32x4 o; o.x = pk2(s[0 * 33], s[1 * 33]); o.y = pk2(s[2 * 33], s[3 * 33]); o.z = pk2(s[4 * 33], s[5 * 33]); o.w = pk2(s[6 * 33], s[7 * 33]);
        *(u32x4*)(WT + (size_t)(n0 + n) * K + k0 + 8 * c) = o; }
    LDS_WAIT();
}
__device__ __forceinline__ void phase_weights(const Params& p, unsigned char* lds) {
    const int tid = threadIdx.x, wave = tid >> 6, lane = tid & 63;
    float* scr = (float*)(lds + wave * 16384);
    const int vb = ((int)blockIdx.x + (int)gridDim.x - 192 % (int)gridDim.x) % (int)gridDim.x;
    const int gw = vb * NWAVES + wave, NGW = gridDim.x * NWAVES;
    constexpr int I_IN = 32 * (NP / 32), I_UA = 16 * 64, I_UB = 16 * 64, I_O = 32 * 64, I_Q = 32 * 64;
    constexpr int NITEMS = I_IN + I_UA + I_UB + I_O + I_Q;
    bf16_t* win_t = (bf16_t*)((unsigned char*)p.out + OUT_WIN);
    for (int it = gw; it < NITEMS; it += NGW) {
        int r = it;
        if (r < I_IN) { transpose_item(p.in[6], 2048, 12368, win_t, NP / 32, r, lane, scr, 1); continue; } r -= I_IN;
        if (r < I_UA) { transpose_item(p.in[9], 1024, 2048, (bf16_t*)(p.ws + WS_WUA), 64, r, lane, scr, 0); continue; } r -= I_UA;
        if (r < I_UB) { transpose_item(p.in[10], 1024, 2048, (bf16_t*)(p.ws + WS_WUB), 64, r, lane, scr, 0); continue; } r -= I_UB;
        if (r < I_O) { transpose_item(p.in[11], 2048, 2048, (bf16_t*)(p.ws + WS_WOUT), 64, r, lane, scr, 0); continue; } r -= I_O;
        transpose_item(p.in[12], 2048, 2048, (bf16_t*)(p.ws + WS_WQ), 64, r, lane, scr, 0);
    }
    { const float* ks = p.in[13]; bf16_t* kd = (bf16_t*)(p.ws + WS_KEYS);
      for (int i = (blockIdx.x * NTHREADS + tid) * 4; i < 8 * 2 * 128 * 128; i += gridDim.x * NTHREADS * 4) { const f32x4 v = *(const f32x4*)(ks + i); u32x2 o; o.x = pk2(v[0], v[1]); o.y = pk2(v[2], v[3]); *(u32x2*)(kd + i) = o; } }
}

__device__ __forceinline__ void phase_norm_rows(const float* src, const float* gain, const float* shift, const float* scale, bf16_t* dst) {
    const int tid = threadIdx.x, wave = tid >> 6, lane = tid & 63;
    const int gw = blockIdx.x * NWAVES + wave, NGW = gridDim.x * NWAVES;
    for (int row = gw; row < T; row += NGW) {
        const int b = row >> 11; const f32x4* xr = (const f32x4*)(src + (size_t)row * D) + lane;
        f32x4 v[8]; float ss = 0.f;
#pragma unroll
        for (int j = 0; j < 8; ++j) { v[j] = xr[64 * j]; ss += (v[j][0] * v[j][0] + v[j][1] * v[j][1]) + (v[j][2] * v[j][2] + v[j][3] * v[j][3]); }
        const float rstd = rsqrtf(wave_sum(ss) * (1.f / D) + NORM_EPS);
        u32x2* o8 = (u32x2*)(dst + (size_t)row * D) + lane;
#pragma unroll
        for (int j = 0; j < 8; ++j) { const int col = 4 * (lane + 64 * j);
            const f32x4 g = *(const f32x4*)(gain + col), sh = *(const f32x4*)(shift + (size_t)b * NADA + col), sc = *(const f32x4*)(scale + (size_t)b * NADA + col);
            f32x4 h;
#pragma unroll
            for (int e = 0; e < 4; ++e) h[e] = v[j][e] * rstd * g[e] * (1.f + sc[e]) + sh[e];
            u32x2 w; w.x = pk2(h[0], h[1]); w.y = pk2(h[2], h[3]); o8[64 * j] = w; }
    }
}

__device__ __forceinline__ void phase_vt(const Params& p, unsigned char* lds) {
    const int tid = threadIdx.x, wave = tid >> 6, lane = tid & 63;
    bf16_t* tile = (bf16_t*)(lds + wave * 16384);
    const bf16_t* P = (const bf16_t*)(p.ws + WS_P); bf16_t* VT = (bf16_t*)(p.ws + WS_VT);
    const int gw = blockIdx.x * NWAVES + wave, NGW = gridDim.x * NWAVES;
    for (int it = gw; it < 8 * 8 * 32 * 2; it += NGW) {
        const int dh = it & 1, kt = (it >> 1) & 31, h = (it >> 6) & 7, b = it >> 9;
        const int k0 = kt * 64, d0 = dh * 64;
#pragma unroll
        for (int i = 0; i < 8; ++i) { const int key = i * 8 + (lane >> 3), dc = lane & 7;
            const u32x4 v = *(const u32x4*)(P + (size_t)(b * SEQ + k0 + key) * NP + C_VA + h * 128 + d0 + dc * 8);
            bf16_t* t = tile + (dc * 8) * 72 + key;
            t[0 * 72] = (bf16_t)(v.x & 0xffff); t[1 * 72] = (bf16_t)(v.x >> 16); t[2 * 72] = (bf16_t)(v.y & 0xffff); t[3 * 72] = (bf16_t)(v.y >> 16);
            t[4 * 72] = (bf16_t)(v.z & 0xffff); t[5 * 72] = (bf16_t)(v.z >> 16); t[6 * 72] = (bf16_t)(v.w & 0xffff); t[7 * 72] = (bf16_t)(v.w >> 16); }
        LDS_WAIT();
#pragma unroll
        for (int i = 0; i < 8; ++i) { const int d = i * 8 + (lane >> 3), kc = lane & 7;
            const u32x4 v = *(const u32x4*)(tile + d * 72 + kc * 8);
            *(u32x4*)(VT + ((size_t)((b * 8 + h) * 128 + d0 + d)) * SEQ + k0 + kc * 8) = v; }
        LDS_WAIT();
    }
}

__device__ __forceinline__ unsigned ord_key(float s) { const unsigned u = __float_as_uint(s); return (u & 0x80000000u) ? ~u : (u | 0x80000000u); }
__device__ __forceinline__ int half_sum(int v) {
#pragma unroll
    for (int o = 1; o < 32; o <<= 1) v += __shfl_xor(v, o);
    return v;
}
__device__ __forceinline__ void indexer_pair(const bf16_t* P, unsigned* MASK, int b, int c, int pair, int lane) {
    const int r = lane & 31, hh = lane >> 5;
    const int q0 = b * SEQ + c * 64 + 2 * pair;
    bf16x8 af[4];
    { const int query = q0 + ((r >> 2) & 1), head = (r & 3) + 4 * (r >> 3);
      const bf16_t* qp = P + (size_t)query * NP + C_QI + head * 64 + 8 * hh;
#pragma unroll
      for (int ks = 0; ks < 4; ++ks) af[ks] = *(const bf16x8*)(qp + ks * 16); }
    float wv[16];
    { const u32x4 w0 = *(const u32x4*)(P + (size_t)(q0 + hh) * NP + C_WI), w1 = *(const u32x4*)(P + (size_t)(q0 + hh) * NP + C_WI + 8);
      wv[0] = bflo(w0.x); wv[1] = bfhi(w0.x); wv[2] = bflo(w0.y); wv[3] = bfhi(w0.y); wv[4] = bflo(w0.z); wv[5] = bfhi(w0.z); wv[6] = bflo(w0.w); wv[7] = bfhi(w0.w);
      wv[8] = bflo(w1.x); wv[9] = bfhi(w1.x); wv[10] = bflo(w1.y); wv[11] = bfhi(w1.y); wv[12] = bflo(w1.z); wv[13] = bfhi(w1.z); wv[14] = bflo(w1.w); wv[15] = bfhi(w1.w); }
    const int nkt = 2 * (c + 1);
    unsigned kv[64];
    const bf16_t* kbase = P + (size_t)(b * SEQ + r) * NP + C_KI + 8 * hh;
#pragma unroll
    for (int kt = 0; kt < 64; ++kt) {
        kv[kt] = 0u;
        if (kt < nkt) {
            const bf16_t* kp = kbase + (size_t)(kt * 32) * NP;
            f32x16 acc;
#pragma unroll
            for (int i = 0; i < 16; ++i) acc[i] = 0.f;
#pragma unroll
            for (int ks = 0; ks < 4; ++ks) { const bf16x8 bfr = *(const bf16x8*)(kp + ks * 16); acc = __builtin_amdgcn_mfma_f32_32x32x16_bf16(af[ks], bfr, acc, 0, 0, 0); }
            float s = 0.f;
#pragma unroll
            for (int i = 0; i < 16; ++i) s += wv[i] * fmaxf(acc[i], 0.f);
            kv[kt] = ord_key(s);
        }
    }
    unsigned thr = 0u;
    for (int bit = 31; bit >= 0; --bit) {
        const unsigned cand = thr | (1u << bit); int cnt = 0;
#pragma unroll
        for (int kt = 0; kt < 64; ++kt) cnt += (kv[kt] >= cand) ? 1 : 0;
        cnt = half_sum(cnt);
        if (cnt >= 256) thr = cand;
    }
    int cge = 0;
#pragma unroll
    for (int kt = 0; kt < 64; ++kt) cge += (kv[kt] >= thr && kv[kt] != 0u) ? 1 : 0;
    cge = half_sum(cge);
    const bool ties = (thr != 0u) && (cge > 256);
    unsigned m0 = 0u, m1 = 0u;
    if (__builtin_amdgcn_ballot_w64(ties) == 0ull) {
#pragma unroll
        for (int kt = 0; kt < 64; ++kt) { const unsigned long long bm = __builtin_amdgcn_ballot_w64(kv[kt] >= thr && kv[kt] != 0u);
            if (lane == kt) { m0 = (unsigned)bm; m1 = (unsigned)(bm >> 32); } }
    } else {
        int cgt = 0;
#pragma unroll
        for (int kt = 0; kt < 64; ++kt) cgt += (kv[kt] > thr) ? 1 : 0;
        cgt = half_sum(cgt);
        const int need = ties ? (256 - cgt) : (1 << 30); int run = 0;
#pragma unroll
        for (int kt = 0; kt < 64; ++kt) { const bool tie = ties && (kv[kt] == thr); const unsigned long long tb = __builtin_amdgcn_ballot_w64(tie);
            const unsigned th = hh ? (unsigned)(tb >> 32) : (unsigned)tb; const int rank = run + __builtin_popcount(th & ((1u << r) - 1u));
            const bool sel = ties ? ((kv[kt] > thr) || (tie && rank < need)) : (kv[kt] >= thr && kv[kt] != 0u);
            run += __builtin_popcount(th);
            const unsigned long long bm = __builtin_amdgcn_ballot_w64(sel);
            if (lane == kt) { m0 = (unsigned)bm; m1 = (unsigned)(bm >> 32); } }
    }
    MASK[(size_t)q0 * 64 + lane] = m0; MASK[(size_t)(q0 + 1) * 64 + lane] = m1;
}
__device__ __forceinline__ void phase_indexer(const Params& p) {
    const int tid = threadIdx.x, wave = tid >> 6, lane = tid & 63;
    const bf16_t* P = (const bf16_t*)(p.ws + WS_P); unsigned* MASK = (unsigned*)(p.ws + WS_MASK);
    const int G = gridDim.x;
    for (int rd = 0;; ++rd) {
        const int base = rd * G; if (base >= 1024) break;
        const int pos = (rd & 1) ? (G - 1 - (int)blockIdx.x) : (int)blockIdx.x; const int i = base + pos; if (i >= 1024) continue;
        const int c = 31 - (i >> 5), b = (i >> 2) & 7, grp = i & 3;
        indexer_pair(P, MASK, b, c, grp * 8 + wave, lane);
    }
}

__device__ __forceinline__ void phase_hgrn_naive(const Params& p, unsigned char* lds) {
    const int tid = threadIdx.x;
    float* F = (float*)lds; float* Q = (float*)(lds + 32768); float* V = (float*)(lds + 65536);
    const bf16_t* P = (const bf16_t*)(p.ws + WS_P); bf16_t* ORAW = (bf16_t*)(p.ws + WS_ORAW);
    const float* lbl = p.in[7];
    for (int it = blockIdx.x; it < 64; it += gridDim.x) {
        const int b = it >> 3, h = it & 7;
        float S[128];
#pragma unroll
        for (int d = 0; d < 128; ++d) S[d] = 0.f;
        for (int tt = 0; tt < 32; ++tt) {
            __syncthreads();
            for (int i = tid; i < 64 * 16; i += NTHREADS) { const int t = i >> 4, dc = i & 15; const size_t ro = (size_t)(b * SEQ + tt * 64 + t) * NP + h * 128 + dc * 8;
                const u32x4 qv = *(const u32x4*)(P + ro + C_QB), fv = *(const u32x4*)(P + ro + C_FB), iv = *(const u32x4*)(P + ro + C_IB);
                const unsigned qa[4] = {qv.x, qv.y, qv.z, qv.w}, fa[4] = {fv.x, fv.y, fv.z, fv.w}, ia[4] = {iv.x, iv.y, iv.z, iv.w};
#pragma unroll
                for (int j = 0; j < 4; ++j) {
#pragma unroll
                    for (int e = 0; e < 2; ++e) { const int d = dc * 8 + 2 * j + e; const float qf = e ? bfhi(qa[j]) : bflo(qa[j]), fl = e ? bfhi(fa[j]) : bflo(fa[j]), vi = e ? bfhi(ia[j]) : bflo(ia[j]);
                        const float lb = sigmoidf_(lbl[h * 128 + d] - lbl[1024 + h * 128 + d]);
                        F[t * 128 + d] = lb + (1.f - lb) * sigmoidf_(fl); Q[t * 128 + d] = siluf_(qf); V[t * 128 + d] = vi; } } }
            __syncthreads();
            if (tid < 128) {
                for (int t = 0; t < 64; ++t) { const float v = V[t * 128 + tid]; float o = 0.f;
#pragma unroll
                    for (int d4 = 0; d4 < 32; ++d4) { const f32x4 f = *(const f32x4*)(F + t * 128 + d4 * 4), q = *(const f32x4*)(Q + t * 128 + d4 * 4);
#pragma unroll
                        for (int e = 0; e < 4; ++e) { const float s = fmaf(f[e], S[d4 * 4 + e] - v, v); S[d4 * 4 + e] = s; o = fmaf(s, q[e], o); } }
                    ORAW[(size_t)(b * SEQ + tt * 64 + t) * 1024 + h * 128 + tid] = (bf16_t)f2bf(o); }
            }
        }
    }
}

__device__ __forceinline__ void attn_task(const bf16_t* P, const bf16_t* VT, const unsigned* MASK, bf16_t* Pout, int b, int c, int qh, int head, int lane) {
    const int r = lane & 31, hh = lane >> 5;
    const int tq = b * SEQ + c * 64 + qh * 32 + r;
    bf16x8 qf[8];
    { const bf16_t* qp = P + (size_t)tq * NP + C_QA + head * 128 + 8 * hh;
#pragma unroll
      for (int ks = 0; ks < 8; ++ks) qf[ks] = *(const bf16x8*)(qp + ks * 16); }
    f32x16 o[4];
#pragma unroll
    for (int db = 0; db < 4; ++db)
#pragma unroll
        for (int i = 0; i < 16; ++i) o[db][i] = 0.f;
    float mrun = -1e30f, lsum = 0.f;
    const float sc = 0.08838834764831845f * 1.4426950408889634f;
    const int nkt = 2 * (c + 1);
    const bf16_t* kbase = P + (size_t)(b * SEQ + r) * NP + C_KA + head * 128 + 8 * hh;
    const bf16_t* vbase = VT + (size_t)((b * 8 + head) * 128 + r) * SEQ + 4 * hh;
    const unsigned* mrow = MASK + (size_t)tq * 64;
    for (int kt = 0; kt < nkt; ++kt) {
        const bf16_t* kp = kbase + (size_t)(kt * 32) * NP;
        f32x16 s;
#pragma unroll
        for (int i = 0; i < 16; ++i) s[i] = 0.f;
#pragma unroll
        for (int ks = 0; ks < 8; ++ks) { const bf16x8 kf = *(const bf16x8*)(kp + ks * 16); s = __builtin_amdgcn_mfma_f32_32x32x16_bf16(kf, qf[ks], s, 0, 0, 0); }
        const unsigned mw = mrow[kt];
        float mx = -1e30f;
#pragma unroll
        for (int i = 0; i < 16; ++i) { const int bit = (i & 3) + 8 * (i >> 2) + 4 * hh; const bool ok = (mw >> bit) & 1u; s[i] = ok ? s[i] * sc : -1e30f; mx = fmaxf(mx, s[i]); }
        mx = fmaxf(mx, __shfl_xor(mx, 32));
        const float mnew = fmaxf(mrun, mx), alpha = exp2f(mrun - mnew); mrun = mnew;
        float ps = 0.f; float pv[16];
#pragma unroll
        for (int i = 0; i < 16; ++i) { const float e = (s[i] > -1e29f) ? exp2f(s[i] - mnew) : 0.f; pv[i] = e; ps += e; }
        lsum = lsum * alpha + ps;
#pragma unroll
        for (int db = 0; db < 4; ++db)
#pragma unroll
            for (int i = 0; i < 16; ++i) o[db][i] *= alpha;
        bf16x8 pf[2];
#pragma unroll
        for (int s2 = 0; s2 < 2; ++s2) { u32x4 w; w.x = pk2(pv[8 * s2 + 0], pv[8 * s2 + 1]); w.y = pk2(pv[8 * s2 + 2], pv[8 * s2 + 3]); w.z = pk2(pv[8 * s2 + 4], pv[8 * s2 + 5]); w.w = pk2(pv[8 * s2 + 6], pv[8 * s2 + 7]); pf[s2] = __builtin_bit_cast(bf16x8, w); }
        const bf16_t* vp = vbase + kt * 32;
#pragma unroll
        for (int db = 0; db < 4; ++db)
#pragma unroll
            for (int s2 = 0; s2 < 2; ++s2) { const u32x2 lo = *(const u32x2*)(vp + (size_t)(db * 32) * SEQ + 16 * s2), hi = *(const u32x2*)(vp + (size_t)(db * 32) * SEQ + 16 * s2 + 8);
                u32x4 w; w.x = lo.x; w.y = lo.y; w.z = hi.x; w.w = hi.y;
                o[db] = __builtin_amdgcn_mfma_f32_32x32x16_bf16(__builtin_bit_cast(bf16x8, w), pf[s2], o[db], 0, 0, 0); }
    }
    const float l = lsum + __shfl_xor(lsum, 32), inv = 1.f / l;
    bf16_t* op = Pout + (size_t)tq * NP + C_QA + head * 128 + 4 * hh;
#pragma unroll
    for (int db = 0; db < 4; ++db)
#pragma unroll
        for (int g4 = 0; g4 < 4; ++g4) { u32x2 w; w.x = pk2(o[db][4 * g4] * inv, o[db][4 * g4 + 1] * inv); w.y = pk2(o[db][4 * g4 + 2] * inv, o[db][4 * g4 + 3] * inv);
            *(u32x2*)(op + db * 32 + 8 * g4) = w; }
}
__device__ __forceinline__ void phase_attn(const Params& p) {
    const int tid = threadIdx.x, wave = tid >> 6, lane = tid & 63;
    bf16_t* P = (bf16_t*)(p.ws + WS_P); const bf16_t* VT = (const bf16_t*)(p.ws + WS_VT); const unsigned* MASK = (const unsigned*)(p.ws + WS_MASK);
    const int G = gridDim.x;
    for (int rd = 0;; ++rd) {
        const int base = rd * G; if (base >= 512) break;
        const int pos = (rd & 1) ? (G - 1 - (int)blockIdx.x) : (int)blockIdx.x; const int i = base + pos; if (i >= 512) continue;
        const int c = 31 - (i >> 4), b = (i >> 1) & 7, qh = i & 1;
        attn_task(P, VT, MASK, P, b, c, qh, wave, lane);
    }
}
__device__ __forceinline__ void phase_rec(const Params& p) {
    const int tid = threadIdx.x, wave = tid >> 6, lane = tid & 63;
    bf16_t* P = (bf16_t*)(p.ws + WS_P); const bf16_t* ORAW = (const bf16_t*)(p.ws + WS_ORAW); const float* gain = p.in[8];
    const int gw = blockIdx.x * NWAVES + wave, NGW = gridDim.x * NWAVES;
    for (int row = gw; row < T; row += NGW) {
        const u32x4 a0 = *(const u32x4*)(ORAW + (size_t)row * 1024 + lane * 16), a1 = *(const u32x4*)(ORAW + (size_t)row * 1024 + lane * 16 + 8);
        const u32x4 g0 = *(const u32x4*)(P + (size_t)row * NP + C_GB + lane * 16), g1 = *(const u32x4*)(P + (size_t)row * NP + C_GB + lane * 16 + 8);
        const unsigned aw[8] = {a0.x, a0.y, a0.z, a0.w, a1.x, a1.y, a1.z, a1.w}, gwv[8] = {g0.x, g0.y, g0.z, g0.w, g1.x, g1.y, g1.z, g1.w};
        float v[16]; float ss = 0.f;
#pragma unroll
        for (int j = 0; j < 8; ++j) { v[2 * j] = bflo(aw[j]); v[2 * j + 1] = bfhi(aw[j]); ss += v[2 * j] * v[2 * j] + v[2 * j + 1] * v[2 * j + 1]; }
        ss += __shfl_xor(ss, 1); ss += __shfl_xor(ss, 2); ss += __shfl_xor(ss, 4);
        const float rstd = rsqrtf(ss * (1.f / 128.f) + NORM_EPS);
        const int e0 = (lane & 7) * 16; unsigned ow[8];
#pragma unroll
        for (int j = 0; j < 8; ++j) { const float r0 = v[2 * j] * rstd * gain[e0 + 2 * j] * siluf_(bflo(gwv[j])), r1 = v[2 * j + 1] * rstd * gain[e0 + 2 * j + 1] * siluf_(bfhi(gwv[j])); ow[j] = pk2(r0, r1); }
        u32x4 w0 = {ow[0], ow[1], ow[2], ow[3]}, w1 = {ow[4], ow[5], ow[6], ow[7]};
        *(u32x4*)(P + (size_t)row * NP + C_QB + lane * 16) = w0; *(u32x4*)(P + (size_t)row * NP + C_QB + lane * 16 + 8) = w1;
    }
}
__device__ __forceinline__ void phase_uv(const Params& p) {
    const size_t n = (size_t)16384 * 2048; const size_t i0 = ((size_t)blockIdx.x * NTHREADS + threadIdx.x) * 8, st = (size_t)gridDim.x * NTHREADS * 8;
    const float* u = p.in[14]; const float* v = p.in[15]; bf16_t* u16 = (bf16_t*)(p.ws + WS_U16); bf16_t* v16 = (bf16_t*)(p.ws + WS_V16);
    for (size_t i = i0; i < n; i += st) {
        const f32x4 a = *(const f32x4*)(u + i), b = *(const f32x4*)(u + i + 4), c = *(const f32x4*)(v + i), d = *(const f32x4*)(v + i + 4);
        u32x4 wu = {pk2(a[0], a[1]), pk2(a[2], a[3]), pk2(b[0], b[1]), pk2(b[2], b[3])}, wv = {pk2(c[0], c[1]), pk2(c[2], c[3]), pk2(d[0], d[1]), pk2(d[2], d[3])};
        *(u32x4*)(u16 + i) = wu; *(u32x4*)(v16 + i) = wv; }
}

#define INS16(v, x) do { _Pragma("unroll") for (int _j = 15; _j >= 1; --_j) v[_j] = __builtin_amdgcn_fmed3f(v[_j - 1], v[_j], (x)); v[0] = fmaxf(v[0], (x)); } while (0)
__device__ __forceinline__ void peer_half_top16(const bf16_t* QP, const bf16_t* KEYS, int tok, int p, int hf, int r, int hh, float (&v)[16]) {
    bf16x8 qf[8];
    { const bf16_t* qp = QP + (size_t)tok * D + p * 256 + hf * 128 + 8 * hh;
#pragma unroll
      for (int ks = 0; ks < 8; ++ks) qf[ks] = *(const bf16x8*)(qp + ks * 16); }
#pragma unroll
    for (int k = 0; k < 16; ++k) v[k] = -3.0e38f;
    const bf16_t* kb = KEYS + (size_t)((p * 2 + hf) * 128 + r) * 128 + 8 * hh;
#pragma unroll 1
    for (int nb = 0; nb < 4; ++nb) {
        f32x16 acc;
#pragma unroll
        for (int i = 0; i < 16; ++i) acc[i] = 0.f;
#pragma unroll
        for (int ks = 0; ks < 8; ++ks) { const bf16x8 kf = *(const bf16x8*)(kb + (size_t)(nb * 32) * 128 + ks * 16); acc = __builtin_amdgcn_mfma_f32_32x32x16_bf16(kf, qf[ks], acc, 0, 0, 0); }
#pragma unroll
        for (int i = 0; i < 16; ++i) { const unsigned xi = (unsigned)(nb * 32 + (i & 3) + 8 * (i >> 2) + 4 * hh); const float x = __uint_as_float((__float_as_uint(acc[i]) & ~0x7fu) | xi); INS16(v, x); }
    }
    float ov[16];
#pragma unroll
    for (int k = 0; k < 16; ++k) ov[k] = __shfl_xor(v[k], 32);
#pragma unroll
    for (int k = 0; k < 16; ++k) INS16(v, ov[k]);
}
__device__ __forceinline__ void phase_peer_topk(const Params& p) {
    const int tid = threadIdx.x, wave = tid >> 6, lane = tid & 63, r = lane & 31, hh = lane >> 5;
    const bf16_t* QP = (const bf16_t*)(p.ws + WS_QP); const bf16_t* KEYS = (const bf16_t*)(p.ws + WS_KEYS);
    int* EIDX = (int*)(p.ws + WS_EIDX); float* EGATE = (float*)(p.ws + WS_EGATE);
    const int gw = blockIdx.x * NWAVES + wave, NGW = gridDim.x * NWAVES;
    for (int it = gw; it < 512 * 8; it += NGW) {
        const int tg = it >> 3, hd = it & 7, tok = tg * 32 + r;
        float va[16], vb[16];
        peer_half_top16(QP, KEYS, tok, hd, 0, r, hh, va);
        peer_half_top16(QP, KEYS, tok, hd, 1, r, hh, vb);
        float bv[16];
#pragma unroll
        for (int k = 0; k < 16; ++k) bv[k] = -3.0e38f;
#pragma unroll
        for (int a = 0; a < 16; ++a)
#pragma unroll
            for (int b2 = 0; b2 < 16; ++b2) if ((a + 1) * (b2 + 1) <= 16) { const float x = va[a] + vb[b2]; INS16(bv, x); }
        float se = 0.f;
#pragma unroll
        for (int k = 0; k < 16; ++k) se += __expf(bv[k] - bv[0]);
        const float inv = 1.f / se, thr = bv[15], top = bv[0];
        int cnt = 0; int* ei = EIDX + (size_t)tok * 128 + hd * 16; float* eg = EGATE + (size_t)tok * 128 + hd * 16;
#pragma unroll
        for (int a = 0; a < 16; ++a)
#pragma unroll
            for (int b2 = 0; b2 < 16; ++b2) if ((a + 1) * (b2 + 1) <= 16) { const float x = va[a] + vb[b2];
                if (x >= thr && cnt < 16) { if (hh == 0) { ei[cnt] = (int)((__float_as_uint(va[a]) & 0x7fu) * 128u + (__float_as_uint(vb[b2]) & 0x7fu)); eg[cnt] = __expf(x - top) * inv; } ++cnt; } }
    }
}

__device__ __forceinline__ void unpack8(const u32x4 w, float* f) { f[0] = bflo(w.x); f[1] = bfhi(w.x); f[2] = bflo(w.y); f[3] = bfhi(w.y); f[4] = bflo(w.z); f[5] = bfhi(w.z); f[6] = bflo(w.w); f[7] = bfhi(w.w); }
__device__ __forceinline__ void phase_experts(const Params& p) {
    const int tid = threadIdx.x, wave = tid >> 6, lane = tid & 63;
    const bf16_t* H2 = (const bf16_t*)(p.ws + WS_H2); const bf16_t* U16 = (const bf16_t*)(p.ws + WS_U16); const bf16_t* V16 = (const bf16_t*)(p.ws + WS_V16);
    const int* EIDX = (const int*)(p.ws + WS_EIDX); const float* EGATE = (const float*)(p.ws + WS_EGATE);
    const float* mod = (const float*)(p.ws + WS_MOD); const float* fin = p.in[16]; float* out = p.out;
    const int gw = blockIdx.x * NWAVES + wave, NGW = gridDim.x * NWAVES;
    for (int tok = gw; tok < T; tok += NGW) {
        const int b = tok >> 11;
        float hv[32], oacc[32];
#pragma unroll
        for (int j = 0; j < 4; ++j) { const u32x4 w = *(const u32x4*)(H2 + (size_t)tok * D + 8 * lane + 512 * j); unpack8(w, hv + 8 * j); }
#pragma unroll
        for (int k = 0; k < 32; ++k) oacc[k] = 0.f;
        const int ei0 = EIDX[(size_t)tok * 128 + lane], ei1 = EIDX[(size_t)tok * 128 + 64 + lane];
        const float eg0 = EGATE[(size_t)tok * 128 + lane], eg1 = EGATE[(size_t)tok * 128 + 64 + lane];
#pragma unroll 1
        for (int e0 = 0; e0 < 128; e0 += 4) {
            u32x4 uw[4][4], vw[4][4]; float gt[4];
#pragma unroll
            for (int q = 0; q < 4; ++q) { const int e = e0 + q; const int idx = (e < 64) ? __builtin_amdgcn_readlane(ei0, e & 63) : __builtin_amdgcn_readlane(ei1, e & 63);
                gt[q] = __int_as_float((e < 64) ? __builtin_amdgcn_readlane(__float_as_int(eg0), e & 63) : __builtin_amdgcn_readlane(__float_as_int(eg1), e & 63));
                const bf16_t* ur = U16 + (size_t)idx * D + 8 * lane; const bf16_t* vr = V16 + (size_t)idx * D + 8 * lane;
#pragma unroll
                for (int j = 0; j < 4; ++j) { uw[q][j] = *(const u32x4*)(ur + 512 * j); vw[q][j] = *(const u32x4*)(vr + 512 * j); } }
            float dot[4];
#pragma unroll
            for (int q = 0; q < 4; ++q) { float s = 0.f;
#pragma unroll
                for (int j = 0; j < 4; ++j) { float f[8]; unpack8(uw[q][j], f);
#pragma unroll
                    for (int k = 0; k < 8; ++k) s = fmaf(f[k], hv[8 * j + k], s); }
                dot[q] = s; }
#pragma unroll
            for (int o = 1; o < 64; o <<= 1) {
#pragma unroll
                for (int q = 0; q < 4; ++q) dot[q] += __shfl_xor(dot[q], o); }
#pragma unroll
            for (int q = 0; q < 4; ++q) { const float z = dot[q]; const float act = 0.5f * z * (1.f + erff(z * 0.70710678118654752f)) * gt[q];
#pragma unroll
                for (int j = 0; j < 4; ++j) { float f[8]; unpack8(vw[q][j], f);
#pragma unroll
                    for (int k = 0; k < 8; ++k) oacc[8 * j + k] = fmaf(act, f[k], oacc[8 * j + k]); } }
        }
        float x2[32]; float ss = 0.f;
#pragma unroll
        for (int j = 0; j < 4; ++j) { const int col = 8 * lane + 512 * j;
            const f32x4 a = *(const f32x4*)(out + (size_t)tok * D + col), c = *(const f32x4*)(out + (size_t)tok * D + col + 4);
            const f32x4 g0 = *(const f32x4*)(mod + (size_t)b * NADA + 5 * 2048 + col), g1 = *(const f32x4*)(mod + (size_t)b * NADA + 5 * 2048 + col + 4);
#pragma unroll
            for (int k = 0; k < 4; ++k) { x2[8 * j + k] = a[k] + g0[k] * oacc[8 * j + k]; x2[8 * j + 4 + k] = c[k] + g1[k] * oacc[8 * j + 4 + k]; }
#pragma unroll
            for (int k = 0; k < 8; ++k) ss = fmaf(x2[8 * j + k], x2[8 * j + k], ss); }
        const float rstd = rsqrtf(wave_sum(ss) * (1.f / D) + NORM_EPS);
#pragma unroll
        for (int j = 0; j < 4; ++j) { const int col = 8 * lane + 512 * j; const f32x4 f0 = *(const f32x4*)(fin + col), f1 = *(const f32x4*)(fin + col + 4);
            f32x4 o0, o1;
#pragma unroll
            for (int k = 0; k < 4; ++k) { o0[k] = x2[8 * j + k] * rstd * f0[k]; o1[k] = x2[8 * j + 4 + k] * rstd * f1[k]; }
            *(f32x4*)(out + (size_t)tok * D + col) = o0; *(f32x4*)(out + (size_t)tok * D + col + 4) = o1; }
    }
}

constexpr int NPHASES = 11;
__global__ void __launch_bounds__(NTHREADS, 2) mega_fwd(Params p) {
    extern __shared__ __attribute__((aligned(16))) unsigned char lds[];
    cg::grid_group grid = cg::this_grid();
    const int lo = p.ph_lo, hi = p.ph_hi;
#ifndef PHASE_MASK
#define PHASE_MASK 0x7ff
#endif
#define IN(k) (((PHASE_MASK >> (k)) & 1) && lo <= (k) && (k) < hi)
#define SEAM(k) do { if (IN(k) && IN((k) + 1)) grid.sync(); } while (0)
    unsigned char* ws = p.ws;
    bf16_t* P = (bf16_t*)(ws + WS_P);
    bf16_t* Hb = (bf16_t*)((unsigned char*)p.out + OUT_H);
    bf16_t* WinT = (bf16_t*)((unsigned char*)p.out + OUT_WIN);
    const float* mod = (const float*)(ws + WS_MOD);
    LAS unsigned char* ldsl = (LAS unsigned char*)lds;

    if (IN(0)) { phase_mod(p, lds); __syncthreads(); phase_weights(p, lds); }
    SEAM(0);
    if (IN(1)) { phase_norm_rows(p.in[0], p.in[4], mod, mod + 2048, Hb); }
    SEAM(1);
    if (IN(2)) { pg8::Gemm g{Hb, WinT, nullptr, nullptr, D, D, T, NP, D}; pg8::StaticOrder<1> S; S.init(T, NP, gridDim.x, blockIdx.x);
        pg8::EpiBf16 E{P, NP, 33}; pg8::gemm_phase(ldsl, g, S, E); }
    SEAM(2);
    if (IN(3)) { phase_vt(p, lds); phase_indexer(p); __syncthreads(); phase_hgrn_naive(p, lds); }
    SEAM(3);
    if (IN(4)) { phase_attn(p); phase_rec(p); }
    SEAM(4);
    if (IN(5)) { pg8::Gemm g{P + C_QA, (const bf16_t*)(ws + WS_WUA), P + C_QB, (const bf16_t*)(ws + WS_WUB), NP, 1024, T, D, 1024}; pg8::StaticOrder<2> S; S.init(T, D, gridDim.x, blockIdx.x);
        pg8::EpiMix E{(bf16_t*)(ws + WS_MIXED), P}; pg8::gemm_phase(ldsl, g, S, E); }
    SEAM(5);
    if (IN(6)) { pg8::Gemm g{(const bf16_t*)(ws + WS_MIXED), (const bf16_t*)(ws + WS_WOUT), nullptr, nullptr, D, D, T, D, D}; pg8::StaticOrder<1> S; S.init(T, D, gridDim.x, blockIdx.x);
        pg8::EpiX1 E{p.in[0], p.out, mod + 4096}; pg8::gemm_phase(ldsl, g, S, E); }
    SEAM(6);
    if (IN(7)) { phase_norm_rows(p.out, p.in[5], mod + 3 * 2048, mod + 4 * 2048, (bf16_t*)(ws + WS_H2)); phase_uv(p); }
    SEAM(7);
    if (IN(8)) { pg8::Gemm g{(const bf16_t*)(ws + WS_H2), (const bf16_t*)(ws + WS_WQ), nullptr, nullptr, D, D, T, D, D}; pg8::StaticOrder<1> S; S.init(T, D, gridDim.x, blockIdx.x);
        pg8::EpiBf16 E{(bf16_t*)(ws + WS_QP), D, 1 << 30}; pg8::gemm_phase(ldsl, g, S, E); }
    SEAM(8);
    if (IN(9)) { phase_peer_topk(p); }
    SEAM(9);
    if (IN(10)) { phase_experts(p); }
#undef IN
#undef SEAM
}

#ifndef MK_N_LAUNCHES
#define MK_N_LAUNCHES 1
#endif
extern "C" void kernel_launch(void* const* d_in, const int* in_sizes, int n_in, void* d_out, int out_size, void* d_ws, size_t ws_size, hipStream_t stream) {
    static int grid = 0;
    if (grid == 0) {
        if (n_in != 17 || out_size != T * D || ws_size < WS_END) { fprintf(stderr, "kernel_launch: unexpected shapes (n_in %d out %d ws %zu)\n", n_in, out_size, ws_size); grid = -1; return; }
        int dev = 0, cus = 0, per_cu = 0;
        hipGetDevice(&dev); hipDeviceGetAttribute(&cus, hipDeviceAttributeMultiprocessorCount, dev);
        hipFuncSetAttribute((const void*)mega_fwd, hipFuncAttributeMaxDynamicSharedMemorySize, LDS_BYTES);
        hipOccupancyMaxActiveBlocksPerMultiprocessor(&per_cu, (const void*)mega_fwd, NTHREADS, LDS_BYTES);
        if (per_cu < 1) { fprintf(stderr, "kernel_launch: occupancy query says %d blocks/CU\n", per_cu); per_cu = 1; }
        (void)hipGetLastError();
        grid = cus * 1;
    }
    if (grid < 0) return;
    Params p{};
    for (int i = 0; i < 17; ++i) p.in[i] = (const float*)d_in[i];
    p.out = (float*)d_out; p.ws = (unsigned char*)d_ws;
#if MK_N_LAUNCHES == 1
    p.ph_lo = 0; p.ph_hi = NPHASES;
    void* args[] = {&p};
    hipError_t e = hipLaunchCooperativeKernel((const void*)mega_fwd, dim3(grid), dim3(NTHREADS), args, LDS_BYTES, stream);
    if (e != hipSuccess) fprintf(stderr, "cooperative launch failed: %s (grid %d)\n", hipGetErrorString(e), grid);
#else
    for (int k = 0; k < NPHASES; ++k) { p.ph_lo = k; p.ph_hi = k + 1; void* args[] = {&p};
        hipError_t e = hipLaunchCooperativeKernel((const void*)mega_fwd, dim3(grid), dim3(NTHREADS), args, LDS_BYTES, stream);
        if (e != hipSuccess) { fprintf(stderr, "launch %d failed: %s\n", k, hipGetErrorString(e)); break; } }
#endif
}
```

```cpp
#include <hip/hip_runtime.h>
#include <hip/hip_cooperative_groups.h>
#include <cstdio>
#include <cstdint>
namespace cg = cooperative_groups;

#define LAS __attribute__((address_space(3)))
typedef unsigned short bf16_t;
typedef short bf16x8 __attribute__((ext_vector_type(8)));
typedef short bf16x4 __attribute__((ext_vector_type(4)));
typedef float f32x2 __attribute__((ext_vector_type(2)));
typedef float f32x4 __attribute__((ext_vector_type(4)));
typedef float f32x16 __attribute__((ext_vector_type(16)));
typedef unsigned u32x2 __attribute__((ext_vector_type(2)));
typedef unsigned u32x4 __attribute__((ext_vector_type(4)));

constexpr int T = 16384, D = 2048, SEQ = 2048, NBATCH = 8, NP = 12544;
constexpr int C_QA = 0, C_KA = 1024, C_VA = 2048, C_QI = 3072, C_KI = 4096, C_WI = 4160, C_QB = 4352, C_FB = 5376, C_IB = 6400, C_GB = 7424, C_GA = 8448, C_GG = 10496;
constexpr int NADA = 12288;
constexpr float NORM_EPS = 1e-6f;
constexpr int NTHREADS = 512, NWAVES = 8;
constexpr int LDS_BYTES = 147456;
constexpr size_t MiB = 1u << 20;
constexpr size_t WS_CTL = 0, WS_MOD = 1 * MiB, WS_WUA = 2 * MiB, WS_WUB = 6 * MiB, WS_WOUT = 10 * MiB, WS_WQ = 18 * MiB, WS_KEYS = 26 * MiB, WS_MASK = 27 * MiB;
constexpr size_t WS_MIXED = 32 * MiB;
constexpr size_t WS_VT = 32 * MiB, WS_ORAW = 64 * MiB;
constexpr size_t WS_P = 96 * MiB;
constexpr size_t WS_H2 = 96 * MiB, WS_QP = 160 * MiB, WS_U16 = 224 * MiB, WS_V16 = 288 * MiB, WS_EIDX = 352 * MiB, WS_EGATE = 360 * MiB;
constexpr size_t WS_X1 = 368 * MiB;
constexpr size_t WS_END = 496 * MiB;
constexpr size_t OUT_H = 0, OUT_WIN = 64 * MiB;
constexpr size_t OUT_AO = 0, OUT_REC = 32 * MiB;

struct Params { const float* in[17]; float* out; unsigned char* ws; int ph_lo, ph_hi; };

__device__ __forceinline__ unsigned f2bf(float f) { unsigned u = __float_as_uint(f); return (u + 0x7fffu + ((u >> 16) & 1u)) >> 16; }
__device__ __forceinline__ float bf2f(unsigned b) { return __uint_as_float(b << 16); }
__device__ __forceinline__ float bflo(unsigned w) { return __uint_as_float(w << 16); }
__device__ __forceinline__ float bfhi(unsigned w) { return __uint_as_float(w & 0xffff0000u); }
__device__ __forceinline__ unsigned pk2(float lo, float hi) { unsigned r; asm volatile("v_cvt_pk_bf16_f32 %0, %1, %2" : "=v"(r) : "v"(lo), "v"(hi)); return r; }
__device__ __forceinline__ float wave_sum(float v) {
#pragma unroll
    for (int o = 1; o < 64; o <<= 1) v += __shfl_xor(v, o);
    return v;
}
__device__ __forceinline__ float sigmoidf_(float v) { return 1.f / (1.f + __expf(-v)); }
__device__ __forceinline__ float siluf_(float v) { return v / (1.f + __expf(-v)); }
#define LDS_WAIT() asm volatile("s_waitcnt lgkmcnt(0)" ::: "memory")

namespace pg8 {
constexpr int BM = 256, BK = 64, HALF = 128, HTB = HALF * BK * 2, STAGE_BYTES = 8 * HTB, NXCD = 8, WGM = 8;
__host__ __device__ __forceinline__ int lds_byte(int r, int c) { const int st = (r >> 4) * 2 + (c >> 5), rr = r & 15, cc = c & 31, ob = rr * 64 + cc * 2; return st * 1024 + (ob ^ (((ob >> 9) & 1) << 5)); }
__host__ __device__ __forceinline__ void stage_rc(int b, int& R, int& C) { const int st = b / 1024, sb = b % 1024, swz = sb ^ (((sb >> 9) & 1) << 5); R = (st >> 1) * 16 + swz / 64; C = (st & 1) * 32 + (swz % 64) / 2; }
__host__ __device__ __forceinline__ int perm32(int rho) { const int n = rho >> 4, i = rho & 15; return 8 * (i >> 2) + 4 * n + (i & 3); }

struct Unit { int pm, pn, z; };
struct Gemm { const bf16_t* A; const bf16_t* Bt; const bf16_t* A2; const bf16_t* Bt2; int lda, ldb, M, N, K; };

template <int NZ> struct StaticOrder {
    int nM, nN, nwg, G, c;
    __device__ void init(int M, int N, int G_, int c_) { nM = M / BM; nN = N / BM; nwg = nM * nN; G = G_; c = c_; }
    __device__ bool next(int i, Unit& u) const {
        const long L = (long)(i / NZ) * G + c; if (L >= nwg) return false;
        int wgid = (int)L; { const int q = nwg / NXCD, r = nwg % NXCD, xcd = wgid % NXCD, off = wgid / NXCD; wgid = (xcd < r ? xcd * (q + 1) : r * (q + 1) + (xcd - r) * q) + off; }
        const int nig = WGM * nN, gid = wgid / nig, fm = gid * WGM, gsz = (nM - fm) < WGM ? (nM - fm) : WGM;
        u.pm = fm + ((wgid % nig) % gsz); u.pn = (wgid % nig) / gsz; u.z = i % NZ; return true;
    }
};

template <class Epi, class Sched>
__device__ __forceinline__ void gemm_phase(LAS unsigned char* lds, const Gemm g, const Sched& S, const Epi& E) {
    const int tid = threadIdx.x, wid = __builtin_amdgcn_readfirstlane(tid >> 6), lane = tid & 63, wr = wid >> 2, wc = wid & 3, fr = lane & 15, fq = lane >> 4;
    const int K = g.K, nt = K / BK;
    unsigned voffA[2], voffB[2];
#pragma unroll
    for (int i = 0; i < 2; ++i) { int R, C; stage_rc(tid * 16 + i * 8192, R, C); const int Rb = Epi::PERM ? ((R & ~31) + perm32(R & 31)) : R;
        voffA[i] = (unsigned)(R * g.lda + C) * 2u; voffB[i] = (unsigned)(Rb * g.ldb + C) * 2u; }
    const size_t kstep = (size_t)(BK * 2);
    const size_t hstepA = (size_t)HALF * g.lda * 2, hstepB = (size_t)HALF * g.ldb * 2;
    const size_t tstepA = 2 * hstepA, tstepB = 2 * hstepB;
    const unsigned ldsw = (unsigned)wid * 1024u;
    const int aoff = lds_byte(wr * 64 + fr, fq * 8), boff = lds_byte(wc * 32 + fr, fq * 8);
#define PG8_SA(b, h) (((b) * 2 + (h)) * HTB)
#define PG8_SB(b, h) ((4 + (b) * 2 + (h)) * HTB)
#define PG8_STAGE(bufoff, gbase, voff) do { _Pragma("unroll") for (int _i = 0; _i < 2; ++_i) \
        __builtin_amdgcn_global_load_lds((const unsigned*)((const char*)(gbase) + (voff)[_i]), (LAS unsigned*)(lds + (bufoff) + ldsw + _i * 8192), 16, 0, 0); } while (0)
#define PG8_LDA(dst, b, h) do { _Pragma("unroll") for (int m = 0; m < 4; ++m) _Pragma("unroll") for (int k = 0; k < 2; ++k) dst[m][k] = *(const LAS bf16x8*)(lds + PG8_SA(b, h) + aoff + m * 2048 + k * 1024); } while (0)
#define PG8_LDB(dst, b, h) do { _Pragma("unroll") for (int n = 0; n < 2; ++n) _Pragma("unroll") for (int k = 0; k < 2; ++k) dst[n][k] = *(const LAS bf16x8*)(lds + PG8_SB(b, h) + boff + n * 2048 + k * 1024); } while (0)
#define PG8_MMA(ai, bj, At, Bt) do { __builtin_amdgcn_s_setprio(1); _Pragma("unroll") for (int m = 0; m < 4; ++m) _Pragma("unroll") for (int n = 0; n < 2; ++n) _Pragma("unroll") for (int k = 0; k < 2; ++k) \
        acc[ai][bj][m][n] = __builtin_amdgcn_mfma_f32_16x16x32_bf16(Bt[n][k], At[m][k], acc[ai][bj][m][n], 0, 0, 0); __builtin_amdgcn_s_setprio(0); } while (0)
#define PG8_WAIT_V(n) asm volatile("s_waitcnt vmcnt(" #n ")" ::: "memory")
#define PG8_WAIT_L(n) asm volatile("s_waitcnt lgkmcnt(" #n ")" ::: "memory")
#define PG8_BAR __builtin_amdgcn_s_barrier()
#define PG8_SCHED __builtin_amdgcn_sched_barrier(0)
#define PG8_ABASE(u) ((const char*)((u).z ? g.A2 : g.A) + (size_t)(u).pm * tstepA)
#define PG8_BBASE(u) ((const char*)((u).z ? g.Bt2 : g.Bt) + (size_t)(u).pn * tstepB)
    Unit cur, nxt; int ui = 0;
    if (!S.next(0, cur)) return;
    f32x4 acc[2][2][4][2];
#pragma unroll
    for (int a = 0; a < 2; ++a)
#pragma unroll
        for (int b = 0; b < 2; ++b)
#pragma unroll
            for (int m = 0; m < 4; ++m)
#pragma unroll
                for (int n = 0; n < 2; ++n) acc[a][b][m][n] = (f32x4){0.f, 0.f, 0.f, 0.f};
    bf16x8 At[4][2], B0[2][2], B1[2][2];
    const char* cA = PG8_ABASE(cur); const char* cB = PG8_BBASE(cur);
    PG8_STAGE(PG8_SB(0, 0), cB, voffB); PG8_STAGE(PG8_SA(0, 0), cA, voffA); PG8_STAGE(PG8_SB(0, 1), cB + hstepB, voffB); PG8_STAGE(PG8_SA(0, 1), cA + hstepA, voffA);
    if (wr == 1) PG8_BAR;
    PG8_WAIT_V(4); PG8_BAR;
    PG8_STAGE(PG8_SB(1, 0), cB + kstep, voffB); PG8_STAGE(PG8_SA(1, 0), cA + kstep, voffA); PG8_STAGE(PG8_SB(1, 1), cB + hstepB + kstep, voffB);
    PG8_WAIT_V(6); PG8_BAR;
    for (;;) {
        const bool has_next = S.next(ui + 1, nxt);
        const char* nA = has_next ? PG8_ABASE(nxt) : cA; const char* nB = has_next ? PG8_BBASE(nxt) : cB;
        for (int t = 0; t < nt; t += 2) {
            const bool last = (t == nt - 2);
            const char* a1 = cA + (size_t)(t + 1) * kstep;
            const char* a2 = last ? nA : cA + (size_t)(t + 2) * kstep; const char* b2 = last ? nB : cB + (size_t)(t + 2) * kstep;
            const char* a3 = a2 + kstep; const char* b3 = b2 + kstep;
            PG8_LDB(B0, 0, 0); PG8_SCHED; PG8_LDA(At, 0, 0); PG8_STAGE(PG8_SA(1, 1), a1 + hstepA, voffA);
            PG8_WAIT_L(8); PG8_BAR; PG8_WAIT_L(0); PG8_MMA(0, 0, At, B0); PG8_BAR; PG8_SCHED;
            PG8_LDB(B1, 0, 1); PG8_STAGE(PG8_SB(0, 0), b2, voffB);
            PG8_BAR; PG8_WAIT_L(0); PG8_MMA(0, 1, At, B1); PG8_BAR;
            PG8_LDA(At, 0, 1); PG8_STAGE(PG8_SA(0, 0), a2, voffA);
            PG8_BAR; PG8_WAIT_L(0); PG8_MMA(1, 0, At, B0); PG8_BAR; PG8_SCHED;
            PG8_STAGE(PG8_SB(0, 1), b2 + hstepB, voffB);
            PG8_WAIT_V(6); PG8_BAR; PG8_MMA(1, 1, At, B1); PG8_BAR;
            PG8_LDB(B0, 1, 0); PG8_SCHED; PG8_LDA(At, 1, 0); PG8_STAGE(PG8_SA(0, 1), a2 + hstepA, voffA);
            PG8_WAIT_L(8); PG8_BAR; PG8_WAIT_L(0); PG8_MMA(0, 0, At, B0); PG8_BAR; PG8_SCHED;
            PG8_LDB(B1, 1, 1); PG8_STAGE(PG8_SB(1, 0), b3, voffB);
            PG8_BAR; PG8_WAIT_L(0); PG8_MMA(0, 1, At, B1); PG8_BAR;
            PG8_LDA(At, 1, 1); PG8_STAGE(PG8_SA(1, 0), a3, voffA);
            PG8_BAR; PG8_WAIT_L(0); PG8_MMA(1, 0, At, B0); PG8_BAR; PG8_SCHED;
            PG8_STAGE(PG8_SB(1, 1), b3 + hstepB, voffB);
            PG8_WAIT_V(6); PG8_BAR; PG8_MMA(1, 1, At, B1); PG8_BAR;
        }
        E(acc, cur, wr, wc, fr, fq);
        if (!has_next) break;
#pragma unroll
        for (int a = 0; a < 2; ++a)
#pragma unroll
            for (int b = 0; b < 2; ++b)
#pragma unroll
                for (int m = 0; m < 4; ++m)
#pragma unroll
                    for (int n = 0; n < 2; ++n) acc[a][b][m][n] = (f32x4){0.f, 0.f, 0.f, 0.f};
        cur = nxt; cA = nA; cB = nB; ++ui;
    }
    PG8_WAIT_V(0);
    if (wr == 0) PG8_BAR;
    PG8_BAR;
#undef PG8_SA
#undef PG8_SB
#undef PG8_STAGE
#undef PG8_LDA
#undef PG8_LDB
#undef PG8_MMA
#undef PG8_WAIT_V
#undef PG8_WAIT_L
#undef PG8_BAR
#undef PG8_SCHED
#undef PG8_ABASE
#undef PG8_BBASE
}

struct EpiBf16 {
    static constexpr bool PERM = true;
    bf16_t* O; int ldc; int sig_from;
    __device__ __forceinline__ void operator()(const f32x4 (&acc)[2][2][4][2], const Unit& u, int wr, int wc, int fr, int fq) const {
        const int row0 = u.pm * BM + wr * 64 + fr, col0 = u.pn * BM + wc * 32 + 8 * fq; const bool sig = u.pn >= sig_from;
#pragma unroll
        for (int ai = 0; ai < 2; ++ai)
#pragma unroll
            for (int m = 0; m < 4; ++m) { bf16_t* rowp = O + (size_t)(row0 + ai * HALF + m * 16) * ldc + col0;
#pragma unroll
                for (int bj = 0; bj < 2; ++bj) { f32x4 v0 = acc[ai][bj][m][0], v1 = acc[ai][bj][m][1];
                    if (sig) {
#pragma unroll
                        for (int j = 0; j < 4; ++j) { v0[j] = sigmoidf_(v0[j]); v1[j] = sigmoidf_(v1[j]); } }
                    u32x4 w; w.x = pk2(v0[0], v0[1]); w.y = pk2(v0[2], v0[3]); w.z = pk2(v1[0], v1[1]); w.w = pk2(v1[2], v1[3]);
                    *(u32x4*)(rowp + bj * HALF) = w; } }
    }
};
struct EpiMix {
    static constexpr bool PERM = true;
    bf16_t* O; const bf16_t* P;
    __device__ __forceinline__ void operator()(const f32x4 (&acc)[2][2][4][2], const Unit& u, int wr, int wc, int fr, int fq) const {
        const int row0 = u.pm * BM + wr * 64 + fr, col0 = u.pn * BM + wc * 32 + 8 * fq; const int gcol = (u.z ? C_GG : C_GA);
#pragma unroll
        for (int ai = 0; ai < 2; ++ai)
#pragma unroll
            for (int m = 0; m < 4; ++m) { const size_t r = (size_t)(row0 + ai * HALF + m * 16);
#pragma unroll
                for (int bj = 0; bj < 2; ++bj) { const f32x4 v0 = acc[ai][bj][m][0], v1 = acc[ai][bj][m][1];
                    const u32x4 gw = *(const u32x4*)(P + r * NP + gcol + col0 + bj * HALF);
                    float o[8] = {v0[0] * bflo(gw.x), v0[1] * bfhi(gw.x), v0[2] * bflo(gw.y), v0[3] * bfhi(gw.y), v1[0] * bflo(gw.z), v1[1] * bfhi(gw.z), v1[2] * bflo(gw.w), v1[3] * bfhi(gw.w)};
                    bf16_t* op = O + r * D + col0 + bj * HALF;
                    if (u.z) { const u32x4 pw = *(const u32x4*)op; o[0] += bflo(pw.x); o[1] += bfhi(pw.x); o[2] += bflo(pw.y); o[3] += bfhi(pw.y); o[4] += bflo(pw.z); o[5] += bfhi(pw.z); o[6] += bflo(pw.w); o[7] += bfhi(pw.w); }
                    u32x4 w; w.x = pk2(o[0], o[1]); w.y = pk2(o[2], o[3]); w.z = pk2(o[4], o[5]); w.w = pk2(o[6], o[7]);
                    *(u32x4*)op = w; } }
    }
};
struct EpiX1 {
    static constexpr bool PERM = false;
    const float* x; float* out; const float* gate;
    __device__ __forceinline__ void operator()(const f32x4 (&acc)[2][2][4][2], const Unit& u, int wr, int wc, int fr, int fq) const {
        const int row0 = u.pm * BM + wr * 64 + fr, col0 = u.pn * BM + wc * 32 + 4 * fq; const int b = (u.pm * BM) >> 11;
        f32x4 gv[2][2];
#pragma unroll
        for (int bj = 0; bj < 2; ++bj)
#pragma unroll
            for (int n = 0; n < 2; ++n) gv[bj][n] = *(const f32x4*)(gate + (size_t)b * NADA + col0 + bj * HALF + n * 16);
#pragma unroll
        for (int ai = 0; ai < 2; ++ai)
#pragma unroll
            for (int m = 0; m < 4; ++m) { const size_t off = (size_t)(row0 + ai * HALF + m * 16) * D + col0;
#pragma unroll
                for (int bj = 0; bj < 2; ++bj)
#pragma unroll
                    for (int n = 0; n < 2; ++n) { const f32x4 xv = *(const f32x4*)(x + off + bj * HALF + n * 16);
                        *(f32x4*)(out + off + bj * HALF + n * 16) = xv + gv[bj][n] * acc[ai][bj][m][n]; } }
    }
};
}

__device__ __forceinline__ void phase_mod(const Params& p, unsigned char* lds) {
    float* sc = (float*)lds;
    float* red = (float*)(lds + 65536);
    const int tid = threadIdx.x, wave = tid >> 6, lane = tid & 63;
    const float* c = p.in[1]; const float* wada = p.in[2]; const float* bada = p.in[3];
    float* mod = (float*)(p.ws + WS_MOD);
    if ((int)blockIdx.x >= 192) return;
    for (int i = tid; i < NBATCH * D; i += NTHREADS) { const int b = i >> 11, k = i & 2047; sc[k * 8 + b] = siluf_(c[i]); }
    __syncthreads();
    const int cgp = tid & 15, rg = tid >> 4;
    for (int item = blockIdx.x; item < 192; item += gridDim.x) {
        const float* w = wada + item * 64 + cgp * 4;
        float acc[8][4];
#pragma unroll
        for (int b = 0; b < 8; ++b)
#pragma unroll
            for (int j = 0; j < 4; ++j) acc[b][j] = 0.f;
#pragma unroll 4
        for (int i = 0; i < 64; ++i) { const int k = rg + 32 * i; const f32x4 wv = *(const f32x4*)(w + (size_t)k * NADA);
            const f32x4 s0 = *(const f32x4*)(sc + k * 8), s1 = *(const f32x4*)(sc + k * 8 + 4);
#pragma unroll
            for (int j = 0; j < 4; ++j) { acc[0][j] += s0[0] * wv[j]; acc[1][j] += s0[1] * wv[j]; acc[2][j] += s0[2] * wv[j]; acc[3][j] += s0[3] * wv[j];
                acc[4][j] += s1[0] * wv[j]; acc[5][j] += s1[1] * wv[j]; acc[6][j] += s1[2] * wv[j]; acc[7][j] += s1[3] * wv[j]; } }
#pragma unroll
        for (int b = 0; b < 8; ++b)
#pragma unroll
            for (int j = 0; j < 4; ++j) { float v = acc[b][j]; v += __shfl_xor(v, 16); v += __shfl_xor(v, 32); acc[b][j] = v; }
        if (lane < 16) {
#pragma unroll
            for (int b = 0; b < 8; ++b)
#pragma unroll
                for (int j = 0; j < 4; ++j) red[(wave * 16 + cgp) * 32 + b * 4 + j] = acc[b][j]; }
        __syncthreads();
        { const int cgo = tid >> 5, b = (tid >> 2) & 7, j = tid & 3; float s = 0.f;
#pragma unroll
          for (int w8 = 0; w8 < 8; ++w8) s += red[(w8 * 16 + cgo) * 32 + (tid & 31)];
          const int col = item * 64 + cgo * 4 + j; mod[b * NADA + col] = s + bada[col]; }
        __syncthreads();
    }
}
__device__ __forceinline__ void transpose_item(const float* W, int K, int N, bf16_t* WT, int nblk, int item, int lane, float* scr, int mode) {
    const int kb = item / nblk, nb = item % nblk, k0 = 64 * kb, n0 = 32 * nb;
    const int nd = n0 + (lane & 31); int ns = nd; bool valid = true;
    if (mode == 1) { if (nd >= C_QB) ns = nd - 176; else if (nd >= 4176) valid = false; }
#pragma unroll 8
    for (int i = 0; i < 32; ++i) { const int kk = 2 * i + (lane >> 5); scr[kk * 33 + (lane & 31)] = valid ? W[(size_t)(k0 + kk) * N + ns] : 0.f; }
    LDS_WAIT();
    const int c = lane & 7;
#pragma unroll
    for (int j = 0; j < 4; ++j) { const int n = (lane >> 3) + 8 * j; const float* s = scr + (8 * c) * 33 + n;
        u32x4 o; o.x = pk2(s[0 * 33], s[1 * 33]); o.y = pk2(s[2 * 33], s[3 * 33]); o.z = pk2(s[4 * 33], s[5 * 33]); o.w = pk2(s[6 * 33], s[7 * 33]);
        *(u32x4*)(WT + (size_t)(n0 + n) * K + k0 + 8 * c) = o; }
    LDS_WAIT();
}
__device__ __forceinline__ void phase_weights(const Params& p, unsigned char* lds) {
    const int tid = threadIdx.x, wave = tid >> 6, lane = tid & 63;
    float* scr = (float*)(lds + wave * 16384);
    const int vb = ((int)blockIdx.x + (int)gridDim.x - 192 % (int)gridDim.x) % (int)gridDim.x;
    const int gw = vb * NWAVES + wave, NGW = gridDim.x * NWAVES;
    constexpr int I_IN = 32 * (NP / 32), I_UA = 16 * 64, I_UB = 16 * 64, I_O = 32 * 64, I_Q = 32 * 64;
    constexpr int NITEMS = I_IN + I_UA + I_UB + I_O + I_Q;
    bf16_t* win_t = (bf16_t*)((unsigned char*)p.out + OUT_WIN);
    for (int it = gw; it < NITEMS; it += NGW) {
        int r = it;
        if (r < I_IN) { transpose_item(p.in[6], 2048, 12368, win_t, NP / 32, r, lane, scr, 1); continue; } r -= I_IN;
        if (r < I_UA) { transpose_item(p.in[9], 1024, 2048, (bf16_t*)(p.ws + WS_WUA), 64, r, lane, scr, 0); continue; } r -= I_UA;
        if (r < I_UB) { transpose_item(p.in[10], 1024, 2048, (bf16_t*)(p.ws + WS_WUB), 64, r, lane, scr, 0); continue; } r -= I_UB;
        if (r < I_O) { transpose_item(p.in[11], 2048, 2048, (bf16_t*)(p.ws + WS_WOUT), 64, r, lane, scr, 0); continue; } r -= I_O;
        transpose_item(p.in[12], 2048, 2048, (bf16_t*)(p.ws + WS_WQ), 64, r, lane, scr, 0);
    }
    { const float* ks = p.in[13]; bf16_t* kd = (bf16_t*)(p.ws + WS_KEYS);
      for (int i = (blockIdx.x * NTHREADS + tid) * 4; i < 8 * 2 * 128 * 128; i += gridDim.x * NTHREADS * 4) { const f32x4 v = *(const f32x4*)(ks + i); u32x2 o; o.x = pk2(v[0], v[1]); o.y = pk2(v[2], v[3]); *(u32x2*)(kd + i) = o; } }
}

__device__ __forceinline__ void phase_norm_rows(const float* src, const float* gain, const float* shift, const float* scale, bf16_t* dst) {
    const int tid = threadIdx.x, wave = tid >> 6, lane = tid & 63;
    const int gw = blockIdx.x * NWAVES + wave, NGW = gridDim.x * NWAVES;
    for (int row = gw; row < T; row += NGW) {
        const int b = row >> 11; const f32x4* xr = (const f32x4*)(src + (size_t)row * D) + lane;
        f32x4 v[8]; float ss = 0.f;
#pragma unroll
        for (int j = 0; j < 8; ++j) { v[j] = xr[64 * j]; ss += (v[j][0] * v[j][0] + v[j][1] * v[j][1]) + (v[j][2] * v[j][2] + v[j][3] * v[j][3]); }
        const float rstd = rsqrtf(wave_sum(ss) * (1.f / D) + NORM_EPS);
        u32x2* o8 = (u32x2*)(dst + (size_t)row * D) + lane;
#pragma unroll
        for (int j = 0; j < 8; ++j) { const int col = 4 * (lane + 64 * j);
            const f32x4 g = *(const f32x4*)(gain + col), sh = *(const f32x4*)(shift + (size_t)b * NADA + col), sc = *(const f32x4*)(scale + (size_t)b * NADA + col);
            f32x4 h;
#pragma unroll
            for (int e = 0; e < 4; ++e) h[e] = v[j][e] * rstd * g[e] * (1.f + sc[e]) + sh[e];
            u32x2 w; w.x = pk2(h[0], h[1]); w.y = pk2(h[2], h[3]); o8[64 * j] = w; }
    }
}

__device__ __forceinline__ void phase_vt(const Params& p, unsigned char* lds, int vb, int vG) {
    const int tid = threadIdx.x, wave = tid >> 6, lane = tid & 63;
    bf16_t* tile = (bf16_t*)(lds + wave * 16384);
    const bf16_t* P = (const bf16_t*)(p.ws + WS_P); bf16_t* VT = (bf16_t*)(p.ws + WS_VT);
    const int gw = vb * NWAVES + wave, NGW = vG * NWAVES;
    for (int it = gw; it < 8 * 8 * 32 * 2; it += NGW) {
        const int dh = it & 1, kt = (it >> 1) & 31, h = (it >> 6) & 7, b = it >> 9;
        const int k0 = kt * 64, d0 = dh * 64;
#pragma unroll
        for (int i = 0; i < 8; ++i) { const int key = i * 8 + (lane >> 3), dc = lane & 7;
            const u32x4 v = *(const u32x4*)(P + (size_t)(b * SEQ + k0 + key) * NP + C_VA + h * 128 + d0 + dc * 8);
            bf16_t* t = tile + (dc * 8) * 72 + key;
            t[0 * 72] = (bf16_t)(v.x & 0xffff); t[1 * 72] = (bf16_t)(v.x >> 16); t[2 * 72] = (bf16_t)(v.y & 0xffff); t[3 * 72] = (bf16_t)(v.y >> 16);
            t[4 * 72] = (bf16_t)(v.z & 0xffff); t[5 * 72] = (bf16_t)(v.z >> 16); t[6 * 72] = (bf16_t)(v.w & 0xffff); t[7 * 72] = (bf16_t)(v.w >> 16); }
        LDS_WAIT();
#pragma unroll
        for (int i = 0; i < 8; ++i) { const int d = i * 8 + (lane >> 3), kc = lane & 7;
            const u32x4 v = *(const u32x4*)(tile + d * 72 + kc * 8);
            *(u32x4*)(VT + ((size_t)((b * 8 + h) * 128 + d0 + d)) * SEQ + k0 + kc * 8) = v; }
        LDS_WAIT();
    }
}

__device__ __forceinline__ unsigned ord_key(float s) { const unsigned u = __float_as_uint(s); return (u & 0x80000000u) ? ~u : (u | 0x80000000u); }
__device__ __forceinline__ int half_sum(int v) {
#pragma unroll
    for (int o = 1; o < 32; o <<= 1) v += __shfl_xor(v, o);
    return v;
}
__device__ __forceinline__ void indexer_pair(const bf16_t* P, unsigned* MASK, int b, int c, int pair, int lane) {
    const int r = lane & 31, hh = lane >> 5;
    const int q0 = b * SEQ + c * 64 + 2 * pair;
    bf16x8 af[4];
    { const int query = q0 + ((r >> 2) & 1), head = (r & 3) + 4 * (r >> 3);
      const bf16_t* qp = P + (size_t)query * NP + C_QI + head * 64 + 8 * hh;
#pragma unroll
      for (int ks = 0; ks < 4; ++ks) af[ks] = *(const bf16x8*)(qp + ks * 16); }
    float wv[16];
    { const u32x4 w0 = *(const u32x4*)(P + (size_t)(q0 + hh) * NP + C_WI), w1 = *(const u32x4*)(P + (size_t)(q0 + hh) * NP + C_WI + 8);
      wv[0] = bflo(w0.x); wv[1] = bfhi(w0.x); wv[2] = bflo(w0.y); wv[3] = bfhi(w0.y); wv[4] = bflo(w0.z); wv[5] = bfhi(w0.z); wv[6] = bflo(w0.w); wv[7] = bfhi(w0.w);
      wv[8] = bflo(w1.x); wv[9] = bfhi(w1.x); wv[10] = bflo(w1.y); wv[11] = bfhi(w1.y); wv[12] = bflo(w1.z); wv[13] = bfhi(w1.z); wv[14] = bflo(w1.w); wv[15] = bfhi(w1.w); }
    const int nkt = 2 * (c + 1);
    unsigned kv[64];
    const bf16_t* kbase = P + (size_t)(b * SEQ + r) * NP + C_KI + 8 * hh;
#pragma unroll
    for (int kt = 0; kt < 64; ++kt) {
        kv[kt] = 0u;
        if (kt < nkt) {
            const bf16_t* kp = kbase + (size_t)(kt * 32) * NP;
            f32x16 acc;
#pragma unroll
            for (int i = 0; i < 16; ++i) acc[i] = 0.f;
#pragma unroll
            for (int ks = 0; ks < 4; ++ks) { const bf16x8 bfr = *(const bf16x8*)(kp + ks * 16); acc = __builtin_amdgcn_mfma_f32_32x32x16_bf16(af[ks], bfr, acc, 0, 0, 0); }
            float s = 0.f;
#pragma unroll
            for (int i = 0; i < 16; ++i) s += wv[i] * fmaxf(acc[i], 0.f);
            kv[kt] = ord_key(s);
        }
    }
    unsigned thr = 0u;
    for (int bit = 31; bit >= 0; --bit) {
        const unsigned cand = thr | (1u << bit); int cnt = 0;
#pragma unroll
        for (int kt = 0; kt < 64; ++kt) cnt += (kv[kt] >= cand) ? 1 : 0;
        cnt = half_sum(cnt);
        if (cnt >= 256) thr = cand;
    }
    int cge = 0;
#pragma unroll
    for (int kt = 0; kt < 64; ++kt) cge += (kv[kt] >= thr && kv[kt] != 0u) ? 1 : 0;
    cge = half_sum(cge);
    const bool ties = (thr != 0u) && (cge > 256);
    unsigned m0 = 0u, m1 = 0u;
    if (__builtin_amdgcn_ballot_w64(ties) == 0ull) {
#pragma unroll
        for (int kt = 0; kt < 64; ++kt) { const unsigned long long bm = __builtin_amdgcn_ballot_w64(kv[kt] >= thr && kv[kt] != 0u);
            if (lane == kt) { m0 = (unsigned)bm; m1 = (unsigned)(bm >> 32); } }
    } else {
        int cgt = 0;
#pragma unroll
        for (int kt = 0; kt < 64; ++kt) cgt += (kv[kt] > thr) ? 1 : 0;
        cgt = half_sum(cgt);
        const int need = ties ? (256 - cgt) : (1 << 30); int run = 0;
#pragma unroll
        for (int kt = 0; kt < 64; ++kt) { const bool tie = ties && (kv[kt] == thr); const unsigned long long tb = __builtin_amdgcn_ballot_w64(tie);
            const unsigned th = hh ? (unsigned)(tb >> 32) : (unsigned)tb; const int rank = run + __builtin_popcount(th & ((1u << r) - 1u));
            const bool sel = ties ? ((kv[kt] > thr) || (tie && rank < need)) : (kv[kt] >= thr && kv[kt] != 0u);
            run += __builtin_popcount(th);
            const unsigned long long bm = __builtin_amdgcn_ballot_w64(sel);
            if (lane == kt) { m0 = (unsigned)bm; m1 = (unsigned)(bm >> 32); } }
    }
    MASK[(size_t)q0 * 64 + lane] = m0; MASK[(size_t)(q0 + 1) * 64 + lane] = m1;
}
__device__ __forceinline__ void phase_indexer(const Params& p, int vb, int vG) {
    const int tid = threadIdx.x, wave = tid >> 6, lane = tid & 63;
    const bf16_t* P = (const bf16_t*)(p.ws + WS_P); unsigned* MASK = (unsigned*)(p.ws + WS_MASK);
    const int G = vG;
    for (int rd = 0;; ++rd) {
        const int base = rd * G; if (base >= 1024) break;
        const int pos = (rd & 1) ? (G - 1 - vb) : vb; const int i = base + pos; if (i >= 1024) continue;
        const int c = 31 - (i >> 5), b = (i >> 2) & 7, grp = i & 3;
        indexer_pair(P, MASK, b, c, grp * 8 + wave, lane);
    }
}

constexpr int HG_RS = 136, HG_TS = 72, HG_SS = 136;
constexpr int HG_QT = 0, HG_QH = 17408, HG_KT = 34816, HG_KHT = 52224, HG_VT = 70656, HG_ST = 89088, HG_DEC = 123904, HG_SSQ = 124416;
__device__ __forceinline__ void hgrn_item(const Params& p, unsigned char* lds, int item) {
    const int tid = threadIdx.x, w = tid >> 6, lane = tid & 63, r = lane & 31, hh = lane >> 5;
    const int b = item >> 3, h = item & 7;
    const bf16_t* P = (const bf16_t*)(p.ws + WS_P); bf16_t* REC = (bf16_t*)((unsigned char*)p.out + OUT_REC);
    bf16_t* QT = (bf16_t*)(lds + HG_QT); bf16_t* QH = (bf16_t*)(lds + HG_QH); bf16_t* KT = (bf16_t*)(lds + HG_KT); bf16_t* KHT = (bf16_t*)(lds + HG_KHT); bf16_t* VT = (bf16_t*)(lds + HG_VT);
    bf16_t* ST = (bf16_t*)(lds + HG_ST); float* DEC = (float*)(lds + HG_DEC); float* SSQ = (float*)(lds + HG_SSQ);
    const int seg = lane >> 4, dl = lane & 15, d = 16 * w + dl;
    const float lb = sigmoidf_(p.in[7][h * 128 + d] - p.in[7][1024 + h * 128 + d]);
    const int tb = w & 1, eb = w >> 1, sdb = w & 3, seb0 = 2 * (w >> 2);
    const float gain_e = p.in[8][32 * eb + r];
    f32x16 S0, S1;
#pragma unroll
    for (int i = 0; i < 16; ++i) { S0[i] = 0.f; S1[i] = 0.f; }
    __syncthreads();
    for (int i = tid; i < 128 * HG_SS / 2; i += NTHREADS) ((unsigned*)ST)[i] = 0u;
    unsigned short rq[16], rf[16], ri[16];
    { const bf16_t* src = P + (size_t)(b * SEQ + 16 * seg) * NP + h * 128 + d;
#pragma unroll
      for (int i = 0; i < 16; ++i) { rq[i] = src[(size_t)i * NP + C_QB]; rf[i] = src[(size_t)i * NP + C_FB]; ri[i] = src[(size_t)i * NP + C_IB]; } }
#pragma unroll 1
    for (int n = 0; n < 32; ++n) {
        {
            float lf[16], kk[16];
            float run = 0.f;
#pragma unroll
            for (int i = 0; i < 16; ++i) { const float f = lb + (1.f - lb) * sigmoidf_(bf2f(rf[i])); kk[i] = 1.f - f; run += __logf(f); lf[i] = run; }
            const float p0 = __shfl(run, dl), p1 = __shfl(run, 16 + dl), p2 = __shfl(run, 32 + dl), p3 = __shfl(run, 48 + dl);
            const float off = (seg > 0 ? p0 : 0.f) + (seg > 1 ? p1 : 0.f) + (seg > 2 ? p2 : 0.f), bL = (p0 + p1) + (p2 + p3), bref = p0 + p1;
            unsigned kh[8], vv[8];
#pragma unroll
            for (int i = 0; i < 16; ++i) { const float bt = off + lf[i]; const float qs = siluf_(bf2f(rq[i]));
                const float e1 = __expf(bt - bref), e2 = __expf(bt), e3 = __builtin_amdgcn_rcpf(e1), e4 = __expf(bL - bt);
                const int t = 16 * seg + i;
                QT[t * HG_RS + d] = (bf16_t)f2bf(qs * e1); QH[t * HG_RS + d] = (bf16_t)f2bf(qs * e2); KT[t * HG_RS + d] = (bf16_t)f2bf(kk[i] * e3);
                const unsigned khv = f2bf(kk[i] * e4);
                if (i & 1) { kh[i >> 1] |= khv << 16; vv[i >> 1] |= (unsigned)ri[i] << 16; } else { kh[i >> 1] = khv; vv[i >> 1] = (unsigned)ri[i]; } }
            *(u32x4*)(KHT + d * HG_TS + 16 * seg) = (u32x4){kh[0], kh[1], kh[2], kh[3]}; *(u32x4*)(KHT + d * HG_TS + 16 * seg + 8) = (u32x4){kh[4], kh[5], kh[6], kh[7]};
            *(u32x4*)(VT + d * HG_TS + 16 * seg) = (u32x4){vv[0], vv[1], vv[2], vv[3]}; *(u32x4*)(VT + d * HG_TS + 16 * seg + 8) = (u32x4){vv[4], vv[5], vv[6], vv[7]};
            if (seg == 0) DEC[d] = __expf(bL);
        }
        __syncthreads();
        if (n < 31) { const bf16_t* src = P + (size_t)(b * SEQ + (n + 1) * 64 + 16 * seg) * NP + h * 128 + d;
#pragma unroll
            for (int i = 0; i < 16; ++i) { rq[i] = src[(size_t)i * NP + C_QB]; rf[i] = src[(size_t)i * NP + C_FB]; ri[i] = src[(size_t)i * NP + C_IB]; } }
        unsigned short gbv[16];
        { const bf16_t* gsrc = P + (size_t)(b * SEQ + n * 64 + 32 * tb + 4 * hh) * NP + C_GB + h * 128 + 32 * eb + r;
#pragma unroll
          for (int i = 0; i < 16; ++i) gbv[i] = gsrc[(size_t)((i & 3) + 8 * (i >> 2)) * NP]; }
        f32x16 X0, X1, o;
#pragma unroll
        for (int i = 0; i < 16; ++i) { X0[i] = 0.f; X1[i] = 0.f; o[i] = 0.f; }
#pragma unroll
        for (int ks = 0; ks < 8; ++ks) { const bf16x8 bq = *(const bf16x8*)(QT + (32 * tb + r) * HG_RS + 16 * ks + 8 * hh);
            const bf16x8 a0 = *(const bf16x8*)(KT + r * HG_RS + 16 * ks + 8 * hh); X0 = __builtin_amdgcn_mfma_f32_32x32x16_bf16(a0, bq, X0, 0, 0, 0);
            if (tb == 1) { const bf16x8 a1 = *(const bf16x8*)(KT + (32 + r) * HG_RS + 16 * ks + 8 * hh); X1 = __builtin_amdgcn_mfma_f32_32x32x16_bf16(a1, bq, X1, 0, 0, 0); } }
#pragma unroll
        for (int i = 0; i < 16; ++i) { const bool keep = ((i & 3) + 8 * (i >> 2) + 4 * hh) <= r; if (tb == 0) X0[i] = keep ? X0[i] : 0.f; else X1[i] = keep ? X1[i] : 0.f; }
#pragma unroll
        for (int sb = 0; sb < 2; ++sb) { if (sb <= tb) {
#pragma unroll
            for (int s2 = 0; s2 < 2; ++s2) { u32x4 aw;
                if (sb == 0) { aw.x = pk2(X0[8 * s2], X0[8 * s2 + 1]); aw.y = pk2(X0[8 * s2 + 2], X0[8 * s2 + 3]); aw.z = pk2(X0[8 * s2 + 4], X0[8 * s2 + 5]); aw.w = pk2(X0[8 * s2 + 6], X0[8 * s2 + 7]); }
                else { aw.x = pk2(X1[8 * s2], X1[8 * s2 + 1]); aw.y = pk2(X1[8 * s2 + 2], X1[8 * s2 + 3]); aw.z = pk2(X1[8 * s2 + 4], X1[8 * s2 + 5]); aw.w = pk2(X1[8 * s2 + 6], X1[8 * s2 + 7]); }
                const bf16_t* vp = VT + (32 * eb + r) * HG_TS + 32 * sb + 16 * s2 + 4 * hh;
                const u32x2 lo = *(const u32x2*)vp, hi = *(const u32x2*)(vp + 8); const u32x4 bw = {lo.x, lo.y, hi.x, hi.y};
                o = __builtin_amdgcn_mfma_f32_32x32x16_bf16(__builtin_bit_cast(bf16x8, aw), __builtin_bit_cast(bf16x8, bw), o, 0, 0, 0); } } }
#pragma unroll
        for (int ks = 0; ks < 8; ++ks) { const bf16x8 aq = *(const bf16x8*)(QH + (32 * tb + r) * HG_RS + 16 * ks + 8 * hh), bs = *(const bf16x8*)(ST + (32 * eb + r) * HG_SS + 16 * ks + 8 * hh);
            o = __builtin_amdgcn_mfma_f32_32x32x16_bf16(aq, bs, o, 0, 0, 0); }
        { float a8[8], a4[4], a2[2], a1;
#pragma unroll
          for (int i = 0; i < 8; ++i) { const float lo = o[i] * o[i], hi = o[i + 8] * o[i + 8]; const bool up = lane & 16; const float keep = up ? hi : lo, send = up ? lo : hi; a8[i] = keep + __shfl_xor(send, 16); }
#pragma unroll
          for (int i = 0; i < 4; ++i) { const bool up = lane & 8; const float keep = up ? a8[i + 4] : a8[i], send = up ? a8[i] : a8[i + 4]; a4[i] = keep + __shfl_xor(send, 8); }
#pragma unroll
          for (int i = 0; i < 2; ++i) { const bool up = lane & 4; const float keep = up ? a4[i + 2] : a4[i], send = up ? a4[i] : a4[i + 2]; a2[i] = keep + __shfl_xor(send, 4); }
          { const bool up = lane & 2; const float keep = up ? a2[1] : a2[0], send = up ? a2[0] : a2[1]; a1 = keep + __shfl_xor(send, 2); }
          a1 += __shfl_xor(a1, 1);
          const int ri2 = (lane >> 1) & 15;
          if ((lane & 1) == 0) SSQ[(32 * tb + (ri2 & 3) + 8 * (ri2 >> 2) + 4 * hh) * 4 + eb] = a1; }
        { float dc[16];
#pragma unroll
          for (int g4 = 0; g4 < 4; ++g4) { const f32x4 dv = *(const f32x4*)(DEC + 32 * sdb + 8 * g4 + 4 * hh); dc[4 * g4] = dv[0]; dc[4 * g4 + 1] = dv[1]; dc[4 * g4 + 2] = dv[2]; dc[4 * g4 + 3] = dv[3]; }
#pragma unroll
          for (int i = 0; i < 16; ++i) { S0[i] *= dc[i]; S1[i] *= dc[i]; }
#pragma unroll
          for (int ss = 0; ss < 4; ++ss) { const bf16x8 a = *(const bf16x8*)(KHT + (32 * sdb + r) * HG_TS + 16 * ss + 8 * hh);
              const bf16x8 b0 = *(const bf16x8*)(VT + (32 * seb0 + r) * HG_TS + 16 * ss + 8 * hh), b1 = *(const bf16x8*)(VT + (32 * (seb0 + 1) + r) * HG_TS + 16 * ss + 8 * hh);
              S0 = __builtin_amdgcn_mfma_f32_32x32x16_bf16(a, b0, S0, 0, 0, 0); S1 = __builtin_amdgcn_mfma_f32_32x32x16_bf16(a, b1, S1, 0, 0, 0); } }
        __syncthreads();
#pragma unroll
        for (int g4 = 0; g4 < 4; ++g4) { const int d0 = 32 * sdb + 8 * g4 + 4 * hh;
            *(u32x2*)(ST + (32 * seb0 + r) * HG_SS + d0) = (u32x2){pk2(S0[4 * g4], S0[4 * g4 + 1]), pk2(S0[4 * g4 + 2], S0[4 * g4 + 3])};
            *(u32x2*)(ST + (32 * (seb0 + 1) + r) * HG_SS + d0) = (u32x2){pk2(S1[4 * g4], S1[4 * g4 + 1]), pk2(S1[4 * g4 + 2], S1[4 * g4 + 3])}; }
        { bf16_t* dst = REC + (size_t)(b * SEQ + n * 64 + 32 * tb + 4 * hh) * 1024 + h * 128 + 32 * eb + r;
#pragma unroll
          for (int i = 0; i < 16; ++i) { const int tr = (i & 3) + 8 * (i >> 2); const f32x4 q4 = *(const f32x4*)(SSQ + (32 * tb + tr + 4 * hh) * 4);
              const float rstd = rsqrtf(((q4[0] + q4[1]) + (q4[2] + q4[3])) * (1.f / 128.f) + NORM_EPS);
              dst[(size_t)tr * 1024] = (bf16_t)f2bf(o[i] * rstd * gain_e * siluf_(bf2f(gbv[i]))); } }
    }
}
__device__ __forceinline__ void phase_hgrn(const Params& p, unsigned char* lds, int vb, int vG) {
    for (int it = vb; it < 64; it += vG) hgrn_item(p, lds, it);
}

__device__ __forceinline__ void attn_task(const bf16_t* P, const bf16_t* VT, const unsigned* MASK, bf16_t* Pout, int b, int c, int qh, int head, int lane) {
    const int r = lane & 31, hh = lane >> 5;
    const int tq = b * SEQ + c * 64 + qh * 32 + r;
    bf16x8 qf[8];
    { const bf16_t* qp = P + (size_t)tq * NP + C_QA + head * 128 + 8 * hh;
#pragma unroll
      for (int ks = 0; ks < 8; ++ks) qf[ks] = *(const bf16x8*)(qp + ks * 16); }
    f32x16 o[4];
#pragma unroll
    for (int db = 0; db < 4; ++db)
#pragma unroll
        for (int i = 0; i < 16; ++i) o[db][i] = 0.f;
    float mrun = -1e30f, lsum = 0.f;
    const float sc = 0.08838834764831845f * 1.4426950408889634f;
    const int nkt = 2 * (c + 1);
    const bf16_t* kbase = P + (size_t)(b * SEQ + r) * NP + C_KA + head * 128 + 8 * hh;
    const bf16_t* vbase = VT + (size_t)((b * 8 + head) * 128 + r) * SEQ + 4 * hh;
    const unsigned* mrow = MASK + (size_t)tq * 64;
    for (int kt = 0; kt < nkt; ++kt) {
        const bf16_t* kp = kbase + (size_t)(kt * 32) * NP;
        f32x16 s;
#pragma unroll
        for (int i = 0; i < 16; ++i) s[i] = 0.f;
#pragma unroll
        for (int ks = 0; ks < 8; ++ks) { const bf16x8 kf = *(const bf16x8*)(kp + ks * 16); s = __builtin_amdgcn_mfma_f32_32x32x16_bf16(kf, qf[ks], s, 0, 0, 0); }
        const unsigned mw = mrow[kt];
        float mx = -1e30f;
#pragma unroll
        for (int i = 0; i < 16; ++i) { const int bit = (i & 3) + 8 * (i >> 2) + 4 * hh; const bool ok = (mw >> bit) & 1u; s[i] = ok ? s[i] * sc : -1e30f; mx = fmaxf(mx, s[i]); }
        mx = fmaxf(mx, __shfl_xor(mx, 32));
        const float mnew = fmaxf(mrun, mx), alpha = exp2f(mrun - mnew); mrun = mnew;
        float ps = 0.f; float pv[16];
#pragma unroll
        for (int i = 0; i < 16; ++i) { const float e = (s[i] > -1e29f) ? exp2f(s[i] - mnew) : 0.f; pv[i] = e; ps += e; }
        lsum = lsum * alpha + ps;
#pragma unroll
        for (int db = 0; db < 4; ++db)
#pragma unroll
            for (int i = 0; i < 16; ++i) o[db][i] *= alpha;
        bf16x8 pf[2];
#pragma unroll
        for (int s2 = 0; s2 < 2; ++s2) { u32x4 w; w.x = pk2(pv[8 * s2 + 0], pv[8 * s2 + 1]); w.y = pk2(pv[8 * s2 + 2], pv[8 * s2 + 3]); w.z = pk2(pv[8 * s2 + 4], pv[8 * s2 + 5]); w.w = pk2(pv[8 * s2 + 6], pv[8 * s2 + 7]); pf[s2] = __builtin_bit_cast(bf16x8, w); }
        const bf16_t* vp = vbase + kt * 32;
#pragma unroll
        for (int db = 0; db < 4; ++db)
#pragma unroll
            for (int s2 = 0; s2 < 2; ++s2) { const u32x2 lo = *(const u32x2*)(vp + (size_t)(db * 32) * SEQ + 16 * s2), hi = *(const u32x2*)(vp + (size_t)(db * 32) * SEQ + 16 * s2 + 8);
                u32x4 w; w.x = lo.x; w.y = lo.y; w.z = hi.x; w.w = hi.y;
                o[db] = __builtin_amdgcn_mfma_f32_32x32x16_bf16(__builtin_bit_cast(bf16x8, w), pf[s2], o[db], 0, 0, 0); }
    }
    const float l = lsum + __shfl_xor(lsum, 32), inv = 1.f / l;
    bf16_t* op = Pout + (size_t)tq * 1024 + head * 128 + 4 * hh;
#pragma unroll
    for (int db = 0; db < 4; ++db)
#pragma unroll
        for (int g4 = 0; g4 < 4; ++g4) { u32x2 w; w.x = pk2(o[db][4 * g4] * inv, o[db][4 * g4 + 1] * inv); w.y = pk2(o[db][4 * g4 + 2] * inv, o[db][4 * g4 + 3] * inv);
            *(u32x2*)(op + db * 32 + 8 * g4) = w; }
}
__device__ __forceinline__ void phase_attn(const Params& p) {
    const int tid = threadIdx.x, wave = tid >> 6, lane = tid & 63;
    bf16_t* P = (bf16_t*)(p.ws + WS_P); const bf16_t* VT = (const bf16_t*)(p.ws + WS_VT); const unsigned* MASK = (const unsigned*)(p.ws + WS_MASK);
    const int G = gridDim.x;
    for (int rd = 0;; ++rd) {
        const int base = rd * G; if (base >= 512) break;
        const int pos = (rd & 1) ? (G - 1 - (int)blockIdx.x) : (int)blockIdx.x; const int i = base + pos; if (i >= 512) continue;
        const int c = 31 - (i >> 4), b = (i >> 1) & 7, qh = i & 1;
        attn_task(P, VT, MASK, (bf16_t*)((unsigned char*)p.out + OUT_AO), b, c, qh, wave, lane);
    }
}
__device__ __forceinline__ void phase_uv(const Params& p) {
    const float* u = p.in[14]; const float* v = p.in[15]; bf16_t* u16 = (bf16_t*)(p.ws + WS_U16); bf16_t* v16 = (bf16_t*)(p.ws + WS_V16);
    const int i0 = blockIdx.x * NTHREADS + threadIdx.x, st = gridDim.x * NTHREADS;
    for (int i = i0; i < 16384 * 256; i += st) { const int row = i >> 8, c = i & 255; const size_t so = (size_t)row * 2048 + c * 8, dof = ((size_t)(c >> 3) * 16384 + row) * 64 + (c & 7) * 8;
        const f32x4 a = *(const f32x4*)(u + so), b2 = *(const f32x4*)(u + so + 4), c4 = *(const f32x4*)(v + so), d = *(const f32x4*)(v + so + 4);
        u32x4 wu = {pk2(a[0], a[1]), pk2(a[2], a[3]), pk2(b2[0], b2[1]), pk2(b2[2], b2[3])}, wv = {pk2(c4[0], c4[1]), pk2(c4[2], c4[3]), pk2(d[0], d[1]), pk2(d[2], d[3])};
        *(u32x4*)(u16 + dof) = wu; *(u32x4*)(v16 + dof) = wv; }
}

#define INS16(v, x) do { _Pragma("unroll") for (int _j = 15; _j >= 1; --_j) v[_j] = __builtin_amdgcn_fmed3f(v[_j - 1], v[_j], (x)); v[0] = fmaxf(v[0], (x)); } while (0)
__device__ __forceinline__ void peer_half_top16(const bf16_t* QP, const bf16_t* KEYS, int tok, int p, int hf, int r, int hh, float (&v)[16]) {
    bf16x8 qf[8];
    { const bf16_t* qp = QP + (size_t)tok * D + p * 256 + hf * 128 + 8 * hh;
#pragma unroll
      for (int ks = 0; ks < 8; ++ks) qf[ks] = *(const bf16x8*)(qp + ks * 16); }
#pragma unroll
    for (int k = 0; k < 16; ++k) v[k] = -3.0e38f;
    const bf16_t* kb = KEYS + (size_t)((p * 2 + hf) * 128 + r) * 128 + 8 * hh;
#pragma unroll 1
    for (int nb = 0; nb < 4; ++nb) {
        f32x16 acc;
#pragma unroll
        for (int i = 0; i < 16; ++i) acc[i] = 0.f;
#pragma unroll
        for (int ks = 0; ks < 8; ++ks) { const bf16x8 kf = *(const bf16x8*)(kb + (size_t)(nb * 32) * 128 + ks * 16); acc = __builtin_amdgcn_mfma_f32_32x32x16_bf16(kf, qf[ks], acc, 0, 0, 0); }
#pragma unroll
        for (int i = 0; i < 16; ++i) { const unsigned xi = (unsigned)(nb * 32 + (i & 3) + 8 * (i >> 2) + 4 * hh); const float x = __uint_as_float((__float_as_uint(acc[i]) & ~0x7fu) | xi); INS16(v, x); }
    }
    float ov[16];
#pragma unroll
    for (int k = 0; k < 16; ++k) ov[k] = __shfl_xor(v[k], 32);
#pragma unroll
    for (int k = 0; k < 16; ++k) INS16(v, ov[k]);
}
__device__ __forceinline__ void phase_peer_topk(const Params& p) {
    const int tid = threadIdx.x, wave = tid >> 6, lane = tid & 63, r = lane & 31, hh = lane >> 5;
    const bf16_t* QP = (const bf16_t*)(p.ws + WS_QP); const bf16_t* KEYS = (const bf16_t*)(p.ws + WS_KEYS);
    int* EIDX = (int*)(p.ws + WS_EIDX); float* EGATE = (float*)(p.ws + WS_EGATE);
    const int gw = blockIdx.x * NWAVES + wave, NGW = gridDim.x * NWAVES;
    for (int it = gw; it < 512 * 8; it += NGW) {
        const int tg = it >> 3, hd = it & 7, tok = tg * 32 + r;
        float va[16], vb[16];
        peer_half_top16(QP, KEYS, tok, hd, 0, r, hh, va);
        peer_half_top16(QP, KEYS, tok, hd, 1, r, hh, vb);
        float bv[16];
#pragma unroll
        for (int k = 0; k < 16; ++k) bv[k] = -3.0e38f;
#pragma unroll
        for (int a = 0; a < 16; ++a)
#pragma unroll
            for (int b2 = 0; b2 < 16; ++b2) if ((a + 1) * (b2 + 1) <= 16) { const float x = va[a] + vb[b2]; INS16(bv, x); }
        float se = 0.f;
#pragma unroll
        for (int k = 0; k < 16; ++k) se += __expf(bv[k] - bv[0]);
        const float inv = 1.f / se, thr = bv[15], top = bv[0];
        int cnt = 0; int* ei = EIDX + (size_t)tok * 128 + hd * 16; float* eg = EGATE + (size_t)tok * 128 + hd * 16;
#pragma unroll
        for (int a = 0; a < 16; ++a)
#pragma unroll
            for (int b2 = 0; b2 < 16; ++b2) if ((a + 1) * (b2 + 1) <= 16) { const float x = va[a] + vb[b2];
                if (x >= thr && cnt < 16) { if (hh == 0) { ei[cnt] = (int)((__float_as_uint(va[a]) & 0x7fu) * 128u + (__float_as_uint(vb[b2]) & 0x7fu)); eg[cnt] = __expf(x - top) * inv; } ++cnt; } }
    }
}

typedef __bf16 bf16x2_t __attribute__((ext_vector_type(2)));
__device__ __forceinline__ float gelu_erf(float v) {
    const float av = fabsf(v), d = av * 0.2316418882f + 1.0f, t = __builtin_amdgcn_rcpf(d);
    float q = t * 0.5307027145f + (-0.7265760135f); q = q * t + 0.7107068705f; q = q * t + (-0.142248368f); q = q * t + 0.127414796f; q = q * t;
    const float e = __builtin_amdgcn_exp2f((v * v) * (-0.72134752044f));
    const float m = v * (q * e), r = v - m;
    return v < 0.f ? m : r;
}
__device__ __forceinline__ float dot2bf(unsigned a, unsigned b, float c) { return __builtin_amdgcn_fdot2_f32_bf16(__builtin_bit_cast(bf16x2_t, a), __builtin_bit_cast(bf16x2_t, b), c, false); }
__device__ __forceinline__ void phase_experts(const Params& p, unsigned char* lds) {
    const int tid = threadIdx.x, wave = tid >> 6, lane = tid & 63, rr = lane >> 3, cc = lane & 7;
    const bf16_t* H2 = (const bf16_t*)(p.ws + WS_H2); const unsigned char* U16 = p.ws + WS_U16; const unsigned char* V16 = p.ws + WS_V16;
    const int* EIDX = (const int*)(p.ws + WS_EIDX); const float* EGATE = (const float*)(p.ws + WS_EGATE);
    const float* mod = (const float*)(p.ws + WS_MOD); const float* fin = p.in[16]; float* out = p.out; const float* X1 = (const float*)(p.ws + WS_X1);
    unsigned* offs = (unsigned*)lds; float* gts = (float*)(lds + 32768); float* rstl = (float*)(lds + 65536);
    const unsigned xcc = (unsigned)__builtin_amdgcn_s_getreg((3 << 11) | 20) & 7u; const unsigned cc16 = cc * 16;
    for (int tile = blockIdx.x; tile < T / 64; tile += gridDim.x) {
        const int tok0 = tile * 64, b = tok0 >> 11;
        __syncthreads();
        for (int i = tid; i < 8192; i += NTHREADS) { const int tl = i >> 7, j = i & 127, g = j >> 3, r8 = j & 7;
            offs[(tl * 8 + r8) * 16 + g] = (unsigned)EIDX[(size_t)tok0 * 128 + i] * 128u; gts[(tl * 8 + r8) * 16 + g] = EGATE[(size_t)tok0 * 128 + i]; }
        __syncthreads();
#pragma unroll 1
        for (int half = 0; half < 2; ++half) {
            const int tlb = wave * 8 + half * 4;
            float zp[4][16];
#pragma unroll
            for (int k = 0; k < 4; ++k)
#pragma unroll
                for (int g = 0; g < 16; ++g) zp[k][g] = 0.f;
#pragma unroll 1
            for (int i = 0; i < 32; ++i) { const unsigned s = (xcc * 4u + (unsigned)i) & 31u; const unsigned char* ub = U16 + (size_t)s * (2u << 20);
#pragma unroll
                for (int k = 0; k < 4; ++k) { const int tl = tlb + k;
                    const u32x4 hq = *(const u32x4*)(H2 + (size_t)(tok0 + tl) * D + s * 64 + cc * 8);
                    u32x4 o4[4];
#pragma unroll
                    for (int q = 0; q < 4; ++q) o4[q] = *(const u32x4*)(offs + (tl * 8 + rr) * 16 + 4 * q);
                    u32x4 d[16];
#pragma unroll
                    for (int g = 0; g < 16; ++g) d[g] = *(const u32x4*)(ub + (o4[g >> 2][g & 3] + cc16));
#pragma unroll
                    for (int g = 0; g < 16; ++g) { float z = zp[k][g]; z = dot2bf(d[g].x, hq.x, z); z = dot2bf(d[g].y, hq.y, z); z = dot2bf(d[g].z, hq.z, z); z = dot2bf(d[g].w, hq.w, z); zp[k][g] = z; }
                    __builtin_amdgcn_sched_barrier(0); } }
#pragma unroll
            for (int k = 0; k < 4; ++k)
#pragma unroll
                for (int g = 0; g < 16; ++g) { float z = zp[k][g]; z += __shfl_xor(z, 1); z += __shfl_xor(z, 2); z += __shfl_xor(z, 4);
                    zp[k][g] = __uint_as_float(f2bf(gelu_erf(z) * gts[((tlb + k) * 8 + rr) * 16 + g])); }
            float ssq[4] = {0.f, 0.f, 0.f, 0.f};
#pragma unroll 1
            for (int i = 0; i < 32; ++i) { const unsigned s = (xcc * 4u + (unsigned)i) & 31u; const unsigned char* vb = V16 + (size_t)s * (2u << 20);
#pragma unroll
                for (int k = 0; k < 4; ++k) { const int tl = tlb + k;
                    float oa[8] = {0.f, 0.f, 0.f, 0.f, 0.f, 0.f, 0.f, 0.f};
                    u32x4 o4[4];
#pragma unroll
                    for (int q = 0; q < 4; ++q) o4[q] = *(const u32x4*)(offs + (tl * 8 + rr) * 16 + 4 * q);
                    u32x4 d[16];
#pragma unroll
                    for (int g = 0; g < 16; ++g) d[g] = *(const u32x4*)(vb + (o4[g >> 2][g & 3] + cc16));
#pragma unroll
                    for (int g = 0; g < 16; ++g) { const unsigned alo = __float_as_uint(zp[k][g]), ahi = alo << 16;
                        oa[0] = dot2bf(d[g].x, alo, oa[0]); oa[1] = dot2bf(d[g].x, ahi, oa[1]); oa[2] = dot2bf(d[g].y, alo, oa[2]); oa[3] = dot2bf(d[g].y, ahi, oa[3]);
                        oa[4] = dot2bf(d[g].z, alo, oa[4]); oa[5] = dot2bf(d[g].z, ahi, oa[5]); oa[6] = dot2bf(d[g].w, alo, oa[6]); oa[7] = dot2bf(d[g].w, ahi, oa[7]); }
#pragma unroll
                    for (int j = 0; j < 8; ++j) { float v = oa[j]; v += __shfl_xor(v, 8); v += __shfl_xor(v, 16); v += __shfl_xor(v, 32); oa[j] = v; }
                    if (rr == 0) { const int col = s * 64 + cc * 8; float* xp = out + (size_t)(tok0 + tl) * D + col; const float* xi = X1 + (size_t)(tok0 + tl) * D + col;
                        const f32x4 x0 = *(const f32x4*)xi, x1 = *(const f32x4*)(xi + 4);
                        const f32x4 g0 = *(const f32x4*)(mod + (size_t)b * NADA + 5 * 2048 + col), g1 = *(const f32x4*)(mod + (size_t)b * NADA + 5 * 2048 + col + 4);
                        f32x4 y0, y1;
#pragma unroll
                        for (int e = 0; e < 4; ++e) { y0[e] = x0[e] + g0[e] * oa[e]; y1[e] = x1[e] + g1[e] * oa[4 + e]; ssq[k] += y0[e] * y0[e] + y1[e] * y1[e]; }
                        *(f32x4*)xp = y0; *(f32x4*)(xp + 4) = y1; }
                    __builtin_amdgcn_sched_barrier(0); } }
#pragma unroll
            for (int k = 0; k < 4; ++k) { float q = ssq[k]; q += __shfl_xor(q, 1); q += __shfl_xor(q, 2); q += __shfl_xor(q, 4);
                const float tot = __int_as_float(__builtin_amdgcn_readfirstlane(__float_as_int(q))); const float rs = rsqrtf(tot * (1.f / D) + NORM_EPS);
                rstl[wave * 8 + half * 4 + k] = rs; }
        }
        __builtin_amdgcn_fence(__ATOMIC_RELEASE, "agent"); __builtin_amdgcn_fence(__ATOMIC_ACQUIRE, "agent");
        LDS_WAIT();
        int lane2 = (int)__builtin_amdgcn_mbcnt_hi(~0u, __builtin_amdgcn_mbcnt_lo(~0u, 0u)); asm volatile("" : "+v"(lane2));
#pragma unroll 1
        for (int k = 0; k < 8; ++k) { float* xr = out + (size_t)(tok0 + wave * 8 + k) * D; const float rs = rstl[wave * 8 + k];
#pragma unroll
            for (int j = 0; j < 8; ++j) { const int col = 4 * (lane2 + 64 * j); const f32x4 v = *(const f32x4*)(xr + col), f = *(const f32x4*)(fin + col);
                f32x4 o; o[0] = v[0] * rs * f[0]; o[1] = v[1] * rs * f[1]; o[2] = v[2] * rs * f[2]; o[3] = v[3] * rs * f[3]; *(f32x4*)(xr + col) = o; } }
    }
}

constexpr int NPHASES = 11;
__global__ void __launch_bounds__(NTHREADS, 2) mega_fwd(Params p) {
    extern __shared__ __attribute__((aligned(16))) unsigned char lds[];
    cg::grid_group grid = cg::this_grid();
    const int lo = p.ph_lo, hi = p.ph_hi;
#ifndef PHASE_MASK
#define PHASE_MASK 0x7ff
#endif
#define IN(k) (((PHASE_MASK >> (k)) & 1) && lo <= (k) && (k) < hi)
#define SEAM(k) do { if (IN(k) && IN((k) + 1)) grid.sync(); } while (0)
    unsigned char* ws = p.ws;
    bf16_t* P = (bf16_t*)(ws + WS_P);
    bf16_t* Hb = (bf16_t*)((unsigned char*)p.out + OUT_H);
    bf16_t* WinT = (bf16_t*)((unsigned char*)p.out + OUT_WIN);
    const float* mod = (const float*)(ws + WS_MOD);
    LAS unsigned char* ldsl = (LAS unsigned char*)lds;

#ifndef REPEAT_PHASE
#define REPEAT_PHASE -1
#endif
#define RUNPH(k, ...) do { if (IN(k)) { __VA_ARGS__; if (REPEAT_PHASE == (k)) { grid.sync(); __VA_ARGS__; } } } while (0)
    RUNPH(0, { phase_mod(p, lds); __syncthreads(); phase_weights(p, lds); });
    SEAM(0);
    RUNPH(1, { phase_norm_rows(p.in[0], p.in[4], mod, mod + 2048, Hb); });
    SEAM(1);
    RUNPH(2, { pg8::Gemm g{Hb, WinT, nullptr, nullptr, D, D, T, NP, D}; pg8::StaticOrder<1> S; S.init(T, NP, gridDim.x, blockIdx.x);
        pg8::EpiBf16 E{P, NP, 33}; pg8::gemm_phase(ldsl, g, S, E); });
    SEAM(2);
    RUNPH(3, { const int G = gridDim.x, bx = blockIdx.x;
        if (G >= 128) { if (bx < 64) { phase_hgrn(p, lds, bx, 64); if (REPEAT_PHASE == 32) phase_hgrn(p, lds, bx, 64); }
                        else { phase_vt(p, lds, bx - 64, G - 64); phase_indexer(p, bx - 64, G - 64); if (REPEAT_PHASE == 31) phase_indexer(p, bx - 64, G - 64); } }
        else { phase_vt(p, lds, bx, G); phase_indexer(p, bx, G); __syncthreads(); phase_hgrn(p, lds, bx, G); } });
    SEAM(3);
    RUNPH(4, { phase_attn(p); });
    SEAM(4);
    RUNPH(5, { pg8::Gemm g{(const bf16_t*)((unsigned char*)p.out + OUT_AO), (const bf16_t*)(ws + WS_WUA), (const bf16_t*)((unsigned char*)p.out + OUT_REC), (const bf16_t*)(ws + WS_WUB), 1024, 1024, T, D, 1024}; pg8::StaticOrder<2> S; S.init(T, D, gridDim.x, blockIdx.x);
        pg8::EpiMix E{(bf16_t*)(ws + WS_MIXED), P}; pg8::gemm_phase(ldsl, g, S, E); });
    SEAM(5);
    RUNPH(6, { pg8::Gemm g{(const bf16_t*)(ws + WS_MIXED), (const bf16_t*)(ws + WS_WOUT), nullptr, nullptr, D, D, T, D, D}; pg8::StaticOrder<1> S; S.init(T, D, gridDim.x, blockIdx.x);
        pg8::EpiX1 E{p.in[0], (float*)(ws + WS_X1), mod + 4096}; pg8::gemm_phase(ldsl, g, S, E); });
    SEAM(6);
    RUNPH(7, { phase_norm_rows((const float*)(ws + WS_X1), p.in[5], mod + 3 * 2048, mod + 4 * 2048, (bf16_t*)(ws + WS_H2)); phase_uv(p); });
    SEAM(7);
    RUNPH(8, { pg8::Gemm g{(const bf16_t*)(ws + WS_H2), (const bf16_t*)(ws + WS_WQ), nullptr, nullptr, D, D, T, D, D}; pg8::StaticOrder<1> S; S.init(T, D, gridDim.x, blockIdx.x);
        pg8::EpiBf16 E{(bf16_t*)(ws + WS_QP), D, 1 << 30}; pg8::gemm_phase(ldsl, g, S, E); });
    SEAM(8);
    RUNPH(9, { phase_peer_topk(p); });
    SEAM(9);
    RUNPH(10, { phase_experts(p, lds); });
#undef IN
#undef SEAM
}

#ifndef MK_N_LAUNCHES
#define MK_N_LAUNCHES 1
#endif
extern "C" void kernel_launch(void* const* d_in, const int* in_sizes, int n_in, void* d_out, int out_size, void* d_ws, size_t ws_size, hipStream_t stream) {
    static int grid = 0;
    if (grid == 0) {
        if (n_in != 17 || out_size != T * D || ws_size < WS_END) { fprintf(stderr, "kernel_launch: unexpected shapes (n_in %d out %d ws %zu)\n", n_in, out_size, ws_size); grid = -1; return; }
        int dev = 0, cus = 0, per_cu = 0;
        hipGetDevice(&dev); hipDeviceGetAttribute(&cus, hipDeviceAttributeMultiprocessorCount, dev);
        hipFuncSetAttribute((const void*)mega_fwd, hipFuncAttributeMaxDynamicSharedMemorySize, LDS_BYTES);
        hipOccupancyMaxActiveBlocksPerMultiprocessor(&per_cu, (const void*)mega_fwd, NTHREADS, LDS_BYTES);
        if (per_cu < 1) { fprintf(stderr, "kernel_launch: occupancy query says %d blocks/CU\n", per_cu); per_cu = 1; }
        (void)hipGetLastError();
        grid = cus * 1;
    }
    if (grid < 0) return;
    Params p{};
    for (int i = 0; i < 17; ++i) p.in[i] = (const float*)d_in[i];
    p.out = (float*)d_out; p.ws = (unsigned char*)d_ws;
#if MK_N_LAUNCHES == 1
    p.ph_lo = 0; p.ph_hi = NPHASES;
    void* args[] = {&p};
    hipError_t e = hipLaunchCooperativeKernel((const void*)mega_fwd, dim3(grid), dim3(NTHREADS), args, LDS_BYTES, stream);
    if (e != hipSuccess) fprintf(stderr, "cooperative launch failed: %s (grid %d)\n", hipGetErrorString(e), grid);
#else
    for (int k = 0; k < NPHASES; ++k) { p.ph_lo = k; p.ph_hi = k + 1; void* args[] = {&p};
        hipError_t e = hipLaunchCooperativeKernel((const void*)mega_fwd, dim3(grid), dim3(NTHREADS), args, LDS_BYTES, stream);
        if (e != hipSuccess) { fprintf(stderr, "launch %d failed: %s\n", k, hipGetErrorString(e)); break; } }
#endif
}
```

```cpp
#include <hip/hip_runtime.h>
#include <hip/hip_cooperative_groups.h>
#include <cstdio>
#include <cstdint>
namespace cg = cooperative_groups;

#define LAS __attribute__((address_space(3)))
typedef unsigned short bf16_t;
typedef short bf16x8 __attribute__((ext_vector_type(8)));
typedef short bf16x4 __attribute__((ext_vector_type(4)));
typedef float f32x2 __attribute__((ext_vector_type(2)));
typedef float f32x4 __attribute__((ext_vector_type(4)));
typedef float f32x16 __attribute__((ext_vector_type(16)));
typedef unsigned u32x2 __attribute__((ext_vector_type(2)));
typedef unsigned u32x4 __attribute__((ext_vector_type(4)));

constexpr int T = 16384, D = 2048, SEQ = 2048, NBATCH = 8, NP = 12544;
constexpr int C_QA = 0, C_KA = 1024, C_VA = 2048, C_QI = 3072, C_KI = 4096, C_WI = 4160, C_QB = 4352, C_FB = 5376, C_IB = 6400, C_GB = 7424, C_GA = 8448, C_GG = 10496;
constexpr int NADA = 12288;
constexpr float NORM_EPS = 1e-6f;
constexpr int NTHREADS = 512, NWAVES = 8;
constexpr int LDS_BYTES = 147456;
constexpr size_t MiB = 1u << 20;
constexpr size_t WS_CTL = 0, WS_MOD = 1 * MiB, WS_WUA = 2 * MiB, WS_WUB = 6 * MiB, WS_WOUT = 10 * MiB, WS_WQ = 18 * MiB, WS_KEYS = 26 * MiB, WS_MASK = 27 * MiB;
constexpr size_t WS_MIXED = 32 * MiB;
constexpr size_t WS_VT = 32 * MiB, WS_ORAW = 64 * MiB;
constexpr size_t WS_P = 96 * MiB;
constexpr size_t WS_H2 = 96 * MiB, WS_QP = 160 * MiB, WS_U16 = 224 * MiB, WS_V16 = 288 * MiB, WS_EIDX = 352 * MiB, WS_EGATE = 360 * MiB;
constexpr size_t WS_X1 = 368 * MiB;
constexpr size_t WS_END = 496 * MiB;
constexpr size_t OUT_H = 0, OUT_WIN = 64 * MiB;
constexpr size_t OUT_AO = 0, OUT_REC = 32 * MiB;

struct Params { const float* in[17]; float* out; unsigned char* ws; int ph_lo, ph_hi; };

__device__ __forceinline__ unsigned f2bf(float f) { unsigned u = __float_as_uint(f); return (u + 0x7fffu + ((u >> 16) & 1u)) >> 16; }
__device__ __forceinline__ float bf2f(unsigned b) { return __uint_as_float(b << 16); }
__device__ __forceinline__ float bflo(unsigned w) { return __uint_as_float(w << 16); }
__device__ __forceinline__ float bfhi(unsigned w) { return __uint_as_float(w & 0xffff0000u); }
__device__ __forceinline__ unsigned pk2(float lo, float hi) { unsigned r; asm volatile("v_cvt_pk_bf16_f32 %0, %1, %2" : "=v"(r) : "v"(lo), "v"(hi)); return r; }
__device__ __forceinline__ float wave_sum(float v) {
#pragma unroll
    for (int o = 1; o < 64; o <<= 1) v += __shfl_xor(v, o);
    return v;
}
__device__ __forceinline__ float sigmoidf_(float v) { return 1.f / (1.f + __expf(-v)); }
__device__ __forceinline__ float siluf_(float v) { return v / (1.f + __expf(-v)); }
#define LDS_WAIT() asm volatile("s_waitcnt lgkmcnt(0)" ::: "memory")

namespace pg8 {
constexpr int BM = 256, BK = 64, HALF = 128, HTB = HALF * BK * 2, STAGE_BYTES = 8 * HTB, NXCD = 8, WGM = 8;
__host__ __device__ __forceinline__ int lds_byte(int r, int c) { const int st = (r >> 4) * 2 + (c >> 5), rr = r & 15, cc = c & 31, ob = rr * 64 + cc * 2; return st * 1024 + (ob ^ (((ob >> 9) & 1) << 5)); }
__host__ __device__ __forceinline__ void stage_rc(int b, int& R, int& C) { const int st = b / 1024, sb = b % 1024, swz = sb ^ (((sb >> 9) & 1) << 5); R = (st >> 1) * 16 + swz / 64; C = (st & 1) * 32 + (swz % 64) / 2; }
__host__ __device__ __forceinline__ int perm32(int rho) { const int n = rho >> 4, i = rho & 15; return 8 * (i >> 2) + 4 * n + (i & 3); }

struct Unit { int pm, pn, z; };
struct Gemm { const bf16_t* A; const bf16_t* Bt; const bf16_t* A2; const bf16_t* Bt2; int lda, ldb, M, N, K; };

template <int NZ> struct StaticOrder {
    int nM, nN, nwg, G, c;
    __device__ void init(int M, int N, int G_, int c_) { nM = M / BM; nN = N / BM; nwg = nM * nN; G = G_; c = c_; }
    __device__ bool next(int i, Unit& u) const {
        const long L = (long)(i / NZ) * G + c; if (L >= nwg) return false;
        int wgid = (int)L; { const int q = nwg / NXCD, r = nwg % NXCD, xcd = wgid % NXCD, off = wgid / NXCD; wgid = (xcd < r ? xcd * (q + 1) : r * (q + 1) + (xcd - r) * q) + off; }
        const int nig = WGM * nN, gid = wgid / nig, fm = gid * WGM, gsz = (nM - fm) < WGM ? (nM - fm) : WGM;
        u.pm = fm + ((wgid % nig) % gsz); u.pn = (wgid % nig) / gsz; u.z = i % NZ; return true;
    }
};

template <class Epi, class Sched>
__device__ __forceinline__ void gemm_phase(LAS unsigned char* lds, const Gemm g, const Sched& S, const Epi& E) {
    const int tid = threadIdx.x, wid = __builtin_amdgcn_readfirstlane(tid >> 6), lane = tid & 63, wr = wid >> 2, wc = wid & 3, fr = lane & 15, fq = lane >> 4;
    const int K = g.K, nt = K / BK;
    unsigned voffA[2], voffB[2];
#pragma unroll
    for (int i = 0; i < 2; ++i) { int R, C; stage_rc(tid * 16 + i * 8192, R, C); const int Rb = Epi::PERM ? ((R & ~31) + perm32(R & 31)) : R;
        voffA[i] = (unsigned)(R * g.lda + C) * 2u; voffB[i] = (unsigned)(Rb * g.ldb + C) * 2u; }
    const size_t kstep = (size_t)(BK * 2);
    const size_t hstepA = (size_t)HALF * g.lda * 2, hstepB = (size_t)HALF * g.ldb * 2;
    const size_t tstepA = 2 * hstepA, tstepB = 2 * hstepB;
    const unsigned ldsw = (unsigned)wid * 1024u;
    const int aoff = lds_byte(wr * 64 + fr, fq * 8), boff = lds_byte(wc * 32 + fr, fq * 8);
#define PG8_SA(b, h) (((b) * 2 + (h)) * HTB)
#define PG8_SB(b, h) ((4 + (b) * 2 + (h)) * HTB)
#define PG8_STAGE(bufoff, gbase, voff) do { _Pragma("unroll") for (int _i = 0; _i < 2; ++_i) \
        __builtin_amdgcn_global_load_lds((const unsigned*)((const char*)(gbase) + (voff)[_i]), (LAS unsigned*)(lds + (bufoff) + ldsw + _i * 8192), 16, 0, 0); } while (0)
#define PG8_LDA(dst, b, h) do { _Pragma("unroll") for (int m = 0; m < 4; ++m) _Pragma("unroll") for (int k = 0; k < 2; ++k) dst[m][k] = *(const LAS bf16x8*)(lds + PG8_SA(b, h) + aoff + m * 2048 + k * 1024); } while (0)
#define PG8_LDB(dst, b, h) do { _Pragma("unroll") for (int n = 0; n < 2; ++n) _Pragma("unroll") for (int k = 0; k < 2; ++k) dst[n][k] = *(const LAS bf16x8*)(lds + PG8_SB(b, h) + boff + n * 2048 + k * 1024); } while (0)
#define PG8_MMA(ai, bj, At, Bt) do { __builtin_amdgcn_s_setprio(1); _Pragma("unroll") for (int m = 0; m < 4; ++m) _Pragma("unroll") for (int n = 0; n < 2; ++n) _Pragma("unroll") for (int k = 0; k < 2; ++k) \
        acc[ai][bj][m][n] = __builtin_amdgcn_mfma_f32_16x16x32_bf16(Bt[n][k], At[m][k], acc[ai][bj][m][n], 0, 0, 0); __builtin_amdgcn_s_setprio(0); } while (0)
#define PG8_WAIT_V(n) asm volatile("s_waitcnt vmcnt(" #n ")" ::: "memory")
#define PG8_WAIT_L(n) asm volatile("s_waitcnt lgkmcnt(" #n ")" ::: "memory")
#define PG8_BAR __builtin_amdgcn_s_barrier()
#define PG8_SCHED __builtin_amdgcn_sched_barrier(0)
#define PG8_ABASE(u) ((const char*)((u).z ? g.A2 : g.A) + (size_t)(u).pm * tstepA)
#define PG8_BBASE(u) ((const char*)((u).z ? g.Bt2 : g.Bt) + (size_t)(u).pn * tstepB)
    Unit cur, nxt; int ui = 0;
    if (!S.next(0, cur)) return;
    f32x4 acc[2][2][4][2];
#pragma unroll
    for (int a = 0; a < 2; ++a)
#pragma unroll
        for (int b = 0; b < 2; ++b)
#pragma unroll
            for (int m = 0; m < 4; ++m)
#pragma unroll
                for (int n = 0; n < 2; ++n) acc[a][b][m][n] = (f32x4){0.f, 0.f, 0.f, 0.f};
    bf16x8 At[4][2], B0[2][2], B1[2][2];
    const char* cA = PG8_ABASE(cur); const char* cB = PG8_BBASE(cur);
    PG8_STAGE(PG8_SB(0, 0), cB, voffB); PG8_STAGE(PG8_SA(0, 0), cA, voffA); PG8_STAGE(PG8_SB(0, 1), cB + hstepB, voffB); PG8_STAGE(PG8_SA(0, 1), cA + hstepA, voffA);
    if (wr == 1) PG8_BAR;
    PG8_WAIT_V(4); PG8_BAR;
    PG8_STAGE(PG8_SB(1, 0), cB + kstep, voffB); PG8_STAGE(PG8_SA(1, 0), cA + kstep, voffA); PG8_STAGE(PG8_SB(1, 1), cB + hstepB + kstep, voffB);
    PG8_WAIT_V(6); PG8_BAR;
    for (;;) {
        const bool has_next = S.next(ui + 1, nxt);
        const char* nA = has_next ? PG8_ABASE(nxt) : cA; const char* nB = has_next ? PG8_BBASE(nxt) : cB;
        for (int t = 0; t < nt; t += 2) {
            const bool last = (t == nt - 2);
            const char* a1 = cA + (size_t)(t + 1) * kstep;
            const char* a2 = last ? nA : cA + (size_t)(t + 2) * kstep; const char* b2 = last ? nB : cB + (size_t)(t + 2) * kstep;
            const char* a3 = a2 + kstep; const char* b3 = b2 + kstep;
            PG8_LDB(B0, 0, 0); PG8_SCHED; PG8_LDA(At, 0, 0); PG8_STAGE(PG8_SA(1, 1), a1 + hstepA, voffA);
            PG8_WAIT_L(8); PG8_BAR; PG8_WAIT_L(0); PG8_MMA(0, 0, At, B0); PG8_BAR; PG8_SCHED;
            PG8_LDB(B1, 0, 1); PG8_STAGE(PG8_SB(0, 0), b2, voffB);
            PG8_BAR; PG8_WAIT_L(0); PG8_MMA(0, 1, At, B1); PG8_BAR;
            PG8_LDA(At, 0, 1); PG8_STAGE(PG8_SA(0, 0), a2, voffA);
            PG8_BAR; PG8_WAIT_L(0); PG8_MMA(1, 0, At, B0); PG8_BAR; PG8_SCHED;
            PG8_STAGE(PG8_SB(0, 1), b2 + hstepB, voffB);
            PG8_WAIT_V(6); PG8_BAR; PG8_MMA(1, 1, At, B1); PG8_BAR;
            PG8_LDB(B0, 1, 0); PG8_SCHED; PG8_LDA(At, 1, 0); PG8_STAGE(PG8_SA(0, 1), a2 + hstepA, voffA);
            PG8_WAIT_L(8); PG8_BAR; PG8_WAIT_L(0); PG8_MMA(0, 0, At, B0); PG8_BAR; PG8_SCHED;
            PG8_LDB(B1, 1, 1); PG8_STAGE(PG8_SB(1, 0), b3, voffB);
            PG8_BAR; PG8_WAIT_L(0); PG8_MMA(0, 1, At, B1); PG8_BAR;
            PG8_LDA(At, 1, 1); PG8_STAGE(PG8_SA(1, 0), a3, voffA);
            PG8_BAR; PG8_WAIT_L(0); PG8_MMA(1, 0, At, B0); PG8_BAR; PG8_SCHED;
            PG8_STAGE(PG8_SB(1, 1), b3 + hstepB, voffB);
            PG8_WAIT_V(6); PG8_BAR; PG8_MMA(1, 1, At, B1); PG8_BAR;
        }
        E(acc, cur, wr, wc, fr, fq);
        if (!has_next) break;
#pragma unroll
        for (int a = 0; a < 2; ++a)
#pragma unroll
            for (int b = 0; b < 2; ++b)
#pragma unroll
                for (int m = 0; m < 4; ++m)
#pragma unroll
                    for (int n = 0; n < 2; ++n) acc[a][b][m][n] = (f32x4){0.f, 0.f, 0.f, 0.f};
        cur = nxt; cA = nA; cB = nB; ++ui;
    }
    PG8_WAIT_V(0);
    if (wr == 0) PG8_BAR;
    PG8_BAR;
#undef PG8_SA
#undef PG8_SB
#undef PG8_STAGE
#undef PG8_LDA
#undef PG8_LDB
#undef PG8_MMA
#undef PG8_WAIT_V
#undef PG8_WAIT_L
#undef PG8_BAR
#undef PG8_SCHED
#undef PG8_ABASE
#undef PG8_BBASE
}

struct EpiBf16 {
    static constexpr bool PERM = true;
    bf16_t* O; int ldc; int sig_from;
    __device__ __forceinline__ void operator()(const f32x4 (&acc)[2][2][4][2], const Unit& u, int wr, int wc, int fr, int fq) const {
        const int row0 = u.pm * BM + wr * 64 + fr, col0 = u.pn * BM + wc * 32 + 8 * fq; const bool sig = u.pn >= sig_from;
#pragma unroll
        for (int ai = 0; ai < 2; ++ai)
#pragma unroll
            for (int m = 0; m < 4; ++m) { bf16_t* rowp = O + (size_t)(row0 + ai * HALF + m * 16) * ldc + col0;
#pragma unroll
                for (int bj = 0; bj < 2; ++bj) { f32x4 v0 = acc[ai][bj][m][0], v1 = acc[ai][bj][m][1];
                    if (sig) {
#pragma unroll
                        for (int j = 0; j < 4; ++j) { v0[j] = sigmoidf_(v0[j]); v1[j] = sigmoidf_(v1[j]); } }
                    u32x4 w; w.x = pk2(v0[0], v0[1]); w.y = pk2(v0[2], v0[3]); w.z = pk2(v1[0], v1[1]); w.w = pk2(v1[2], v1[3]);
                    *(u32x4*)(rowp + bj * HALF) = w; } }
    }
};
struct EpiMix {
    static constexpr bool PERM = true;
    bf16_t* O; const bf16_t* P;
    __device__ __forceinline__ void operator()(const f32x4 (&acc)[2][2][4][2], const Unit& u, int wr, int wc, int fr, int fq) const {
        const int row0 = u.pm * BM + wr * 64 + fr, col0 = u.pn * BM + wc * 32 + 8 * fq; const int gcol = (u.z ? C_GG : C_GA);
#pragma unroll
        for (int ai = 0; ai < 2; ++ai)
#pragma unroll
            for (int m = 0; m < 4; ++m) { const size_t r = (size_t)(row0 + ai * HALF + m * 16);
#pragma unroll
                for (int bj = 0; bj < 2; ++bj) { const f32x4 v0 = acc[ai][bj][m][0], v1 = acc[ai][bj][m][1];
                    const u32x4 gw = *(const u32x4*)(P + r * NP + gcol + col0 + bj * HALF);
                    float o[8] = {v0[0] * bflo(gw.x), v0[1] * bfhi(gw.x), v0[2] * bflo(gw.y), v0[3] * bfhi(gw.y), v1[0] * bflo(gw.z), v1[1] * bfhi(gw.z), v1[2] * bflo(gw.w), v1[3] * bfhi(gw.w)};
                    bf16_t* op = O + r * D + col0 + bj * HALF;
                    if (u.z) { const u32x4 pw = *(const u32x4*)op; o[0] += bflo(pw.x); o[1] += bfhi(pw.x); o[2] += bflo(pw.y); o[3] += bfhi(pw.y); o[4] += bflo(pw.z); o[5] += bfhi(pw.z); o[6] += bflo(pw.w); o[7] += bfhi(pw.w); }
                    u32x4 w; w.x = pk2(o[0], o[1]); w.y = pk2(o[2], o[3]); w.z = pk2(o[4], o[5]); w.w = pk2(o[6], o[7]);
                    *(u32x4*)op = w; } }
    }
};
struct EpiX1 {
    static constexpr bool PERM = false;
    const float* x; float* out; const float* gate;
    __device__ __forceinline__ void operator()(const f32x4 (&acc)[2][2][4][2], const Unit& u, int wr, int wc, int fr, int fq) const {
        const int row0 = u.pm * BM + wr * 64 + fr, col0 = u.pn * BM + wc * 32 + 4 * fq; const int b = (u.pm * BM) >> 11;
        f32x4 gv[2][2];
#pragma unroll
        for (int bj = 0; bj < 2; ++bj)
#pragma unroll
            for (int n = 0; n < 2; ++n) gv[bj][n] = *(const f32x4*)(gate + (size_t)b * NADA + col0 + bj * HALF + n * 16);
#pragma unroll
        for (int ai = 0; ai < 2; ++ai)
#pragma unroll
            for (int m = 0; m < 4; ++m) { const size_t off = (size_t)(row0 + ai * HALF + m * 16) * D + col0;
#pragma unroll
                for (int bj = 0; bj < 2; ++bj)
#pragma unroll
                    for (int n = 0; n < 2; ++n) { const f32x4 xv = *(const f32x4*)(x + off + bj * HALF + n * 16);
                        *(f32x4*)(out + off + bj * HALF + n * 16) = xv + gv[bj][n] * acc[ai][bj][m][n]; } }
    }
};
}

__device__ __forceinline__ void phase_mod(const Params& p, unsigned char* lds) {
    float* sc = (float*)lds;
    float* red = (float*)(lds + 65536);
    const int tid = threadIdx.x, wave = tid >> 6, lane = tid & 63;
    const float* c = p.in[1]; const float* wada = p.in[2]; const float* bada = p.in[3];
    float* mod = (float*)(p.ws + WS_MOD);
    if ((int)blockIdx.x >= 192) return;
    for (int i = tid; i < NBATCH * D; i += NTHREADS) { const int b = i >> 11, k = i & 2047; sc[k * 8 + b] = siluf_(c[i]); }
    __syncthreads();
    const int cgp = tid & 15, rg = tid >> 4;
    for (int item = blockIdx.x; item < 192; item += gridDim.x) {
        const float* w = wada + item * 64 + cgp * 4;
        float acc[8][4];
#pragma unroll
        for (int b = 0; b < 8; ++b)
#pragma unroll
            for (int j = 0; j < 4; ++j) acc[b][j] = 0.f;
#pragma unroll 4
        for (int i = 0; i < 64; ++i) { const int k = rg + 32 * i; const f32x4 wv = *(const f32x4*)(w + (size_t)k * NADA);
            const f32x4 s0 = *(const f32x4*)(sc + k * 8), s1 = *(const f32x4*)(sc + k * 8 + 4);
#pragma unroll
            for (int j = 0; j < 4; ++j) { acc[0][j] += s0[0] * wv[j]; acc[1][j] += s0[1] * wv[j]; acc[2][j] += s0[2] * wv[j]; acc[3][j] += s0[3] * wv[j];
                acc[4][j] += s1[0] * wv[j]; acc[5][j] += s1[1] * wv[j]; acc[6][j] += s1[2] * wv[j]; acc[7][j] += s1[3] * wv[j]; } }
#pragma unroll
        for (int b = 0; b < 8; ++b)
#pragma unroll
            for (int j = 0; j < 4; ++j) { float v = acc[b][j]; v += __shfl_xor(v, 16); v += __shfl_xor(v, 32); acc[b][j] = v; }
        if (lane < 16) {
#pragma unroll
            for (int b = 0; b < 8; ++b)
#pragma unroll
                for (int j = 0; j < 4; ++j) red[(wave * 16 + cgp) * 32 + b * 4 + j] = acc[b][j]; }
        __syncthreads();
        { const int cgo = tid >> 5, b = (tid >> 2) & 7, j = tid & 3; float s = 0.f;
#pragma unroll
          for (int w8 = 0; w8 < 8; ++w8) s += red[(w8 * 16 + cgo) * 32 + (tid & 31)];
          const int col = item * 64 + cgo * 4 + j; mod[b * NADA + col] = s + bada[col]; }
        __syncthreads();
    }
}
__device__ __forceinline__ void transpose_item(const float* W, int K, int N, bf16_t* WT, int nblk, int item, int lane, float* scr, int mode) {
    const int kb = item / nblk, nb = item % nblk, k0 = 64 * kb, n0 = 32 * nb;
    const int nd = n0 + (lane & 31); int ns = nd; bool valid = true;
    if (mode == 1) { if (nd >= C_QB) ns = nd - 176; else if (nd >= 4176) valid = false; }
#pragma unroll 8
    for (int i = 0; i < 32; ++i) { const int kk = 2 * i + (lane >> 5); scr[kk * 33 + (lane & 31)] = valid ? W[(size_t)(k0 + kk) * N + ns] : 0.f; }
    LDS_WAIT();
    const int c = lane & 7;
#pragma unroll
    for (int j = 0; j < 4; ++j) { const int n = (lane >> 3) + 8 * j; const float* s = scr + (8 * c) * 33 + n;
        u32x4 o; o.x = pk2(s[0 * 33], s[1 * 33]); o.y = pk2(s[2 * 33], s[3 * 33]); o.z = pk2(s[4 * 33], s[5 * 33]); o.w = pk2(s[6 * 33], s[7 * 33]);
        *(u32x4*)(WT + (size_t)(n0 + n) * K + k0 + 8 * c) = o; }
    LDS_WAIT();
}
__device__ __forceinline__ void phase_weights(const Params& p, unsigned char* lds) {
    const int tid = threadIdx.x, wave = tid >> 6, lane = tid & 63;
    float* scr = (float*)(lds + wave * 16384);
    const int vb = ((int)blockIdx.x + (int)gridDim.x - 192 % (int)gridDim.x) % (int)gridDim.x;
    const int gw = vb * NWAVES + wave, NGW = gridDim.x * NWAVES;
    constexpr int I_IN = 32 * (NP / 32), I_UA = 16 * 64, I_UB = 16 * 64, I_O = 32 * 64, I_Q = 32 * 64;
    constexpr int NITEMS = I_IN + I_UA + I_UB + I_O + I_Q;
    bf16_t* win_t = (bf16_t*)((unsigned char*)p.out + OUT_WIN);
    for (int it = gw; it < NITEMS; it += NGW) {
        int r = it;
        if (r < I_IN) { transpose_item(p.in[6], 2048, 12368, win_t, NP / 32, r, lane, scr, 1); continue; } r -= I_IN;
        if (r < I_UA) { transpose_item(p.in[9], 1024, 2048, (bf16_t*)(p.ws + WS_WUA), 64, r, lane, scr, 0); continue; } r -= I_UA;
        if (r < I_UB) { transpose_item(p.in[10], 1024, 2048, (bf16_t*)(p.ws + WS_WUB), 64, r, lane, scr, 0); continue; } r -= I_UB;
        if (r < I_O) { transpose_item(p.in[11], 2048, 2048, (bf16_t*)(p.ws + WS_WOUT), 64, r, lane, scr, 0); continue; } r -= I_O;
        transpose_item(p.in[12], 2048, 2048, (bf16_t*)(p.ws + WS_WQ), 64, r, lane, scr, 0);
    }
    { const float* ks = p.in[13]; bf16_t* kd = (bf16_t*)(p.ws + WS_KEYS);
      for (int i = (blockIdx.x * NTHREADS + tid) * 4; i < 8 * 2 * 128 * 128; i += gridDim.x * NTHREADS * 4) { const f32x4 v = *(const f32x4*)(ks + i); u32x2 o; o.x = pk2(v[0], v[1]); o.y = pk2(v[2], v[3]); *(u32x2*)(kd + i) = o; } }
}

__device__ __forceinline__ void phase_norm_rows(const float* src, const float* gain, const float* shift, const float* scale, bf16_t* dst) {
    const int tid = threadIdx.x, wave = tid >> 6, lane = tid & 63;
    const int gw = blockIdx.x * NWAVES + wave, NGW = gridDim.x * NWAVES;
    for (int row = gw; row < T; row += NGW) {
        const int b = row >> 11; const f32x4* xr = (const f32x4*)(src + (size_t)row * D) + lane;
        f32x4 v[8]; float ss = 0.f;
#pragma unroll
        for (int j = 0; j < 8; ++j) { v[j] = xr[64 * j]; ss += (v[j][0] * v[j][0] + v[j][1] * v[j][1]) + (v[j][2] * v[j][2] + v[j][3] * v[j][3]); }
        const float rstd = rsqrtf(wave_sum(ss) * (1.f / D) + NORM_EPS);
        u32x2* o8 = (u32x2*)(dst + (size_t)row * D) + lane;
#pragma unroll
        for (int j = 0; j < 8; ++j) { const int col = 4 * (lane + 64 * j);
            const f32x4 g = *(const f32x4*)(gain + col), sh = *(const f32x4*)(shift + (size_t)b * NADA + col), sc = *(const f32x4*)(scale + (size_t)b * NADA + col);
            f32x4 h;
#pragma unroll
            for (int e = 0; e < 4; ++e) h[e] = v[j][e] * rstd * g[e] * (1.f + sc[e]) + sh[e];
            u32x2 w; w.x = pk2(h[0], h[1]); w.y = pk2(h[2], h[3]); o8[64 * j] = w; }
    }
}

__device__ __forceinline__ void phase_vt(const Params& p, unsigned char* lds, int vb, int vG) {
    const int tid = threadIdx.x, wave = tid >> 6, lane = tid & 63;
    bf16_t* tile = (bf16_t*)(lds + wave * 16384);
    const bf16_t* P = (const bf16_t*)(p.ws + WS_P); bf16_t* VT = (bf16_t*)(p.ws + WS_VT);
    const int gw = vb * NWAVES + wave, NGW = vG * NWAVES;
    for (int it = gw; it < 8 * 8 * 32 * 2; it += NGW) {
        const int dh = it & 1, kt = (it >> 1) & 31, h = (it >> 6) & 7, b = it >> 9;
        const int k0 = kt * 64, d0 = dh * 64;
#pragma unroll
        for (int i = 0; i < 8; ++i) { const int key = i * 8 + (lane >> 3), dc = lane & 7;
            const u32x4 v = *(const u32x4*)(P + (size_t)(b * SEQ + k0 + key) * NP + C_VA + h * 128 + d0 + dc * 8);
            bf16_t* t = tile + (dc * 8) * 72 + key;
            t[0 * 72] = (bf16_t)(v.x & 0xffff); t[1 * 72] = (bf16_t)(v.x >> 16); t[2 * 72] = (bf16_t)(v.y & 0xffff); t[3 * 72] = (bf16_t)(v.y >> 16);
            t[4 * 72] = (bf16_t)(v.z & 0xffff); t[5 * 72] = (bf16_t)(v.z >> 16); t[6 * 72] = (bf16_t)(v.w & 0xffff); t[7 * 72] = (bf16_t)(v.w >> 16); }
        LDS_WAIT();
#pragma unroll
        for (int i = 0; i < 8; ++i) { const int d = i * 8 + (lane >> 3), kc = lane & 7;
            const u32x4 v = *(const u32x4*)(tile + d * 72 + kc * 8);
            *(u32x4*)(VT + ((size_t)((b * 8 + h) * 128 + d0 + d)) * SEQ + k0 + kc * 8) = v; }
        LDS_WAIT();
    }
}

__device__ __forceinline__ unsigned ord_key(float s) { const unsigned u = __float_as_uint(s); return (u & 0x80000000u) ? ~u : (u | 0x80000000u); }
__device__ __forceinline__ int half_sum(int v) {
#pragma unroll
    for (int o = 1; o < 32; o <<= 1) v += __shfl_xor(v, o);
    return v;
}
__device__ __forceinline__ void indexer_pair(const bf16_t* P, unsigned* MASK, int b, int c, int pair, int lane) {
    const int r = lane & 31, hh = lane >> 5;
    const int q0 = b * SEQ + c * 64 + 2 * pair;
    bf16x8 af[4];
    { const int query = q0 + ((r >> 2) & 1), head = (r & 3) + 4 * (r >> 3);
      const bf16_t* qp = P + (size_t)query * NP + C_QI + head * 64 + 8 * hh;
#pragma unroll
      for (int ks = 0; ks < 4; ++ks) af[ks] = *(const bf16x8*)(qp + ks * 16); }
    float wv[16];
    { const u32x4 w0 = *(const u32x4*)(P + (size_t)(q0 + hh) * NP + C_WI), w1 = *(const u32x4*)(P + (size_t)(q0 + hh) * NP + C_WI + 8);
      wv[0] = bflo(w0.x); wv[1] = bfhi(w0.x); wv[2] = bflo(w0.y); wv[3] = bfhi(w0.y); wv[4] = bflo(w0.z); wv[5] = bfhi(w0.z); wv[6] = bflo(w0.w); wv[7] = bfhi(w0.w);
      wv[8] = bflo(w1.x); wv[9] = bfhi(w1.x); wv[10] = bflo(w1.y); wv[11] = bfhi(w1.y); wv[12] = bflo(w1.z); wv[13] = bfhi(w1.z); wv[14] = bflo(w1.w); wv[15] = bfhi(w1.w); }
    const int nkt = 2 * (c + 1);
    unsigned kv[64];
    const bf16_t* kbase = P + (size_t)(b * SEQ + r) * NP + C_KI + 8 * hh;
#pragma unroll
    for (int kt = 0; kt < 64; ++kt) {
        kv[kt] = 0u;
        if (kt < nkt) {
            const bf16_t* kp = kbase + (size_t)(kt * 32) * NP;
            f32x16 acc;
#pragma unroll
            for (int i = 0; i < 16; ++i) acc[i] = 0.f;
#pragma unroll
            for (int ks = 0; ks < 4; ++ks) { const bf16x8 bfr = *(const bf16x8*)(kp + ks * 16); acc = __builtin_amdgcn_mfma_f32_32x32x16_bf16(af[ks], bfr, acc, 0, 0, 0); }
            float s = 0.f;
#pragma unroll
            for (int i = 0; i < 16; ++i) s += wv[i] * fmaxf(acc[i], 0.f);
            kv[kt] = ord_key(s);
        }
    }
    unsigned thr = 0u;
    for (int bit = 31; bit >= 0; --bit) {
        const unsigned cand = thr | (1u << bit); int cnt = 0;
#pragma unroll
        for (int kt = 0; kt < 64; ++kt) cnt += (kv[kt] >= cand) ? 1 : 0;
        cnt = half_sum(cnt);
        if (cnt >= 256) thr = cand;
    }
    int cge = 0;
#pragma unroll
    for (int kt = 0; kt < 64; ++kt) cge += (kv[kt] >= thr && kv[kt] != 0u) ? 1 : 0;
    cge = half_sum(cge);
    const bool ties = (thr != 0u) && (cge > 256);
    unsigned m0 = 0u, m1 = 0u;
    if (__builtin_amdgcn_ballot_w64(ties) == 0ull) {
#pragma unroll
        for (int kt = 0; kt < 64; ++kt) { const unsigned long long bm = __builtin_amdgcn_ballot_w64(kv[kt] >= thr && kv[kt] != 0u);
            if (lane == kt) { m0 = (unsigned)bm; m1 = (unsigned)(bm >> 32); } }
    } else {
        int cgt = 0;
#pragma unroll
        for (int kt = 0; kt < 64; ++kt) cgt += (kv[kt] > thr) ? 1 : 0;
        cgt = half_sum(cgt);
        const int need = ties ? (256 - cgt) : (1 << 30); int run = 0;
#pragma unroll
        for (int kt = 0; kt < 64; ++kt) { const bool tie = ties && (kv[kt] == thr); const unsigned long long tb = __builtin_amdgcn_ballot_w64(tie);
            const unsigned th = hh ? (unsigned)(tb >> 32) : (unsigned)tb; const int rank = run + __builtin_popcount(th & ((1u << r) - 1u));
            const bool sel = ties ? ((kv[kt] > thr) || (tie && rank < need)) : (kv[kt] >= thr && kv[kt] != 0u);
            run += __builtin_popcount(th);
            const unsigned long long bm = __builtin_amdgcn_ballot_w64(sel);
            if (lane == kt) { m0 = (unsigned)bm; m1 = (unsigned)(bm >> 32); } }
    }
    MASK[(size_t)q0 * 64 + lane] = m0; MASK[(size_t)(q0 + 1) * 64 + lane] = m1;
}
__device__ __forceinline__ void phase_indexer(const Params& p, int vb, int vG) {
    const int tid = threadIdx.x, wave = tid >> 6, lane = tid & 63;
    const bf16_t* P = (const bf16_t*)(p.ws + WS_P); unsigned* MASK = (unsigned*)(p.ws + WS_MASK);
    const int G = vG;
    for (int rd = 0;; ++rd) {
        const int base = rd * G; if (base >= 1024) break;
        const int pos = (rd & 1) ? (G - 1 - vb) : vb; const int i = base + pos; if (i >= 1024) continue;
        const int c = 31 - (i >> 5), b = (i >> 2) & 7, grp = i & 3;
        indexer_pair(P, MASK, b, c, grp * 8 + wave, lane);
    }
}

constexpr int HG_RS = 136, HG_TS = 72, HG_SS = 136;
constexpr int HG_QT = 0, HG_QH = 17408, HG_KT = 34816, HG_KHT = 52224, HG_VT = 70656, HG_ST = 89088, HG_DEC = 123904, HG_SSQ = 124416;
__device__ __forceinline__ void hgrn_item(const Params& p, unsigned char* lds, int item) {
    const int tid = threadIdx.x, w = tid >> 6, lane = tid & 63, r = lane & 31, hh = lane >> 5;
    const int b = item >> 3, h = item & 7;
    const bf16_t* P = (const bf16_t*)(p.ws + WS_P); bf16_t* REC = (bf16_t*)((unsigned char*)p.out + OUT_REC);
    bf16_t* QT = (bf16_t*)(lds + HG_QT); bf16_t* QH = (bf16_t*)(lds + HG_QH); bf16_t* KT = (bf16_t*)(lds + HG_KT); bf16_t* KHT = (bf16_t*)(lds + HG_KHT); bf16_t* VT = (bf16_t*)(lds + HG_VT);
    bf16_t* ST = (bf16_t*)(lds + HG_ST); float* DEC = (float*)(lds + HG_DEC); float* SSQ = (float*)(lds + HG_SSQ);
    const int seg = lane >> 4, dl = lane & 15, d = 16 * w + dl;
    const float lb = sigmoidf_(p.in[7][h * 128 + d] - p.in[7][1024 + h * 128 + d]);
    const int tb = w & 1, eb = w >> 1, sdb = w & 3, seb0 = 2 * (w >> 2);
    const float gain_e = p.in[8][32 * eb + r];
    f32x16 S0, S1;
#pragma unroll
    for (int i = 0; i < 16; ++i) { S0[i] = 0.f; S1[i] = 0.f; }
    __syncthreads();
    for (int i = tid; i < 128 * HG_SS / 2; i += NTHREADS) ((unsigned*)ST)[i] = 0u;
    unsigned short rq[16], rf[16], ri[16];
    { const bf16_t* src = P + (size_t)(b * SEQ + 16 * seg) * NP + h * 128 + d;
#pragma unroll
      for (int i = 0; i < 16; ++i) { rq[i] = src[(size_t)i * NP + C_QB]; rf[i] = src[(size_t)i * NP + C_FB]; ri[i] = src[(size_t)i * NP + C_IB]; } }
#pragma unroll 1
    for (int n = 0; n < 32; ++n) {
        {
            float lf[16], kk[16];
            float run = 0.f;
#pragma unroll
            for (int i = 0; i < 16; ++i) { const float f = lb + (1.f - lb) * sigmoidf_(bf2f(rf[i])); kk[i] = 1.f - f; run += __logf(f); lf[i] = run; }
            const float p0 = __shfl(run, dl), p1 = __shfl(run, 16 + dl), p2 = __shfl(run, 32 + dl), p3 = __shfl(run, 48 + dl);
            const float off = (seg > 0 ? p0 : 0.f) + (seg > 1 ? p1 : 0.f) + (seg > 2 ? p2 : 0.f), bL = (p0 + p1) + (p2 + p3), bref = p0 + p1;
            unsigned kh[8], vv[8];
#pragma unroll
            for (int i = 0; i < 16; ++i) { const float bt = off + lf[i]; const float qs = siluf_(bf2f(rq[i]));
                const float e1 = __expf(bt - bref), e2 = __expf(bt), e3 = __builtin_amdgcn_rcpf(e1), e4 = __expf(bL - bt);
                const int t = 16 * seg + i;
                QT[t * HG_RS + d] = (bf16_t)f2bf(qs * e1); QH[t * HG_RS + d] = (bf16_t)f2bf(qs * e2); KT[t * HG_RS + d] = (bf16_t)f2bf(kk[i] * e3);
                const unsigned khv = f2bf(kk[i] * e4);
                if (i & 1) { kh[i >> 1] |= khv << 16; vv[i >> 1] |= (unsigned)ri[i] << 16; } else { kh[i >> 1] = khv; vv[i >> 1] = (unsigned)ri[i]; } }
            *(u32x4*)(KHT + d * HG_TS + 16 * seg) = (u32x4){kh[0], kh[1], kh[2], kh[3]}; *(u32x4*)(KHT + d * HG_TS + 16 * seg + 8) = (u32x4){kh[4], kh[5], kh[6], kh[7]};
            *(u32x4*)(VT + d * HG_TS + 16 * seg) = (u32x4){vv[0], vv[1], vv[2], vv[3]}; *(u32x4*)(VT + d * HG_TS + 16 * seg + 8) = (u32x4){vv[4], vv[5], vv[6], vv[7]};
            if (seg == 0) DEC[d] = __expf(bL);
        }
        __syncthreads();
        if (n < 31) { const bf16_t* src = P + (size_t)(b * SEQ + (n + 1) * 64 + 16 * seg) * NP + h * 128 + d;
#pragma unroll
            for (int i = 0; i < 16; ++i) { rq[i] = src[(size_t)i * NP + C_QB]; rf[i] = src[(size_t)i * NP + C_FB]; ri[i] = src[(size_t)i * NP + C_IB]; } }
        unsigned short gbv[16];
        { const bf16_t* gsrc = P + (size_t)(b * SEQ + n * 64 + 32 * tb + 4 * hh) * NP + C_GB + h * 128 + 32 * eb + r;
#pragma unroll
          for (int i = 0; i < 16; ++i) gbv[i] = gsrc[(size_t)((i & 3) + 8 * (i >> 2)) * NP]; }
        f32x16 X0, X1, o;
#pragma unroll
        for (int i = 0; i < 16; ++i) { X0[i] = 0.f; X1[i] = 0.f; o[i] = 0.f; }
#pragma unroll
        for (int ks = 0; ks < 8; ++ks) { const bf16x8 bq = *(const bf16x8*)(QT + (32 * tb + r) * HG_RS + 16 * ks + 8 * hh);
            const bf16x8 a0 = *(const bf16x8*)(KT + r * HG_RS + 16 * ks + 8 * hh); X0 = __builtin_amdgcn_mfma_f32_32x32x16_bf16(a0, bq, X0, 0, 0, 0);
            if (tb == 1) { const bf16x8 a1 = *(const bf16x8*)(KT + (32 + r) * HG_RS + 16 * ks + 8 * hh); X1 = __builtin_amdgcn_mfma_f32_32x32x16_bf16(a1, bq, X1, 0, 0, 0); } }
#pragma unroll
        for (int i = 0; i < 16; ++i) { const bool keep = ((i & 3) + 8 * (i >> 2) + 4 * hh) <= r; if (tb == 0) X0[i] = keep ? X0[i] : 0.f; else X1[i] = keep ? X1[i] : 0.f; }
#pragma unroll
        for (int sb = 0; sb < 2; ++sb) { if (sb <= tb) {
#pragma unroll
            for (int s2 = 0; s2 < 2; ++s2) { u32x4 aw;
                if (sb == 0) { aw.x = pk2(X0[8 * s2], X0[8 * s2 + 1]); aw.y = pk2(X0[8 * s2 + 2], X0[8 * s2 + 3]); aw.z = pk2(X0[8 * s2 + 4], X0[8 * s2 + 5]); aw.w = pk2(X0[8 * s2 + 6], X0[8 * s2 + 7]); }
                else { aw.x = pk2(X1[8 * s2], X1[8 * s2 + 1]); aw.y = pk2(X1[8 * s2 + 2], X1[8 * s2 + 3]); aw.z = pk2(X1[8 * s2 + 4], X1[8 * s2 + 5]); aw.w = pk2(X1[8 * s2 + 6], X1[8 * s2 + 7]); }
                const bf16_t* vp = VT + (32 * eb + r) * HG_TS + 32 * sb + 16 * s2 + 4 * hh;
                const u32x2 lo = *(const u32x2*)vp, hi = *(const u32x2*)(vp + 8); const u32x4 bw = {lo.x, lo.y, hi.x, hi.y};
                o = __builtin_amdgcn_mfma_f32_32x32x16_bf16(__builtin_bit_cast(bf16x8, aw), __builtin_bit_cast(bf16x8, bw), o, 0, 0, 0); } } }
#pragma unroll
        for (int ks = 0; ks < 8; ++ks) { const bf16x8 aq = *(const bf16x8*)(QH + (32 * tb + r) * HG_RS + 16 * ks + 8 * hh), bs = *(const bf16x8*)(ST + (32 * eb + r) * HG_SS + 16 * ks + 8 * hh);
            o = __builtin_amdgcn_mfma_f32_32x32x16_bf16(aq, bs, o, 0, 0, 0); }
        { float a8[8], a4[4], a2[2], a1;
#pragma unroll
          for (int i = 0; i < 8; ++i) { const float lo = o[i] * o[i], hi = o[i + 8] * o[i + 8]; const bool up = lane & 16; const float keep = up ? hi : lo, send = up ? lo : hi; a8[i] = keep + __shfl_xor(send, 16); }
#pragma unroll
          for (int i = 0; i < 4; ++i) { const bool up = lane & 8; const float keep = up ? a8[i + 4] : a8[i], send = up ? a8[i] : a8[i + 4]; a4[i] = keep + __shfl_xor(send, 8); }
#pragma unroll
          for (int i = 0; i < 2; ++i) { const bool up = lane & 4; const float keep = up ? a4[i + 2] : a4[i], send = up ? a4[i] : a4[i + 2]; a2[i] = keep + __shfl_xor(send, 4); }
          { const bool up = lane & 2; const float keep = up ? a2[1] : a2[0], send = up ? a2[0] : a2[1]; a1 = keep + __shfl_xor(send, 2); }
          a1 += __shfl_xor(a1, 1);
          const int ri2 = (lane >> 1) & 15;
          if ((lane & 1) == 0) SSQ[(32 * tb + (ri2 & 3) + 8 * (ri2 >> 2) + 4 * hh) * 4 + eb] = a1; }
        { float dc[16];
#pragma unroll
          for (int g4 = 0; g4 < 4; ++g4) { const f32x4 dv = *(const f32x4*)(DEC + 32 * sdb + 8 * g4 + 4 * hh); dc[4 * g4] = dv[0]; dc[4 * g4 + 1] = dv[1]; dc[4 * g4 + 2] = dv[2]; dc[4 * g4 + 3] = dv[3]; }
#pragma unroll
          for (int i = 0; i < 16; ++i) { S0[i] *= dc[i]; S1[i] *= dc[i]; }
#pragma unroll
          for (int ss = 0; ss < 4; ++ss) { const bf16x8 a = *(const bf16x8*)(KHT + (32 * sdb + r) * HG_TS + 16 * ss + 8 * hh);
              const bf16x8 b0 = *(const bf16x8*)(VT + (32 * seb0 + r) * HG_TS + 16 * ss + 8 * hh), b1 = *(const bf16x8*)(VT + (32 * (seb0 + 1) + r) * HG_TS + 16 * ss + 8 * hh);
              S0 = __builtin_amdgcn_mfma_f32_32x32x16_bf16(a, b0, S0, 0, 0, 0); S1 = __builtin_amdgcn_mfma_f32_32x32x16_bf16(a, b1, S1, 0, 0, 0); } }
        __syncthreads();
#pragma unroll
        for (int g4 = 0; g4 < 4; ++g4) { const int d0 = 32 * sdb + 8 * g4 + 4 * hh;
            *(u32x2*)(ST + (32 * seb0 + r) * HG_SS + d0) = (u32x2){pk2(S0[4 * g4], S0[4 * g4 + 1]), pk2(S0[4 * g4 + 2], S0[4 * g4 + 3])};
            *(u32x2*)(ST + (32 * (seb0 + 1) + r) * HG_SS + d0) = (u32x2){pk2(S1[4 * g4], S1[4 * g4 + 1]), pk2(S1[4 * g4 + 2], S1[4 * g4 + 3])}; }
        { bf16_t* dst = REC + (size_t)(b * SEQ + n * 64 + 32 * tb + 4 * hh) * 1024 + h * 128 + 32 * eb + r;
#pragma unroll
          for (int i = 0; i < 16; ++i) { const int tr = (i & 3) + 8 * (i >> 2); const f32x4 q4 = *(const f32x4*)(SSQ + (32 * tb + tr + 4 * hh) * 4);
              const float rstd = rsqrtf(((q4[0] + q4[1]) + (q4[2] + q4[3])) * (1.f / 128.f) + NORM_EPS);
              dst[(size_t)tr * 1024] = (bf16_t)f2bf(o[i] * rstd * gain_e * siluf_(bf2f(gbv[i]))); } }
    }
}
__device__ __forceinline__ void phase_hgrn(const Params& p, unsigned char* lds, int vb, int vG) {
    for (int it = vb; it < 64; it += vG) hgrn_item(p, lds, it);
}

__device__ __forceinline__ void attn_task(const bf16_t* P, const bf16_t* VT, const unsigned* MASK, bf16_t* Pout, int b, int c, int qh, int head, int lane) {
    const int r = lane & 31, hh = lane >> 5;
    const int tq = b * SEQ + c * 64 + qh * 32 + r;
    bf16x8 qf[8];
    { const bf16_t* qp = P + (size_t)tq * NP + C_QA + head * 128 + 8 * hh;
#pragma unroll
      for (int ks = 0; ks < 8; ++ks) qf[ks] = *(const bf16x8*)(qp + ks * 16); }
    f32x16 o[4];
#pragma unroll
    for (int db = 0; db < 4; ++db)
#pragma unroll
        for (int i = 0; i < 16; ++i) o[db][i] = 0.f;
    float mrun = -1e30f, lsum = 0.f;
    const float sc = 0.08838834764831845f * 1.4426950408889634f;
    const int nkt = 2 * (c + 1);
    const bf16_t* kbase = P + (size_t)(b * SEQ + r) * NP + C_KA + head * 128 + 8 * hh;
    const bf16_t* vbase = VT + (size_t)((b * 8 + head) * 128 + r) * SEQ + 4 * hh;
    const unsigned* mrow = MASK + (size_t)tq * 64;
    for (int kt = 0; kt < nkt; ++kt) {
        const bf16_t* kp = kbase + (size_t)(kt * 32) * NP;
        f32x16 s;
#pragma unroll
        for (int i = 0; i < 16; ++i) s[i] = 0.f;
#pragma unroll
        for (int ks = 0; ks < 8; ++ks) { const bf16x8 kf = *(const bf16x8*)(kp + ks * 16); s = __builtin_amdgcn_mfma_f32_32x32x16_bf16(kf, qf[ks], s, 0, 0, 0); }
        const unsigned mw = mrow[kt];
        float mx = -1e30f;
#pragma unroll
        for (int i = 0; i < 16; ++i) { const int bit = (i & 3) + 8 * (i >> 2) + 4 * hh; const bool ok = (mw >> bit) & 1u; s[i] = ok ? s[i] * sc : -1e30f; mx = fmaxf(mx, s[i]); }
        mx = fmaxf(mx, __shfl_xor(mx, 32));
        const float mnew = fmaxf(mrun, mx), alpha = exp2f(mrun - mnew); mrun = mnew;
        float ps = 0.f; float pv[16];
#pragma unroll
        for (int i = 0; i < 16; ++i) { const float e = (s[i] > -1e29f) ? exp2f(s[i] - mnew) : 0.f; pv[i] = e; ps += e; }
        lsum = lsum * alpha + ps;
#pragma unroll
        for (int db = 0; db < 4; ++db)
#pragma unroll
            for (int i = 0; i < 16; ++i) o[db][i] *= alpha;
        bf16x8 pf[2];
#pragma unroll
        for (int s2 = 0; s2 < 2; ++s2) { u32x4 w; w.x = pk2(pv[8 * s2 + 0], pv[8 * s2 + 1]); w.y = pk2(pv[8 * s2 + 2], pv[8 * s2 + 3]); w.z = pk2(pv[8 * s2 + 4], pv[8 * s2 + 5]); w.w = pk2(pv[8 * s2 + 6], pv[8 * s2 + 7]); pf[s2] = __builtin_bit_cast(bf16x8, w); }
        const bf16_t* vp = vbase + kt * 32;
#pragma unroll
        for (int db = 0; db < 4; ++db)
#pragma unroll
            for (int s2 = 0; s2 < 2; ++s2) { const u32x2 lo = *(const u32x2*)(vp + (size_t)(db * 32) * SEQ + 16 * s2), hi = *(const u32x2*)(vp + (size_t)(db * 32) * SEQ + 16 * s2 + 8);
                u32x4 w; w.x = lo.x; w.y = lo.y; w.z = hi.x; w.w = hi.y;
                o[db] = __builtin_amdgcn_mfma_f32_32x32x16_bf16(__builtin_bit_cast(bf16x8, w), pf[s2], o[db], 0, 0, 0); }
    }
    const float l = lsum + __shfl_xor(lsum, 32), inv = 1.f / l;
    bf16_t* op = Pout + (size_t)tq * 1024 + head * 128 + 4 * hh;
#pragma unroll
    for (int db = 0; db < 4; ++db)
#pragma unroll
        for (int g4 = 0; g4 < 4; ++g4) { u32x2 w; w.x = pk2(o[db][4 * g4] * inv, o[db][4 * g4 + 1] * inv); w.y = pk2(o[db][4 * g4 + 2] * inv, o[db][4 * g4 + 3] * inv);
            *(u32x2*)(op + db * 32 + 8 * g4) = w; }
}
__device__ __forceinline__ void phase_attn(const Params& p) {
    const int tid = threadIdx.x, wave = tid >> 6, lane = tid & 63;
    bf16_t* P = (bf16_t*)(p.ws + WS_P); const bf16_t* VT = (const bf16_t*)(p.ws + WS_VT); const unsigned* MASK = (const unsigned*)(p.ws + WS_MASK);
    const int G = gridDim.x;
    for (int rd = 0;; ++rd) {
        const int base = rd * G; if (base >= 512) break;
        const int pos = (rd & 1) ? (G - 1 - (int)blockIdx.x) : (int)blockIdx.x; const int i = base + pos; if (i >= 512) continue;
        const int c = 31 - (i >> 4), b = (i >> 1) & 7, qh = i & 1;
        attn_task(P, VT, MASK, (bf16_t*)((unsigned char*)p.out + OUT_AO), b, c, qh, wave, lane);
    }
}
__device__ __forceinline__ void phase_uv(const Params& p) {
    const float* u = p.in[14]; const float* v = p.in[15]; bf16_t* u16 = (bf16_t*)(p.ws + WS_U16); bf16_t* v16 = (bf16_t*)(p.ws + WS_V16);
    const int i0 = blockIdx.x * NTHREADS + threadIdx.x, st = gridDim.x * NTHREADS;
    for (int i = i0; i < 16384 * 256; i += st) { const int row = i >> 8, c = i & 255; const size_t so = (size_t)row * 2048 + c * 8, dof = ((size_t)(c >> 3) * 16384 + row) * 64 + (c & 7) * 8;
        const f32x4 a = *(const f32x4*)(u + so), b2 = *(const f32x4*)(u + so + 4), c4 = *(const f32x4*)(v + so), d = *(const f32x4*)(v + so + 4);
        u32x4 wu = {pk2(a[0], a[1]), pk2(a[2], a[3]), pk2(b2[0], b2[1]), pk2(b2[2], b2[3])}, wv = {pk2(c4[0], c4[1]), pk2(c4[2], c4[3]), pk2(d[0], d[1]), pk2(d[2], d[3])};
        *(u32x4*)(u16 + dof) = wu; *(u32x4*)(v16 + dof) = wv; }
}

#define INS16(v, x) do { _Pragma("unroll") for (int _j = 15; _j >= 1; --_j) v[_j] = __builtin_amdgcn_fmed3f(v[_j - 1], v[_j], (x)); v[0] = fmaxf(v[0], (x)); } while (0)
__device__ __forceinline__ void peer_half_top16(const bf16_t* QP, const bf16_t* KEYS, int tok, int p, int hf, int r, int hh, float (&v)[16]) {
    bf16x8 qf[8];
    { const bf16_t* qp = QP + (size_t)tok * D + p * 256 + hf * 128 + 8 * hh;
#pragma unroll
      for (int ks = 0; ks < 8; ++ks) qf[ks] = *(const bf16x8*)(qp + ks * 16); }
#pragma unroll
    for (int k = 0; k < 16; ++k) v[k] = -3.0e38f;
    const bf16_t* kb = KEYS + (size_t)((p * 2 + hf) * 128 + r) * 128 + 8 * hh;
#pragma unroll 1
    for (int nb = 0; nb < 4; ++nb) {
        f32x16 acc;
#pragma unroll
        for (int i = 0; i < 16; ++i) acc[i] = 0.f;
#pragma unroll
        for (int ks = 0; ks < 8; ++ks) { const bf16x8 kf = *(const bf16x8*)(kb + (size_t)(nb * 32) * 128 + ks * 16); acc = __builtin_amdgcn_mfma_f32_32x32x16_bf16(kf, qf[ks], acc, 0, 0, 0); }
#pragma unroll
        for (int i = 0; i < 16; ++i) { const unsigned xi = (unsigned)(nb * 32 + (i & 3) + 8 * (i >> 2) + 4 * hh); const float x = __uint_as_float((__float_as_uint(acc[i]) & ~0x7fu) | xi); INS16(v, x); }
    }
    float ov[16];
#pragma unroll
    for (int k = 0; k < 16; ++k) ov[k] = __shfl_xor(v[k], 32);
#pragma unroll
    for (int k = 0; k < 16; ++k) INS16(v, ov[k]);
}
__device__ __forceinline__ void phase_peer_topk(const Params& p) {
    const int tid = threadIdx.x, wave = tid >> 6, lane = tid & 63, r = lane & 31, hh = lane >> 5;
    const bf16_t* QP = (const bf16_t*)(p.ws + WS_QP); const bf16_t* KEYS = (const bf16_t*)(p.ws + WS_KEYS);
    int* EIDX = (int*)(p.ws + WS_EIDX); float* EGATE = (float*)(p.ws + WS_EGATE);
    const int gw = blockIdx.x * NWAVES + wave, NGW = gridDim.x * NWAVES;
    for (int it = gw; it < 512 * 8; it += NGW) {
        const int tg = it >> 3, hd = it & 7, tok = tg * 32 + r;
        float va[16], vb[16];
        peer_half_top16(QP, KEYS, tok, hd, 0, r, hh, va);
        peer_half_top16(QP, KEYS, tok, hd, 1, r, hh, vb);
        float bv[16];
#pragma unroll
        for (int k = 0; k < 16; ++k) bv[k] = -3.0e38f;
#pragma unroll
        for (int a = 0; a < 16; ++a)
#pragma unroll
            for (int b2 = 0; b2 < 16; ++b2) if ((a + 1) * (b2 + 1) <= 16) { const float x = va[a] + vb[b2]; INS16(bv, x); }
        float se = 0.f;
#pragma unroll
        for (int k = 0; k < 16; ++k) se += __expf(bv[k] - bv[0]);
        const float inv = 1.f / se, thr = bv[15], top = bv[0];
        int cnt = 0; int* ei = EIDX + (size_t)tok * 128 + hd * 16; float* eg = EGATE + (size_t)tok * 128 + hd * 16;
#pragma unroll
        for (int a = 0; a < 16; ++a)
#pragma unroll
            for (int b2 = 0; b2 < 16; ++b2) if ((a + 1) * (b2 + 1) <= 16) { const float x = va[a] + vb[b2];
                if (x >= thr && cnt < 16) { if (hh == 0) { ei[cnt] = (int)((__float_as_uint(va[a]) & 0x7fu) * 128u + (__float_as_uint(vb[b2]) & 0x7fu)); eg[cnt] = __expf(x - top) * inv; } ++cnt; } }
    }
}

typedef __bf16 bf16x2_t __attribute__((ext_vector_type(2)));
__device__ __forceinline__ float gelu_erf(float v) {
    const float av = fabsf(v), d = av * 0.2316418882f + 1.0f, t = __builtin_amdgcn_rcpf(d);
    float q = t * 0.5307027145f + (-0.7265760135f); q = q * t + 0.7107068705f; q = q * t + (-0.142248368f); q = q * t + 0.127414796f; q = q * t;
    const float e = __builtin_amdgcn_exp2f((v * v) * (-0.72134752044f));
    const float m = v * (q * e), r = v - m;
    return v < 0.f ? m : r;
}
__device__ __forceinline__ float dot2bf(unsigned a, unsigned b, float c) { return __builtin_amdgcn_fdot2_f32_bf16(__builtin_bit_cast(bf16x2_t, a), __builtin_bit_cast(bf16x2_t, b), c, false); }
__device__ __forceinline__ float dpp_f(float x, int ctrl_xor1_xor2_mirror) {
    const int v = __float_as_int(x);
    if (ctrl_xor1_xor2_mirror == 0) return __int_as_float(__builtin_amdgcn_update_dpp(0, v, 0xB1, 0xF, 0xF, true));
    if (ctrl_xor1_xor2_mirror == 1) return __int_as_float(__builtin_amdgcn_update_dpp(0, v, 0x4E, 0xF, 0xF, true));
    return __int_as_float(__builtin_amdgcn_update_dpp(0, v, 0x141, 0xF, 0xF, true));
}
__device__ __forceinline__ void phase_experts(const Params& p, unsigned char* lds) {
    const int tid = threadIdx.x, wave = __builtin_amdgcn_readfirstlane(tid >> 6), lane = tid & 63, rr = lane >> 3, cc = lane & 7; const bool odd = cc & 1;
    const bf16_t* H2 = (const bf16_t*)(p.ws + WS_H2); const unsigned char* U16 = p.ws + WS_U16; const unsigned char* V16 = p.ws + WS_V16;
    const int* EIDX = (const int*)(p.ws + WS_EIDX); const float* EGATE = (const float*)(p.ws + WS_EGATE);
    const float* mod = (const float*)(p.ws + WS_MOD); const float* fin = p.in[16]; float* out = p.out; const float* X1 = (const float*)(p.ws + WS_X1);
    unsigned* offs = (unsigned*)lds; float* gts = (float*)(lds + 32768); float* rstl = (float*)(lds + 65536);
    const unsigned xcc = (unsigned)__builtin_amdgcn_s_getreg((3 << 11) | 20) & 7u; const unsigned cc16 = cc * 16;
    for (int tile = blockIdx.x; tile < T / 64; tile += gridDim.x) {
        const int tok0 = tile * 64, b = tok0 >> 11;
        __syncthreads();
        for (int i = tid; i < 8192; i += NTHREADS) { const int tl = i >> 7, j = i & 127, g = j >> 3, r8 = j & 7;
            offs[(tl * 8 + r8) * 16 + g] = (unsigned)EIDX[(size_t)tok0 * 128 + i] * 128u; gts[(tl * 8 + r8) * 16 + g] = EGATE[(size_t)tok0 * 128 + i]; }
        __syncthreads();
#pragma unroll 1
        for (int half = 0; half < 2; ++half) {
            const int tlb = wave * 8 + half * 4;
            u32x4 dA[16], dB[16], hA, hB;
#define EX_SLICE(i_) ((xcc * 4u + (unsigned)(i_)) & 31u)
#define EX_LOAD(buf, TBL, i_, k_) do { const unsigned char* tb_ = (TBL) + (size_t)EX_SLICE(i_) * (2u << 20); u32x4 o4_[4]; \
    _Pragma("unroll") for (int q_ = 0; q_ < 4; ++q_) o4_[q_] = *(const u32x4*)(offs + ((tlb + (k_)) * 8 + rr) * 16 + 4 * q_); \
    _Pragma("unroll") for (int g_ = 0; g_ < 16; ++g_) buf[g_] = *(const u32x4*)(tb_ + (o4_[g_ >> 2][g_ & 3] + cc16)); } while (0)
#define EX_LOADH(hreg, i_, k_) hreg = *(const u32x4*)(H2 + (size_t)(tok0 + tlb + (k_)) * D + EX_SLICE(i_) * 64 + cc * 8)
#define EX_UCOMP(buf, hreg, k_) do { _Pragma("unroll") for (int j_ = 0; j_ < 8; ++j_) { float te_ = 0.f, to_ = 0.f; \
    te_ = dot2bf(buf[2 * j_].x, hreg.x, te_); te_ = dot2bf(buf[2 * j_].y, hreg.y, te_); te_ = dot2bf(buf[2 * j_].z, hreg.z, te_); te_ = dot2bf(buf[2 * j_].w, hreg.w, te_); \
    to_ = dot2bf(buf[2 * j_ + 1].x, hreg.x, to_); to_ = dot2bf(buf[2 * j_ + 1].y, hreg.y, to_); to_ = dot2bf(buf[2 * j_ + 1].z, hreg.z, to_); to_ = dot2bf(buf[2 * j_ + 1].w, hreg.w, to_); \
    const float my_ = odd ? to_ : te_, ot_ = odd ? te_ : to_; zp[k_][j_] += my_ + dpp_f(ot_, 0); asm volatile("" : "+v"(zp[k_][j_])); } } while (0)
#define SB() __builtin_amdgcn_sched_barrier(0)
            float zp[4][8];
#pragma unroll
            for (int k = 0; k < 4; ++k)
#pragma unroll
                for (int j = 0; j < 8; ++j) zp[k][j] = 0.f;
            EX_LOADH(hA, 0, 0); EX_LOAD(dA, U16, 0, 0); SB();
#pragma unroll 1
            for (int i = 0; i < 32; ++i) {
                __builtin_amdgcn_s_barrier();
                EX_LOADH(hB, i, 1); EX_LOAD(dB, U16, i, 1); SB(); EX_UCOMP(dA, hA, 0); SB();
                EX_LOADH(hA, i, 2); EX_LOAD(dA, U16, i, 2); SB(); EX_UCOMP(dB, hB, 1); SB();
                EX_LOADH(hB, i, 3); EX_LOAD(dB, U16, i, 3); SB(); EX_UCOMP(dA, hA, 2); SB();
                if (i < 31) { EX_LOADH(hA, i + 1, 0); EX_LOAD(dA, U16, i + 1, 0); } SB(); EX_UCOMP(dB, hB, 3); SB();
            }
            unsigned ap[4][8];
#pragma unroll
            for (int k = 0; k < 4; ++k)
#pragma unroll
                for (int j = 0; j < 8; ++j) { float z = zp[k][j]; z += dpp_f(z, 1); z += __shfl_xor(z, 4);
                    const float act = gelu_erf(z) * gts[((tlb + k) * 8 + rr) * 16 + 2 * j + (odd ? 1 : 0)]; const float oth = dpp_f(act, 0);
                    ap[k][j] = f2bf(odd ? oth : act) | (f2bf(odd ? act : oth) << 16); }
            float ssq[4] = {0.f, 0.f, 0.f, 0.f};
#define EX_VCOMP(buf, i_, k_) do { float oa_[8] = {0.f, 0.f, 0.f, 0.f, 0.f, 0.f, 0.f, 0.f}; \
    _Pragma("unroll") for (int j_ = 0; j_ < 8; ++j_) { unsigned pr_ = ap[k_][j_]; asm volatile("" : "+v"(pr_)); unsigned alo_ = pr_ & 0xffffu, ahi_ = pr_ << 16; \
        oa_[0] = dot2bf(buf[2 * j_].x, alo_, oa_[0]); oa_[1] = dot2bf(buf[2 * j_].x, ahi_, oa_[1]); oa_[2] = dot2bf(buf[2 * j_].y, alo_, oa_[2]); oa_[3] = dot2bf(buf[2 * j_].y, ahi_, oa_[3]); \
        oa_[4] = dot2bf(buf[2 * j_].z, alo_, oa_[4]); oa_[5] = dot2bf(buf[2 * j_].z, ahi_, oa_[5]); oa_[6] = dot2bf(buf[2 * j_].w, alo_, oa_[6]); oa_[7] = dot2bf(buf[2 * j_].w, ahi_, oa_[7]); \
        alo_ = pr_ >> 16; ahi_ = pr_ & 0xffff0000u; \
        oa_[0] = dot2bf(buf[2 * j_ + 1].x, alo_, oa_[0]); oa_[1] = dot2bf(buf[2 * j_ + 1].x, ahi_, oa_[1]); oa_[2] = dot2bf(buf[2 * j_ + 1].y, alo_, oa_[2]); oa_[3] = dot2bf(buf[2 * j_ + 1].y, ahi_, oa_[3]); \
        oa_[4] = dot2bf(buf[2 * j_ + 1].z, alo_, oa_[4]); oa_[5] = dot2bf(buf[2 * j_ + 1].z, ahi_, oa_[5]); oa_[6] = dot2bf(buf[2 * j_ + 1].w, alo_, oa_[6]); oa_[7] = dot2bf(buf[2 * j_ + 1].w, ahi_, oa_[7]); } \
      \
    float b4_[4], b2_[2], b1_; \
    _Pragma("unroll") for (int e_ = 0; e_ < 4; ++e_) { const bool up_ = lane & 32; const float kp_ = up_ ? oa_[e_ + 4] : oa_[e_], sd_ = up_ ? oa_[e_] : oa_[e_ + 4]; b4_[e_] = kp_ + __shfl_xor(sd_, 32); } \
    _Pragma("unroll") for (int e_ = 0; e_ < 2; ++e_) { const bool up_ = lane & 16; const float kp_ = up_ ? b4_[e_ + 2] : b4_[e_], sd_ = up_ ? b4_[e_] : b4_[e_ + 2]; b2_[e_] = kp_ + __shfl_xor(sd_, 16); } \
    { const bool up_ = lane & 8; const float kp_ = up_ ? b2_[1] : b2_[0], sd_ = up_ ? b2_[0] : b2_[1]; b1_ = kp_ + __shfl_xor(sd_, 8); } \
    const int col_ = (int)EX_SLICE(i_) * 64 + cc * 8 + rr; const size_t xo_ = (size_t)(tok0 + tlb + (k_)) * D + col_; \
    const float y_ = X1[xo_] + mod[(size_t)b * NADA + 5 * 2048 + col_] * b1_; out[xo_] = y_; ssq[k_] = fmaf(y_, y_, ssq[k_]); asm volatile("" : "+v"(ssq[k_])); } while (0)
            EX_LOAD(dA, V16, 0, 0); SB();
#pragma unroll 1
            for (int i = 0; i < 32; ++i) {
                __builtin_amdgcn_s_barrier();
                EX_LOAD(dB, V16, i, 1); SB(); EX_VCOMP(dA, i, 0); SB();
                EX_LOAD(dA, V16, i, 2); SB(); EX_VCOMP(dB, i, 1); SB();
                EX_LOAD(dB, V16, i, 3); SB(); EX_VCOMP(dA, i, 2); SB();
                if (i < 31) { EX_LOAD(dA, V16, i + 1, 0); } SB(); EX_VCOMP(dB, i, 3); SB();
            }
#pragma unroll
            for (int k = 0; k < 4; ++k) { const float tot = wave_sum(ssq[k]); rstl[wave * 8 + half * 4 + k] = rsqrtf(tot * (1.f / D) + NORM_EPS); }
        }
#undef EX_SLICE
#undef EX_LOAD
#undef EX_LOADH
#undef EX_UCOMP
#undef EX_VCOMP
#undef SB
        __builtin_amdgcn_fence(__ATOMIC_RELEASE, "agent"); __builtin_amdgcn_fence(__ATOMIC_ACQUIRE, "agent");
        LDS_WAIT();
        int lane2 = (int)__builtin_amdgcn_mbcnt_hi(~0u, __builtin_amdgcn_mbcnt_lo(~0u, 0u)); asm volatile("" : "+v"(lane2));
#pragma unroll 1
        for (int k = 0; k < 8; ++k) { float* xr = out + (size_t)(tok0 + wave * 8 + k) * D; const float rs = rstl[wave * 8 + k];
#pragma unroll
            for (int j = 0; j < 8; ++j) { const int col = 4 * (lane2 + 64 * j); const f32x4 v = *(const f32x4*)(xr + col), f = *(const f32x4*)(fin + col);
                f32x4 o; o[0] = v[0] * rs * f[0]; o[1] = v[1] * rs * f[1]; o[2] = v[2] * rs * f[2]; o[3] = v[3] * rs * f[3]; *(f32x4*)(xr + col) = o; } }
    }
}

#define XB_TMO      128
#define XB_XCNT(j)  (256  + 64 * (j))
#define XB_XSUB(j)  (1280 + 64 * (j))
#define XB_XGEN(j)  (2304 + 64 * (j))
#define XB_TOP      3328
#define XB_TOPGEN   3392
#define XCD_BAR_WORDS 3456
#define XB_SPIN_CAP (1u << 22)
__device__ __forceinline__ unsigned xb_ld(unsigned* p)              { return __hip_atomic_load(p, __ATOMIC_RELAXED, __HIP_MEMORY_SCOPE_AGENT); }
__device__ __forceinline__ unsigned xb_add(unsigned* p, unsigned v) { return __hip_atomic_fetch_add(p, v, __ATOMIC_RELAXED, __HIP_MEMORY_SCOPE_AGENT); }
__device__ __forceinline__ unsigned xb_xcc_id() { return (unsigned)__builtin_amdgcn_s_getreg((3 << 11) | 20) & 0xFu; }
#define XB_SPIN(cond, bar) do { unsigned _sp = 0; while (cond) { __builtin_amdgcn_s_sleep(1); \
    if ((++_sp & 255u) == 0u) { if (xb_ld(&(bar)[XB_TMO])) break; if (_sp > XB_SPIN_CAP) { atomicAdd(&(bar)[XB_TMO], 1u); break; } } } } while (0)
struct XcdBarrier { unsigned* bar; unsigned x; volatile LAS unsigned* st; };
__device__ __forceinline__ XcdBarrier xcd_barrier_post(unsigned* bar, volatile LAS unsigned* st) {
    XcdBarrier b; b.bar = bar; b.x = xb_xcc_id(); b.st = st;
    if (threadIdx.x == 0) (void)xb_add(&bar[XB_XCNT(b.x)], 1u);
    return b;
}
__device__ __forceinline__ void xcd_barrier_complete(unsigned* bar, unsigned x, unsigned& nloc, unsigned& nx) {
    const unsigned G = gridDim.x * gridDim.y * gridDim.z;
    unsigned sum, cnt, mine, sp = 0u;
    for (;;) {
        sum = 0u; cnt = 0u; mine = 0u;
#pragma unroll
        for (unsigned j = 0; j < 16; ++j) { const unsigned c = xb_ld(&bar[XB_XCNT(j)]); sum += c; cnt += (c > 0u) ? 1u : 0u; mine = (j == x) ? c : mine; }
        if (sum == G) break;
        __builtin_amdgcn_s_sleep(1);
        if ((++sp & 255u) == 0u) { if (xb_ld(&bar[XB_TMO])) break; if (sp > XB_SPIN_CAP) { atomicAdd(&bar[XB_TMO], 1u); break; } }
    }
    nloc = mine > 0u ? mine : 1u; nx = cnt > 0u ? cnt : 1u;
}
__device__ __forceinline__ void xcd_barrier(const XcdBarrier& b) {
    asm volatile("s_waitcnt vmcnt(0)" ::: "memory");
    __syncthreads();
    if (threadIdx.x == 0) {
        unsigned* bar = b.bar;
        __builtin_amdgcn_s_waitcnt(0);
        unsigned nloc = b.st[0], nx = b.st[1];
        if (nloc == 0u) { xcd_barrier_complete(bar, b.x, nloc, nx); b.st[0] = nloc; b.st[1] = nx; }
        const unsigned old = xb_add(&bar[XB_XSUB(b.x)], 1u);
        const unsigned gen = old / nloc;
        if (old + 1u == (gen + 1u) * nloc) {
            __builtin_amdgcn_fence(__ATOMIC_RELEASE, "agent");
            asm volatile("s_waitcnt vmcnt(0)" ::: "memory");
            const unsigned og = xb_add(&bar[XB_TOP], 1u);
            const unsigned tg = og / nx;
            if (og + 1u == (tg + 1u) * nx) xb_add(&bar[XB_TOPGEN], 1u);
            else XB_SPIN(xb_ld(&bar[XB_TOPGEN]) == tg, bar);
            __builtin_amdgcn_fence(__ATOMIC_ACQUIRE, "agent");
            xb_add(&bar[XB_XGEN(b.x)], 1u);
            asm volatile("s_waitcnt vmcnt(0)" ::: "memory");
        } else {
            XB_SPIN(xb_ld(&bar[XB_XGEN(b.x)]) == gen, bar);
            __builtin_amdgcn_fence(__ATOMIC_ACQUIRE, "agent");
            asm volatile("s_waitcnt vmcnt(0)" ::: "memory");
        }
    }
    __syncthreads();
}

constexpr int NPHASES = 11;
__global__ void __launch_bounds__(NTHREADS, 2) mega_fwd(Params p) {
    extern __shared__ __attribute__((aligned(16))) unsigned char lds[];
    cg::grid_group grid = cg::this_grid();
    const int lo = p.ph_lo, hi = p.ph_hi;
#ifndef PHASE_MASK
#define PHASE_MASK 0x7ff
#endif
#define IN(k) (((PHASE_MASK >> (k)) & 1) && lo <= (k) && (k) < hi)
#define SEAM(k) do { if (IN(k) && IN((k) + 1)) { if ((k) == 0) grid.sync(); else xcd_barrier(xbar); } } while (0)
    unsigned char* ws = p.ws;
    bf16_t* P = (bf16_t*)(ws + WS_P);
    bf16_t* Hb = (bf16_t*)((unsigned char*)p.out + OUT_H);
    bf16_t* WinT = (bf16_t*)((unsigned char*)p.out + OUT_WIN);
    const float* mod = (const float*)(ws + WS_MOD);
    LAS unsigned char* ldsl = (LAS unsigned char*)lds;
    volatile LAS unsigned* xst = (volatile LAS unsigned*)(ldsl + LDS_BYTES - 64);
    if (threadIdx.x < 2) xst[threadIdx.x] = 0u;
    __syncthreads();
    XcdBarrier xbar = xcd_barrier_post((unsigned*)(ws + WS_CTL) + 4096, xst);

#ifndef REPEAT_PHASE
#define REPEAT_PHASE -1
#endif
#define RUNPH(k, ...) do { if (IN(k)) { __VA_ARGS__; if (REPEAT_PHASE == (k)) { grid.sync(); __VA_ARGS__; } } } while (0)
    RUNPH(0, { phase_mod(p, lds); __syncthreads(); phase_weights(p, lds); });
    SEAM(0);
    RUNPH(1, { phase_norm_rows(p.in[0], p.in[4], mod, mod + 2048, Hb); });
    SEAM(1);
    RUNPH(2, { pg8::Gemm g{Hb, WinT, nullptr, nullptr, D, D, T, NP, D}; pg8::StaticOrder<1> S; S.init(T, NP, gridDim.x, blockIdx.x);
        pg8::EpiBf16 E{P, NP, 33}; pg8::gemm_phase(ldsl, g, S, E); });
    SEAM(2);
    RUNPH(3, { const int G = gridDim.x, bx = blockIdx.x;
        if (G >= 128) { if (bx < 64) { phase_hgrn(p, lds, bx, 64); if (REPEAT_PHASE == 32) phase_hgrn(p, lds, bx, 64); }
                        else { phase_vt(p, lds, bx - 64, G - 64); phase_indexer(p, bx - 64, G - 64); if (REPEAT_PHASE == 31) phase_indexer(p, bx - 64, G - 64); } }
        else { phase_vt(p, lds, bx, G); phase_indexer(p, bx, G); __syncthreads(); phase_hgrn(p, lds, bx, G); } });
    SEAM(3);
    RUNPH(4, { phase_attn(p); });
    SEAM(4);
    RUNPH(5, { pg8::Gemm g{(const bf16_t*)((unsigned char*)p.out + OUT_AO), (const bf16_t*)(ws + WS_WUA), (const bf16_t*)((unsigned char*)p.out + OUT_REC), (const bf16_t*)(ws + WS_WUB), 1024, 1024, T, D, 1024}; pg8::StaticOrder<2> S; S.init(T, D, gridDim.x, blockIdx.x);
        pg8::EpiMix E{(bf16_t*)(ws + WS_MIXED), P}; pg8::gemm_phase(ldsl, g, S, E); });
    SEAM(5);
    RUNPH(6, { pg8::Gemm g{(const bf16_t*)(ws + WS_MIXED), (const bf16_t*)(ws + WS_WOUT), nullptr, nullptr, D, D, T, D, D}; pg8::StaticOrder<1> S; S.init(T, D, gridDim.x, blockIdx.x);
        pg8::EpiX1 E{p.in[0], (float*)(ws + WS_X1), mod + 4096}; pg8::gemm_phase(ldsl, g, S, E); });
    SEAM(6);
    RUNPH(7, { phase_norm_rows((const float*)(ws + WS_X1), p.in[5], mod + 3 * 2048, mod + 4 * 2048, (bf16_t*)(ws + WS_H2)); phase_uv(p); });
    SEAM(7);
    RUNPH(8, { pg8::Gemm g{(const bf16_t*)(ws + WS_H2), (const bf16_t*)(ws + WS_WQ), nullptr, nullptr, D, D, T, D, D}; pg8::StaticOrder<1> S; S.init(T, D, gridDim.x, blockIdx.x);
        pg8::EpiBf16 E{(bf16_t*)(ws + WS_QP), D, 1 << 30}; pg8::gemm_phase(ldsl, g, S, E); });
    SEAM(8);
    RUNPH(9, { phase_peer_topk(p); });
    SEAM(9);
    RUNPH(10, { phase_experts(p, lds); });
#undef IN
#undef SEAM
}

#ifndef MK_N_LAUNCHES
#define MK_N_LAUNCHES 1
#endif
extern "C" void kernel_launch(void* const* d_in, const int* in_sizes, int n_in, void* d_out, int out_size, void* d_ws, size_t ws_size, hipStream_t stream) {
    static int grid = 0;
    if (grid == 0) {
        if (n_in != 17 || out_size != T * D || ws_size < WS_END) { fprintf(stderr, "kernel_launch: unexpected shapes (n_in %d out %d ws %zu)\n", n_in, out_size, ws_size); grid = -1; return; }
        int dev = 0, cus = 0, per_cu = 0;
        hipGetDevice(&dev); hipDeviceGetAttribute(&cus, hipDeviceAttributeMultiprocessorCount, dev);
        hipFuncSetAttribute((const void*)mega_fwd, hipFuncAttributeMaxDynamicSharedMemorySize, LDS_BYTES);
        hipOccupancyMaxActiveBlocksPerMultiprocessor(&per_cu, (const void*)mega_fwd, NTHREADS, LDS_BYTES);
        if (per_cu < 1) { fprintf(stderr, "kernel_launch: occupancy query says %d blocks/CU\n", per_cu); per_cu = 1; }
        (void)hipGetLastError();
        grid = cus * 1;
    }
    if (grid < 0) return;
    if (hipMemsetAsync((char*)d_ws + WS_CTL, 0, 65536, stream) != hipSuccess) { fprintf(stderr, "kernel_launch: memset failed\n"); return; }
    Params p{};
    for (int i = 0; i < 17; ++i) p.in[i] = (const float*)d_in[i];
    p.out = (float*)d_out; p.ws = (unsigned char*)d_ws;
#if MK_N_LAUNCHES == 1
    p.ph_lo = 0; p.ph_hi = NPHASES;
    void* args[] = {&p};
    hipError_t e = hipLaunchCooperativeKernel((const void*)mega_fwd, dim3(grid), dim3(NTHREADS), args, LDS_BYTES, stream);
    if (e != hipSuccess) fprintf(stderr, "cooperative launch failed: %s (grid %d)\n", hipGetErrorString(e), grid);
#else
    for (int k = 0; k < NPHASES; ++k) { p.ph_lo = k; p.ph_hi = k + 1; void* args[] = {&p};
        hipError_t e = hipLaunchCooperativeKernel((const void*)mega_fwd, dim3(grid), dim3(NTHREADS), args, LDS_BYTES, stream);
        if (e != hipSuccess) { fprintf(stderr, "launch %d failed: %s\n", k, hipGetErrorString(e)); break; } }
#endif
}
```

```cpp
#include <hip/hip_runtime.h>
#include <hip/hip_cooperative_groups.h>
#include <cstdio>
#include <cstdint>
namespace cg = cooperative_groups;

#define LAS __attribute__((address_space(3)))
typedef unsigned short bf16_t;
typedef short bf16x8 __attribute__((ext_vector_type(8)));
typedef short bf16x4 __attribute__((ext_vector_type(4)));
typedef float f32x2 __attribute__((ext_vector_type(2)));
typedef float f32x4 __attribute__((ext_vector_type(4)));
typedef float f32x16 __attribute__((ext_vector_type(16)));
typedef unsigned u32x2 __attribute__((ext_vector_type(2)));
typedef unsigned u32x4 __attribute__((ext_vector_type(4)));

constexpr int T = 16384, D = 2048, SEQ = 2048, NBATCH = 8, NP = 12544;
constexpr int C_QA = 0, C_KA = 1024, C_VA = 2048, C_QI = 3072, C_KI = 4096, C_WI = 4160, C_QB = 4352, C_FB = 5376, C_IB = 6400, C_GB = 7424, C_GA = 8448, C_GG = 10496;
constexpr int NADA = 12288;
constexpr float NORM_EPS = 1e-6f;
constexpr int NTHREADS = 512, NWAVES = 8;
constexpr int LDS_BYTES = 147456;
constexpr size_t MiB = 1u << 20;
constexpr size_t WS_CTL = 0, WS_MOD = 1 * MiB, WS_WUA = 2 * MiB, WS_WUB = 6 * MiB, WS_WOUT = 10 * MiB, WS_WQ = 18 * MiB, WS_KEYS = 26 * MiB, WS_MASK = 27 * MiB;
constexpr size_t WS_MIXED = 32 * MiB;
constexpr size_t WS_VT = 32 * MiB, WS_ORAW = 64 * MiB;
constexpr size_t WS_P = 96 * MiB;
constexpr size_t WS_H2 = 96 * MiB, WS_QP = 160 * MiB, WS_U8 = 224 * MiB, WS_V8 = 256 * MiB, WS_ISU = 290 * MiB, WS_ISV = 291 * MiB, WS_EIDX = 352 * MiB, WS_EGATE = 360 * MiB;
constexpr size_t WS_X1 = 368 * MiB;
constexpr size_t WS_END = 496 * MiB;
constexpr size_t OUT_H = 0, OUT_WIN = 64 * MiB;
constexpr size_t OUT_AO = 0, OUT_REC = 32 * MiB;

struct Params { const float* in[17]; float* out; unsigned char* ws; int ph_lo, ph_hi; };

__device__ __forceinline__ unsigned f2bf(float f) { unsigned u = __float_as_uint(f); return (u + 0x7fffu + ((u >> 16) & 1u)) >> 16; }
__device__ __forceinline__ float bf2f(unsigned b) { return __uint_as_float(b << 16); }
__device__ __forceinline__ float bflo(unsigned w) { return __uint_as_float(w << 16); }
__device__ __forceinline__ float bfhi(unsigned w) { return __uint_as_float(w & 0xffff0000u); }
__device__ __forceinline__ unsigned pk2(float lo, float hi) { unsigned r; asm volatile("v_cvt_pk_bf16_f32 %0, %1, %2" : "=v"(r) : "v"(lo), "v"(hi)); return r; }
__device__ __forceinline__ float wave_sum(float v) {
#pragma unroll
    for (int o = 1; o < 64; o <<= 1) v += __shfl_xor(v, o);
    return v;
}
__device__ __forceinline__ float sigmoidf_(float v) { return 1.f / (1.f + __expf(-v)); }
__device__ __forceinline__ float siluf_(float v) { return v / (1.f + __expf(-v)); }
#define LDS_WAIT() asm volatile("s_waitcnt lgkmcnt(0)" ::: "memory")

namespace pg8 {
constexpr int BM = 256, BK = 64, HALF = 128, HTB = HALF * BK * 2, STAGE_BYTES = 8 * HTB, NXCD = 8, WGM = 8;
__host__ __device__ __forceinline__ int lds_byte(int r, int c) { const int st = (r >> 4) * 2 + (c >> 5), rr = r & 15, cc = c & 31, ob = rr * 64 + cc * 2; return st * 1024 + (ob ^ (((ob >> 9) & 1) << 5)); }
__host__ __device__ __forceinline__ void stage_rc(int b, int& R, int& C) { const int st = b / 1024, sb = b % 1024, swz = sb ^ (((sb >> 9) & 1) << 5); R = (st >> 1) * 16 + swz / 64; C = (st & 1) * 32 + (swz % 64) / 2; }
__host__ __device__ __forceinline__ int perm32(int rho) { const int n = rho >> 4, i = rho & 15; return 8 * (i >> 2) + 4 * n + (i & 3); }

struct Unit { int pm, pn, z; };
struct Gemm { const bf16_t* A; const bf16_t* Bt; const bf16_t* A2; const bf16_t* Bt2; int lda, ldb, M, N, K; };

template <int NZ> struct StaticOrder {
    int nM, nN, nwg, G, c;
    __device__ void init(int M, int N, int G_, int c_) { nM = M / BM; nN = N / BM; nwg = nM * nN; G = G_; c = c_; }
    __device__ bool next(int i, Unit& u) const {
        const long L = (long)(i / NZ) * G + c; if (L >= nwg) return false;
        int wgid = (int)L; { const int q = nwg / NXCD, r = nwg % NXCD, xcd = wgid % NXCD, off = wgid / NXCD; wgid = (xcd < r ? xcd * (q + 1) : r * (q + 1) + (xcd - r) * q) + off; }
        const int nig = WGM * nN, gid = wgid / nig, fm = gid * WGM, gsz = (nM - fm) < WGM ? (nM - fm) : WGM;
        u.pm = fm + ((wgid % nig) % gsz); u.pn = (wgid % nig) / gsz; u.z = i % NZ; return true;
    }
};

template <class Epi, class Sched>
__device__ __forceinline__ void gemm_phase(LAS unsigned char* lds, const Gemm g, const Sched& S, const Epi& E) {
    const int tid = threadIdx.x, wid = __builtin_amdgcn_readfirstlane(tid >> 6), lane = tid & 63, wr = wid >> 2, wc = wid & 3, fr = lane & 15, fq = lane >> 4;
    const int K = g.K, nt = K / BK;
    unsigned voffA[2], voffB[2];
#pragma unroll
    for (int i = 0; i < 2; ++i) { int R, C; stage_rc(tid * 16 + i * 8192, R, C); const int Rb = Epi::PERM ? ((R & ~31) + perm32(R & 31)) : R;
        voffA[i] = (unsigned)(R * g.lda + C) * 2u; voffB[i] = (unsigned)(Rb * g.ldb + C) * 2u; }
    const size_t kstep = (size_t)(BK * 2);
    const size_t hstepA = (size_t)HALF * g.lda * 2, hstepB = (size_t)HALF * g.ldb * 2;
    const size_t tstepA = 2 * hstepA, tstepB = 2 * hstepB;
    const unsigned ldsw = (unsigned)wid * 1024u;
    const int aoff = lds_byte(wr * 64 + fr, fq * 8), boff = lds_byte(wc * 32 + fr, fq * 8);
#define PG8_SA(b, h) (((b) * 2 + (h)) * HTB)
#define PG8_SB(b, h) ((4 + (b) * 2 + (h)) * HTB)
#define PG8_STAGE(bufoff, gbase, voff) do { _Pragma("unroll") for (int _i = 0; _i < 2; ++_i) \
        __builtin_amdgcn_global_load_lds((const unsigned*)((const char*)(gbase) + (voff)[_i]), (LAS unsigned*)(lds + (bufoff) + ldsw + _i * 8192), 16, 0, 0); } while (0)
#define PG8_LDA(dst, b, h) do { _Pragma("unroll") for (int m = 0; m < 4; ++m) _Pragma("unroll") for (int k = 0; k < 2; ++k) dst[m][k] = *(const LAS bf16x8*)(lds + PG8_SA(b, h) + aoff + m * 2048 + k * 1024); } while (0)
#define PG8_LDB(dst, b, h) do { _Pragma("unroll") for (int n = 0; n < 2; ++n) _Pragma("unroll") for (int k = 0; k < 2; ++k) dst[n][k] = *(const LAS bf16x8*)(lds + PG8_SB(b, h) + boff + n * 2048 + k * 1024); } while (0)
#define PG8_MMA(ai, bj, At, Bt) do { __builtin_amdgcn_s_setprio(1); _Pragma("unroll") for (int m = 0; m < 4; ++m) _Pragma("unroll") for (int n = 0; n < 2; ++n) _Pragma("unroll") for (int k = 0; k < 2; ++k) \
        acc[ai][bj][m][n] = __builtin_amdgcn_mfma_f32_16x16x32_bf16(Bt[n][k], At[m][k], acc[ai][bj][m][n], 0, 0, 0); __builtin_amdgcn_s_setprio(0); } while (0)
#define PG8_WAIT_V(n) asm volatile("s_waitcnt vmcnt(" #n ")" ::: "memory")
#define PG8_WAIT_L(n) asm volatile("s_waitcnt lgkmcnt(" #n ")" ::: "memory")
#define PG8_BAR __builtin_amdgcn_s_barrier()
#define PG8_SCHED __builtin_amdgcn_sched_barrier(0)
#define PG8_ABASE(u) ((const char*)((u).z ? g.A2 : g.A) + (size_t)(u).pm * tstepA)
#define PG8_BBASE(u) ((const char*)((u).z ? g.Bt2 : g.Bt) + (size_t)(u).pn * tstepB)
    Unit cur, nxt; int ui = 0;
    if (!S.next(0, cur)) return;
    f32x4 acc[2][2][4][2];
#pragma unroll
    for (int a = 0; a < 2; ++a)
#pragma unroll
        for (int b = 0; b < 2; ++b)
#pragma unroll
            for (int m = 0; m < 4; ++m)
#pragma unroll
                for (int n = 0; n < 2; ++n) acc[a][b][m][n] = (f32x4){0.f, 0.f, 0.f, 0.f};
    bf16x8 At[4][2], B0[2][2], B1[2][2];
    const char* cA = PG8_ABASE(cur); const char* cB = PG8_BBASE(cur);
    PG8_STAGE(PG8_SB(0, 0), cB, voffB); PG8_STAGE(PG8_SA(0, 0), cA, voffA); PG8_STAGE(PG8_SB(0, 1), cB + hstepB, voffB); PG8_STAGE(PG8_SA(0, 1), cA + hstepA, voffA);
    if (wr == 1) PG8_BAR;
    PG8_WAIT_V(4); PG8_BAR;
    PG8_STAGE(PG8_SB(1, 0), cB + kstep, voffB); PG8_STAGE(PG8_SA(1, 0), cA + kstep, voffA); PG8_STAGE(PG8_SB(1, 1), cB + hstepB + kstep, voffB);
    PG8_WAIT_V(6); PG8_BAR;
    for (;;) {
        const bool has_next = S.next(ui + 1, nxt);
        const char* nA = has_next ? PG8_ABASE(nxt) : cA; const char* nB = has_next ? PG8_BBASE(nxt) : cB;
        for (int t = 0; t < nt; t += 2) {
            const bool last = (t == nt - 2);
            const char* a1 = cA + (size_t)(t + 1) * kstep;
            const char* a2 = last ? nA : cA + (size_t)(t + 2) * kstep; const char* b2 = last ? nB : cB + (size_t)(t + 2) * kstep;
            const char* a3 = a2 + kstep; const char* b3 = b2 + kstep;
            PG8_LDB(B0, 0, 0); PG8_SCHED; PG8_LDA(At, 0, 0); PG8_STAGE(PG8_SA(1, 1), a1 + hstepA, voffA);
            PG8_WAIT_L(8); PG8_BAR; PG8_WAIT_L(0); PG8_MMA(0, 0, At, B0); PG8_BAR; PG8_SCHED;
            PG8_LDB(B1, 0, 1); PG8_STAGE(PG8_SB(0, 0), b2, voffB);
            PG8_BAR; PG8_WAIT_L(0); PG8_MMA(0, 1, At, B1); PG8_BAR;
            PG8_LDA(At, 0, 1); PG8_STAGE(PG8_SA(0, 0), a2, voffA);
            PG8_BAR; PG8_WAIT_L(0); PG8_MMA(1, 0, At, B0); PG8_BAR; PG8_SCHED;
            PG8_STAGE(PG8_SB(0, 1), b2 + hstepB, voffB);
            PG8_WAIT_V(6); PG8_BAR; PG8_MMA(1, 1, At, B1); PG8_BAR;
            PG8_LDB(B0, 1, 0); PG8_SCHED; PG8_LDA(At, 1, 0); PG8_STAGE(PG8_SA(0, 1), a2 + hstepA, voffA);
            PG8_WAIT_L(8); PG8_BAR; PG8_WAIT_L(0); PG8_MMA(0, 0, At, B0); PG8_BAR; PG8_SCHED;
            PG8_LDB(B1, 1, 1); PG8_STAGE(PG8_SB(1, 0), b3, voffB);
            PG8_BAR; PG8_WAIT_L(0); PG8_MMA(0, 1, At, B1); PG8_BAR;
            PG8_LDA(At, 1, 1); PG8_STAGE(PG8_SA(1, 0), a3, voffA);
            PG8_BAR; PG8_WAIT_L(0); PG8_MMA(1, 0, At, B0); PG8_BAR; PG8_SCHED;
            PG8_STAGE(PG8_SB(1, 1), b3 + hstepB, voffB);
            PG8_WAIT_V(6); PG8_BAR; PG8_MMA(1, 1, At, B1); PG8_BAR;
        }
        E(acc, cur, wr, wc, fr, fq);
        if (!has_next) break;
#pragma unroll
        for (int a = 0; a < 2; ++a)
#pragma unroll
            for (int b = 0; b < 2; ++b)
#pragma unroll
                for (int m = 0; m < 4; ++m)
#pragma unroll
                    for (int n = 0; n < 2; ++n) acc[a][b][m][n] = (f32x4){0.f, 0.f, 0.f, 0.f};
        cur = nxt; cA = nA; cB = nB; ++ui;
    }
    PG8_WAIT_V(0);
    if (wr == 0) PG8_BAR;
    PG8_BAR;
#undef PG8_SA
#undef PG8_SB
#undef PG8_STAGE
#undef PG8_LDA
#undef PG8_LDB
#undef PG8_MMA
#undef PG8_WAIT_V
#undef PG8_WAIT_L
#undef PG8_BAR
#undef PG8_SCHED
#undef PG8_ABASE
#undef PG8_BBASE
}

struct EpiBf16 {
    static constexpr bool PERM = true;
    bf16_t* O; int ldc; int sig_from;
    __device__ __forceinline__ void operator()(const f32x4 (&acc)[2][2][4][2], const Unit& u, int wr, int wc, int fr, int fq) const {
        const int row0 = u.pm * BM + wr * 64 + fr, col0 = u.pn * BM + wc * 32 + 8 * fq; const bool sig = u.pn >= sig_from;
#pragma unroll
        for (int ai = 0; ai < 2; ++ai)
#pragma unroll
            for (int m = 0; m < 4; ++m) { bf16_t* rowp = O + (size_t)(row0 + ai * HALF + m * 16) * ldc + col0;
#pragma unroll
                for (int bj = 0; bj < 2; ++bj) { f32x4 v0 = acc[ai][bj][m][0], v1 = acc[ai][bj][m][1];
                    if (sig) {
#pragma unroll
                        for (int j = 0; j < 4; ++j) { v0[j] = sigmoidf_(v0[j]); v1[j] = sigmoidf_(v1[j]); } }
                    u32x4 w; w.x = pk2(v0[0], v0[1]); w.y = pk2(v0[2], v0[3]); w.z = pk2(v1[0], v1[1]); w.w = pk2(v1[2], v1[3]);
                    *(u32x4*)(rowp + bj * HALF) = w; } }
    }
};
struct EpiMix {
    static constexpr bool PERM = true;
    bf16_t* O; const bf16_t* P;
    __device__ __forceinline__ void operator()(const f32x4 (&acc)[2][2][4][2], const Unit& u, int wr, int wc, int fr, int fq) const {
        const int row0 = u.pm * BM + wr * 64 + fr, col0 = u.pn * BM + wc * 32 + 8 * fq; const int gcol = (u.z ? C_GG : C_GA);
#pragma unroll
        for (int ai = 0; ai < 2; ++ai)
#pragma unroll
            for (int m = 0; m < 4; ++m) { const size_t r = (size_t)(row0 + ai * HALF + m * 16);
#pragma unroll
                for (int bj = 0; bj < 2; ++bj) { const f32x4 v0 = acc[ai][bj][m][0], v1 = acc[ai][bj][m][1];
                    const u32x4 gw = *(const u32x4*)(P + r * NP + gcol + col0 + bj * HALF);
                    float o[8] = {v0[0] * bflo(gw.x), v0[1] * bfhi(gw.x), v0[2] * bflo(gw.y), v0[3] * bfhi(gw.y), v1[0] * bflo(gw.z), v1[1] * bfhi(gw.z), v1[2] * bflo(gw.w), v1[3] * bfhi(gw.w)};
                    bf16_t* op = O + r * D + col0 + bj * HALF;
                    if (u.z) { const u32x4 pw = *(const u32x4*)op; o[0] += bflo(pw.x); o[1] += bfhi(pw.x); o[2] += bflo(pw.y); o[3] += bfhi(pw.y); o[4] += bflo(pw.z); o[5] += bfhi(pw.z); o[6] += bflo(pw.w); o[7] += bfhi(pw.w); }
                    u32x4 w; w.x = pk2(o[0], o[1]); w.y = pk2(o[2], o[3]); w.z = pk2(o[4], o[5]); w.w = pk2(o[6], o[7]);
                    *(u32x4*)op = w; } }
    }
};
struct EpiX1 {
    static constexpr bool PERM = false;
    const float* x; float* out; const float* gate;
    __device__ __forceinline__ void operator()(const f32x4 (&acc)[2][2][4][2], const Unit& u, int wr, int wc, int fr, int fq) const {
        const int row0 = u.pm * BM + wr * 64 + fr, col0 = u.pn * BM + wc * 32 + 4 * fq; const int b = (u.pm * BM) >> 11;
        f32x4 gv[2][2];
#pragma unroll
        for (int bj = 0; bj < 2; ++bj)
#pragma unroll
            for (int n = 0; n < 2; ++n) gv[bj][n] = *(const f32x4*)(gate + (size_t)b * NADA + col0 + bj * HALF + n * 16);
#pragma unroll
        for (int ai = 0; ai < 2; ++ai)
#pragma unroll
            for (int m = 0; m < 4; ++m) { const size_t off = (size_t)(row0 + ai * HALF + m * 16) * D + col0;
#pragma unroll
                for (int bj = 0; bj < 2; ++bj)
#pragma unroll
                    for (int n = 0; n < 2; ++n) { const f32x4 xv = *(const f32x4*)(x + off + bj * HALF + n * 16);
                        *(f32x4*)(out + off + bj * HALF + n * 16) = xv + gv[bj][n] * acc[ai][bj][m][n]; } }
    }
};
}

__device__ __forceinline__ void phase_mod(const Params& p, unsigned char* lds) {
    float* sc = (float*)lds;
    float* red = (float*)(lds + 65536);
    const int tid = threadIdx.x, wave = tid >> 6, lane = tid & 63;
    const float* c = p.in[1]; const float* wada = p.in[2]; const float* bada = p.in[3];
    float* mod = (float*)(p.ws + WS_MOD);
    if ((int)blockIdx.x >= 192) return;
    for (int i = tid; i < NBATCH * D; i += NTHREADS) { const int b = i >> 11, k = i & 2047; sc[k * 8 + b] = siluf_(c[i]); }
    __syncthreads();
    const int cgp = tid & 15, rg = tid >> 4;
    for (int item = blockIdx.x; item < 192; item += gridDim.x) {
        const float* w = wada + item * 64 + cgp * 4;
        float acc[8][4];
#pragma unroll
        for (int b = 0; b < 8; ++b)
#pragma unroll
            for (int j = 0; j < 4; ++j) acc[b][j] = 0.f;
#pragma unroll 4
        for (int i = 0; i < 64; ++i) { const int k = rg + 32 * i; const f32x4 wv = *(const f32x4*)(w + (size_t)k * NADA);
            const f32x4 s0 = *(const f32x4*)(sc + k * 8), s1 = *(const f32x4*)(sc + k * 8 + 4);
#pragma unroll
            for (int j = 0; j < 4; ++j) { acc[0][j] += s0[0] * wv[j]; acc[1][j] += s0[1] * wv[j]; acc[2][j] += s0[2] * wv[j]; acc[3][j] += s0[3] * wv[j];
                acc[4][j] += s1[0] * wv[j]; acc[5][j] += s1[1] * wv[j]; acc[6][j] += s1[2] * wv[j]; acc[7][j] += s1[3] * wv[j]; } }
#pragma unroll
        for (int b = 0; b < 8; ++b)
#pragma unroll
            for (int j = 0; j < 4; ++j) { float v = acc[b][j]; v += __shfl_xor(v, 16); v += __shfl_xor(v, 32); acc[b][j] = v; }
        if (lane < 16) {
#pragma unroll
            for (int b = 0; b < 8; ++b)
#pragma unroll
                for (int j = 0; j < 4; ++j) red[(wave * 16 + cgp) * 32 + b * 4 + j] = acc[b][j]; }
        __syncthreads();
        { const int cgo = tid >> 5, b = (tid >> 2) & 7, j = tid & 3; float s = 0.f;
#pragma unroll
          for (int w8 = 0; w8 < 8; ++w8) s += red[(w8 * 16 + cgo) * 32 + (tid & 31)];
          const int col = item * 64 + cgo * 4 + j; mod[b * NADA + col] = s + bada[col]; }
        __syncthreads();
    }
}
__device__ __forceinline__ void transpose_item(const float* W, int K, int N, bf16_t* WT, int nblk, int item, int lane, float* scr, int mode) {
    const int kb = item / nblk, nb = item % nblk, k0 = 64 * kb, n0 = 32 * nb;
    const int nd = n0 + (lane & 31); int ns = nd; bool valid = true;
    if (mode == 1) { if (nd >= C_QB) ns = nd - 176; else if (nd >= 4176) valid = false; }
#pragma unroll 8
    for (int i = 0; i < 32; ++i) { const int kk = 2 * i + (lane >> 5); scr[kk * 33 + (lane & 31)] = valid ? W[(size_t)(k0 + kk) * N + ns] : 0.f; }
    LDS_WAIT();
    const int c = lane & 7;
#pragma unroll
    for (int j = 0; j < 4; ++j) { const int n = (lane >> 3) + 8 * j; const float* s = scr + (8 * c) * 33 + n;
        u32x4 o; o.x = pk2(s[0 * 33], s[1 * 33]); o.y = pk2(s[2 * 33], s[3 * 33]); o.z = pk2(s[4 * 33], s[5 * 33]); o.w = pk2(s[6 * 33], s[7 * 33]);
        *(u32x4*)(WT + (size_t)(n0 + n) * K + k0 + 8 * c) = o; }
    LDS_WAIT();
}
__device__ __forceinline__ void phase_weights(const Params& p, unsigned char* lds) {
    const int tid = threadIdx.x, wave = tid >> 6, lane = tid & 63;
    float* scr = (float*)(lds + wave * 16384);
    const int vb = ((int)blockIdx.x + (int)gridDim.x - 192 % (int)gridDim.x) % (int)gridDim.x;
    const int gw = vb * NWAVES + wave, NGW = gridDim.x * NWAVES;
    constexpr int I_IN = 32 * (NP / 32), I_UA = 16 * 64, I_UB = 16 * 64, I_O = 32 * 64, I_Q = 32 * 64;
    constexpr int NITEMS = I_IN + I_UA + I_UB + I_O + I_Q;
    bf16_t* win_t = (bf16_t*)((unsigned char*)p.out + OUT_WIN);
    for (int it = gw; it < NITEMS; it += NGW) {
        int r = it;
        if (r < I_IN) { transpose_item(p.in[6], 2048, 12368, win_t, NP / 32, r, lane, scr, 1); continue; } r -= I_IN;
        if (r < I_UA) { transpose_item(p.in[9], 1024, 2048, (bf16_t*)(p.ws + WS_WUA), 64, r, lane, scr, 0); continue; } r -= I_UA;
        if (r < I_UB) { transpose_item(p.in[10], 1024, 2048, (bf16_t*)(p.ws + WS_WUB), 64, r, lane, scr, 0); continue; } r -= I_UB;
        if (r < I_O) { transpose_item(p.in[11], 2048, 2048, (bf16_t*)(p.ws + WS_WOUT), 64, r, lane, scr, 0); continue; } r -= I_O;
        transpose_item(p.in[12], 2048, 2048, (bf16_t*)(p.ws + WS_WQ), 64, r, lane, scr, 0);
    }
    { const float* ks = p.in[13]; bf16_t* kd = (bf16_t*)(p.ws + WS_KEYS);
      for (int i = (blockIdx.x * NTHREADS + tid) * 4; i < 8 * 2 * 128 * 128; i += gridDim.x * NTHREADS * 4) { const f32x4 v = *(const f32x4*)(ks + i); u32x2 o; o.x = pk2(v[0], v[1]); o.y = pk2(v[2], v[3]); *(u32x2*)(kd + i) = o; } }
}

__device__ __forceinline__ void phase_norm_rows(const float* src, const float* gain, const float* shift, const float* scale, bf16_t* dst) {
    const int tid = threadIdx.x, wave = tid >> 6, lane = tid & 63;
    const int gw = blockIdx.x * NWAVES + wave, NGW = gridDim.x * NWAVES;
    for (int row = gw; row < T; row += NGW) {
        const int b = row >> 11; const f32x4* xr = (const f32x4*)(src + (size_t)row * D) + lane;
        f32x4 v[8]; float ss = 0.f;
#pragma unroll
        for (int j = 0; j < 8; ++j) { v[j] = xr[64 * j]; ss += (v[j][0] * v[j][0] + v[j][1] * v[j][1]) + (v[j][2] * v[j][2] + v[j][3] * v[j][3]); }
        const float rstd = rsqrtf(wave_sum(ss) * (1.f / D) + NORM_EPS);
        u32x2* o8 = (u32x2*)(dst + (size_t)row * D) + lane;
#pragma unroll
        for (int j = 0; j < 8; ++j) { const int col = 4 * (lane + 64 * j);
            const f32x4 g = *(const f32x4*)(gain + col), sh = *(const f32x4*)(shift + (size_t)b * NADA + col), sc = *(const f32x4*)(scale + (size_t)b * NADA + col);
            f32x4 h;
#pragma unroll
            for (int e = 0; e < 4; ++e) h[e] = v[j][e] * rstd * g[e] * (1.f + sc[e]) + sh[e];
            u32x2 w; w.x = pk2(h[0], h[1]); w.y = pk2(h[2], h[3]); o8[64 * j] = w; }
    }
}

__device__ __forceinline__ void phase_vt(const Params& p, unsigned char* lds, int vb, int vG) {
    const int tid = threadIdx.x, wave = tid >> 6, lane = tid & 63;
    bf16_t* tile = (bf16_t*)(lds + wave * 16384);
    const bf16_t* P = (const bf16_t*)(p.ws + WS_P); bf16_t* VT = (bf16_t*)(p.ws + WS_VT);
    const int gw = vb * NWAVES + wave, NGW = vG * NWAVES;
    for (int it = gw; it < 8 * 8 * 32 * 2; it += NGW) {
        const int dh = it & 1, kt = (it >> 1) & 31, h = (it >> 6) & 7, b = it >> 9;
        const int k0 = kt * 64, d0 = dh * 64;
#pragma unroll
        for (int i = 0; i < 8; ++i) { const int key = i * 8 + (lane >> 3), dc = lane & 7;
            const u32x4 v = *(const u32x4*)(P + (size_t)(b * SEQ + k0 + key) * NP + C_VA + h * 128 + d0 + dc * 8);
            bf16_t* t = tile + (dc * 8) * 72 + key;
            t[0 * 72] = (bf16_t)(v.x & 0xffff); t[1 * 72] = (bf16_t)(v.x >> 16); t[2 * 72] = (bf16_t)(v.y & 0xffff); t[3 * 72] = (bf16_t)(v.y >> 16);
            t[4 * 72] = (bf16_t)(v.z & 0xffff); t[5 * 72] = (bf16_t)(v.z >> 16); t[6 * 72] = (bf16_t)(v.w & 0xffff); t[7 * 72] = (bf16_t)(v.w >> 16); }
        LDS_WAIT();
#pragma unroll
        for (int i = 0; i < 8; ++i) { const int d = i * 8 + (lane >> 3), kc = lane & 7;
            const u32x4 v = *(const u32x4*)(tile + d * 72 + kc * 8);
            *(u32x4*)(VT + ((size_t)((b * 8 + h) * 128 + d0 + d)) * SEQ + k0 + kc * 8) = v; }
        LDS_WAIT();
    }
}

__device__ __forceinline__ unsigned ord_key(float s) { const unsigned u = __float_as_uint(s); return (u & 0x80000000u) ? ~u : (u | 0x80000000u); }
__device__ __forceinline__ int half_sum(int v) {
#pragma unroll
    for (int o = 1; o < 32; o <<= 1) v += __shfl_xor(v, o);
    return v;
}
__device__ __forceinline__ void indexer_pair(const bf16_t* P, unsigned* MASK, int b, int c, int pair, int lane) {
    const int r = lane & 31, hh = lane >> 5;
    const int q0 = b * SEQ + c * 64 + 2 * pair;
    bf16x8 af[4];
    { const int query = q0 + ((r >> 2) & 1), head = (r & 3) + 4 * (r >> 3);
      const bf16_t* qp = P + (size_t)query * NP + C_QI + head * 64 + 8 * hh;
#pragma unroll
      for (int ks = 0; ks < 4; ++ks) af[ks] = *(const bf16x8*)(qp + ks * 16); }
    float wv[16];
    { const u32x4 w0 = *(const u32x4*)(P + (size_t)(q0 + hh) * NP + C_WI), w1 = *(const u32x4*)(P + (size_t)(q0 + hh) * NP + C_WI + 8);
      wv[0] = bflo(w0.x); wv[1] = bfhi(w0.x); wv[2] = bflo(w0.y); wv[3] = bfhi(w0.y); wv[4] = bflo(w0.z); wv[5] = bfhi(w0.z); wv[6] = bflo(w0.w); wv[7] = bfhi(w0.w);
      wv[8] = bflo(w1.x); wv[9] = bfhi(w1.x); wv[10] = bflo(w1.y); wv[11] = bfhi(w1.y); wv[12] = bflo(w1.z); wv[13] = bfhi(w1.z); wv[14] = bflo(w1.w); wv[15] = bfhi(w1.w); }
    const int nkt = 2 * (c + 1);
    unsigned kv[64];
    const bf16_t* kbase = P + (size_t)(b * SEQ + r) * NP + C_KI + 8 * hh;
#pragma unroll
    for (int kt = 0; kt < 64; ++kt) {
        kv[kt] = 0u;
        if (kt < nkt) {
            const bf16_t* kp = kbase + (size_t)(kt * 32) * NP;
            f32x16 acc;
#pragma unroll
            for (int i = 0; i < 16; ++i) acc[i] = 0.f;
#pragma unroll
            for (int ks = 0; ks < 4; ++ks) { const bf16x8 bfr = *(const bf16x8*)(kp + ks * 16); acc = __builtin_amdgcn_mfma_f32_32x32x16_bf16(af[ks], bfr, acc, 0, 0, 0); }
            float s = 0.f;
#pragma unroll
            for (int i = 0; i < 16; ++i) s += wv[i] * fmaxf(acc[i], 0.f);
            kv[kt] = ord_key(s);
        }
    }
    unsigned thr = 0u;
    for (int bit = 31; bit >= 0; --bit) {
        const unsigned cand = thr | (1u << bit); int cnt = 0;
#pragma unroll
        for (int kt = 0; kt < 64; ++kt) cnt += (kv[kt] >= cand) ? 1 : 0;
        cnt = half_sum(cnt);
        if (cnt >= 256) thr = cand;
    }
    int cge = 0;
#pragma unroll
    for (int kt = 0; kt < 64; ++kt) cge += (kv[kt] >= thr && kv[kt] != 0u) ? 1 : 0;
    cge = half_sum(cge);
    const bool ties = (thr != 0u) && (cge > 256);
    unsigned m0 = 0u, m1 = 0u;
    if (__builtin_amdgcn_ballot_w64(ties) == 0ull) {
#pragma unroll
        for (int kt = 0; kt < 64; ++kt) { const unsigned long long bm = __builtin_amdgcn_ballot_w64(kv[kt] >= thr && kv[kt] != 0u);
            if (lane == kt) { m0 = (unsigned)bm; m1 = (unsigned)(bm >> 32); } }
    } else {
        int cgt = 0;
#pragma unroll
        for (int kt = 0; kt < 64; ++kt) cgt += (kv[kt] > thr) ? 1 : 0;
        cgt = half_sum(cgt);
        const int need = ties ? (256 - cgt) : (1 << 30); int run = 0;
#pragma unroll
        for (int kt = 0; kt < 64; ++kt) { const bool tie = ties && (kv[kt] == thr); const unsigned long long tb = __builtin_amdgcn_ballot_w64(tie);
            const unsigned th = hh ? (unsigned)(tb >> 32) : (unsigned)tb; const int rank = run + __builtin_popcount(th & ((1u << r) - 1u));
            const bool sel = ties ? ((kv[kt] > thr) || (tie && rank < need)) : (kv[kt] >= thr && kv[kt] != 0u);
            run += __builtin_popcount(th);
            const unsigned long long bm = __builtin_amdgcn_ballot_w64(sel);
            if (lane == kt) { m0 = (unsigned)bm; m1 = (unsigned)(bm >> 32); } }
    }
    { const int qpos = c * 64 + 2 * pair; unsigned* mt = MASK + ((size_t)(b * 64 + lane)) * SEQ + qpos; mt[0] = m0; mt[1] = m1; }
}
__device__ __forceinline__ void phase_indexer(const Params& p, int vb, int vG) {
    const int tid = threadIdx.x, wave = tid >> 6, lane = tid & 63;
    const bf16_t* P = (const bf16_t*)(p.ws + WS_P); unsigned* MASK = (unsigned*)(p.ws + WS_MASK);
    const int G = vG;
    for (int rd = 0;; ++rd) {
        const int base = rd * G; if (base >= 1024) break;
        const int pos = (rd & 1) ? (G - 1 - vb) : vb; const int i = base + pos; if (i >= 1024) continue;
        const int c = 31 - (i >> 5), b = (i >> 2) & 7, grp = i & 3;
        indexer_pair(P, MASK, b, c, grp * 8 + wave, lane);
    }
}

constexpr int HG_RS = 136, HG_TS = 72, HG_SS = 136;
constexpr int HG_QT = 0, HG_QH = 17408, HG_KT = 34816, HG_KHT = 52224, HG_VT = 70656, HG_ST = 89088, HG_DEC = 123904, HG_SSQ = 124416;
__device__ __forceinline__ void hgrn_item(const Params& p, unsigned char* lds, int item) {
    const int tid = threadIdx.x, w = tid >> 6, lane = tid & 63, r = lane & 31, hh = lane >> 5;
    const int b = item >> 3, h = item & 7;
    const bf16_t* P = (const bf16_t*)(p.ws + WS_P); bf16_t* REC = (bf16_t*)((unsigned char*)p.out + OUT_REC);
    bf16_t* QT = (bf16_t*)(lds + HG_QT); bf16_t* QH = (bf16_t*)(lds + HG_QH); bf16_t* KT = (bf16_t*)(lds + HG_KT); bf16_t* KHT = (bf16_t*)(lds + HG_KHT); bf16_t* VT = (bf16_t*)(lds + HG_VT);
    bf16_t* ST = (bf16_t*)(lds + HG_ST); float* DEC = (float*)(lds + HG_DEC); float* SSQ = (float*)(lds + HG_SSQ);
    const int seg = lane >> 4, dl = lane & 15, d = 16 * w + dl;
    const float lb = sigmoidf_(p.in[7][h * 128 + d] - p.in[7][1024 + h * 128 + d]);
    const int tb = w & 1, eb = w >> 1, sdb = w & 3, seb0 = 2 * (w >> 2);
    const float gain_e = p.in[8][32 * eb + r];
    f32x16 S0, S1;
#pragma unroll
    for (int i = 0; i < 16; ++i) { S0[i] = 0.f; S1[i] = 0.f; }
    __syncthreads();
    for (int i = tid; i < 128 * HG_SS / 2; i += NTHREADS) ((unsigned*)ST)[i] = 0u;
    unsigned short rq[16], rf[16], ri[16];
    { const bf16_t* src = P + (size_t)(b * SEQ + 16 * seg) * NP + h * 128 + d;
#pragma unroll
      for (int i = 0; i < 16; ++i) { rq[i] = src[(size_t)i * NP + C_QB]; rf[i] = src[(size_t)i * NP + C_FB]; ri[i] = src[(size_t)i * NP + C_IB]; } }
#pragma unroll 1
    for (int n = 0; n < 32; ++n) {
        {
            float lf[16], kk[16];
            float run = 0.f;
#pragma unroll
            for (int i = 0; i < 16; ++i) { const float f = lb + (1.f - lb) * sigmoidf_(bf2f(rf[i])); kk[i] = 1.f - f; run += __logf(f); lf[i] = run; }
            const float p0 = __shfl(run, dl), p1 = __shfl(run, 16 + dl), p2 = __shfl(run, 32 + dl), p3 = __shfl(run, 48 + dl);
            const float off = (seg > 0 ? p0 : 0.f) + (seg > 1 ? p1 : 0.f) + (seg > 2 ? p2 : 0.f), bL = (p0 + p1) + (p2 + p3), bref = p0 + p1;
            unsigned kh[8], vv[8];
#pragma unroll
            for (int i = 0; i < 16; ++i) { const float bt = off + lf[i]; const float qs = siluf_(bf2f(rq[i]));
                const float e1 = __expf(bt - bref), e2 = __expf(bt), e3 = __builtin_amdgcn_rcpf(e1), e4 = __expf(bL - bt);
                const int t = 16 * seg + i;
                QT[t * HG_RS + d] = (bf16_t)f2bf(qs * e1); QH[t * HG_RS + d] = (bf16_t)f2bf(qs * e2); KT[t * HG_RS + d] = (bf16_t)f2bf(kk[i] * e3);
                const unsigned khv = f2bf(kk[i] * e4);
                if (i & 1) { kh[i >> 1] |= khv << 16; vv[i >> 1] |= (unsigned)ri[i] << 16; } else { kh[i >> 1] = khv; vv[i >> 1] = (unsigned)ri[i]; } }
            *(u32x4*)(KHT + d * HG_TS + 16 * seg) = (u32x4){kh[0], kh[1], kh[2], kh[3]}; *(u32x4*)(KHT + d * HG_TS + 16 * seg + 8) = (u32x4){kh[4], kh[5], kh[6], kh[7]};
            *(u32x4*)(VT + d * HG_TS + 16 * seg) = (u32x4){vv[0], vv[1], vv[2], vv[3]}; *(u32x4*)(VT + d * HG_TS + 16 * seg + 8) = (u32x4){vv[4], vv[5], vv[6], vv[7]};
            if (seg == 0) DEC[d] = __expf(bL);
        }
        __syncthreads();
        if (n < 31) { const bf16_t* src = P + (size_t)(b * SEQ + (n + 1) * 64 + 16 * seg) * NP + h * 128 + d;
#pragma unroll
            for (int i = 0; i < 16; ++i) { rq[i] = src[(size_t)i * NP + C_QB]; rf[i] = src[(size_t)i * NP + C_FB]; ri[i] = src[(size_t)i * NP + C_IB]; } }
        unsigned short gbv[16];
        { const bf16_t* gsrc = P + (size_t)(b * SEQ + n * 64 + 32 * tb + 4 * hh) * NP + C_GB + h * 128 + 32 * eb + r;
#pragma unroll
          for (int i = 0; i < 16; ++i) gbv[i] = gsrc[(size_t)((i & 3) + 8 * (i >> 2)) * NP]; }
        f32x16 X0, X1, o;
#pragma unroll
        for (int i = 0; i < 16; ++i) { X0[i] = 0.f; X1[i] = 0.f; o[i] = 0.f; }
#pragma unroll
        for (int ks = 0; ks < 8; ++ks) { const bf16x8 bq = *(const bf16x8*)(QT + (32 * tb + r) * HG_RS + 16 * ks + 8 * hh);
            const bf16x8 a0 = *(const bf16x8*)(KT + r * HG_RS + 16 * ks + 8 * hh); X0 = __builtin_amdgcn_mfma_f32_32x32x16_bf16(a0, bq, X0, 0, 0, 0);
            if (tb == 1) { const bf16x8 a1 = *(const bf16x8*)(KT + (32 + r) * HG_RS + 16 * ks + 8 * hh); X1 = __builtin_amdgcn_mfma_f32_32x32x16_bf16(a1, bq, X1, 0, 0, 0); } }
#pragma unroll
        for (int i = 0; i < 16; ++i) { const bool keep = ((i & 3) + 8 * (i >> 2) + 4 * hh) <= r; if (tb == 0) X0[i] = keep ? X0[i] : 0.f; else X1[i] = keep ? X1[i] : 0.f; }
#pragma unroll
        for (int sb = 0; sb < 2; ++sb) { if (sb <= tb) {
#pragma unroll
            for (int s2 = 0; s2 < 2; ++s2) { u32x4 aw;
                if (sb == 0) { aw.x = pk2(X0[8 * s2], X0[8 * s2 + 1]); aw.y = pk2(X0[8 * s2 + 2], X0[8 * s2 + 3]); aw.z = pk2(X0[8 * s2 + 4], X0[8 * s2 + 5]); aw.w = pk2(X0[8 * s2 + 6], X0[8 * s2 + 7]); }
                else { aw.x = pk2(X1[8 * s2], X1[8 * s2 + 1]); aw.y = pk2(X1[8 * s2 + 2], X1[8 * s2 + 3]); aw.z = pk2(X1[8 * s2 + 4], X1[8 * s2 + 5]); aw.w = pk2(X1[8 * s2 + 6], X1[8 * s2 + 7]); }
                const bf16_t* vp = VT + (32 * eb + r) * HG_TS + 32 * sb + 16 * s2 + 4 * hh;
                const u32x2 lo = *(const u32x2*)vp, hi = *(const u32x2*)(vp + 8); const u32x4 bw = {lo.x, lo.y, hi.x, hi.y};
                o = __builtin_amdgcn_mfma_f32_32x32x16_bf16(__builtin_bit_cast(bf16x8, aw), __builtin_bit_cast(bf16x8, bw), o, 0, 0, 0); } } }
#pragma unroll
        for (int ks = 0; ks < 8; ++ks) { const bf16x8 aq = *(const bf16x8*)(QH + (32 * tb + r) * HG_RS + 16 * ks + 8 * hh), bs = *(const bf16x8*)(ST + (32 * eb + r) * HG_SS + 16 * ks + 8 * hh);
            o = __builtin_amdgcn_mfma_f32_32x32x16_bf16(aq, bs, o, 0, 0, 0); }
        { float a8[8], a4[4], a2[2], a1;
#pragma unroll
          for (int i = 0; i < 8; ++i) { const float lo = o[i] * o[i], hi = o[i + 8] * o[i + 8]; const bool up = lane & 16; const float keep = up ? hi : lo, send = up ? lo : hi; a8[i] = keep + __shfl_xor(send, 16); }
#pragma unroll
          for (int i = 0; i < 4; ++i) { const bool up = lane & 8; const float keep = up ? a8[i + 4] : a8[i], send = up ? a8[i] : a8[i + 4]; a4[i] = keep + __shfl_xor(send, 8); }
#pragma unroll
          for (int i = 0; i < 2; ++i) { const bool up = lane & 4; const float keep = up ? a4[i + 2] : a4[i], send = up ? a4[i] : a4[i + 2]; a2[i] = keep + __shfl_xor(send, 4); }
          { const bool up = lane & 2; const float keep = up ? a2[1] : a2[0], send = up ? a2[0] : a2[1]; a1 = keep + __shfl_xor(send, 2); }
          a1 += __shfl_xor(a1, 1);
          const int ri2 = (lane >> 1) & 15;
          if ((lane & 1) == 0) SSQ[(32 * tb + (ri2 & 3) + 8 * (ri2 >> 2) + 4 * hh) * 4 + eb] = a1; }
        { float dc[16];
#pragma unroll
          for (int g4 = 0; g4 < 4; ++g4) { const f32x4 dv = *(const f32x4*)(DEC + 32 * sdb + 8 * g4 + 4 * hh); dc[4 * g4] = dv[0]; dc[4 * g4 + 1] = dv[1]; dc[4 * g4 + 2] = dv[2]; dc[4 * g4 + 3] = dv[3]; }
#pragma unroll
          for (int i = 0; i < 16; ++i) { S0[i] *= dc[i]; S1[i] *= dc[i]; }
#pragma unroll
          for (int ss = 0; ss < 4; ++ss) { const bf16x8 a = *(const bf16x8*)(KHT + (32 * sdb + r) * HG_TS + 16 * ss + 8 * hh);
              const bf16x8 b0 = *(const bf16x8*)(VT + (32 * seb0 + r) * HG_TS + 16 * ss + 8 * hh), b1 = *(const bf16x8*)(VT + (32 * (seb0 + 1) + r) * HG_TS + 16 * ss + 8 * hh);
              S0 = __builtin_amdgcn_mfma_f32_32x32x16_bf16(a, b0, S0, 0, 0, 0); S1 = __builtin_amdgcn_mfma_f32_32x32x16_bf16(a, b1, S1, 0, 0, 0); } }
        __syncthreads();
#pragma unroll
        for (int g4 = 0; g4 < 4; ++g4) { const int d0 = 32 * sdb + 8 * g4 + 4 * hh;
            *(u32x2*)(ST + (32 * seb0 + r) * HG_SS + d0) = (u32x2){pk2(S0[4 * g4], S0[4 * g4 + 1]), pk2(S0[4 * g4 + 2], S0[4 * g4 + 3])};
            *(u32x2*)(ST + (32 * (seb0 + 1) + r) * HG_SS + d0) = (u32x2){pk2(S1[4 * g4], S1[4 * g4 + 1]), pk2(S1[4 * g4 + 2], S1[4 * g4 + 3])}; }
        { bf16_t* dst = REC + (size_t)(b * SEQ + n * 64 + 32 * tb + 4 * hh) * 1024 + h * 128 + 32 * eb + r;
#pragma unroll
          for (int i = 0; i < 16; ++i) { const int tr = (i & 3) + 8 * (i >> 2); const f32x4 q4 = *(const f32x4*)(SSQ + (32 * tb + tr + 4 * hh) * 4);
              const float rstd = rsqrtf(((q4[0] + q4[1]) + (q4[2] + q4[3])) * (1.f / 128.f) + NORM_EPS);
              dst[(size_t)tr * 1024] = (bf16_t)f2bf(o[i] * rstd * gain_e * siluf_(bf2f(gbv[i]))); } }
    }
}
__device__ __forceinline__ void phase_hgrn(const Params& p, unsigned char* lds, int vb, int vG) {
    for (int it = vb; it < 64; it += vG) hgrn_item(p, lds, it);
}

constexpr int AT_KRS = 136, AT_VRS = 36, AT_KB = 32 * AT_KRS * 2, AT_VB = 128 * AT_VRS * 2, AT_STAGE = AT_KB + AT_VB;
__device__ __forceinline__ void attn_item(const Params& p, unsigned char* lds, int b, int head, int cq) {
    const int tid = threadIdx.x, w = __builtin_amdgcn_readfirstlane(tid >> 6), lane = tid & 63, r = lane & 31, hh = lane >> 5;
    const bf16_t* P = (const bf16_t*)(p.ws + WS_P); const bf16_t* VT = (const bf16_t*)(p.ws + WS_VT); const unsigned* MASKT = (const unsigned*)(p.ws + WS_MASK);
    bf16_t* AO = (bf16_t*)((unsigned char*)p.out + OUT_AO);
    const int c = 4 * cq + (w >> 1), qpos = c * 64 + (w & 1) * 32 + r, tq = b * SEQ + qpos;
    const int nkt_w = 2 * (c + 1), nkt = 8 * (cq + 1);
    const bf16_t* kg = P + (size_t)(b * SEQ + (tid >> 4)) * NP + C_KA + head * 128 + (tid & 15) * 8;
    const bf16_t* vg = VT + (size_t)((b * 8 + head) * 128 + (tid >> 2)) * SEQ + (tid & 3) * 8;
    const int kls = (tid >> 4) * AT_KRS * 2 + (tid & 15) * 16, vls = AT_KB + (tid >> 2) * AT_VRS * 2 + (tid & 3) * 16;
    bf16x8 qf[8];
    { const bf16_t* qp = P + (size_t)tq * NP + C_QA + head * 128 + 8 * hh;
#pragma unroll
      for (int ks = 0; ks < 8; ++ks) qf[ks] = *(const bf16x8*)(qp + ks * 16); }
    f32x16 o[4];
#pragma unroll
    for (int db = 0; db < 4; ++db)
#pragma unroll
        for (int i = 0; i < 16; ++i) o[db][i] = 0.f;
    float mrun = -1e30f, lsum = 0.f;
    const float sc = 0.08838834764831845f * 1.4426950408889634f;
    __syncthreads();
    u32x4 kr, vr;
#pragma unroll
    for (int t0 = 0; t0 < 2; ++t0) { kr = *(const u32x4*)(kg + (size_t)(t0 * 32) * NP); vr = *(const u32x4*)(vg + t0 * 32);
        *(u32x4*)(lds + t0 * AT_STAGE + kls) = kr; *(u32x2*)(lds + t0 * AT_STAGE + vls) = (u32x2){vr.x, vr.y}; *(u32x2*)(lds + t0 * AT_STAGE + vls + 8) = (u32x2){vr.z, vr.w}; }
    if (2 < nkt) { kr = *(const u32x4*)(kg + (size_t)(2 * 32) * NP); vr = *(const u32x4*)(vg + 2 * 32); }
    unsigned mw = MASKT[(size_t)(b * 64) * SEQ + qpos];
    __syncthreads();
    int st = 0, st2 = 2;
#pragma unroll 1
    for (int kt = 0; kt < nkt; ++kt) {
        if (kt + 2 < nkt) { *(u32x4*)(lds + st2 * AT_STAGE + kls) = kr; *(u32x2*)(lds + st2 * AT_STAGE + vls) = (u32x2){vr.x, vr.y}; *(u32x2*)(lds + st2 * AT_STAGE + vls + 8) = (u32x2){vr.z, vr.w}; }
        if (kt + 3 < nkt) { kr = *(const u32x4*)(kg + (size_t)((kt + 3) * 32) * NP); vr = *(const u32x4*)(vg + (kt + 3) * 32); }
        if (kt < nkt_w) {
            const unsigned mwc = mw;
            if (kt + 1 < nkt_w) mw = MASKT[(size_t)(b * 64 + kt + 1) * SEQ + qpos];
            const bf16_t* Ks = (const bf16_t*)(lds + st * AT_STAGE); const bf16_t* Vs = (const bf16_t*)(lds + st * AT_STAGE + AT_KB);
            f32x16 s;
#pragma unroll
            for (int i = 0; i < 16; ++i) s[i] = 0.f;
#pragma unroll
            for (int ks = 0; ks < 8; ++ks) { const bf16x8 kf = *(const bf16x8*)(Ks + r * AT_KRS + ks * 16 + 8 * hh); s = __builtin_amdgcn_mfma_f32_32x32x16_bf16(kf, qf[ks], s, 0, 0, 0); }
            float mx = -1e30f;
#pragma unroll
            for (int i = 0; i < 16; ++i) { const int bit = (i & 3) + 8 * (i >> 2) + 4 * hh; const bool ok = (mwc >> bit) & 1u; s[i] = ok ? s[i] * sc : -1e30f; mx = fmaxf(mx, s[i]); }
            mx = fmaxf(mx, __shfl_xor(mx, 32));
            const float mnew = fmaxf(mrun, mx), alpha = exp2f(mrun - mnew); mrun = mnew;
            float ps = 0.f; float pv[16];
#pragma unroll
            for (int i = 0; i < 16; ++i) { const float e = (s[i] > -1e29f) ? exp2f(s[i] - mnew) : 0.f; pv[i] = e; ps += e; }
            lsum = lsum * alpha + ps;
#pragma unroll
            for (int db = 0; db < 4; ++db)
#pragma unroll
                for (int i = 0; i < 16; ++i) o[db][i] *= alpha;
            bf16x8 pf[2];
#pragma unroll
            for (int s2 = 0; s2 < 2; ++s2) { u32x4 wv; wv.x = pk2(pv[8 * s2 + 0], pv[8 * s2 + 1]); wv.y = pk2(pv[8 * s2 + 2], pv[8 * s2 + 3]); wv.z = pk2(pv[8 * s2 + 4], pv[8 * s2 + 5]); wv.w = pk2(pv[8 * s2 + 6], pv[8 * s2 + 7]); pf[s2] = __builtin_bit_cast(bf16x8, wv); }
#pragma unroll
            for (int db = 0; db < 4; ++db)
#pragma unroll
                for (int s2 = 0; s2 < 2; ++s2) { const bf16_t* vp = Vs + (db * 32 + r) * AT_VRS + 16 * s2 + 4 * hh; const u32x2 lo = *(const u32x2*)vp, hi = *(const u32x2*)(vp + 8);
                    const u32x4 wv = {lo.x, lo.y, hi.x, hi.y};
                    o[db] = __builtin_amdgcn_mfma_f32_32x32x16_bf16(__builtin_bit_cast(bf16x8, wv), pf[s2], o[db], 0, 0, 0); }
        }
        __syncthreads();
        st = (st == 2) ? 0 : st + 1; st2 = (st2 == 2) ? 0 : st2 + 1;
    }
    const float l = lsum + __shfl_xor(lsum, 32), inv = 1.f / l;
    bf16_t* op = AO + (size_t)tq * 1024 + head * 128 + 4 * hh;
#pragma unroll
    for (int db = 0; db < 4; ++db)
#pragma unroll
        for (int g4 = 0; g4 < 4; ++g4) { u32x2 wv; wv.x = pk2(o[db][4 * g4] * inv, o[db][4 * g4 + 1] * inv); wv.y = pk2(o[db][4 * g4 + 2] * inv, o[db][4 * g4 + 3] * inv);
            *(u32x2*)(op + db * 32 + 8 * g4) = wv; }
}
__device__ __forceinline__ void phase_attn(const Params& p, unsigned char* lds) {
    const int G = gridDim.x;
    for (int rd = 0;; ++rd) {
        const int base = rd * G; if (base >= 512) break;
        const int pos = (rd & 1) ? (G - 1 - (int)blockIdx.x) : (int)blockIdx.x; const int i = base + pos; if (i >= 512) continue;
        attn_item(p, lds, (i >> 3) & 7, i & 7, 7 - (i >> 6));
    }
}
__device__ __forceinline__ void phase_uv(const Params& p) {
    const int tid = threadIdx.x, wave = tid >> 6, lane = tid & 63;
    const int gw = blockIdx.x * NWAVES + wave, NGW = gridDim.x * NWAVES;
    for (int it = gw; it < 2 * 16384; it += NGW) {
        const int tbl = it >> 14, row = it & 16383;
        const float* src = (tbl ? p.in[15] : p.in[14]) + (size_t)row * 2048 + 32 * lane;
        unsigned char* dst = p.ws + (tbl ? WS_V8 : WS_U8); float* isc = (float*)(p.ws + (tbl ? WS_ISV : WS_ISU));
        f32x4 v[8]; float am = 0.f;
#pragma unroll
        for (int j = 0; j < 8; ++j) { v[j] = *(const f32x4*)(src + 4 * j); am = fmaxf(am, fmaxf(fmaxf(fabsf(v[j][0]), fabsf(v[j][1])), fmaxf(fabsf(v[j][2]), fabsf(v[j][3])))); }
#pragma unroll
        for (int o = 1; o < 64; o <<= 1) am = fmaxf(am, __shfl_xor(am, o));
        am = fmaxf(am, 1e-30f); const float sc = 256.f / am;
        unsigned wq[8];
#pragma unroll
        for (int j = 0; j < 8; ++j) { int pk = 0; pk = __builtin_amdgcn_cvt_pk_fp8_f32(v[j][0] * sc, v[j][1] * sc, pk, false); pk = __builtin_amdgcn_cvt_pk_fp8_f32(v[j][2] * sc, v[j][3] * sc, pk, true); wq[j] = (unsigned)pk; }
        unsigned char* d = dst + (size_t)(lane >> 2) * (2u << 20) + (size_t)row * 128 + (lane & 3) * 32;
        *(u32x4*)d = (u32x4){wq[0], wq[1], wq[2], wq[3]}; *(u32x4*)(d + 16) = (u32x4){wq[4], wq[5], wq[6], wq[7]};
        if (lane == 0) isc[row] = am * (1.f / 256.f);
    }
}

#define INS16(v, x) do { _Pragma("unroll") for (int _j = 15; _j >= 1; --_j) v[_j] = __builtin_amdgcn_fmed3f(v[_j - 1], v[_j], (x)); v[0] = fmaxf(v[0], (x)); } while (0)
__device__ __forceinline__ void peer_half_top16(const bf16_t* QP, const bf16_t* KEYS, int tok, int p, int hf, int r, int hh, float (&v)[16]) {
    bf16x8 qf[8];
    { const bf16_t* qp = QP + (size_t)tok * D + p * 256 + hf * 128 + 8 * hh;
#pragma unroll
      for (int ks = 0; ks < 8; ++ks) qf[ks] = *(const bf16x8*)(qp + ks * 16); }
#pragma unroll
    for (int k = 0; k < 16; ++k) v[k] = -3.0e38f;
    const bf16_t* kb = KEYS + (size_t)((p * 2 + hf) * 128 + r) * 128 + 8 * hh;
#pragma unroll 1
    for (int nb = 0; nb < 4; ++nb) {
        f32x16 acc;
#pragma unroll
        for (int i = 0; i < 16; ++i) acc[i] = 0.f;
#pragma unroll
        for (int ks = 0; ks < 8; ++ks) { const bf16x8 kf = *(const bf16x8*)(kb + (size_t)(nb * 32) * 128 + ks * 16); acc = __builtin_amdgcn_mfma_f32_32x32x16_bf16(kf, qf[ks], acc, 0, 0, 0); }
#pragma unroll
        for (int i = 0; i < 16; ++i) { const unsigned xi = (unsigned)(nb * 32 + (i & 3) + 8 * (i >> 2) + 4 * hh); const float x = __uint_as_float((__float_as_uint(acc[i]) & ~0x7fu) | xi); INS16(v, x); }
    }
    float ov[16];
#pragma unroll
    for (int k = 0; k < 16; ++k) ov[k] = __shfl_xor(v[k], 32);
#pragma unroll
    for (int k = 0; k < 16; ++k) INS16(v, ov[k]);
}
__device__ __forceinline__ void phase_peer_topk(const Params& p) {
    const int tid = threadIdx.x, wave = tid >> 6, lane = tid & 63, r = lane & 31, hh = lane >> 5;
    const bf16_t* QP = (const bf16_t*)(p.ws + WS_QP); const bf16_t* KEYS = (const bf16_t*)(p.ws + WS_KEYS);
    int* EIDX = (int*)(p.ws + WS_EIDX); float* EGATE = (float*)(p.ws + WS_EGATE);
    const int gw = blockIdx.x * NWAVES + wave, NGW = gridDim.x * NWAVES;
    for (int it = gw; it < 512 * 8; it += NGW) {
        const int tg = it >> 3, hd = it & 7, tok = tg * 32 + r;
        float va[16], vb[16];
        peer_half_top16(QP, KEYS, tok, hd, 0, r, hh, va);
        peer_half_top16(QP, KEYS, tok, hd, 1, r, hh, vb);
        float bv[16];
#pragma unroll
        for (int k = 0; k < 16; ++k) bv[k] = -3.0e38f;
#pragma unroll
        for (int a = 0; a < 16; ++a)
#pragma unroll
            for (int b2 = 0; b2 < 16; ++b2) if ((a + 1) * (b2 + 1) <= 16) { const float x = va[a] + vb[b2]; INS16(bv, x); }
        float se = 0.f;
#pragma unroll
        for (int k = 0; k < 16; ++k) se += __expf(bv[k] - bv[0]);
        const float inv = 1.f / se, thr = bv[15], top = bv[0];
        int cnt = 0; int* ei = EIDX + (size_t)tok * 128 + hd * 16; float* eg = EGATE + (size_t)tok * 128 + hd * 16;
#pragma unroll
        for (int a = 0; a < 16; ++a)
#pragma unroll
            for (int b2 = 0; b2 < 16; ++b2) if ((a + 1) * (b2 + 1) <= 16) { const float x = va[a] + vb[b2];
                if (x >= thr && cnt < 16) { if (hh == 0) { ei[cnt] = (int)((__float_as_uint(va[a]) & 0x7fu) * 128u + (__float_as_uint(vb[b2]) & 0x7fu)); eg[cnt] = __expf(x - top) * inv; } ++cnt; } }
    }
}

typedef __bf16 bf16x2_t __attribute__((ext_vector_type(2)));
__device__ __forceinline__ float gelu_erf(float v) {
    const float av = fabsf(v), d = av * 0.2316418882f + 1.0f, t = __builtin_amdgcn_rcpf(d);
    float q = t * 0.5307027145f + (-0.7265760135f); q = q * t + 0.7107068705f; q = q * t + (-0.142248368f); q = q * t + 0.127414796f; q = q * t;
    const float e = __builtin_amdgcn_exp2f((v * v) * (-0.72134752044f));
    const float m = v * (q * e), r = v - m;
    return v < 0.f ? m : r;
}
__device__ __forceinline__ float dot2bf(unsigned a, unsigned b, float c) { return __builtin_amdgcn_fdot2_f32_bf16(__builtin_bit_cast(bf16x2_t, a), __builtin_bit_cast(bf16x2_t, b), c, false); }
__device__ __forceinline__ float dpp_f(float x, int ctrl_xor1_xor2_mirror) {
    const int v = __float_as_int(x);
    if (ctrl_xor1_xor2_mirror == 0) return __int_as_float(__builtin_amdgcn_update_dpp(0, v, 0xB1, 0xF, 0xF, true));
    if (ctrl_xor1_xor2_mirror == 1) return __int_as_float(__builtin_amdgcn_update_dpp(0, v, 0x4E, 0xF, 0xF, true));
    return __int_as_float(__builtin_amdgcn_update_dpp(0, v, 0x141, 0xF, 0xF, true));
}
typedef float f32x2v __attribute__((ext_vector_type(2)));
__device__ __forceinline__ void unpack8(const u32x4 w, float* f) { f[0] = bflo(w.x); f[1] = bfhi(w.x); f[2] = bflo(w.y); f[3] = bfhi(w.y); f[4] = bflo(w.z); f[5] = bfhi(w.z); f[6] = bflo(w.w); f[7] = bfhi(w.w); }
__device__ __forceinline__ void cvt16(const u32x4 w, float* f) {
#pragma unroll
    for (int q = 0; q < 4; ++q) { const f32x2v lo = __builtin_amdgcn_cvt_pk_f32_fp8((int)w[q], false), hi = __builtin_amdgcn_cvt_pk_f32_fp8((int)w[q], true);
        f[4 * q] = lo.x; f[4 * q + 1] = lo.y; f[4 * q + 2] = hi.x; f[4 * q + 3] = hi.y; }
}
__device__ __forceinline__ void phase_experts(const Params& p, unsigned char* lds) {
    const int tid = threadIdx.x, wave = __builtin_amdgcn_readfirstlane(tid >> 6), lane = tid & 63, rr = lane >> 3, cc = lane & 7; const bool odd = cc & 1;
    const bf16_t* H2 = (const bf16_t*)(p.ws + WS_H2); const unsigned char* U8 = p.ws + WS_U8; const unsigned char* V8 = p.ws + WS_V8;
    const float* ISU = (const float*)(p.ws + WS_ISU); const float* ISV = (const float*)(p.ws + WS_ISV);
    const int* EIDX = (const int*)(p.ws + WS_EIDX); const float* EGATE = (const float*)(p.ws + WS_EGATE);
    const float* mod = (const float*)(p.ws + WS_MOD); const float* fin = p.in[16]; float* out = p.out; const float* X1 = (const float*)(p.ws + WS_X1);
    unsigned* offs = (unsigned*)lds; float* gts = (float*)(lds + 32768); float* rstl = (float*)(lds + 65536);
    const unsigned xcc = (unsigned)__builtin_amdgcn_s_getreg((3 << 11) | 20) & 7u; const unsigned cc16 = cc * 16;
    for (int tile = blockIdx.x; tile < T / 64; tile += gridDim.x) {
        const int tok0 = tile * 64, b = tok0 >> 11;
        __syncthreads();
        for (int i = tid; i < 8192; i += NTHREADS) { const int tl = i >> 7, j = i & 127, g = j >> 3, r8 = j & 7;
            offs[(tl * 8 + r8) * 16 + g] = (unsigned)EIDX[(size_t)tok0 * 128 + i] * 128u; gts[(tl * 8 + r8) * 16 + g] = EGATE[(size_t)tok0 * 128 + i]; }
        __syncthreads();
#pragma unroll 1
        for (int half = 0; half < 2; ++half) {
            const int tlb = wave * 8 + half * 4;
            u32x4 dA[16], hA0, hA1;
#define EX_SLICE(i_) ((xcc * 2u + (unsigned)(i_)) & 15u)
#define EX_LOAD(buf, TBL, i_, k_) do { const unsigned char* tb_ = (TBL) + (size_t)EX_SLICE(i_) * (2u << 20); u32x4 o4_[4]; \
    _Pragma("unroll") for (int q_ = 0; q_ < 4; ++q_) o4_[q_] = *(const u32x4*)(offs + ((tlb + (k_)) * 8 + rr) * 16 + 4 * q_); \
    _Pragma("unroll") for (int g_ = 0; g_ < 16; ++g_) buf[g_] = *(const u32x4*)(tb_ + (o4_[g_ >> 2][g_ & 3] + cc16)); } while (0)
#define EX_LOADH(h0, h1, i_, k_) do { const bf16_t* hp_ = H2 + (size_t)(tok0 + tlb + (k_)) * D + EX_SLICE(i_) * 128 + cc * 16; h0 = *(const u32x4*)hp_; h1 = *(const u32x4*)(hp_ + 8); } while (0)
#define EX_DOT16(acc, WSRC, hf) do { u32x4 w_ = WSRC; asm volatile("" : "+v"(w_.x), "+v"(w_.y), "+v"(w_.z), "+v"(w_.w), "+v"(ch_)); float f_[16]; cvt16(w_, f_); _Pragma("unroll") for (int e_ = 0; e_ < 16; ++e_) acc = fmaf(f_[e_], hf[e_], acc); ch_ = acc; } while (0)
#define EX_UCOMP(buf, h0, h1, k_) do { float hf_[16]; unpack8(h0, hf_); unpack8(h1, hf_ + 8); float ch_ = 0.f; \
    _Pragma("unroll") for (int j_ = 0; j_ < 8; ++j_) { float te_ = 0.f, to_ = 0.f; EX_DOT16(te_, buf[2 * j_], hf_); __builtin_amdgcn_sched_barrier(0); EX_DOT16(to_, buf[2 * j_ + 1], hf_); \
    const float my_ = odd ? to_ : te_, ot_ = odd ? te_ : to_; zp[k_][j_] += my_ + dpp_f(ot_, 0); asm volatile("" : "+v"(zp[k_][j_])); __builtin_amdgcn_sched_barrier(0); } } while (0)
#define SB() __builtin_amdgcn_sched_barrier(0)
            float zp[4][8];
#pragma unroll
            for (int k = 0; k < 4; ++k)
#pragma unroll
                for (int j = 0; j < 8; ++j) zp[k][j] = 0.f;
#pragma unroll 1
            for (int i = 0; i < 16; ++i) {
                __builtin_amdgcn_s_barrier();
                EX_LOADH(hA0, hA1, i, 0); EX_LOAD(dA, U8, i, 0); SB(); EX_UCOMP(dA, hA0, hA1, 0); SB();
                EX_LOADH(hA0, hA1, i, 1); EX_LOAD(dA, U8, i, 1); SB(); EX_UCOMP(dA, hA0, hA1, 1); SB();
                EX_LOADH(hA0, hA1, i, 2); EX_LOAD(dA, U8, i, 2); SB(); EX_UCOMP(dA, hA0, hA1, 2); SB();
                EX_LOADH(hA0, hA1, i, 3); EX_LOAD(dA, U8, i, 3); SB(); EX_UCOMP(dA, hA0, hA1, 3); SB();
            }
            unsigned* apl = (unsigned*)(lds + 66560);
#pragma unroll
            for (int k = 0; k < 4; ++k)
#pragma unroll
                for (int j = 0; j < 8; ++j) { float z = zp[k][j]; z += dpp_f(z, 1); z += __shfl_xor(z, 4);
                    const int li = ((tlb + k) * 8 + rr) * 16 + 2 * j + (odd ? 1 : 0); const unsigned eid = offs[li] >> 7;
                    const float act = gelu_erf(z * ISU[eid]) * gts[li] * ISV[eid]; const float oth = dpp_f(act, 0);
                    apl[((tlb + k) * 8 + rr) * 8 + j] = f2bf(odd ? oth : act) | (f2bf(odd ? act : oth) << 16); if (j & 1) __builtin_amdgcn_sched_barrier(0); }
            LDS_WAIT();
            float ssq[4] = {0.f, 0.f, 0.f, 0.f};
#define EX_VCOMP(buf, i_, k_) do { float oa_[16]; _Pragma("unroll") for (int e_ = 0; e_ < 16; ++e_) oa_[e_] = 0.f; \
    const u32x4 ap0_ = *(const u32x4*)(apl + ((tlb + (k_)) * 8 + rr) * 8), ap1_ = *(const u32x4*)(apl + ((tlb + (k_)) * 8 + rr) * 8 + 4); \
    _Pragma("unroll") for (int j_ = 0; j_ < 8; ++j_) { const unsigned pr_ = (j_ < 4) ? ap0_[j_ & 3] : ap1_[j_ & 3]; const float a0_ = bflo(pr_), a1_ = bfhi(pr_); \
        { u32x4 w_ = buf[2 * j_]; asm volatile("" : "+v"(w_.x), "+v"(w_.y), "+v"(w_.z), "+v"(w_.w), "+v"(oa_[0])); float f_[16]; cvt16(w_, f_); _Pragma("unroll") for (int e_ = 0; e_ < 16; ++e_) oa_[e_] = fmaf(a0_, f_[e_], oa_[e_]); } \
        { u32x4 w_ = buf[2 * j_ + 1]; asm volatile("" : "+v"(w_.x), "+v"(w_.y), "+v"(w_.z), "+v"(w_.w), "+v"(oa_[0])); float f_[16]; cvt16(w_, f_); _Pragma("unroll") for (int e_ = 0; e_ < 16; ++e_) oa_[e_] = fmaf(a1_, f_[e_], oa_[e_]); } } \
      \
    float b8_[8], b4_[4], b2_[2]; \
    _Pragma("unroll") for (int e_ = 0; e_ < 8; ++e_) { const bool up_ = lane & 32; const float kp_ = up_ ? oa_[e_ + 8] : oa_[e_], sd_ = up_ ? oa_[e_] : oa_[e_ + 8]; b8_[e_] = kp_ + __shfl_xor(sd_, 32); } \
    _Pragma("unroll") for (int e_ = 0; e_ < 4; ++e_) { const bool up_ = lane & 16; const float kp_ = up_ ? b8_[e_ + 4] : b8_[e_], sd_ = up_ ? b8_[e_] : b8_[e_ + 4]; b4_[e_] = kp_ + __shfl_xor(sd_, 16); } \
    _Pragma("unroll") for (int e_ = 0; e_ < 2; ++e_) { const bool up_ = lane & 8; const float kp_ = up_ ? b4_[e_ + 2] : b4_[e_], sd_ = up_ ? b4_[e_] : b4_[e_ + 2]; b2_[e_] = kp_ + __shfl_xor(sd_, 8); } \
    const int col_ = (int)EX_SLICE(i_) * 128 + cc * 16 + 2 * rr; const size_t xo_ = (size_t)(tok0 + tlb + (k_)) * D + col_; \
    const f32x2v x1_ = *(const f32x2v*)(X1 + xo_), g2_ = *(const f32x2v*)(mod + (size_t)b * NADA + 5 * 2048 + col_); \
    f32x2v y_; y_.x = x1_.x + g2_.x * b2_[0]; y_.y = x1_.y + g2_.y * b2_[1]; *(f32x2v*)(out + xo_) = y_; ssq[k_] = fmaf(y_.x, y_.x, fmaf(y_.y, y_.y, ssq[k_])); asm volatile("" : "+v"(ssq[k_])); } while (0)
#pragma unroll 1
            for (int i = 0; i < 16; ++i) {
                __builtin_amdgcn_s_barrier();
                EX_LOAD(dA, V8, i, 0); SB(); EX_VCOMP(dA, i, 0); SB();
                EX_LOAD(dA, V8, i, 1); SB(); EX_VCOMP(dA, i, 1); SB();
                EX_LOAD(dA, V8, i, 2); SB(); EX_VCOMP(dA, i, 2); SB();
                EX_LOAD(dA, V8, i, 3); SB(); EX_VCOMP(dA, i, 3); SB();
            }
#pragma unroll
            for (int k = 0; k < 4; ++k) { const float tot = wave_sum(ssq[k]); rstl[wave * 8 + half * 4 + k] = rsqrtf(tot * (1.f / D) + NORM_EPS); }
        }
#undef EX_SLICE
#undef EX_LOAD
#undef EX_LOADH
#undef EX_DOT16
#undef EX_UCOMP
#undef EX_VCOMP
#undef SB
        __builtin_amdgcn_fence(__ATOMIC_RELEASE, "agent"); __builtin_amdgcn_fence(__ATOMIC_ACQUIRE, "agent");
        LDS_WAIT();
        int lane2 = (int)__builtin_amdgcn_mbcnt_hi(~0u, __builtin_amdgcn_mbcnt_lo(~0u, 0u)); asm volatile("" : "+v"(lane2));
#pragma unroll 1
        for (int k = 0; k < 8; ++k) { float* xr = out + (size_t)(tok0 + wave * 8 + k) * D; const float rs = rstl[wave * 8 + k];
#pragma unroll
            for (int j = 0; j < 8; ++j) { const int col = 4 * (lane2 + 64 * j); const f32x4 v = *(const f32x4*)(xr + col), f = *(const f32x4*)(fin + col);
                f32x4 o; o[0] = v[0] * rs * f[0]; o[1] = v[1] * rs * f[1]; o[2] = v[2] * rs * f[2]; o[3] = v[3] * rs * f[3]; *(f32x4*)(xr + col) = o; } }
    }
}

#define XB_TMO      128
#define XB_XCNT(j)  (256  + 64 * (j))
#define XB_XSUB(j)  (1280 + 64 * (j))
#define XB_XGEN(j)  (2304 + 64 * (j))
#define XB_TOP      3328
#define XB_TOPGEN   3392
#define XCD_BAR_WORDS 3456
#define XB_SPIN_CAP (1u << 22)
__device__ __forceinline__ unsigned xb_ld(unsigned* p)              { return __hip_atomic_load(p, __ATOMIC_RELAXED, __HIP_MEMORY_SCOPE_AGENT); }
__device__ __forceinline__ unsigned xb_add(unsigned* p, unsigned v) { return __hip_atomic_fetch_add(p, v, __ATOMIC_RELAXED, __HIP_MEMORY_SCOPE_AGENT); }
__device__ __forceinline__ unsigned xb_xcc_id() { return (unsigned)__builtin_amdgcn_s_getreg((3 << 11) | 20) & 0xFu; }
#define XB_SPIN(cond, bar) do { unsigned _sp = 0; while (cond) { __builtin_amdgcn_s_sleep(1); \
    if ((++_sp & 255u) == 0u) { if (xb_ld(&(bar)[XB_TMO])) break; if (_sp > XB_SPIN_CAP) { atomicAdd(&(bar)[XB_TMO], 1u); break; } } } } while (0)
struct XcdBarrier { unsigned* bar; unsigned x; volatile LAS unsigned* st; };
__device__ __forceinline__ XcdBarrier xcd_barrier_post(unsigned* bar, volatile LAS unsigned* st) {
    XcdBarrier b; b.bar = bar; b.x = xb_xcc_id(); b.st = st;
    if (threadIdx.x == 0) (void)xb_add(&bar[XB_XCNT(b.x)], 1u);
    return b;
}
__device__ __forceinline__ void xcd_barrier_complete(unsigned* bar, unsigned x, unsigned& nloc, unsigned& nx) {
    const unsigned G = gridDim.x * gridDim.y * gridDim.z;
    unsigned sum, cnt, mine, sp = 0u;
    for (;;) {
        sum = 0u; cnt = 0u; mine = 0u;
#pragma unroll
        for (unsigned j = 0; j < 16; ++j) { const unsigned c = xb_ld(&bar[XB_XCNT(j)]); sum += c; cnt += (c > 0u) ? 1u : 0u; mine = (j == x) ? c : mine; }
        if (sum == G) break;
        __builtin_amdgcn_s_sleep(1);
        if ((++sp & 255u) == 0u) { if (xb_ld(&bar[XB_TMO])) break; if (sp > XB_SPIN_CAP) { atomicAdd(&bar[XB_TMO], 1u); break; } }
    }
    nloc = mine > 0u ? mine : 1u; nx = cnt > 0u ? cnt : 1u;
}
__device__ __forceinline__ void xcd_barrier(const XcdBarrier& b) {
    asm volatile("s_waitcnt vmcnt(0)" ::: "memory");
    __syncthreads();
    if (threadIdx.x == 0) {
        unsigned* bar = b.bar;
        __builtin_amdgcn_s_waitcnt(0);
        unsigned nloc = b.st[0], nx = b.st[1];
        if (nloc == 0u) { xcd_barrier_complete(bar, b.x, nloc, nx); b.st[0] = nloc; b.st[1] = nx; }
        const unsigned old = xb_add(&bar[XB_XSUB(b.x)], 1u);
        const unsigned gen = old / nloc;
        if (old + 1u == (gen + 1u) * nloc) {
            __builtin_amdgcn_fence(__ATOMIC_RELEASE, "agent");
            asm volatile("s_waitcnt vmcnt(0)" ::: "memory");
            const unsigned og = xb_add(&bar[XB_TOP], 1u);
            const unsigned tg = og / nx;
            if (og + 1u == (tg + 1u) * nx) xb_add(&bar[XB_TOPGEN], 1u);
            else XB_SPIN(xb_ld(&bar[XB_TOPGEN]) == tg, bar);
            __builtin_amdgcn_fence(__ATOMIC_ACQUIRE, "agent");
            xb_add(&bar[XB_XGEN(b.x)], 1u);
            asm volatile("s_waitcnt vmcnt(0)" ::: "memory");
        } else {
            XB_SPIN(xb_ld(&bar[XB_XGEN(b.x)]) == gen, bar);
            __builtin_amdgcn_fence(__ATOMIC_ACQUIRE, "agent");
            asm volatile("s_waitcnt vmcnt(0)" ::: "memory");
        }
    }
    __syncthreads();
}

constexpr int NPHASES = 11;
__global__ void __launch_bounds__(NTHREADS, 2) mega_fwd(Params p) {
    extern __shared__ __attribute__((aligned(16))) unsigned char lds[];
    cg::grid_group grid = cg::this_grid();
    const int lo = p.ph_lo, hi = p.ph_hi;
#ifndef PHASE_MASK
#define PHASE_MASK 0x7ff
#endif
#define IN(k) (((PHASE_MASK >> (k)) & 1) && lo <= (k) && (k) < hi)
#define SEAM(k) do { if (IN(k) && IN((k) + 1)) { if ((k) == 0) grid.sync(); else xcd_barrier(xbar); } } while (0)
    unsigned char* ws = p.ws;
    bf16_t* P = (bf16_t*)(ws + WS_P);
    bf16_t* Hb = (bf16_t*)((unsigned char*)p.out + OUT_H);
    bf16_t* WinT = (bf16_t*)((unsigned char*)p.out + OUT_WIN);
    const float* mod = (const float*)(ws + WS_MOD);
    LAS unsigned char* ldsl = (LAS unsigned char*)lds;
    volatile LAS unsigned* xst = (volatile LAS unsigned*)(ldsl + LDS_BYTES - 64);
    if (threadIdx.x < 2) xst[threadIdx.x] = 0u;
    __syncthreads();
    XcdBarrier xbar = xcd_barrier_post((unsigned*)(ws + WS_CTL) + 4096, xst);

#ifndef REPEAT_PHASE
#define REPEAT_PHASE -1
#endif
#define RUNPH(k, ...) do { if (IN(k)) { __VA_ARGS__; if (REPEAT_PHASE == (k)) { grid.sync(); __VA_ARGS__; } } } while (0)
    RUNPH(0, { phase_mod(p, lds); __syncthreads(); phase_weights(p, lds); });
    SEAM(0);
    RUNPH(1, { phase_norm_rows(p.in[0], p.in[4], mod, mod + 2048, Hb); });
    SEAM(1);
    RUNPH(2, { pg8::Gemm g{Hb, WinT, nullptr, nullptr, D, D, T, NP, D}; pg8::StaticOrder<1> S; S.init(T, NP, gridDim.x, blockIdx.x);
        pg8::EpiBf16 E{P, NP, 33}; pg8::gemm_phase(ldsl, g, S, E); });
    SEAM(2);
    RUNPH(3, { const int G = gridDim.x, bx = blockIdx.x;
        if (G >= 128) { if (bx < 64) { phase_hgrn(p, lds, bx, 64); if (REPEAT_PHASE == 32) phase_hgrn(p, lds, bx, 64); }
                        else { phase_vt(p, lds, bx - 64, G - 64); phase_indexer(p, bx - 64, G - 64); if (REPEAT_PHASE == 31) phase_indexer(p, bx - 64, G - 64); } }
        else { phase_vt(p, lds, bx, G); phase_indexer(p, bx, G); __syncthreads(); phase_hgrn(p, lds, bx, G); } });
    SEAM(3);
    RUNPH(4, { phase_attn(p, lds); });
    SEAM(4);
    RUNPH(5, { pg8::Gemm g{(const bf16_t*)((unsigned char*)p.out + OUT_AO), (const bf16_t*)(ws + WS_WUA), (const bf16_t*)((unsigned char*)p.out + OUT_REC), (const bf16_t*)(ws + WS_WUB), 1024, 1024, T, D, 1024}; pg8::StaticOrder<2> S; S.init(T, D, gridDim.x, blockIdx.x);
        pg8::EpiMix E{(bf16_t*)(ws + WS_MIXED), P}; pg8::gemm_phase(ldsl, g, S, E); });
    SEAM(5);
    RUNPH(6, { pg8::Gemm g{(const bf16_t*)(ws + WS_MIXED), (const bf16_t*)(ws + WS_WOUT), nullptr, nullptr, D, D, T, D, D}; pg8::StaticOrder<1> S; S.init(T, D, gridDim.x, blockIdx.x);
        pg8::EpiX1 E{p.in[0], (float*)(ws + WS_X1), mod + 4096}; pg8::gemm_phase(ldsl, g, S, E); });
    SEAM(6);
    RUNPH(7, { phase_norm_rows((const float*)(ws + WS_X1), p.in[5], mod + 3 * 2048, mod + 4 * 2048, (bf16_t*)(ws + WS_H2)); phase_uv(p); });
    SEAM(7);
    RUNPH(8, { pg8::Gemm g{(const bf16_t*)(ws + WS_H2), (const bf16_t*)(ws + WS_WQ), nullptr, nullptr, D, D, T, D, D}; pg8::StaticOrder<1> S; S.init(T, D, gridDim.x, blockIdx.x);
        pg8::EpiBf16 E{(bf16_t*)(ws + WS_QP), D, 1 << 30}; pg8::gemm_phase(ldsl, g, S, E); });
    SEAM(8);
    RUNPH(9, { phase_peer_topk(p); });
    SEAM(9);
    RUNPH(10, { phase_experts(p, lds); });
#undef IN
#undef SEAM
}

#ifndef MK_N_LAUNCHES
#define MK_N_LAUNCHES 1
#endif
extern "C" void kernel_launch(void* const* d_in, const int* in_sizes, int n_in, void* d_out, int out_size, void* d_ws, size_t ws_size, hipStream_t stream) {
    static int grid = 0;
    if (grid == 0) {
        if (n_in != 17 || out_size != T * D || ws_size < WS_END) { fprintf(stderr, "kernel_launch: unexpected shapes (n_in %d out %d ws %zu)\n", n_in, out_size, ws_size); grid = -1; return; }
        int dev = 0, cus = 0, per_cu = 0;
        hipGetDevice(&dev); hipDeviceGetAttribute(&cus, hipDeviceAttributeMultiprocessorCount, dev);
        hipFuncSetAttribute((const void*)mega_fwd, hipFuncAttributeMaxDynamicSharedMemorySize, LDS_BYTES);
        hipOccupancyMaxActiveBlocksPerMultiprocessor(&per_cu, (const void*)mega_fwd, NTHREADS, LDS_BYTES);
        if (per_cu < 1) { fprintf(stderr, "kernel_launch: occupancy query says %d blocks/CU\n", per_cu); per_cu = 1; }
        (void)hipGetLastError();
        grid = cus * 1;
    }
    if (grid < 0) return;
    if (hipMemsetAsync((char*)d_ws + WS_CTL, 0, 65536, stream) != hipSuccess) { fprintf(stderr, "kernel_launch: memset failed\n"); return; }
    Params p{};
    for (int i = 0; i < 17; ++i) p.in[i] = (const float*)d_in[i];
    p.out = (float*)d_out; p.ws = (unsigned char*)d_ws;
#if MK_N_LAUNCHES == 1
    p.ph_lo = 0; p.ph_hi = NPHASES;
    void* args[] = {&p};
    hipError_t e = hipLaunchCooperativeKernel((const void*)mega_fwd, dim3(grid), dim3(NTHREADS), args, LDS_BYTES, stream);
    if (e != hipSuccess) fprintf(stderr, "cooperative launch failed: %s (grid %d)\n", hipGetErrorString(e), grid);
#else
    for (int k = 0; k < NPHASES; ++k) { p.ph_lo = k; p.ph_hi = k + 1; void* args[] = {&p};
        hipError_t e = hipLaunchCooperativeKernel((const void*)mega_fwd, dim3(grid), dim3(NTHREADS), args, LDS_BYTES, stream);
        if (e != hipSuccess) { fprintf(stderr, "launch %d failed: %s\n", k, hipGetErrorString(e)); break; } }
#endif
}
```

```cpp
#include <hip/hip_runtime.h>
#include <hip/hip_cooperative_groups.h>
#include <cstdio>
#include <cstdint>
namespace cg = cooperative_groups;

#define LAS __attribute__((address_space(3)))
typedef unsigned short bf16_t;
typedef short bf16x8 __attribute__((ext_vector_type(8)));
typedef short bf16x4 __attribute__((ext_vector_type(4)));
typedef float f32x2 __attribute__((ext_vector_type(2)));
typedef float f32x4 __attribute__((ext_vector_type(4)));
typedef float f32x16 __attribute__((ext_vector_type(16)));
typedef unsigned u32x2 __attribute__((ext_vector_type(2)));
typedef unsigned u32x4 __attribute__((ext_vector_type(4)));

constexpr int T = 16384, D = 2048, SEQ = 2048, NBATCH = 8, NP = 12544;
constexpr int C_QA = 0, C_KA = 1024, C_VA = 2048, C_QI = 3072, C_KI = 4096, C_WI = 4160, C_QB = 4352, C_FB = 5376, C_IB = 6400, C_GB = 7424, C_GA = 8448, C_GG = 10496;
constexpr int NADA = 12288;
constexpr float NORM_EPS = 1e-6f;
constexpr int NTHREADS = 512, NWAVES = 8;
constexpr int LDS_BYTES = 147456;
constexpr size_t MiB = 1u << 20;
constexpr size_t WS_CTL = 0, WS_MOD = 1 * MiB, WS_WUA = 2 * MiB, WS_WUB = 6 * MiB, WS_WOUT = 10 * MiB, WS_WQ = 18 * MiB, WS_KEYS = 26 * MiB, WS_MASK = 27 * MiB;
constexpr size_t WS_MIXED = 32 * MiB;
constexpr size_t WS_VT = 32 * MiB, WS_ORAW = 64 * MiB;
constexpr size_t WS_P = 96 * MiB;
constexpr size_t WS_H2 = 96 * MiB, WS_QP = 160 * MiB, WS_U8 = 224 * MiB, WS_V8 = 256 * MiB, WS_ISU = 290 * MiB, WS_ISV = 291 * MiB, WS_EIDX = 352 * MiB, WS_EGATE = 360 * MiB;
constexpr size_t WS_X1 = 368 * MiB;
constexpr size_t WS_END = 496 * MiB;
constexpr int LDP = 2048 + 64;
constexpr size_t OUT_H = 0, OUT_WIN = 68 * MiB;
constexpr size_t OUT_AO = 0, OUT_REC = 32 * MiB;

struct Params { const float* in[17]; float* out; unsigned char* ws; int ph_lo, ph_hi; };

__device__ __forceinline__ unsigned f2bf(float f) { unsigned u = __float_as_uint(f); return (u + 0x7fffu + ((u >> 16) & 1u)) >> 16; }
__device__ __forceinline__ float bf2f(unsigned b) { return __uint_as_float(b << 16); }
__device__ __forceinline__ float bflo(unsigned w) { return __uint_as_float(w << 16); }
__device__ __forceinline__ float bfhi(unsigned w) { return __uint_as_float(w & 0xffff0000u); }
__device__ __forceinline__ unsigned pk2(float lo, float hi) { unsigned r; asm volatile("v_cvt_pk_bf16_f32 %0, %1, %2" : "=v"(r) : "v"(lo), "v"(hi)); return r; }
__device__ __forceinline__ float wave_sum(float v) {
#pragma unroll
    for (int o = 1; o < 64; o <<= 1) v += __shfl_xor(v, o);
    return v;
}
__device__ __forceinline__ float sigmoidf_(float v) { return 1.f / (1.f + __expf(-v)); }
__device__ __forceinline__ float siluf_(float v) { return v / (1.f + __expf(-v)); }
#define LDS_WAIT() asm volatile("s_waitcnt lgkmcnt(0)" ::: "memory")

namespace pg8 {
constexpr int BM = 256, BK = 64, HALF = 128, HTB = HALF * BK * 2, STAGE_BYTES = 8 * HTB, NXCD = 8, WGM = 8;
__host__ __device__ __forceinline__ int lds_byte(int r, int c) { const int st = (r >> 4) * 2 + (c >> 5), rr = r & 15, cc = c & 31, ob = rr * 64 + cc * 2; return st * 1024 + (ob ^ (((ob >> 9) & 1) << 5)); }
__host__ __device__ __forceinline__ void stage_rc(int b, int& R, int& C) { const int st = b / 1024, sb = b % 1024, swz = sb ^ (((sb >> 9) & 1) << 5); R = (st >> 1) * 16 + swz / 64; C = (st & 1) * 32 + (swz % 64) / 2; }
__host__ __device__ __forceinline__ int perm32(int rho) { const int n = rho >> 4, i = rho & 15; return 8 * (i >> 2) + 4 * n + (i & 3); }

struct Unit { int pm, pn, z; };
struct Gemm { const bf16_t* A; const bf16_t* Bt; const bf16_t* A2; const bf16_t* Bt2; int lda, ldb, M, N, K; };

template <int NZ> struct StaticOrder {
    int nM, nN, nwg, G, c;
    __device__ void init(int M, int N, int G_, int c_) { nM = M / BM; nN = N / BM; nwg = nM * nN; G = G_; c = c_; }
    __device__ bool next(int i, Unit& u) const {
        const long L = (long)(i / NZ) * G + c; if (L >= nwg) return false;
        int wgid = (int)L; { const int q = nwg / NXCD, r = nwg % NXCD, xcd = wgid % NXCD, off = wgid / NXCD; wgid = (xcd < r ? xcd * (q + 1) : r * (q + 1) + (xcd - r) * q) + off; }
        const int nig = WGM * nN, gid = wgid / nig, fm = gid * WGM, gsz = (nM - fm) < WGM ? (nM - fm) : WGM;
        u.pm = fm + ((wgid % nig) % gsz); u.pn = (wgid % nig) / gsz; u.z = i % NZ; return true;
    }
};

template <class Epi, class Sched>
__device__ __forceinline__ void gemm_phase(LAS unsigned char* lds, const Gemm g, const Sched& S, const Epi& E) {
    const int tid = threadIdx.x, wid = __builtin_amdgcn_readfirstlane(tid >> 6), lane = tid & 63, wr = wid >> 2, wc = wid & 3, fr = lane & 15, fq = lane >> 4;
    const int K = g.K, nt = K / BK;
    unsigned voffA[2], voffB[2];
#pragma unroll
    for (int i = 0; i < 2; ++i) { int R, C; stage_rc(tid * 16 + i * 8192, R, C); const int Rb = Epi::PERM ? ((R & ~31) + perm32(R & 31)) : R;
        voffA[i] = (unsigned)(R * g.lda + C) * 2u; voffB[i] = (unsigned)(Rb * g.ldb + C) * 2u; }
    const size_t kstep = (size_t)(BK * 2);
    const size_t hstepA = (size_t)HALF * g.lda * 2, hstepB = (size_t)HALF * g.ldb * 2;
    const size_t tstepA = 2 * hstepA, tstepB = 2 * hstepB;
    const unsigned ldsw = (unsigned)wid * 1024u;
    const int aoff = lds_byte(wr * 64 + fr, fq * 8), boff = lds_byte(wc * 32 + fr, fq * 8);
#define PG8_SA(b, h) (((b) * 2 + (h)) * HTB)
#define PG8_SB(b, h) ((4 + (b) * 2 + (h)) * HTB)
#define PG8_STAGE(bufoff, gbase, voff) do { _Pragma("unroll") for (int _i = 0; _i < 2; ++_i) \
        __builtin_amdgcn_global_load_lds((const unsigned*)((const char*)(gbase) + (voff)[_i]), (LAS unsigned*)(lds + (bufoff) + ldsw + _i * 8192), 16, 0, 0); } while (0)
#define PG8_LDA(dst, b, h) do { _Pragma("unroll") for (int m = 0; m < 4; ++m) _Pragma("unroll") for (int k = 0; k < 2; ++k) dst[m][k] = *(const LAS bf16x8*)(lds + PG8_SA(b, h) + aoff + m * 2048 + k * 1024); } while (0)
#define PG8_LDB(dst, b, h) do { _Pragma("unroll") for (int n = 0; n < 2; ++n) _Pragma("unroll") for (int k = 0; k < 2; ++k) dst[n][k] = *(const LAS bf16x8*)(lds + PG8_SB(b, h) + boff + n * 2048 + k * 1024); } while (0)
#define PG8_MMA(ai, bj, At, Bt) do { __builtin_amdgcn_s_setprio(1); _Pragma("unroll") for (int m = 0; m < 4; ++m) _Pragma("unroll") for (int n = 0; n < 2; ++n) _Pragma("unroll") for (int k = 0; k < 2; ++k) \
        acc[ai][bj][m][n] = __builtin_amdgcn_mfma_f32_16x16x32_bf16(Bt[n][k], At[m][k], acc[ai][bj][m][n], 0, 0, 0); __builtin_amdgcn_s_setprio(0); } while (0)
#define PG8_WAIT_V(n) asm volatile("s_waitcnt vmcnt(" #n ")" ::: "memory")
#define PG8_WAIT_L(n) asm volatile("s_waitcnt lgkmcnt(" #n ")" ::: "memory")
#define PG8_BAR __builtin_amdgcn_s_barrier()
#define PG8_SCHED __builtin_amdgcn_sched_barrier(0)
#define PG8_ABASE(u) ((const char*)((u).z ? g.A2 : g.A) + (size_t)(u).pm * tstepA)
#define PG8_BBASE(u) ((const char*)((u).z ? g.Bt2 : g.Bt) + (size_t)(u).pn * tstepB)
    Unit cur, nxt; int ui = 0;
    if (!S.next(0, cur)) return;
    f32x4 acc[2][2][4][2];
#pragma unroll
    for (int a = 0; a < 2; ++a)
#pragma unroll
        for (int b = 0; b < 2; ++b)
#pragma unroll
            for (int m = 0; m < 4; ++m)
#pragma unroll
                for (int n = 0; n < 2; ++n) acc[a][b][m][n] = (f32x4){0.f, 0.f, 0.f, 0.f};
    bf16x8 At[4][2], B0[2][2], B1[2][2];
    const char* cA = PG8_ABASE(cur); const char* cB = PG8_BBASE(cur);
    PG8_STAGE(PG8_SB(0, 0), cB, voffB); PG8_STAGE(PG8_SA(0, 0), cA, voffA); PG8_STAGE(PG8_SB(0, 1), cB + hstepB, voffB); PG8_STAGE(PG8_SA(0, 1), cA + hstepA, voffA);
    if (wr == 1) PG8_BAR;
    PG8_WAIT_V(4); PG8_BAR;
    PG8_STAGE(PG8_SB(1, 0), cB + kstep, voffB); PG8_STAGE(PG8_SA(1, 0), cA + kstep, voffA); PG8_STAGE(PG8_SB(1, 1), cB + hstepB + kstep, voffB);
    PG8_WAIT_V(6); PG8_BAR;
    for (;;) {
        const bool has_next = S.next(ui + 1, nxt);
        const char* nA = has_next ? PG8_ABASE(nxt) : cA; const char* nB = has_next ? PG8_BBASE(nxt) : cB;
        for (int t = 0; t < nt; t += 2) {
            const bool last = (t == nt - 2);
            const char* a1 = cA + (size_t)(t + 1) * kstep;
            const char* a2 = last ? nA : cA + (size_t)(t + 2) * kstep; const char* b2 = last ? nB : cB + (size_t)(t + 2) * kstep;
            const char* a3 = a2 + kstep; const char* b3 = b2 + kstep;
            PG8_LDB(B0, 0, 0); PG8_SCHED; PG8_LDA(At, 0, 0); PG8_STAGE(PG8_SA(1, 1), a1 + hstepA, voffA);
            PG8_WAIT_L(8); PG8_BAR; PG8_WAIT_L(0); PG8_MMA(0, 0, At, B0); PG8_BAR; PG8_SCHED;
            PG8_LDB(B1, 0, 1); PG8_STAGE(PG8_SB(0, 0), b2, voffB);
            PG8_BAR; PG8_WAIT_L(0); PG8_MMA(0, 1, At, B1); PG8_BAR;
            PG8_LDA(At, 0, 1); PG8_STAGE(PG8_SA(0, 0), a2, voffA);
            PG8_BAR; PG8_WAIT_L(0); PG8_MMA(1, 0, At, B0); PG8_BAR; PG8_SCHED;
            PG8_STAGE(PG8_SB(0, 1), b2 + hstepB, voffB);
            PG8_WAIT_V(6); PG8_BAR; PG8_MMA(1, 1, At, B1); PG8_BAR;
            PG8_LDB(B0, 1, 0); PG8_SCHED; PG8_LDA(At, 1, 0); PG8_STAGE(PG8_SA(0, 1), a2 + hstepA, voffA);
            PG8_WAIT_L(8); PG8_BAR; PG8_WAIT_L(0); PG8_MMA(0, 0, At, B0); PG8_BAR; PG8_SCHED;
            PG8_LDB(B1, 1, 1); PG8_STAGE(PG8_SB(1, 0), b3, voffB);
            PG8_BAR; PG8_WAIT_L(0); PG8_MMA(0, 1, At, B1); PG8_BAR;
            PG8_LDA(At, 1, 1); PG8_STAGE(PG8_SA(1, 0), a3, voffA);
            PG8_BAR; PG8_WAIT_L(0); PG8_MMA(1, 0, At, B0); PG8_BAR; PG8_SCHED;
            PG8_STAGE(PG8_SB(1, 1), b3 + hstepB, voffB);
            PG8_WAIT_V(6); PG8_BAR; PG8_MMA(1, 1, At, B1); PG8_BAR;
        }
        E(acc, cur, wr, wc, fr, fq);
        if (!has_next) break;
#pragma unroll
        for (int a = 0; a < 2; ++a)
#pragma unroll
            for (int b = 0; b < 2; ++b)
#pragma unroll
                for (int m = 0; m < 4; ++m)
#pragma unroll
                    for (int n = 0; n < 2; ++n) acc[a][b][m][n] = (f32x4){0.f, 0.f, 0.f, 0.f};
        cur = nxt; cA = nA; cB = nB; ++ui;
    }
    PG8_WAIT_V(0);
    if (wr == 0) PG8_BAR;
    PG8_BAR;
#undef PG8_SA
#undef PG8_SB
#undef PG8_STAGE
#undef PG8_LDA
#undef PG8_LDB
#undef PG8_MMA
#undef PG8_WAIT_V
#undef PG8_WAIT_L
#undef PG8_BAR
#undef PG8_SCHED
#undef PG8_ABASE
#undef PG8_BBASE
}

struct EpiBf16 {
    static constexpr bool PERM = true;
    bf16_t* O; int ldc; int sig_from;
    __device__ __forceinline__ void operator()(const f32x4 (&acc)[2][2][4][2], const Unit& u, int wr, int wc, int fr, int fq) const {
        const int row0 = u.pm * BM + wr * 64 + fr, col0 = u.pn * BM + wc * 32 + 8 * fq; const bool sig = u.pn >= sig_from;
#pragma unroll
        for (int ai = 0; ai < 2; ++ai)
#pragma unroll
            for (int m = 0; m < 4; ++m) { bf16_t* rowp = O + (size_t)(row0 + ai * HALF + m * 16) * ldc + col0;
#pragma unroll
                for (int bj = 0; bj < 2; ++bj) { f32x4 v0 = acc[ai][bj][m][0], v1 = acc[ai][bj][m][1];
                    if (sig) {
#pragma unroll
                        for (int j = 0; j < 4; ++j) { v0[j] = sigmoidf_(v0[j]); v1[j] = sigmoidf_(v1[j]); } }
                    u32x4 w; w.x = pk2(v0[0], v0[1]); w.y = pk2(v0[2], v0[3]); w.z = pk2(v1[0], v1[1]); w.w = pk2(v1[2], v1[3]);
                    *(u32x4*)(rowp + bj * HALF) = w; } }
    }
};
struct EpiMix {
    static constexpr bool PERM = true;
    bf16_t* O; const bf16_t* P;
    __device__ __forceinline__ void operator()(const f32x4 (&acc)[2][2][4][2], const Unit& u, int wr, int wc, int fr, int fq) const {
        const int row0 = u.pm * BM + wr * 64 + fr, col0 = u.pn * BM + wc * 32 + 8 * fq; const int gcol = (u.z ? C_GG : C_GA);
#pragma unroll
        for (int ai = 0; ai < 2; ++ai)
#pragma unroll
            for (int m = 0; m < 4; ++m) { const size_t r = (size_t)(row0 + ai * HALF + m * 16);
#pragma unroll
                for (int bj = 0; bj < 2; ++bj) { const f32x4 v0 = acc[ai][bj][m][0], v1 = acc[ai][bj][m][1];
                    const u32x4 gw = *(const u32x4*)(P + r * NP + gcol + col0 + bj * HALF);
                    float o[8] = {v0[0] * bflo(gw.x), v0[1] * bfhi(gw.x), v0[2] * bflo(gw.y), v0[3] * bfhi(gw.y), v1[0] * bflo(gw.z), v1[1] * bfhi(gw.z), v1[2] * bflo(gw.w), v1[3] * bfhi(gw.w)};
                    bf16_t* op = O + r * D + col0 + bj * HALF;
                    if (u.z) { const u32x4 pw = *(const u32x4*)op; o[0] += bflo(pw.x); o[1] += bfhi(pw.x); o[2] += bflo(pw.y); o[3] += bfhi(pw.y); o[4] += bflo(pw.z); o[5] += bfhi(pw.z); o[6] += bflo(pw.w); o[7] += bfhi(pw.w); }
                    u32x4 w; w.x = pk2(o[0], o[1]); w.y = pk2(o[2], o[3]); w.z = pk2(o[4], o[5]); w.w = pk2(o[6], o[7]);
                    *(u32x4*)op = w; } }
    }
};
struct EpiX1 {
    static constexpr bool PERM = false;
    const float* x; float* out; const float* gate;
    __device__ __forceinline__ void operator()(const f32x4 (&acc)[2][2][4][2], const Unit& u, int wr, int wc, int fr, int fq) const {
        const int row0 = u.pm * BM + wr * 64 + fr, col0 = u.pn * BM + wc * 32 + 4 * fq; const int b = (u.pm * BM) >> 11;
        f32x4 gv[2][2];
#pragma unroll
        for (int bj = 0; bj < 2; ++bj)
#pragma unroll
            for (int n = 0; n < 2; ++n) gv[bj][n] = *(const f32x4*)(gate + (size_t)b * NADA + col0 + bj * HALF + n * 16);
#pragma unroll
        for (int ai = 0; ai < 2; ++ai)
#pragma unroll
            for (int m = 0; m < 4; ++m) { const size_t off = (size_t)(row0 + ai * HALF + m * 16) * D + col0;
#pragma unroll
                for (int bj = 0; bj < 2; ++bj)
#pragma unroll
                    for (int n = 0; n < 2; ++n) { const f32x4 xv = *(const f32x4*)(x + off + bj * HALF + n * 16);
                        *(f32x4*)(out + off + bj * HALF + n * 16) = xv + gv[bj][n] * acc[ai][bj][m][n]; } }
    }
};
}

__device__ __forceinline__ void phase_mod(const Params& p, unsigned char* lds) {
    float* sc = (float*)lds;
    float* red = (float*)(lds + 65536);
    const int tid = threadIdx.x, wave = tid >> 6, lane = tid & 63;
    const float* c = p.in[1]; const float* wada = p.in[2]; const float* bada = p.in[3];
    float* mod = (float*)(p.ws + WS_MOD);
    if ((int)blockIdx.x >= 192) return;
    for (int i = tid; i < NBATCH * D; i += NTHREADS) { const int b = i >> 11, k = i & 2047; sc[k * 8 + b] = siluf_(c[i]); }
    __syncthreads();
    const int cgp = tid & 15, rg = tid >> 4;
    for (int item = blockIdx.x; item < 192; item += gridDim.x) {
        const float* w = wada + item * 64 + cgp * 4;
        float acc[8][4];
#pragma unroll
        for (int b = 0; b < 8; ++b)
#pragma unroll
            for (int j = 0; j < 4; ++j) acc[b][j] = 0.f;
#pragma unroll 4
        for (int i = 0; i < 64; ++i) { const int k = rg + 32 * i; const f32x4 wv = *(const f32x4*)(w + (size_t)k * NADA);
            const f32x4 s0 = *(const f32x4*)(sc + k * 8), s1 = *(const f32x4*)(sc + k * 8 + 4);
#pragma unroll
            for (int j = 0; j < 4; ++j) { acc[0][j] += s0[0] * wv[j]; acc[1][j] += s0[1] * wv[j]; acc[2][j] += s0[2] * wv[j]; acc[3][j] += s0[3] * wv[j];
                acc[4][j] += s1[0] * wv[j]; acc[5][j] += s1[1] * wv[j]; acc[6][j] += s1[2] * wv[j]; acc[7][j] += s1[3] * wv[j]; } }
#pragma unroll
        for (int b = 0; b < 8; ++b)
#pragma unroll
            for (int j = 0; j < 4; ++j) { float v = acc[b][j]; v += __shfl_xor(v, 16); v += __shfl_xor(v, 32); acc[b][j] = v; }
        if (lane < 16) {
#pragma unroll
            for (int b = 0; b < 8; ++b)
#pragma unroll
                for (int j = 0; j < 4; ++j) red[(wave * 16 + cgp) * 32 + b * 4 + j] = acc[b][j]; }
        __syncthreads();
        { const int cgo = tid >> 5, b = (tid >> 2) & 7, j = tid & 3; float s = 0.f;
#pragma unroll
          for (int w8 = 0; w8 < 8; ++w8) s += red[(w8 * 16 + cgo) * 32 + (tid & 31)];
          const int col = item * 64 + cgo * 4 + j; mod[b * NADA + col] = s + bada[col]; }
        __syncthreads();
    }
}
__device__ __forceinline__ void transpose_item(const float* W, int K, int N, bf16_t* WT, int nblk, int item, int lane, float* scr, int mode, int pitch) {
    const int kb = item / nblk, nb = item % nblk, k0 = 64 * kb, n0 = 32 * nb;
    const int nd = n0 + (lane & 31); int ns = nd; bool valid = true;
    if (mode == 1) { if (nd >= C_QB) ns = nd - 176; else if (nd >= 4176) valid = false; }
#pragma unroll 8
    for (int i = 0; i < 32; ++i) { const int kk = 2 * i + (lane >> 5); scr[kk * 33 + (lane & 31)] = valid ? W[(size_t)(k0 + kk) * N + ns] : 0.f; }
    LDS_WAIT();
    const int c = lane & 7;
#pragma unroll
    for (int j = 0; j < 4; ++j) { const int n = (lane >> 3) + 8 * j; const float* s = scr + (8 * c) * 33 + n;
        u32x4 o; o.x = pk2(s[0 * 33], s[1 * 33]); o.y = pk2(s[2 * 33], s[3 * 33]); o.z = pk2(s[4 * 33], s[5 * 33]); o.w = pk2(s[6 * 33], s[7 * 33]);
        *(u32x4*)(WT + (size_t)(n0 + n) * pitch + k0 + 8 * c) = o; }
    LDS_WAIT();
}
__device__ __forceinline__ void phase_weights(const Params& p, unsigned char* lds) {
    const int tid = threadIdx.x, wave = tid >> 6, lane = tid & 63;
    float* scr = (float*)(lds + wave * 16384);
    const int vb = ((int)blockIdx.x + (int)gridDim.x - 192 % (int)gridDim.x) % (int)gridDim.x;
    const int gw = vb * NWAVES + wave, NGW = gridDim.x * NWAVES;
    constexpr int I_IN = 32 * (NP / 32), I_UA = 16 * 64, I_UB = 16 * 64, I_O = 32 * 64, I_Q = 32 * 64;
    constexpr int NITEMS = I_IN + I_UA + I_UB + I_O + I_Q;
    bf16_t* win_t = (bf16_t*)((unsigned char*)p.out + OUT_WIN);
    for (int it = gw; it < NITEMS; it += NGW) {
        int r = it;
        if (r < I_IN) { transpose_item(p.in[6], 2048, 12368, win_t, NP / 32, r, lane, scr, 1, LDP); continue; } r -= I_IN;
        if (r < I_UA) { transpose_item(p.in[9], 1024, 2048, (bf16_t*)(p.ws + WS_WUA), 64, r, lane, scr, 0, 1024); continue; } r -= I_UA;
        if (r < I_UB) { transpose_item(p.in[10], 1024, 2048, (bf16_t*)(p.ws + WS_WUB), 64, r, lane, scr, 0, 1024); continue; } r -= I_UB;
        if (r < I_O) { transpose_item(p.in[11], 2048, 2048, (bf16_t*)(p.ws + WS_WOUT), 64, r, lane, scr, 0, 2048); continue; } r -= I_O;
        transpose_item(p.in[12], 2048, 2048, (bf16_t*)(p.ws + WS_WQ), 64, r, lane, scr, 0, 2048);
    }
    { const float* ks = p.in[13]; bf16_t* kd = (bf16_t*)(p.ws + WS_KEYS);
      for (int i = (blockIdx.x * NTHREADS + tid) * 4; i < 8 * 2 * 128 * 128; i += gridDim.x * NTHREADS * 4) { const f32x4 v = *(const f32x4*)(ks + i); u32x2 o; o.x = pk2(v[0], v[1]); o.y = pk2(v[2], v[3]); *(u32x2*)(kd + i) = o; } }
}

__device__ __forceinline__ void phase_norm_rows(const float* src, const float* gain, const float* shift, const float* scale, bf16_t* dst, int pitch) {
    const int tid = threadIdx.x, wave = tid >> 6, lane = tid & 63;
    const int gw = blockIdx.x * NWAVES + wave, NGW = gridDim.x * NWAVES;
    for (int row = gw; row < T; row += NGW) {
        const int b = row >> 11; const f32x4* xr = (const f32x4*)(src + (size_t)row * D) + lane;
        f32x4 v[8]; float ss = 0.f;
#pragma unroll
        for (int j = 0; j < 8; ++j) { v[j] = xr[64 * j]; ss += (v[j][0] * v[j][0] + v[j][1] * v[j][1]) + (v[j][2] * v[j][2] + v[j][3] * v[j][3]); }
        const float rstd = rsqrtf(wave_sum(ss) * (1.f / D) + NORM_EPS);
        u32x2* o8 = (u32x2*)(dst + (size_t)row * pitch) + lane;
#pragma unroll
        for (int j = 0; j < 8; ++j) { const int col = 4 * (lane + 64 * j);
            const f32x4 g = *(const f32x4*)(gain + col), sh = *(const f32x4*)(shift + (size_t)b * NADA + col), sc = *(const f32x4*)(scale + (size_t)b * NADA + col);
            f32x4 h;
#pragma unroll
            for (int e = 0; e < 4; ++e) h[e] = v[j][e] * rstd * g[e] * (1.f + sc[e]) + sh[e];
            u32x2 w; w.x = pk2(h[0], h[1]); w.y = pk2(h[2], h[3]); o8[64 * j] = w; }
    }
}

__device__ __forceinline__ void phase_vt(const Params& p, unsigned char* lds, int vb, int vG) {
    const int tid = threadIdx.x, wave = tid >> 6, lane = tid & 63;
    bf16_t* tile = (bf16_t*)(lds + wave * 16384);
    const bf16_t* P = (const bf16_t*)(p.ws + WS_P); bf16_t* VT = (bf16_t*)(p.ws + WS_VT);
    const int gw = vb * NWAVES + wave, NGW = vG * NWAVES;
    for (int it = gw; it < 8 * 8 * 32 * 2; it += NGW) {
        const int dh = it & 1, kt = (it >> 1) & 31, h = (it >> 6) & 7, b = it >> 9;
        const int k0 = kt * 64, d0 = dh * 64;
#pragma unroll
        for (int i = 0; i < 8; ++i) { const int key = i * 8 + (lane >> 3), dc = lane & 7;
            const u32x4 v = *(const u32x4*)(P + (size_t)(b * SEQ + k0 + key) * NP + C_VA + h * 128 + d0 + dc * 8);
            bf16_t* t = tile + (dc * 8) * 72 + key;
            t[0 * 72] = (bf16_t)(v.x & 0xffff); t[1 * 72] = (bf16_t)(v.x >> 16); t[2 * 72] = (bf16_t)(v.y & 0xffff); t[3 * 72] = (bf16_t)(v.y >> 16);
            t[4 * 72] = (bf16_t)(v.z & 0xffff); t[5 * 72] = (bf16_t)(v.z >> 16); t[6 * 72] = (bf16_t)(v.w & 0xffff); t[7 * 72] = (bf16_t)(v.w >> 16); }
        LDS_WAIT();
#pragma unroll
        for (int i = 0; i < 8; ++i) { const int d = i * 8 + (lane >> 3), kc = lane & 7;
            const u32x4 v = *(const u32x4*)(tile + d * 72 + kc * 8);
            *(u32x4*)(VT + ((size_t)((b * 8 + h) * 128 + d0 + d)) * SEQ + k0 + kc * 8) = v; }
        LDS_WAIT();
    }
}

__device__ __forceinline__ unsigned ord_key(float s) { const unsigned u = __float_as_uint(s); return (u & 0x80000000u) ? ~u : (u | 0x80000000u); }
__device__ __forceinline__ int half_sum(int v) {
    v += __builtin_amdgcn_update_dpp(0, v, 0xB1, 0xF, 0xF, true);
    v += __builtin_amdgcn_update_dpp(0, v, 0x4E, 0xF, 0xF, true);
    v += __builtin_amdgcn_update_dpp(0, v, 0x141, 0xF, 0xF, true);
    v += __builtin_amdgcn_update_dpp(0, v, 0x140, 0xF, 0xF, true);
    v += __shfl_xor(v, 16);
    return v;
}
constexpr int IX_RS = 72, IX_STAGE = 32 * IX_RS * 2;
__device__ __forceinline__ void indexer_item(const Params& p, unsigned char* lds, int b, int c, int grp) {
    const int tid = threadIdx.x, w = __builtin_amdgcn_readfirstlane(tid >> 6), lane = tid & 63, r = lane & 31, hh = lane >> 5;
    const bf16_t* P = (const bf16_t*)(p.ws + WS_P); unsigned* MASK = (unsigned*)(p.ws + WS_MASK);
    const int pair = grp * 8 + w, q0 = b * SEQ + c * 64 + 2 * pair;
    bf16x8 af[4];
    { const int query = q0 + ((r >> 2) & 1), head = (r & 3) + 4 * (r >> 3);
      const bf16_t* qp = P + (size_t)query * NP + C_QI + head * 64 + 8 * hh;
#pragma unroll
      for (int ks = 0; ks < 4; ++ks) af[ks] = *(const bf16x8*)(qp + ks * 16); }
    float wv[16];
    { const u32x4 w0 = *(const u32x4*)(P + (size_t)(q0 + hh) * NP + C_WI), w1 = *(const u32x4*)(P + (size_t)(q0 + hh) * NP + C_WI + 8);
      wv[0] = bflo(w0.x); wv[1] = bfhi(w0.x); wv[2] = bflo(w0.y); wv[3] = bfhi(w0.y); wv[4] = bflo(w0.z); wv[5] = bfhi(w0.z); wv[6] = bflo(w0.w); wv[7] = bfhi(w0.w);
      wv[8] = bflo(w1.x); wv[9] = bfhi(w1.x); wv[10] = bflo(w1.y); wv[11] = bfhi(w1.y); wv[12] = bflo(w1.z); wv[13] = bfhi(w1.z); wv[14] = bflo(w1.w); wv[15] = bfhi(w1.w); }
    const int nkt = 2 * (c + 1);
    const bool ldr = tid < 256;
    const bf16_t* kg = P + (size_t)(b * SEQ + ((tid >> 3) & 31)) * NP + C_KI + (tid & 7) * 8;
    const int kls = ((tid >> 3) & 31) * IX_RS * 2 + (tid & 7) * 16;
    u32x4 kr = {0u, 0u, 0u, 0u};
    __syncthreads();
    if (ldr) { *(u32x4*)(lds + kls) = *(const u32x4*)kg; *(u32x4*)(lds + IX_STAGE + kls) = *(const u32x4*)(kg + (size_t)32 * NP); }
    if (ldr && 2 < nkt) kr = *(const u32x4*)(kg + (size_t)64 * NP);
    __syncthreads();
    unsigned kv[64];
#pragma unroll
    for (int kt = 0; kt < 64; ++kt) {
        kv[kt] = 0u;
        if (kt < nkt) {
            if (ldr && kt + 2 < nkt) *(u32x4*)(lds + ((kt + 2) % 3) * IX_STAGE + kls) = kr;
            if (ldr && kt + 3 < nkt) kr = *(const u32x4*)(kg + (size_t)((kt + 3) * 32) * NP);
            const bf16_t* Ks = (const bf16_t*)(lds + (kt % 3) * IX_STAGE);
            f32x16 acc;
#pragma unroll
            for (int i = 0; i < 16; ++i) acc[i] = 0.f;
#pragma unroll
            for (int ks = 0; ks < 4; ++ks) { const bf16x8 bfr = *(const bf16x8*)(Ks + r * IX_RS + ks * 16 + 8 * hh); acc = __builtin_amdgcn_mfma_f32_32x32x16_bf16(af[ks], bfr, acc, 0, 0, 0); }
            float sc = 0.f;
#pragma unroll
            for (int i = 0; i < 16; ++i) sc += wv[i] * fmaxf(acc[i], 0.f);
            kv[kt] = ord_key(sc);
            __syncthreads();
        }
    }
    unsigned thr = 0u;
    if (nkt > 8) {
        int cur = 1 << 20;
        for (int bit = 31; bit >= 0; --bit) {
            const unsigned cand = thr | (1u << bit); int cnt = 0;
#pragma unroll
            for (int kt = 0; kt < 32; ++kt) cnt += (kv[kt] >= cand) ? 1 : 0;
            if (nkt > 32) {
#pragma unroll
                for (int kt = 32; kt < 64; ++kt) cnt += (kv[kt] >= cand) ? 1 : 0; }
            cnt = half_sum(cnt);
            if (cnt >= 256) { thr = cand; cur = cnt; }
            if (__builtin_amdgcn_ballot_w64(cur != 256) == 0ull) break;
        }
    }
    int cge = 0;
#pragma unroll
    for (int kt = 0; kt < 64; ++kt) cge += (kv[kt] >= thr && kv[kt] != 0u) ? 1 : 0;
    cge = half_sum(cge);
    const bool ties = (thr != 0u) && (cge > 256);
    unsigned m0 = 0u, m1 = 0u;
    if (__builtin_amdgcn_ballot_w64(ties) == 0ull) {
#pragma unroll
        for (int kt = 0; kt < 64; ++kt) { const unsigned long long bm = __builtin_amdgcn_ballot_w64(kv[kt] >= thr && kv[kt] != 0u);
            if (lane == kt) { m0 = (unsigned)bm; m1 = (unsigned)(bm >> 32); } }
    } else {
        int cgt = 0;
#pragma unroll
        for (int kt = 0; kt < 64; ++kt) cgt += (kv[kt] > thr) ? 1 : 0;
        cgt = half_sum(cgt);
        const int need = ties ? (256 - cgt) : (1 << 30); int run = 0;
#pragma unroll
        for (int kt = 0; kt < 64; ++kt) { const bool tie = ties && (kv[kt] == thr); const unsigned long long tb = __builtin_amdgcn_ballot_w64(tie);
            const unsigned th = hh ? (unsigned)(tb >> 32) : (unsigned)tb; const int rank = run + __builtin_popcount(th & ((1u << r) - 1u));
            const bool sel = ties ? ((kv[kt] > thr) || (tie && rank < need)) : (kv[kt] >= thr && kv[kt] != 0u);
            run += __builtin_popcount(th);
            const unsigned long long bm = __builtin_amdgcn_ballot_w64(sel);
            if (lane == kt) { m0 = (unsigned)bm; m1 = (unsigned)(bm >> 32); } }
    }
    { const int qpos = c * 64 + 2 * pair; unsigned* mt = MASK + ((size_t)(b * 64 + lane)) * SEQ + qpos; mt[0] = m0; mt[1] = m1; }
}
__device__ __forceinline__ void phase_indexer(const Params& p, unsigned char* lds, int vb, int vG) {
    const int G = vG;
    for (int rd = 0;; ++rd) {
        const int base = rd * G; if (base >= 1024) break;
        const int pos = (rd & 1) ? (G - 1 - vb) : vb; const int i = base + pos; if (i >= 1024) continue;
        indexer_item(p, lds, (i >> 2) & 7, 31 - (i >> 5), i & 3);
    }
}

constexpr int HG_RS = 136, HG_TS = 72, HG_SS = 136;
constexpr int HG_QT = 0, HG_QH = 17408, HG_KT = 34816, HG_KHT = 52224, HG_VT = 70656, HG_ST = 89088, HG_DEC = 123904, HG_SSQ = 124416;
__device__ __forceinline__ void hgrn_item(const Params& p, unsigned char* lds, int item) {
    const int tid = threadIdx.x, w = tid >> 6, lane = tid & 63, r = lane & 31, hh = lane >> 5;
    const int b = item >> 3, h = item & 7;
    const bf16_t* P = (const bf16_t*)(p.ws + WS_P); bf16_t* REC = (bf16_t*)((unsigned char*)p.out + OUT_REC);
    bf16_t* QT = (bf16_t*)(lds + HG_QT); bf16_t* QH = (bf16_t*)(lds + HG_QH); bf16_t* KT = (bf16_t*)(lds + HG_KT); bf16_t* KHT = (bf16_t*)(lds + HG_KHT); bf16_t* VT = (bf16_t*)(lds + HG_VT);
    bf16_t* ST = (bf16_t*)(lds + HG_ST); float* DEC = (float*)(lds + HG_DEC); float* SSQ = (float*)(lds + HG_SSQ);
    const int seg = lane >> 4, dl = lane & 15, d = 16 * w + dl;
    const float lb = sigmoidf_(p.in[7][h * 128 + d] - p.in[7][1024 + h * 128 + d]);
    const int tb = w & 1, eb = w >> 1, sdb = w & 3, seb0 = 2 * (w >> 2);
    const float gain_e = p.in[8][32 * eb + r];
    f32x16 S0, S1;
#pragma unroll
    for (int i = 0; i < 16; ++i) { S0[i] = 0.f; S1[i] = 0.f; }
    __syncthreads();
    for (int i = tid; i < 128 * HG_SS / 2; i += NTHREADS) ((unsigned*)ST)[i] = 0u;
    unsigned short rq[16], rf[16], ri[16];
    { const bf16_t* src = P + (size_t)(b * SEQ + 16 * seg) * NP + h * 128 + d;
#pragma unroll
      for (int i = 0; i < 16; ++i) { rq[i] = src[(size_t)i * NP + C_QB]; rf[i] = src[(size_t)i * NP + C_FB]; ri[i] = src[(size_t)i * NP + C_IB]; } }
#pragma unroll 1
    for (int n = 0; n < 32; ++n) {
        {
            float lf[16], kk[16];
            float run = 0.f;
#pragma unroll
            for (int i = 0; i < 16; ++i) { const float f = lb + (1.f - lb) * sigmoidf_(bf2f(rf[i])); kk[i] = 1.f - f; run += __logf(f); lf[i] = run; }
            const float p0 = __shfl(run, dl), p1 = __shfl(run, 16 + dl), p2 = __shfl(run, 32 + dl), p3 = __shfl(run, 48 + dl);
            const float off = (seg > 0 ? p0 : 0.f) + (seg > 1 ? p1 : 0.f) + (seg > 2 ? p2 : 0.f), bL = (p0 + p1) + (p2 + p3), bref = p0 + p1;
            unsigned kh[8], vv[8];
#pragma unroll
            for (int i = 0; i < 16; ++i) { const float bt = off + lf[i]; const float qs = siluf_(bf2f(rq[i]));
                const float e1 = __expf(bt - bref), e2 = __expf(bt), e3 = __builtin_amdgcn_rcpf(e1), e4 = __expf(bL - bt);
                const int t = 16 * seg + i;
                QT[t * HG_RS + d] = (bf16_t)f2bf(qs * e1); QH[t * HG_RS + d] = (bf16_t)f2bf(qs * e2); KT[t * HG_RS + d] = (bf16_t)f2bf(kk[i] * e3);
                const unsigned khv = f2bf(kk[i] * e4);
                if (i & 1) { kh[i >> 1] |= khv << 16; vv[i >> 1] |= (unsigned)ri[i] << 16; } else { kh[i >> 1] = khv; vv[i >> 1] = (unsigned)ri[i]; } }
            *(u32x4*)(KHT + d * HG_TS + 16 * seg) = (u32x4){kh[0], kh[1], kh[2], kh[3]}; *(u32x4*)(KHT + d * HG_TS + 16 * seg + 8) = (u32x4){kh[4], kh[5], kh[6], kh[7]};
            *(u32x4*)(VT + d * HG_TS + 16 * seg) = (u32x4){vv[0], vv[1], vv[2], vv[3]}; *(u32x4*)(VT + d * HG_TS + 16 * seg + 8) = (u32x4){vv[4], vv[5], vv[6], vv[7]};
            if (seg == 0) DEC[d] = __expf(bL);
        }
        __syncthreads();
        if (n < 31) { const bf16_t* src = P + (size_t)(b * SEQ + (n + 1) * 64 + 16 * seg) * NP + h * 128 + d;
#pragma unroll
            for (int i = 0; i < 16; ++i) { rq[i] = src[(size_t)i * NP + C_QB]; rf[i] = src[(size_t)i * NP + C_FB]; ri[i] = src[(size_t)i * NP + C_IB]; } }
        unsigned short gbv[16];
        { const bf16_t* gsrc = P + (size_t)(b * SEQ + n * 64 + 32 * tb + 4 * hh) * NP + C_GB + h * 128 + 32 * eb + r;
#pragma unroll
          for (int i = 0; i < 16; ++i) gbv[i] = gsrc[(size_t)((i & 3) + 8 * (i >> 2)) * NP]; }
        f32x16 X0, X1, o;
#pragma unroll
        for (int i = 0; i < 16; ++i) { X0[i] = 0.f; X1[i] = 0.f; o[i] = 0.f; }
#pragma unroll
        for (int ks = 0; ks < 8; ++ks) { const bf16x8 bq = *(const bf16x8*)(QT + (32 * tb + r) * HG_RS + 16 * ks + 8 * hh);
            const bf16x8 a0 = *(const bf16x8*)(KT + r * HG_RS + 16 * ks + 8 * hh); X0 = __builtin_amdgcn_mfma_f32_32x32x16_bf16(a0, bq, X0, 0, 0, 0);
            if (tb == 1) { const bf16x8 a1 = *(const bf16x8*)(KT + (32 + r) * HG_RS + 16 * ks + 8 * hh); X1 = __builtin_amdgcn_mfma_f32_32x32x16_bf16(a1, bq, X1, 0, 0, 0); } }
#pragma unroll
        for (int i = 0; i < 16; ++i) { const bool keep = ((i & 3) + 8 * (i >> 2) + 4 * hh) <= r; if (tb == 0) X0[i] = keep ? X0[i] : 0.f; else X1[i] = keep ? X1[i] : 0.f; }
#pragma unroll
        for (int sb = 0; sb < 2; ++sb) { if (sb <= tb) {
#pragma unroll
            for (int s2 = 0; s2 < 2; ++s2) { u32x4 aw;
                if (sb == 0) { aw.x = pk2(X0[8 * s2], X0[8 * s2 + 1]); aw.y = pk2(X0[8 * s2 + 2], X0[8 * s2 + 3]); aw.z = pk2(X0[8 * s2 + 4], X0[8 * s2 + 5]); aw.w = pk2(X0[8 * s2 + 6], X0[8 * s2 + 7]); }
                else { aw.x = pk2(X1[8 * s2], X1[8 * s2 + 1]); aw.y = pk2(X1[8 * s2 + 2], X1[8 * s2 + 3]); aw.z = pk2(X1[8 * s2 + 4], X1[8 * s2 + 5]); aw.w = pk2(X1[8 * s2 + 6], X1[8 * s2 + 7]); }
                const bf16_t* vp = VT + (32 * eb + r) * HG_TS + 32 * sb + 16 * s2 + 4 * hh;
                const u32x2 lo = *(const u32x2*)vp, hi = *(const u32x2*)(vp + 8); const u32x4 bw = {lo.x, lo.y, hi.x, hi.y};
                o = __builtin_amdgcn_mfma_f32_32x32x16_bf16(__builtin_bit_cast(bf16x8, aw), __builtin_bit_cast(bf16x8, bw), o, 0, 0, 0); } } }
#pragma unroll
        for (int ks = 0; ks < 8; ++ks) { const bf16x8 aq = *(const bf16x8*)(QH + (32 * tb + r) * HG_RS + 16 * ks + 8 * hh), bs = *(const bf16x8*)(ST + (32 * eb + r) * HG_SS + 16 * ks + 8 * hh);
            o = __builtin_amdgcn_mfma_f32_32x32x16_bf16(aq, bs, o, 0, 0, 0); }
        { float a8[8], a4[4], a2[2], a1;
#pragma unroll
          for (int i = 0; i < 8; ++i) { const float lo = o[i] * o[i], hi = o[i + 8] * o[i + 8]; const bool up = lane & 16; const float keep = up ? hi : lo, send = up ? lo : hi; a8[i] = keep + __shfl_xor(send, 16); }
#pragma unroll
          for (int i = 0; i < 4; ++i) { const bool up = lane & 8; const float keep = up ? a8[i + 4] : a8[i], send = up ? a8[i] : a8[i + 4]; a4[i] = keep + __shfl_xor(send, 8); }
#pragma unroll
          for (int i = 0; i < 2; ++i) { const bool up = lane & 4; const float keep = up ? a4[i + 2] : a4[i], send = up ? a4[i] : a4[i + 2]; a2[i] = keep + __shfl_xor(send, 4); }
          { const bool up = lane & 2; const float keep = up ? a2[1] : a2[0], send = up ? a2[0] : a2[1]; a1 = keep + __shfl_xor(send, 2); }
          a1 += __shfl_xor(a1, 1);
          const int ri2 = (lane >> 1) & 15;
          if ((lane & 1) == 0) SSQ[(32 * tb + (ri2 & 3) + 8 * (ri2 >> 2) + 4 * hh) * 4 + eb] = a1; }
        { float dc[16];
#pragma unroll
          for (int g4 = 0; g4 < 4; ++g4) { const f32x4 dv = *(const f32x4*)(DEC + 32 * sdb + 8 * g4 + 4 * hh); dc[4 * g4] = dv[0]; dc[4 * g4 + 1] = dv[1]; dc[4 * g4 + 2] = dv[2]; dc[4 * g4 + 3] = dv[3]; }
#pragma unroll
          for (int i = 0; i < 16; ++i) { S0[i] *= dc[i]; S1[i] *= dc[i]; }
#pragma unroll
          for (int ss = 0; ss < 4; ++ss) { const bf16x8 a = *(const bf16x8*)(KHT + (32 * sdb + r) * HG_TS + 16 * ss + 8 * hh);
              const bf16x8 b0 = *(const bf16x8*)(VT + (32 * seb0 + r) * HG_TS + 16 * ss + 8 * hh), b1 = *(const bf16x8*)(VT + (32 * (seb0 + 1) + r) * HG_TS + 16 * ss + 8 * hh);
              S0 = __builtin_amdgcn_mfma_f32_32x32x16_bf16(a, b0, S0, 0, 0, 0); S1 = __builtin_amdgcn_mfma_f32_32x32x16_bf16(a, b1, S1, 0, 0, 0); } }
        __syncthreads();
#pragma unroll
        for (int g4 = 0; g4 < 4; ++g4) { const int d0 = 32 * sdb + 8 * g4 + 4 * hh;
            *(u32x2*)(ST + (32 * seb0 + r) * HG_SS + d0) = (u32x2){pk2(S0[4 * g4], S0[4 * g4 + 1]), pk2(S0[4 * g4 + 2], S0[4 * g4 + 3])};
            *(u32x2*)(ST + (32 * (seb0 + 1) + r) * HG_SS + d0) = (u32x2){pk2(S1[4 * g4], S1[4 * g4 + 1]), pk2(S1[4 * g4 + 2], S1[4 * g4 + 3])}; }
        { bf16_t* dst = REC + (size_t)(b * SEQ + n * 64 + 32 * tb + 4 * hh) * 1024 + h * 128 + 32 * eb + r;
#pragma unroll
          for (int i = 0; i < 16; ++i) { const int tr = (i & 3) + 8 * (i >> 2); const f32x4 q4 = *(const f32x4*)(SSQ + (32 * tb + tr + 4 * hh) * 4);
              const float rstd = rsqrtf(((q4[0] + q4[1]) + (q4[2] + q4[3])) * (1.f / 128.f) + NORM_EPS);
              dst[(size_t)tr * 1024] = (bf16_t)f2bf(o[i] * rstd * gain_e * siluf_(bf2f(gbv[i]))); } }
    }
}
__device__ __forceinline__ void phase_hgrn(const Params& p, unsigned char* lds, int vb, int vG) {
    for (int it = vb; it < 64; it += vG) hgrn_item(p, lds, it);
}

constexpr int AT_KRS = 136, AT_VRS = 36, AT_KB = 32 * AT_KRS * 2, AT_VB = 128 * AT_VRS * 2, AT_STAGE = AT_KB + AT_VB;
__device__ __forceinline__ void attn_item(const Params& p, unsigned char* lds, int b, int head, int cq) {
    const int tid = threadIdx.x, w = __builtin_amdgcn_readfirstlane(tid >> 6), lane = tid & 63, r = lane & 31, hh = lane >> 5;
    const bf16_t* P = (const bf16_t*)(p.ws + WS_P); const bf16_t* VT = (const bf16_t*)(p.ws + WS_VT); const unsigned* MASKT = (const unsigned*)(p.ws + WS_MASK);
    bf16_t* AO = (bf16_t*)((unsigned char*)p.out + OUT_AO);
    const int c = 4 * cq + (w >> 1), qpos = c * 64 + (w & 1) * 32 + r, tq = b * SEQ + qpos;
    const int nkt_w = 2 * (c + 1), nkt = 8 * (cq + 1);
    const bf16_t* kg = P + (size_t)(b * SEQ + (tid >> 4)) * NP + C_KA + head * 128 + (tid & 15) * 8;
    const bf16_t* vg = VT + (size_t)((b * 8 + head) * 128 + (tid >> 2)) * SEQ + (tid & 3) * 8;
    const int kls = (tid >> 4) * AT_KRS * 2 + (tid & 15) * 16, vls = AT_KB + (tid >> 2) * AT_VRS * 2 + (tid & 3) * 16;
    bf16x8 qf[8];
    { const bf16_t* qp = P + (size_t)tq * NP + C_QA + head * 128 + 8 * hh;
#pragma unroll
      for (int ks = 0; ks < 8; ++ks) qf[ks] = *(const bf16x8*)(qp + ks * 16); }
    f32x16 o[4];
#pragma unroll
    for (int db = 0; db < 4; ++db)
#pragma unroll
        for (int i = 0; i < 16; ++i) o[db][i] = 0.f;
    float mrun = -1e30f, lsum = 0.f;
    const float sc = 0.08838834764831845f * 1.4426950408889634f;
    __syncthreads();
    u32x4 krA, vrA, krB, vrB;
#pragma unroll
    for (int t0 = 0; t0 < 2; ++t0) { krA = *(const u32x4*)(kg + (size_t)(t0 * 32) * NP); vrA = *(const u32x4*)(vg + t0 * 32);
        *(u32x4*)(lds + t0 * AT_STAGE + kls) = krA; *(u32x2*)(lds + t0 * AT_STAGE + vls) = (u32x2){vrA.x, vrA.y}; *(u32x2*)(lds + t0 * AT_STAGE + vls + 8) = (u32x2){vrA.z, vrA.w}; }
    krA = *(const u32x4*)(kg + (size_t)(2 * 32) * NP); vrA = *(const u32x4*)(vg + 2 * 32);
    krB = *(const u32x4*)(kg + (size_t)(3 * 32) * NP); vrB = *(const u32x4*)(vg + 3 * 32);
    unsigned mwA = MASKT[(size_t)(b * 64) * SEQ + qpos], mwB = MASKT[(size_t)(b * 64 + 1) * SEQ + qpos];
    __syncthreads();
    int st = 0, st2 = 2;
#define AT_TILE(KT, KR, VR, MW) do { const int kt_ = (KT); \
        if (kt_ + 2 < nkt) { *(u32x4*)(lds + st2 * AT_STAGE + kls) = KR; *(u32x2*)(lds + st2 * AT_STAGE + vls) = (u32x2){VR.x, VR.y}; *(u32x2*)(lds + st2 * AT_STAGE + vls + 8) = (u32x2){VR.z, VR.w}; } \
        if (kt_ + 4 < nkt) { KR = *(const u32x4*)(kg + (size_t)((kt_ + 4) * 32) * NP); VR = *(const u32x4*)(vg + (kt_ + 4) * 32); } \
        if (kt_ < nkt_w) { \
            const unsigned mwc = MW; \
            if (kt_ + 2 < nkt_w) MW = MASKT[(size_t)(b * 64 + kt_ + 2) * SEQ + qpos]; \
            const bf16_t* Ks = (const bf16_t*)(lds + st * AT_STAGE); const bf16_t* Vs = (const bf16_t*)(lds + st * AT_STAGE + AT_KB); \
            f32x16 s; \
            _Pragma("unroll") for (int i = 0; i < 16; ++i) s[i] = 0.f; \
            _Pragma("unroll") for (int ks = 0; ks < 8; ++ks) { const bf16x8 kf = *(const bf16x8*)(Ks + r * AT_KRS + ks * 16 + 8 * hh); s = __builtin_amdgcn_mfma_f32_32x32x16_bf16(kf, qf[ks], s, 0, 0, 0); } \
            float mx = -1e30f; \
            _Pragma("unroll") for (int i = 0; i < 16; ++i) { const int bit = (i & 3) + 8 * (i >> 2) + 4 * hh; const bool ok = (mwc >> bit) & 1u; s[i] = ok ? s[i] * sc : -1e30f; mx = fmaxf(mx, s[i]); } \
            mx = fmaxf(mx, __shfl_xor(mx, 32)); \
            const float mnew = fmaxf(mrun, mx), alpha = exp2f(mrun - mnew); mrun = mnew; \
            float ps = 0.f; float pv[16]; \
            _Pragma("unroll") for (int i = 0; i < 16; ++i) { const float e = (s[i] > -1e29f) ? exp2f(s[i] - mnew) : 0.f; pv[i] = e; ps += e; } \
            lsum = lsum * alpha + ps; \
            _Pragma("unroll") for (int db = 0; db < 4; ++db) _Pragma("unroll") for (int i = 0; i < 16; ++i) o[db][i] *= alpha; \
            bf16x8 pf[2]; \
            _Pragma("unroll") for (int s2 = 0; s2 < 2; ++s2) { u32x4 wv; wv.x = pk2(pv[8 * s2 + 0], pv[8 * s2 + 1]); wv.y = pk2(pv[8 * s2 + 2], pv[8 * s2 + 3]); wv.z = pk2(pv[8 * s2 + 4], pv[8 * s2 + 5]); wv.w = pk2(pv[8 * s2 + 6], pv[8 * s2 + 7]); pf[s2] = __builtin_bit_cast(bf16x8, wv); } \
            _Pragma("unroll") for (int db = 0; db < 4; ++db) _Pragma("unroll") for (int s2 = 0; s2 < 2; ++s2) { const bf16_t* vp = Vs + (db * 32 + r) * AT_VRS + 16 * s2 + 4 * hh; const u32x2 lo = *(const u32x2*)vp, hi = *(const u32x2*)(vp + 8); \
                    const u32x4 wv = {lo.x, lo.y, hi.x, hi.y}; \
                    o[db] = __builtin_amdgcn_mfma_f32_32x32x16_bf16(__builtin_bit_cast(bf16x8, wv), pf[s2], o[db], 0, 0, 0); } \
        } \
        __syncthreads(); \
        st = (st == 2) ? 0 : st + 1; st2 = (st2 == 2) ? 0 : st2 + 1; } while (0)
#pragma unroll 1
    for (int kt = 0; kt < nkt; kt += 2) { AT_TILE(kt, krA, vrA, mwA); AT_TILE(kt + 1, krB, vrB, mwB); }
#undef AT_TILE
    const float l = lsum + __shfl_xor(lsum, 32), inv = 1.f / l;
    bf16_t* op = AO + (size_t)tq * 1024 + head * 128 + 4 * hh;
#pragma unroll
    for (int db = 0; db < 4; ++db)
#pragma unroll
        for (int g4 = 0; g4 < 4; ++g4) { u32x2 wv; wv.x = pk2(o[db][4 * g4] * inv, o[db][4 * g4 + 1] * inv); wv.y = pk2(o[db][4 * g4 + 2] * inv, o[db][4 * g4 + 3] * inv);
            *(u32x2*)(op + db * 32 + 8 * g4) = wv; }
}
__device__ __forceinline__ void phase_attn(const Params& p, unsigned char* lds, int vb, int vG) {
    const int G = vG;
    for (int rd = 0;; ++rd) {
        const int base = rd * G; if (base >= 512) break;
        const int pos = (rd & 1) ? (G - 1 - vb) : vb; const int i = base + pos; if (i >= 512) continue;
        attn_item(p, lds, (i >> 3) & 7, i & 7, 7 - (i >> 6));
    }
}
__device__ __forceinline__ void phase_uv(const Params& p) {
    const int tid = threadIdx.x, wave = tid >> 6, lane = tid & 63;
    const int gw = blockIdx.x * NWAVES + wave, NGW = gridDim.x * NWAVES;
    for (int it = gw; it < 2 * 16384; it += NGW) {
        const int tbl = it >> 14, row = it & 16383;
        const float* src = (tbl ? p.in[15] : p.in[14]) + (size_t)row * 2048 + 32 * lane;
        unsigned char* dst = p.ws + (tbl ? WS_V8 : WS_U8); float* isc = (float*)(p.ws + (tbl ? WS_ISV : WS_ISU));
        f32x4 v[8]; float am = 0.f;
#pragma unroll
        for (int j = 0; j < 8; ++j) { v[j] = *(const f32x4*)(src + 4 * j); am = fmaxf(am, fmaxf(fmaxf(fabsf(v[j][0]), fabsf(v[j][1])), fmaxf(fabsf(v[j][2]), fabsf(v[j][3])))); }
#pragma unroll
        for (int o = 1; o < 64; o <<= 1) am = fmaxf(am, __shfl_xor(am, o));
        am = fmaxf(am, 1e-30f); const float sc = 256.f / am;
        unsigned wq[8];
#pragma unroll
        for (int j = 0; j < 8; ++j) { int pk = 0; pk = __builtin_amdgcn_cvt_pk_fp8_f32(v[j][0] * sc, v[j][1] * sc, pk, false); pk = __builtin_amdgcn_cvt_pk_fp8_f32(v[j][2] * sc, v[j][3] * sc, pk, true); wq[j] = (unsigned)pk; }
        unsigned char* d = dst + (size_t)(lane >> 2) * (2u << 20) + (size_t)row * 128 + (lane & 3) * 32;
        *(u32x4*)d = (u32x4){wq[0], wq[1], wq[2], wq[3]}; *(u32x4*)(d + 16) = (u32x4){wq[4], wq[5], wq[6], wq[7]};
        if (lane == 0) isc[row] = am * (1.f / 256.f);
    }
}

#define INS16(v, x) do { _Pragma("unroll") for (int _j = 15; _j >= 1; --_j) v[_j] = __builtin_amdgcn_fmed3f(v[_j - 1], v[_j], (x)); v[0] = fmaxf(v[0], (x)); } while (0)
__device__ __forceinline__ void peer_half_top16(const bf16_t* QP, const bf16_t* KEYS, int tok, int p, int hf, int r, int hh, float (&v)[16]) {
    bf16x8 qf[8];
    { const bf16_t* qp = QP + (size_t)tok * D + p * 256 + hf * 128 + 8 * hh;
#pragma unroll
      for (int ks = 0; ks < 8; ++ks) qf[ks] = *(const bf16x8*)(qp + ks * 16); }
#pragma unroll
    for (int k = 0; k < 16; ++k) v[k] = -3.0e38f;
    const bf16_t* kb = KEYS + (size_t)((p * 2 + hf) * 128 + r) * 128 + 8 * hh;
#pragma unroll 1
    for (int nb = 0; nb < 4; ++nb) {
        f32x16 acc;
#pragma unroll
        for (int i = 0; i < 16; ++i) acc[i] = 0.f;
#pragma unroll
        for (int ks = 0; ks < 8; ++ks) { const bf16x8 kf = *(const bf16x8*)(kb + (size_t)(nb * 32) * 128 + ks * 16); acc = __builtin_amdgcn_mfma_f32_32x32x16_bf16(kf, qf[ks], acc, 0, 0, 0); }
#pragma unroll
        for (int i = 0; i < 16; ++i) { const unsigned xi = (unsigned)(nb * 32 + (i & 3) + 8 * (i >> 2) + 4 * hh); const float x = __uint_as_float((__float_as_uint(acc[i]) & ~0x7fu) | xi); INS16(v, x); }
    }
    float ov[16];
#pragma unroll
    for (int k = 0; k < 16; ++k) ov[k] = __shfl_xor(v[k], 32);
#pragma unroll
    for (int k = 0; k < 16; ++k) INS16(v, ov[k]);
}
__device__ __forceinline__ void phase_peer_topk(const Params& p) {
    const int tid = threadIdx.x, wave = tid >> 6, lane = tid & 63, r = lane & 31, hh = lane >> 5;
    const bf16_t* QP = (const bf16_t*)(p.ws + WS_QP); const bf16_t* KEYS = (const bf16_t*)(p.ws + WS_KEYS);
    int* EIDX = (int*)(p.ws + WS_EIDX); float* EGATE = (float*)(p.ws + WS_EGATE);
    const int gw = blockIdx.x * NWAVES + wave, NGW = gridDim.x * NWAVES;
    for (int it = gw; it < 512 * 8; it += NGW) {
        const int tg = it >> 3, hd = it & 7, tok = tg * 32 + r;
        float va[16], vb[16];
        peer_half_top16(QP, KEYS, tok, hd, 0, r, hh, va);
        peer_half_top16(QP, KEYS, tok, hd, 1, r, hh, vb);
        float bv[16];
#pragma unroll
        for (int k = 0; k < 16; ++k) bv[k] = -3.0e38f;
#pragma unroll
        for (int a = 0; a < 16; ++a)
#pragma unroll
            for (int b2 = 0; b2 < 16; ++b2) if ((a + 1) * (b2 + 1) <= 16) { const float x = va[a] + vb[b2]; INS16(bv, x); }
        float se = 0.f;
#pragma unroll
        for (int k = 0; k < 16; ++k) se += __expf(bv[k] - bv[0]);
        const float inv = 1.f / se, thr = bv[15], top = bv[0];
        int cnt = 0; int* ei = EIDX + (size_t)tok * 128 + hd * 16; float* eg = EGATE + (size_t)tok * 128 + hd * 16;
#pragma unroll
        for (int a = 0; a < 16; ++a)
#pragma unroll
            for (int b2 = 0; b2 < 16; ++b2) if ((a + 1) * (b2 + 1) <= 16) { const float x = va[a] + vb[b2];
                if (x >= thr && cnt < 16) { if (hh == 0) { ei[cnt] = (int)((__float_as_uint(va[a]) & 0x7fu) * 128u + (__float_as_uint(vb[b2]) & 0x7fu)); eg[cnt] = __expf(x - top) * inv; } ++cnt; } }
    }
}

typedef __bf16 bf16x2_t __attribute__((ext_vector_type(2)));
__device__ __forceinline__ float gelu_erf(float v) {
    const float av = fabsf(v), d = av * 0.2316418882f + 1.0f, t = __builtin_amdgcn_rcpf(d);
    float q = t * 0.5307027145f + (-0.7265760135f); q = q * t + 0.7107068705f; q = q * t + (-0.142248368f); q = q * t + 0.127414796f; q = q * t;
    const float e = __builtin_amdgcn_exp2f((v * v) * (-0.72134752044f));
    const float m = v * (q * e), r = v - m;
    return v < 0.f ? m : r;
}
__device__ __forceinline__ float dot2bf(unsigned a, unsigned b, float c) { return __builtin_amdgcn_fdot2_f32_bf16(__builtin_bit_cast(bf16x2_t, a), __builtin_bit_cast(bf16x2_t, b), c, false); }
__device__ __forceinline__ float dpp_f(float x, int ctrl_xor1_xor2_mirror) {
    const int v = __float_as_int(x);
    if (ctrl_xor1_xor2_mirror == 0) return __int_as_float(__builtin_amdgcn_update_dpp(0, v, 0xB1, 0xF, 0xF, true));
    if (ctrl_xor1_xor2_mirror == 1) return __int_as_float(__builtin_amdgcn_update_dpp(0, v, 0x4E, 0xF, 0xF, true));
    return __int_as_float(__builtin_amdgcn_update_dpp(0, v, 0x141, 0xF, 0xF, true));
}
typedef float f32x2v __attribute__((ext_vector_type(2)));
__device__ __forceinline__ void unpack8(const u32x4 w, float* f) { f[0] = bflo(w.x); f[1] = bfhi(w.x); f[2] = bflo(w.y); f[3] = bfhi(w.y); f[4] = bflo(w.z); f[5] = bfhi(w.z); f[6] = bflo(w.w); f[7] = bfhi(w.w); }
__device__ __forceinline__ void cvt16(const u32x4 w, float* f) {
#pragma unroll
    for (int q = 0; q < 4; ++q) { const f32x2v lo = __builtin_amdgcn_cvt_pk_f32_fp8((int)w[q], false), hi = __builtin_amdgcn_cvt_pk_f32_fp8((int)w[q], true);
        f[4 * q] = lo.x; f[4 * q + 1] = lo.y; f[4 * q + 2] = hi.x; f[4 * q + 3] = hi.y; }
}
__device__ __forceinline__ void phase_experts(const Params& p, unsigned char* lds) {
    const int tid = threadIdx.x, wave = __builtin_amdgcn_readfirstlane(tid >> 6), lane = tid & 63, rr = lane >> 3, cc = lane & 7; const bool odd = cc & 1;
    const bf16_t* H2 = (const bf16_t*)(p.ws + WS_H2); const unsigned char* U8 = p.ws + WS_U8; const unsigned char* V8 = p.ws + WS_V8;
    const float* ISU = (const float*)(p.ws + WS_ISU); const float* ISV = (const float*)(p.ws + WS_ISV);
    const int* EIDX = (const int*)(p.ws + WS_EIDX); const float* EGATE = (const float*)(p.ws + WS_EGATE);
    const float* mod = (const float*)(p.ws + WS_MOD); const float* fin = p.in[16]; float* out = p.out; const float* X1 = (const float*)(p.ws + WS_X1);
    unsigned* offs = (unsigned*)lds; float* gts = (float*)(lds + 32768); float* rstl = (float*)(lds + 65536);
    const unsigned xcc = (unsigned)__builtin_amdgcn_s_getreg((3 << 11) | 20) & 7u; const unsigned cc16 = cc * 16;
    for (int tile = blockIdx.x; tile < T / 64; tile += gridDim.x) {
        const int tok0 = tile * 64, b = tok0 >> 11;
        __syncthreads();
        for (int i = tid; i < 8192; i += NTHREADS) { const int tl = i >> 7, j = i & 127, g = j >> 3, r8 = j & 7;
            offs[(tl * 8 + r8) * 16 + g] = (unsigned)EIDX[(size_t)tok0 * 128 + i] * 128u; gts[(tl * 8 + r8) * 16 + g] = EGATE[(size_t)tok0 * 128 + i]; }
        __syncthreads();
#pragma unroll 1
        for (int half = 0; half < 2; ++half) {
            const int tlb = wave * 8 + half * 4;
            u32x4 dA[16], dB[16], hA0, hA1, hB0, hB1;
#ifndef EXP_REP_U
#define EXP_REP_U 0
#endif
#ifndef EXP_REP_V
#define EXP_REP_V 0
#endif
#define EX_SLICE(i_) ((xcc * 2u + (unsigned)(i_)) & 15u)
#define EX_LOAD(buf, TBL, i_, k_) do { const unsigned char* tb_ = (TBL) + (size_t)EX_SLICE(i_) * (2u << 20); u32x4 o4_[4]; \
    _Pragma("unroll") for (int q_ = 0; q_ < 4; ++q_) o4_[q_] = *(const u32x4*)(offs + ((tlb + (k_)) * 8 + rr) * 16 + 4 * q_); \
    _Pragma("unroll") for (int g_ = 0; g_ < 16; ++g_) buf[g_] = *(const u32x4*)(tb_ + (o4_[g_ >> 2][g_ & 3] + cc16)); } while (0)
#define EX_LOADH(h0, h1, i_, k_) do { const bf16_t* hp_ = H2 + (size_t)(tok0 + tlb + (k_)) * D + EX_SLICE(i_) * 128 + cc * 16; h0 = *(const u32x4*)hp_; h1 = *(const u32x4*)(hp_ + 8); } while (0)
#define EX_DOT16(acc, WSRC, hf) do { u32x4 w_ = WSRC; asm volatile("" : "+v"(w_.x), "+v"(w_.y), "+v"(w_.z), "+v"(w_.w), "+v"(ch_)); float f_[16]; cvt16(w_, f_); _Pragma("unroll") for (int e_ = 0; e_ < 16; ++e_) acc = fmaf(f_[e_], hf[e_], acc); ch_ = acc; } while (0)
#define EX_UCOMP(buf, h0, h1, k_) do { float hf_[16]; unpack8(h0, hf_); unpack8(h1, hf_ + 8); float ch_ = 0.f; \
    _Pragma("unroll") for (int j_ = 0; j_ < 8; ++j_) { float te_ = 0.f, to_ = 0.f; EX_DOT16(te_, buf[2 * j_], hf_); __builtin_amdgcn_sched_barrier(0); EX_DOT16(to_, buf[2 * j_ + 1], hf_); \
    const float my_ = odd ? to_ : te_, ot_ = odd ? te_ : to_; zp[k_][j_] += my_ + dpp_f(ot_, 0); asm volatile("" : "+v"(zp[k_][j_])); __builtin_amdgcn_sched_barrier(0); } } while (0)
#define SB() __builtin_amdgcn_sched_barrier(0)
            float zp[4][8];
#pragma unroll
            for (int k = 0; k < 4; ++k)
#pragma unroll
                for (int j = 0; j < 8; ++j) zp[k][j] = 0.f;
            EX_LOADH(hA0, hA1, 0, 0); EX_LOAD(dA, U8, 0, 0); SB();
#pragma unroll 1
            for (int i = 0; i < 16 * (1 + EXP_REP_U); ++i) {
                __builtin_amdgcn_s_barrier();
                EX_LOADH(hB0, hB1, i, 1); EX_LOAD(dB, U8, i, 1); SB(); EX_UCOMP(dA, hA0, hA1, 0); SB();
                EX_LOADH(hA0, hA1, i, 2); EX_LOAD(dA, U8, i, 2); SB(); EX_UCOMP(dB, hB0, hB1, 1); SB();
                EX_LOADH(hB0, hB1, i, 3); EX_LOAD(dB, U8, i, 3); SB(); EX_UCOMP(dA, hA0, hA1, 2); SB();
                if (i < 16 * (1 + EXP_REP_U) - 1) { EX_LOADH(hA0, hA1, i + 1, 0); EX_LOAD(dA, U8, i + 1, 0); } SB(); EX_UCOMP(dB, hB0, hB1, 3); SB();
            }
            if (EXP_REP_U) {
#pragma unroll
                for (int k = 0; k < 4; ++k)
#pragma unroll
                    for (int j = 0; j < 8; ++j) zp[k][j] *= 0.5f; }
            unsigned* apl = (unsigned*)(lds + 66560);
#pragma unroll
            for (int k = 0; k < 4; ++k)
#pragma unroll
                for (int j = 0; j < 8; ++j) { float z = zp[k][j]; z += dpp_f(z, 1); z += __shfl_xor(z, 4);
                    const int li = ((tlb + k) * 8 + rr) * 16 + 2 * j + (odd ? 1 : 0); const unsigned eid = offs[li] >> 7;
                    const float act = gelu_erf(z * ISU[eid]) * gts[li] * ISV[eid]; const float oth = dpp_f(act, 0);
                    apl[((tlb + k) * 8 + rr) * 8 + j] = f2bf(odd ? oth : act) | (f2bf(odd ? act : oth) << 16); }
            LDS_WAIT();
            float ssq[4] = {0.f, 0.f, 0.f, 0.f};
#define EX_VCOMP(buf, i_, k_) do { float oa_[16]; _Pragma("unroll") for (int e_ = 0; e_ < 16; ++e_) oa_[e_] = 0.f; \
    const int col_ = (int)EX_SLICE(i_) * 128 + cc * 16 + 2 * rr; const size_t xo_ = (size_t)(tok0 + tlb + (k_)) * D + col_; \
    const f32x2v x1_ = *(const f32x2v*)(X1 + xo_), g2_ = *(const f32x2v*)(mod + (size_t)b * NADA + 5 * 2048 + col_); \
    const u32x4 ap0_ = *(const u32x4*)(apl + ((tlb + (k_)) * 8 + rr) * 8), ap1_ = *(const u32x4*)(apl + ((tlb + (k_)) * 8 + rr) * 8 + 4); \
    _Pragma("unroll") for (int j_ = 0; j_ < 8; ++j_) { const unsigned pr_ = (j_ < 4) ? ap0_[j_ & 3] : ap1_[j_ & 3]; const float a0_ = bflo(pr_), a1_ = bfhi(pr_); \
        { u32x4 w_ = buf[2 * j_]; asm volatile("" : "+v"(w_.x), "+v"(w_.y), "+v"(w_.z), "+v"(w_.w), "+v"(oa_[0])); float f_[16]; cvt16(w_, f_); _Pragma("unroll") for (int e_ = 0; e_ < 16; ++e_) oa_[e_] = fmaf(a0_, f_[e_], oa_[e_]); } \
        { u32x4 w_ = buf[2 * j_ + 1]; asm volatile("" : "+v"(w_.x), "+v"(w_.y), "+v"(w_.z), "+v"(w_.w), "+v"(oa_[0])); float f_[16]; cvt16(w_, f_); _Pragma("unroll") for (int e_ = 0; e_ < 16; ++e_) oa_[e_] = fmaf(a1_, f_[e_], oa_[e_]); } } \
      \
    float b8_[8], b4_[4], b2_[2]; \
    _Pragma("unroll") for (int e_ = 0; e_ < 8; ++e_) { const bool up_ = lane & 32; const float kp_ = up_ ? oa_[e_ + 8] : oa_[e_], sd_ = up_ ? oa_[e_] : oa_[e_ + 8]; b8_[e_] = kp_ + __shfl_xor(sd_, 32); } \
    _Pragma("unroll") for (int e_ = 0; e_ < 4; ++e_) { const bool up_ = lane & 16; const float kp_ = up_ ? b8_[e_ + 4] : b8_[e_], sd_ = up_ ? b8_[e_] : b8_[e_ + 4]; b4_[e_] = kp_ + __shfl_xor(sd_, 16); } \
    _Pragma("unroll") for (int e_ = 0; e_ < 2; ++e_) { const bool up_ = lane & 8; const float kp_ = up_ ? b4_[e_ + 2] : b4_[e_], sd_ = up_ ? b4_[e_] : b4_[e_ + 2]; b2_[e_] = kp_ + __shfl_xor(sd_, 8); } \
    f32x2v y_; y_.x = x1_.x + g2_.x * b2_[0]; y_.y = x1_.y + g2_.y * b2_[1]; *(f32x2v*)(out + xo_) = y_; ssq[k_] = fmaf(y_.x, y_.x, fmaf(y_.y, y_.y, ssq[k_])); asm volatile("" : "+v"(ssq[k_])); } while (0)
#pragma unroll 1
            for (int i = 0; i < 16 * (1 + EXP_REP_V); ++i) {
                if (EXP_REP_V && i == 16) { ssq[0] = 0.f; ssq[1] = 0.f; ssq[2] = 0.f; ssq[3] = 0.f; }
                __builtin_amdgcn_s_barrier();
                EX_LOAD(dA, V8, i, 0); SB(); EX_VCOMP(dA, i, 0); SB();
                EX_LOAD(dA, V8, i, 1); SB(); EX_VCOMP(dA, i, 1); SB();
                EX_LOAD(dA, V8, i, 2); SB(); EX_VCOMP(dA, i, 2); SB();
                EX_LOAD(dA, V8, i, 3); SB(); EX_VCOMP(dA, i, 3); SB();
            }
#pragma unroll
            for (int k = 0; k < 4; ++k) { const float tot = wave_sum(ssq[k]); rstl[wave * 8 + half * 4 + k] = rsqrtf(tot * (1.f / D) + NORM_EPS); }
        }
#undef EX_SLICE
#undef EX_LOAD
#undef EX_LOADH
#undef EX_DOT16
#undef EX_UCOMP
#undef EX_VCOMP
#undef SB
        __builtin_amdgcn_fence(__ATOMIC_RELEASE, "agent"); __builtin_amdgcn_fence(__ATOMIC_ACQUIRE, "agent");
        LDS_WAIT();
        int lane2 = (int)__builtin_amdgcn_mbcnt_hi(~0u, __builtin_amdgcn_mbcnt_lo(~0u, 0u)); asm volatile("" : "+v"(lane2));
#pragma unroll 1
        for (int k = 0; k < 8; ++k) { float* xr = out + (size_t)(tok0 + wave * 8 + k) * D; const float rs = rstl[wave * 8 + k];
#pragma unroll
            for (int j = 0; j < 8; ++j) { const int col = 4 * (lane2 + 64 * j); const f32x4 v = *(const f32x4*)(xr + col), f = *(const f32x4*)(fin + col);
                f32x4 o; o[0] = v[0] * rs * f[0]; o[1] = v[1] * rs * f[1]; o[2] = v[2] * rs * f[2]; o[3] = v[3] * rs * f[3]; *(f32x4*)(xr + col) = o; } }
    }
}

#define XB_TMO      128
#define XB_XCNT(j)  (256  + 64 * (j))
#define XB_XSUB(j)  (1280 + 64 * (j))
#define XB_XGEN(j)  (2304 + 64 * (j))
#define XB_TOP      3328
#define XB_TOPGEN   3392
#define XCD_BAR_WORDS 3456
#define XB_SPIN_CAP (1u << 22)
__device__ __forceinline__ unsigned xb_ld(unsigned* p)              { return __hip_atomic_load(p, __ATOMIC_RELAXED, __HIP_MEMORY_SCOPE_AGENT); }
__device__ __forceinline__ unsigned xb_add(unsigned* p, unsigned v) { return __hip_atomic_fetch_add(p, v, __ATOMIC_RELAXED, __HIP_MEMORY_SCOPE_AGENT); }
__device__ __forceinline__ unsigned xb_xcc_id() { return (unsigned)__builtin_amdgcn_s_getreg((3 << 11) | 20) & 0xFu; }
#define XB_SPIN(cond, bar) do { unsigned _sp = 0; while (cond) { __builtin_amdgcn_s_sleep(1); \
    if ((++_sp & 255u) == 0u) { if (xb_ld(&(bar)[XB_TMO])) break; if (_sp > XB_SPIN_CAP) { atomicAdd(&(bar)[XB_TMO], 1u); break; } } } } while (0)
struct XcdBarrier { unsigned* bar; unsigned x; volatile LAS unsigned* st; };
__device__ __forceinline__ XcdBarrier xcd_barrier_post(unsigned* bar, volatile LAS unsigned* st) {
    XcdBarrier b; b.bar = bar; b.x = xb_xcc_id(); b.st = st;
    if (threadIdx.x == 0) (void)xb_add(&bar[XB_XCNT(b.x)], 1u);
    return b;
}
__device__ __forceinline__ void xcd_barrier_complete(unsigned* bar, unsigned x, unsigned& nloc, unsigned& nx) {
    const unsigned G = gridDim.x * gridDim.y * gridDim.z;
    unsigned sum, cnt, mine, sp = 0u;
    for (;;) {
        sum = 0u; cnt = 0u; mine = 0u;
#pragma unroll
        for (unsigned j = 0; j < 16; ++j) { const unsigned c = xb_ld(&bar[XB_XCNT(j)]); sum += c; cnt += (c > 0u) ? 1u : 0u; mine = (j == x) ? c : mine; }
        if (sum == G) break;
        __builtin_amdgcn_s_sleep(1);
        if ((++sp & 255u) == 0u) { if (xb_ld(&bar[XB_TMO])) break; if (sp > XB_SPIN_CAP) { atomicAdd(&bar[XB_TMO], 1u); break; } }
    }
    nloc = mine > 0u ? mine : 1u; nx = cnt > 0u ? cnt : 1u;
}
__device__ __forceinline__ void xcd_barrier(const XcdBarrier& b) {
    asm volatile("s_waitcnt vmcnt(0)" ::: "memory");
    __syncthreads();
    if (threadIdx.x == 0) {
        unsigned* bar = b.bar;
        __builtin_amdgcn_s_waitcnt(0);
        unsigned nloc = b.st[0], nx = b.st[1];
        if (nloc == 0u) { xcd_barrier_complete(bar, b.x, nloc, nx); b.st[0] = nloc; b.st[1] = nx; }
        const unsigned old = xb_add(&bar[XB_XSUB(b.x)], 1u);
        const unsigned gen = old / nloc;
        if (old + 1u == (gen + 1u) * nloc) {
            __builtin_amdgcn_fence(__ATOMIC_RELEASE, "agent");
            asm volatile("s_waitcnt vmcnt(0)" ::: "memory");
            const unsigned og = xb_add(&bar[XB_TOP], 1u);
            const unsigned tg = og / nx;
            if (og + 1u == (tg + 1u) * nx) xb_add(&bar[XB_TOPGEN], 1u);
            else XB_SPIN(xb_ld(&bar[XB_TOPGEN]) == tg, bar);
            __builtin_amdgcn_fence(__ATOMIC_ACQUIRE, "agent");
            xb_add(&bar[XB_XGEN(b.x)], 1u);
            asm volatile("s_waitcnt vmcnt(0)" ::: "memory");
        } else {
            XB_SPIN(xb_ld(&bar[XB_XGEN(b.x)]) == gen, bar);
            __builtin_amdgcn_fence(__ATOMIC_ACQUIRE, "agent");
            asm volatile("s_waitcnt vmcnt(0)" ::: "memory");
        }
    }
    __syncthreads();
}

__device__ __forceinline__ void subset_barrier(unsigned* cnt, unsigned n) {
    asm volatile("s_waitcnt vmcnt(0)" ::: "memory");
    __syncthreads();
    if (threadIdx.x == 0) {
        __builtin_amdgcn_fence(__ATOMIC_RELEASE, "agent");
        asm volatile("s_waitcnt vmcnt(0)" ::: "memory");
        __hip_atomic_fetch_add(cnt, 1u, __ATOMIC_RELAXED, __HIP_MEMORY_SCOPE_AGENT);
        unsigned sp = 0;
        while (__hip_atomic_load(cnt, __ATOMIC_RELAXED, __HIP_MEMORY_SCOPE_AGENT) < n) { __builtin_amdgcn_s_sleep(1); if (++sp > (1u << 24)) break; }
        __builtin_amdgcn_fence(__ATOMIC_ACQUIRE, "agent");
        asm volatile("s_waitcnt vmcnt(0)" ::: "memory");
    }
    __syncthreads();
}
constexpr int NPHASES = 11;
__global__ void __launch_bounds__(NTHREADS, 2) mega_fwd(Params p) {
    extern __shared__ __attribute__((aligned(16))) unsigned char lds[];
    cg::grid_group grid = cg::this_grid();
    const int lo = p.ph_lo, hi = p.ph_hi;
#ifndef PHASE_MASK
#define PHASE_MASK 0x7ff
#endif
#define IN(k) (((PHASE_MASK >> (k)) & 1) && lo <= (k) && (k) < hi)
#define SEAM(k) do { if (IN(k) && IN((k) + 1)) { if ((k) == 0) grid.sync(); else xcd_barrier(xbar); } } while (0)
    unsigned char* ws = p.ws;
    bf16_t* P = (bf16_t*)(ws + WS_P);
    bf16_t* Hb = (bf16_t*)((unsigned char*)p.out + OUT_H);
    bf16_t* WinT = (bf16_t*)((unsigned char*)p.out + OUT_WIN);
    const float* mod = (const float*)(ws + WS_MOD);
    LAS unsigned char* ldsl = (LAS unsigned char*)lds;
    volatile LAS unsigned* xst = (volatile LAS unsigned*)(ldsl + LDS_BYTES - 64);
    if (threadIdx.x < 2) xst[threadIdx.x] = 0u;
    __syncthreads();
    XcdBarrier xbar = xcd_barrier_post((unsigned*)(ws + WS_CTL) + 4096, xst);

#ifndef REPEAT_PHASE
#define REPEAT_PHASE -1
#endif
    int rep3 = 0;
#define RUNPH(k, ...) do { if (IN(k)) { __VA_ARGS__; if (REPEAT_PHASE == (k)) { grid.sync(); __VA_ARGS__; } } } while (0)
    RUNPH(0, { phase_mod(p, lds); __syncthreads(); phase_weights(p, lds); });
    SEAM(0);
    RUNPH(1, { phase_norm_rows(p.in[0], p.in[4], mod, mod + 2048, Hb, LDP); });
    SEAM(1);
    RUNPH(2, { pg8::Gemm g{Hb, WinT, nullptr, nullptr, LDP, LDP, T, NP, D}; pg8::StaticOrder<1> S; S.init(T, NP, gridDim.x, blockIdx.x);
        pg8::EpiBf16 E{P, NP, 33}; pg8::gemm_phase(ldsl, g, S, E); });
    SEAM(2);
    RUNPH(3, { const int G = gridDim.x, bx = blockIdx.x;
        if (G >= 128) { if (bx < 64) { phase_hgrn(p, lds, bx, 64); if (REPEAT_PHASE == 32) phase_hgrn(p, lds, bx, 64); }
                        else { phase_vt(p, lds, bx - 64, G - 64); phase_indexer(p, lds, bx - 64, G - 64); if (REPEAT_PHASE == 31) phase_indexer(p, lds, bx - 64, G - 64);
                               subset_barrier((unsigned*)(ws + WS_CTL) + 12288 + ((REPEAT_PHASE == 3) ? 64 * rep3 : 0), (unsigned)(G - 64)); phase_attn(p, lds, bx - 64, G - 64); if (REPEAT_PHASE == 33) phase_attn(p, lds, bx - 64, G - 64); } }
        else { phase_vt(p, lds, bx, G); phase_indexer(p, lds, bx, G); __syncthreads(); phase_hgrn(p, lds, bx, G); grid.sync(); phase_attn(p, lds, bx, G); }
        ++rep3; });
    SEAM(3);
    RUNPH(5, { pg8::Gemm g{(const bf16_t*)((unsigned char*)p.out + OUT_AO), (const bf16_t*)(ws + WS_WUA), (const bf16_t*)((unsigned char*)p.out + OUT_REC), (const bf16_t*)(ws + WS_WUB), 1024, 1024, T, D, 1024}; pg8::StaticOrder<2> S; S.init(T, D, gridDim.x, blockIdx.x);
        pg8::EpiMix E{(bf16_t*)(ws + WS_MIXED), P}; pg8::gemm_phase(ldsl, g, S, E); });
    SEAM(5);
    RUNPH(6, { pg8::Gemm g{(const bf16_t*)(ws + WS_MIXED), (const bf16_t*)(ws + WS_WOUT), nullptr, nullptr, D, D, T, D, D}; pg8::StaticOrder<1> S; S.init(T, D, gridDim.x, blockIdx.x);
        pg8::EpiX1 E{p.in[0], (float*)(ws + WS_X1), mod + 4096}; pg8::gemm_phase(ldsl, g, S, E); });
    SEAM(6);
    RUNPH(7, { phase_norm_rows((const float*)(ws + WS_X1), p.in[5], mod + 3 * 2048, mod + 4 * 2048, (bf16_t*)(ws + WS_H2), D); phase_uv(p); });
    SEAM(7);
    RUNPH(8, { pg8::Gemm g{(const bf16_t*)(ws + WS_H2), (const bf16_t*)(ws + WS_WQ), nullptr, nullptr, D, D, T, D, D}; pg8::StaticOrder<1> S; S.init(T, D, gridDim.x, blockIdx.x);
        pg8::EpiBf16 E{(bf16_t*)(ws + WS_QP), D, 1 << 30}; pg8::gemm_phase(ldsl, g, S, E); });
    SEAM(8);
    RUNPH(9, { phase_peer_topk(p); });
    SEAM(9);
    RUNPH(10, { phase_experts(p, lds); });
#undef IN
#undef SEAM
}

#ifndef MK_N_LAUNCHES
#define MK_N_LAUNCHES 1
#endif
extern "C" void kernel_launch(void* const* d_in, const int* in_sizes, int n_in, void* d_out, int out_size, void* d_ws, size_t ws_size, hipStream_t stream) {
    static int grid = 0;
    if (grid == 0) {
        if (n_in != 17 || out_size != T * D || ws_size < WS_END) { fprintf(stderr, "kernel_launch: unexpected shapes (n_in %d out %d ws %zu)\n", n_in, out_size, ws_size); grid = -1; return; }
        int dev = 0, cus = 0, per_cu = 0;
        hipGetDevice(&dev); hipDeviceGetAttribute(&cus, hipDeviceAttributeMultiprocessorCount, dev);
        hipFuncSetAttribute((const void*)mega_fwd, hipFuncAttributeMaxDynamicSharedMemorySize, LDS_BYTES);
        hipOccupancyMaxActiveBlocksPerMultiprocessor(&per_cu, (const void*)mega_fwd, NTHREADS, LDS_BYTES);
        if (per_cu < 1) { fprintf(stderr, "kernel_launch: occupancy query says %d blocks/CU\n", per_cu); per_cu = 1; }
        (void)hipGetLastError();
        grid = cus * 1;
    }
    if (grid < 0) return;
    if (hipMemsetAsync((char*)d_ws + WS_CTL, 0, 65536, stream) != hipSuccess) { fprintf(stderr, "kernel_launch: memset failed\n"); return; }
    Params p{};
    for (int i = 0; i < 17; ++i) p.in[i] = (const float*)d_in[i];
    p.out = (float*)d_out; p.ws = (unsigned char*)d_ws;
#if MK_N_LAUNCHES == 1
    p.ph_lo = 0; p.ph_hi = NPHASES;
    void* args[] = {&p};
    hipError_t e = hipLaunchCooperativeKernel((const void*)mega_fwd, dim3(grid), dim3(NTHREADS), args, LDS_BYTES, stream);
    if (e != hipSuccess) fprintf(stderr, "cooperative launch failed: %s (grid %d)\n", hipGetErrorString(e), grid);
#else
    for (int k = 0; k < NPHASES; ++k) { p.ph_lo = k; p.ph_hi = k + 1; void* args[] = {&p};
        hipError_t e = hipLaunchCooperativeKernel((const void*)mega_fwd, dim3(grid), dim3(NTHREADS), args, LDS_BYTES, stream);
        if (e != hipSuccess) { fprintf(stderr, "launch %d failed: %s\n", k, hipGetErrorString(e)); break; } }
#endif
}
```

```cpp
#include <hip/hip_runtime.h>
#include <hip/hip_cooperative_groups.h>
#include <cstdio>
#include <cstdint>
namespace cg = cooperative_groups;

#define LAS __attribute__((address_space(3)))
typedef unsigned short bf16_t;
typedef short bf16x8 __attribute__((ext_vector_type(8)));
typedef short bf16x4 __attribute__((ext_vector_type(4)));
typedef float f32x2 __attribute__((ext_vector_type(2)));
typedef float f32x4 __attribute__((ext_vector_type(4)));
typedef float f32x16 __attribute__((ext_vector_type(16)));
typedef unsigned u32x2 __attribute__((ext_vector_type(2)));
typedef unsigned u32x4 __attribute__((ext_vector_type(4)));

constexpr int T = 16384, D = 2048, SEQ = 2048, NBATCH = 8, NP = 12544;
constexpr int C_QA = 0, C_KA = 1024, C_VA = 2048, C_QI = 3072, C_KI = 4096, C_WI = 4160, C_QB = 4352, C_FB = 5376, C_IB = 6400, C_GB = 7424, C_GA = 8448, C_GG = 10496;
constexpr int NADA = 12288;
constexpr float NORM_EPS = 1e-6f;
constexpr int NTHREADS = 512, NWAVES = 8;
constexpr int LDS_BYTES = 147456;
constexpr size_t MiB = 1u << 20;
constexpr size_t WS_CTL = 0, WS_MOD = 1 * MiB, WS_WUA = 2 * MiB, WS_WUB = 6 * MiB, WS_WOUT = 10 * MiB, WS_WQ = 18 * MiB, WS_KEYS = 26 * MiB, WS_MASK = 27 * MiB;
constexpr size_t WS_MIXED = 32 * MiB;
constexpr size_t WS_VT = 32 * MiB, WS_ORAW = 64 * MiB;
constexpr size_t WS_P = 96 * MiB;
constexpr size_t WS_H2 = 96 * MiB, WS_QP = 160 * MiB, WS_U8 = 224 * MiB, WS_V8 = 256 * MiB, WS_ISU = 26 * MiB + 512 * 1024, WS_ISV = 26 * MiB + 768 * 1024, WS_Y = 288 * MiB, WS_EIDX = 352 * MiB, WS_EGATE = 360 * MiB;
constexpr size_t WS_X1 = 368 * MiB;
constexpr size_t WS_END = 496 * MiB;
constexpr int LDP = 2048 + 64;
constexpr size_t OUT_H = 0, OUT_WIN = 68 * MiB;
constexpr size_t OUT_AO = 0, OUT_REC = 32 * MiB;

struct Params { const float* in[17]; float* out; unsigned char* ws; int ph_lo, ph_hi; };

__device__ __forceinline__ unsigned f2bf(float f) { unsigned u = __float_as_uint(f); return (u + 0x7fffu + ((u >> 16) & 1u)) >> 16; }
__device__ __forceinline__ float bf2f(unsigned b) { return __uint_as_float(b << 16); }
__device__ __forceinline__ float bflo(unsigned w) { return __uint_as_float(w << 16); }
__device__ __forceinline__ float bfhi(unsigned w) { return __uint_as_float(w & 0xffff0000u); }
__device__ __forceinline__ unsigned pk2(float lo, float hi) { unsigned r; asm volatile("v_cvt_pk_bf16_f32 %0, %1, %2" : "=v"(r) : "v"(lo), "v"(hi)); return r; }
__device__ __forceinline__ float wave_sum(float v) {
#pragma unroll
    for (int o = 1; o < 64; o <<= 1) v += __shfl_xor(v, o);
    return v;
}
__device__ __forceinline__ float sigmoidf_(float v) { return 1.f / (1.f + __expf(-v)); }
__device__ __forceinline__ float siluf_(float v) { return v / (1.f + __expf(-v)); }
#define LDS_WAIT() asm volatile("s_waitcnt lgkmcnt(0)" ::: "memory")

namespace pg8 {
constexpr int BM = 256, BK = 64, HALF = 128, HTB = HALF * BK * 2, STAGE_BYTES = 8 * HTB, NXCD = 8, WGM = 8;
__host__ __device__ __forceinline__ int lds_byte(int r, int c) { const int st = (r >> 4) * 2 + (c >> 5), rr = r & 15, cc = c & 31, ob = rr * 64 + cc * 2; return st * 1024 + (ob ^ (((ob >> 9) & 1) << 5)); }
__host__ __device__ __forceinline__ void stage_rc(int b, int& R, int& C) { const int st = b / 1024, sb = b % 1024, swz = sb ^ (((sb >> 9) & 1) << 5); R = (st >> 1) * 16 + swz / 64; C = (st & 1) * 32 + (swz % 64) / 2; }
__host__ __device__ __forceinline__ int perm32(int rho) { const int n = rho >> 4, i = rho & 15; return 8 * (i >> 2) + 4 * n + (i & 3); }

struct Unit { int pm, pn, z; };
struct Gemm { const bf16_t* A; const bf16_t* Bt; const bf16_t* A2; const bf16_t* Bt2; int lda, ldb, M, N, K; };

template <int NZ> struct StaticOrder {
    int nM, nN, nwg, G, c;
    __device__ void init(int M, int N, int G_, int c_) { nM = M / BM; nN = N / BM; nwg = nM * nN; G = G_; c = c_; }
    __device__ bool next(int i, Unit& u) const {
        const long L = (long)(i / NZ) * G + c; if (L >= nwg) return false;
        int wgid = (int)L; { const int q = nwg / NXCD, r = nwg % NXCD, xcd = wgid % NXCD, off = wgid / NXCD; wgid = (xcd < r ? xcd * (q + 1) : r * (q + 1) + (xcd - r) * q) + off; }
        const int nig = WGM * nN, gid = wgid / nig, fm = gid * WGM, gsz = (nM - fm) < WGM ? (nM - fm) : WGM;
        u.pm = fm + ((wgid % nig) % gsz); u.pn = (wgid % nig) / gsz; u.z = i % NZ; return true;
    }
};

template <class Epi, class Sched>
__device__ __forceinline__ void gemm_phase(LAS unsigned char* lds, const Gemm g, const Sched& S, const Epi& E) {
    const int tid = threadIdx.x, wid = __builtin_amdgcn_readfirstlane(tid >> 6), lane = tid & 63, wr = wid >> 2, wc = wid & 3, fr = lane & 15, fq = lane >> 4;
    const int K = g.K, nt = K / BK;
    unsigned voffA[2], voffB[2];
#pragma unroll
    for (int i = 0; i < 2; ++i) { int R, C; stage_rc(tid * 16 + i * 8192, R, C); const int Rb = Epi::PERM ? ((R & ~31) + perm32(R & 31)) : R;
        voffA[i] = (unsigned)(R * g.lda + C) * 2u; voffB[i] = (unsigned)(Rb * g.ldb + C) * 2u; }
    const size_t kstep = (size_t)(BK * 2);
    const size_t hstepA = (size_t)HALF * g.lda * 2, hstepB = (size_t)HALF * g.ldb * 2;
    const size_t tstepA = 2 * hstepA, tstepB = 2 * hstepB;
    const unsigned ldsw = (unsigned)wid * 1024u;
    const int aoff = lds_byte(wr * 64 + fr, fq * 8), boff = lds_byte(wc * 32 + fr, fq * 8);
#define PG8_SA(b, h) (((b) * 2 + (h)) * HTB)
#define PG8_SB(b, h) ((4 + (b) * 2 + (h)) * HTB)
#define PG8_STAGE(bufoff, gbase, voff) do { _Pragma("unroll") for (int _i = 0; _i < 2; ++_i) \
        __builtin_amdgcn_global_load_lds((const unsigned*)((const char*)(gbase) + (voff)[_i]), (LAS unsigned*)(lds + (bufoff) + ldsw + _i * 8192), 16, 0, 0); } while (0)
#define PG8_LDA(dst, b, h) do { _Pragma("unroll") for (int m = 0; m < 4; ++m) _Pragma("unroll") for (int k = 0; k < 2; ++k) dst[m][k] = *(const LAS bf16x8*)(lds + PG8_SA(b, h) + aoff + m * 2048 + k * 1024); } while (0)
#define PG8_LDB(dst, b, h) do { _Pragma("unroll") for (int n = 0; n < 2; ++n) _Pragma("unroll") for (int k = 0; k < 2; ++k) dst[n][k] = *(const LAS bf16x8*)(lds + PG8_SB(b, h) + boff + n * 2048 + k * 1024); } while (0)
#define PG8_MMA(ai, bj, At, Bt) do { __builtin_amdgcn_s_setprio(1); _Pragma("unroll") for (int m = 0; m < 4; ++m) _Pragma("unroll") for (int n = 0; n < 2; ++n) _Pragma("unroll") for (int k = 0; k < 2; ++k) \
        acc[ai][bj][m][n] = __builtin_amdgcn_mfma_f32_16x16x32_bf16(Bt[n][k], At[m][k], acc[ai][bj][m][n], 0, 0, 0); __builtin_amdgcn_s_setprio(0); } while (0)
#define PG8_WAIT_V(n) asm volatile("s_waitcnt vmcnt(" #n ")" ::: "memory")
#define PG8_WAIT_L(n) asm volatile("s_waitcnt lgkmcnt(" #n ")" ::: "memory")
#define PG8_BAR __builtin_amdgcn_s_barrier()
#define PG8_SCHED __builtin_amdgcn_sched_barrier(0)
#define PG8_ABASE(u) ((const char*)((u).z ? g.A2 : g.A) + (size_t)(u).pm * tstepA)
#define PG8_BBASE(u) ((const char*)((u).z ? g.Bt2 : g.Bt) + (size_t)(u).pn * tstepB)
    Unit cur, nxt; int ui = 0;
    if (!S.next(0, cur)) return;
    f32x4 acc[2][2][4][2];
#pragma unroll
    for (int a = 0; a < 2; ++a)
#pragma unroll
        for (int b = 0; b < 2; ++b)
#pragma unroll
            for (int m = 0; m < 4; ++m)
#pragma unroll
                for (int n = 0; n < 2; ++n) acc[a][b][m][n] = (f32x4){0.f, 0.f, 0.f, 0.f};
    bf16x8 At[4][2], B0[2][2], B1[2][2];
    const char* cA = PG8_ABASE(cur); const char* cB = PG8_BBASE(cur);
    PG8_STAGE(PG8_SB(0, 0), cB, voffB); PG8_STAGE(PG8_SA(0, 0), cA, voffA); PG8_STAGE(PG8_SB(0, 1), cB + hstepB, voffB); PG8_STAGE(PG8_SA(0, 1), cA + hstepA, voffA);
    if (wr == 1) PG8_BAR;
    PG8_WAIT_V(4); PG8_BAR;
    PG8_STAGE(PG8_SB(1, 0), cB + kstep, voffB); PG8_STAGE(PG8_SA(1, 0), cA + kstep, voffA); PG8_STAGE(PG8_SB(1, 1), cB + hstepB + kstep, voffB);
    PG8_WAIT_V(6); PG8_BAR;
    for (;;) {
        const bool has_next = S.next(ui + 1, nxt);
        const char* nA = has_next ? PG8_ABASE(nxt) : cA; const char* nB = has_next ? PG8_BBASE(nxt) : cB;
        for (int t = 0; t < nt; t += 2) {
            const bool last = (t == nt - 2);
            const char* a1 = cA + (size_t)(t + 1) * kstep;
            const char* a2 = last ? nA : cA + (size_t)(t + 2) * kstep; const char* b2 = last ? nB : cB + (size_t)(t + 2) * kstep;
            const char* a3 = a2 + kstep; const char* b3 = b2 + kstep;
            PG8_LDB(B0, 0, 0); PG8_SCHED; PG8_LDA(At, 0, 0); PG8_STAGE(PG8_SA(1, 1), a1 + hstepA, voffA);
            PG8_WAIT_L(8); PG8_BAR; PG8_WAIT_L(0); PG8_MMA(0, 0, At, B0); PG8_BAR; PG8_SCHED;
            PG8_LDB(B1, 0, 1); PG8_STAGE(PG8_SB(0, 0), b2, voffB);
            PG8_BAR; PG8_WAIT_L(0); PG8_MMA(0, 1, At, B1); PG8_BAR;
            PG8_LDA(At, 0, 1); PG8_STAGE(PG8_SA(0, 0), a2, voffA);
            PG8_BAR; PG8_WAIT_L(0); PG8_MMA(1, 0, At, B0); PG8_BAR; PG8_SCHED;
            PG8_STAGE(PG8_SB(0, 1), b2 + hstepB, voffB);
            PG8_WAIT_V(6); PG8_BAR; PG8_MMA(1, 1, At, B1); PG8_BAR;
            PG8_LDB(B0, 1, 0); PG8_SCHED; PG8_LDA(At, 1, 0); PG8_STAGE(PG8_SA(0, 1), a2 + hstepA, voffA);
            PG8_WAIT_L(8); PG8_BAR; PG8_WAIT_L(0); PG8_MMA(0, 0, At, B0); PG8_BAR; PG8_SCHED;
            PG8_LDB(B1, 1, 1); PG8_STAGE(PG8_SB(1, 0), b3, voffB);
            PG8_BAR; PG8_WAIT_L(0); PG8_MMA(0, 1, At, B1); PG8_BAR;
            PG8_LDA(At, 1, 1); PG8_STAGE(PG8_SA(1, 0), a3, voffA);
            PG8_BAR; PG8_WAIT_L(0); PG8_MMA(1, 0, At, B0); PG8_BAR; PG8_SCHED;
            PG8_STAGE(PG8_SB(1, 1), b3 + hstepB, voffB);
            PG8_WAIT_V(6); PG8_BAR; PG8_MMA(1, 1, At, B1); PG8_BAR;
        }
        E(acc, cur, wr, wc, fr, fq);
        if (!has_next) break;
#pragma unroll
        for (int a = 0; a < 2; ++a)
#pragma unroll
            for (int b = 0; b < 2; ++b)
#pragma unroll
                for (int m = 0; m < 4; ++m)
#pragma unroll
                    for (int n = 0; n < 2; ++n) acc[a][b][m][n] = (f32x4){0.f, 0.f, 0.f, 0.f};
        cur = nxt; cA = nA; cB = nB; ++ui;
    }
    PG8_WAIT_V(0);
    if (wr == 0) PG8_BAR;
    PG8_BAR;
#undef PG8_SA
#undef PG8_SB
#undef PG8_STAGE
#undef PG8_LDA
#undef PG8_LDB
#undef PG8_MMA
#undef PG8_WAIT_V
#undef PG8_WAIT_L
#undef PG8_BAR
#undef PG8_SCHED
#undef PG8_ABASE
#undef PG8_BBASE
}

struct EpiBf16 {
    static constexpr bool PERM = true;
    bf16_t* O; int ldc; int sig_from;
    __device__ __forceinline__ void operator()(const f32x4 (&acc)[2][2][4][2], const Unit& u, int wr, int wc, int fr, int fq) const {
        const int row0 = u.pm * BM + wr * 64 + fr, col0 = u.pn * BM + wc * 32 + 8 * fq; const bool sig = u.pn >= sig_from;
#pragma unroll
        for (int ai = 0; ai < 2; ++ai)
#pragma unroll
            for (int m = 0; m < 4; ++m) { bf16_t* rowp = O + (size_t)(row0 + ai * HALF + m * 16) * ldc + col0;
#pragma unroll
                for (int bj = 0; bj < 2; ++bj) { f32x4 v0 = acc[ai][bj][m][0], v1 = acc[ai][bj][m][1];
                    if (sig) {
#pragma unroll
                        for (int j = 0; j < 4; ++j) { v0[j] = sigmoidf_(v0[j]); v1[j] = sigmoidf_(v1[j]); } }
                    u32x4 w; w.x = pk2(v0[0], v0[1]); w.y = pk2(v0[2], v0[3]); w.z = pk2(v1[0], v1[1]); w.w = pk2(v1[2], v1[3]);
                    *(u32x4*)(rowp + bj * HALF) = w; } }
    }
};
struct EpiMix {
    static constexpr bool PERM = true;
    bf16_t* O; const bf16_t* P;
    __device__ __forceinline__ void operator()(const f32x4 (&acc)[2][2][4][2], const Unit& u, int wr, int wc, int fr, int fq) const {
        const int row0 = u.pm * BM + wr * 64 + fr, col0 = u.pn * BM + wc * 32 + 8 * fq; const int gcol = (u.z ? C_GG : C_GA);
#pragma unroll
        for (int ai = 0; ai < 2; ++ai) {
            u32x4 gw[4][2], pw[4][2];
#pragma unroll
            for (int m = 0; m < 4; ++m)
#pragma unroll
                for (int bj = 0; bj < 2; ++bj) { const size_t r = (size_t)(row0 + ai * HALF + m * 16);
                    gw[m][bj] = *(const u32x4*)(P + r * NP + gcol + col0 + bj * HALF);
                    if (u.z) pw[m][bj] = *(const u32x4*)(O + r * D + col0 + bj * HALF); else pw[m][bj] = (u32x4){0u, 0u, 0u, 0u}; }
            asm volatile("" ::: "memory");
#pragma unroll
            for (int m = 0; m < 4; ++m)
#pragma unroll
                for (int bj = 0; bj < 2; ++bj) { const size_t r = (size_t)(row0 + ai * HALF + m * 16); const f32x4 v0 = acc[ai][bj][m][0], v1 = acc[ai][bj][m][1]; const u32x4 g = gw[m][bj], q = pw[m][bj];
                    u32x4 w; w.x = pk2(fmaf(v0[0], bflo(g.x), bflo(q.x)), fmaf(v0[1], bfhi(g.x), bfhi(q.x))); w.y = pk2(fmaf(v0[2], bflo(g.y), bflo(q.y)), fmaf(v0[3], bfhi(g.y), bfhi(q.y)));
                    w.z = pk2(fmaf(v1[0], bflo(g.z), bflo(q.z)), fmaf(v1[1], bfhi(g.z), bfhi(q.z))); w.w = pk2(fmaf(v1[2], bflo(g.w), bflo(q.w)), fmaf(v1[3], bfhi(g.w), bfhi(q.w)));
                    *(u32x4*)(O + r * D + col0 + bj * HALF) = w; }
            asm volatile("" ::: "memory");
        }
    }
};
struct EpiX1 {
    static constexpr bool PERM = false;
    const float* x; float* out; const float* gate;
    __device__ __forceinline__ void operator()(const f32x4 (&acc)[2][2][4][2], const Unit& u, int wr, int wc, int fr, int fq) const {
        const int row0 = u.pm * BM + wr * 64 + fr, col0 = u.pn * BM + wc * 32 + 4 * fq; const int b = (u.pm * BM) >> 11;
        f32x4 gv[2][2];
#pragma unroll
        for (int bj = 0; bj < 2; ++bj)
#pragma unroll
            for (int n = 0; n < 2; ++n) gv[bj][n] = *(const f32x4*)(gate + (size_t)b * NADA + col0 + bj * HALF + n * 16);
#pragma unroll
        for (int ai = 0; ai < 2; ++ai) {
            f32x4 xv[4][2][2];
#pragma unroll
            for (int m = 0; m < 4; ++m)
#pragma unroll
                for (int bj = 0; bj < 2; ++bj)
#pragma unroll
                    for (int n = 0; n < 2; ++n) xv[m][bj][n] = *(const f32x4*)(x + (size_t)(row0 + ai * HALF + m * 16) * D + col0 + bj * HALF + n * 16);
            asm volatile("" ::: "memory");
#pragma unroll
            for (int m = 0; m < 4; ++m)
#pragma unroll
                for (int bj = 0; bj < 2; ++bj)
#pragma unroll
                    for (int n = 0; n < 2; ++n) *(f32x4*)(out + (size_t)(row0 + ai * HALF + m * 16) * D + col0 + bj * HALF + n * 16) = xv[m][bj][n] + gv[bj][n] * acc[ai][bj][m][n];
            asm volatile("" ::: "memory");
        }
    }
};
}

__device__ __forceinline__ void phase_mod(const Params& p, unsigned char* lds) {
    float* sc = (float*)lds;
    float* red = (float*)(lds + 65536);
    const int tid = threadIdx.x, wave = tid >> 6, lane = tid & 63;
    const float* c = p.in[1]; const float* wada = p.in[2]; const float* bada = p.in[3];
    float* mod = (float*)(p.ws + WS_MOD);
    if ((int)blockIdx.x >= 192) return;
    for (int i = tid; i < NBATCH * D; i += NTHREADS) { const int b = i >> 11, k = i & 2047; sc[k * 8 + b] = siluf_(c[i]); }
    __syncthreads();
    const int cgp = tid & 15, rg = tid >> 4;
    for (int item = blockIdx.x; item < 192; item += gridDim.x) {
        const float* w = wada + item * 64 + cgp * 4;
        float acc[8][4];
#pragma unroll
        for (int b = 0; b < 8; ++b)
#pragma unroll
            for (int j = 0; j < 4; ++j) acc[b][j] = 0.f;
#pragma unroll 4
        for (int i = 0; i < 64; ++i) { const int k = rg + 32 * i; const f32x4 wv = *(const f32x4*)(w + (size_t)k * NADA);
            const f32x4 s0 = *(const f32x4*)(sc + k * 8), s1 = *(const f32x4*)(sc + k * 8 + 4);
#pragma unroll
            for (int j = 0; j < 4; ++j) { acc[0][j] += s0[0] * wv[j]; acc[1][j] += s0[1] * wv[j]; acc[2][j] += s0[2] * wv[j]; acc[3][j] += s0[3] * wv[j];
                acc[4][j] += s1[0] * wv[j]; acc[5][j] += s1[1] * wv[j]; acc[6][j] += s1[2] * wv[j]; acc[7][j] += s1[3] * wv[j]; } }
#pragma unroll
        for (int b = 0; b < 8; ++b)
#pragma unroll
            for (int j = 0; j < 4; ++j) { float v = acc[b][j]; v += __shfl_xor(v, 16); v += __shfl_xor(v, 32); acc[b][j] = v; }
        if (lane < 16) {
#pragma unroll
            for (int b = 0; b < 8; ++b)
#pragma unroll
                for (int j = 0; j < 4; ++j) red[(wave * 16 + cgp) * 32 + b * 4 + j] = acc[b][j]; }
        __syncthreads();
        { const int cgo = tid >> 5, b = (tid >> 2) & 7, j = tid & 3; float s = 0.f;
#pragma unroll
          for (int w8 = 0; w8 < 8; ++w8) s += red[(w8 * 16 + cgo) * 32 + (tid & 31)];
          const int col = item * 64 + cgo * 4 + j; mod[b * NADA + col] = s + bada[col]; }
        __syncthreads();
    }
}
__device__ __forceinline__ void transpose_item(const float* W, int K, int N, bf16_t* WT, int nblk, int item, int lane, float* scr, int mode, int pitch) {
    const int kb = item / nblk, nb = item % nblk, k0 = 64 * kb, n0 = 32 * nb;
    const int nd = n0 + (lane & 31); int ns = nd; bool valid = true;
    if (mode == 1) { if (nd >= C_QB) ns = nd - 176; else if (nd >= 4176) valid = false; }
    if (mode == 0 || n0 < 4160 || n0 >= C_QB) {
        const int ns0 = (mode == 1 && n0 >= C_QB) ? n0 - 176 : n0;
        f32x4 v[8];
#pragma unroll
        for (int i = 0; i < 8; ++i) v[i] = *(const f32x4*)(W + (size_t)(k0 + 8 * i + (lane >> 3)) * N + ns0 + 4 * (lane & 7));
#pragma unroll
        for (int i = 0; i < 8; ++i) { float* d = scr + (8 * i + (lane >> 3)) * 33 + 4 * (lane & 7); d[0] = v[i][0]; d[1] = v[i][1]; d[2] = v[i][2]; d[3] = v[i][3]; }
    } else {
#pragma unroll 8
        for (int i = 0; i < 32; ++i) { const int kk = 2 * i + (lane >> 5); scr[kk * 33 + (lane & 31)] = valid ? W[(size_t)(k0 + kk) * N + ns] : 0.f; }
    }
    LDS_WAIT();
    const int c = lane & 7;
#pragma unroll
    for (int j = 0; j < 4; ++j) { const int n = (lane >> 3) + 8 * j; const float* s = scr + (8 * c) * 33 + n;
        u32x4 o; o.x = pk2(s[0 * 33], s[1 * 33]); o.y = pk2(s[2 * 33], s[3 * 33]); o.z = pk2(s[4 * 33], s[5 * 33]); o.w = pk2(s[6 * 33], s[7 * 33]);
        *(u32x4*)(WT + (size_t)(n0 + n) * pitch + k0 + 8 * c) = o; }
    LDS_WAIT();
}
__device__ __forceinline__ void phase_weights(const Params& p, unsigned char* lds) {
    const int tid = threadIdx.x, wave = tid >> 6, lane = tid & 63;
    float* scr = (float*)(lds + wave * 16384);
    const int vb = ((int)blockIdx.x + (int)gridDim.x - 192 % (int)gridDim.x) % (int)gridDim.x;
    const int gw = vb * NWAVES + wave, NGW = gridDim.x * NWAVES;
    constexpr int I_IN = 32 * (NP / 32), I_UA = 16 * 64, I_UB = 16 * 64, I_O = 32 * 64, I_Q = 32 * 64;
    constexpr int NITEMS = I_IN + I_UA + I_UB + I_O + I_Q;
    bf16_t* win_t = (bf16_t*)((unsigned char*)p.out + OUT_WIN);
    for (int it = gw; it < NITEMS; it += NGW) {
        int r = it;
        if (r < I_IN) { transpose_item(p.in[6], 2048, 12368, win_t, NP / 32, r, lane, scr, 1, LDP); continue; } r -= I_IN;
        if (r < I_UA) { transpose_item(p.in[9], 1024, 2048, (bf16_t*)(p.ws + WS_WUA), 64, r, lane, scr, 0, 1024); continue; } r -= I_UA;
        if (r < I_UB) { transpose_item(p.in[10], 1024, 2048, (bf16_t*)(p.ws + WS_WUB), 64, r, lane, scr, 0, 1024); continue; } r -= I_UB;
        if (r < I_O) { transpose_item(p.in[11], 2048, 2048, (bf16_t*)(p.ws + WS_WOUT), 64, r, lane, scr, 0, 2048); continue; } r -= I_O;
        transpose_item(p.in[12], 2048, 2048, (bf16_t*)(p.ws + WS_WQ), 64, r, lane, scr, 0, 2048);
    }
    { const float* ks = p.in[13]; bf16_t* kd = (bf16_t*)(p.ws + WS_KEYS);
      for (int i = (blockIdx.x * NTHREADS + tid) * 4; i < 8 * 2 * 128 * 128; i += gridDim.x * NTHREADS * 4) { const f32x4 v = *(const f32x4*)(ks + i); u32x2 o; o.x = pk2(v[0], v[1]); o.y = pk2(v[2], v[3]); *(u32x2*)(kd + i) = o; } }
}

__device__ __forceinline__ void phase_norm_rows(const float* src, const float* gain, const float* shift, const float* scale, bf16_t* dst, int pitch) {
    const int tid = threadIdx.x, wave = tid >> 6, lane = tid & 63;
    const int gw = blockIdx.x * NWAVES + wave, NGW = gridDim.x * NWAVES;
    for (int row = gw; row < T; row += NGW) {
        const int b = row >> 11; const f32x4* xr = (const f32x4*)(src + (size_t)row * D) + lane;
        f32x4 v[8]; float ss = 0.f;
#pragma unroll
        for (int j = 0; j < 8; ++j) { v[j] = xr[64 * j]; ss += (v[j][0] * v[j][0] + v[j][1] * v[j][1]) + (v[j][2] * v[j][2] + v[j][3] * v[j][3]); }
        const float rstd = rsqrtf(wave_sum(ss) * (1.f / D) + NORM_EPS);
        u32x2* o8 = (u32x2*)(dst + (size_t)row * pitch) + lane;
#pragma unroll
        for (int j = 0; j < 8; ++j) { const int col = 4 * (lane + 64 * j);
            const f32x4 g = *(const f32x4*)(gain + col), sh = *(const f32x4*)(shift + (size_t)b * NADA + col), sc = *(const f32x4*)(scale + (size_t)b * NADA + col);
            f32x4 h;
#pragma unroll
            for (int e = 0; e < 4; ++e) h[e] = v[j][e] * rstd * g[e] * (1.f + sc[e]) + sh[e];
            u32x2 w; w.x = pk2(h[0], h[1]); w.y = pk2(h[2], h[3]); o8[64 * j] = w; }
    }
}

__device__ __forceinline__ void phase_x1_h2(const Params& p) {
    const int tid = threadIdx.x, wave = tid >> 6, lane = tid & 63;
    const float* x = p.in[0]; const float* gain = p.in[5]; const float* mod = (const float*)(p.ws + WS_MOD);
    const bf16_t* Y = (const bf16_t*)(p.ws + WS_Y); float* X1 = (float*)(p.ws + WS_X1); bf16_t* H2 = (bf16_t*)(p.ws + WS_H2);
    const int gw = blockIdx.x * NWAVES + wave, NGW = gridDim.x * NWAVES;
    for (int row = gw; row < T; row += NGW) {
        const int b = row >> 11; const float* mb = mod + (size_t)b * NADA;
        f32x4 v[8]; float ss = 0.f;
#pragma unroll
        for (int j = 0; j < 8; ++j) { const int col = 4 * (lane + 64 * j); const f32x4 xv = *(const f32x4*)(x + (size_t)row * D + col), g1 = *(const f32x4*)(mb + 4096 + col);
            const u32x2 yw = *(const u32x2*)(Y + (size_t)row * D + col);
            v[j][0] = xv[0] + g1[0] * bflo(yw.x); v[j][1] = xv[1] + g1[1] * bfhi(yw.x); v[j][2] = xv[2] + g1[2] * bflo(yw.y); v[j][3] = xv[3] + g1[3] * bfhi(yw.y);
            *(f32x4*)(X1 + (size_t)row * D + col) = v[j];
            ss += (v[j][0] * v[j][0] + v[j][1] * v[j][1]) + (v[j][2] * v[j][2] + v[j][3] * v[j][3]); }
        const float rstd = rsqrtf(wave_sum(ss) * (1.f / D) + NORM_EPS);
#pragma unroll
        for (int j = 0; j < 8; ++j) { const int col = 4 * (lane + 64 * j);
            const f32x4 g = *(const f32x4*)(gain + col), sh = *(const f32x4*)(mb + 3 * 2048 + col), sc = *(const f32x4*)(mb + 4 * 2048 + col);
            f32x4 h;
#pragma unroll
            for (int e = 0; e < 4; ++e) h[e] = v[j][e] * rstd * g[e] * (1.f + sc[e]) + sh[e];
            u32x2 w; w.x = pk2(h[0], h[1]); w.y = pk2(h[2], h[3]); *(u32x2*)(H2 + (size_t)row * D + col) = w; }
    }
}
__device__ __forceinline__ void phase_vt(const Params& p, unsigned char* lds, int vb, int vG) {
    const int tid = threadIdx.x, wave = tid >> 6, lane = tid & 63;
    bf16_t* tile = (bf16_t*)(lds + wave * 16384);
    const bf16_t* P = (const bf16_t*)(p.ws + WS_P); bf16_t* VT = (bf16_t*)(p.ws + WS_VT);
    const int gw = vb * NWAVES + wave, NGW = vG * NWAVES;
    for (int it = gw; it < 8 * 8 * 32 * 2; it += NGW) {
        const int dh = it & 1, kt = (it >> 1) & 31, h = (it >> 6) & 7, b = it >> 9;
        const int k0 = kt * 64, d0 = dh * 64;
#pragma unroll
        for (int i = 0; i < 8; ++i) { const int key = i * 8 + (lane >> 3), dc = lane & 7;
            const u32x4 v = *(const u32x4*)(P + (size_t)(b * SEQ + k0 + key) * NP + C_VA + h * 128 + d0 + dc * 8);
            bf16_t* t = tile + (dc * 8) * 72 + key;
            t[0 * 72] = (bf16_t)(v.x & 0xffff); t[1 * 72] = (bf16_t)(v.x >> 16); t[2 * 72] = (bf16_t)(v.y & 0xffff); t[3 * 72] = (bf16_t)(v.y >> 16);
            t[4 * 72] = (bf16_t)(v.z & 0xffff); t[5 * 72] = (bf16_t)(v.z >> 16); t[6 * 72] = (bf16_t)(v.w & 0xffff); t[7 * 72] = (bf16_t)(v.w >> 16); }
        LDS_WAIT();
#pragma unroll
        for (int i = 0; i < 8; ++i) { const int d = i * 8 + (lane >> 3), kc = lane & 7;
            const u32x4 v = *(const u32x4*)(tile + d * 72 + kc * 8);
            *(u32x4*)(VT + ((size_t)((b * 8 + h) * 128 + d0 + d)) * SEQ + k0 + kc * 8) = v; }
        LDS_WAIT();
    }
}

__device__ __forceinline__ unsigned ord_key(float s) { const unsigned u = __float_as_uint(s); return (u & 0x80000000u) ? ~u : (u | 0x80000000u); }
__device__ __forceinline__ int half_sum(int v) {
    v += __builtin_amdgcn_update_dpp(0, v, 0xB1, 0xF, 0xF, true);
    v += __builtin_amdgcn_update_dpp(0, v, 0x4E, 0xF, 0xF, true);
    v += __builtin_amdgcn_update_dpp(0, v, 0x141, 0xF, 0xF, true);
    v += __builtin_amdgcn_update_dpp(0, v, 0x140, 0xF, 0xF, true);
    v += __shfl_xor(v, 16);
    return v;
}
constexpr int IX_RS = 72, IX_STAGE = 32 * IX_RS * 2;
__device__ __forceinline__ void indexer_item(const Params& p, unsigned char* lds, int b, int c, int grp) {
    const int tid = threadIdx.x, w = __builtin_amdgcn_readfirstlane(tid >> 6), lane = tid & 63, r = lane & 31, hh = lane >> 5;
    const bf16_t* P = (const bf16_t*)(p.ws + WS_P); unsigned* MASK = (unsigned*)(p.ws + WS_MASK);
    const int pair = grp * 8 + w, q0 = b * SEQ + c * 64 + 2 * pair;
    bf16x8 af[4];
    { const int query = q0 + ((r >> 2) & 1), head = (r & 3) + 4 * (r >> 3);
      const bf16_t* qp = P + (size_t)query * NP + C_QI + head * 64 + 8 * hh;
#pragma unroll
      for (int ks = 0; ks < 4; ++ks) af[ks] = *(const bf16x8*)(qp + ks * 16); }
    float wv[16];
    { const u32x4 w0 = *(const u32x4*)(P + (size_t)(q0 + hh) * NP + C_WI), w1 = *(const u32x4*)(P + (size_t)(q0 + hh) * NP + C_WI + 8);
      wv[0] = bflo(w0.x); wv[1] = bfhi(w0.x); wv[2] = bflo(w0.y); wv[3] = bfhi(w0.y); wv[4] = bflo(w0.z); wv[5] = bfhi(w0.z); wv[6] = bflo(w0.w); wv[7] = bfhi(w0.w);
      wv[8] = bflo(w1.x); wv[9] = bfhi(w1.x); wv[10] = bflo(w1.y); wv[11] = bfhi(w1.y); wv[12] = bflo(w1.z); wv[13] = bfhi(w1.z); wv[14] = bflo(w1.w); wv[15] = bfhi(w1.w); }
    const int nkt = 2 * (c + 1);
    const bool ldr = tid < 256;
    const bf16_t* kg = P + (size_t)(b * SEQ + ((tid >> 3) & 31)) * NP + C_KI + (tid & 7) * 8;
    const int kls = ((tid >> 3) & 31) * IX_RS * 2 + (tid & 7) * 16;
    u32x4 kr = {0u, 0u, 0u, 0u};
    __syncthreads();
    if (ldr) { *(u32x4*)(lds + kls) = *(const u32x4*)kg; *(u32x4*)(lds + IX_STAGE + kls) = *(const u32x4*)(kg + (size_t)32 * NP); }
    if (ldr && 2 < nkt) kr = *(const u32x4*)(kg + (size_t)64 * NP);
    __syncthreads();
    unsigned kv[64];
#pragma unroll
    for (int kt = 0; kt < 64; ++kt) {
        kv[kt] = 0u;
        if (kt < nkt) {
            if (ldr && kt + 2 < nkt) *(u32x4*)(lds + ((kt + 2) % 3) * IX_STAGE + kls) = kr;
            if (ldr && kt + 3 < nkt) kr = *(const u32x4*)(kg + (size_t)((kt + 3) * 32) * NP);
            const bf16_t* Ks = (const bf16_t*)(lds + (kt % 3) * IX_STAGE);
            f32x16 acc;
#pragma unroll
            for (int i = 0; i < 16; ++i) acc[i] = 0.f;
#pragma unroll
            for (int ks = 0; ks < 4; ++ks) { const bf16x8 bfr = *(const bf16x8*)(Ks + r * IX_RS + ks * 16 + 8 * hh); acc = __builtin_amdgcn_mfma_f32_32x32x16_bf16(af[ks], bfr, acc, 0, 0, 0); }
            float sc = 0.f;
#pragma unroll
            for (int i = 0; i < 16; ++i) sc += wv[i] * fmaxf(acc[i], 0.f);
            kv[kt] = ord_key(sc);
            __syncthreads();
        }
    }
    unsigned thr = 0u;
    if (nkt > 8) {
        int cur = 1 << 20;
        for (int bit = 31; bit >= 0; --bit) {
            const unsigned cand = thr | (1u << bit); int cnt = 0;
#pragma unroll
            for (int kt = 0; kt < 32; ++kt) cnt += (kv[kt] >= cand) ? 1 : 0;
            if (nkt > 32) {
#pragma unroll
                for (int kt = 32; kt < 64; ++kt) cnt += (kv[kt] >= cand) ? 1 : 0; }
            cnt = half_sum(cnt);
            if (cnt >= 256) { thr = cand; cur = cnt; }
            if (__builtin_amdgcn_ballot_w64(cur != 256) == 0ull) break;
        }
    }
    int cge = 0;
#pragma unroll
    for (int kt = 0; kt < 64; ++kt) cge += (kv[kt] >= thr && kv[kt] != 0u) ? 1 : 0;
    cge = half_sum(cge);
    const bool ties = (thr != 0u) && (cge > 256);
    unsigned m0 = 0u, m1 = 0u;
    if (__builtin_amdgcn_ballot_w64(ties) == 0ull) {
#pragma unroll
        for (int kt = 0; kt < 64; ++kt) { const unsigned long long bm = __builtin_amdgcn_ballot_w64(kv[kt] >= thr && kv[kt] != 0u);
            if (lane == kt) { m0 = (unsigned)bm; m1 = (unsigned)(bm >> 32); } }
    } else {
        int cgt = 0;
#pragma unroll
        for (int kt = 0; kt < 64; ++kt) cgt += (kv[kt] > thr) ? 1 : 0;
        cgt = half_sum(cgt);
        const int need = ties ? (256 - cgt) : (1 << 30); int run = 0;
#pragma unroll
        for (int kt = 0; kt < 64; ++kt) { const bool tie = ties && (kv[kt] == thr); const unsigned long long tb = __builtin_amdgcn_ballot_w64(tie);
            const unsigned th = hh ? (unsigned)(tb >> 32) : (unsigned)tb; const int rank = run + __builtin_popcount(th & ((1u << r) - 1u));
            const bool sel = ties ? ((kv[kt] > thr) || (tie && rank < need)) : (kv[kt] >= thr && kv[kt] != 0u);
            run += __builtin_popcount(th);
            const unsigned long long bm = __builtin_amdgcn_ballot_w64(sel);
            if (lane == kt) { m0 = (unsigned)bm; m1 = (unsigned)(bm >> 32); } }
    }
    { const int qpos = c * 64 + 2 * pair; unsigned* mt = MASK + ((size_t)(b * 64 + lane)) * SEQ + qpos; mt[0] = m0; mt[1] = m1; }
}
__device__ __forceinline__ void phase_indexer(const Params& p, unsigned char* lds, int vb, int vG) {
    const int G = vG;
    for (int rd = 0;; ++rd) {
        const int base = rd * G; if (base >= 1024) break;
        const int pos = (rd & 1) ? (G - 1 - vb) : vb; const int i = base + pos; if (i >= 1024) continue;
        indexer_item(p, lds, (i >> 2) & 7, 31 - (i >> 5), i & 3);
    }
}

constexpr int HG_RS = 136, HG_TS = 72, HG_SS = 136;
constexpr int HG_QT = 0, HG_QH = 17408, HG_KT = 34816, HG_KHT = 52224, HG_VT = 70656, HG_ST = 89088, HG_DEC = 123904, HG_SSQ = 124416;
__device__ __forceinline__ void hgrn_item(const Params& p, unsigned char* lds, int item) {
    const int tid = threadIdx.x, w = tid >> 6, lane = tid & 63, r = lane & 31, hh = lane >> 5;
    const int b = item >> 3, h = item & 7;
    const bf16_t* P = (const bf16_t*)(p.ws + WS_P); bf16_t* REC = (bf16_t*)((unsigned char*)p.out + OUT_REC);
    bf16_t* QT = (bf16_t*)(lds + HG_QT); bf16_t* QH = (bf16_t*)(lds + HG_QH); bf16_t* KT = (bf16_t*)(lds + HG_KT); bf16_t* KHT = (bf16_t*)(lds + HG_KHT); bf16_t* VT = (bf16_t*)(lds + HG_VT);
    bf16_t* ST = (bf16_t*)(lds + HG_ST); float* DEC = (float*)(lds + HG_DEC); float* SSQ = (float*)(lds + HG_SSQ);
    const int seg = lane >> 4, dl = lane & 15, d = 16 * w + dl;
    const float lb = sigmoidf_(p.in[7][h * 128 + d] - p.in[7][1024 + h * 128 + d]);
    const int tb = w & 1, eb = w >> 1, sdb = w & 3, seb0 = 2 * (w >> 2);
    const float gain_e = p.in[8][32 * eb + r];
    f32x16 S0, S1;
#pragma unroll
    for (int i = 0; i < 16; ++i) { S0[i] = 0.f; S1[i] = 0.f; }
    __syncthreads();
    for (int i = tid; i < 128 * HG_SS / 2; i += NTHREADS) ((unsigned*)ST)[i] = 0u;
    unsigned short rq[16], rf[16], ri[16];
    { const bf16_t* src = P + (size_t)(b * SEQ + 16 * seg) * NP + h * 128 + d;
#pragma unroll
      for (int i = 0; i < 16; ++i) { rq[i] = src[(size_t)i * NP + C_QB]; rf[i] = src[(size_t)i * NP + C_FB]; ri[i] = src[(size_t)i * NP + C_IB]; } }
#pragma unroll 1
    for (int n = 0; n < 32; ++n) {
        {
            float lf[16], kk[16];
            float run = 0.f;
#pragma unroll
            for (int i = 0; i < 16; ++i) { const float f = lb + (1.f - lb) * sigmoidf_(bf2f(rf[i])); kk[i] = 1.f - f; run += __logf(f); lf[i] = run; }
            const float p0 = __shfl(run, dl), p1 = __shfl(run, 16 + dl), p2 = __shfl(run, 32 + dl), p3 = __shfl(run, 48 + dl);
            const float off = (seg > 0 ? p0 : 0.f) + (seg > 1 ? p1 : 0.f) + (seg > 2 ? p2 : 0.f), bL = (p0 + p1) + (p2 + p3), bref = p0 + p1;
            unsigned kh[8], vv[8];
#pragma unroll
            for (int i = 0; i < 16; ++i) { const float bt = off + lf[i]; const float qs = siluf_(bf2f(rq[i]));
                const float e1 = __expf(bt - bref), e2 = __expf(bt), e3 = __builtin_amdgcn_rcpf(e1), e4 = __expf(bL - bt);
                const int t = 16 * seg + i;
                QT[t * HG_RS + d] = (bf16_t)f2bf(qs * e1); QH[t * HG_RS + d] = (bf16_t)f2bf(qs * e2); KT[t * HG_RS + d] = (bf16_t)f2bf(kk[i] * e3);
                const unsigned khv = f2bf(kk[i] * e4);
                if (i & 1) { kh[i >> 1] |= khv << 16; vv[i >> 1] |= (unsigned)ri[i] << 16; } else { kh[i >> 1] = khv; vv[i >> 1] = (unsigned)ri[i]; } }
            *(u32x4*)(KHT + d * HG_TS + 16 * seg) = (u32x4){kh[0], kh[1], kh[2], kh[3]}; *(u32x4*)(KHT + d * HG_TS + 16 * seg + 8) = (u32x4){kh[4], kh[5], kh[6], kh[7]};
            *(u32x4*)(VT + d * HG_TS + 16 * seg) = (u32x4){vv[0], vv[1], vv[2], vv[3]}; *(u32x4*)(VT + d * HG_TS + 16 * seg + 8) = (u32x4){vv[4], vv[5], vv[6], vv[7]};
            if (seg == 0) DEC[d] = __expf(bL);
        }
        __syncthreads();
        if (n < 31) { const bf16_t* src = P + (size_t)(b * SEQ + (n + 1) * 64 + 16 * seg) * NP + h * 128 + d;
#pragma unroll
            for (int i = 0; i < 16; ++i) { rq[i] = src[(size_t)i * NP + C_QB]; rf[i] = src[(size_t)i * NP + C_FB]; ri[i] = src[(size_t)i * NP + C_IB]; } }
        unsigned short gbv[16];
        { const bf16_t* gsrc = P + (size_t)(b * SEQ + n * 64 + 32 * tb + 4 * hh) * NP + C_GB + h * 128 + 32 * eb + r;
#pragma unroll
          for (int i = 0; i < 16; ++i) gbv[i] = gsrc[(size_t)((i & 3) + 8 * (i >> 2)) * NP]; }
        f32x16 X0, X1, o;
#pragma unroll
        for (int i = 0; i < 16; ++i) { X0[i] = 0.f; X1[i] = 0.f; o[i] = 0.f; }
#pragma unroll
        for (int ks = 0; ks < 8; ++ks) { const bf16x8 bq = *(const bf16x8*)(QT + (32 * tb + r) * HG_RS + 16 * ks + 8 * hh);
            const bf16x8 a0 = *(const bf16x8*)(KT + r * HG_RS + 16 * ks + 8 * hh); X0 = __builtin_amdgcn_mfma_f32_32x32x16_bf16(a0, bq, X0, 0, 0, 0);
            if (tb == 1) { const bf16x8 a1 = *(const bf16x8*)(KT + (32 + r) * HG_RS + 16 * ks + 8 * hh); X1 = __builtin_amdgcn_mfma_f32_32x32x16_bf16(a1, bq, X1, 0, 0, 0); } }
#pragma unroll
        for (int i = 0; i < 16; ++i) { const bool keep = ((i & 3) + 8 * (i >> 2) + 4 * hh) <= r; if (tb == 0) X0[i] = keep ? X0[i] : 0.f; else X1[i] = keep ? X1[i] : 0.f; }
#pragma unroll
        for (int sb = 0; sb < 2; ++sb) { if (sb <= tb) {
#pragma unroll
            for (int s2 = 0; s2 < 2; ++s2) { u32x4 aw;
                if (sb == 0) { aw.x = pk2(X0[8 * s2], X0[8 * s2 + 1]); aw.y = pk2(X0[8 * s2 + 2], X0[8 * s2 + 3]); aw.z = pk2(X0[8 * s2 + 4], X0[8 * s2 + 5]); aw.w = pk2(X0[8 * s2 + 6], X0[8 * s2 + 7]); }
                else { aw.x = pk2(X1[8 * s2], X1[8 * s2 + 1]); aw.y = pk2(X1[8 * s2 + 2], X1[8 * s2 + 3]); aw.z = pk2(X1[8 * s2 + 4], X1[8 * s2 + 5]); aw.w = pk2(X1[8 * s2 + 6], X1[8 * s2 + 7]); }
                const bf16_t* vp = VT + (32 * eb + r) * HG_TS + 32 * sb + 16 * s2 + 4 * hh;
                const u32x2 lo = *(const u32x2*)vp, hi = *(const u32x2*)(vp + 8); const u32x4 bw = {lo.x, lo.y, hi.x, hi.y};
                o = __builtin_amdgcn_mfma_f32_32x32x16_bf16(__builtin_bit_cast(bf16x8, aw), __builtin_bit_cast(bf16x8, bw), o, 0, 0, 0); } } }
#pragma unroll
        for (int ks = 0; ks < 8; ++ks) { const bf16x8 aq = *(const bf16x8*)(QH + (32 * tb + r) * HG_RS + 16 * ks + 8 * hh), bs = *(const bf16x8*)(ST + (32 * eb + r) * HG_SS + 16 * ks + 8 * hh);
            o = __builtin_amdgcn_mfma_f32_32x32x16_bf16(aq, bs, o, 0, 0, 0); }
        { float a8[8], a4[4], a2[2], a1;
#pragma unroll
          for (int i = 0; i < 8; ++i) { const float lo = o[i] * o[i], hi = o[i + 8] * o[i + 8]; const bool up = lane & 16; const float keep = up ? hi : lo, send = up ? lo : hi; a8[i] = keep + __shfl_xor(send, 16); }
#pragma unroll
          for (int i = 0; i < 4; ++i) { const bool up = lane & 8; const float keep = up ? a8[i + 4] : a8[i], send = up ? a8[i] : a8[i + 4]; a4[i] = keep + __shfl_xor(send, 8); }
#pragma unroll
          for (int i = 0; i < 2; ++i) { const bool up = lane & 4; const float keep = up ? a4[i + 2] : a4[i], send = up ? a4[i] : a4[i + 2]; a2[i] = keep + __shfl_xor(send, 4); }
          { const bool up = lane & 2; const float keep = up ? a2[1] : a2[0], send = up ? a2[0] : a2[1]; a1 = keep + __shfl_xor(send, 2); }
          a1 += __shfl_xor(a1, 1);
          const int ri2 = (lane >> 1) & 15;
          if ((lane & 1) == 0) SSQ[(32 * tb + (ri2 & 3) + 8 * (ri2 >> 2) + 4 * hh) * 4 + eb] = a1; }
        { float dc[16];
#pragma unroll
          for (int g4 = 0; g4 < 4; ++g4) { const f32x4 dv = *(const f32x4*)(DEC + 32 * sdb + 8 * g4 + 4 * hh); dc[4 * g4] = dv[0]; dc[4 * g4 + 1] = dv[1]; dc[4 * g4 + 2] = dv[2]; dc[4 * g4 + 3] = dv[3]; }
#pragma unroll
          for (int i = 0; i < 16; ++i) { S0[i] *= dc[i]; S1[i] *= dc[i]; }
#pragma unroll
          for (int ss = 0; ss < 4; ++ss) { const bf16x8 a = *(const bf16x8*)(KHT + (32 * sdb + r) * HG_TS + 16 * ss + 8 * hh);
              const bf16x8 b0 = *(const bf16x8*)(VT + (32 * seb0 + r) * HG_TS + 16 * ss + 8 * hh), b1 = *(const bf16x8*)(VT + (32 * (seb0 + 1) + r) * HG_TS + 16 * ss + 8 * hh);
              S0 = __builtin_amdgcn_mfma_f32_32x32x16_bf16(a, b0, S0, 0, 0, 0); S1 = __builtin_amdgcn_mfma_f32_32x32x16_bf16(a, b1, S1, 0, 0, 0); } }
        __syncthreads();
#pragma unroll
        for (int g4 = 0; g4 < 4; ++g4) { const int d0 = 32 * sdb + 8 * g4 + 4 * hh;
            *(u32x2*)(ST + (32 * seb0 + r) * HG_SS + d0) = (u32x2){pk2(S0[4 * g4], S0[4 * g4 + 1]), pk2(S0[4 * g4 + 2], S0[4 * g4 + 3])};
            *(u32x2*)(ST + (32 * (seb0 + 1) + r) * HG_SS + d0) = (u32x2){pk2(S1[4 * g4], S1[4 * g4 + 1]), pk2(S1[4 * g4 + 2], S1[4 * g4 + 3])}; }
        { bf16_t* dst = REC + (size_t)(b * SEQ + n * 64 + 32 * tb + 4 * hh) * 1024 + h * 128 + 32 * eb + r;
#pragma unroll
          for (int i = 0; i < 16; ++i) { const int tr = (i & 3) + 8 * (i >> 2); const f32x4 q4 = *(const f32x4*)(SSQ + (32 * tb + tr + 4 * hh) * 4);
              const float rstd = rsqrtf(((q4[0] + q4[1]) + (q4[2] + q4[3])) * (1.f / 128.f) + NORM_EPS);
              dst[(size_t)tr * 1024] = (bf16_t)f2bf(o[i] * rstd * gain_e * siluf_(bf2f(gbv[i]))); } }
    }
}
__device__ __forceinline__ void phase_hgrn(const Params& p, unsigned char* lds, int vb, int vG) {
    for (int it = vb; it < 64; it += vG) hgrn_item(p, lds, it);
}

constexpr int AT_KRS = 136, AT_VRS = 36, AT_KB = 32 * AT_KRS * 2, AT_VB = 128 * AT_VRS * 2, AT_STAGE = AT_KB + AT_VB;
__device__ __forceinline__ void attn_item(const Params& p, unsigned char* lds, int b, int head, int cq) {
    const int tid = threadIdx.x, w = __builtin_amdgcn_readfirstlane(tid >> 6), lane = tid & 63, r = lane & 31, hh = lane >> 5;
    const bf16_t* P = (const bf16_t*)(p.ws + WS_P); const bf16_t* VT = (const bf16_t*)(p.ws + WS_VT); const unsigned* MASKT = (const unsigned*)(p.ws + WS_MASK);
    bf16_t* AO = (bf16_t*)((unsigned char*)p.out + OUT_AO);
    const int c = 4 * cq + (w >> 1), qpos = c * 64 + (w & 1) * 32 + r, tq = b * SEQ + qpos;
    const int nkt_w = 2 * (c + 1), nkt = 8 * (cq + 1);
    const bf16_t* kg = P + (size_t)(b * SEQ + (tid >> 4)) * NP + C_KA + head * 128 + (tid & 15) * 8;
    const bf16_t* vg = VT + (size_t)((b * 8 + head) * 128 + (tid >> 2)) * SEQ + (tid & 3) * 8;
    const int kls = (tid >> 4) * AT_KRS * 2 + (tid & 15) * 16, vls = AT_KB + (tid >> 2) * AT_VRS * 2 + (tid & 3) * 16;
    bf16x8 qf[8];
    { const bf16_t* qp = P + (size_t)tq * NP + C_QA + head * 128 + 8 * hh;
#pragma unroll
      for (int ks = 0; ks < 8; ++ks) qf[ks] = *(const bf16x8*)(qp + ks * 16); }
    f32x16 o[4];
#pragma unroll
    for (int db = 0; db < 4; ++db)
#pragma unroll
        for (int i = 0; i < 16; ++i) o[db][i] = 0.f;
    float mrun = -1e30f, lsum = 0.f;
    const float sc = 0.08838834764831845f * 1.4426950408889634f;
    __syncthreads();
    u32x4 krA, vrA, krB, vrB;
#pragma unroll
    for (int t0 = 0; t0 < 2; ++t0) { krA = *(const u32x4*)(kg + (size_t)(t0 * 32) * NP); vrA = *(const u32x4*)(vg + t0 * 32);
        *(u32x4*)(lds + t0 * AT_STAGE + kls) = krA; *(u32x2*)(lds + t0 * AT_STAGE + vls) = (u32x2){vrA.x, vrA.y}; *(u32x2*)(lds + t0 * AT_STAGE + vls + 8) = (u32x2){vrA.z, vrA.w}; }
    krA = *(const u32x4*)(kg + (size_t)(2 * 32) * NP); vrA = *(const u32x4*)(vg + 2 * 32);
    krB = *(const u32x4*)(kg + (size_t)(3 * 32) * NP); vrB = *(const u32x4*)(vg + 3 * 32);
    unsigned mwA = MASKT[(size_t)(b * 64) * SEQ + qpos], mwB = MASKT[(size_t)(b * 64 + 1) * SEQ + qpos];
    __syncthreads();
    int st = 0, st2 = 2;
#define AT_TILE(KT, KR, VR, MW) do { const int kt_ = (KT); \
        if (kt_ + 2 < nkt) { *(u32x4*)(lds + st2 * AT_STAGE + kls) = KR; *(u32x2*)(lds + st2 * AT_STAGE + vls) = (u32x2){VR.x, VR.y}; *(u32x2*)(lds + st2 * AT_STAGE + vls + 8) = (u32x2){VR.z, VR.w}; } \
        if (kt_ + 4 < nkt) { KR = *(const u32x4*)(kg + (size_t)((kt_ + 4) * 32) * NP); VR = *(const u32x4*)(vg + (kt_ + 4) * 32); } \
        if (kt_ < nkt_w) { \
            const unsigned mwc = MW; \
            if (kt_ + 2 < nkt_w) MW = MASKT[(size_t)(b * 64 + kt_ + 2) * SEQ + qpos]; \
            const bf16_t* Ks = (const bf16_t*)(lds + st * AT_STAGE); const bf16_t* Vs = (const bf16_t*)(lds + st * AT_STAGE + AT_KB); \
            f32x16 s; \
            _Pragma("unroll") for (int i = 0; i < 16; ++i) s[i] = 0.f; \
            _Pragma("unroll") for (int ks = 0; ks < 8; ++ks) { const bf16x8 kf = *(const bf16x8*)(Ks + r * AT_KRS + ks * 16 + 8 * hh); s = __builtin_amdgcn_mfma_f32_32x32x16_bf16(kf, qf[ks], s, 0, 0, 0); } \
            float mx = -1e30f; \
            _Pragma("unroll") for (int i = 0; i < 16; ++i) { const int bit = (i & 3) + 8 * (i >> 2) + 4 * hh; const bool ok = (mwc >> bit) & 1u; s[i] = ok ? s[i] * sc : -1e30f; mx = fmaxf(mx, s[i]); } \
            mx = fmaxf(mx, __shfl_xor(mx, 32)); \
            const float mnew = fmaxf(mrun, mx), alpha = exp2f(mrun - mnew); mrun = mnew; \
            float ps = 0.f; float pv[16]; \
            _Pragma("unroll") for (int i = 0; i < 16; ++i) { const float e = (s[i] > -1e29f) ? exp2f(s[i] - mnew) : 0.f; pv[i] = e; ps += e; } \
            lsum = lsum * alpha + ps; \
            _Pragma("unroll") for (int db = 0; db < 4; ++db) _Pragma("unroll") for (int i = 0; i < 16; ++i) o[db][i] *= alpha; \
            bf16x8 pf[2]; \
            _Pragma("unroll") for (int s2 = 0; s2 < 2; ++s2) { u32x4 wv; wv.x = pk2(pv[8 * s2 + 0], pv[8 * s2 + 1]); wv.y = pk2(pv[8 * s2 + 2], pv[8 * s2 + 3]); wv.z = pk2(pv[8 * s2 + 4], pv[8 * s2 + 5]); wv.w = pk2(pv[8 * s2 + 6], pv[8 * s2 + 7]); pf[s2] = __builtin_bit_cast(bf16x8, wv); } \
            _Pragma("unroll") for (int db = 0; db < 4; ++db) _Pragma("unroll") for (int s2 = 0; s2 < 2; ++s2) { const bf16_t* vp = Vs + (db * 32 + r) * AT_VRS + 16 * s2 + 4 * hh; const u32x2 lo = *(const u32x2*)vp, hi = *(const u32x2*)(vp + 8); \
                    const u32x4 wv = {lo.x, lo.y, hi.x, hi.y}; \
                    o[db] = __builtin_amdgcn_mfma_f32_32x32x16_bf16(__builtin_bit_cast(bf16x8, wv), pf[s2], o[db], 0, 0, 0); } \
        } \
        __syncthreads(); \
        st = (st == 2) ? 0 : st + 1; st2 = (st2 == 2) ? 0 : st2 + 1; } while (0)
#pragma unroll 1
    for (int kt = 0; kt < nkt; kt += 2) { AT_TILE(kt, krA, vrA, mwA); AT_TILE(kt + 1, krB, vrB, mwB); }
#undef AT_TILE
    const float l = lsum + __shfl_xor(lsum, 32), inv = 1.f / l;
    bf16_t* op = AO + (size_t)tq * 1024 + head * 128 + 4 * hh;
#pragma unroll
    for (int db = 0; db < 4; ++db)
#pragma unroll
        for (int g4 = 0; g4 < 4; ++g4) { u32x2 wv; wv.x = pk2(o[db][4 * g4] * inv, o[db][4 * g4 + 1] * inv); wv.y = pk2(o[db][4 * g4 + 2] * inv, o[db][4 * g4 + 3] * inv);
            *(u32x2*)(op + db * 32 + 8 * g4) = wv; }
}
__device__ __forceinline__ void phase_attn(const Params& p, unsigned char* lds, int vb, int vG) {
    const int G = vG;
    for (int rd = 0;; ++rd) {
        const int base = rd * G; if (base >= 512) break;
        const int pos = (rd & 1) ? (G - 1 - vb) : vb; const int i = base + pos; if (i >= 512) continue;
        attn_item(p, lds, (i >> 3) & 7, i & 7, 7 - (i >> 6));
    }
}
__device__ __forceinline__ void phase_uv(const Params& p) {
    const int tid = threadIdx.x, wave = tid >> 6, lane = tid & 63;
    const int gw = blockIdx.x * NWAVES + wave, NGW = gridDim.x * NWAVES;
    for (int it = gw; it < 2 * 16384; it += NGW) {
        const int tbl = it >> 14, row = it & 16383;
        const float* src = (tbl ? p.in[15] : p.in[14]) + (size_t)row * 2048 + 32 * lane;
        unsigned char* dst = p.ws + (tbl ? WS_V8 : WS_U8); float* isc = (float*)(p.ws + (tbl ? WS_ISV : WS_ISU));
        f32x4 v[8]; float am = 0.f;
#pragma unroll
        for (int j = 0; j < 8; ++j) { v[j] = *(const f32x4*)(src + 4 * j); am = fmaxf(am, fmaxf(fmaxf(fabsf(v[j][0]), fabsf(v[j][1])), fmaxf(fabsf(v[j][2]), fabsf(v[j][3])))); }
#pragma unroll
        for (int o = 1; o < 64; o <<= 1) am = fmaxf(am, __shfl_xor(am, o));
        am = fmaxf(am, 1e-30f); const float sc = 256.f / am;
        unsigned wq[8];
#pragma unroll
        for (int j = 0; j < 8; ++j) { int pk = 0; pk = __builtin_amdgcn_cvt_pk_fp8_f32(v[j][0] * sc, v[j][1] * sc, pk, false); pk = __builtin_amdgcn_cvt_pk_fp8_f32(v[j][2] * sc, v[j][3] * sc, pk, true); wq[j] = (unsigned)pk; }
        unsigned char* d = dst + (size_t)(lane >> 2) * (2u << 20) + (size_t)row * 128 + (lane & 3) * 32;
        *(u32x4*)d = (u32x4){wq[0], wq[1], wq[2], wq[3]}; *(u32x4*)(d + 16) = (u32x4){wq[4], wq[5], wq[6], wq[7]};
        if (lane == 0) isc[row] = am * (1.f / 256.f);
    }
}

#define INS16(v, x) do { _Pragma("unroll") for (int _j = 15; _j >= 1; --_j) v[_j] = __builtin_amdgcn_fmed3f(v[_j - 1], v[_j], (x)); v[0] = fmaxf(v[0], (x)); } while (0)
__device__ __forceinline__ void peer_half_top16(const bf16_t* QP, const bf16_t* KEYS, int tok, int p, int hf, int r, int hh, float (&v)[16]) {
    bf16x8 qf[8];
    { const bf16_t* qp = QP + (size_t)tok * D + p * 256 + hf * 128 + 8 * hh;
#pragma unroll
      for (int ks = 0; ks < 8; ++ks) qf[ks] = *(const bf16x8*)(qp + ks * 16); }
#pragma unroll
    for (int k = 0; k < 16; ++k) v[k] = -3.0e38f;
    const bf16_t* kb = KEYS + (size_t)((p * 2 + hf) * 128 + r) * 128 + 8 * hh;
#pragma unroll 1
    for (int nb = 0; nb < 4; ++nb) {
        f32x16 acc;
#pragma unroll
        for (int i = 0; i < 16; ++i) acc[i] = 0.f;
#pragma unroll
        for (int ks = 0; ks < 8; ++ks) { const bf16x8 kf = *(const bf16x8*)(kb + (size_t)(nb * 32) * 128 + ks * 16); acc = __builtin_amdgcn_mfma_f32_32x32x16_bf16(kf, qf[ks], acc, 0, 0, 0); }
#pragma unroll
        for (int i = 0; i < 16; ++i) { const unsigned xi = (unsigned)(nb * 32 + (i & 3) + 8 * (i >> 2) + 4 * hh); const float x = __uint_as_float((__float_as_uint(acc[i]) & ~0x7fu) | xi); INS16(v, x); }
    }
    float ov[16];
#pragma unroll
    for (int k = 0; k < 16; ++k) ov[k] = __shfl_xor(v[k], 32);
#pragma unroll
    for (int k = 0; k < 16; ++k) INS16(v, ov[k]);
}
__device__ __forceinline__ void phase_peer_topk(const Params& p) {
    const int tid = threadIdx.x, wave = tid >> 6, lane = tid & 63, r = lane & 31, hh = lane >> 5;
    const bf16_t* QP = (const bf16_t*)(p.ws + WS_QP); const bf16_t* KEYS = (const bf16_t*)(p.ws + WS_KEYS);
    int* EIDX = (int*)(p.ws + WS_EIDX); float* EGATE = (float*)(p.ws + WS_EGATE);
    const int gw = blockIdx.x * NWAVES + wave, NGW = gridDim.x * NWAVES;
    for (int it = gw; it < 512 * 8; it += NGW) {
        const int tg = it >> 3, hd = it & 7, tok = tg * 32 + r;
        float va[16], vb[16];
        peer_half_top16(QP, KEYS, tok, hd, 0, r, hh, va);
        peer_half_top16(QP, KEYS, tok, hd, 1, r, hh, vb);
        float bv[16];
#pragma unroll
        for (int k = 0; k < 16; ++k) bv[k] = -3.0e38f;
#pragma unroll
        for (int a = 0; a < 16; ++a)
#pragma unroll
            for (int b2 = 0; b2 < 16; ++b2) if ((a + 1) * (b2 + 1) <= 16) { const float x = va[a] + vb[b2]; INS16(bv, x); }
        float se = 0.f;
#pragma unroll
        for (int k = 0; k < 16; ++k) se += __expf(bv[k] - bv[0]);
        const float inv = 1.f / se, thr = bv[15], top = bv[0];
        int cnt = 0; int* ei = EIDX + (size_t)tok * 128 + hd * 16; float* eg = EGATE + (size_t)tok * 128 + hd * 16;
#pragma unroll
        for (int a = 0; a < 16; ++a)
#pragma unroll
            for (int b2 = 0; b2 < 16; ++b2) if ((a + 1) * (b2 + 1) <= 16) { const float x = va[a] + vb[b2];
                if (x >= thr && cnt < 16) { if (hh == 0) { ei[cnt] = (int)((__float_as_uint(va[a]) & 0x7fu) * 128u + (__float_as_uint(vb[b2]) & 0x7fu)); eg[cnt] = __expf(x - top) * inv; } ++cnt; } }
    }
}

typedef __bf16 bf16x2_t __attribute__((ext_vector_type(2)));
__device__ __forceinline__ float gelu_erf(float v) {
    const float av = fabsf(v), d = av * 0.2316418882f + 1.0f, t = __builtin_amdgcn_rcpf(d);
    float q = t * 0.5307027145f + (-0.7265760135f); q = q * t + 0.7107068705f; q = q * t + (-0.142248368f); q = q * t + 0.127414796f; q = q * t;
    const float e = __builtin_amdgcn_exp2f((v * v) * (-0.72134752044f));
    const float m = v * (q * e), r = v - m;
    return v < 0.f ? m : r;
}
__device__ __forceinline__ float dot2bf(unsigned a, unsigned b, float c) { return __builtin_amdgcn_fdot2_f32_bf16(__builtin_bit_cast(bf16x2_t, a), __builtin_bit_cast(bf16x2_t, b), c, false); }
__device__ __forceinline__ float dpp_f(float x, int ctrl_xor1_xor2_mirror) {
    const int v = __float_as_int(x);
    if (ctrl_xor1_xor2_mirror == 0) return __int_as_float(__builtin_amdgcn_update_dpp(0, v, 0xB1, 0xF, 0xF, true));
    if (ctrl_xor1_xor2_mirror == 1) return __int_as_float(__builtin_amdgcn_update_dpp(0, v, 0x4E, 0xF, 0xF, true));
    return __int_as_float(__builtin_amdgcn_update_dpp(0, v, 0x141, 0xF, 0xF, true));
}
typedef float f32x2v __attribute__((ext_vector_type(2)));
__device__ __forceinline__ void unpack8(const u32x4 w, float* f) { f[0] = bflo(w.x); f[1] = bfhi(w.x); f[2] = bflo(w.y); f[3] = bfhi(w.y); f[4] = bflo(w.z); f[5] = bfhi(w.z); f[6] = bflo(w.w); f[7] = bfhi(w.w); }
__device__ __forceinline__ void cvt16(const u32x4 w, float* f) {
#pragma unroll
    for (int q = 0; q < 4; ++q) { const f32x2v lo = __builtin_amdgcn_cvt_pk_f32_fp8((int)w[q], false), hi = __builtin_amdgcn_cvt_pk_f32_fp8((int)w[q], true);
        f[4 * q] = lo.x; f[4 * q + 1] = lo.y; f[4 * q + 2] = hi.x; f[4 * q + 3] = hi.y; }
}
__device__ __forceinline__ void phase_experts(const Params& p, unsigned char* lds) {
    const int tid = threadIdx.x, wave = __builtin_amdgcn_readfirstlane(tid >> 6), lane = tid & 63, rr = lane >> 3, cc = lane & 7; const bool odd = cc & 1;
    const bf16_t* H2 = (const bf16_t*)(p.ws + WS_H2); const unsigned char* U8 = p.ws + WS_U8; const unsigned char* V8 = p.ws + WS_V8;
    const float* ISU = (const float*)(p.ws + WS_ISU); const float* ISV = (const float*)(p.ws + WS_ISV);
    const int* EIDX = (const int*)(p.ws + WS_EIDX); const float* EGATE = (const float*)(p.ws + WS_EGATE);
    const float* mod = (const float*)(p.ws + WS_MOD); const float* fin = p.in[16]; float* out = p.out; const float* X1 = (const float*)(p.ws + WS_X1);
    unsigned* offs = (unsigned*)lds; float* gts = (float*)(lds + 32768); float* rstl = (float*)(lds + 65536);
    const unsigned xcc = (unsigned)__builtin_amdgcn_s_getreg((3 << 11) | 20) & 7u; const unsigned cc16 = cc * 16;
    for (int tile = blockIdx.x; tile < T / 64; tile += gridDim.x) {
        const int tok0 = tile * 64, b = tok0 >> 11;
        __syncthreads();
        for (int i = tid; i < 8192; i += NTHREADS) { const int tl = i >> 7, j = i & 127, g = j >> 3, r8 = j & 7;
            offs[(tl * 8 + r8) * 16 + g] = (unsigned)EIDX[(size_t)tok0 * 128 + i] * 128u; gts[(tl * 8 + r8) * 16 + g] = EGATE[(size_t)tok0 * 128 + i]; }
        __syncthreads();
#pragma unroll 1
        for (int half = 0; half < 2; ++half) {
            const int tlb = wave * 8 + half * 4;
            u32x4 dA[16], dB[16], hA0, hA1, hB0, hB1;
#ifndef EXP_REP_U
#define EXP_REP_U 0
#endif
#ifndef EXP_REP_V
#define EXP_REP_V 0
#endif
#define EX_SLICE(i_) ((xcc * 2u + (unsigned)(i_)) & 15u)
#define EX_LOAD(buf, TBL, i_, k_) do { const unsigned char* tb_ = (TBL) + (size_t)EX_SLICE(i_) * (2u << 20); u32x4 o4_[4]; \
    _Pragma("unroll") for (int q_ = 0; q_ < 4; ++q_) o4_[q_] = *(const u32x4*)(offs + ((tlb + (k_)) * 8 + rr) * 16 + 4 * q_); \
    _Pragma("unroll") for (int g_ = 0; g_ < 16; ++g_) buf[g_] = *(const u32x4*)(tb_ + (o4_[g_ >> 2][g_ & 3] + cc16)); } while (0)
#define EX_LOADH(h0, h1, i_, k_) do { const bf16_t* hp_ = H2 + (size_t)(tok0 + tlb + (k_)) * D + EX_SLICE(i_) * 128 + cc * 16; h0 = *(const u32x4*)hp_; h1 = *(const u32x4*)(hp_ + 8); } while (0)
#define EX_DOT16(acc, WSRC, hf) do { u32x4 w_ = WSRC; asm volatile("" : "+v"(w_.x), "+v"(w_.y), "+v"(w_.z), "+v"(w_.w), "+v"(ch_)); float f_[16]; cvt16(w_, f_); _Pragma("unroll") for (int e_ = 0; e_ < 16; ++e_) acc = fmaf(f_[e_], hf[e_], acc); ch_ = acc; } while (0)
#define EX_UCOMP(buf, h0, h1, k_) do { float hf_[16]; unpack8(h0, hf_); unpack8(h1, hf_ + 8); float ch_ = 0.f; \
    _Pragma("unroll") for (int j_ = 0; j_ < 8; ++j_) { float te_ = 0.f, to_ = 0.f; EX_DOT16(te_, buf[2 * j_], hf_); __builtin_amdgcn_sched_barrier(0); EX_DOT16(to_, buf[2 * j_ + 1], hf_); \
    const float my_ = odd ? to_ : te_, ot_ = odd ? te_ : to_; zp[k_][j_] += my_ + dpp_f(ot_, 0); asm volatile("" : "+v"(zp[k_][j_])); __builtin_amdgcn_sched_barrier(0); } } while (0)
#define SB() __builtin_amdgcn_sched_barrier(0)
            float zp[4][8];
#pragma unroll
            for (int k = 0; k < 4; ++k)
#pragma unroll
                for (int j = 0; j < 8; ++j) zp[k][j] = 0.f;
            EX_LOADH(hA0, hA1, 0, 0); EX_LOAD(dA, U8, 0, 0); SB();
#pragma unroll 1
            for (int i = 0; i < 16 * (1 + EXP_REP_U); ++i) {
                __builtin_amdgcn_s_barrier();
                EX_LOADH(hB0, hB1, i, 1); EX_LOAD(dB, U8, i, 1); SB(); EX_UCOMP(dA, hA0, hA1, 0); SB();
                EX_LOADH(hA0, hA1, i, 2); EX_LOAD(dA, U8, i, 2); SB(); EX_UCOMP(dB, hB0, hB1, 1); SB();
                EX_LOADH(hB0, hB1, i, 3); EX_LOAD(dB, U8, i, 3); SB(); EX_UCOMP(dA, hA0, hA1, 2); SB();
                if (i < 16 * (1 + EXP_REP_U) - 1) { EX_LOADH(hA0, hA1, i + 1, 0); EX_LOAD(dA, U8, i + 1, 0); } SB(); EX_UCOMP(dB, hB0, hB1, 3); SB();
            }
            if (EXP_REP_U) {
#pragma unroll
                for (int k = 0; k < 4; ++k)
#pragma unroll
                    for (int j = 0; j < 8; ++j) zp[k][j] *= 0.5f; }
            unsigned* apl = (unsigned*)(lds + 66560);
#pragma unroll
            for (int k = 0; k < 4; ++k)
#pragma unroll
                for (int j = 0; j < 8; ++j) { float z = zp[k][j]; z += dpp_f(z, 1); z += __shfl_xor(z, 4);
                    const int li = ((tlb + k) * 8 + rr) * 16 + 2 * j + (odd ? 1 : 0); const unsigned eid = offs[li] >> 7;
                    const float act = gelu_erf(z * ISU[eid]) * gts[li] * ISV[eid]; const float oth = dpp_f(act, 0);
                    apl[((tlb + k) * 8 + rr) * 8 + j] = f2bf(odd ? oth : act) | (f2bf(odd ? act : oth) << 16); }
            LDS_WAIT();
            float ssq[4] = {0.f, 0.f, 0.f, 0.f};
#define EX_VCOMP(buf, i_, k_) do { float oa_[16]; _Pragma("unroll") for (int e_ = 0; e_ < 16; ++e_) oa_[e_] = 0.f; \
    const int col_ = (int)EX_SLICE(i_) * 128 + cc * 16 + 2 * rr; const size_t xo_ = (size_t)(tok0 + tlb + (k_)) * D + col_; \
    const f32x2v x1_ = *(const f32x2v*)(X1 + xo_), g2_ = *(const f32x2v*)(mod + (size_t)b * NADA + 5 * 2048 + col_); \
    const u32x4 ap0_ = *(const u32x4*)(apl + ((tlb + (k_)) * 8 + rr) * 8), ap1_ = *(const u32x4*)(apl + ((tlb + (k_)) * 8 + rr) * 8 + 4); \
    _Pragma("unroll") for (int j_ = 0; j_ < 8; ++j_) { const unsigned pr_ = (j_ < 4) ? ap0_[j_ & 3] : ap1_[j_ & 3]; const float a0_ = bflo(pr_), a1_ = bfhi(pr_); \
        { u32x4 w_ = buf[2 * j_]; asm volatile("" : "+v"(w_.x), "+v"(w_.y), "+v"(w_.z), "+v"(w_.w), "+v"(oa_[0])); float f_[16]; cvt16(w_, f_); _Pragma("unroll") for (int e_ = 0; e_ < 16; ++e_) oa_[e_] = fmaf(a0_, f_[e_], oa_[e_]); } \
        { u32x4 w_ = buf[2 * j_ + 1]; asm volatile("" : "+v"(w_.x), "+v"(w_.y), "+v"(w_.z), "+v"(w_.w), "+v"(oa_[0])); float f_[16]; cvt16(w_, f_); _Pragma("unroll") for (int e_ = 0; e_ < 16; ++e_) oa_[e_] = fmaf(a1_, f_[e_], oa_[e_]); } } \
      \
    float b8_[8], b4_[4], b2_[2]; \
    _Pragma("unroll") for (int e_ = 0; e_ < 8; ++e_) { const bool up_ = lane & 32; const float kp_ = up_ ? oa_[e_ + 8] : oa_[e_], sd_ = up_ ? oa_[e_] : oa_[e_ + 8]; b8_[e_] = kp_ + __shfl_xor(sd_, 32); } \
    _Pragma("unroll") for (int e_ = 0; e_ < 4; ++e_) { const bool up_ = lane & 16; const float kp_ = up_ ? b8_[e_ + 4] : b8_[e_], sd_ = up_ ? b8_[e_] : b8_[e_ + 4]; b4_[e_] = kp_ + __shfl_xor(sd_, 16); } \
    _Pragma("unroll") for (int e_ = 0; e_ < 2; ++e_) { const bool up_ = lane & 8; const float kp_ = up_ ? b4_[e_ + 2] : b4_[e_], sd_ = up_ ? b4_[e_] : b4_[e_ + 2]; b2_[e_] = kp_ + __shfl_xor(sd_, 8); } \
    f32x2v y_; y_.x = x1_.x + g2_.x * b2_[0]; y_.y = x1_.y + g2_.y * b2_[1]; *(f32x2v*)(out + xo_) = y_; ssq[k_] = fmaf(y_.x, y_.x, fmaf(y_.y, y_.y, ssq[k_])); asm volatile("" : "+v"(ssq[k_])); } while (0)
#pragma unroll 1
            for (int i = 0; i < 16 * (1 + EXP_REP_V); ++i) {
                if (EXP_REP_V && i == 16) { ssq[0] = 0.f; ssq[1] = 0.f; ssq[2] = 0.f; ssq[3] = 0.f; }
                __builtin_amdgcn_s_barrier();
                EX_LOAD(dA, V8, i, 0); SB(); EX_VCOMP(dA, i, 0); SB();
                EX_LOAD(dA, V8, i, 1); SB(); EX_VCOMP(dA, i, 1); SB();
                EX_LOAD(dA, V8, i, 2); SB(); EX_VCOMP(dA, i, 2); SB();
                EX_LOAD(dA, V8, i, 3); SB(); EX_VCOMP(dA, i, 3); SB();
            }
#pragma unroll
            for (int k = 0; k < 4; ++k) { const float tot = wave_sum(ssq[k]); rstl[wave * 8 + half * 4 + k] = rsqrtf(tot * (1.f / D) + NORM_EPS); }
        }
#undef EX_SLICE
#undef EX_LOAD
#undef EX_LOADH
#undef EX_DOT16
#undef EX_UCOMP
#undef EX_VCOMP
#undef SB
        __builtin_amdgcn_fence(__ATOMIC_RELEASE, "agent"); __builtin_amdgcn_fence(__ATOMIC_ACQUIRE, "agent");
        LDS_WAIT();
        int lane2 = (int)__builtin_amdgcn_mbcnt_hi(~0u, __builtin_amdgcn_mbcnt_lo(~0u, 0u)); asm volatile("" : "+v"(lane2));
#pragma unroll 1
        for (int k = 0; k < 8; ++k) { float* xr = out + (size_t)(tok0 + wave * 8 + k) * D; const float rs = rstl[wave * 8 + k];
#pragma unroll
            for (int j = 0; j < 8; ++j) { const int col = 4 * (lane2 + 64 * j); const f32x4 v = *(const f32x4*)(xr + col), f = *(const f32x4*)(fin + col);
                f32x4 o; o[0] = v[0] * rs * f[0]; o[1] = v[1] * rs * f[1]; o[2] = v[2] * rs * f[2]; o[3] = v[3] * rs * f[3]; *(f32x4*)(xr + col) = o; } }
    }
}

#define XB_TMO      128
#define XB_XCNT(j)  (256  + 64 * (j))
#define XB_XSUB(j)  (1280 + 64 * (j))
#define XB_XGEN(j)  (2304 + 64 * (j))
#define XB_TOP      3328
#define XB_TOPGEN   3392
#define XCD_BAR_WORDS 3456
#define XB_SPIN_CAP (1u << 22)
__device__ __forceinline__ unsigned xb_ld(unsigned* p)              { return __hip_atomic_load(p, __ATOMIC_RELAXED, __HIP_MEMORY_SCOPE_AGENT); }
__device__ __forceinline__ unsigned xb_add(unsigned* p, unsigned v) { return __hip_atomic_fetch_add(p, v, __ATOMIC_RELAXED, __HIP_MEMORY_SCOPE_AGENT); }
__device__ __forceinline__ unsigned xb_xcc_id() { return (unsigned)__builtin_amdgcn_s_getreg((3 << 11) | 20) & 0xFu; }
#define XB_SPIN(cond, bar) do { unsigned _sp = 0; while (cond) { __builtin_amdgcn_s_sleep(1); \
    if ((++_sp & 255u) == 0u) { if (xb_ld(&(bar)[XB_TMO])) break; if (_sp > XB_SPIN_CAP) { atomicAdd(&(bar)[XB_TMO], 1u); break; } } } } while (0)
struct XcdBarrier { unsigned* bar; unsigned x; volatile LAS unsigned* st; };
__device__ __forceinline__ XcdBarrier xcd_barrier_post(unsigned* bar, volatile LAS unsigned* st) {
    XcdBarrier b; b.bar = bar; b.x = xb_xcc_id(); b.st = st;
    if (threadIdx.x == 0) (void)xb_add(&bar[XB_XCNT(b.x)], 1u);
    return b;
}
__device__ __forceinline__ void xcd_barrier_complete(unsigned* bar, unsigned x, unsigned& nloc, unsigned& nx) {
    const unsigned G = gridDim.x * gridDim.y * gridDim.z;
    unsigned sum, cnt, mine, sp = 0u;
    for (;;) {
        sum = 0u; cnt = 0u; mine = 0u;
#pragma unroll
        for (unsigned j = 0; j < 16; ++j) { const unsigned c = xb_ld(&bar[XB_XCNT(j)]); sum += c; cnt += (c > 0u) ? 1u : 0u; mine = (j == x) ? c : mine; }
        if (sum == G) break;
        __builtin_amdgcn_s_sleep(1);
        if ((++sp & 255u) == 0u) { if (xb_ld(&bar[XB_TMO])) break; if (sp > XB_SPIN_CAP) { atomicAdd(&bar[XB_TMO], 1u); break; } }
    }
    nloc = mine > 0u ? mine : 1u; nx = cnt > 0u ? cnt : 1u;
}
__device__ __forceinline__ void xcd_barrier(const XcdBarrier& b) {
    asm volatile("s_waitcnt vmcnt(0)" ::: "memory");
    __syncthreads();
    if (threadIdx.x == 0) {
        unsigned* bar = b.bar;
        __builtin_amdgcn_s_waitcnt(0);
        unsigned nloc = b.st[0], nx = b.st[1];
        if (nloc == 0u) { xcd_barrier_complete(bar, b.x, nloc, nx); b.st[0] = nloc; b.st[1] = nx; }
        const unsigned old = xb_add(&bar[XB_XSUB(b.x)], 1u);
        const unsigned gen = old / nloc;
        if (old + 1u == (gen + 1u) * nloc) {
            __builtin_amdgcn_fence(__ATOMIC_RELEASE, "agent");
            asm volatile("s_waitcnt vmcnt(0)" ::: "memory");
            const unsigned og = xb_add(&bar[XB_TOP], 1u);
            const unsigned tg = og / nx;
            if (og + 1u == (tg + 1u) * nx) xb_add(&bar[XB_TOPGEN], 1u);
            else XB_SPIN(xb_ld(&bar[XB_TOPGEN]) == tg, bar);
            __builtin_amdgcn_fence(__ATOMIC_ACQUIRE, "agent");
            xb_add(&bar[XB_XGEN(b.x)], 1u);
            asm volatile("s_waitcnt vmcnt(0)" ::: "memory");
        } else {
            XB_SPIN(xb_ld(&bar[XB_XGEN(b.x)]) == gen, bar);
            __builtin_amdgcn_fence(__ATOMIC_ACQUIRE, "agent");
            asm volatile("s_waitcnt vmcnt(0)" ::: "memory");
        }
    }
    __syncthreads();
}

__device__ __forceinline__ void subset_barrier(unsigned* cnt, unsigned n) {
    asm volatile("s_waitcnt vmcnt(0)" ::: "memory");
    __syncthreads();
    if (threadIdx.x == 0) {
        __builtin_amdgcn_fence(__ATOMIC_RELEASE, "agent");
        asm volatile("s_waitcnt vmcnt(0)" ::: "memory");
        __hip_atomic_fetch_add(cnt, 1u, __ATOMIC_RELAXED, __HIP_MEMORY_SCOPE_AGENT);
        unsigned sp = 0;
        while (__hip_atomic_load(cnt, __ATOMIC_RELAXED, __HIP_MEMORY_SCOPE_AGENT) < n) { __builtin_amdgcn_s_sleep(1); if (++sp > (1u << 24)) break; }
        __builtin_amdgcn_fence(__ATOMIC_ACQUIRE, "agent");
        asm volatile("s_waitcnt vmcnt(0)" ::: "memory");
    }
    __syncthreads();
}
constexpr int NPHASES = 11;
__global__ void __launch_bounds__(NTHREADS, 2) mega_fwd(Params p) {
    extern __shared__ __attribute__((aligned(16))) unsigned char lds[];
    cg::grid_group grid = cg::this_grid();
    const int lo = p.ph_lo, hi = p.ph_hi;
#ifndef PHASE_MASK
#define PHASE_MASK 0x7ff
#endif
#define IN(k) (((PHASE_MASK >> (k)) & 1) && lo <= (k) && (k) < hi)
#define SEAM(k) do { if (IN(k) && IN((k) + 1)) { if ((k) == 0) grid.sync(); else xcd_barrier(xbar); } } while (0)
    unsigned char* ws = p.ws;
    bf16_t* P = (bf16_t*)(ws + WS_P);
    bf16_t* Hb = (bf16_t*)((unsigned char*)p.out + OUT_H);
    bf16_t* WinT = (bf16_t*)((unsigned char*)p.out + OUT_WIN);
    const float* mod = (const float*)(ws + WS_MOD);
    LAS unsigned char* ldsl = (LAS unsigned char*)lds;
    volatile LAS unsigned* xst = (volatile LAS unsigned*)(ldsl + LDS_BYTES - 64);
    if (threadIdx.x < 2) xst[threadIdx.x] = 0u;
    __syncthreads();
    XcdBarrier xbar = xcd_barrier_post((unsigned*)(ws + WS_CTL) + 4096, xst);

#ifndef REPEAT_PHASE
#define REPEAT_PHASE -1
#endif
    int rep3 = 0;
#define RUNPH(k, ...) do { if (IN(k)) { __VA_ARGS__; if (REPEAT_PHASE == (k)) { grid.sync(); __VA_ARGS__; } } } while (0)
    RUNPH(0, { phase_mod(p, lds); __syncthreads(); phase_weights(p, lds); });
    SEAM(0);
    RUNPH(1, { phase_norm_rows(p.in[0], p.in[4], mod, mod + 2048, Hb, LDP); });
    SEAM(1);
    RUNPH(2, { pg8::Gemm g{Hb, WinT, nullptr, nullptr, LDP, LDP, T, NP, D}; pg8::StaticOrder<1> S; S.init(T, NP, gridDim.x, blockIdx.x);
        pg8::EpiBf16 E{P, NP, 33}; pg8::gemm_phase(ldsl, g, S, E); });
    SEAM(2);
    RUNPH(3, { const int G = gridDim.x, bx = blockIdx.x;
        if (G >= 128) { if (bx < 64) { phase_hgrn(p, lds, bx, 64); if (REPEAT_PHASE == 32) phase_hgrn(p, lds, bx, 64); }
                        else { phase_vt(p, lds, bx - 64, G - 64); phase_indexer(p, lds, bx - 64, G - 64); if (REPEAT_PHASE == 31) phase_indexer(p, lds, bx - 64, G - 64);
                               subset_barrier((unsigned*)(ws + WS_CTL) + 12288 + ((REPEAT_PHASE == 3) ? 64 * rep3 : 0), (unsigned)(G - 64)); phase_attn(p, lds, bx - 64, G - 64); if (REPEAT_PHASE == 33) phase_attn(p, lds, bx - 64, G - 64); } }
        else { phase_vt(p, lds, bx, G); phase_indexer(p, lds, bx, G); __syncthreads(); phase_hgrn(p, lds, bx, G); grid.sync(); phase_attn(p, lds, bx, G); }
        ++rep3; });
    SEAM(3);
    RUNPH(5, { pg8::Gemm g{(const bf16_t*)((unsigned char*)p.out + OUT_AO), (const bf16_t*)(ws + WS_WUA), (const bf16_t*)((unsigned char*)p.out + OUT_REC), (const bf16_t*)(ws + WS_WUB), 1024, 1024, T, D, 1024}; pg8::StaticOrder<2> S; S.init(T, D, gridDim.x, blockIdx.x);
        pg8::EpiMix E{(bf16_t*)(ws + WS_MIXED), P}; pg8::gemm_phase(ldsl, g, S, E); });
    SEAM(5);
    RUNPH(6, { pg8::Gemm g{(const bf16_t*)(ws + WS_MIXED), (const bf16_t*)(ws + WS_WOUT), nullptr, nullptr, D, D, T, D, D}; pg8::StaticOrder<1> S; S.init(T, D, gridDim.x, blockIdx.x);
        pg8::EpiX1 E{p.in[0], (float*)(ws + WS_X1), mod + 4096}; pg8::gemm_phase(ldsl, g, S, E); });
    SEAM(6);
    RUNPH(7, { phase_norm_rows((const float*)(ws + WS_X1), p.in[5], mod + 3 * 2048, mod + 4 * 2048, (bf16_t*)(ws + WS_H2), D); phase_uv(p); });
    SEAM(7);
    RUNPH(8, { pg8::Gemm g{(const bf16_t*)(ws + WS_H2), (const bf16_t*)(ws + WS_WQ), nullptr, nullptr, D, D, T, D, D}; pg8::StaticOrder<1> S; S.init(T, D, gridDim.x, blockIdx.x);
        pg8::EpiBf16 E{(bf16_t*)(ws + WS_QP), D, 1 << 30}; pg8::gemm_phase(ldsl, g, S, E); });
    SEAM(8);
    RUNPH(9, { phase_peer_topk(p); });
    SEAM(9);
    RUNPH(10, { phase_experts(p, lds); });
#undef IN
#undef SEAM
}

#ifndef MK_N_LAUNCHES
#define MK_N_LAUNCHES 1
#endif
extern "C" void kernel_launch(void* const* d_in, const int* in_sizes, int n_in, void* d_out, int out_size, void* d_ws, size_t ws_size, hipStream_t stream) {
    static int grid = 0;
    if (grid == 0) {
        if (n_in != 17 || out_size != T * D || ws_size < WS_END) { fprintf(stderr, "kernel_launch: unexpected shapes (n_in %d out %d ws %zu)\n", n_in, out_size, ws_size); grid = -1; return; }
        int dev = 0, cus = 0, per_cu = 0;
        hipGetDevice(&dev); hipDeviceGetAttribute(&cus, hipDeviceAttributeMultiprocessorCount, dev);
        hipFuncSetAttribute((const void*)mega_fwd, hipFuncAttributeMaxDynamicSharedMemorySize, LDS_BYTES);
        hipOccupancyMaxActiveBlocksPerMultiprocessor(&per_cu, (const void*)mega_fwd, NTHREADS, LDS_BYTES);
        if (per_cu < 1) { fprintf(stderr, "kernel_launch: occupancy query says %d blocks/CU\n", per_cu); per_cu = 1; }
        (void)hipGetLastError();
        grid = cus * 1;
    }
    if (grid < 0) return;
    if (hipMemsetAsync((char*)d_ws + WS_CTL, 0, 65536, stream) != hipSuccess) { fprintf(stderr, "kernel_launch: memset failed\n"); return; }
    Params p{};
    for (int i = 0; i < 17; ++i) p.in[i] = (const float*)d_in[i];
    p.out = (float*)d_out; p.ws = (unsigned char*)d_ws;
#if MK_N_LAUNCHES == 1
    p.ph_lo = 0; p.ph_hi = NPHASES;
    void* args[] = {&p};
    hipError_t e = hipLaunchCooperativeKernel((const void*)mega_fwd, dim3(grid), dim3(NTHREADS), args, LDS_BYTES, stream);
    if (e != hipSuccess) fprintf(stderr, "cooperative launch failed: %s (grid %d)\n", hipGetErrorString(e), grid);
#else
    for (int k = 0; k < NPHASES; ++k) { p.ph_lo = k; p.ph_hi = k + 1; void* args[] = {&p};
        hipError_t e = hipLaunchCooperativeKernel((const void*)mega_fwd, dim3(grid), dim3(NTHREADS), args, LDS_BYTES, stream);
        if (e != hipSuccess) { fprintf(stderr, "launch %d failed: %s\n", k, hipGetErrorString(e)); break; } }
#endif
}
```

```cpp
#include <hip/hip_runtime.h>
#include <hip/hip_cooperative_groups.h>
#include <cstdio>
#include <cstdint>
namespace cg = cooperative_groups;

#define LAS __attribute__((address_space(3)))
typedef unsigned short bf16_t;
typedef short bf16x8 __attribute__((ext_vector_type(8)));
typedef short bf16x4 __attribute__((ext_vector_type(4)));
typedef float f32x2 __attribute__((ext_vector_type(2)));
typedef float f32x4 __attribute__((ext_vector_type(4)));
typedef float f32x16 __attribute__((ext_vector_type(16)));
typedef unsigned u32x2 __attribute__((ext_vector_type(2)));
typedef unsigned u32x4 __attribute__((ext_vector_type(4)));

constexpr int T = 16384, D = 2048, SEQ = 2048, NBATCH = 8, NP = 12544;
constexpr int C_QA = 0, C_KA = 1024, C_VA = 2048, C_QI = 3072, C_KI = 4096, C_WI = 4160, C_QB = 4352, C_FB = 5376, C_IB = 6400, C_GB = 7424, C_GA = 8448, C_GG = 10496;
constexpr int NADA = 12288;
constexpr float NORM_EPS = 1e-6f;
constexpr int NTHREADS = 512, NWAVES = 8;
constexpr int LDS_BYTES = 147456;
constexpr size_t MiB = 1u << 20;
constexpr size_t WS_CTL = 0, WS_MOD = 1 * MiB, WS_WUA = 2 * MiB, WS_WUB = 6 * MiB, WS_WOUT = 10 * MiB, WS_WQ = 18 * MiB, WS_KEYS = 26 * MiB, WS_MASK = 27 * MiB;
constexpr size_t WS_MIXED = 32 * MiB;
constexpr size_t WS_VT = 32 * MiB, WS_ORAW = 64 * MiB;
constexpr size_t WS_P = 96 * MiB;
constexpr size_t WS_H2 = 96 * MiB, WS_QP = 160 * MiB, WS_U8 = 224 * MiB, WS_V8 = 256 * MiB, WS_ISU = 26 * MiB + 512 * 1024, WS_ISV = 26 * MiB + 768 * 1024, WS_Y = 288 * MiB, WS_EIDX = 352 * MiB, WS_EGATE = 360 * MiB;
constexpr size_t WS_X1 = 368 * MiB;
constexpr size_t WS_END = 496 * MiB;
constexpr int LDP = 2048 + 64;
constexpr size_t OUT_H = 0, OUT_WIN = 68 * MiB;
constexpr size_t OUT_AO = 0, OUT_REC = 32 * MiB;

struct Params { const float* in[17]; float* out; unsigned char* ws; int ph_lo, ph_hi; };

__device__ __forceinline__ unsigned f2bf(float f) { unsigned u = __float_as_uint(f); return (u + 0x7fffu + ((u >> 16) & 1u)) >> 16; }
__device__ __forceinline__ float bf2f(unsigned b) { return __uint_as_float(b << 16); }
__device__ __forceinline__ float bflo(unsigned w) { return __uint_as_float(w << 16); }
__device__ __forceinline__ float bfhi(unsigned w) { return __uint_as_float(w & 0xffff0000u); }
__device__ __forceinline__ unsigned pk2(float lo, float hi) { unsigned r; asm volatile("v_cvt_pk_bf16_f32 %0, %1, %2" : "=v"(r) : "v"(lo), "v"(hi)); return r; }
__device__ __forceinline__ float wave_sum(float v) {
#pragma unroll
    for (int o = 1; o < 64; o <<= 1) v += __shfl_xor(v, o);
    return v;
}
__device__ __forceinline__ float sigmoidf_(float v) { return 1.f / (1.f + __expf(-v)); }
__device__ __forceinline__ float siluf_(float v) { return v / (1.f + __expf(-v)); }
#define LDS_WAIT() asm volatile("s_waitcnt lgkmcnt(0)" ::: "memory")

namespace pg8 {
constexpr int BM = 256, BK = 64, HALF = 128, HTB = HALF * BK * 2, STAGE_BYTES = 8 * HTB, NXCD = 8, WGM = 8;
__host__ __device__ __forceinline__ int lds_byte(int r, int c) { const int st = (r >> 4) * 2 + (c >> 5), rr = r & 15, cc = c & 31, ob = rr * 64 + cc * 2; return st * 1024 + (ob ^ (((ob >> 9) & 1) << 5)); }
__host__ __device__ __forceinline__ void stage_rc(int b, int& R, int& C) { const int st = b / 1024, sb = b % 1024, swz = sb ^ (((sb >> 9) & 1) << 5); R = (st >> 1) * 16 + swz / 64; C = (st & 1) * 32 + (swz % 64) / 2; }
__host__ __device__ __forceinline__ int perm32(int rho) { const int n = rho >> 4, i = rho & 15; return 8 * (i >> 2) + 4 * n + (i & 3); }

struct Unit { int pm, pn, z; };
struct Gemm { const bf16_t* A; const bf16_t* Bt; const bf16_t* A2; const bf16_t* Bt2; int lda, ldb, M, N, K; };

template <int NZ> struct StaticOrder {
    int nM, nN, nwg, G, c;
    __device__ void init(int M, int N, int G_, int c_) { nM = M / BM; nN = N / BM; nwg = nM * nN; G = G_; c = c_; }
    __device__ bool next(int i, Unit& u) const {
        const long L = (long)(i / NZ) * G + c; if (L >= nwg) return false;
        int wgid = (int)L; { const int q = nwg / NXCD, r = nwg % NXCD, xcd = wgid % NXCD, off = wgid / NXCD; wgid = (xcd < r ? xcd * (q + 1) : r * (q + 1) + (xcd - r) * q) + off; }
        const int nig = WGM * nN, gid = wgid / nig, fm = gid * WGM, gsz = (nM - fm) < WGM ? (nM - fm) : WGM;
        u.pm = fm + ((wgid % nig) % gsz); u.pn = (wgid % nig) / gsz; u.z = i % NZ; return true;
    }
};

template <class Epi, class Sched>
__device__ __forceinline__ void gemm_phase(LAS unsigned char* lds, const Gemm g, const Sched& S, const Epi& E) {
    const int tid = threadIdx.x, wid = __builtin_amdgcn_readfirstlane(tid >> 6), lane = tid & 63, wr = wid >> 2, wc = wid & 3, fr = lane & 15, fq = lane >> 4;
    const int K = g.K, nt = K / BK;
    unsigned voffA[2], voffB[2];
#pragma unroll
    for (int i = 0; i < 2; ++i) { int R, C; stage_rc(tid * 16 + i * 8192, R, C); const int Rb = Epi::PERM ? ((R & ~31) + perm32(R & 31)) : R;
        voffA[i] = (unsigned)(R * g.lda + C) * 2u; voffB[i] = (unsigned)(Rb * g.ldb + C) * 2u; }
    const size_t kstep = (size_t)(BK * 2);
    const size_t hstepA = (size_t)HALF * g.lda * 2, hstepB = (size_t)HALF * g.ldb * 2;
    const size_t tstepA = 2 * hstepA, tstepB = 2 * hstepB;
    const unsigned ldsw = (unsigned)wid * 1024u;
    const int aoff = lds_byte(wr * 64 + fr, fq * 8), boff = lds_byte(wc * 32 + fr, fq * 8);
#define PG8_SA(b, h) (((b) * 2 + (h)) * HTB)
#define PG8_SB(b, h) ((4 + (b) * 2 + (h)) * HTB)
#define PG8_STAGE(bufoff, gbase, voff) do { _Pragma("unroll") for (int _i = 0; _i < 2; ++_i) \
        __builtin_amdgcn_global_load_lds((const unsigned*)((const char*)(gbase) + (voff)[_i]), (LAS unsigned*)(lds + (bufoff) + ldsw + _i * 8192), 16, 0, 0); } while (0)
#define PG8_LDA(dst, b, h) do { _Pragma("unroll") for (int m = 0; m < 4; ++m) _Pragma("unroll") for (int k = 0; k < 2; ++k) dst[m][k] = *(const LAS bf16x8*)(lds + PG8_SA(b, h) + aoff + m * 2048 + k * 1024); } while (0)
#define PG8_LDB(dst, b, h) do { _Pragma("unroll") for (int n = 0; n < 2; ++n) _Pragma("unroll") for (int k = 0; k < 2; ++k) dst[n][k] = *(const LAS bf16x8*)(lds + PG8_SB(b, h) + boff + n * 2048 + k * 1024); } while (0)
#define PG8_MMA(ai, bj, At, Bt) do { __builtin_amdgcn_s_setprio(1); _Pragma("unroll") for (int m = 0; m < 4; ++m) _Pragma("unroll") for (int n = 0; n < 2; ++n) _Pragma("unroll") for (int k = 0; k < 2; ++k) \
        acc[ai][bj][m][n] = __builtin_amdgcn_mfma_f32_16x16x32_bf16(Bt[n][k], At[m][k], acc[ai][bj][m][n], 0, 0, 0); __builtin_amdgcn_s_setprio(0); } while (0)
#define PG8_WAIT_V(n) asm volatile("s_waitcnt vmcnt(" #n ")" ::: "memory")
#define PG8_WAIT_L(n) asm volatile("s_waitcnt lgkmcnt(" #n ")" ::: "memory")
#define PG8_BAR __builtin_amdgcn_s_barrier()
#define PG8_SCHED __builtin_amdgcn_sched_barrier(0)
#define PG8_ABASE(u) ((const char*)((u).z ? g.A2 : g.A) + (size_t)(u).pm * tstepA)
#define PG8_BBASE(u) ((const char*)((u).z ? g.Bt2 : g.Bt) + (size_t)(u).pn * tstepB)
    Unit cur, nxt; int ui = 0;
    if (!S.next(0, cur)) return;
    f32x4 acc[2][2][4][2];
#pragma unroll
    for (int a = 0; a < 2; ++a)
#pragma unroll
        for (int b = 0; b < 2; ++b)
#pragma unroll
            for (int m = 0; m < 4; ++m)
#pragma unroll
                for (int n = 0; n < 2; ++n) acc[a][b][m][n] = (f32x4){0.f, 0.f, 0.f, 0.f};
    bf16x8 At[4][2], B0[2][2], B1[2][2];
    const char* cA = PG8_ABASE(cur); const char* cB = PG8_BBASE(cur);
    PG8_STAGE(PG8_SB(0, 0), cB, voffB); PG8_STAGE(PG8_SA(0, 0), cA, voffA); PG8_STAGE(PG8_SB(0, 1), cB + hstepB, voffB); PG8_STAGE(PG8_SA(0, 1), cA + hstepA, voffA);
    if (wr == 1) PG8_BAR;
    PG8_WAIT_V(4); PG8_BAR;
    PG8_STAGE(PG8_SB(1, 0), cB + kstep, voffB); PG8_STAGE(PG8_SA(1, 0), cA + kstep, voffA); PG8_STAGE(PG8_SB(1, 1), cB + hstepB + kstep, voffB);
    PG8_WAIT_V(6); PG8_BAR;
    for (;;) {
        const bool has_next = S.next(ui + 1, nxt);
        const char* nA = has_next ? PG8_ABASE(nxt) : cA; const char* nB = has_next ? PG8_BBASE(nxt) : cB;
        for (int t = 0; t < nt; t += 2) {
            const bool last = (t == nt - 2);
            const char* a1 = cA + (size_t)(t + 1) * kstep;
            const char* a2 = last ? nA : cA + (size_t)(t + 2) * kstep; const char* b2 = last ? nB : cB + (size_t)(t + 2) * kstep;
            const char* a3 = a2 + kstep; const char* b3 = b2 + kstep;
            PG8_LDB(B0, 0, 0); PG8_SCHED; PG8_LDA(At, 0, 0); PG8_STAGE(PG8_SA(1, 1), a1 + hstepA, voffA);
            PG8_WAIT_L(8); PG8_BAR; PG8_WAIT_L(0); PG8_MMA(0, 0, At, B0); PG8_BAR; PG8_SCHED;
            PG8_LDB(B1, 0, 1); PG8_STAGE(PG8_SB(0, 0), b2, voffB);
            PG8_BAR; PG8_WAIT_L(0); PG8_MMA(0, 1, At, B1); PG8_BAR;
            PG8_LDA(At, 0, 1); PG8_STAGE(PG8_SA(0, 0), a2, voffA);
            PG8_BAR; PG8_WAIT_L(0); PG8_MMA(1, 0, At, B0); PG8_BAR; PG8_SCHED;
            PG8_STAGE(PG8_SB(0, 1), b2 + hstepB, voffB);
            PG8_WAIT_V(6); PG8_BAR; PG8_MMA(1, 1, At, B1); PG8_BAR;
            PG8_LDB(B0, 1, 0); PG8_SCHED; PG8_LDA(At, 1, 0); PG8_STAGE(PG8_SA(0, 1), a2 + hstepA, voffA);
            PG8_WAIT_L(8); PG8_BAR; PG8_WAIT_L(0); PG8_MMA(0, 0, At, B0); PG8_BAR; PG8_SCHED;
            PG8_LDB(B1, 1, 1); PG8_STAGE(PG8_SB(1, 0), b3, voffB);
            PG8_BAR; PG8_WAIT_L(0); PG8_MMA(0, 1, At, B1); PG8_BAR;
            PG8_LDA(At, 1, 1); PG8_STAGE(PG8_SA(1, 0), a3, voffA);
            PG8_BAR; PG8_WAIT_L(0); PG8_MMA(1, 0, At, B0); PG8_BAR; PG8_SCHED;
            PG8_STAGE(PG8_SB(1, 1), b3 + hstepB, voffB);
            PG8_WAIT_V(6); PG8_BAR; PG8_MMA(1, 1, At, B1); PG8_BAR;
        }
        E(acc, cur, wr, wc, fr, fq);
        if (!has_next) break;
#pragma unroll
        for (int a = 0; a < 2; ++a)
#pragma unroll
            for (int b = 0; b < 2; ++b)
#pragma unroll
                for (int m = 0; m < 4; ++m)
#pragma unroll
                    for (int n = 0; n < 2; ++n) acc[a][b][m][n] = (f32x4){0.f, 0.f, 0.f, 0.f};
        cur = nxt; cA = nA; cB = nB; ++ui;
    }
    PG8_WAIT_V(0);
    if (wr == 0) PG8_BAR;
    PG8_BAR;
#undef PG8_SA
#undef PG8_SB
#undef PG8_STAGE
#undef PG8_LDA
#undef PG8_LDB
#undef PG8_MMA
#undef PG8_WAIT_V
#undef PG8_WAIT_L
#undef PG8_BAR
#undef PG8_SCHED
#undef PG8_ABASE
#undef PG8_BBASE
}

struct EpiBf16 {
    static constexpr bool PERM = true;
    bf16_t* O; int ldc; int sig_from;
    __device__ __forceinline__ void operator()(const f32x4 (&acc)[2][2][4][2], const Unit& u, int wr, int wc, int fr, int fq) const {
        const int row0 = u.pm * BM + wr * 64 + fr, col0 = u.pn * BM + wc * 32 + 8 * fq; const bool sig = u.pn >= sig_from;
#pragma unroll
        for (int ai = 0; ai < 2; ++ai)
#pragma unroll
            for (int m = 0; m < 4; ++m) { bf16_t* rowp = O + (size_t)(row0 + ai * HALF + m * 16) * ldc + col0;
#pragma unroll
                for (int bj = 0; bj < 2; ++bj) { f32x4 v0 = acc[ai][bj][m][0], v1 = acc[ai][bj][m][1];
                    if (sig) {
#pragma unroll
                        for (int j = 0; j < 4; ++j) { v0[j] = sigmoidf_(v0[j]); v1[j] = sigmoidf_(v1[j]); } }
                    u32x4 w; w.x = pk2(v0[0], v0[1]); w.y = pk2(v0[2], v0[3]); w.z = pk2(v1[0], v1[1]); w.w = pk2(v1[2], v1[3]);
                    *(u32x4*)(rowp + bj * HALF) = w; } }
    }
};
struct EpiMix {
    static constexpr bool PERM = true;
    bf16_t* O; const bf16_t* P;
    __device__ __forceinline__ void operator()(const f32x4 (&acc)[2][2][4][2], const Unit& u, int wr, int wc, int fr, int fq) const {
        const int row0 = u.pm * BM + wr * 64 + fr, col0 = u.pn * BM + wc * 32 + 8 * fq; const int gcol = (u.z ? C_GG : C_GA);
#pragma unroll
        for (int ai = 0; ai < 2; ++ai) {
            u32x4 gw[4][2], pw[4][2];
#pragma unroll
            for (int m = 0; m < 4; ++m)
#pragma unroll
                for (int bj = 0; bj < 2; ++bj) { const size_t r = (size_t)(row0 + ai * HALF + m * 16);
                    gw[m][bj] = *(const u32x4*)(P + r * NP + gcol + col0 + bj * HALF);
                    if (u.z) pw[m][bj] = *(const u32x4*)(O + r * D + col0 + bj * HALF); else pw[m][bj] = (u32x4){0u, 0u, 0u, 0u}; }
            asm volatile("" ::: "memory");
#pragma unroll
            for (int m = 0; m < 4; ++m)
#pragma unroll
                for (int bj = 0; bj < 2; ++bj) { const size_t r = (size_t)(row0 + ai * HALF + m * 16); const f32x4 v0 = acc[ai][bj][m][0], v1 = acc[ai][bj][m][1]; const u32x4 g = gw[m][bj], q = pw[m][bj];
                    u32x4 w; w.x = pk2(fmaf(v0[0], bflo(g.x), bflo(q.x)), fmaf(v0[1], bfhi(g.x), bfhi(q.x))); w.y = pk2(fmaf(v0[2], bflo(g.y), bflo(q.y)), fmaf(v0[3], bfhi(g.y), bfhi(q.y)));
                    w.z = pk2(fmaf(v1[0], bflo(g.z), bflo(q.z)), fmaf(v1[1], bfhi(g.z), bfhi(q.z))); w.w = pk2(fmaf(v1[2], bflo(g.w), bflo(q.w)), fmaf(v1[3], bfhi(g.w), bfhi(q.w)));
                    *(u32x4*)(O + r * D + col0 + bj * HALF) = w; }
            asm volatile("" ::: "memory");
        }
    }
};
struct EpiX1 {
    static constexpr bool PERM = false;
    const float* x; float* out; const float* gate;
    __device__ __forceinline__ void operator()(const f32x4 (&acc)[2][2][4][2], const Unit& u, int wr, int wc, int fr, int fq) const {
        const int row0 = u.pm * BM + wr * 64 + fr, col0 = u.pn * BM + wc * 32 + 4 * fq; const int b = (u.pm * BM) >> 11;
        f32x4 gv[2][2];
#pragma unroll
        for (int bj = 0; bj < 2; ++bj)
#pragma unroll
            for (int n = 0; n < 2; ++n) gv[bj][n] = *(const f32x4*)(gate + (size_t)b * NADA + col0 + bj * HALF + n * 16);
#pragma unroll
        for (int ai = 0; ai < 2; ++ai) {
            f32x4 xv[4][2][2];
#pragma unroll
            for (int m = 0; m < 4; ++m)
#pragma unroll
                for (int bj = 0; bj < 2; ++bj)
#pragma unroll
                    for (int n = 0; n < 2; ++n) xv[m][bj][n] = *(const f32x4*)(x + (size_t)(row0 + ai * HALF + m * 16) * D + col0 + bj * HALF + n * 16);
            asm volatile("" ::: "memory");
#pragma unroll
            for (int m = 0; m < 4; ++m)
#pragma unroll
                for (int bj = 0; bj < 2; ++bj)
#pragma unroll
                    for (int n = 0; n < 2; ++n) *(f32x4*)(out + (size_t)(row0 + ai * HALF + m * 16) * D + col0 + bj * HALF + n * 16) = xv[m][bj][n] + gv[bj][n] * acc[ai][bj][m][n];
            asm volatile("" ::: "memory");
        }
    }
};
}

__device__ __forceinline__ void phase_mod(const Params& p, unsigned char* lds) {
    float* sc = (float*)lds;
    float* red = (float*)(lds + 65536);
    const int tid = threadIdx.x, wave = tid >> 6, lane = tid & 63;
    const float* c = p.in[1]; const float* wada = p.in[2]; const float* bada = p.in[3];
    float* mod = (float*)(p.ws + WS_MOD);
    if ((int)blockIdx.x >= 192) return;
    for (int i = tid; i < NBATCH * D; i += NTHREADS) { const int b = i >> 11, k = i & 2047; sc[k * 8 + b] = siluf_(c[i]); }
    __syncthreads();
    const int cgp = tid & 15, rg = tid >> 4;
    for (int item = blockIdx.x; item < 192; item += gridDim.x) {
        const float* w = wada + item * 64 + cgp * 4;
        float acc[8][4];
#pragma unroll
        for (int b = 0; b < 8; ++b)
#pragma unroll
            for (int j = 0; j < 4; ++j) acc[b][j] = 0.f;
#pragma unroll 1
        for (int i0 = 0; i0 < 64; i0 += 8) {
            f32x4 wvv[8];
#pragma unroll
            for (int u = 0; u < 8; ++u) wvv[u] = __builtin_nontemporal_load((const f32x4*)(w + (size_t)(rg + 32 * (i0 + u)) * NADA));
#pragma unroll
            for (int u = 0; u < 8; ++u) { const int k = rg + 32 * (i0 + u); const f32x4 wv = wvv[u];
                const f32x4 s0 = *(const f32x4*)(sc + k * 8), s1 = *(const f32x4*)(sc + k * 8 + 4);
#pragma unroll
                for (int j = 0; j < 4; ++j) { acc[0][j] += s0[0] * wv[j]; acc[1][j] += s0[1] * wv[j]; acc[2][j] += s0[2] * wv[j]; acc[3][j] += s0[3] * wv[j];
                    acc[4][j] += s1[0] * wv[j]; acc[5][j] += s1[1] * wv[j]; acc[6][j] += s1[2] * wv[j]; acc[7][j] += s1[3] * wv[j]; } } }
#pragma unroll
        for (int b = 0; b < 8; ++b)
#pragma unroll
            for (int j = 0; j < 4; ++j) { float v = acc[b][j]; v += __shfl_xor(v, 16); v += __shfl_xor(v, 32); acc[b][j] = v; }
        if (lane < 16) {
#pragma unroll
            for (int b = 0; b < 8; ++b)
#pragma unroll
                for (int j = 0; j < 4; ++j) red[(wave * 16 + cgp) * 32 + b * 4 + j] = acc[b][j]; }
        __syncthreads();
        { const int cgo = tid >> 5, b = (tid >> 2) & 7, j = tid & 3; float s = 0.f;
#pragma unroll
          for (int w8 = 0; w8 < 8; ++w8) s += red[(w8 * 16 + cgo) * 32 + (tid & 31)];
          const int col = item * 64 + cgo * 4 + j; mod[b * NADA + col] = s + bada[col]; }
        __syncthreads();
    }
}
__device__ __forceinline__ void transpose_item(const float* W, int K, int N, bf16_t* WT, int nblk, int item, int lane, float* scr, int mode, int pitch) {
    const int kb = item / nblk, nb = item % nblk, k0 = 64 * kb, n0 = 32 * nb;
    const int nd = n0 + (lane & 31); int ns = nd; bool valid = true;
    if (mode == 1) { if (nd >= C_QB) ns = nd - 176; else if (nd >= 4176) valid = false; }
    if (mode == 0 || n0 < 4160 || n0 >= C_QB) {
        const int ns0 = (mode == 1 && n0 >= C_QB) ? n0 - 176 : n0;
        f32x4 v[8];
#pragma unroll
        for (int i = 0; i < 8; ++i) v[i] = *(const f32x4*)(W + (size_t)(k0 + 8 * i + (lane >> 3)) * N + ns0 + 4 * (lane & 7));
#pragma unroll
        for (int i = 0; i < 8; ++i) { float* d = scr + (8 * i + (lane >> 3)) * 33 + 4 * (lane & 7); d[0] = v[i][0]; d[1] = v[i][1]; d[2] = v[i][2]; d[3] = v[i][3]; }
    } else {
#pragma unroll 8
        for (int i = 0; i < 32; ++i) { const int kk = 2 * i + (lane >> 5); scr[kk * 33 + (lane & 31)] = valid ? W[(size_t)(k0 + kk) * N + ns] : 0.f; }
    }
    LDS_WAIT();
    const int c = lane & 7;
#pragma unroll
    for (int j = 0; j < 4; ++j) { const int n = (lane >> 3) + 8 * j; const float* s = scr + (8 * c) * 33 + n;
        u32x4 o; o.x = pk2(s[0 * 33], s[1 * 33]); o.y = pk2(s[2 * 33], s[3 * 33]); o.z = pk2(s[4 * 33], s[5 * 33]); o.w = pk2(s[6 * 33], s[7 * 33]);
        *(u32x4*)(WT + (size_t)(n0 + n) * pitch + k0 + 8 * c) = o; }
    LDS_WAIT();
}
__device__ __forceinline__ void phase_weights(const Params& p, unsigned char* lds) {
    const int tid = threadIdx.x, wave = tid >> 6, lane = tid & 63;
    float* scr = (float*)(lds + wave * 16384);
    const int vb = ((int)blockIdx.x + (int)gridDim.x - 192 % (int)gridDim.x) % (int)gridDim.x;
    const int gw = vb * NWAVES + wave, NGW = gridDim.x * NWAVES;
    constexpr int I_IN = 32 * (NP / 32), I_UA = 16 * 64, I_UB = 16 * 64, I_O = 32 * 64, I_Q = 32 * 64;
    constexpr int NITEMS = I_IN + I_UA + I_UB + I_O + I_Q;
    bf16_t* win_t = (bf16_t*)((unsigned char*)p.out + OUT_WIN);
    for (int it = gw; it < NITEMS; it += NGW) {
        int r = it;
        if (r < I_IN) { transpose_item(p.in[6], 2048, 12368, win_t, NP / 32, r, lane, scr, 1, LDP); continue; } r -= I_IN;
        if (r < I_UA) { transpose_item(p.in[9], 1024, 2048, (bf16_t*)(p.ws + WS_WUA), 64, r, lane, scr, 0, 1024); continue; } r -= I_UA;
        if (r < I_UB) { transpose_item(p.in[10], 1024, 2048, (bf16_t*)(p.ws + WS_WUB), 64, r, lane, scr, 0, 1024); continue; } r -= I_UB;
        if (r < I_O) { transpose_item(p.in[11], 2048, 2048, (bf16_t*)(p.ws + WS_WOUT), 64, r, lane, scr, 0, 2048); continue; } r -= I_O;
        transpose_item(p.in[12], 2048, 2048, (bf16_t*)(p.ws + WS_WQ), 64, r, lane, scr, 0, 2048);
    }
    { const float* ks = p.in[13]; bf16_t* kd = (bf16_t*)(p.ws + WS_KEYS);
      for (int i = (blockIdx.x * NTHREADS + tid) * 4; i < 8 * 2 * 128 * 128; i += gridDim.x * NTHREADS * 4) { const f32x4 v = *(const f32x4*)(ks + i); u32x2 o; o.x = pk2(v[0], v[1]); o.y = pk2(v[2], v[3]); *(u32x2*)(kd + i) = o; } }
}

__device__ __forceinline__ void phase_norm_rows(const float* src, const float* gain, const float* shift, const float* scale, bf16_t* dst, int pitch) {
    const int tid = threadIdx.x, wave = tid >> 6, lane = tid & 63;
    const int gw = blockIdx.x * NWAVES + wave, NGW = gridDim.x * NWAVES;
    for (int row = gw; row < T; row += NGW) {
        const int b = row >> 11; const f32x4* xr = (const f32x4*)(src + (size_t)row * D) + lane;
        f32x4 v[8]; float ss = 0.f;
#pragma unroll
        for (int j = 0; j < 8; ++j) { v[j] = xr[64 * j]; ss += (v[j][0] * v[j][0] + v[j][1] * v[j][1]) + (v[j][2] * v[j][2] + v[j][3] * v[j][3]); }
        const float rstd = rsqrtf(wave_sum(ss) * (1.f / D) + NORM_EPS);
        u32x2* o8 = (u32x2*)(dst + (size_t)row * pitch) + lane;
#pragma unroll
        for (int j = 0; j < 8; ++j) { const int col = 4 * (lane + 64 * j);
            const f32x4 g = *(const f32x4*)(gain + col), sh = *(const f32x4*)(shift + (size_t)b * NADA + col), sc = *(const f32x4*)(scale + (size_t)b * NADA + col);
            f32x4 h;
#pragma unroll
            for (int e = 0; e < 4; ++e) h[e] = v[j][e] * rstd * g[e] * (1.f + sc[e]) + sh[e];
            u32x2 w; w.x = pk2(h[0], h[1]); w.y = pk2(h[2], h[3]); o8[64 * j] = w; }
    }
}

__device__ __forceinline__ void phase_vt(const Params& p, unsigned char* lds, int vb, int vG) {
    const int tid = threadIdx.x, wave = tid >> 6, lane = tid & 63;
    bf16_t* tile = (bf16_t*)(lds + wave * 16384);
    const bf16_t* P = (const bf16_t*)(p.ws + WS_P); bf16_t* VT = (bf16_t*)(p.ws + WS_VT);
    const int gw = vb * NWAVES + wave, NGW = vG * NWAVES;
    for (int it = gw; it < 8 * 8 * 32 * 2; it += NGW) {
        const int dh = it & 1, kt = (it >> 1) & 31, h = (it >> 6) & 7, b = it >> 9;
        const int k0 = kt * 64, d0 = dh * 64;
#pragma unroll
        for (int i = 0; i < 8; ++i) { const int key = i * 8 + (lane >> 3), dc = lane & 7;
            const u32x4 v = *(const u32x4*)(P + (size_t)(b * SEQ + k0 + key) * NP + C_VA + h * 128 + d0 + dc * 8);
            bf16_t* t = tile + (dc * 8) * 72 + key;
            t[0 * 72] = (bf16_t)(v.x & 0xffff); t[1 * 72] = (bf16_t)(v.x >> 16); t[2 * 72] = (bf16_t)(v.y & 0xffff); t[3 * 72] = (bf16_t)(v.y >> 16);
            t[4 * 72] = (bf16_t)(v.z & 0xffff); t[5 * 72] = (bf16_t)(v.z >> 16); t[6 * 72] = (bf16_t)(v.w & 0xffff); t[7 * 72] = (bf16_t)(v.w >> 16); }
        LDS_WAIT();
#pragma unroll
        for (int i = 0; i < 8; ++i) { const int d = i * 8 + (lane >> 3), kc = lane & 7;
            const u32x4 v = *(const u32x4*)(tile + d * 72 + kc * 8);
            *(u32x4*)(VT + ((size_t)((b * 8 + h) * 128 + d0 + d)) * SEQ + k0 + kc * 8) = v; }
        LDS_WAIT();
    }
}

__device__ __forceinline__ unsigned ord_key(float s) { const unsigned u = __float_as_uint(s); return (u & 0x80000000u) ? ~u : (u | 0x80000000u); }
__device__ __forceinline__ int half_sum(int v) {
    v += __builtin_amdgcn_update_dpp(0, v, 0xB1, 0xF, 0xF, true);
    v += __builtin_amdgcn_update_dpp(0, v, 0x4E, 0xF, 0xF, true);
    v += __builtin_amdgcn_update_dpp(0, v, 0x141, 0xF, 0xF, true);
    v += __builtin_amdgcn_update_dpp(0, v, 0x140, 0xF, 0xF, true);
    v += __shfl_xor(v, 16);
    return v;
}
constexpr int IX_RS = 72, IX_STAGE = 32 * IX_RS * 2;
__device__ __forceinline__ void indexer_item(const Params& p, unsigned char* lds, int b, int c, int grp) {
    const int tid = threadIdx.x, w = __builtin_amdgcn_readfirstlane(tid >> 6), lane = tid & 63, r = lane & 31, hh = lane >> 5;
    const bf16_t* P = (const bf16_t*)(p.ws + WS_P); unsigned* MASK = (unsigned*)(p.ws + WS_MASK);
    const int pair = grp * 8 + w, q0 = b * SEQ + c * 64 + 2 * pair;
    bf16x8 af[4];
    { const int query = q0 + ((r >> 2) & 1), head = (r & 3) + 4 * (r >> 3);
      const bf16_t* qp = P + (size_t)query * NP + C_QI + head * 64 + 8 * hh;
#pragma unroll
      for (int ks = 0; ks < 4; ++ks) af[ks] = *(const bf16x8*)(qp + ks * 16); }
    float wv[16];
    { const u32x4 w0 = *(const u32x4*)(P + (size_t)(q0 + hh) * NP + C_WI), w1 = *(const u32x4*)(P + (size_t)(q0 + hh) * NP + C_WI + 8);
      wv[0] = bflo(w0.x); wv[1] = bfhi(w0.x); wv[2] = bflo(w0.y); wv[3] = bfhi(w0.y); wv[4] = bflo(w0.z); wv[5] = bfhi(w0.z); wv[6] = bflo(w0.w); wv[7] = bfhi(w0.w);
      wv[8] = bflo(w1.x); wv[9] = bfhi(w1.x); wv[10] = bflo(w1.y); wv[11] = bfhi(w1.y); wv[12] = bflo(w1.z); wv[13] = bfhi(w1.z); wv[14] = bflo(w1.w); wv[15] = bfhi(w1.w); }
    const int nkt = 2 * (c + 1);
    const bool ldr = tid < 256;
    const bf16_t* kg = P + (size_t)(b * SEQ + ((tid >> 3) & 31)) * NP + C_KI + (tid & 7) * 8;
    const int kls = ((tid >> 3) & 31) * IX_RS * 2 + (tid & 7) * 16;
    u32x4 kr = {0u, 0u, 0u, 0u};
    __syncthreads();
    if (ldr) { *(u32x4*)(lds + kls) = *(const u32x4*)kg; *(u32x4*)(lds + IX_STAGE + kls) = *(const u32x4*)(kg + (size_t)32 * NP); }
    if (ldr && 2 < nkt) kr = *(const u32x4*)(kg + (size_t)64 * NP);
    __syncthreads();
    unsigned kv[64];
#pragma unroll
    for (int kt = 0; kt < 64; ++kt) {
        kv[kt] = 0u;
        if (kt < nkt) {
            if (ldr && kt + 2 < nkt) *(u32x4*)(lds + ((kt + 2) % 3) * IX_STAGE + kls) = kr;
            if (ldr && kt + 3 < nkt) kr = *(const u32x4*)(kg + (size_t)((kt + 3) * 32) * NP);
            const bf16_t* Ks = (const bf16_t*)(lds + (kt % 3) * IX_STAGE);
            f32x16 acc;
#pragma unroll
            for (int i = 0; i < 16; ++i) acc[i] = 0.f;
#pragma unroll
            for (int ks = 0; ks < 4; ++ks) { const bf16x8 bfr = *(const bf16x8*)(Ks + r * IX_RS + ks * 16 + 8 * hh); acc = __builtin_amdgcn_mfma_f32_32x32x16_bf16(af[ks], bfr, acc, 0, 0, 0); }
            float sc = 0.f;
#pragma unroll
            for (int i = 0; i < 16; ++i) sc += wv[i] * fmaxf(acc[i], 0.f);
            kv[kt] = ord_key(sc);
            __syncthreads();
        }
    }
    unsigned thr = 0u;
    if (nkt > 8) {
        int cur = 1 << 20;
        for (int bit = 31; bit >= 0; --bit) {
            const unsigned cand = thr | (1u << bit); int cnt = 0;
#pragma unroll
            for (int kt = 0; kt < 32; ++kt) cnt += (kv[kt] >= cand) ? 1 : 0;
            if (nkt > 32) {
#pragma unroll
                for (int kt = 32; kt < 64; ++kt) cnt += (kv[kt] >= cand) ? 1 : 0; }
            cnt = half_sum(cnt);
            if (cnt >= 256) { thr = cand; cur = cnt; }
            if (__builtin_amdgcn_ballot_w64(cur != 256) == 0ull) break;
        }
    }
    int cge = 0;
#pragma unroll
    for (int kt = 0; kt < 64; ++kt) cge += (kv[kt] >= thr && kv[kt] != 0u) ? 1 : 0;
    cge = half_sum(cge);
    const bool ties = (thr != 0u) && (cge > 256);
    unsigned m0 = 0u, m1 = 0u;
    if (__builtin_amdgcn_ballot_w64(ties) == 0ull) {
#pragma unroll
        for (int kt = 0; kt < 64; ++kt) { const unsigned long long bm = __builtin_amdgcn_ballot_w64(kv[kt] >= thr && kv[kt] != 0u);
            if (lane == kt) { m0 = (unsigned)bm; m1 = (unsigned)(bm >> 32); } }
    } else {
        int cgt = 0;
#pragma unroll
        for (int kt = 0; kt < 64; ++kt) cgt += (kv[kt] > thr) ? 1 : 0;
        cgt = half_sum(cgt);
        const int need = ties ? (256 - cgt) : (1 << 30); int run = 0;
#pragma unroll
        for (int kt = 0; kt < 64; ++kt) { const bool tie = ties && (kv[kt] == thr); const unsigned long long tb = __builtin_amdgcn_ballot_w64(tie);
            const unsigned th = hh ? (unsigned)(tb >> 32) : (unsigned)tb; const int rank = run + __builtin_popcount(th & ((1u << r) - 1u));
            const bool sel = ties ? ((kv[kt] > thr) || (tie && rank < need)) : (kv[kt] >= thr && kv[kt] != 0u);
            run += __builtin_popcount(th);
            const unsigned long long bm = __builtin_amdgcn_ballot_w64(sel);
            if (lane == kt) { m0 = (unsigned)bm; m1 = (unsigned)(bm >> 32); } }
    }
    { const int qpos = c * 64 + 2 * pair; unsigned* mt = MASK + ((size_t)(b * 64 + lane)) * SEQ + qpos; mt[0] = m0; mt[1] = m1; }
}
__device__ __forceinline__ void phase_indexer(const Params& p, unsigned char* lds, int vb, int vG) {
    const int G = vG;
    for (int rd = 0;; ++rd) {
        const int base = rd * G; if (base >= 1024) break;
        const int pos = (rd & 1) ? (G - 1 - vb) : vb; const int i = base + pos; if (i >= 1024) continue;
        indexer_item(p, lds, (i >> 2) & 7, 31 - (i >> 5), i & 3);
    }
}

#ifndef HG_REP_A
#define HG_REP_A 0
#endif
#ifndef HG_REP_B
#define HG_REP_B 0
#endif
constexpr int HG_RS = 136, HG_TS = 72, HG_SS = 136;
constexpr int HG_QT = 0, HG_QH = 17408, HG_KT = 34816, HG_KHT = 52224, HG_VT = 70656, HG_ST = 89088, HG_DEC = 123904, HG_SSQ = 124416, HG_OT = 125440;
__device__ __forceinline__ void hgrn_item(const Params& p, unsigned char* lds, int item) {
    const int tid = threadIdx.x, w = __builtin_amdgcn_readfirstlane(tid >> 6), lane = tid & 63, r = lane & 31, hh = lane >> 5;
    const int b = item >> 3, h = item & 7;
    const bf16_t* P = (const bf16_t*)(p.ws + WS_P); bf16_t* REC = (bf16_t*)((unsigned char*)p.out + OUT_REC);
    bf16_t* QT = (bf16_t*)(lds + HG_QT); bf16_t* QH = (bf16_t*)(lds + HG_QH); bf16_t* KT = (bf16_t*)(lds + HG_KT); bf16_t* KHT = (bf16_t*)(lds + HG_KHT); bf16_t* VT = (bf16_t*)(lds + HG_VT);
    bf16_t* ST = (bf16_t*)(lds + HG_ST); float* DEC = (float*)(lds + HG_DEC); float* SSQ = (float*)(lds + HG_SSQ); bf16_t* OT = (bf16_t*)(lds + HG_OT);
    const int seg = lane >> 4, dl = lane & 15, d = 16 * w + dl;
    const float lb = sigmoidf_(p.in[7][h * 128 + d] - p.in[7][1024 + h * 128 + d]);
    const int tb = w & 1, eb = w >> 1, sdb = w & 3, seb0 = 2 * (w >> 2);
    const int ot_t = tid >> 3, ot_c = tid & 7;
    float gn[16];
#pragma unroll
    for (int j = 0; j < 4; ++j) { const f32x4 g4 = *(const f32x4*)(p.in[8] + 16 * ot_c + 4 * j); gn[4 * j] = g4[0]; gn[4 * j + 1] = g4[1]; gn[4 * j + 2] = g4[2]; gn[4 * j + 3] = g4[3]; }
    f32x16 S0, S1;
#pragma unroll
    for (int i = 0; i < 16; ++i) { S0[i] = 0.f; S1[i] = 0.f; }
    __syncthreads();
    for (int i = tid; i < 128 * HG_SS / 2; i += NTHREADS) ((unsigned*)ST)[i] = 0u;
    unsigned short rq[16], rf[16], ri[16];
    { const bf16_t* src = P + (size_t)(b * SEQ + 16 * seg) * NP + h * 128 + d;
#pragma unroll
      for (int i = 0; i < 16; ++i) { rq[i] = src[(size_t)i * NP + C_QB]; rf[i] = src[(size_t)i * NP + C_FB]; ri[i] = src[(size_t)i * NP + C_IB]; } }
#pragma unroll 1
    for (int n = 0; n < 32; ++n) {
#pragma unroll 1
        for (int repa = 0; repa <= HG_REP_A; ++repa) {
            float lf[16], kk[16];
            float run = 0.f;
#pragma unroll
            for (int i = 0; i < 16; ++i) { const float f = lb + (1.f - lb) * sigmoidf_(bf2f(rf[i])); kk[i] = 1.f - f; run += __logf(f); lf[i] = run; }
            const float p0 = __shfl(run, dl), p1 = __shfl(run, 16 + dl), p2 = __shfl(run, 32 + dl), p3 = __shfl(run, 48 + dl);
            const float off = (seg > 0 ? p0 : 0.f) + (seg > 1 ? p1 : 0.f) + (seg > 2 ? p2 : 0.f), bL = (p0 + p1) + (p2 + p3), bref = p0 + p1;
            const float eref = __expf(bref), elref = __expf(bL - bref);
            unsigned kh[8], vv[8];
#pragma unroll
            for (int i = 0; i < 16; ++i) { const float bt = off + lf[i]; const float qs = siluf_(bf2f(rq[i]));
                const float e1 = __expf(bt - bref), e2 = e1 * eref, e3 = __builtin_amdgcn_rcpf(e1), e4 = e3 * elref;
                const int t = 16 * seg + i;
                QT[t * HG_RS + d] = (bf16_t)f2bf(qs * e1); QH[t * HG_RS + d] = (bf16_t)f2bf(qs * e2); KT[t * HG_RS + d] = (bf16_t)f2bf(kk[i] * e3);
                const unsigned khv = f2bf(kk[i] * e4);
                if (i & 1) { kh[i >> 1] |= khv << 16; vv[i >> 1] |= (unsigned)ri[i] << 16; } else { kh[i >> 1] = khv; vv[i >> 1] = (unsigned)ri[i]; } }
            *(u32x4*)(KHT + d * HG_TS + 16 * seg) = (u32x4){kh[0], kh[1], kh[2], kh[3]}; *(u32x4*)(KHT + d * HG_TS + 16 * seg + 8) = (u32x4){kh[4], kh[5], kh[6], kh[7]};
            *(u32x4*)(VT + d * HG_TS + 16 * seg) = (u32x4){vv[0], vv[1], vv[2], vv[3]}; *(u32x4*)(VT + d * HG_TS + 16 * seg + 8) = (u32x4){vv[4], vv[5], vv[6], vv[7]};
            if (seg == 0) DEC[d] = eref * elref;
        }
        __syncthreads();
        if (n < 31) { const bf16_t* src = P + (size_t)(b * SEQ + (n + 1) * 64 + 16 * seg) * NP + h * 128 + d;
#pragma unroll
            for (int i = 0; i < 16; ++i) { rq[i] = src[(size_t)i * NP + C_QB]; rf[i] = src[(size_t)i * NP + C_FB]; ri[i] = src[(size_t)i * NP + C_IB]; } }
        const u32x4 gb0 = *(const u32x4*)(P + (size_t)(b * SEQ + n * 64 + ot_t) * NP + C_GB + h * 128 + 16 * ot_c), gb1 = *(const u32x4*)(P + (size_t)(b * SEQ + n * 64 + ot_t) * NP + C_GB + h * 128 + 16 * ot_c + 8);
        f32x16 X0, X1, o;
#pragma unroll 1
        for (int repb = 0; repb <= HG_REP_B; ++repb) {
#pragma unroll
        for (int i = 0; i < 16; ++i) { X0[i] = 0.f; X1[i] = 0.f; o[i] = 0.f; }
#pragma unroll
        for (int ks = 0; ks < 8; ++ks) { const bf16x8 bq = *(const bf16x8*)(QT + (32 * tb + r) * HG_RS + 16 * ks + 8 * hh);
            const bf16x8 a0 = *(const bf16x8*)(KT + r * HG_RS + 16 * ks + 8 * hh); X0 = __builtin_amdgcn_mfma_f32_32x32x16_bf16(a0, bq, X0, 0, 0, 0);
            if (tb == 1) { const bf16x8 a1 = *(const bf16x8*)(KT + (32 + r) * HG_RS + 16 * ks + 8 * hh); X1 = __builtin_amdgcn_mfma_f32_32x32x16_bf16(a1, bq, X1, 0, 0, 0); } }
#pragma unroll
        for (int i = 0; i < 16; ++i) { const bool keep = ((i & 3) + 8 * (i >> 2) + 4 * hh) <= r; if (tb == 0) X0[i] = keep ? X0[i] : 0.f; else X1[i] = keep ? X1[i] : 0.f; }
#pragma unroll
        for (int sb = 0; sb < 2; ++sb) { if (sb <= tb) {
#pragma unroll
            for (int s2 = 0; s2 < 2; ++s2) { u32x4 aw;
                if (sb == 0) { aw.x = pk2(X0[8 * s2], X0[8 * s2 + 1]); aw.y = pk2(X0[8 * s2 + 2], X0[8 * s2 + 3]); aw.z = pk2(X0[8 * s2 + 4], X0[8 * s2 + 5]); aw.w = pk2(X0[8 * s2 + 6], X0[8 * s2 + 7]); }
                else { aw.x = pk2(X1[8 * s2], X1[8 * s2 + 1]); aw.y = pk2(X1[8 * s2 + 2], X1[8 * s2 + 3]); aw.z = pk2(X1[8 * s2 + 4], X1[8 * s2 + 5]); aw.w = pk2(X1[8 * s2 + 6], X1[8 * s2 + 7]); }
                const bf16_t* vp = VT + (32 * eb + r) * HG_TS + 32 * sb + 16 * s2 + 4 * hh;
                const u32x2 lo = *(const u32x2*)vp, hi = *(const u32x2*)(vp + 8); const u32x4 bw = {lo.x, lo.y, hi.x, hi.y};
                o = __builtin_amdgcn_mfma_f32_32x32x16_bf16(__builtin_bit_cast(bf16x8, aw), __builtin_bit_cast(bf16x8, bw), o, 0, 0, 0); } } }
#pragma unroll
        for (int ks = 0; ks < 8; ++ks) { const bf16x8 aq = *(const bf16x8*)(QH + (32 * tb + r) * HG_RS + 16 * ks + 8 * hh), bs = *(const bf16x8*)(ST + (32 * eb + r) * HG_SS + 16 * ks + 8 * hh);
            o = __builtin_amdgcn_mfma_f32_32x32x16_bf16(aq, bs, o, 0, 0, 0); }
        { float a8[8], a4[4], a2[2], a1;
#pragma unroll
          for (int i = 0; i < 8; ++i) { const float lo = o[i] * o[i], hi = o[i + 8] * o[i + 8]; const bool up = lane & 16; const float keep = up ? hi : lo, send = up ? lo : hi; a8[i] = keep + __shfl_xor(send, 16); }
#pragma unroll
          for (int i = 0; i < 4; ++i) { const bool up = lane & 8; const float keep = up ? a8[i + 4] : a8[i], send = up ? a8[i] : a8[i + 4]; a4[i] = keep + __shfl_xor(send, 8); }
#pragma unroll
          for (int i = 0; i < 2; ++i) { const bool up = lane & 4; const float keep = up ? a4[i + 2] : a4[i], send = up ? a4[i] : a4[i + 2]; a2[i] = keep + __shfl_xor(send, 4); }
          { const bool up = lane & 2; const float keep = up ? a2[1] : a2[0], send = up ? a2[0] : a2[1]; a1 = keep + __shfl_xor(send, 2); }
          a1 += __shfl_xor(a1, 1);
          const int ri2 = (lane >> 1) & 15;
          if ((lane & 1) == 0) SSQ[(32 * tb + (ri2 & 3) + 8 * (ri2 >> 2) + 4 * hh) * 4 + eb] = a1; }
#pragma unroll
        for (int i = 0; i < 16; ++i) OT[(32 * tb + (i & 3) + 8 * (i >> 2) + 4 * hh) * HG_RS + 32 * eb + r] = (bf16_t)f2bf(o[i]);
        }
        { float dc[16];
#pragma unroll
          for (int g4 = 0; g4 < 4; ++g4) { const f32x4 dv = *(const f32x4*)(DEC + 32 * sdb + 8 * g4 + 4 * hh); dc[4 * g4] = dv[0]; dc[4 * g4 + 1] = dv[1]; dc[4 * g4 + 2] = dv[2]; dc[4 * g4 + 3] = dv[3]; }
#pragma unroll
          for (int i = 0; i < 16; ++i) { S0[i] *= dc[i]; S1[i] *= dc[i]; }
#pragma unroll
          for (int ss = 0; ss < 4; ++ss) { const bf16x8 a = *(const bf16x8*)(KHT + (32 * sdb + r) * HG_TS + 16 * ss + 8 * hh);
              const bf16x8 b0 = *(const bf16x8*)(VT + (32 * seb0 + r) * HG_TS + 16 * ss + 8 * hh), b1 = *(const bf16x8*)(VT + (32 * (seb0 + 1) + r) * HG_TS + 16 * ss + 8 * hh);
              S0 = __builtin_amdgcn_mfma_f32_32x32x16_bf16(a, b0, S0, 0, 0, 0); S1 = __builtin_amdgcn_mfma_f32_32x32x16_bf16(a, b1, S1, 0, 0, 0); } }
        __syncthreads();
#pragma unroll
        for (int g4 = 0; g4 < 4; ++g4) { const int d0 = 32 * sdb + 8 * g4 + 4 * hh;
            *(u32x2*)(ST + (32 * seb0 + r) * HG_SS + d0) = (u32x2){pk2(S0[4 * g4], S0[4 * g4 + 1]), pk2(S0[4 * g4 + 2], S0[4 * g4 + 3])};
            *(u32x2*)(ST + (32 * (seb0 + 1) + r) * HG_SS + d0) = (u32x2){pk2(S1[4 * g4], S1[4 * g4 + 1]), pk2(S1[4 * g4 + 2], S1[4 * g4 + 3])}; }
        { const f32x4 q4 = *(const f32x4*)(SSQ + ot_t * 4); const float rstd = rsqrtf(((q4[0] + q4[1]) + (q4[2] + q4[3])) * (1.f / 128.f) + NORM_EPS);
          const u32x4 o0 = *(const u32x4*)(OT + ot_t * HG_RS + 16 * ot_c), o1 = *(const u32x4*)(OT + ot_t * HG_RS + 16 * ot_c + 8);
          const unsigned ow[8] = {o0.x, o0.y, o0.z, o0.w, o1.x, o1.y, o1.z, o1.w}, gwv[8] = {gb0.x, gb0.y, gb0.z, gb0.w, gb1.x, gb1.y, gb1.z, gb1.w};
          unsigned rw[8];
#pragma unroll
          for (int j = 0; j < 8; ++j) rw[j] = pk2(bflo(ow[j]) * rstd * gn[2 * j] * siluf_(bflo(gwv[j])), bfhi(ow[j]) * rstd * gn[2 * j + 1] * siluf_(bfhi(gwv[j])));
          bf16_t* dst = REC + (size_t)(b * SEQ + n * 64 + ot_t) * 1024 + h * 128 + 16 * ot_c;
          *(u32x4*)dst = (u32x4){rw[0], rw[1], rw[2], rw[3]}; *(u32x4*)(dst + 8) = (u32x4){rw[4], rw[5], rw[6], rw[7]}; }
    }
}
__device__ __forceinline__ void phase_hgrn(const Params& p, unsigned char* lds, int vb, int vG) {
    for (int it = vb; it < 64; it += vG) hgrn_item(p, lds, it);
}

constexpr int AT_KRS = 136, AT_VRS = 36, AT_KB = 32 * AT_KRS * 2, AT_VB = 128 * AT_VRS * 2, AT_STAGE = AT_KB + AT_VB;
__device__ __forceinline__ void attn_item(const Params& p, unsigned char* lds, int b, int head, int cq) {
    const int tid = threadIdx.x, w = __builtin_amdgcn_readfirstlane(tid >> 6), lane = tid & 63, r = lane & 31, hh = lane >> 5;
    const bf16_t* P = (const bf16_t*)(p.ws + WS_P); const bf16_t* VT = (const bf16_t*)(p.ws + WS_VT); const unsigned* MASKT = (const unsigned*)(p.ws + WS_MASK);
    bf16_t* AO = (bf16_t*)((unsigned char*)p.out + OUT_AO);
    const int c = 4 * cq + (w >> 1), qpos = c * 64 + (w & 1) * 32 + r, tq = b * SEQ + qpos;
    const int nkt_w = 2 * (c + 1), nkt = 8 * (cq + 1);
    const bf16_t* kg = P + (size_t)(b * SEQ + (tid >> 4)) * NP + C_KA + head * 128 + (tid & 15) * 8;
    const bf16_t* vg = VT + (size_t)((b * 8 + head) * 128 + (tid >> 2)) * SEQ + (tid & 3) * 8;
    const int kls = (tid >> 4) * AT_KRS * 2 + (tid & 15) * 16, vls = AT_KB + (tid >> 2) * AT_VRS * 2 + (tid & 3) * 16;
    bf16x8 qf[8];
    { const bf16_t* qp = P + (size_t)tq * NP + C_QA + head * 128 + 8 * hh;
#pragma unroll
      for (int ks = 0; ks < 8; ++ks) qf[ks] = *(const bf16x8*)(qp + ks * 16); }
    f32x16 o[4];
#pragma unroll
    for (int db = 0; db < 4; ++db)
#pragma unroll
        for (int i = 0; i < 16; ++i) o[db][i] = 0.f;
    float mrun = -1e30f, lsum = 0.f;
    const float sc = 0.08838834764831845f * 1.4426950408889634f;
    __syncthreads();
    u32x4 krA, vrA, krB, vrB;
#pragma unroll
    for (int t0 = 0; t0 < 2; ++t0) { krA = *(const u32x4*)(kg + (size_t)(t0 * 32) * NP); vrA = *(const u32x4*)(vg + t0 * 32);
        *(u32x4*)(lds + t0 * AT_STAGE + kls) = krA; *(u32x2*)(lds + t0 * AT_STAGE + vls) = (u32x2){vrA.x, vrA.y}; *(u32x2*)(lds + t0 * AT_STAGE + vls + 8) = (u32x2){vrA.z, vrA.w}; }
    krA = *(const u32x4*)(kg + (size_t)(2 * 32) * NP); vrA = *(const u32x4*)(vg + 2 * 32);
    krB = *(const u32x4*)(kg + (size_t)(3 * 32) * NP); vrB = *(const u32x4*)(vg + 3 * 32);
    unsigned mwA = MASKT[(size_t)(b * 64) * SEQ + qpos], mwB = MASKT[(size_t)(b * 64 + 1) * SEQ + qpos];
    __syncthreads();
    int st = 0, st2 = 2;
#define AT_TILE(KT, KR, VR, MW) do { const int kt_ = (KT); \
        if (kt_ + 2 < nkt) { *(u32x4*)(lds + st2 * AT_STAGE + kls) = KR; *(u32x2*)(lds + st2 * AT_STAGE + vls) = (u32x2){VR.x, VR.y}; *(u32x2*)(lds + st2 * AT_STAGE + vls + 8) = (u32x2){VR.z, VR.w}; } \
        if (kt_ + 4 < nkt) { KR = *(const u32x4*)(kg + (size_t)((kt_ + 4) * 32) * NP); VR = *(const u32x4*)(vg + (kt_ + 4) * 32); } \
        if (kt_ < nkt_w) { \
            const unsigned mwc = MW; \
            if (kt_ + 2 < nkt_w) MW = MASKT[(size_t)(b * 64 + kt_ + 2) * SEQ + qpos]; \
            const bf16_t* Ks = (const bf16_t*)(lds + st * AT_STAGE); const bf16_t* Vs = (const bf16_t*)(lds + st * AT_STAGE + AT_KB); \
            f32x16 s; \
            _Pragma("unroll") for (int i = 0; i < 16; ++i) s[i] = 0.f; \
            _Pragma("unroll") for (int ks = 0; ks < 8; ++ks) { const bf16x8 kf = *(const bf16x8*)(Ks + r * AT_KRS + ks * 16 + 8 * hh); s = __builtin_amdgcn_mfma_f32_32x32x16_bf16(kf, qf[ks], s, 0, 0, 0); } \
            float mx = -3e38f; const unsigned mws = mwc >> (4 * hh);        \
            _Pragma("unroll") for (int i = 0; i < 16; ++i) { const bool ok = (mws >> ((i & 3) + 8 * (i >> 2))) & 1u; s[i] = ok ? s[i] : -3e38f; mx = fmaxf(mx, s[i]); } \
            mx = fmaxf(mx, __shfl_xor(mx, 32)); \
            const float mnew = fmaxf(mrun, mx * sc), alpha = exp2f(mrun - mnew); \
            const bool grew = mnew > mrun; mrun = mnew; \
            float ps = 0.f; float pv[16]; \
            _Pragma("unroll") for (int i = 0; i < 16; ++i) { const float e = exp2f(fmaf(s[i], sc, -mnew)); pv[i] = e; ps += e; }        \
            lsum = lsum * alpha + ps; \
            if (__builtin_amdgcn_ballot_w64(grew) != 0ull) { _Pragma("unroll") for (int db = 0; db < 4; ++db) _Pragma("unroll") for (int i = 0; i < 16; ++i) o[db][i] *= alpha; } \
            bf16x8 pf[2]; \
            _Pragma("unroll") for (int s2 = 0; s2 < 2; ++s2) { u32x4 wv; wv.x = pk2(pv[8 * s2 + 0], pv[8 * s2 + 1]); wv.y = pk2(pv[8 * s2 + 2], pv[8 * s2 + 3]); wv.z = pk2(pv[8 * s2 + 4], pv[8 * s2 + 5]); wv.w = pk2(pv[8 * s2 + 6], pv[8 * s2 + 7]); pf[s2] = __builtin_bit_cast(bf16x8, wv); } \
            _Pragma("unroll") for (int db = 0; db < 4; ++db) _Pragma("unroll") for (int s2 = 0; s2 < 2; ++s2) { const bf16_t* vp = Vs + (db * 32 + r) * AT_VRS + 16 * s2 + 4 * hh; const u32x2 lo = *(const u32x2*)vp, hi = *(const u32x2*)(vp + 8); \
                    const u32x4 wv = {lo.x, lo.y, hi.x, hi.y}; \
                    o[db] = __builtin_amdgcn_mfma_f32_32x32x16_bf16(__builtin_bit_cast(bf16x8, wv), pf[s2], o[db], 0, 0, 0); } \
        } \
        __syncthreads(); \
        st = (st == 2) ? 0 : st + 1; st2 = (st2 == 2) ? 0 : st2 + 1; } while (0)
#pragma unroll 1
    for (int kt = 0; kt < nkt; kt += 2) { AT_TILE(kt, krA, vrA, mwA); AT_TILE(kt + 1, krB, vrB, mwB); }
#undef AT_TILE
    const float l = lsum + __shfl_xor(lsum, 32), inv = 1.f / l;
    bf16_t* op = AO + (size_t)tq * 1024 + head * 128 + 4 * hh;
#pragma unroll
    for (int db = 0; db < 4; ++db)
#pragma unroll
        for (int g4 = 0; g4 < 4; ++g4) { u32x2 wv; wv.x = pk2(o[db][4 * g4] * inv, o[db][4 * g4 + 1] * inv); wv.y = pk2(o[db][4 * g4 + 2] * inv, o[db][4 * g4 + 3] * inv);
            *(u32x2*)(op + db * 32 + 8 * g4) = wv; }
}
__device__ __forceinline__ void phase_attn(const Params& p, unsigned char* lds, int vb, int vG) {
    const int G = vG;
    for (int rd = 0;; ++rd) {
        const int base = rd * G; if (base >= 512) break;
        const int pos = (rd & 1) ? (G - 1 - vb) : vb; const int i = base + pos; if (i >= 512) continue;
        attn_item(p, lds, (i >> 3) & 7, i & 7, 7 - (i >> 6));
    }
}
__device__ __forceinline__ void phase_attn_queue(const Params& p, unsigned char* lds, unsigned* qhead) {
    volatile LAS int* slot = (volatile LAS int*)((LAS unsigned char*)lds + LDS_BYTES - 32);
    for (;;) {
        __syncthreads();
        if (threadIdx.x == 0) slot[0] = (int)__hip_atomic_fetch_add(qhead, 1u, __ATOMIC_RELAXED, __HIP_MEMORY_SCOPE_AGENT);
        __syncthreads();
        const int i = slot[0]; if (i >= 512) break;
        attn_item(p, lds, (i >> 3) & 7, i & 7, 7 - (i >> 6));
    }
}
__device__ __forceinline__ void phase_uv(const Params& p) {
    const int tid = threadIdx.x, wave = tid >> 6, lane = tid & 63;
    const int gw = blockIdx.x * NWAVES + wave, NGW = gridDim.x * NWAVES;
    for (int it = gw; it < 2 * 16384; it += NGW) {
        const int tbl = it >> 14, row = it & 16383;
        const float* src = (tbl ? p.in[15] : p.in[14]) + (size_t)row * 2048 + 32 * lane;
        unsigned char* dst = p.ws + (tbl ? WS_V8 : WS_U8); float* isc = (float*)(p.ws + (tbl ? WS_ISV : WS_ISU));
        f32x4 v[8]; float am = 0.f;
#pragma unroll
        for (int j = 0; j < 8; ++j) { v[j] = *(const f32x4*)(src + 4 * j); am = fmaxf(am, fmaxf(fmaxf(fabsf(v[j][0]), fabsf(v[j][1])), fmaxf(fabsf(v[j][2]), fabsf(v[j][3])))); }
#pragma unroll
        for (int o = 1; o < 64; o <<= 1) am = fmaxf(am, __shfl_xor(am, o));
        am = fmaxf(am, 1e-30f); const float sc = 256.f / am;
        unsigned wq[8];
#pragma unroll
        for (int j = 0; j < 8; ++j) { int pk = 0; pk = __builtin_amdgcn_cvt_pk_fp8_f32(v[j][0] * sc, v[j][1] * sc, pk, false); pk = __builtin_amdgcn_cvt_pk_fp8_f32(v[j][2] * sc, v[j][3] * sc, pk, true); wq[j] = (unsigned)pk; }
        unsigned char* d = dst + (size_t)(lane >> 2) * (2u << 20) + (size_t)row * 128 + (lane & 3) * 32;
        *(u32x4*)d = (u32x4){wq[0], wq[1], wq[2], wq[3]}; *(u32x4*)(d + 16) = (u32x4){wq[4], wq[5], wq[6], wq[7]};
        if (lane == 0) isc[row] = am * (1.f / 256.f);
    }
}

#define INS16(v, x) do { _Pragma("unroll") for (int _j = 15; _j >= 1; --_j) v[_j] = __builtin_amdgcn_fmed3f(v[_j - 1], v[_j], (x)); v[0] = fmaxf(v[0], (x)); } while (0)
__device__ __forceinline__ void peer_half_top16(const bf16_t* QP, const bf16_t* KEYS, int tok, int p, int hf, int r, int hh, float (&v)[16]) {
    bf16x8 qf[8];
    { const bf16_t* qp = QP + (size_t)tok * D + p * 256 + hf * 128 + 8 * hh;
#pragma unroll
      for (int ks = 0; ks < 8; ++ks) qf[ks] = *(const bf16x8*)(qp + ks * 16); }
#pragma unroll
    for (int k = 0; k < 16; ++k) v[k] = -3.0e38f;
    const bf16_t* kb = KEYS + (size_t)((p * 2 + hf) * 128 + r) * 128 + 8 * hh;
#pragma unroll 1
    for (int nb = 0; nb < 4; ++nb) {
        f32x16 acc;
#pragma unroll
        for (int i = 0; i < 16; ++i) acc[i] = 0.f;
#pragma unroll
        for (int ks = 0; ks < 8; ++ks) { const bf16x8 kf = *(const bf16x8*)(kb + (size_t)(nb * 32) * 128 + ks * 16); acc = __builtin_amdgcn_mfma_f32_32x32x16_bf16(kf, qf[ks], acc, 0, 0, 0); }
#pragma unroll
        for (int i = 0; i < 16; ++i) { const unsigned xi = (unsigned)(nb * 32 + (i & 3) + 8 * (i >> 2) + 4 * hh); const float x = __uint_as_float((__float_as_uint(acc[i]) & ~0x7fu) | xi); INS16(v, x); }
    }
    float ov[16];
#pragma unroll
    for (int k = 0; k < 16; ++k) ov[k] = __shfl_xor(v[k], 32);
#pragma unroll
    for (int k = 0; k < 16; ++k) INS16(v, ov[k]);
}
__device__ __forceinline__ void phase_peer_topk(const Params& p) {
    const int tid = threadIdx.x, wave = tid >> 6, lane = tid & 63, r = lane & 31, hh = lane >> 5;
    const bf16_t* QP = (const bf16_t*)(p.ws + WS_QP); const bf16_t* KEYS = (const bf16_t*)(p.ws + WS_KEYS);
    int* EIDX = (int*)(p.ws + WS_EIDX); float* EGATE = (float*)(p.ws + WS_EGATE);
    const int gw = blockIdx.x * NWAVES + wave, NGW = gridDim.x * NWAVES;
    for (int it = gw; it < 512 * 8; it += NGW) {
        const int tg = it >> 3, hd = it & 7, tok = tg * 32 + r;
        float va[16], vb[16];
        peer_half_top16(QP, KEYS, tok, hd, 0, r, hh, va);
        peer_half_top16(QP, KEYS, tok, hd, 1, r, hh, vb);
        float bv[16];
#pragma unroll
        for (int k = 0; k < 16; ++k) bv[k] = -3.0e38f;
#pragma unroll
        for (int a = 0; a < 16; ++a)
#pragma unroll
            for (int b2 = 0; b2 < 16; ++b2) if ((a + 1) * (b2 + 1) <= 16) { const float x = va[a] + vb[b2]; INS16(bv, x); }
        float se = 0.f;
#pragma unroll
        for (int k = 0; k < 16; ++k) se += __expf(bv[k] - bv[0]);
        const float inv = 1.f / se, thr = bv[15], top = bv[0];
        int cnt = 0; int* ei = EIDX + (size_t)tok * 128 + hd * 16; float* eg = EGATE + (size_t)tok * 128 + hd * 16;
#pragma unroll
        for (int a = 0; a < 16; ++a)
#pragma unroll
            for (int b2 = 0; b2 < 16; ++b2) if ((a + 1) * (b2 + 1) <= 16) { const float x = va[a] + vb[b2];
                if (x >= thr && cnt < 16) { if (hh == 0) { ei[cnt] = (int)((__float_as_uint(va[a]) & 0x7fu) * 128u + (__float_as_uint(vb[b2]) & 0x7fu)); eg[cnt] = __expf(x - top) * inv; } ++cnt; } }
    }
}

typedef __bf16 bf16x2_t __attribute__((ext_vector_type(2)));
__device__ __forceinline__ float gelu_erf(float v) {
    const float av = fabsf(v), d = av * 0.2316418882f + 1.0f, t = __builtin_amdgcn_rcpf(d);
    float q = t * 0.5307027145f + (-0.7265760135f); q = q * t + 0.7107068705f; q = q * t + (-0.142248368f); q = q * t + 0.127414796f; q = q * t;
    const float e = __builtin_amdgcn_exp2f((v * v) * (-0.72134752044f));
    const float m = v * (q * e), r = v - m;
    return v < 0.f ? m : r;
}
__device__ __forceinline__ float dot2bf(unsigned a, unsigned b, float c) { return __builtin_amdgcn_fdot2_f32_bf16(__builtin_bit_cast(bf16x2_t, a), __builtin_bit_cast(bf16x2_t, b), c, false); }
__device__ __forceinline__ float dpp_f(float x, int ctrl_xor1_xor2_mirror) {
    const int v = __float_as_int(x);
    if (ctrl_xor1_xor2_mirror == 0) return __int_as_float(__builtin_amdgcn_update_dpp(0, v, 0xB1, 0xF, 0xF, true));
    if (ctrl_xor1_xor2_mirror == 1) return __int_as_float(__builtin_amdgcn_update_dpp(0, v, 0x4E, 0xF, 0xF, true));
    return __int_as_float(__builtin_amdgcn_update_dpp(0, v, 0x141, 0xF, 0xF, true));
}
typedef float f32x2v __attribute__((ext_vector_type(2)));
__device__ __forceinline__ void unpack8(const u32x4 w, float* f) { f[0] = bflo(w.x); f[1] = bfhi(w.x); f[2] = bflo(w.y); f[3] = bfhi(w.y); f[4] = bflo(w.z); f[5] = bfhi(w.z); f[6] = bflo(w.w); f[7] = bfhi(w.w); }
__device__ __forceinline__ void cvt16(const u32x4 w, float* f) {
#pragma unroll
    for (int q = 0; q < 4; ++q) { const f32x2v lo = __builtin_amdgcn_cvt_pk_f32_fp8((int)w[q], false), hi = __builtin_amdgcn_cvt_pk_f32_fp8((int)w[q], true);
        f[4 * q] = lo.x; f[4 * q + 1] = lo.y; f[4 * q + 2] = hi.x; f[4 * q + 3] = hi.y; }
}
__device__ __forceinline__ void phase_experts(const Params& p, unsigned char* lds) {
    const int tid = threadIdx.x, wave = __builtin_amdgcn_readfirstlane(tid >> 6), lane = tid & 63, rr = lane >> 3, cc = lane & 7; const bool odd = cc & 1;
    const bf16_t* H2 = (const bf16_t*)(p.ws + WS_H2); const unsigned char* U8 = p.ws + WS_U8; const unsigned char* V8 = p.ws + WS_V8;
    const float* ISU = (const float*)(p.ws + WS_ISU); const float* ISV = (const float*)(p.ws + WS_ISV);
    const int* EIDX = (const int*)(p.ws + WS_EIDX); const float* EGATE = (const float*)(p.ws + WS_EGATE);
    const float* mod = (const float*)(p.ws + WS_MOD); const float* fin = p.in[16]; float* out = p.out; const float* X1 = (const float*)(p.ws + WS_X1);
    unsigned* offs = (unsigned*)lds; float* gts = (float*)(lds + 32768); float* rstl = (float*)(lds + 65536);
    const unsigned xcc = (unsigned)__builtin_amdgcn_s_getreg((3 << 11) | 20) & 7u; const unsigned cc16 = cc * 16;
    for (int tile = blockIdx.x; tile < T / 64; tile += gridDim.x) {
        const int tok0 = tile * 64, b = tok0 >> 11;
        __syncthreads();
        for (int i = tid; i < 8192; i += NTHREADS) { const int tl = i >> 7, j = i & 127, g = j >> 3, r8 = j & 7;
            offs[(tl * 8 + r8) * 16 + g] = (unsigned)EIDX[(size_t)tok0 * 128 + i] * 128u; gts[(tl * 8 + r8) * 16 + g] = EGATE[(size_t)tok0 * 128 + i]; }
        __syncthreads();
#pragma unroll 1
        for (int half = 0; half < 1; ++half) {
            const int tlb = wave * 8;
            u32x4 dA[16], hA0, hA1;
#ifndef EXP_REP_U
#define EXP_REP_U 0
#endif
#ifndef EXP_REP_V
#define EXP_REP_V 0
#endif
#define EX_SLICE(i_) ((xcc * 2u + (unsigned)(i_)) & 15u)
#define EX_LOAD(buf, TBL, i_, k_) do { const unsigned char* tb_ = (TBL) + (size_t)EX_SLICE(i_) * (2u << 20); u32x4 o4_[4]; \
    _Pragma("unroll") for (int q_ = 0; q_ < 4; ++q_) o4_[q_] = *(const u32x4*)(offs + ((tlb + (k_)) * 8 + rr) * 16 + 4 * q_); \
    _Pragma("unroll") for (int g_ = 0; g_ < 16; ++g_) buf[g_] = *(const u32x4*)(tb_ + (o4_[g_ >> 2][g_ & 3] + cc16)); } while (0)
#define EX_LOADH(h0, h1, i_, k_) do { const bf16_t* hp_ = H2 + (size_t)(tok0 + tlb + (k_)) * D + EX_SLICE(i_) * 128 + cc * 16; h0 = *(const u32x4*)hp_; h1 = *(const u32x4*)(hp_ + 8); } while (0)
#define EX_DOT16(acc, WSRC, hf) do { u32x4 w_ = WSRC; asm volatile("" : "+v"(w_.x), "+v"(w_.y), "+v"(w_.z), "+v"(w_.w), "+v"(ch_)); \
    _Pragma("unroll") for (int q_ = 0; q_ < 4; ++q_) { const f32x2v lo_ = __builtin_amdgcn_cvt_pk_f32_fp8((int)w_[q_], false), hi_ = __builtin_amdgcn_cvt_pk_f32_fp8((int)w_[q_], true); \
        acc = dot2bf(pk2(lo_.x, lo_.y), hf[2 * q_], acc); acc = dot2bf(pk2(hi_.x, hi_.y), hf[2 * q_ + 1], acc); } ch_ = acc; } while (0)
#define EX_UCOMP(buf, h0, h1, k_) do { const unsigned hf_[8] = {h0.x, h0.y, h0.z, h0.w, h1.x, h1.y, h1.z, h1.w}; float ch_ = 0.f; \
    _Pragma("unroll") for (int j_ = 0; j_ < 8; ++j_) { float te_ = 0.f, to_ = 0.f; EX_DOT16(te_, buf[2 * j_], hf_); __builtin_amdgcn_sched_barrier(0); EX_DOT16(to_, buf[2 * j_ + 1], hf_); \
    const float my_ = odd ? to_ : te_, ot_ = odd ? te_ : to_; zp[k_][j_] += my_ + dpp_f(ot_, 0); asm volatile("" : "+v"(zp[k_][j_])); __builtin_amdgcn_sched_barrier(0); } } while (0)
#define SB() __builtin_amdgcn_sched_barrier(0)
            float zp[8][8];
#pragma unroll
            for (int k = 0; k < 8; ++k)
#pragma unroll
                for (int j = 0; j < 8; ++j) zp[k][j] = 0.f;
#pragma unroll 1
            for (int i = 0; i < 16 * (1 + EXP_REP_U); ++i) {
                __builtin_amdgcn_s_barrier();
                EX_LOADH(hA0, hA1, i, 0); EX_LOAD(dA, U8, i, 0); SB(); EX_UCOMP(dA, hA0, hA1, 0); SB();
                EX_LOADH(hA0, hA1, i, 1); EX_LOAD(dA, U8, i, 1); SB(); EX_UCOMP(dA, hA0, hA1, 1); SB();
                EX_LOADH(hA0, hA1, i, 2); EX_LOAD(dA, U8, i, 2); SB(); EX_UCOMP(dA, hA0, hA1, 2); SB();
                EX_LOADH(hA0, hA1, i, 3); EX_LOAD(dA, U8, i, 3); SB(); EX_UCOMP(dA, hA0, hA1, 3); SB();
                EX_LOADH(hA0, hA1, i, 4); EX_LOAD(dA, U8, i, 4); SB(); EX_UCOMP(dA, hA0, hA1, 4); SB();
                EX_LOADH(hA0, hA1, i, 5); EX_LOAD(dA, U8, i, 5); SB(); EX_UCOMP(dA, hA0, hA1, 5); SB();
                EX_LOADH(hA0, hA1, i, 6); EX_LOAD(dA, U8, i, 6); SB(); EX_UCOMP(dA, hA0, hA1, 6); SB();
                EX_LOADH(hA0, hA1, i, 7); EX_LOAD(dA, U8, i, 7); SB(); EX_UCOMP(dA, hA0, hA1, 7); SB();
            }
            if (EXP_REP_U) {
#pragma unroll
                for (int k = 0; k < 8; ++k)
#pragma unroll
                    for (int j = 0; j < 8; ++j) zp[k][j] *= 0.5f; }
            unsigned* apl = (unsigned*)(lds + 66560);
#pragma unroll
            for (int k = 0; k < 8; ++k)
#pragma unroll
                for (int j = 0; j < 8; ++j) { float z = zp[k][j]; z += dpp_f(z, 1); z += __shfl_xor(z, 4);
                    const int li = ((tlb + k) * 8 + rr) * 16 + 2 * j + (odd ? 1 : 0); const unsigned eid = offs[li] >> 7;
                    const float act = gelu_erf(z * ISU[eid]) * gts[li] * ISV[eid]; const float oth = dpp_f(act, 0);
                    apl[((tlb + k) * 8 + rr) * 8 + j] = f2bf(odd ? oth : act) | (f2bf(odd ? act : oth) << 16); }
            LDS_WAIT();
#define EX_VCOMP(buf, i_, k_) do { float oa_[16]; _Pragma("unroll") for (int e_ = 0; e_ < 16; ++e_) oa_[e_] = 0.f; \
    const int col_ = (int)EX_SLICE(i_) * 128 + cc * 16 + 2 * rr; const size_t xo_ = (size_t)(tok0 + tlb + (k_)) * D + col_; \
    const f32x2v x1_ = *(const f32x2v*)(X1 + xo_), g2_ = *(const f32x2v*)(mod + (size_t)b * NADA + 5 * 2048 + col_); \
    _Pragma("unroll") for (int j_ = 0; j_ < 8; ++j_) { const unsigned pr_ = apl[((tlb + (k_)) * 8 + rr) * 8 + j_]; const float a0_ = bflo(pr_), a1_ = bfhi(pr_); \
        { u32x4 w_ = buf[2 * j_]; asm volatile("" : "+v"(w_.x), "+v"(w_.y), "+v"(w_.z), "+v"(w_.w), "+v"(oa_[0])); float f_[16]; cvt16(w_, f_); _Pragma("unroll") for (int e_ = 0; e_ < 16; ++e_) oa_[e_] = fmaf(a0_, f_[e_], oa_[e_]); } \
        { u32x4 w_ = buf[2 * j_ + 1]; asm volatile("" : "+v"(w_.x), "+v"(w_.y), "+v"(w_.z), "+v"(w_.w), "+v"(oa_[0])); float f_[16]; cvt16(w_, f_); _Pragma("unroll") for (int e_ = 0; e_ < 16; ++e_) oa_[e_] = fmaf(a1_, f_[e_], oa_[e_]); } } \
      \
    float b8_[8], b4_[4], b2_[2]; \
    _Pragma("unroll") for (int e_ = 0; e_ < 8; ++e_) { const bool up_ = lane & 32; const float kp_ = up_ ? oa_[e_ + 8] : oa_[e_], sd_ = up_ ? oa_[e_] : oa_[e_ + 8]; b8_[e_] = kp_ + __shfl_xor(sd_, 32); } \
    _Pragma("unroll") for (int e_ = 0; e_ < 4; ++e_) { const bool up_ = lane & 16; const float kp_ = up_ ? b8_[e_ + 4] : b8_[e_], sd_ = up_ ? b8_[e_] : b8_[e_ + 4]; b4_[e_] = kp_ + __shfl_xor(sd_, 16); } \
    _Pragma("unroll") for (int e_ = 0; e_ < 2; ++e_) { const bool up_ = lane & 8; const float kp_ = up_ ? b4_[e_ + 2] : b4_[e_], sd_ = up_ ? b4_[e_] : b4_[e_ + 2]; b2_[e_] = kp_ + __shfl_xor(sd_, 8); } \
    f32x2v y_; y_.x = x1_.x + g2_.x * b2_[0]; y_.y = x1_.y + g2_.y * b2_[1]; *(f32x2v*)(out + xo_) = y_; } while (0)
#pragma unroll 1
            for (int i = 0; i < 16 * (1 + EXP_REP_V); ++i) {
                __builtin_amdgcn_s_barrier();
                EX_LOAD(dA, V8, i, 0); SB(); EX_VCOMP(dA, i, 0); SB();
                EX_LOAD(dA, V8, i, 1); SB(); EX_VCOMP(dA, i, 1); SB();
                EX_LOAD(dA, V8, i, 2); SB(); EX_VCOMP(dA, i, 2); SB();
                EX_LOAD(dA, V8, i, 3); SB(); EX_VCOMP(dA, i, 3); SB();
                EX_LOAD(dA, V8, i, 4); SB(); EX_VCOMP(dA, i, 4); SB();
                EX_LOAD(dA, V8, i, 5); SB(); EX_VCOMP(dA, i, 5); SB();
                EX_LOAD(dA, V8, i, 6); SB(); EX_VCOMP(dA, i, 6); SB();
                EX_LOAD(dA, V8, i, 7); SB(); EX_VCOMP(dA, i, 7); SB();
            }
        }
#undef EX_SLICE
#undef EX_LOAD
#undef EX_LOADH
#undef EX_DOT16
#undef EX_UCOMP
#undef EX_VCOMP
#undef SB
        __builtin_amdgcn_fence(__ATOMIC_RELEASE, "agent"); __builtin_amdgcn_fence(__ATOMIC_ACQUIRE, "agent");
        LDS_WAIT();
        int lane2 = (int)__builtin_amdgcn_mbcnt_hi(~0u, __builtin_amdgcn_mbcnt_lo(~0u, 0u)); asm volatile("" : "+v"(lane2));
#pragma unroll 1
        for (int k = 0; k < 8; ++k) { float* xr = out + (size_t)(tok0 + wave * 8 + k) * D;
            f32x4 v[8]; float ss = 0.f;
#pragma unroll
            for (int j = 0; j < 8; ++j) { v[j] = *(const f32x4*)(xr + 4 * (lane2 + 64 * j)); ss += (v[j][0] * v[j][0] + v[j][1] * v[j][1]) + (v[j][2] * v[j][2] + v[j][3] * v[j][3]); }
            const float rs = rsqrtf(wave_sum(ss) * (1.f / D) + NORM_EPS);
#pragma unroll
            for (int j = 0; j < 8; ++j) { const int col = 4 * (lane2 + 64 * j); const f32x4 f = *(const f32x4*)(fin + col);
                f32x4 o; o[0] = v[j][0] * rs * f[0]; o[1] = v[j][1] * rs * f[1]; o[2] = v[j][2] * rs * f[2]; o[3] = v[j][3] * rs * f[3]; *(f32x4*)(xr + col) = o; } }
    }
}

#define XB_TMO      128
#define XB_XCNT(j)  (256  + 64 * (j))
#define XB_XSUB(j)  (1280 + 64 * (j))
#define XB_XGEN(j)  (2304 + 64 * (j))
#define XB_TOP      3328
#define XB_TOPGEN   3392
#define XCD_BAR_WORDS 3456
#define XB_SPIN_CAP (1u << 22)
__device__ __forceinline__ unsigned xb_ld(unsigned* p)              { return __hip_atomic_load(p, __ATOMIC_RELAXED, __HIP_MEMORY_SCOPE_AGENT); }
__device__ __forceinline__ unsigned xb_add(unsigned* p, unsigned v) { return __hip_atomic_fetch_add(p, v, __ATOMIC_RELAXED, __HIP_MEMORY_SCOPE_AGENT); }
__device__ __forceinline__ unsigned xb_xcc_id() { return (unsigned)__builtin_amdgcn_s_getreg((3 << 11) | 20) & 0xFu; }
#define XB_SPIN(cond, bar) do { unsigned _sp = 0; while (cond) { __builtin_amdgcn_s_sleep(1); \
    if ((++_sp & 255u) == 0u) { if (xb_ld(&(bar)[XB_TMO])) break; if (_sp > XB_SPIN_CAP) { atomicAdd(&(bar)[XB_TMO], 1u); break; } } } } while (0)
struct XcdBarrier { unsigned* bar; unsigned x; volatile LAS unsigned* st; };
__device__ __forceinline__ XcdBarrier xcd_barrier_post(unsigned* bar, volatile LAS unsigned* st) {
    XcdBarrier b; b.bar = bar; b.x = xb_xcc_id(); b.st = st;
    if (threadIdx.x == 0) (void)xb_add(&bar[XB_XCNT(b.x)], 1u);
    return b;
}
__device__ __forceinline__ void xcd_barrier_complete(unsigned* bar, unsigned x, unsigned& nloc, unsigned& nx) {
    const unsigned G = gridDim.x * gridDim.y * gridDim.z;
    unsigned sum, cnt, mine, sp = 0u;
    for (;;) {
        sum = 0u; cnt = 0u; mine = 0u;
#pragma unroll
        for (unsigned j = 0; j < 16; ++j) { const unsigned c = xb_ld(&bar[XB_XCNT(j)]); sum += c; cnt += (c > 0u) ? 1u : 0u; mine = (j == x) ? c : mine; }
        if (sum == G) break;
        __builtin_amdgcn_s_sleep(1);
        if ((++sp & 255u) == 0u) { if (xb_ld(&bar[XB_TMO])) break; if (sp > XB_SPIN_CAP) { atomicAdd(&bar[XB_TMO], 1u); break; } }
    }
    nloc = mine > 0u ? mine : 1u; nx = cnt > 0u ? cnt : 1u;
}
__device__ __forceinline__ void xcd_barrier(const XcdBarrier& b) {
    asm volatile("s_waitcnt vmcnt(0)" ::: "memory");
    __syncthreads();
    if (threadIdx.x == 0) {
        unsigned* bar = b.bar;
        __builtin_amdgcn_s_waitcnt(0);
        unsigned nloc = b.st[0], nx = b.st[1];
        if (nloc == 0u) { xcd_barrier_complete(bar, b.x, nloc, nx); b.st[0] = nloc; b.st[1] = nx; }
        const unsigned old = xb_add(&bar[XB_XSUB(b.x)], 1u);
        const unsigned gen = old / nloc;
        if (old + 1u == (gen + 1u) * nloc) {
            __builtin_amdgcn_fence(__ATOMIC_RELEASE, "agent");
            asm volatile("s_waitcnt vmcnt(0)" ::: "memory");
            const unsigned og = xb_add(&bar[XB_TOP], 1u);
            const unsigned tg = og / nx;
            if (og + 1u == (tg + 1u) * nx) xb_add(&bar[XB_TOPGEN], 1u);
            else XB_SPIN(xb_ld(&bar[XB_TOPGEN]) == tg, bar);
            __builtin_amdgcn_fence(__ATOMIC_ACQUIRE, "agent");
            xb_add(&bar[XB_XGEN(b.x)], 1u);
            asm volatile("s_waitcnt vmcnt(0)" ::: "memory");
        } else {
            XB_SPIN(xb_ld(&bar[XB_XGEN(b.x)]) == gen, bar);
            __builtin_amdgcn_fence(__ATOMIC_ACQUIRE, "agent");
            asm volatile("s_waitcnt vmcnt(0)" ::: "memory");
        }
    }
    __syncthreads();
}

__device__ __forceinline__ void subset_barrier(unsigned* cnt, unsigned n) {
    asm volatile("s_waitcnt vmcnt(0)" ::: "memory");
    __syncthreads();
    if (threadIdx.x == 0) {
        __builtin_amdgcn_fence(__ATOMIC_RELEASE, "agent");
        asm volatile("s_waitcnt vmcnt(0)" ::: "memory");
        __hip_atomic_fetch_add(cnt, 1u, __ATOMIC_RELAXED, __HIP_MEMORY_SCOPE_AGENT);
        unsigned sp = 0;
        while (__hip_atomic_load(cnt, __ATOMIC_RELAXED, __HIP_MEMORY_SCOPE_AGENT) < n) { __builtin_amdgcn_s_sleep(1); if (++sp > (1u << 24)) break; }
        __builtin_amdgcn_fence(__ATOMIC_ACQUIRE, "agent");
        asm volatile("s_waitcnt vmcnt(0)" ::: "memory");
    }
    __syncthreads();
}
__device__ __forceinline__ void subset_wait(unsigned* cnt, unsigned n) {
    __syncthreads();
    if (threadIdx.x == 0) {
        unsigned sp = 0;
        while (__hip_atomic_load(cnt, __ATOMIC_RELAXED, __HIP_MEMORY_SCOPE_AGENT) < n) { __builtin_amdgcn_s_sleep(2); if (++sp > (1u << 24)) break; }
        __builtin_amdgcn_fence(__ATOMIC_ACQUIRE, "agent");
        asm volatile("s_waitcnt vmcnt(0)" ::: "memory");
    }
    __syncthreads();
}
constexpr int NPHASES = 11;
__global__ void __launch_bounds__(NTHREADS, 2) mega_fwd(Params p) {
    extern __shared__ __attribute__((aligned(16))) unsigned char lds[];
    cg::grid_group grid = cg::this_grid();
    const int lo = p.ph_lo, hi = p.ph_hi;
#ifndef PHASE_MASK
#define PHASE_MASK 0x7ff
#endif
#define IN(k) (((PHASE_MASK >> (k)) & 1) && lo <= (k) && (k) < hi)
#define SEAM(k) do { if (IN(k) && IN((k) + 1)) { if ((k) == 0) grid.sync(); else xcd_barrier(xbar); } } while (0)
    unsigned char* ws = p.ws;
    bf16_t* P = (bf16_t*)(ws + WS_P);
    bf16_t* Hb = (bf16_t*)((unsigned char*)p.out + OUT_H);
    bf16_t* WinT = (bf16_t*)((unsigned char*)p.out + OUT_WIN);
    const float* mod = (const float*)(ws + WS_MOD);
    LAS unsigned char* ldsl = (LAS unsigned char*)lds;
    volatile LAS unsigned* xst = (volatile LAS unsigned*)(ldsl + LDS_BYTES - 64);
    if (threadIdx.x < 2) xst[threadIdx.x] = 0u;
    __syncthreads();
    XcdBarrier xbar = xcd_barrier_post((unsigned*)(ws + WS_CTL) + 4096, xst);

#ifndef REPEAT_PHASE
#define REPEAT_PHASE -1
#endif
    int rep3 = 0;
#define RUNPH(k, ...) do { if (IN(k)) { __VA_ARGS__; if (REPEAT_PHASE == (k)) { grid.sync(); __VA_ARGS__; } } } while (0)
    RUNPH(0, { phase_mod(p, lds); __syncthreads(); phase_weights(p, lds); });
    SEAM(0);
    RUNPH(1, { phase_norm_rows(p.in[0], p.in[4], mod, mod + 2048, Hb, LDP); });
    SEAM(1);
    RUNPH(2, { pg8::Gemm g{Hb, WinT, nullptr, nullptr, LDP, LDP, T, NP, D}; pg8::StaticOrder<1> S; S.init(T, NP, gridDim.x, blockIdx.x);
        pg8::EpiBf16 E{P, NP, 33}; pg8::gemm_phase(ldsl, g, S, E); });
    SEAM(2);
    RUNPH(3, { const int G = gridDim.x, bx = blockIdx.x;
        unsigned* sbar = (unsigned*)(ws + WS_CTL) + 12288 + ((REPEAT_PHASE == 3) ? 64 * rep3 : 0); unsigned* qh = sbar + 16;
        if (G >= 128) { if (bx < 64) { phase_hgrn(p, lds, bx, 64); if (REPEAT_PHASE == 32) phase_hgrn(p, lds, bx, 64); subset_wait(sbar, (unsigned)(G - 64)); phase_attn_queue(p, lds, qh); }
                        else { phase_vt(p, lds, bx - 64, G - 64); phase_indexer(p, lds, bx - 64, G - 64); if (REPEAT_PHASE == 31) phase_indexer(p, lds, bx - 64, G - 64);
                               subset_barrier(sbar, (unsigned)(G - 64)); phase_attn_queue(p, lds, qh); } }
        else { phase_vt(p, lds, bx, G); phase_indexer(p, lds, bx, G); __syncthreads(); phase_hgrn(p, lds, bx, G); grid.sync(); phase_attn(p, lds, bx, G); }
        ++rep3; });
    SEAM(3);
    RUNPH(5, { pg8::Gemm g{(const bf16_t*)((unsigned char*)p.out + OUT_AO), (const bf16_t*)(ws + WS_WUA), (const bf16_t*)((unsigned char*)p.out + OUT_REC), (const bf16_t*)(ws + WS_WUB), 1024, 1024, T, D, 1024}; pg8::StaticOrder<2> S; S.init(T, D, gridDim.x, blockIdx.x);
        pg8::EpiMix E{(bf16_t*)(ws + WS_MIXED), P}; pg8::gemm_phase(ldsl, g, S, E); });
    SEAM(5);
    RUNPH(6, { pg8::Gemm g{(const bf16_t*)(ws + WS_MIXED), (const bf16_t*)(ws + WS_WOUT), nullptr, nullptr, D, D, T, D, D}; pg8::StaticOrder<1> S; S.init(T, D, gridDim.x, blockIdx.x);
        pg8::EpiX1 E{p.in[0], (float*)(ws + WS_X1), mod + 4096}; pg8::gemm_phase(ldsl, g, S, E); });
    SEAM(6);
    RUNPH(7, { phase_norm_rows((const float*)(ws + WS_X1), p.in[5], mod + 3 * 2048, mod + 4 * 2048, (bf16_t*)(ws + WS_H2), D); phase_uv(p); });
    SEAM(7);
    RUNPH(8, { pg8::Gemm g{(const bf16_t*)(ws + WS_H2), (const bf16_t*)(ws + WS_WQ), nullptr, nullptr, D, D, T, D, D}; pg8::StaticOrder<1> S; S.init(T, D, gridDim.x, blockIdx.x);
        pg8::EpiBf16 E{(bf16_t*)(ws + WS_QP), D, 1 << 30}; pg8::gemm_phase(ldsl, g, S, E); });
    SEAM(8);
    RUNPH(9, { phase_peer_topk(p); });
    SEAM(9);
    RUNPH(10, { phase_experts(p, lds); });
#undef IN
#undef SEAM
}

#ifndef MK_N_LAUNCHES
#define MK_N_LAUNCHES 1
#endif
extern "C" void kernel_launch(void* const* d_in, const int* in_sizes, int n_in, void* d_out, int out_size, void* d_ws, size_t ws_size, hipStream_t stream) {
    static int grid = 0;
    if (grid == 0) {
        if (n_in != 17 || out_size != T * D || ws_size < WS_END) { fprintf(stderr, "kernel_launch: unexpected shapes (n_in %d out %d ws %zu)\n", n_in, out_size, ws_size); grid = -1; return; }
        int dev = 0, cus = 0, per_cu = 0;
        hipGetDevice(&dev); hipDeviceGetAttribute(&cus, hipDeviceAttributeMultiprocessorCount, dev);
        hipFuncSetAttribute((const void*)mega_fwd, hipFuncAttributeMaxDynamicSharedMemorySize, LDS_BYTES);
        hipOccupancyMaxActiveBlocksPerMultiprocessor(&per_cu, (const void*)mega_fwd, NTHREADS, LDS_BYTES);
        if (per_cu < 1) { fprintf(stderr, "kernel_launch: occupancy query says %d blocks/CU\n", per_cu); per_cu = 1; }
        (void)hipGetLastError();
        grid = cus * 1;
    }
    if (grid < 0) return;
    if (hipMemsetAsync((char*)d_ws + WS_CTL, 0, 65536, stream) != hipSuccess) { fprintf(stderr, "kernel_launch: memset failed\n"); return; }
    Params p{};
    for (int i = 0; i < 17; ++i) p.in[i] = (const float*)d_in[i];
    p.out = (float*)d_out; p.ws = (unsigned char*)d_ws;
#if MK_N_LAUNCHES == 1
    p.ph_lo = 0; p.ph_hi = NPHASES;
    void* args[] = {&p};
    hipError_t e = hipLaunchCooperativeKernel((const void*)mega_fwd, dim3(grid), dim3(NTHREADS), args, LDS_BYTES, stream);
    if (e != hipSuccess) fprintf(stderr, "cooperative launch failed: %s (grid %d)\n", hipGetErrorString(e), grid);
#else
    for (int k = 0; k < NPHASES; ++k) { p.ph_lo = k; p.ph_hi = k + 1; void* args[] = {&p};
        hipError_t e = hipLaunchCooperativeKernel((const void*)mega_fwd, dim3(grid), dim3(NTHREADS), args, LDS_BYTES, stream);
        if (e != hipSuccess) { fprintf(stderr, "launch %d failed: %s\n", k, hipGetErrorString(e)); break; } }
#endif
}
```

```cpp
#include <hip/hip_runtime.h>
#include <hip/hip_cooperative_groups.h>
#include <cstdio>
#include <cstdint>
namespace cg = cooperative_groups;

#define LAS __attribute__((address_space(3)))
typedef unsigned short bf16_t;
typedef short bf16x8 __attribute__((ext_vector_type(8)));
typedef short bf16x4 __attribute__((ext_vector_type(4)));
typedef float f32x2 __attribute__((ext_vector_type(2)));
typedef float f32x4 __attribute__((ext_vector_type(4)));
typedef float f32x16 __attribute__((ext_vector_type(16)));
typedef unsigned u32x2 __attribute__((ext_vector_type(2)));
typedef unsigned u32x4 __attribute__((ext_vector_type(4)));

constexpr int T = 16384, D = 2048, SEQ = 2048, NBATCH = 8, NP = 12544;
constexpr int C_QA = 0, C_KA = 1024, C_VA = 2048, C_QI = 3072, C_KI = 4096, C_WI = 4160, C_QB = 4352, C_FB = 5376, C_IB = 6400, C_GB = 7424, C_GA = 8448, C_GG = 10496;
constexpr int NADA = 12288;
constexpr float NORM_EPS = 1e-6f;
constexpr int NTHREADS = 512, NWAVES = 8;
constexpr int LDS_BYTES = 147456;
constexpr size_t MiB = 1u << 20;
constexpr size_t WS_CTL = 0, WS_MOD = 1 * MiB, WS_WUA = 2 * MiB, WS_WUB = 6 * MiB, WS_WOUT = 10 * MiB, WS_WQ = 18 * MiB, WS_KEYS = 26 * MiB, WS_MASK = 27 * MiB;
constexpr size_t WS_MIXED = 32 * MiB;
constexpr size_t WS_VT = 32 * MiB, WS_ORAW = 64 * MiB;
constexpr size_t WS_P = 96 * MiB;
constexpr size_t WS_H2 = 96 * MiB, WS_QP = 160 * MiB, WS_U8 = 224 * MiB, WS_V8 = 256 * MiB, WS_ISU = 26 * MiB + 512 * 1024, WS_ISV = 26 * MiB + 768 * 1024, WS_Y = 288 * MiB, WS_EIDX = 352 * MiB, WS_EGATE = 360 * MiB;
constexpr size_t WS_X1 = 368 * MiB;
constexpr size_t WS_END = 496 * MiB;
constexpr int LDP = 2048 + 64;
constexpr size_t OUT_H = 0, OUT_WIN = 68 * MiB;
constexpr size_t OUT_AO = 0, OUT_REC = 32 * MiB;

struct Params { const float* in[17]; float* out; unsigned char* ws; int ph_lo, ph_hi; };

__device__ __forceinline__ unsigned f2bf(float f) { unsigned u = __float_as_uint(f); return (u + 0x7fffu + ((u >> 16) & 1u)) >> 16; }
__device__ __forceinline__ float bf2f(unsigned b) { return __uint_as_float(b << 16); }
__device__ __forceinline__ float bflo(unsigned w) { return __uint_as_float(w << 16); }
__device__ __forceinline__ float bfhi(unsigned w) { return __uint_as_float(w & 0xffff0000u); }
__device__ __forceinline__ unsigned pk2(float lo, float hi) { unsigned r; asm volatile("v_cvt_pk_bf16_f32 %0, %1, %2" : "=v"(r) : "v"(lo), "v"(hi)); return r; }
__device__ __forceinline__ float wave_sum(float v) {
#pragma unroll
    for (int o = 1; o < 64; o <<= 1) v += __shfl_xor(v, o);
    return v;
}
__device__ __forceinline__ float sigmoidf_(float v) { return 1.f / (1.f + __expf(-v)); }
__device__ __forceinline__ float siluf_(float v) { return v / (1.f + __expf(-v)); }
#define LDS_WAIT() asm volatile("s_waitcnt lgkmcnt(0)" ::: "memory")

namespace pg8 {
constexpr int BM = 256, BK = 64, HALF = 128, HTB = HALF * BK * 2, STAGE_BYTES = 8 * HTB, NXCD = 8, WGM = 8;
__host__ __device__ __forceinline__ int lds_byte(int r, int c) { const int st = (r >> 4) * 2 + (c >> 5), rr = r & 15, cc = c & 31, ob = rr * 64 + cc * 2; return st * 1024 + (ob ^ (((ob >> 9) & 1) << 5)); }
__host__ __device__ __forceinline__ void stage_rc(int b, int& R, int& C) { const int st = b / 1024, sb = b % 1024, swz = sb ^ (((sb >> 9) & 1) << 5); R = (st >> 1) * 16 + swz / 64; C = (st & 1) * 32 + (swz % 64) / 2; }
__host__ __device__ __forceinline__ int perm32(int rho) { const int n = rho >> 4, i = rho & 15; return 8 * (i >> 2) + 4 * n + (i & 3); }

struct Unit { int pm, pn, z; };
struct Gemm { const bf16_t* A; const bf16_t* Bt; const bf16_t* A2; const bf16_t* Bt2; int lda, ldb, M, N, K; };

template <int NZ> struct StaticOrder {
    int nM, nN, nwg, G, c;
    __device__ void init(int M, int N, int G_, int c_) { nM = M / BM; nN = N / BM; nwg = nM * nN; G = G_; c = c_; }
    __device__ bool next(int i, Unit& u) const {
        const long L = (long)(i / NZ) * G + c; if (L >= nwg) return false;
        int wgid = (int)L; { const int q = nwg / NXCD, r = nwg % NXCD, xcd = wgid % NXCD, off = wgid / NXCD; wgid = (xcd < r ? xcd * (q + 1) : r * (q + 1) + (xcd - r) * q) + off; }
        const int nig = WGM * nN, gid = wgid / nig, fm = gid * WGM, gsz = (nM - fm) < WGM ? (nM - fm) : WGM;
        u.pm = fm + ((wgid % nig) % gsz); u.pn = (wgid % nig) / gsz; u.z = i % NZ; return true;
    }
};

template <class Epi, class Sched>
__device__ __forceinline__ void gemm_phase(LAS unsigned char* lds, const Gemm g, const Sched& S, const Epi& E) {
    const int tid = threadIdx.x, wid = __builtin_amdgcn_readfirstlane(tid >> 6), lane = tid & 63, wr = wid >> 2, wc = wid & 3, fr = lane & 15, fq = lane >> 4;
    const int K = g.K, nt = K / BK;
    unsigned voffA[2], voffB[2];
#pragma unroll
    for (int i = 0; i < 2; ++i) { int R, C; stage_rc(tid * 16 + i * 8192, R, C); const int Rb = Epi::PERM ? ((R & ~31) + perm32(R & 31)) : R;
        voffA[i] = (unsigned)(R * g.lda + C) * 2u; voffB[i] = (unsigned)(Rb * g.ldb + C) * 2u; }
    const size_t kstep = (size_t)(BK * 2);
    const size_t hstepA = (size_t)HALF * g.lda * 2, hstepB = (size_t)HALF * g.ldb * 2;
    const size_t tstepA = 2 * hstepA, tstepB = 2 * hstepB;
    const unsigned ldsw = (unsigned)wid * 1024u;
    const int aoff = lds_byte(wr * 64 + fr, fq * 8), boff = lds_byte(wc * 32 + fr, fq * 8);
#define PG8_SA(b, h) (((b) * 2 + (h)) * HTB)
#define PG8_SB(b, h) ((4 + (b) * 2 + (h)) * HTB)
#define PG8_STAGE(bufoff, gbase, voff) do { _Pragma("unroll") for (int _i = 0; _i < 2; ++_i) \
        __builtin_amdgcn_global_load_lds((const unsigned*)((const char*)(gbase) + (voff)[_i]), (LAS unsigned*)(lds + (bufoff) + ldsw + _i * 8192), 16, 0, 0); } while (0)
#define PG8_LDA(dst, b, h) do { _Pragma("unroll") for (int m = 0; m < 4; ++m) _Pragma("unroll") for (int k = 0; k < 2; ++k) dst[m][k] = *(const LAS bf16x8*)(lds + PG8_SA(b, h) + aoff + m * 2048 + k * 1024); } while (0)
#define PG8_LDB(dst, b, h) do { _Pragma("unroll") for (int n = 0; n < 2; ++n) _Pragma("unroll") for (int k = 0; k < 2; ++k) dst[n][k] = *(const LAS bf16x8*)(lds + PG8_SB(b, h) + boff + n * 2048 + k * 1024); } while (0)
#define PG8_MMA(ai, bj, At, Bt) do { __builtin_amdgcn_s_setprio(1); _Pragma("unroll") for (int m = 0; m < 4; ++m) _Pragma("unroll") for (int n = 0; n < 2; ++n) _Pragma("unroll") for (int k = 0; k < 2; ++k) \
        acc[ai][bj][m][n] = __builtin_amdgcn_mfma_f32_16x16x32_bf16(Bt[n][k], At[m][k], acc[ai][bj][m][n], 0, 0, 0); __builtin_amdgcn_s_setprio(0); } while (0)
#define PG8_WAIT_V(n) asm volatile("s_waitcnt vmcnt(" #n ")" ::: "memory")
#define PG8_WAIT_L(n) asm volatile("s_waitcnt lgkmcnt(" #n ")" ::: "memory")
#define PG8_BAR __builtin_amdgcn_s_barrier()
#define PG8_SCHED __builtin_amdgcn_sched_barrier(0)
#define PG8_ABASE(u) ((const char*)((u).z ? g.A2 : g.A) + (size_t)(u).pm * tstepA)
#define PG8_BBASE(u) ((const char*)((u).z ? g.Bt2 : g.Bt) + (size_t)(u).pn * tstepB)
    Unit cur, nxt; int ui = 0;
    if (!S.next(0, cur)) return;
    f32x4 acc[2][2][4][2];
#pragma unroll
    for (int a = 0; a < 2; ++a)
#pragma unroll
        for (int b = 0; b < 2; ++b)
#pragma unroll
            for (int m = 0; m < 4; ++m)
#pragma unroll
                for (int n = 0; n < 2; ++n) acc[a][b][m][n] = (f32x4){0.f, 0.f, 0.f, 0.f};
    bf16x8 At[4][2], B0[2][2], B1[2][2];
    const char* cA = PG8_ABASE(cur); const char* cB = PG8_BBASE(cur);
    PG8_STAGE(PG8_SB(0, 0), cB, voffB); PG8_STAGE(PG8_SA(0, 0), cA, voffA); PG8_STAGE(PG8_SB(0, 1), cB + hstepB, voffB); PG8_STAGE(PG8_SA(0, 1), cA + hstepA, voffA);
    if (wr == 1) PG8_BAR;
    PG8_WAIT_V(4); PG8_BAR;
    PG8_STAGE(PG8_SB(1, 0), cB + kstep, voffB); PG8_STAGE(PG8_SA(1, 0), cA + kstep, voffA); PG8_STAGE(PG8_SB(1, 1), cB + hstepB + kstep, voffB);
    PG8_WAIT_V(6); PG8_BAR;
    for (;;) {
        const bool has_next = S.next(ui + 1, nxt);
        const char* nA = has_next ? PG8_ABASE(nxt) : cA; const char* nB = has_next ? PG8_BBASE(nxt) : cB;
        for (int t = 0; t < nt; t += 2) {
            const bool last = (t == nt - 2);
            const char* a1 = cA + (size_t)(t + 1) * kstep;
            const char* a2 = last ? nA : cA + (size_t)(t + 2) * kstep; const char* b2 = last ? nB : cB + (size_t)(t + 2) * kstep;
            const char* a3 = a2 + kstep; const char* b3 = b2 + kstep;
            PG8_LDB(B0, 0, 0); PG8_SCHED; PG8_LDA(At, 0, 0); PG8_STAGE(PG8_SA(1, 1), a1 + hstepA, voffA);
            PG8_WAIT_L(8); PG8_BAR; PG8_WAIT_L(0); PG8_MMA(0, 0, At, B0); PG8_BAR; PG8_SCHED;
            PG8_LDB(B1, 0, 1); PG8_STAGE(PG8_SB(0, 0), b2, voffB);
            PG8_BAR; PG8_WAIT_L(0); PG8_MMA(0, 1, At, B1); PG8_BAR;
            PG8_LDA(At, 0, 1); PG8_STAGE(PG8_SA(0, 0), a2, voffA);
            PG8_BAR; PG8_WAIT_L(0); PG8_MMA(1, 0, At, B0); PG8_BAR; PG8_SCHED;
            PG8_STAGE(PG8_SB(0, 1), b2 + hstepB, voffB);
            PG8_WAIT_V(6); PG8_BAR; PG8_MMA(1, 1, At, B1); PG8_BAR;
            PG8_LDB(B0, 1, 0); PG8_SCHED; PG8_LDA(At, 1, 0); PG8_STAGE(PG8_SA(0, 1), a2 + hstepA, voffA);
            PG8_WAIT_L(8); PG8_BAR; PG8_WAIT_L(0); PG8_MMA(0, 0, At, B0); PG8_BAR; PG8_SCHED;
            PG8_LDB(B1, 1, 1); PG8_STAGE(PG8_SB(1, 0), b3, voffB);
            PG8_BAR; PG8_WAIT_L(0); PG8_MMA(0, 1, At, B1); PG8_BAR;
            PG8_LDA(At, 1, 1); PG8_STAGE(PG8_SA(1, 0), a3, voffA);
            PG8_BAR; PG8_WAIT_L(0); PG8_MMA(1, 0, At, B0); PG8_BAR; PG8_SCHED;
            PG8_STAGE(PG8_SB(1, 1), b3 + hstepB, voffB);
            PG8_WAIT_V(6); PG8_BAR; PG8_MMA(1, 1, At, B1); PG8_BAR;
        }
        E(acc, cur, wr, wc, fr, fq);
        if (!has_next) break;
#pragma unroll
        for (int a = 0; a < 2; ++a)
#pragma unroll
            for (int b = 0; b < 2; ++b)
#pragma unroll
                for (int m = 0; m < 4; ++m)
#pragma unroll
                    for (int n = 0; n < 2; ++n) acc[a][b][m][n] = (f32x4){0.f, 0.f, 0.f, 0.f};
        cur = nxt; cA = nA; cB = nB; ++ui;
    }
    PG8_WAIT_V(0);
    if (wr == 0) PG8_BAR;
    PG8_BAR;
#undef PG8_SA
#undef PG8_SB
#undef PG8_STAGE
#undef PG8_LDA
#undef PG8_LDB
#undef PG8_MMA
#undef PG8_WAIT_V
#undef PG8_WAIT_L
#undef PG8_BAR
#undef PG8_SCHED
#undef PG8_ABASE
#undef PG8_BBASE
}

struct EpiBf16 {
    static constexpr bool PERM = true;
    bf16_t* O; int ldc; int sig_from;
    __device__ __forceinline__ void operator()(const f32x4 (&acc)[2][2][4][2], const Unit& u, int wr, int wc, int fr, int fq) const {
        const int row0 = u.pm * BM + wr * 64 + fr, col0 = u.pn * BM + wc * 32 + 8 * fq; const bool sig = u.pn >= sig_from;
#pragma unroll
        for (int ai = 0; ai < 2; ++ai)
#pragma unroll
            for (int m = 0; m < 4; ++m) { bf16_t* rowp = O + (size_t)(row0 + ai * HALF + m * 16) * ldc + col0;
#pragma unroll
                for (int bj = 0; bj < 2; ++bj) { f32x4 v0 = acc[ai][bj][m][0], v1 = acc[ai][bj][m][1];
                    if (sig) {
#pragma unroll
                        for (int j = 0; j < 4; ++j) { v0[j] = sigmoidf_(v0[j]); v1[j] = sigmoidf_(v1[j]); } }
                    u32x4 w; w.x = pk2(v0[0], v0[1]); w.y = pk2(v0[2], v0[3]); w.z = pk2(v1[0], v1[1]); w.w = pk2(v1[2], v1[3]);
                    *(u32x4*)(rowp + bj * HALF) = w; } }
    }
};
struct EpiMix {
    static constexpr bool PERM = true;
    bf16_t* O; const bf16_t* P;
    __device__ __forceinline__ void operator()(const f32x4 (&acc)[2][2][4][2], const Unit& u, int wr, int wc, int fr, int fq) const {
        const int row0 = u.pm * BM + wr * 64 + fr, col0 = u.pn * BM + wc * 32 + 8 * fq; const int gcol = (u.z ? C_GG : C_GA);
#pragma unroll
        for (int ai = 0; ai < 2; ++ai) {
            u32x4 gw[4][2], pw[4][2];
#pragma unroll
            for (int m = 0; m < 4; ++m)
#pragma unroll
                for (int bj = 0; bj < 2; ++bj) { const size_t r = (size_t)(row0 + ai * HALF + m * 16);
                    gw[m][bj] = *(const u32x4*)(P + r * NP + gcol + col0 + bj * HALF);
                    if (u.z) pw[m][bj] = *(const u32x4*)(O + r * D + col0 + bj * HALF); else pw[m][bj] = (u32x4){0u, 0u, 0u, 0u}; }
            asm volatile("" ::: "memory");
#pragma unroll
            for (int m = 0; m < 4; ++m)
#pragma unroll
                for (int bj = 0; bj < 2; ++bj) { const size_t r = (size_t)(row0 + ai * HALF + m * 16); const f32x4 v0 = acc[ai][bj][m][0], v1 = acc[ai][bj][m][1]; const u32x4 g = gw[m][bj], q = pw[m][bj];
                    u32x4 w; w.x = pk2(fmaf(v0[0], bflo(g.x), bflo(q.x)), fmaf(v0[1], bfhi(g.x), bfhi(q.x))); w.y = pk2(fmaf(v0[2], bflo(g.y), bflo(q.y)), fmaf(v0[3], bfhi(g.y), bfhi(q.y)));
                    w.z = pk2(fmaf(v1[0], bflo(g.z), bflo(q.z)), fmaf(v1[1], bfhi(g.z), bfhi(q.z))); w.w = pk2(fmaf(v1[2], bflo(g.w), bflo(q.w)), fmaf(v1[3], bfhi(g.w), bfhi(q.w)));
                    *(u32x4*)(O + r * D + col0 + bj * HALF) = w; }
            asm volatile("" ::: "memory");
        }
    }
};
struct EpiX1 {
    static constexpr bool PERM = false;
    const float* x; float* out; const float* gate;
    __device__ __forceinline__ void operator()(const f32x4 (&acc)[2][2][4][2], const Unit& u, int wr, int wc, int fr, int fq) const {
        const int row0 = u.pm * BM + wr * 64 + fr, col0 = u.pn * BM + wc * 32 + 4 * fq; const int b = (u.pm * BM) >> 11;
        f32x4 gv[2][2];
#pragma unroll
        for (int bj = 0; bj < 2; ++bj)
#pragma unroll
            for (int n = 0; n < 2; ++n) gv[bj][n] = *(const f32x4*)(gate + (size_t)b * NADA + col0 + bj * HALF + n * 16);
#pragma unroll
        for (int ai = 0; ai < 2; ++ai) {
            f32x4 xv[4][2][2];
#pragma unroll
            for (int m = 0; m < 4; ++m)
#pragma unroll
                for (int bj = 0; bj < 2; ++bj)
#pragma unroll
                    for (int n = 0; n < 2; ++n) xv[m][bj][n] = *(const f32x4*)(x + (size_t)(row0 + ai * HALF + m * 16) * D + col0 + bj * HALF + n * 16);
            asm volatile("" ::: "memory");
#pragma unroll
            for (int m = 0; m < 4; ++m)
#pragma unroll
                for (int bj = 0; bj < 2; ++bj)
#pragma unroll
                    for (int n = 0; n < 2; ++n) *(f32x4*)(out + (size_t)(row0 + ai * HALF + m * 16) * D + col0 + bj * HALF + n * 16) = xv[m][bj][n] + gv[bj][n] * acc[ai][bj][m][n];
            asm volatile("" ::: "memory");
        }
    }
};
}

__device__ __forceinline__ void phase_mod(const Params& p, unsigned char* lds) {
    float* sc = (float*)lds;
    float* red = (float*)(lds + 65536);
    const int tid = threadIdx.x, wave = tid >> 6, lane = tid & 63;
    const float* c = p.in[1]; const float* wada = p.in[2]; const float* bada = p.in[3];
    float* mod = (float*)(p.ws + WS_MOD);
    if ((int)blockIdx.x >= 192) return;
    for (int i = tid; i < NBATCH * D; i += NTHREADS) { const int b = i >> 11, k = i & 2047; sc[k * 8 + b] = siluf_(c[i]); }
    __syncthreads();
    const int cgp = tid & 15, rg = tid >> 4;
    for (int item = blockIdx.x; item < 192; item += gridDim.x) {
        const float* w = wada + item * 64 + cgp * 4;
        float acc[8][4];
#pragma unroll
        for (int b = 0; b < 8; ++b)
#pragma unroll
            for (int j = 0; j < 4; ++j) acc[b][j] = 0.f;
#pragma unroll 1
        for (int i0 = 0; i0 < 64; i0 += 8) {
            f32x4 wvv[8];
#pragma unroll
            for (int u = 0; u < 8; ++u) wvv[u] = __builtin_nontemporal_load((const f32x4*)(w + (size_t)(rg + 32 * (i0 + u)) * NADA));
#pragma unroll
            for (int u = 0; u < 8; ++u) { const int k = rg + 32 * (i0 + u); const f32x4 wv = wvv[u];
                const f32x4 s0 = *(const f32x4*)(sc + k * 8), s1 = *(const f32x4*)(sc + k * 8 + 4);
#pragma unroll
                for (int j = 0; j < 4; ++j) { acc[0][j] += s0[0] * wv[j]; acc[1][j] += s0[1] * wv[j]; acc[2][j] += s0[2] * wv[j]; acc[3][j] += s0[3] * wv[j];
                    acc[4][j] += s1[0] * wv[j]; acc[5][j] += s1[1] * wv[j]; acc[6][j] += s1[2] * wv[j]; acc[7][j] += s1[3] * wv[j]; } } }
#pragma unroll
        for (int b = 0; b < 8; ++b)
#pragma unroll
            for (int j = 0; j < 4; ++j) { float v = acc[b][j]; v += __shfl_xor(v, 16); v += __shfl_xor(v, 32); acc[b][j] = v; }
        if (lane < 16) {
#pragma unroll
            for (int b = 0; b < 8; ++b)
#pragma unroll
                for (int j = 0; j < 4; ++j) red[(wave * 16 + cgp) * 32 + b * 4 + j] = acc[b][j]; }
        __syncthreads();
        { const int cgo = tid >> 5, b = (tid >> 2) & 7, j = tid & 3; float s = 0.f;
#pragma unroll
          for (int w8 = 0; w8 < 8; ++w8) s += red[(w8 * 16 + cgo) * 32 + (tid & 31)];
          const int col = item * 64 + cgo * 4 + j; mod[b * NADA + col] = s + bada[col]; }
        __syncthreads();
    }
}
__device__ __forceinline__ void transpose_item(const float* W, int K, int N, bf16_t* WT, int nblk, int item, int lane, float* scr, int mode, int pitch) {
    const int kb = item / nblk, nb = item % nblk, k0 = 64 * kb, n0 = 32 * nb;
    const int nd = n0 + (lane & 31); int ns = nd; bool valid = true;
    if (mode == 1) { if (nd >= C_QB) ns = nd - 176; else if (nd >= 4176) valid = false; }
    if (mode == 0 || n0 < 4160 || n0 >= C_QB) {
        const int ns0 = (mode == 1 && n0 >= C_QB) ? n0 - 176 : n0;
        f32x4 v[8];
#pragma unroll
        for (int i = 0; i < 8; ++i) v[i] = *(const f32x4*)(W + (size_t)(k0 + 8 * i + (lane >> 3)) * N + ns0 + 4 * (lane & 7));
#pragma unroll
        for (int i = 0; i < 8; ++i) { float* d = scr + (8 * i + (lane >> 3)) * 33 + 4 * (lane & 7); d[0] = v[i][0]; d[1] = v[i][1]; d[2] = v[i][2]; d[3] = v[i][3]; }
    } else {
#pragma unroll 8
        for (int i = 0; i < 32; ++i) { const int kk = 2 * i + (lane >> 5); scr[kk * 33 + (lane & 31)] = valid ? W[(size_t)(k0 + kk) * N + ns] : 0.f; }
    }
    LDS_WAIT();
    const int c = lane & 7;
#pragma unroll
    for (int j = 0; j < 4; ++j) { const int n = (lane >> 3) + 8 * j; const float* s = scr + (8 * c) * 33 + n;
        u32x4 o; o.x = pk2(s[0 * 33], s[1 * 33]); o.y = pk2(s[2 * 33], s[3 * 33]); o.z = pk2(s[4 * 33], s[5 * 33]); o.w = pk2(s[6 * 33], s[7 * 33]);
        *(u32x4*)(WT + (size_t)(n0 + n) * pitch + k0 + 8 * c) = o; }
    LDS_WAIT();
}
__device__ __forceinline__ void phase_weights(const Params& p, unsigned char* lds) {
    const int tid = threadIdx.x, wave = tid >> 6, lane = tid & 63;
    float* scr = (float*)(lds + wave * 16384);
    const int vb = ((int)blockIdx.x + (int)gridDim.x - 192 % (int)gridDim.x) % (int)gridDim.x;
    const int gw = vb * NWAVES + wave, NGW = gridDim.x * NWAVES;
    constexpr int I_IN = 32 * (NP / 32), I_UA = 16 * 64, I_UB = 16 * 64, I_O = 32 * 64, I_Q = 32 * 64;
    constexpr int NITEMS = I_IN + I_UA + I_UB + I_O + I_Q;
    bf16_t* win_t = (bf16_t*)((unsigned char*)p.out + OUT_WIN);
    for (int it = gw; it < NITEMS; it += NGW) {
        int r = it;
        if (r < I_IN) { transpose_item(p.in[6], 2048, 12368, win_t, NP / 32, r, lane, scr, 1, LDP); continue; } r -= I_IN;
        if (r < I_UA) { transpose_item(p.in[9], 1024, 2048, (bf16_t*)(p.ws + WS_WUA), 64, r, lane, scr, 0, 1024); continue; } r -= I_UA;
        if (r < I_UB) { transpose_item(p.in[10], 1024, 2048, (bf16_t*)(p.ws + WS_WUB), 64, r, lane, scr, 0, 1024); continue; } r -= I_UB;
        if (r < I_O) { transpose_item(p.in[11], 2048, 2048, (bf16_t*)(p.ws + WS_WOUT), 64, r, lane, scr, 0, 2048); continue; } r -= I_O;
        transpose_item(p.in[12], 2048, 2048, (bf16_t*)(p.ws + WS_WQ), 64, r, lane, scr, 0, 2048);
    }
    { const float* ks = p.in[13]; bf16_t* kd = (bf16_t*)(p.ws + WS_KEYS);
      for (int i = (blockIdx.x * NTHREADS + tid) * 4; i < 8 * 2 * 128 * 128; i += gridDim.x * NTHREADS * 4) { const f32x4 v = *(const f32x4*)(ks + i); u32x2 o; o.x = pk2(v[0], v[1]); o.y = pk2(v[2], v[3]); *(u32x2*)(kd + i) = o; } }
}

__device__ __forceinline__ void phase_norm_rows(const float* src, const float* gain, const float* shift, const float* scale, bf16_t* dst, int pitch) {
    const int tid = threadIdx.x, wave = tid >> 6, lane = tid & 63;
    const int gw = blockIdx.x * NWAVES + wave, NGW = gridDim.x * NWAVES;
    for (int row = gw; row < T; row += NGW) {
        const int b = row >> 11; const f32x4* xr = (const f32x4*)(src + (size_t)row * D) + lane;
        f32x4 v[8]; float ss = 0.f;
#pragma unroll
        for (int j = 0; j < 8; ++j) { v[j] = xr[64 * j]; ss += (v[j][0] * v[j][0] + v[j][1] * v[j][1]) + (v[j][2] * v[j][2] + v[j][3] * v[j][3]); }
        const float rstd = rsqrtf(wave_sum(ss) * (1.f / D) + NORM_EPS);
        u32x2* o8 = (u32x2*)(dst + (size_t)row * pitch) + lane;
#pragma unroll
        for (int j = 0; j < 8; ++j) { const int col = 4 * (lane + 64 * j);
            const f32x4 g = *(const f32x4*)(gain + col), sh = *(const f32x4*)(shift + (size_t)b * NADA + col), sc = *(const f32x4*)(scale + (size_t)b * NADA + col);
            f32x4 h;
#pragma unroll
            for (int e = 0; e < 4; ++e) h[e] = v[j][e] * rstd * g[e] * (1.f + sc[e]) + sh[e];
            u32x2 w; w.x = pk2(h[0], h[1]); w.y = pk2(h[2], h[3]); o8[64 * j] = w; }
    }
}

__device__ __forceinline__ void phase_vt(const Params& p, unsigned char* lds, int vb, int vG) {
    const int tid = threadIdx.x, wave = tid >> 6, lane = tid & 63;
    bf16_t* tile = (bf16_t*)(lds + wave * 16384);
    const bf16_t* P = (const bf16_t*)(p.ws + WS_P); bf16_t* VT = (bf16_t*)(p.ws + WS_VT);
    const int gw = vb * NWAVES + wave, NGW = vG * NWAVES;
    for (int it = gw; it < 8 * 8 * 32 * 2; it += NGW) {
        const int dh = it & 1, kt = (it >> 1) & 31, h = (it >> 6) & 7, b = it >> 9;
        const int k0 = kt * 64, d0 = dh * 64;
#pragma unroll
        for (int i = 0; i < 8; ++i) { const int key = i * 8 + (lane >> 3), dc = lane & 7;
            const u32x4 v = *(const u32x4*)(P + (size_t)(b * SEQ + k0 + key) * NP + C_VA + h * 128 + d0 + dc * 8);
            bf16_t* t = tile + (dc * 8) * 72 + key;
            t[0 * 72] = (bf16_t)(v.x & 0xffff); t[1 * 72] = (bf16_t)(v.x >> 16); t[2 * 72] = (bf16_t)(v.y & 0xffff); t[3 * 72] = (bf16_t)(v.y >> 16);
            t[4 * 72] = (bf16_t)(v.z & 0xffff); t[5 * 72] = (bf16_t)(v.z >> 16); t[6 * 72] = (bf16_t)(v.w & 0xffff); t[7 * 72] = (bf16_t)(v.w >> 16); }
        LDS_WAIT();
#pragma unroll
        for (int i = 0; i < 8; ++i) { const int d = i * 8 + (lane >> 3), kc = lane & 7;
            const u32x4 v = *(const u32x4*)(tile + d * 72 + kc * 8);
            *(u32x4*)(VT + ((size_t)((b * 8 + h) * 128 + d0 + d)) * SEQ + k0 + kc * 8) = v; }
        LDS_WAIT();
    }
}

__device__ __forceinline__ unsigned ord_key(float s) { const unsigned u = __float_as_uint(s); return (u & 0x80000000u) ? ~u : (u | 0x80000000u); }
__device__ __forceinline__ int half_sum(int v) {
    v += __builtin_amdgcn_update_dpp(0, v, 0xB1, 0xF, 0xF, true);
    v += __builtin_amdgcn_update_dpp(0, v, 0x4E, 0xF, 0xF, true);
    v += __builtin_amdgcn_update_dpp(0, v, 0x141, 0xF, 0xF, true);
    v += __builtin_amdgcn_update_dpp(0, v, 0x140, 0xF, 0xF, true);
    v += __shfl_xor(v, 16);
    return v;
}
constexpr int IX_RS = 72, IX_STAGE = 32 * IX_RS * 2;
__device__ __forceinline__ void indexer_item(const Params& p, unsigned char* lds, int b, int c, int grp) {
    const int tid = threadIdx.x, w = __builtin_amdgcn_readfirstlane(tid >> 6), lane = tid & 63, r = lane & 31, hh = lane >> 5;
    const bf16_t* P = (const bf16_t*)(p.ws + WS_P); unsigned* MASK = (unsigned*)(p.ws + WS_MASK);
    const int pair = grp * 8 + w, q0 = b * SEQ + c * 64 + 2 * pair;
    bf16x8 af[4];
    { const int query = q0 + ((r >> 2) & 1), head = (r & 3) + 4 * (r >> 3);
      const bf16_t* qp = P + (size_t)query * NP + C_QI + head * 64 + 8 * hh;
#pragma unroll
      for (int ks = 0; ks < 4; ++ks) af[ks] = *(const bf16x8*)(qp + ks * 16); }
    float wv[16];
    { const u32x4 w0 = *(const u32x4*)(P + (size_t)(q0 + hh) * NP + C_WI), w1 = *(const u32x4*)(P + (size_t)(q0 + hh) * NP + C_WI + 8);
      wv[0] = bflo(w0.x); wv[1] = bfhi(w0.x); wv[2] = bflo(w0.y); wv[3] = bfhi(w0.y); wv[4] = bflo(w0.z); wv[5] = bfhi(w0.z); wv[6] = bflo(w0.w); wv[7] = bfhi(w0.w);
      wv[8] = bflo(w1.x); wv[9] = bfhi(w1.x); wv[10] = bflo(w1.y); wv[11] = bfhi(w1.y); wv[12] = bflo(w1.z); wv[13] = bfhi(w1.z); wv[14] = bflo(w1.w); wv[15] = bfhi(w1.w); }
    const int nkt = 2 * (c + 1);
    const bool ldr = tid < 256;
    const bf16_t* kg = P + (size_t)(b * SEQ + ((tid >> 3) & 31)) * NP + C_KI + (tid & 7) * 8;
    const int kls = ((tid >> 3) & 31) * IX_RS * 2 + (tid & 7) * 16;
    u32x4 kr = {0u, 0u, 0u, 0u};
    __syncthreads();
    if (ldr) { *(u32x4*)(lds + kls) = *(const u32x4*)kg; *(u32x4*)(lds + IX_STAGE + kls) = *(const u32x4*)(kg + (size_t)32 * NP); }
    if (ldr && 2 < nkt) kr = *(const u32x4*)(kg + (size_t)64 * NP);
    __syncthreads();
    unsigned kv[64];
#pragma unroll
    for (int kt = 0; kt < 64; ++kt) {
        kv[kt] = 0u;
        if (kt < nkt) {
            if (ldr && kt + 2 < nkt) *(u32x4*)(lds + ((kt + 2) % 3) * IX_STAGE + kls) = kr;
            if (ldr && kt + 3 < nkt) kr = *(const u32x4*)(kg + (size_t)((kt + 3) * 32) * NP);
            const bf16_t* Ks = (const bf16_t*)(lds + (kt % 3) * IX_STAGE);
            f32x16 acc;
#pragma unroll
            for (int i = 0; i < 16; ++i) acc[i] = 0.f;
#pragma unroll
            for (int ks = 0; ks < 4; ++ks) { const bf16x8 bfr = *(const bf16x8*)(Ks + r * IX_RS + ks * 16 + 8 * hh); acc = __builtin_amdgcn_mfma_f32_32x32x16_bf16(af[ks], bfr, acc, 0, 0, 0); }
            float sc = 0.f;
#pragma unroll
            for (int i = 0; i < 16; ++i) sc += wv[i] * fmaxf(acc[i], 0.f);
            kv[kt] = ord_key(sc);
            __syncthreads();
        }
    }
    unsigned thr = 0u;
    if (nkt > 8) {
        int cur = 1 << 20;
        for (int bit = 31; bit >= 0; --bit) {
            const unsigned cand = thr | (1u << bit); int cnt = 0;
#pragma unroll
            for (int kt = 0; kt < 32; ++kt) cnt += (kv[kt] >= cand) ? 1 : 0;
            if (nkt > 32) {
#pragma unroll
                for (int kt = 32; kt < 64; ++kt) cnt += (kv[kt] >= cand) ? 1 : 0; }
            cnt = half_sum(cnt);
            if (cnt >= 256) { thr = cand; cur = cnt; }
            if (__builtin_amdgcn_ballot_w64(cur != 256) == 0ull) break;
        }
    }
    int cge = 0;
#pragma unroll
    for (int kt = 0; kt < 64; ++kt) cge += (kv[kt] >= thr && kv[kt] != 0u) ? 1 : 0;
    cge = half_sum(cge);
    const bool ties = (thr != 0u) && (cge > 256);
    unsigned m0 = 0u, m1 = 0u;
    if (__builtin_amdgcn_ballot_w64(ties) == 0ull) {
#pragma unroll
        for (int kt = 0; kt < 64; ++kt) { const unsigned long long bm = __builtin_amdgcn_ballot_w64(kv[kt] >= thr && kv[kt] != 0u);
            if (lane == kt) { m0 = (unsigned)bm; m1 = (unsigned)(bm >> 32); } }
    } else {
        int cgt = 0;
#pragma unroll
        for (int kt = 0; kt < 64; ++kt) cgt += (kv[kt] > thr) ? 1 : 0;
        cgt = half_sum(cgt);
        const int need = ties ? (256 - cgt) : (1 << 30); int run = 0;
#pragma unroll
        for (int kt = 0; kt < 64; ++kt) { const bool tie = ties && (kv[kt] == thr); const unsigned long long tb = __builtin_amdgcn_ballot_w64(tie);
            const unsigned th = hh ? (unsigned)(tb >> 32) : (unsigned)tb; const int rank = run + __builtin_popcount(th & ((1u << r) - 1u));
            const bool sel = ties ? ((kv[kt] > thr) || (tie && rank < need)) : (kv[kt] >= thr && kv[kt] != 0u);
            run += __builtin_popcount(th);
            const unsigned long long bm = __builtin_amdgcn_ballot_w64(sel);
            if (lane == kt) { m0 = (unsigned)bm; m1 = (unsigned)(bm >> 32); } }
    }
    { const int qpos = c * 64 + 2 * pair; unsigned* mt = MASK + ((size_t)(b * 64 + lane)) * SEQ + qpos; mt[0] = m0; mt[1] = m1; }
}
__device__ __forceinline__ void phase_indexer(const Params& p, unsigned char* lds, int vb, int vG) {
    const int G = vG;
    for (int rd = 0;; ++rd) {
        const int base = rd * G; if (base >= 1024) break;
        const int pos = (rd & 1) ? (G - 1 - vb) : vb; const int i = base + pos; if (i >= 1024) continue;
        indexer_item(p, lds, (i >> 2) & 7, 31 - (i >> 5), i & 3);
    }
}

#ifndef HG_REP_A
#define HG_REP_A 0
#endif
#ifndef HG_REP_B
#define HG_REP_B 0
#endif
constexpr int HG_RS = 136, HG_TS = 72, HG_SS = 136;
constexpr int HG_QT = 0, HG_QH = 17408, HG_KT = 34816, HG_KHT = 52224, HG_VT = 70656, HG_ST = 89088, HG_DEC = 123904, HG_SSQ = 124416, HG_OT = 125440;
__device__ __forceinline__ void hgrn_item(const Params& p, unsigned char* lds, int item) {
    const int tid = threadIdx.x, w = __builtin_amdgcn_readfirstlane(tid >> 6), lane = tid & 63, r = lane & 31, hh = lane >> 5;
    const int b = item >> 3, h = item & 7;
    const bf16_t* P = (const bf16_t*)(p.ws + WS_P); bf16_t* REC = (bf16_t*)((unsigned char*)p.out + OUT_REC);
    bf16_t* QT = (bf16_t*)(lds + HG_QT); bf16_t* QH = (bf16_t*)(lds + HG_QH); bf16_t* KT = (bf16_t*)(lds + HG_KT); bf16_t* KHT = (bf16_t*)(lds + HG_KHT); bf16_t* VT = (bf16_t*)(lds + HG_VT);
    bf16_t* ST = (bf16_t*)(lds + HG_ST); float* DEC = (float*)(lds + HG_DEC); float* SSQ = (float*)(lds + HG_SSQ); bf16_t* OT = (bf16_t*)(lds + HG_OT);
    const int seg = lane >> 4, dl = lane & 15, d = 16 * w + dl;
    const float lb = sigmoidf_(p.in[7][h * 128 + d] - p.in[7][1024 + h * 128 + d]);
    const int tb = w & 1, eb = w >> 1, sdb = w & 3, seb0 = 2 * (w >> 2);
    const int ot_t = tid >> 3, ot_c = tid & 7;
    float gn[16];
#pragma unroll
    for (int j = 0; j < 4; ++j) { const f32x4 g4 = *(const f32x4*)(p.in[8] + 16 * ot_c + 4 * j); gn[4 * j] = g4[0]; gn[4 * j + 1] = g4[1]; gn[4 * j + 2] = g4[2]; gn[4 * j + 3] = g4[3]; }
    f32x16 S0, S1;
#pragma unroll
    for (int i = 0; i < 16; ++i) { S0[i] = 0.f; S1[i] = 0.f; }
    __syncthreads();
    for (int i = tid; i < 128 * HG_SS / 2; i += NTHREADS) ((unsigned*)ST)[i] = 0u;
    unsigned short rq[16], rf[16], ri[16];
    { const bf16_t* src = P + (size_t)(b * SEQ + 16 * seg) * NP + h * 128 + d;
#pragma unroll
      for (int i = 0; i < 16; ++i) { rq[i] = src[(size_t)i * NP + C_QB]; rf[i] = src[(size_t)i * NP + C_FB]; ri[i] = src[(size_t)i * NP + C_IB]; } }
#pragma unroll 1
    for (int n = 0; n < 32; ++n) {
#pragma unroll 1
        for (int repa = 0; repa <= HG_REP_A; ++repa) {
            float lf[16], kk[16];
            float run = 0.f;
#pragma unroll
            for (int i = 0; i < 16; ++i) { const float f = lb + (1.f - lb) * sigmoidf_(bf2f(rf[i])); kk[i] = 1.f - f; run += __logf(f); lf[i] = run; }
            const float p0 = __shfl(run, dl), p1 = __shfl(run, 16 + dl), p2 = __shfl(run, 32 + dl), p3 = __shfl(run, 48 + dl);
            const float off = (seg > 0 ? p0 : 0.f) + (seg > 1 ? p1 : 0.f) + (seg > 2 ? p2 : 0.f), bL = (p0 + p1) + (p2 + p3), bref = p0 + p1;
            const float eref = __expf(bref), elref = __expf(bL - bref);
            unsigned kh[8], vv[8];
#pragma unroll
            for (int i = 0; i < 16; ++i) { const float bt = off + lf[i]; const float qs = siluf_(bf2f(rq[i]));
                const float e1 = __expf(bt - bref), e2 = e1 * eref, e3 = __builtin_amdgcn_rcpf(e1), e4 = e3 * elref;
                const int t = 16 * seg + i;
                QT[t * HG_RS + d] = (bf16_t)f2bf(qs * e1); QH[t * HG_RS + d] = (bf16_t)f2bf(qs * e2); KT[t * HG_RS + d] = (bf16_t)f2bf(kk[i] * e3);
                const unsigned khv = f2bf(kk[i] * e4);
                if (i & 1) { kh[i >> 1] |= khv << 16; vv[i >> 1] |= (unsigned)ri[i] << 16; } else { kh[i >> 1] = khv; vv[i >> 1] = (unsigned)ri[i]; } }
            *(u32x4*)(KHT + d * HG_TS + 16 * seg) = (u32x4){kh[0], kh[1], kh[2], kh[3]}; *(u32x4*)(KHT + d * HG_TS + 16 * seg + 8) = (u32x4){kh[4], kh[5], kh[6], kh[7]};
            *(u32x4*)(VT + d * HG_TS + 16 * seg) = (u32x4){vv[0], vv[1], vv[2], vv[3]}; *(u32x4*)(VT + d * HG_TS + 16 * seg + 8) = (u32x4){vv[4], vv[5], vv[6], vv[7]};
            if (seg == 0) DEC[d] = eref * elref;
        }
        __syncthreads();
        if (n < 31) { const bf16_t* src = P + (size_t)(b * SEQ + (n + 1) * 64 + 16 * seg) * NP + h * 128 + d;
#pragma unroll
            for (int i = 0; i < 16; ++i) { rq[i] = src[(size_t)i * NP + C_QB]; rf[i] = src[(size_t)i * NP + C_FB]; ri[i] = src[(size_t)i * NP + C_IB]; } }
        const u32x4 gb0 = *(const u32x4*)(P + (size_t)(b * SEQ + n * 64 + ot_t) * NP + C_GB + h * 128 + 16 * ot_c), gb1 = *(const u32x4*)(P + (size_t)(b * SEQ + n * 64 + ot_t) * NP + C_GB + h * 128 + 16 * ot_c + 8);
        f32x16 X0, X1, o;
#pragma unroll 1
        for (int repb = 0; repb <= HG_REP_B; ++repb) {
#pragma unroll
        for (int i = 0; i < 16; ++i) { X0[i] = 0.f; X1[i] = 0.f; o[i] = 0.f; }
#pragma unroll
        for (int ks = 0; ks < 8; ++ks) { const bf16x8 bq = *(const bf16x8*)(QT + (32 * tb + r) * HG_RS + 16 * ks + 8 * hh);
            const bf16x8 a0 = *(const bf16x8*)(KT + r * HG_RS + 16 * ks + 8 * hh); X0 = __builtin_amdgcn_mfma_f32_32x32x16_bf16(a0, bq, X0, 0, 0, 0);
            if (tb == 1) { const bf16x8 a1 = *(const bf16x8*)(KT + (32 + r) * HG_RS + 16 * ks + 8 * hh); X1 = __builtin_amdgcn_mfma_f32_32x32x16_bf16(a1, bq, X1, 0, 0, 0); } }
#pragma unroll
        for (int i = 0; i < 16; ++i) { const bool keep = ((i & 3) + 8 * (i >> 2) + 4 * hh) <= r; if (tb == 0) X0[i] = keep ? X0[i] : 0.f; else X1[i] = keep ? X1[i] : 0.f; }
#pragma unroll
        for (int sb = 0; sb < 2; ++sb) { if (sb <= tb) {
#pragma unroll
            for (int s2 = 0; s2 < 2; ++s2) { u32x4 aw;
                if (sb == 0) { aw.x = pk2(X0[8 * s2], X0[8 * s2 + 1]); aw.y = pk2(X0[8 * s2 + 2], X0[8 * s2 + 3]); aw.z = pk2(X0[8 * s2 + 4], X0[8 * s2 + 5]); aw.w = pk2(X0[8 * s2 + 6], X0[8 * s2 + 7]); }
                else { aw.x = pk2(X1[8 * s2], X1[8 * s2 + 1]); aw.y = pk2(X1[8 * s2 + 2], X1[8 * s2 + 3]); aw.z = pk2(X1[8 * s2 + 4], X1[8 * s2 + 5]); aw.w = pk2(X1[8 * s2 + 6], X1[8 * s2 + 7]); }
                const bf16_t* vp = VT + (32 * eb + r) * HG_TS + 32 * sb + 16 * s2 + 4 * hh;
                const u32x2 lo = *(const u32x2*)vp, hi = *(const u32x2*)(vp + 8); const u32x4 bw = {lo.x, lo.y, hi.x, hi.y};
                o = __builtin_amdgcn_mfma_f32_32x32x16_bf16(__builtin_bit_cast(bf16x8, aw), __builtin_bit_cast(bf16x8, bw), o, 0, 0, 0); } } }
#pragma unroll
        for (int ks = 0; ks < 8; ++ks) { const bf16x8 aq = *(const bf16x8*)(QH + (32 * tb + r) * HG_RS + 16 * ks + 8 * hh), bs = *(const bf16x8*)(ST + (32 * eb + r) * HG_SS + 16 * ks + 8 * hh);
            o = __builtin_amdgcn_mfma_f32_32x32x16_bf16(aq, bs, o, 0, 0, 0); }
        { float a8[8], a4[4], a2[2], a1;
#pragma unroll
          for (int i = 0; i < 8; ++i) { const float lo = o[i] * o[i], hi = o[i + 8] * o[i + 8]; const bool up = lane & 16; const float keep = up ? hi : lo, send = up ? lo : hi; a8[i] = keep + __shfl_xor(send, 16); }
#pragma unroll
          for (int i = 0; i < 4; ++i) { const bool up = lane & 8; const float keep = up ? a8[i + 4] : a8[i], send = up ? a8[i] : a8[i + 4]; a4[i] = keep + __shfl_xor(send, 8); }
#pragma unroll
          for (int i = 0; i < 2; ++i) { const bool up = lane & 4; const float keep = up ? a4[i + 2] : a4[i], send = up ? a4[i] : a4[i + 2]; a2[i] = keep + __shfl_xor(send, 4); }
          { const bool up = lane & 2; const float keep = up ? a2[1] : a2[0], send = up ? a2[0] : a2[1]; a1 = keep + __shfl_xor(send, 2); }
          a1 += __shfl_xor(a1, 1);
          const int ri2 = (lane >> 1) & 15;
          if ((lane & 1) == 0) SSQ[(32 * tb + (ri2 & 3) + 8 * (ri2 >> 2) + 4 * hh) * 4 + eb] = a1; }
#pragma unroll
        for (int i = 0; i < 16; ++i) OT[(32 * tb + (i & 3) + 8 * (i >> 2) + 4 * hh) * HG_RS + 32 * eb + r] = (bf16_t)f2bf(o[i]);
        }
        { float dc[16];
#pragma unroll
          for (int g4 = 0; g4 < 4; ++g4) { const f32x4 dv = *(const f32x4*)(DEC + 32 * sdb + 8 * g4 + 4 * hh); dc[4 * g4] = dv[0]; dc[4 * g4 + 1] = dv[1]; dc[4 * g4 + 2] = dv[2]; dc[4 * g4 + 3] = dv[3]; }
#pragma unroll
          for (int i = 0; i < 16; ++i) { S0[i] *= dc[i]; S1[i] *= dc[i]; }
#pragma unroll
          for (int ss = 0; ss < 4; ++ss) { const bf16x8 a = *(const bf16x8*)(KHT + (32 * sdb + r) * HG_TS + 16 * ss + 8 * hh);
              const bf16x8 b0 = *(const bf16x8*)(VT + (32 * seb0 + r) * HG_TS + 16 * ss + 8 * hh), b1 = *(const bf16x8*)(VT + (32 * (seb0 + 1) + r) * HG_TS + 16 * ss + 8 * hh);
              S0 = __builtin_amdgcn_mfma_f32_32x32x16_bf16(a, b0, S0, 0, 0, 0); S1 = __builtin_amdgcn_mfma_f32_32x32x16_bf16(a, b1, S1, 0, 0, 0); } }
        __syncthreads();
#pragma unroll
        for (int g4 = 0; g4 < 4; ++g4) { const int d0 = 32 * sdb + 8 * g4 + 4 * hh;
            *(u32x2*)(ST + (32 * seb0 + r) * HG_SS + d0) = (u32x2){pk2(S0[4 * g4], S0[4 * g4 + 1]), pk2(S0[4 * g4 + 2], S0[4 * g4 + 3])};
            *(u32x2*)(ST + (32 * (seb0 + 1) + r) * HG_SS + d0) = (u32x2){pk2(S1[4 * g4], S1[4 * g4 + 1]), pk2(S1[4 * g4 + 2], S1[4 * g4 + 3])}; }
        { const f32x4 q4 = *(const f32x4*)(SSQ + ot_t * 4); const float rstd = rsqrtf(((q4[0] + q4[1]) + (q4[2] + q4[3])) * (1.f / 128.f) + NORM_EPS);
          const u32x4 o0 = *(const u32x4*)(OT + ot_t * HG_RS + 16 * ot_c), o1 = *(const u32x4*)(OT + ot_t * HG_RS + 16 * ot_c + 8);
          const unsigned ow[8] = {o0.x, o0.y, o0.z, o0.w, o1.x, o1.y, o1.z, o1.w}, gwv[8] = {gb0.x, gb0.y, gb0.z, gb0.w, gb1.x, gb1.y, gb1.z, gb1.w};
          unsigned rw[8];
#pragma unroll
          for (int j = 0; j < 8; ++j) rw[j] = pk2(bflo(ow[j]) * rstd * gn[2 * j] * siluf_(bflo(gwv[j])), bfhi(ow[j]) * rstd * gn[2 * j + 1] * siluf_(bfhi(gwv[j])));
          bf16_t* dst = REC + (size_t)(b * SEQ + n * 64 + ot_t) * 1024 + h * 128 + 16 * ot_c;
          *(u32x4*)dst = (u32x4){rw[0], rw[1], rw[2], rw[3]}; *(u32x4*)(dst + 8) = (u32x4){rw[4], rw[5], rw[6], rw[7]}; }
    }
}
__device__ __forceinline__ void phase_hgrn(const Params& p, unsigned char* lds, int vb, int vG) {
    for (int it = vb; it < 64; it += vG) hgrn_item(p, lds, it);
}

constexpr int AT_KRS = 136, AT_VRS = 36, AT_KB = 32 * AT_KRS * 2, AT_VB = 128 * AT_VRS * 2, AT_STAGE = AT_KB + AT_VB;
__device__ __forceinline__ void attn_item(const Params& p, unsigned char* lds, int b, int head, int cq) {
    const int tid = threadIdx.x, w = __builtin_amdgcn_readfirstlane(tid >> 6), lane = tid & 63, r = lane & 31, hh = lane >> 5;
    const bf16_t* P = (const bf16_t*)(p.ws + WS_P); const bf16_t* VT = (const bf16_t*)(p.ws + WS_VT); const unsigned* MASKT = (const unsigned*)(p.ws + WS_MASK);
    bf16_t* AO = (bf16_t*)((unsigned char*)p.out + OUT_AO);
    const int c = 4 * cq + (w >> 1), qpos = c * 64 + (w & 1) * 32 + r, tq = b * SEQ + qpos;
    const int nkt_w = 2 * (c + 1), nkt = 8 * (cq + 1);
    const bf16_t* kg = P + (size_t)(b * SEQ + (tid >> 4)) * NP + C_KA + head * 128 + (tid & 15) * 8;
    const bf16_t* vg = VT + (size_t)((b * 8 + head) * 128 + (tid >> 2)) * SEQ + (tid & 3) * 8;
    const int kls = (tid >> 4) * AT_KRS * 2 + (tid & 15) * 16, vls = AT_KB + (tid >> 2) * AT_VRS * 2 + (tid & 3) * 16;
    bf16x8 qf[8];
    { const bf16_t* qp = P + (size_t)tq * NP + C_QA + head * 128 + 8 * hh;
#pragma unroll
      for (int ks = 0; ks < 8; ++ks) qf[ks] = *(const bf16x8*)(qp + ks * 16); }
    f32x16 o[4];
#pragma unroll
    for (int db = 0; db < 4; ++db)
#pragma unroll
        for (int i = 0; i < 16; ++i) o[db][i] = 0.f;
    float mrun = -1e30f, lsum = 0.f;
    const float sc = 0.08838834764831845f * 1.4426950408889634f;
    __syncthreads();
    u32x4 krA, vrA, krB, vrB;
#pragma unroll
    for (int t0 = 0; t0 < 2; ++t0) { krA = *(const u32x4*)(kg + (size_t)(t0 * 32) * NP); vrA = *(const u32x4*)(vg + t0 * 32);
        *(u32x4*)(lds + t0 * AT_STAGE + kls) = krA; *(u32x2*)(lds + t0 * AT_STAGE + vls) = (u32x2){vrA.x, vrA.y}; *(u32x2*)(lds + t0 * AT_STAGE + vls + 8) = (u32x2){vrA.z, vrA.w}; }
    krA = *(const u32x4*)(kg + (size_t)(2 * 32) * NP); vrA = *(const u32x4*)(vg + 2 * 32);
    krB = *(const u32x4*)(kg + (size_t)(3 * 32) * NP); vrB = *(const u32x4*)(vg + 3 * 32);
    unsigned mwA = MASKT[(size_t)(b * 64) * SEQ + qpos], mwB = MASKT[(size_t)(b * 64 + 1) * SEQ + qpos];
    __syncthreads();
    int st = 0, st2 = 2;
#define AT_TILE(KT, KR, VR, MW) do { const int kt_ = (KT); \
        if (kt_ + 2 < nkt) { *(u32x4*)(lds + st2 * AT_STAGE + kls) = KR; *(u32x2*)(lds + st2 * AT_STAGE + vls) = (u32x2){VR.x, VR.y}; *(u32x2*)(lds + st2 * AT_STAGE + vls + 8) = (u32x2){VR.z, VR.w}; } \
        if (kt_ + 4 < nkt) { KR = *(const u32x4*)(kg + (size_t)((kt_ + 4) * 32) * NP); VR = *(const u32x4*)(vg + (kt_ + 4) * 32); } \
        if (kt_ < nkt_w) { \
            const unsigned mwc = MW; \
            if (kt_ + 2 < nkt_w) MW = MASKT[(size_t)(b * 64 + kt_ + 2) * SEQ + qpos]; \
            const bf16_t* Ks = (const bf16_t*)(lds + st * AT_STAGE); const bf16_t* Vs = (const bf16_t*)(lds + st * AT_STAGE + AT_KB); \
            f32x16 s; \
            _Pragma("unroll") for (int i = 0; i < 16; ++i) s[i] = 0.f; \
            _Pragma("unroll") for (int ks = 0; ks < 8; ++ks) { const bf16x8 kf = *(const bf16x8*)(Ks + r * AT_KRS + ks * 16 + 8 * hh); s = __builtin_amdgcn_mfma_f32_32x32x16_bf16(kf, qf[ks], s, 0, 0, 0); } \
            float mx = -3e38f; const unsigned mws = mwc >> (4 * hh);        \
            _Pragma("unroll") for (int i = 0; i < 16; ++i) { const bool ok = (mws >> ((i & 3) + 8 * (i >> 2))) & 1u; s[i] = ok ? s[i] : -3e38f; mx = fmaxf(mx, s[i]); } \
            mx = fmaxf(mx, __shfl_xor(mx, 32)); \
            const float mnew = fmaxf(mrun, mx * sc), alpha = exp2f(mrun - mnew); \
            const bool grew = mnew > mrun; mrun = mnew; \
            float ps = 0.f; float pv[16]; \
            _Pragma("unroll") for (int i = 0; i < 16; ++i) { const float e = exp2f(fmaf(s[i], sc, -mnew)); pv[i] = e; ps += e; }        \
            lsum = lsum * alpha + ps; \
            if (__builtin_amdgcn_ballot_w64(grew) != 0ull) { _Pragma("unroll") for (int db = 0; db < 4; ++db) _Pragma("unroll") for (int i = 0; i < 16; ++i) o[db][i] *= alpha; } \
            bf16x8 pf[2]; \
            _Pragma("unroll") for (int s2 = 0; s2 < 2; ++s2) { u32x4 wv; wv.x = pk2(pv[8 * s2 + 0], pv[8 * s2 + 1]); wv.y = pk2(pv[8 * s2 + 2], pv[8 * s2 + 3]); wv.z = pk2(pv[8 * s2 + 4], pv[8 * s2 + 5]); wv.w = pk2(pv[8 * s2 + 6], pv[8 * s2 + 7]); pf[s2] = __builtin_bit_cast(bf16x8, wv); } \
            _Pragma("unroll") for (int db = 0; db < 4; ++db) _Pragma("unroll") for (int s2 = 0; s2 < 2; ++s2) { const bf16_t* vp = Vs + (db * 32 + r) * AT_VRS + 16 * s2 + 4 * hh; const u32x2 lo = *(const u32x2*)vp, hi = *(const u32x2*)(vp + 8); \
                    const u32x4 wv = {lo.x, lo.y, hi.x, hi.y}; \
                    o[db] = __builtin_amdgcn_mfma_f32_32x32x16_bf16(__builtin_bit_cast(bf16x8, wv), pf[s2], o[db], 0, 0, 0); } \
        } \
        __syncthreads(); \
        st = (st == 2) ? 0 : st + 1; st2 = (st2 == 2) ? 0 : st2 + 1; } while (0)
#pragma unroll 1
    for (int kt = 0; kt < nkt; kt += 2) { AT_TILE(kt, krA, vrA, mwA); AT_TILE(kt + 1, krB, vrB, mwB); }
#undef AT_TILE
    const float l = lsum + __shfl_xor(lsum, 32), inv = 1.f / l;
    bf16_t* op = AO + (size_t)tq * 1024 + head * 128 + 4 * hh;
#pragma unroll
    for (int db = 0; db < 4; ++db)
#pragma unroll
        for (int g4 = 0; g4 < 4; ++g4) { u32x2 wv; wv.x = pk2(o[db][4 * g4] * inv, o[db][4 * g4 + 1] * inv); wv.y = pk2(o[db][4 * g4 + 2] * inv, o[db][4 * g4 + 3] * inv);
            *(u32x2*)(op + db * 32 + 8 * g4) = wv; }
}
__device__ __forceinline__ void phase_attn(const Params& p, unsigned char* lds, int vb, int vG) {
    const int G = vG;
    for (int rd = 0;; ++rd) {
        const int base = rd * G; if (base >= 512) break;
        const int pos = (rd & 1) ? (G - 1 - vb) : vb; const int i = base + pos; if (i >= 512) continue;
        attn_item(p, lds, (i >> 3) & 7, i & 7, 7 - (i >> 6));
    }
}
__device__ __forceinline__ void phase_attn_queue(const Params& p, unsigned char* lds, unsigned* qhead) {
    volatile LAS int* slot = (volatile LAS int*)((LAS unsigned char*)lds + LDS_BYTES - 32);
    for (;;) {
        __syncthreads();
        if (threadIdx.x == 0) slot[0] = (int)__hip_atomic_fetch_add(qhead, 1u, __ATOMIC_RELAXED, __HIP_MEMORY_SCOPE_AGENT);
        __syncthreads();
        const int i = slot[0]; if (i >= 512) break;
        attn_item(p, lds, (i >> 3) & 7, i & 7, 7 - (i >> 6));
    }
}
__device__ __forceinline__ void phase_uv(const Params& p) {
    const int tid = threadIdx.x, wave = tid >> 6, lane = tid & 63;
    const int gw = blockIdx.x * NWAVES + wave, NGW = gridDim.x * NWAVES;
    for (int it = gw; it < 2 * 16384; it += NGW) {
        const int tbl = it >> 14, row = it & 16383;
        const float* src = (tbl ? p.in[15] : p.in[14]) + (size_t)row * 2048 + 32 * lane;
        unsigned char* dst = p.ws + (tbl ? WS_V8 : WS_U8); float* isc = (float*)(p.ws + (tbl ? WS_ISV : WS_ISU));
        f32x4 v[8]; float am = 0.f;
#pragma unroll
        for (int j = 0; j < 8; ++j) { v[j] = *(const f32x4*)(src + 4 * j); am = fmaxf(am, fmaxf(fmaxf(fabsf(v[j][0]), fabsf(v[j][1])), fmaxf(fabsf(v[j][2]), fabsf(v[j][3])))); }
#pragma unroll
        for (int o = 1; o < 64; o <<= 1) am = fmaxf(am, __shfl_xor(am, o));
        am = fmaxf(am, 1e-30f); const float sc = 256.f / am;
        unsigned wq[8];
#pragma unroll
        for (int j = 0; j < 8; ++j) { int pk = 0; pk = __builtin_amdgcn_cvt_pk_fp8_f32(v[j][0] * sc, v[j][1] * sc, pk, false); pk = __builtin_amdgcn_cvt_pk_fp8_f32(v[j][2] * sc, v[j][3] * sc, pk, true); wq[j] = (unsigned)pk; }
        unsigned char* d = dst + (size_t)(lane >> 2) * (2u << 20) + (size_t)row * 128 + (lane & 3) * 32;
        *(u32x4*)d = (u32x4){wq[0], wq[1], wq[2], wq[3]}; *(u32x4*)(d + 16) = (u32x4){wq[4], wq[5], wq[6], wq[7]};
        if (lane == 0) isc[row] = am * (1.f / 256.f);
    }
}

#define INS16(v, x) do { _Pragma("unroll") for (int _j = 15; _j >= 1; --_j) v[_j] = __builtin_amdgcn_fmed3f(v[_j - 1], v[_j], (x)); v[0] = fmaxf(v[0], (x)); } while (0)
__device__ __forceinline__ void peer_half_top16(const bf16_t* QP, const bf16_t* kb0  , int pitch, int tok, int p, int hf, int r, int hh, float (&v)[16]) {
    bf16x8 qf[8];
    { const bf16_t* qp = QP + (size_t)tok * D + p * 256 + hf * 128 + 8 * hh;
#pragma unroll
      for (int ks = 0; ks < 8; ++ks) qf[ks] = *(const bf16x8*)(qp + ks * 16); }
#pragma unroll
    for (int k = 0; k < 16; ++k) v[k] = -3.0e38f;
    const bf16_t* kb = kb0 + r * pitch + 8 * hh;
#pragma unroll 1
    for (int nb = 0; nb < 4; ++nb) {
        f32x16 acc;
#pragma unroll
        for (int i = 0; i < 16; ++i) acc[i] = 0.f;
#pragma unroll
        for (int ks = 0; ks < 8; ++ks) { const bf16x8 kf = *(const bf16x8*)(kb + (nb * 32) * pitch + ks * 16); acc = __builtin_amdgcn_mfma_f32_32x32x16_bf16(kf, qf[ks], acc, 0, 0, 0); }
#pragma unroll
        for (int i = 0; i < 16; ++i) { const unsigned xi = (unsigned)(nb * 32 + (i & 3) + 8 * (i >> 2) + 4 * hh); const float x = __uint_as_float((__float_as_uint(acc[i]) & ~0x7fu) | xi); INS16(v, x); }
    }
    float ov[16];
#pragma unroll
    for (int k = 0; k < 16; ++k) ov[k] = __shfl_xor(v[k], 32);
#pragma unroll
    for (int k = 0; k < 16; ++k) INS16(v, ov[k]);
}
constexpr int PK_RS = 136;
#define GAS __attribute__((address_space(1)))
__device__ __attribute__((noinline)) void phase_peer_topk_ni(const GAS bf16_t* QPg, const GAS bf16_t* KEYSg, GAS int* EIDXg, GAS float* EGATEg, LAS unsigned char* ldsl) {
    const bf16_t* QP = (const bf16_t*)QPg; const bf16_t* KEYS = (const bf16_t*)KEYSg; int* EIDX = (int*)EIDXg; float* EGATE = (float*)EGATEg; unsigned char* lds = (unsigned char*)ldsl;
    const int tid = threadIdx.x, wave = __builtin_amdgcn_readfirstlane(tid >> 6), lane = tid & 63, r = lane & 31, hh = lane >> 5;
    bf16_t* KL = (bf16_t*)lds;
    const int G = gridDim.x, hd = blockIdx.x & 7;
    __syncthreads();
    for (int i = tid; i < 2 * 128 * 16; i += NTHREADS) { const int row = i >> 4, ch = i & 15;
        *(u32x4*)(KL + row * PK_RS + ch * 8) = *(const u32x4*)(KEYS + (size_t)(hd * 256 + row) * 128 + ch * 8); }
    __syncthreads();
    for (int tile = blockIdx.x >> 3; tile < 64; tile += (G + 7) / 8) {
        const int tok = tile * 256 + wave * 32 + r;
        float va[16], vb[16];
        peer_half_top16(QP, KL, PK_RS, tok, hd, 0, r, hh, va);
        peer_half_top16(QP, KL + 128 * PK_RS, PK_RS, tok, hd, 1, r, hh, vb);
        float bv[16];
#pragma unroll
        for (int k = 0; k < 16; ++k) bv[k] = -3.0e38f;
#pragma unroll
        for (int a = 0; a < 16; ++a)
#pragma unroll
            for (int b2 = 0; b2 < 16; ++b2) if ((a + 1) * (b2 + 1) <= 16) { const float x = va[a] + vb[b2]; INS16(bv, x); }
        float se = 0.f;
#pragma unroll
        for (int k = 0; k < 16; ++k) se += __expf(bv[k] - bv[0]);
        const float inv = 1.f / se, thr = bv[15], top = bv[0];
        int cnt = 0; int* ei = EIDX + (size_t)tok * 128 + hd * 16; float* eg = EGATE + (size_t)tok * 128 + hd * 16;
#pragma unroll
        for (int a = 0; a < 16; ++a)
#pragma unroll
            for (int b2 = 0; b2 < 16; ++b2) if ((a + 1) * (b2 + 1) <= 16) { const float x = va[a] + vb[b2];
                if (x >= thr && cnt < 16) { if (hh == 0) { ei[cnt] = (int)((__float_as_uint(va[a]) & 0x7fu) * 128u + (__float_as_uint(vb[b2]) & 0x7fu)); eg[cnt] = __expf(x - top) * inv; } ++cnt; } }
    }
}

typedef __bf16 bf16x2_t __attribute__((ext_vector_type(2)));
__device__ __forceinline__ float gelu_erf(float v) {
    const float av = fabsf(v), d = av * 0.2316418882f + 1.0f, t = __builtin_amdgcn_rcpf(d);
    float q = t * 0.5307027145f + (-0.7265760135f); q = q * t + 0.7107068705f; q = q * t + (-0.142248368f); q = q * t + 0.127414796f; q = q * t;
    const float e = __builtin_amdgcn_exp2f((v * v) * (-0.72134752044f));
    const float m = v * (q * e), r = v - m;
    return v < 0.f ? m : r;
}
__device__ __forceinline__ float dot2bf(unsigned a, unsigned b, float c) { return __builtin_amdgcn_fdot2_f32_bf16(__builtin_bit_cast(bf16x2_t, a), __builtin_bit_cast(bf16x2_t, b), c, false); }
__device__ __forceinline__ float dpp_f(float x, int ctrl_xor1_xor2_mirror) {
    const int v = __float_as_int(x);
    if (ctrl_xor1_xor2_mirror == 0) return __int_as_float(__builtin_amdgcn_update_dpp(0, v, 0xB1, 0xF, 0xF, true));
    if (ctrl_xor1_xor2_mirror == 1) return __int_as_float(__builtin_amdgcn_update_dpp(0, v, 0x4E, 0xF, 0xF, true));
    return __int_as_float(__builtin_amdgcn_update_dpp(0, v, 0x141, 0xF, 0xF, true));
}
typedef float f32x2v __attribute__((ext_vector_type(2)));
__device__ __forceinline__ void unpack8(const u32x4 w, float* f) { f[0] = bflo(w.x); f[1] = bfhi(w.x); f[2] = bflo(w.y); f[3] = bfhi(w.y); f[4] = bflo(w.z); f[5] = bfhi(w.z); f[6] = bflo(w.w); f[7] = bfhi(w.w); }
__device__ __forceinline__ void cvt16(const u32x4 w, float* f) {
#pragma unroll
    for (int q = 0; q < 4; ++q) { const f32x2v lo = __builtin_amdgcn_cvt_pk_f32_fp8((int)w[q], false), hi = __builtin_amdgcn_cvt_pk_f32_fp8((int)w[q], true);
        f[4 * q] = lo.x; f[4 * q + 1] = lo.y; f[4 * q + 2] = hi.x; f[4 * q + 3] = hi.y; }
}
__device__ __forceinline__ void phase_experts(const Params& p, unsigned char* lds) {
    const int tid = threadIdx.x, wave = __builtin_amdgcn_readfirstlane(tid >> 6), lane = tid & 63, rr = lane >> 3, cc = lane & 7; const bool odd = cc & 1;
    const bf16_t* H2 = (const bf16_t*)(p.ws + WS_H2); const unsigned char* U8 = p.ws + WS_U8; const unsigned char* V8 = p.ws + WS_V8;
    const float* ISU = (const float*)(p.ws + WS_ISU); const float* ISV = (const float*)(p.ws + WS_ISV);
    const int* EIDX = (const int*)(p.ws + WS_EIDX); const float* EGATE = (const float*)(p.ws + WS_EGATE);
    const float* mod = (const float*)(p.ws + WS_MOD); const float* fin = p.in[16]; float* out = p.out; const float* X1 = (const float*)(p.ws + WS_X1);
    unsigned* offs = (unsigned*)lds; float* gts = (float*)(lds + 32768); float* rstl = (float*)(lds + 65536);
    const unsigned xcc = (unsigned)__builtin_amdgcn_s_getreg((3 << 11) | 20) & 7u; const unsigned cc16 = cc * 16;
    for (int tile = blockIdx.x; tile < T / 64; tile += gridDim.x) {
        const int tok0 = tile * 64, b = tok0 >> 11;
        __syncthreads();
        for (int i = tid; i < 8192; i += NTHREADS) { const int tl = i >> 7, j = i & 127, g = j >> 3, r8 = j & 7;
            offs[(tl * 8 + r8) * 16 + g] = (unsigned)EIDX[(size_t)tok0 * 128 + i] * 128u; gts[(tl * 8 + r8) * 16 + g] = EGATE[(size_t)tok0 * 128 + i]; }
        __syncthreads();
#pragma unroll 1
        for (int half = 0; half < 1; ++half) {
            const int tlb = wave * 8;
            u32x4 dA[16], hA0, hA1;
#ifndef EXP_REP_U
#define EXP_REP_U 0
#endif
#ifndef EXP_REP_V
#define EXP_REP_V 0
#endif
#define EX_SLICE(i_) ((xcc * 2u + (unsigned)(i_)) & 15u)
#define EX_LOAD(buf, TBL, i_, k_) do { const unsigned char* tb_ = (TBL) + (size_t)EX_SLICE(i_) * (2u << 20); u32x4 o4_[4]; \
    _Pragma("unroll") for (int q_ = 0; q_ < 4; ++q_) o4_[q_] = *(const u32x4*)(offs + ((tlb + (k_)) * 8 + rr) * 16 + 4 * q_); \
    _Pragma("unroll") for (int g_ = 0; g_ < 16; ++g_) buf[g_] = *(const u32x4*)(tb_ + (o4_[g_ >> 2][g_ & 3] + cc16)); } while (0)
#define EX_LOADH(h0, h1, i_, k_) do { const bf16_t* hp_ = H2 + (size_t)(tok0 + tlb + (k_)) * D + EX_SLICE(i_) * 128 + cc * 16; h0 = *(const u32x4*)hp_; h1 = *(const u32x4*)(hp_ + 8); } while (0)
#define EX_DOT16(acc, WSRC, hf) do { u32x4 w_ = WSRC; asm volatile("" : "+v"(w_.x), "+v"(w_.y), "+v"(w_.z), "+v"(w_.w), "+v"(ch_)); \
    _Pragma("unroll") for (int q_ = 0; q_ < 4; ++q_) { const f32x2v lo_ = __builtin_amdgcn_cvt_pk_f32_fp8((int)w_[q_], false), hi_ = __builtin_amdgcn_cvt_pk_f32_fp8((int)w_[q_], true); \
        acc = dot2bf(pk2(lo_.x, lo_.y), hf[2 * q_], acc); acc = dot2bf(pk2(hi_.x, hi_.y), hf[2 * q_ + 1], acc); } ch_ = acc; } while (0)
#define EX_UCOMP(buf, h0, h1, k_) do { const unsigned hf_[8] = {h0.x, h0.y, h0.z, h0.w, h1.x, h1.y, h1.z, h1.w}; float ch_ = 0.f; \
    _Pragma("unroll") for (int j_ = 0; j_ < 8; ++j_) { float te_ = 0.f, to_ = 0.f; EX_DOT16(te_, buf[2 * j_], hf_); __builtin_amdgcn_sched_barrier(0); EX_DOT16(to_, buf[2 * j_ + 1], hf_); \
    const float my_ = odd ? to_ : te_, ot_ = odd ? te_ : to_; zp[k_][j_] += my_ + dpp_f(ot_, 0); asm volatile("" : "+v"(zp[k_][j_])); __builtin_amdgcn_sched_barrier(0); } } while (0)
#define SB() __builtin_amdgcn_sched_barrier(0)
            float zp[8][8];
#pragma unroll
            for (int k = 0; k < 8; ++k)
#pragma unroll
                for (int j = 0; j < 8; ++j) zp[k][j] = 0.f;
#pragma unroll 1
            for (int i = 0; i < 16 * (1 + EXP_REP_U); ++i) {
                __builtin_amdgcn_s_barrier();
                EX_LOADH(hA0, hA1, i, 0); EX_LOAD(dA, U8, i, 0); SB(); EX_UCOMP(dA, hA0, hA1, 0); SB();
                EX_LOADH(hA0, hA1, i, 1); EX_LOAD(dA, U8, i, 1); SB(); EX_UCOMP(dA, hA0, hA1, 1); SB();
                EX_LOADH(hA0, hA1, i, 2); EX_LOAD(dA, U8, i, 2); SB(); EX_UCOMP(dA, hA0, hA1, 2); SB();
                EX_LOADH(hA0, hA1, i, 3); EX_LOAD(dA, U8, i, 3); SB(); EX_UCOMP(dA, hA0, hA1, 3); SB();
                EX_LOADH(hA0, hA1, i, 4); EX_LOAD(dA, U8, i, 4); SB(); EX_UCOMP(dA, hA0, hA1, 4); SB();
                EX_LOADH(hA0, hA1, i, 5); EX_LOAD(dA, U8, i, 5); SB(); EX_UCOMP(dA, hA0, hA1, 5); SB();
                EX_LOADH(hA0, hA1, i, 6); EX_LOAD(dA, U8, i, 6); SB(); EX_UCOMP(dA, hA0, hA1, 6); SB();
                EX_LOADH(hA0, hA1, i, 7); EX_LOAD(dA, U8, i, 7); SB(); EX_UCOMP(dA, hA0, hA1, 7); SB();
            }
            if (EXP_REP_U) {
#pragma unroll
                for (int k = 0; k < 8; ++k)
#pragma unroll
                    for (int j = 0; j < 8; ++j) zp[k][j] *= 0.5f; }
            unsigned* apl = (unsigned*)(lds + 66560);
#pragma unroll
            for (int k = 0; k < 8; ++k)
#pragma unroll
                for (int j = 0; j < 8; ++j) { float z = zp[k][j]; z += dpp_f(z, 1); z += __shfl_xor(z, 4);
                    const int li = ((tlb + k) * 8 + rr) * 16 + 2 * j + (odd ? 1 : 0); const unsigned eid = offs[li] >> 7;
                    const float act = gelu_erf(z * ISU[eid]) * gts[li] * ISV[eid]; const float oth = dpp_f(act, 0);
                    apl[((tlb + k) * 8 + rr) * 8 + j] = f2bf(odd ? oth : act) | (f2bf(odd ? act : oth) << 16); }
            LDS_WAIT();
#define EX_VCOMP(buf, i_, k_) do { float oa_[16]; _Pragma("unroll") for (int e_ = 0; e_ < 16; ++e_) oa_[e_] = 0.f; \
    const int col_ = (int)EX_SLICE(i_) * 128 + cc * 16 + 2 * rr; const size_t xo_ = (size_t)(tok0 + tlb + (k_)) * D + col_; \
    const f32x2v x1_ = *(const f32x2v*)(X1 + xo_), g2_ = *(const f32x2v*)(mod + (size_t)b * NADA + 5 * 2048 + col_); \
    _Pragma("unroll") for (int j_ = 0; j_ < 8; ++j_) { const unsigned pr_ = apl[((tlb + (k_)) * 8 + rr) * 8 + j_]; const float a0_ = bflo(pr_), a1_ = bfhi(pr_); \
        { u32x4 w_ = buf[2 * j_]; asm volatile("" : "+v"(w_.x), "+v"(w_.y), "+v"(w_.z), "+v"(w_.w), "+v"(oa_[0])); float f_[16]; cvt16(w_, f_); _Pragma("unroll") for (int e_ = 0; e_ < 16; ++e_) oa_[e_] = fmaf(a0_, f_[e_], oa_[e_]); } \
        { u32x4 w_ = buf[2 * j_ + 1]; asm volatile("" : "+v"(w_.x), "+v"(w_.y), "+v"(w_.z), "+v"(w_.w), "+v"(oa_[0])); float f_[16]; cvt16(w_, f_); _Pragma("unroll") for (int e_ = 0; e_ < 16; ++e_) oa_[e_] = fmaf(a1_, f_[e_], oa_[e_]); } } \
      \
    float b8_[8], b4_[4], b2_[2]; \
    _Pragma("unroll") for (int e_ = 0; e_ < 8; ++e_) { const bool up_ = lane & 32; const float kp_ = up_ ? oa_[e_ + 8] : oa_[e_], sd_ = up_ ? oa_[e_] : oa_[e_ + 8]; b8_[e_] = kp_ + __shfl_xor(sd_, 32); } \
    _Pragma("unroll") for (int e_ = 0; e_ < 4; ++e_) { const bool up_ = lane & 16; const float kp_ = up_ ? b8_[e_ + 4] : b8_[e_], sd_ = up_ ? b8_[e_] : b8_[e_ + 4]; b4_[e_] = kp_ + __shfl_xor(sd_, 16); } \
    _Pragma("unroll") for (int e_ = 0; e_ < 2; ++e_) { const bool up_ = lane & 8; const float kp_ = up_ ? b4_[e_ + 2] : b4_[e_], sd_ = up_ ? b4_[e_] : b4_[e_ + 2]; b2_[e_] = kp_ + __shfl_xor(sd_, 8); } \
    f32x2v y_; y_.x = x1_.x + g2_.x * b2_[0]; y_.y = x1_.y + g2_.y * b2_[1]; *(f32x2v*)(out + xo_) = y_; } while (0)
#pragma unroll 1
            for (int i = 0; i < 16 * (1 + EXP_REP_V); ++i) {
                __builtin_amdgcn_s_barrier();
                EX_LOAD(dA, V8, i, 0); SB(); EX_VCOMP(dA, i, 0); SB();
                EX_LOAD(dA, V8, i, 1); SB(); EX_VCOMP(dA, i, 1); SB();
                EX_LOAD(dA, V8, i, 2); SB(); EX_VCOMP(dA, i, 2); SB();
                EX_LOAD(dA, V8, i, 3); SB(); EX_VCOMP(dA, i, 3); SB();
                EX_LOAD(dA, V8, i, 4); SB(); EX_VCOMP(dA, i, 4); SB();
                EX_LOAD(dA, V8, i, 5); SB(); EX_VCOMP(dA, i, 5); SB();
                EX_LOAD(dA, V8, i, 6); SB(); EX_VCOMP(dA, i, 6); SB();
                EX_LOAD(dA, V8, i, 7); SB(); EX_VCOMP(dA, i, 7); SB();
            }
        }
#undef EX_SLICE
#undef EX_LOAD
#undef EX_LOADH
#undef EX_DOT16
#undef EX_UCOMP
#undef EX_VCOMP
#undef SB
        __builtin_amdgcn_fence(__ATOMIC_RELEASE, "agent"); __builtin_amdgcn_fence(__ATOMIC_ACQUIRE, "agent");
        LDS_WAIT();
        int lane2 = (int)__builtin_amdgcn_mbcnt_hi(~0u, __builtin_amdgcn_mbcnt_lo(~0u, 0u)); asm volatile("" : "+v"(lane2));
#pragma unroll 1
        for (int k = 0; k < 8; ++k) { float* xr = out + (size_t)(tok0 + wave * 8 + k) * D;
            f32x4 v[8]; float ss = 0.f;
#pragma unroll
            for (int j = 0; j < 8; ++j) { v[j] = *(const f32x4*)(xr + 4 * (lane2 + 64 * j)); ss += (v[j][0] * v[j][0] + v[j][1] * v[j][1]) + (v[j][2] * v[j][2] + v[j][3] * v[j][3]); }
            const float rs = rsqrtf(wave_sum(ss) * (1.f / D) + NORM_EPS);
#pragma unroll
            for (int j = 0; j < 8; ++j) { const int col = 4 * (lane2 + 64 * j); const f32x4 f = *(const f32x4*)(fin + col);
                f32x4 o; o[0] = v[j][0] * rs * f[0]; o[1] = v[j][1] * rs * f[1]; o[2] = v[j][2] * rs * f[2]; o[3] = v[j][3] * rs * f[3]; *(f32x4*)(xr + col) = o; } }
    }
}

#define XB_TMO      128
#define XB_XCNT(j)  (256  + 64 * (j))
#define XB_XSUB(j)  (1280 + 64 * (j))
#define XB_XGEN(j)  (2304 + 64 * (j))
#define XB_TOP      3328
#define XB_TOPGEN   3392
#define XCD_BAR_WORDS 3456
#define XB_SPIN_CAP (1u << 22)
__device__ __forceinline__ unsigned xb_ld(unsigned* p)              { return __hip_atomic_load(p, __ATOMIC_RELAXED, __HIP_MEMORY_SCOPE_AGENT); }
__device__ __forceinline__ unsigned xb_add(unsigned* p, unsigned v) { return __hip_atomic_fetch_add(p, v, __ATOMIC_RELAXED, __HIP_MEMORY_SCOPE_AGENT); }
__device__ __forceinline__ unsigned xb_xcc_id() { return (unsigned)__builtin_amdgcn_s_getreg((3 << 11) | 20) & 0xFu; }
#define XB_SPIN(cond, bar) do { unsigned _sp = 0; while (cond) { __builtin_amdgcn_s_sleep(1); \
    if ((++_sp & 255u) == 0u) { if (xb_ld(&(bar)[XB_TMO])) break; if (_sp > XB_SPIN_CAP) { atomicAdd(&(bar)[XB_TMO], 1u); break; } } } } while (0)
struct XcdBarrier { unsigned* bar; unsigned x; volatile LAS unsigned* st; };
__device__ __forceinline__ XcdBarrier xcd_barrier_post(unsigned* bar, volatile LAS unsigned* st) {
    XcdBarrier b; b.bar = bar; b.x = xb_xcc_id(); b.st = st;
    if (threadIdx.x == 0) (void)xb_add(&bar[XB_XCNT(b.x)], 1u);
    return b;
}
__device__ __forceinline__ void xcd_barrier_complete(unsigned* bar, unsigned x, unsigned& nloc, unsigned& nx) {
    const unsigned G = gridDim.x * gridDim.y * gridDim.z;
    unsigned sum, cnt, mine, sp = 0u;
    for (;;) {
        sum = 0u; cnt = 0u; mine = 0u;
#pragma unroll
        for (unsigned j = 0; j < 16; ++j) { const unsigned c = xb_ld(&bar[XB_XCNT(j)]); sum += c; cnt += (c > 0u) ? 1u : 0u; mine = (j == x) ? c : mine; }
        if (sum == G) break;
        __builtin_amdgcn_s_sleep(1);
        if ((++sp & 255u) == 0u) { if (xb_ld(&bar[XB_TMO])) break; if (sp > XB_SPIN_CAP) { atomicAdd(&bar[XB_TMO], 1u); break; } }
    }
    nloc = mine > 0u ? mine : 1u; nx = cnt > 0u ? cnt : 1u;
}
__device__ __forceinline__ void xcd_barrier(const XcdBarrier& b) {
    asm volatile("s_waitcnt vmcnt(0)" ::: "memory");
    __syncthreads();
    if (threadIdx.x == 0) {
        unsigned* bar = b.bar;
        __builtin_amdgcn_s_waitcnt(0);
        unsigned nloc = b.st[0], nx = b.st[1];
        if (nloc == 0u) { xcd_barrier_complete(bar, b.x, nloc, nx); b.st[0] = nloc; b.st[1] = nx; }
        const unsigned old = xb_add(&bar[XB_XSUB(b.x)], 1u);
        const unsigned gen = old / nloc;
        if (old + 1u == (gen + 1u) * nloc) {
            __builtin_amdgcn_fence(__ATOMIC_RELEASE, "agent");
            asm volatile("s_waitcnt vmcnt(0)" ::: "memory");
            const unsigned og = xb_add(&bar[XB_TOP], 1u);
            const unsigned tg = og / nx;
            if (og + 1u == (tg + 1u) * nx) xb_add(&bar[XB_TOPGEN], 1u);
            else XB_SPIN(xb_ld(&bar[XB_TOPGEN]) == tg, bar);
            __builtin_amdgcn_fence(__ATOMIC_ACQUIRE, "agent");
            xb_add(&bar[XB_XGEN(b.x)], 1u);
            asm volatile("s_waitcnt vmcnt(0)" ::: "memory");
        } else {
            XB_SPIN(xb_ld(&bar[XB_XGEN(b.x)]) == gen, bar);
            __builtin_amdgcn_fence(__ATOMIC_ACQUIRE, "agent");
            asm volatile("s_waitcnt vmcnt(0)" ::: "memory");
        }
    }
    __syncthreads();
}

__device__ __forceinline__ void subset_barrier(unsigned* cnt, unsigned n) {
    asm volatile("s_waitcnt vmcnt(0)" ::: "memory");
    __syncthreads();
    if (threadIdx.x == 0) {
        __builtin_amdgcn_fence(__ATOMIC_RELEASE, "agent");
        asm volatile("s_waitcnt vmcnt(0)" ::: "memory");
        __hip_atomic_fetch_add(cnt, 1u, __ATOMIC_RELAXED, __HIP_MEMORY_SCOPE_AGENT);
        unsigned sp = 0;
        while (__hip_atomic_load(cnt, __ATOMIC_RELAXED, __HIP_MEMORY_SCOPE_AGENT) < n) { __builtin_amdgcn_s_sleep(1); if (++sp > (1u << 24)) break; }
        __builtin_amdgcn_fence(__ATOMIC_ACQUIRE, "agent");
        asm volatile("s_waitcnt vmcnt(0)" ::: "memory");
    }
    __syncthreads();
}
__device__ __forceinline__ void subset_wait(unsigned* cnt, unsigned n) {
    __syncthreads();
    if (threadIdx.x == 0) {
        unsigned sp = 0;
        while (__hip_atomic_load(cnt, __ATOMIC_RELAXED, __HIP_MEMORY_SCOPE_AGENT) < n) { __builtin_amdgcn_s_sleep(2); if (++sp > (1u << 24)) break; }
        __builtin_amdgcn_fence(__ATOMIC_ACQUIRE, "agent");
        asm volatile("s_waitcnt vmcnt(0)" ::: "memory");
    }
    __syncthreads();
}
constexpr int NPHASES = 11;
__global__ void __launch_bounds__(NTHREADS, 2) mega_fwd(Params p) {
    extern __shared__ __attribute__((aligned(16))) unsigned char lds[];
    cg::grid_group grid = cg::this_grid();
    const int lo = p.ph_lo, hi = p.ph_hi;
#ifndef PHASE_MASK
#define PHASE_MASK 0x7ff
#endif
#define IN(k) (((PHASE_MASK >> (k)) & 1) && lo <= (k) && (k) < hi)
#define SEAM(k) do { if (IN(k) && IN((k) + 1)) { if ((k) == 0) grid.sync(); else xcd_barrier(xbar); } } while (0)
    unsigned char* ws = p.ws;
    bf16_t* P = (bf16_t*)(ws + WS_P);
    bf16_t* Hb = (bf16_t*)((unsigned char*)p.out + OUT_H);
    bf16_t* WinT = (bf16_t*)((unsigned char*)p.out + OUT_WIN);
    const float* mod = (const float*)(ws + WS_MOD);
    LAS unsigned char* ldsl = (LAS unsigned char*)lds;
    volatile LAS unsigned* xst = (volatile LAS unsigned*)(ldsl + LDS_BYTES - 64);
    if (threadIdx.x < 2) xst[threadIdx.x] = 0u;
    __syncthreads();
    XcdBarrier xbar = xcd_barrier_post((unsigned*)(ws + WS_CTL) + 4096, xst);

#ifndef REPEAT_PHASE
#define REPEAT_PHASE -1
#endif
    int rep3 = 0;
#define RUNPH(k, ...) do { if (IN(k)) { __VA_ARGS__; if (REPEAT_PHASE == (k)) { grid.sync(); __VA_ARGS__; } } } while (0)
    RUNPH(0, { phase_mod(p, lds); __syncthreads(); phase_weights(p, lds); });
    SEAM(0);
    RUNPH(1, { phase_norm_rows(p.in[0], p.in[4], mod, mod + 2048, Hb, LDP); });
    SEAM(1);
    RUNPH(2, { pg8::Gemm g{Hb, WinT, nullptr, nullptr, LDP, LDP, T, NP, D}; pg8::StaticOrder<1> S; S.init(T, NP, gridDim.x, blockIdx.x);
        pg8::EpiBf16 E{P, NP, 33}; pg8::gemm_phase(ldsl, g, S, E); });
    SEAM(2);
    RUNPH(3, { const int G = gridDim.x, bx = blockIdx.x;
        unsigned* sbar = (unsigned*)(ws + WS_CTL) + 12288 + ((REPEAT_PHASE == 3) ? 64 * rep3 : 0); unsigned* qh = sbar + 16;
        if (G >= 128) { if (bx < 64) { phase_hgrn(p, lds, bx, 64); if (REPEAT_PHASE == 32) phase_hgrn(p, lds, bx, 64); subset_wait(sbar, (unsigned)(G - 64)); phase_attn_queue(p, lds, qh); }
                        else { phase_vt(p, lds, bx - 64, G - 64); phase_indexer(p, lds, bx - 64, G - 64); if (REPEAT_PHASE == 31) phase_indexer(p, lds, bx - 64, G - 64);
                               subset_barrier(sbar, (unsigned)(G - 64)); phase_attn_queue(p, lds, qh); } }
        else { phase_vt(p, lds, bx, G); phase_indexer(p, lds, bx, G); __syncthreads(); phase_hgrn(p, lds, bx, G); grid.sync(); phase_attn(p, lds, bx, G); }
        ++rep3; });
    SEAM(3);
    RUNPH(5, { pg8::Gemm g{(const bf16_t*)((unsigned char*)p.out + OUT_AO), (const bf16_t*)(ws + WS_WUA), (const bf16_t*)((unsigned char*)p.out + OUT_REC), (const bf16_t*)(ws + WS_WUB), 1024, 1024, T, D, 1024}; pg8::StaticOrder<2> S; S.init(T, D, gridDim.x, blockIdx.x);
        pg8::EpiMix E{(bf16_t*)(ws + WS_MIXED), P}; pg8::gemm_phase(ldsl, g, S, E); });
    SEAM(5);
    RUNPH(6, { pg8::Gemm g{(const bf16_t*)(ws + WS_MIXED), (const bf16_t*)(ws + WS_WOUT), nullptr, nullptr, D, D, T, D, D}; pg8::StaticOrder<1> S; S.init(T, D, gridDim.x, blockIdx.x);
        pg8::EpiX1 E{p.in[0], (float*)(ws + WS_X1), mod + 4096}; pg8::gemm_phase(ldsl, g, S, E); });
    SEAM(6);
    RUNPH(7, { phase_norm_rows((const float*)(ws + WS_X1), p.in[5], mod + 3 * 2048, mod + 4 * 2048, (bf16_t*)(ws + WS_H2), D); phase_uv(p); });
    SEAM(7);
    RUNPH(8, { pg8::Gemm g{(const bf16_t*)(ws + WS_H2), (const bf16_t*)(ws + WS_WQ), nullptr, nullptr, D, D, T, D, D}; pg8::StaticOrder<1> S; S.init(T, D, gridDim.x, blockIdx.x);
        pg8::EpiBf16 E{(bf16_t*)(ws + WS_QP), D, 1 << 30}; pg8::gemm_phase(ldsl, g, S, E); });
    SEAM(8);
    RUNPH(9, { phase_peer_topk_ni((const GAS bf16_t*)(ws + WS_QP), (const GAS bf16_t*)(ws + WS_KEYS), (GAS int*)(ws + WS_EIDX), (GAS float*)(ws + WS_EGATE), ldsl); });
    SEAM(9);
    RUNPH(10, { phase_experts(p, lds); });
#undef IN
#undef SEAM
}

#ifndef MK_N_LAUNCHES
#define MK_N_LAUNCHES 1
#endif
extern "C" void kernel_launch(void* const* d_in, const int* in_sizes, int n_in, void* d_out, int out_size, void* d_ws, size_t ws_size, hipStream_t stream) {
    static int grid = 0;
    if (grid == 0) {
        if (n_in != 17 || out_size != T * D || ws_size < WS_END) { fprintf(stderr, "kernel_launch: unexpected shapes (n_in %d out %d ws %zu)\n", n_in, out_size, ws_size); grid = -1; return; }
        int dev = 0, cus = 0, per_cu = 0;
        hipGetDevice(&dev); hipDeviceGetAttribute(&cus, hipDeviceAttributeMultiprocessorCount, dev);
        hipFuncSetAttribute((const void*)mega_fwd, hipFuncAttributeMaxDynamicSharedMemorySize, LDS_BYTES);
        hipOccupancyMaxActiveBlocksPerMultiprocessor(&per_cu, (const void*)mega_fwd, NTHREADS, LDS_BYTES);
        if (per_cu < 1) { fprintf(stderr, "kernel_launch: occupancy query says %d blocks/CU\n", per_cu); per_cu = 1; }
        (void)hipGetLastError();
        grid = cus * 1;
    }
    if (grid < 0) return;
    if (hipMemsetAsync((char*)d_ws + WS_CTL, 0, 65536, stream) != hipSuccess) { fprintf(stderr, "kernel_launch: memset failed\n"); return; }
    Params p{};
    for (int i = 0; i < 17; ++i) p.in[i] = (const float*)d_in[i];
    p.out = (float*)d_out; p.ws = (unsigned char*)d_ws;
#if MK_N_LAUNCHES == 1
    p.ph_lo = 0; p.ph_hi = NPHASES;
    void* args[] = {&p};
    hipError_t e = hipLaunchCooperativeKernel((const void*)mega_fwd, dim3(grid), dim3(NTHREADS), args, LDS_BYTES, stream);
    if (e != hipSuccess) fprintf(stderr, "cooperative launch failed: %s (grid %d)\n", hipGetErrorString(e), grid);
#else
    for (int k = 0; k < NPHASES; ++k) { p.ph_lo = k; p.ph_hi = k + 1; void* args[] = {&p};
        hipError_t e = hipLaunchCooperativeKernel((const void*)mega_fwd, dim3(grid), dim3(NTHREADS), args, LDS_BYTES, stream);
        if (e != hipSuccess) { fprintf(stderr, "launch %d failed: %s\n", k, hipGetErrorString(e)); break; } }
#endif
}
```

```cpp
#include <hip/hip_runtime.h>
#include <hip/hip_cooperative_groups.h>
#include <cstdio>
#include <cstdint>
namespace cg = cooperative_groups;

#define LAS __attribute__((address_space(3)))
typedef unsigned short bf16_t;
typedef short bf16x8 __attribute__((ext_vector_type(8)));
typedef short bf16x4 __attribute__((ext_vector_type(4)));
typedef float f32x2 __attribute__((ext_vector_type(2)));
typedef float f32x4 __attribute__((ext_vector_type(4)));
typedef float f32x16 __attribute__((ext_vector_type(16)));
typedef unsigned u32x2 __attribute__((ext_vector_type(2)));
typedef unsigned u32x4 __attribute__((ext_vector_type(4)));

constexpr int T = 16384, D = 2048, SEQ = 2048, NBATCH = 8, NP = 12544;
constexpr int C_QA = 0, C_KA = 1024, C_VA = 2048, C_QI = 3072, C_KI = 4096, C_WI = 4160, C_QB = 4352, C_FB = 5376, C_IB = 6400, C_GB = 7424, C_GA = 8448, C_GG = 10496;
constexpr int NADA = 12288;
constexpr float NORM_EPS = 1e-6f;
constexpr int NTHREADS = 512, NWAVES = 8;
constexpr int LDS_BYTES = 147456;
constexpr size_t MiB = 1u << 20;
constexpr size_t WS_CTL = 0, WS_MOD = 1 * MiB, WS_WUA = 2 * MiB, WS_WUB = 6 * MiB, WS_WOUT = 10 * MiB, WS_WQ = 18 * MiB, WS_KEYS = 26 * MiB, WS_MASK = 27 * MiB;
constexpr size_t WS_MIXED = 32 * MiB;
constexpr size_t WS_VT = 32 * MiB, WS_ORAW = 64 * MiB;
constexpr size_t WS_P = 96 * MiB;
constexpr size_t WS_H2 = 96 * MiB, WS_QP = 160 * MiB, WS_U8 = 224 * MiB, WS_V8 = 256 * MiB, WS_ISU = 26 * MiB + 512 * 1024, WS_ISV = 26 * MiB + 768 * 1024, WS_Y = 288 * MiB, WS_EIDX = 352 * MiB, WS_EGATE = 360 * MiB;
constexpr size_t WS_X1 = 368 * MiB;
constexpr size_t WS_END = 496 * MiB;
constexpr int LDP = 2048 + 64;
constexpr size_t OUT_H = 0, OUT_WIN = 68 * MiB;
constexpr size_t OUT_AO = 0, OUT_REC = 32 * MiB;

struct Params { const float* in[17]; float* out; unsigned char* ws; int ph_lo, ph_hi; };

__device__ __forceinline__ unsigned f2bf(float f) { unsigned u = __float_as_uint(f); return (u + 0x7fffu + ((u >> 16) & 1u)) >> 16; }
__device__ __forceinline__ float bf2f(unsigned b) { return __uint_as_float(b << 16); }
__device__ __forceinline__ float bflo(unsigned w) { return __uint_as_float(w << 16); }
__device__ __forceinline__ float bfhi(unsigned w) { return __uint_as_float(w & 0xffff0000u); }
__device__ __forceinline__ unsigned pk2(float lo, float hi) { unsigned r; asm volatile("v_cvt_pk_bf16_f32 %0, %1, %2" : "=v"(r) : "v"(lo), "v"(hi)); return r; }
__device__ __forceinline__ float wave_sum(float v) {
#pragma unroll
    for (int o = 1; o < 64; o <<= 1) v += __shfl_xor(v, o);
    return v;
}
__device__ __forceinline__ float sigmoidf_(float v) { return 1.f / (1.f + __expf(-v)); }
__device__ __forceinline__ float siluf_(float v) { return v / (1.f + __expf(-v)); }
#define LDS_WAIT() asm volatile("s_waitcnt lgkmcnt(0)" ::: "memory")

namespace pg8 {
constexpr int BM = 256, BK = 64, HALF = 128, HTB = HALF * BK * 2, STAGE_BYTES = 8 * HTB, NXCD = 8, WGM = 8;
__host__ __device__ __forceinline__ int lds_byte(int r, int c) { const int st = (r >> 4) * 2 + (c >> 5), rr = r & 15, cc = c & 31, ob = rr * 64 + cc * 2; return st * 1024 + (ob ^ (((ob >> 9) & 1) << 5)); }
__host__ __device__ __forceinline__ void stage_rc(int b, int& R, int& C) { const int st = b / 1024, sb = b % 1024, swz = sb ^ (((sb >> 9) & 1) << 5); R = (st >> 1) * 16 + swz / 64; C = (st & 1) * 32 + (swz % 64) / 2; }
__host__ __device__ __forceinline__ int perm32(int rho) { const int n = rho >> 4, i = rho & 15; return 8 * (i >> 2) + 4 * n + (i & 3); }

struct Unit { int pm, pn, z; };
struct Gemm { const bf16_t* A; const bf16_t* Bt; const bf16_t* A2; const bf16_t* Bt2; int lda, ldb, M, N, K; };

template <int NZ> struct StaticOrder {
    int nM, nN, nwg, G, c;
    __device__ void init(int M, int N, int G_, int c_) { nM = M / BM; nN = N / BM; nwg = nM * nN; G = G_; c = c_; }
    __device__ bool next(int i, Unit& u) const {
        const long L = (long)(i / NZ) * G + c; if (L >= nwg) return false;
        int wgid = (int)L; { const int q = nwg / NXCD, r = nwg % NXCD, xcd = wgid % NXCD, off = wgid / NXCD; wgid = (xcd < r ? xcd * (q + 1) : r * (q + 1) + (xcd - r) * q) + off; }
        const int nig = WGM * nN, gid = wgid / nig, fm = gid * WGM, gsz = (nM - fm) < WGM ? (nM - fm) : WGM;
        u.pm = fm + ((wgid % nig) % gsz); u.pn = (wgid % nig) / gsz; u.z = i % NZ; return true;
    }
};

template <class Epi, class Sched>
__device__ __forceinline__ void gemm_phase(LAS unsigned char* lds, const Gemm g, const Sched& S, const Epi& E) {
    const int tid = threadIdx.x, wid = __builtin_amdgcn_readfirstlane(tid >> 6), lane = tid & 63, wr = wid >> 2, wc = wid & 3, fr = lane & 15, fq = lane >> 4;
    const int K = g.K, nt = K / BK;
    unsigned voffA[2], voffB[2];
#pragma unroll
    for (int i = 0; i < 2; ++i) { int R, C; stage_rc(tid * 16 + i * 8192, R, C); const int Rb = Epi::PERM ? ((R & ~31) + perm32(R & 31)) : R;
        voffA[i] = (unsigned)(R * g.lda + C) * 2u; voffB[i] = (unsigned)(Rb * g.ldb + C) * 2u; }
    const size_t kstep = (size_t)(BK * 2);
    const size_t hstepA = (size_t)HALF * g.lda * 2, hstepB = (size_t)HALF * g.ldb * 2;
    const size_t tstepA = 2 * hstepA, tstepB = 2 * hstepB;
    const unsigned ldsw = (unsigned)wid * 1024u;
    const int aoff = lds_byte(wr * 64 + fr, fq * 8), boff = lds_byte(wc * 32 + fr, fq * 8);
#define PG8_SA(b, h) (((b) * 2 + (h)) * HTB)
#define PG8_SB(b, h) ((4 + (b) * 2 + (h)) * HTB)
#define PG8_STAGE(bufoff, gbase, voff) do { _Pragma("unroll") for (int _i = 0; _i < 2; ++_i) \
        __builtin_amdgcn_global_load_lds((const unsigned*)((const char*)(gbase) + (voff)[_i]), (LAS unsigned*)(lds + (bufoff) + ldsw + _i * 8192), 16, 0, 0); } while (0)
#define PG8_LDA(dst, b, h) do { _Pragma("unroll") for (int m = 0; m < 4; ++m) _Pragma("unroll") for (int k = 0; k < 2; ++k) dst[m][k] = *(const LAS bf16x8*)(lds + PG8_SA(b, h) + aoff + m * 2048 + k * 1024); } while (0)
#define PG8_LDB(dst, b, h) do { _Pragma("unroll") for (int n = 0; n < 2; ++n) _Pragma("unroll") for (int k = 0; k < 2; ++k) dst[n][k] = *(const LAS bf16x8*)(lds + PG8_SB(b, h) + boff + n * 2048 + k * 1024); } while (0)
#define PG8_MMA(ai, bj, At, Bt) do { __builtin_amdgcn_s_setprio(1); _Pragma("unroll") for (int m = 0; m < 4; ++m) _Pragma("unroll") for (int n = 0; n < 2; ++n) _Pragma("unroll") for (int k = 0; k < 2; ++k) \
        acc[ai][bj][m][n] = __builtin_amdgcn_mfma_f32_16x16x32_bf16(Bt[n][k], At[m][k], acc[ai][bj][m][n], 0, 0, 0); __builtin_amdgcn_s_setprio(0); } while (0)
#define PG8_WAIT_V(n) asm volatile("s_waitcnt vmcnt(" #n ")" ::: "memory")
#define PG8_WAIT_L(n) asm volatile("s_waitcnt lgkmcnt(" #n ")" ::: "memory")
#define PG8_BAR __builtin_amdgcn_s_barrier()
#define PG8_SCHED __builtin_amdgcn_sched_barrier(0)
#define PG8_ABASE(u) ((const char*)((u).z ? g.A2 : g.A) + (size_t)(u).pm * tstepA)
#define PG8_BBASE(u) ((const char*)((u).z ? g.Bt2 : g.Bt) + (size_t)(u).pn * tstepB)
    Unit cur, nxt; int ui = 0;
    if (!S.next(0, cur)) return;
    f32x4 acc[2][2][4][2];
#pragma unroll
    for (int a = 0; a < 2; ++a)
#pragma unroll
        for (int b = 0; b < 2; ++b)
#pragma unroll
            for (int m = 0; m < 4; ++m)
#pragma unroll
                for (int n = 0; n < 2; ++n) acc[a][b][m][n] = (f32x4){0.f, 0.f, 0.f, 0.f};
    bf16x8 At[4][2], B0[2][2], B1[2][2];
    const char* cA = PG8_ABASE(cur); const char* cB = PG8_BBASE(cur);
    PG8_STAGE(PG8_SB(0, 0), cB, voffB); PG8_STAGE(PG8_SA(0, 0), cA, voffA); PG8_STAGE(PG8_SB(0, 1), cB + hstepB, voffB); PG8_STAGE(PG8_SA(0, 1), cA + hstepA, voffA);
    if (wr == 1) PG8_BAR;
    PG8_WAIT_V(4); PG8_BAR;
    PG8_STAGE(PG8_SB(1, 0), cB + kstep, voffB); PG8_STAGE(PG8_SA(1, 0), cA + kstep, voffA); PG8_STAGE(PG8_SB(1, 1), cB + hstepB + kstep, voffB);
    PG8_WAIT_V(6); PG8_BAR;
    for (;;) {
        const bool has_next = S.next(ui + 1, nxt);
        const char* nA = has_next ? PG8_ABASE(nxt) : cA; const char* nB = has_next ? PG8_BBASE(nxt) : cB;
        for (int t = 0; t < nt; t += 2) {
            const bool last = (t == nt - 2);
            const char* a1 = cA + (size_t)(t + 1) * kstep;
            const char* a2 = last ? nA : cA + (size_t)(t + 2) * kstep; const char* b2 = last ? nB : cB + (size_t)(t + 2) * kstep;
            const char* a3 = a2 + kstep; const char* b3 = b2 + kstep;
            PG8_LDB(B0, 0, 0); PG8_SCHED; PG8_LDA(At, 0, 0); PG8_STAGE(PG8_SA(1, 1), a1 + hstepA, voffA);
            PG8_WAIT_L(8); PG8_BAR; PG8_WAIT_L(0); PG8_MMA(0, 0, At, B0); PG8_BAR; PG8_SCHED;
            PG8_LDB(B1, 0, 1); PG8_STAGE(PG8_SB(0, 0), b2, voffB);
            PG8_BAR; PG8_WAIT_L(0); PG8_MMA(0, 1, At, B1); PG8_BAR;
            PG8_LDA(At, 0, 1); PG8_STAGE(PG8_SA(0, 0), a2, voffA);
            PG8_BAR; PG8_WAIT_L(0); PG8_MMA(1, 0, At, B0); PG8_BAR; PG8_SCHED;
            PG8_STAGE(PG8_SB(0, 1), b2 + hstepB, voffB);
            PG8_WAIT_V(6); PG8_BAR; PG8_MMA(1, 1, At, B1); PG8_BAR;
            PG8_LDB(B0, 1, 0); PG8_SCHED; PG8_LDA(At, 1, 0); PG8_STAGE(PG8_SA(0, 1), a2 + hstepA, voffA);
            PG8_WAIT_L(8); PG8_BAR; PG8_WAIT_L(0); PG8_MMA(0, 0, At, B0); PG8_BAR; PG8_SCHED;
            PG8_LDB(B1, 1, 1); PG8_STAGE(PG8_SB(1, 0), b3, voffB);
            PG8_BAR; PG8_WAIT_L(0); PG8_MMA(0, 1, At, B1); PG8_BAR;
            PG8_LDA(At, 1, 1); PG8_STAGE(PG8_SA(1, 0), a3, voffA);
            PG8_BAR; PG8_WAIT_L(0); PG8_MMA(1, 0, At, B0); PG8_BAR; PG8_SCHED;
            PG8_STAGE(PG8_SB(1, 1), b3 + hstepB, voffB);
            PG8_WAIT_V(6); PG8_BAR; PG8_MMA(1, 1, At, B1); PG8_BAR;
        }
        E(acc, cur, wr, wc, fr, fq);
        if (!has_next) break;
#pragma unroll
        for (int a = 0; a < 2; ++a)
#pragma unroll
            for (int b = 0; b < 2; ++b)
#pragma unroll
                for (int m = 0; m < 4; ++m)
#pragma unroll
                    for (int n = 0; n < 2; ++n) acc[a][b][m][n] = (f32x4){0.f, 0.f, 0.f, 0.f};
        cur = nxt; cA = nA; cB = nB; ++ui;
    }
    PG8_WAIT_V(0);
    if (wr == 0) PG8_BAR;
    PG8_BAR;
#undef PG8_SA
#undef PG8_SB
#undef PG8_STAGE
#undef PG8_LDA
#undef PG8_LDB
#undef PG8_MMA
#undef PG8_WAIT_V
#undef PG8_WAIT_L
#undef PG8_BAR
#undef PG8_SCHED
#undef PG8_ABASE
#undef PG8_BBASE
}

struct EpiBf16 {
    static constexpr bool PERM = true;
    bf16_t* O; int ldc; int sig_from;
    __device__ __forceinline__ void operator()(const f32x4 (&acc)[2][2][4][2], const Unit& u, int wr, int wc, int fr, int fq) const {
        const int row0 = u.pm * BM + wr * 64 + fr, col0 = u.pn * BM + wc * 32 + 8 * fq; const bool sig = u.pn >= sig_from;
#pragma unroll
        for (int ai = 0; ai < 2; ++ai)
#pragma unroll
            for (int m = 0; m < 4; ++m) { bf16_t* rowp = O + (size_t)(row0 + ai * HALF + m * 16) * ldc + col0;
#pragma unroll
                for (int bj = 0; bj < 2; ++bj) { f32x4 v0 = acc[ai][bj][m][0], v1 = acc[ai][bj][m][1];
                    if (sig) {
#pragma unroll
                        for (int j = 0; j < 4; ++j) { v0[j] = sigmoidf_(v0[j]); v1[j] = sigmoidf_(v1[j]); } }
                    u32x4 w; w.x = pk2(v0[0], v0[1]); w.y = pk2(v0[2], v0[3]); w.z = pk2(v1[0], v1[1]); w.w = pk2(v1[2], v1[3]);
                    *(u32x4*)(rowp + bj * HALF) = w; } }
    }
};
struct EpiMix {
    static constexpr bool PERM = true;
    bf16_t* O; const bf16_t* P;
    __device__ __forceinline__ void operator()(const f32x4 (&acc)[2][2][4][2], const Unit& u, int wr, int wc, int fr, int fq) const {
        const int row0 = u.pm * BM + wr * 64 + fr, col0 = u.pn * BM + wc * 32 + 8 * fq; const int gcol = (u.z ? C_GG : C_GA);
#pragma unroll
        for (int ai = 0; ai < 2; ++ai) {
            u32x4 gw[4][2], pw[4][2];
#pragma unroll
            for (int m = 0; m < 4; ++m)
#pragma unroll
                for (int bj = 0; bj < 2; ++bj) { const size_t r = (size_t)(row0 + ai * HALF + m * 16);
                    gw[m][bj] = *(const u32x4*)(P + r * NP + gcol + col0 + bj * HALF);
                    if (u.z) pw[m][bj] = *(const u32x4*)(O + r * D + col0 + bj * HALF); else pw[m][bj] = (u32x4){0u, 0u, 0u, 0u}; }
            asm volatile("" ::: "memory");
#pragma unroll
            for (int m = 0; m < 4; ++m)
#pragma unroll
                for (int bj = 0; bj < 2; ++bj) { const size_t r = (size_t)(row0 + ai * HALF + m * 16); const f32x4 v0 = acc[ai][bj][m][0], v1 = acc[ai][bj][m][1]; const u32x4 g = gw[m][bj], q = pw[m][bj];
                    u32x4 w; w.x = pk2(fmaf(v0[0], bflo(g.x), bflo(q.x)), fmaf(v0[1], bfhi(g.x), bfhi(q.x))); w.y = pk2(fmaf(v0[2], bflo(g.y), bflo(q.y)), fmaf(v0[3], bfhi(g.y), bfhi(q.y)));
                    w.z = pk2(fmaf(v1[0], bflo(g.z), bflo(q.z)), fmaf(v1[1], bfhi(g.z), bfhi(q.z))); w.w = pk2(fmaf(v1[2], bflo(g.w), bflo(q.w)), fmaf(v1[3], bfhi(g.w), bfhi(q.w)));
                    *(u32x4*)(O + r * D + col0 + bj * HALF) = w; }
            asm volatile("" ::: "memory");
        }
    }
};
struct EpiX1 {
    static constexpr bool PERM = false;
    const float* x; float* out; const float* gate;
    __device__ __forceinline__ void operator()(const f32x4 (&acc)[2][2][4][2], const Unit& u, int wr, int wc, int fr, int fq) const {
        const int row0 = u.pm * BM + wr * 64 + fr, col0 = u.pn * BM + wc * 32 + 4 * fq; const int b = (u.pm * BM) >> 11;
        f32x4 gv[2][2];
#pragma unroll
        for (int bj = 0; bj < 2; ++bj)
#pragma unroll
            for (int n = 0; n < 2; ++n) gv[bj][n] = *(const f32x4*)(gate + (size_t)b * NADA + col0 + bj * HALF + n * 16);
#pragma unroll
        for (int ai = 0; ai < 2; ++ai) {
            f32x4 xv[4][2][2];
#pragma unroll
            for (int m = 0; m < 4; ++m)
#pragma unroll
                for (int bj = 0; bj < 2; ++bj)
#pragma unroll
                    for (int n = 0; n < 2; ++n) xv[m][bj][n] = *(const f32x4*)(x + (size_t)(row0 + ai * HALF + m * 16) * D + col0 + bj * HALF + n * 16);
            asm volatile("" ::: "memory");
#pragma unroll
            for (int m = 0; m < 4; ++m)
#pragma unroll
                for (int bj = 0; bj < 2; ++bj)
#pragma unroll
                    for (int n = 0; n < 2; ++n) *(f32x4*)(out + (size_t)(row0 + ai * HALF + m * 16) * D + col0 + bj * HALF + n * 16) = xv[m][bj][n] + gv[bj][n] * acc[ai][bj][m][n];
            asm volatile("" ::: "memory");
        }
    }
};
}

__device__ __forceinline__ void phase_mod(const Params& p, unsigned char* lds) {
    float* sc = (float*)lds;
    float* red = (float*)(lds + 65536);
    const int tid = threadIdx.x, wave = tid >> 6, lane = tid & 63;
    const float* c = p.in[1]; const float* wada = p.in[2]; const float* bada = p.in[3];
    float* mod = (float*)(p.ws + WS_MOD);
    if ((int)blockIdx.x >= 192) return;
    for (int i = tid; i < NBATCH * D; i += NTHREADS) { const int b = i >> 11, k = i & 2047; sc[k * 8 + b] = siluf_(c[i]); }
    __syncthreads();
    const int cgp = tid & 15, rg = tid >> 4;
    for (int item = blockIdx.x; item < 192; item += gridDim.x) {
        const float* w = wada + item * 64 + cgp * 4;
        float acc[8][4];
#pragma unroll
        for (int b = 0; b < 8; ++b)
#pragma unroll
            for (int j = 0; j < 4; ++j) acc[b][j] = 0.f;
#pragma unroll 1
        for (int i0 = 0; i0 < 64; i0 += 8) {
            f32x4 wvv[8];
#pragma unroll
            for (int u = 0; u < 8; ++u) wvv[u] = __builtin_nontemporal_load((const f32x4*)(w + (size_t)(rg + 32 * (i0 + u)) * NADA));
#pragma unroll
            for (int u = 0; u < 8; ++u) { const int k = rg + 32 * (i0 + u); const f32x4 wv = wvv[u];
                const f32x4 s0 = *(const f32x4*)(sc + k * 8), s1 = *(const f32x4*)(sc + k * 8 + 4);
#pragma unroll
                for (int j = 0; j < 4; ++j) { acc[0][j] += s0[0] * wv[j]; acc[1][j] += s0[1] * wv[j]; acc[2][j] += s0[2] * wv[j]; acc[3][j] += s0[3] * wv[j];
                    acc[4][j] += s1[0] * wv[j]; acc[5][j] += s1[1] * wv[j]; acc[6][j] += s1[2] * wv[j]; acc[7][j] += s1[3] * wv[j]; } } }
#pragma unroll
        for (int b = 0; b < 8; ++b)
#pragma unroll
            for (int j = 0; j < 4; ++j) { float v = acc[b][j]; v += __shfl_xor(v, 16); v += __shfl_xor(v, 32); acc[b][j] = v; }
        if (lane < 16) {
#pragma unroll
            for (int b = 0; b < 8; ++b)
#pragma unroll
                for (int j = 0; j < 4; ++j) red[(wave * 16 + cgp) * 32 + b * 4 + j] = acc[b][j]; }
        __syncthreads();
        { const int cgo = tid >> 5, b = (tid >> 2) & 7, j = tid & 3; float s = 0.f;
#pragma unroll
          for (int w8 = 0; w8 < 8; ++w8) s += red[(w8 * 16 + cgo) * 32 + (tid & 31)];
          const int col = item * 64 + cgo * 4 + j; mod[b * NADA + col] = s + bada[col]; }
        __syncthreads();
    }
}
__device__ __forceinline__ void transpose_item(const float* W, int K, int N, bf16_t* WT, int nblk, int item, int lane, float* scr, int mode, int pitch) {
    const int kb = item / nblk, nb = item % nblk, k0 = 64 * kb, n0 = 32 * nb;
    const int nd = n0 + (lane & 31); int ns = nd; bool valid = true;
    if (mode == 1) { if (nd >= C_QB) ns = nd - 176; else if (nd >= 4176) valid = false; }
    if (mode == 0 || n0 < 4160 || n0 >= C_QB) {
        const int ns0 = (mode == 1 && n0 >= C_QB) ? n0 - 176 : n0;
        f32x4 v[8];
#pragma unroll
        for (int i = 0; i < 8; ++i) v[i] = *(const f32x4*)(W + (size_t)(k0 + 8 * i + (lane >> 3)) * N + ns0 + 4 * (lane & 7));
#pragma unroll
        for (int i = 0; i < 8; ++i) { float* d = scr + (8 * i + (lane >> 3)) * 33 + 4 * (lane & 7); d[0] = v[i][0]; d[1] = v[i][1]; d[2] = v[i][2]; d[3] = v[i][3]; }
    } else {
#pragma unroll 8
        for (int i = 0; i < 32; ++i) { const int kk = 2 * i + (lane >> 5); scr[kk * 33 + (lane & 31)] = valid ? W[(size_t)(k0 + kk) * N + ns] : 0.f; }
    }
    LDS_WAIT();
    const int c = lane & 7;
#pragma unroll
    for (int j = 0; j < 4; ++j) { const int n = (lane >> 3) + 8 * j; const float* s = scr + (8 * c) * 33 + n;
        u32x4 o; o.x = pk2(s[0 * 33], s[1 * 33]); o.y = pk2(s[2 * 33], s[3 * 33]); o.z = pk2(s[4 * 33], s[5 * 33]); o.w = pk2(s[6 * 33], s[7 * 33]);
        *(u32x4*)(WT + (size_t)(n0 + n) * pitch + k0 + 8 * c) = o; }
    LDS_WAIT();
}
__device__ __forceinline__ void phase_weights(const Params& p, unsigned char* lds) {
    const int tid = threadIdx.x, wave = tid >> 6, lane = tid & 63;
    float* scr = (float*)(lds + wave * 16384);
    const int vb = ((int)blockIdx.x + (int)gridDim.x - 192 % (int)gridDim.x) % (int)gridDim.x;
    const int gw = vb * NWAVES + wave, NGW = gridDim.x * NWAVES;
    constexpr int I_IN = 32 * (NP / 32), I_UA = 16 * 64, I_UB = 16 * 64, I_O = 32 * 64, I_Q = 32 * 64;
    constexpr int NITEMS = I_IN + I_UA + I_UB + I_O + I_Q;
    bf16_t* win_t = (bf16_t*)((unsigned char*)p.out + OUT_WIN);
    for (int it = gw; it < NITEMS; it += NGW) {
        int r = it;
        if (r < I_IN) { transpose_item(p.in[6], 2048, 12368, win_t, NP / 32, r, lane, scr, 1, LDP); continue; } r -= I_IN;
        if (r < I_UA) { transpose_item(p.in[9], 1024, 2048, (bf16_t*)(p.ws + WS_WUA), 64, r, lane, scr, 0, 1024); continue; } r -= I_UA;
        if (r < I_UB) { transpose_item(p.in[10], 1024, 2048, (bf16_t*)(p.ws + WS_WUB), 64, r, lane, scr, 0, 1024); continue; } r -= I_UB;
        if (r < I_O) { transpose_item(p.in[11], 2048, 2048, (bf16_t*)(p.ws + WS_WOUT), 64, r, lane, scr, 0, 2048); continue; } r -= I_O;
        transpose_item(p.in[12], 2048, 2048, (bf16_t*)(p.ws + WS_WQ), 64, r, lane, scr, 0, 2048);
    }
    { const float* ks = p.in[13]; bf16_t* kd = (bf16_t*)(p.ws + WS_KEYS);
      for (int i = (blockIdx.x * NTHREADS + tid) * 4; i < 8 * 2 * 128 * 128; i += gridDim.x * NTHREADS * 4) { const f32x4 v = *(const f32x4*)(ks + i); u32x2 o; o.x = pk2(v[0], v[1]); o.y = pk2(v[2], v[3]); *(u32x2*)(kd + i) = o; } }
}

__device__ __forceinline__ void phase_norm_rows(const float* src, const float* gain, const float* shift, const float* scale, bf16_t* dst, int pitch) {
    const int tid = threadIdx.x, wave = tid >> 6, lane = tid & 63;
    const int gw = blockIdx.x * NWAVES + wave, NGW = gridDim.x * NWAVES;
    for (int row = gw; row < T; row += NGW) {
        const int b = row >> 11; const f32x4* xr = (const f32x4*)(src + (size_t)row * D) + lane;
        f32x4 v[8]; float ss = 0.f;
#pragma unroll
        for (int j = 0; j < 8; ++j) { v[j] = xr[64 * j]; ss += (v[j][0] * v[j][0] + v[j][1] * v[j][1]) + (v[j][2] * v[j][2] + v[j][3] * v[j][3]); }
        const float rstd = rsqrtf(wave_sum(ss) * (1.f / D) + NORM_EPS);
        u32x2* o8 = (u32x2*)(dst + (size_t)row * pitch) + lane;
#pragma unroll
        for (int j = 0; j < 8; ++j) { const int col = 4 * (lane + 64 * j);
            const f32x4 g = *(const f32x4*)(gain + col), sh = *(const f32x4*)(shift + (size_t)b * NADA + col), sc = *(const f32x4*)(scale + (size_t)b * NADA + col);
            f32x4 h;
#pragma unroll
            for (int e = 0; e < 4; ++e) h[e] = v[j][e] * rstd * g[e] * (1.f + sc[e]) + sh[e];
            u32x2 w; w.x = pk2(h[0], h[1]); w.y = pk2(h[2], h[3]); o8[64 * j] = w; }
    }
}

__device__ __forceinline__ void phase_vt(const Params& p, unsigned char* lds, int vb, int vG) {
    const int tid = threadIdx.x, wave = tid >> 6, lane = tid & 63;
    bf16_t* tile = (bf16_t*)(lds + wave * 16384);
    const bf16_t* P = (const bf16_t*)(p.ws + WS_P); bf16_t* VT = (bf16_t*)(p.ws + WS_VT);
    const int gw = vb * NWAVES + wave, NGW = vG * NWAVES;
    for (int it = gw; it < 8 * 8 * 32 * 2; it += NGW) {
        const int dh = it & 1, kt = (it >> 1) & 31, h = (it >> 6) & 7, b = it >> 9;
        const int k0 = kt * 64, d0 = dh * 64;
#pragma unroll
        for (int i = 0; i < 8; ++i) { const int key = i * 8 + (lane >> 3), dc = lane & 7;
            const u32x4 v = *(const u32x4*)(P + (size_t)(b * SEQ + k0 + key) * NP + C_VA + h * 128 + d0 + dc * 8);
            bf16_t* t = tile + (dc * 8) * 72 + key;
            t[0 * 72] = (bf16_t)(v.x & 0xffff); t[1 * 72] = (bf16_t)(v.x >> 16); t[2 * 72] = (bf16_t)(v.y & 0xffff); t[3 * 72] = (bf16_t)(v.y >> 16);
            t[4 * 72] = (bf16_t)(v.z & 0xffff); t[5 * 72] = (bf16_t)(v.z >> 16); t[6 * 72] = (bf16_t)(v.w & 0xffff); t[7 * 72] = (bf16_t)(v.w >> 16); }
        LDS_WAIT();
#pragma unroll
        for (int i = 0; i < 8; ++i) { const int d = i * 8 + (lane >> 3), kc = lane & 7;
            const u32x4 v = *(const u32x4*)(tile + d * 72 + kc * 8);
            *(u32x4*)(VT + ((size_t)((b * 8 + h) * 128 + d0 + d)) * SEQ + k0 + kc * 8) = v; }
        LDS_WAIT();
    }
}

__device__ __forceinline__ unsigned ord_key(float s) { const unsigned u = __float_as_uint(s); return (u & 0x80000000u) ? ~u : (u | 0x80000000u); }
__device__ __forceinline__ int half_sum(int v) {
    v += __builtin_amdgcn_update_dpp(0, v, 0xB1, 0xF, 0xF, true);
    v += __builtin_amdgcn_update_dpp(0, v, 0x4E, 0xF, 0xF, true);
    v += __builtin_amdgcn_update_dpp(0, v, 0x141, 0xF, 0xF, true);
    v += __builtin_amdgcn_update_dpp(0, v, 0x140, 0xF, 0xF, true);
    v += __shfl_xor(v, 16);
    return v;
}
constexpr int IX_RS = 72, IX_STAGE = 32 * IX_RS * 2;
__device__ __forceinline__ void indexer_item(const Params& p, unsigned char* lds, int b, int c, int grp) {
    const int tid = threadIdx.x, w = __builtin_amdgcn_readfirstlane(tid >> 6), lane = tid & 63, r = lane & 31, hh = lane >> 5;
    const bf16_t* P = (const bf16_t*)(p.ws + WS_P); unsigned* MASK = (unsigned*)(p.ws + WS_MASK);
    const int pair = grp * 8 + w, q0 = b * SEQ + c * 64 + 2 * pair;
    bf16x8 af[4];
    { const int query = q0 + ((r >> 2) & 1), head = (r & 3) + 4 * (r >> 3);
      const bf16_t* qp = P + (size_t)query * NP + C_QI + head * 64 + 8 * hh;
#pragma unroll
      for (int ks = 0; ks < 4; ++ks) af[ks] = *(const bf16x8*)(qp + ks * 16); }
    float wv[16];
    { const u32x4 w0 = *(const u32x4*)(P + (size_t)(q0 + hh) * NP + C_WI), w1 = *(const u32x4*)(P + (size_t)(q0 + hh) * NP + C_WI + 8);
      wv[0] = bflo(w0.x); wv[1] = bfhi(w0.x); wv[2] = bflo(w0.y); wv[3] = bfhi(w0.y); wv[4] = bflo(w0.z); wv[5] = bfhi(w0.z); wv[6] = bflo(w0.w); wv[7] = bfhi(w0.w);
      wv[8] = bflo(w1.x); wv[9] = bfhi(w1.x); wv[10] = bflo(w1.y); wv[11] = bfhi(w1.y); wv[12] = bflo(w1.z); wv[13] = bfhi(w1.z); wv[14] = bflo(w1.w); wv[15] = bfhi(w1.w); }
    const int nkt = 2 * (c + 1);
    const bool ldr = tid < 256;
    const bf16_t* kg = P + (size_t)(b * SEQ + ((tid >> 3) & 31)) * NP + C_KI + (tid & 7) * 8;
    const int kls = ((tid >> 3) & 31) * IX_RS * 2 + (tid & 7) * 16;
    u32x4 kr = {0u, 0u, 0u, 0u};
    __syncthreads();
    if (ldr) { *(u32x4*)(lds + kls) = *(const u32x4*)kg; *(u32x4*)(lds + IX_STAGE + kls) = *(const u32x4*)(kg + (size_t)32 * NP); }
    if (ldr && 2 < nkt) kr = *(const u32x4*)(kg + (size_t)64 * NP);
    __syncthreads();
    unsigned kv[64];
#pragma unroll
    for (int kt = 0; kt < 64; ++kt) {
        kv[kt] = 0u;
        if (kt < nkt) {
            if (ldr && kt + 2 < nkt) *(u32x4*)(lds + ((kt + 2) % 3) * IX_STAGE + kls) = kr;
            if (ldr && kt + 3 < nkt) kr = *(const u32x4*)(kg + (size_t)((kt + 3) * 32) * NP);
            const bf16_t* Ks = (const bf16_t*)(lds + (kt % 3) * IX_STAGE);
            f32x16 acc;
#pragma unroll
            for (int i = 0; i < 16; ++i) acc[i] = 0.f;
#pragma unroll
            for (int ks = 0; ks < 4; ++ks) { const bf16x8 bfr = *(const bf16x8*)(Ks + r * IX_RS + ks * 16 + 8 * hh); acc = __builtin_amdgcn_mfma_f32_32x32x16_bf16(af[ks], bfr, acc, 0, 0, 0); }
            float sc = 0.f;
#pragma unroll
            for (int i = 0; i < 16; ++i) sc += wv[i] * fmaxf(acc[i], 0.f);
            kv[kt] = ord_key(sc);
            __syncthreads();
        }
    }
    unsigned thr = 0u;
    if (nkt > 8) {
        int cur = 1 << 20;
        for (int bit = 31; bit >= 0; --bit) {
            const unsigned cand = thr | (1u << bit); int cnt = 0;
#pragma unroll
            for (int kt = 0; kt < 32; ++kt) cnt += (kv[kt] >= cand) ? 1 : 0;
            if (nkt > 32) {
#pragma unroll
                for (int kt = 32; kt < 64; ++kt) cnt += (kv[kt] >= cand) ? 1 : 0; }
            cnt = half_sum(cnt);
            if (cnt >= 256) { thr = cand; cur = cnt; }
            if (__builtin_amdgcn_ballot_w64(cur != 256) == 0ull) break;
        }
    }
    int cge = 0;
#pragma unroll
    for (int kt = 0; kt < 64; ++kt) cge += (kv[kt] >= thr && kv[kt] != 0u) ? 1 : 0;
    cge = half_sum(cge);
    const bool ties = (thr != 0u) && (cge > 256);
    unsigned m0 = 0u, m1 = 0u;
    if (__builtin_amdgcn_ballot_w64(ties) == 0ull) {
#pragma unroll
        for (int kt = 0; kt < 64; ++kt) { const unsigned long long bm = __builtin_amdgcn_ballot_w64(kv[kt] >= thr && kv[kt] != 0u);
            if (lane == kt) { m0 = (unsigned)bm; m1 = (unsigned)(bm >> 32); } }
    } else {
        int cgt = 0;
#pragma unroll
        for (int kt = 0; kt < 64; ++kt) cgt += (kv[kt] > thr) ? 1 : 0;
        cgt = half_sum(cgt);
        const int need = ties ? (256 - cgt) : (1 << 30); int run = 0;
#pragma unroll
        for (int kt = 0; kt < 64; ++kt) { const bool tie = ties && (kv[kt] == thr); const unsigned long long tb = __builtin_amdgcn_ballot_w64(tie);
            const unsigned th = hh ? (unsigned)(tb >> 32) : (unsigned)tb; const int rank = run + __builtin_popcount(th & ((1u << r) - 1u));
            const bool sel = ties ? ((kv[kt] > thr) || (tie && rank < need)) : (kv[kt] >= thr && kv[kt] != 0u);
            run += __builtin_popcount(th);
            const unsigned long long bm = __builtin_amdgcn_ballot_w64(sel);
            if (lane == kt) { m0 = (unsigned)bm; m1 = (unsigned)(bm >> 32); } }
    }
    { const int qpos = c * 64 + 2 * pair; unsigned* mt = MASK + ((size_t)(b * 64 + lane)) * SEQ + qpos; mt[0] = m0; mt[1] = m1; }
}
__device__ __forceinline__ void phase_indexer(const Params& p, unsigned char* lds, int vb, int vG) {
    const int G = vG;
    for (int rd = 0;; ++rd) {
        const int base = rd * G; if (base >= 1024) break;
        const int pos = (rd & 1) ? (G - 1 - vb) : vb; const int i = base + pos; if (i >= 1024) continue;
        indexer_item(p, lds, (i >> 2) & 7, 31 - (i >> 5), i & 3);
    }
}

#ifndef HG_REP_A
#define HG_REP_A 0
#endif
#ifndef HG_REP_B
#define HG_REP_B 0
#endif
constexpr int HG_RS = 136, HG_TS = 72, HG_SS = 136;
constexpr int HG_QT = 0, HG_QH = 17408, HG_KT = 34816, HG_KHT = 52224, HG_VT = 70656, HG_ST = 89088, HG_DEC = 123904, HG_SSQ = 124416, HG_OT = 125440;
__device__ __forceinline__ void hgrn_item(const Params& p, unsigned char* lds, int item) {
    const int tid = threadIdx.x, w = __builtin_amdgcn_readfirstlane(tid >> 6), lane = tid & 63, r = lane & 31, hh = lane >> 5;
    const int b = item >> 3, h = item & 7;
    const bf16_t* P = (const bf16_t*)(p.ws + WS_P); bf16_t* REC = (bf16_t*)((unsigned char*)p.out + OUT_REC);
    bf16_t* QT = (bf16_t*)(lds + HG_QT); bf16_t* QH = (bf16_t*)(lds + HG_QH); bf16_t* KT = (bf16_t*)(lds + HG_KT); bf16_t* KHT = (bf16_t*)(lds + HG_KHT); bf16_t* VT = (bf16_t*)(lds + HG_VT);
    bf16_t* ST = (bf16_t*)(lds + HG_ST); float* DEC = (float*)(lds + HG_DEC); float* SSQ = (float*)(lds + HG_SSQ); bf16_t* OT = (bf16_t*)(lds + HG_OT);
    const int seg = lane >> 4, dl = lane & 15, d = 16 * w + dl;
    const float lb = sigmoidf_(p.in[7][h * 128 + d] - p.in[7][1024 + h * 128 + d]);
    const int tb = w & 1, eb = w >> 1, sdb = w & 3, seb0 = 2 * (w >> 2);
    const int ot_t = tid >> 3, ot_c = tid & 7;
    float gn[16];
#pragma unroll
    for (int j = 0; j < 4; ++j) { const f32x4 g4 = *(const f32x4*)(p.in[8] + 16 * ot_c + 4 * j); gn[4 * j] = g4[0]; gn[4 * j + 1] = g4[1]; gn[4 * j + 2] = g4[2]; gn[4 * j + 3] = g4[3]; }
    f32x16 S0, S1;
#pragma unroll
    for (int i = 0; i < 16; ++i) { S0[i] = 0.f; S1[i] = 0.f; }
    __syncthreads();
    for (int i = tid; i < 128 * HG_SS / 2; i += NTHREADS) ((unsigned*)ST)[i] = 0u;
    unsigned short rq[16], rf[16], ri[16];
    { const bf16_t* src = P + (size_t)(b * SEQ + 16 * seg) * NP + h * 128 + d;
#pragma unroll
      for (int i = 0; i < 16; ++i) { rq[i] = src[(size_t)i * NP + C_QB]; rf[i] = src[(size_t)i * NP + C_FB]; ri[i] = src[(size_t)i * NP + C_IB]; } }
#pragma unroll 1
    for (int n = 0; n < 32; ++n) {
#pragma unroll 1
        for (int repa = 0; repa <= HG_REP_A; ++repa) {
            float lf[16], kk[16];
            float run = 0.f;
#pragma unroll
            for (int i = 0; i < 16; ++i) { const float f = lb + (1.f - lb) * sigmoidf_(bf2f(rf[i])); kk[i] = 1.f - f; run += __logf(f); lf[i] = run; }
            const float p0 = __shfl(run, dl), p1 = __shfl(run, 16 + dl), p2 = __shfl(run, 32 + dl), p3 = __shfl(run, 48 + dl);
            const float off = (seg > 0 ? p0 : 0.f) + (seg > 1 ? p1 : 0.f) + (seg > 2 ? p2 : 0.f), bL = (p0 + p1) + (p2 + p3), bref = p0 + p1;
            const float eref = __expf(fmaxf(bref, -80.f)), elref = __expf(fmaxf(bL - bref, -80.f));
            unsigned kh[8], vv[8];
#pragma unroll
            for (int i = 0; i < 16; ++i) { const float bt = off + lf[i]; const float qs = siluf_(bf2f(rq[i]));
                const float e1 = __expf(__builtin_amdgcn_fmed3f(bt - bref, -80.f, 80.f)), e2 = e1 * eref, e3 = __builtin_amdgcn_rcpf(e1), e4 = e3 * elref;
                const int t = 16 * seg + i;
                QT[t * HG_RS + d] = (bf16_t)f2bf(qs * e1); QH[t * HG_RS + d] = (bf16_t)f2bf(qs * e2); KT[t * HG_RS + d] = (bf16_t)f2bf(kk[i] * e3);
                const unsigned khv = f2bf(kk[i] * e4);
                if (i & 1) { kh[i >> 1] |= khv << 16; vv[i >> 1] |= (unsigned)ri[i] << 16; } else { kh[i >> 1] = khv; vv[i >> 1] = (unsigned)ri[i]; } }
            *(u32x4*)(KHT + d * HG_TS + 16 * seg) = (u32x4){kh[0], kh[1], kh[2], kh[3]}; *(u32x4*)(KHT + d * HG_TS + 16 * seg + 8) = (u32x4){kh[4], kh[5], kh[6], kh[7]};
            *(u32x4*)(VT + d * HG_TS + 16 * seg) = (u32x4){vv[0], vv[1], vv[2], vv[3]}; *(u32x4*)(VT + d * HG_TS + 16 * seg + 8) = (u32x4){vv[4], vv[5], vv[6], vv[7]};
            if (seg == 0) DEC[d] = eref * elref;
        }
        __syncthreads();
        if (n < 31) { const bf16_t* src = P + (size_t)(b * SEQ + (n + 1) * 64 + 16 * seg) * NP + h * 128 + d;
#pragma unroll
            for (int i = 0; i < 16; ++i) { rq[i] = src[(size_t)i * NP + C_QB]; rf[i] = src[(size_t)i * NP + C_FB]; ri[i] = src[(size_t)i * NP + C_IB]; } }
        const u32x4 gb0 = *(const u32x4*)(P + (size_t)(b * SEQ + n * 64 + ot_t) * NP + C_GB + h * 128 + 16 * ot_c), gb1 = *(const u32x4*)(P + (size_t)(b * SEQ + n * 64 + ot_t) * NP + C_GB + h * 128 + 16 * ot_c + 8);
        f32x16 X0, X1, o;
#pragma unroll 1
        for (int repb = 0; repb <= HG_REP_B; ++repb) {
#pragma unroll
        for (int i = 0; i < 16; ++i) { X0[i] = 0.f; X1[i] = 0.f; o[i] = 0.f; }
#pragma unroll
        for (int ks = 0; ks < 8; ++ks) { const bf16x8 bq = *(const bf16x8*)(QT + (32 * tb + r) * HG_RS + 16 * ks + 8 * hh);
            const bf16x8 a0 = *(const bf16x8*)(KT + r * HG_RS + 16 * ks + 8 * hh); X0 = __builtin_amdgcn_mfma_f32_32x32x16_bf16(a0, bq, X0, 0, 0, 0);
            if (tb == 1) { const bf16x8 a1 = *(const bf16x8*)(KT + (32 + r) * HG_RS + 16 * ks + 8 * hh); X1 = __builtin_amdgcn_mfma_f32_32x32x16_bf16(a1, bq, X1, 0, 0, 0); } }
#pragma unroll
        for (int i = 0; i < 16; ++i) { const bool keep = ((i & 3) + 8 * (i >> 2) + 4 * hh) <= r; if (tb == 0) X0[i] = keep ? X0[i] : 0.f; else X1[i] = keep ? X1[i] : 0.f; }
#pragma unroll
        for (int sb = 0; sb < 2; ++sb) { if (sb <= tb) {
#pragma unroll
            for (int s2 = 0; s2 < 2; ++s2) { u32x4 aw;
                if (sb == 0) { aw.x = pk2(X0[8 * s2], X0[8 * s2 + 1]); aw.y = pk2(X0[8 * s2 + 2], X0[8 * s2 + 3]); aw.z = pk2(X0[8 * s2 + 4], X0[8 * s2 + 5]); aw.w = pk2(X0[8 * s2 + 6], X0[8 * s2 + 7]); }
                else { aw.x = pk2(X1[8 * s2], X1[8 * s2 + 1]); aw.y = pk2(X1[8 * s2 + 2], X1[8 * s2 + 3]); aw.z = pk2(X1[8 * s2 + 4], X1[8 * s2 + 5]); aw.w = pk2(X1[8 * s2 + 6], X1[8 * s2 + 7]); }
                const bf16_t* vp = VT + (32 * eb + r) * HG_TS + 32 * sb + 16 * s2 + 4 * hh;
                const u32x2 lo = *(const u32x2*)vp, hi = *(const u32x2*)(vp + 8); const u32x4 bw = {lo.x, lo.y, hi.x, hi.y};
                o = __builtin_amdgcn_mfma_f32_32x32x16_bf16(__builtin_bit_cast(bf16x8, aw), __builtin_bit_cast(bf16x8, bw), o, 0, 0, 0); } } }
#pragma unroll
        for (int ks = 0; ks < 8; ++ks) { const bf16x8 aq = *(const bf16x8*)(QH + (32 * tb + r) * HG_RS + 16 * ks + 8 * hh), bs = *(const bf16x8*)(ST + (32 * eb + r) * HG_SS + 16 * ks + 8 * hh);
            o = __builtin_amdgcn_mfma_f32_32x32x16_bf16(aq, bs, o, 0, 0, 0); }
        { float a8[8], a4[4], a2[2], a1;
#pragma unroll
          for (int i = 0; i < 8; ++i) { const float lo = o[i] * o[i], hi = o[i + 8] * o[i + 8]; const bool up = lane & 16; const float keep = up ? hi : lo, send = up ? lo : hi; a8[i] = keep + __shfl_xor(send, 16); }
#pragma unroll
          for (int i = 0; i < 4; ++i) { const bool up = lane & 8; const float keep = up ? a8[i + 4] : a8[i], send = up ? a8[i] : a8[i + 4]; a4[i] = keep + __shfl_xor(send, 8); }
#pragma unroll
          for (int i = 0; i < 2; ++i) { const bool up = lane & 4; const float keep = up ? a4[i + 2] : a4[i], send = up ? a4[i] : a4[i + 2]; a2[i] = keep + __shfl_xor(send, 4); }
          { const bool up = lane & 2; const float keep = up ? a2[1] : a2[0], send = up ? a2[0] : a2[1]; a1 = keep + __shfl_xor(send, 2); }
          a1 += __shfl_xor(a1, 1);
          const int ri2 = (lane >> 1) & 15;
          if ((lane & 1) == 0) SSQ[(32 * tb + (ri2 & 3) + 8 * (ri2 >> 2) + 4 * hh) * 4 + eb] = a1; }
#pragma unroll
        for (int i = 0; i < 16; ++i) OT[(32 * tb + (i & 3) + 8 * (i >> 2) + 4 * hh) * HG_RS + 32 * eb + r] = (bf16_t)f2bf(o[i]);
        }
        { float dc[16];
#pragma unroll
          for (int g4 = 0; g4 < 4; ++g4) { const f32x4 dv = *(const f32x4*)(DEC + 32 * sdb + 8 * g4 + 4 * hh); dc[4 * g4] = dv[0]; dc[4 * g4 + 1] = dv[1]; dc[4 * g4 + 2] = dv[2]; dc[4 * g4 + 3] = dv[3]; }
#pragma unroll
          for (int i = 0; i < 16; ++i) { S0[i] *= dc[i]; S1[i] *= dc[i]; }
#pragma unroll
          for (int ss = 0; ss < 4; ++ss) { const bf16x8 a = *(const bf16x8*)(KHT + (32 * sdb + r) * HG_TS + 16 * ss + 8 * hh);
              const bf16x8 b0 = *(const bf16x8*)(VT + (32 * seb0 + r) * HG_TS + 16 * ss + 8 * hh), b1 = *(const bf16x8*)(VT + (32 * (seb0 + 1) + r) * HG_TS + 16 * ss + 8 * hh);
              S0 = __builtin_amdgcn_mfma_f32_32x32x16_bf16(a, b0, S0, 0, 0, 0); S1 = __builtin_amdgcn_mfma_f32_32x32x16_bf16(a, b1, S1, 0, 0, 0); } }
        __syncthreads();
#pragma unroll
        for (int g4 = 0; g4 < 4; ++g4) { const int d0 = 32 * sdb + 8 * g4 + 4 * hh;
            *(u32x2*)(ST + (32 * seb0 + r) * HG_SS + d0) = (u32x2){pk2(S0[4 * g4], S0[4 * g4 + 1]), pk2(S0[4 * g4 + 2], S0[4 * g4 + 3])};
            *(u32x2*)(ST + (32 * (seb0 + 1) + r) * HG_SS + d0) = (u32x2){pk2(S1[4 * g4], S1[4 * g4 + 1]), pk2(S1[4 * g4 + 2], S1[4 * g4 + 3])}; }
        { const f32x4 q4 = *(const f32x4*)(SSQ + ot_t * 4); const float rstd = rsqrtf(((q4[0] + q4[1]) + (q4[2] + q4[3])) * (1.f / 128.f) + NORM_EPS);
          const u32x4 o0 = *(const u32x4*)(OT + ot_t * HG_RS + 16 * ot_c), o1 = *(const u32x4*)(OT + ot_t * HG_RS + 16 * ot_c + 8);
          const unsigned ow[8] = {o0.x, o0.y, o0.z, o0.w, o1.x, o1.y, o1.z, o1.w}, gwv[8] = {gb0.x, gb0.y, gb0.z, gb0.w, gb1.x, gb1.y, gb1.z, gb1.w};
          unsigned rw[8];
#pragma unroll
          for (int j = 0; j < 8; ++j) rw[j] = pk2(bflo(ow[j]) * rstd * gn[2 * j] * siluf_(bflo(gwv[j])), bfhi(ow[j]) * rstd * gn[2 * j + 1] * siluf_(bfhi(gwv[j])));
          bf16_t* dst = REC + (size_t)(b * SEQ + n * 64 + ot_t) * 1024 + h * 128 + 16 * ot_c;
          *(u32x4*)dst = (u32x4){rw[0], rw[1], rw[2], rw[3]}; *(u32x4*)(dst + 8) = (u32x4){rw[4], rw[5], rw[6], rw[7]}; }
    }
}
__device__ __forceinline__ void phase_hgrn(const Params& p, unsigned char* lds, int vb, int vG) {
    for (int it = vb; it < 64; it += vG) hgrn_item(p, lds, it);
}

constexpr int AT_KRS = 136, AT_VRS = 36, AT_KB = 32 * AT_KRS * 2, AT_VB = 128 * AT_VRS * 2, AT_STAGE = AT_KB + AT_VB;
__device__ __forceinline__ void attn_item(const Params& p, unsigned char* lds, int b, int head, int cq) {
    const int tid = threadIdx.x, w = __builtin_amdgcn_readfirstlane(tid >> 6), lane = tid & 63, r = lane & 31, hh = lane >> 5;
    const bf16_t* P = (const bf16_t*)(p.ws + WS_P); const bf16_t* VT = (const bf16_t*)(p.ws + WS_VT); const unsigned* MASKT = (const unsigned*)(p.ws + WS_MASK);
    bf16_t* AO = (bf16_t*)((unsigned char*)p.out + OUT_AO);
    const int c = 4 * cq + (w >> 1), qpos = c * 64 + (w & 1) * 32 + r, tq = b * SEQ + qpos;
    const int nkt_w = 2 * (c + 1), nkt = 8 * (cq + 1);
    const bf16_t* kg = P + (size_t)(b * SEQ + (tid >> 4)) * NP + C_KA + head * 128 + (tid & 15) * 8;
    const bf16_t* vg = VT + (size_t)((b * 8 + head) * 128 + (tid >> 2)) * SEQ + (tid & 3) * 8;
    const int kls = (tid >> 4) * AT_KRS * 2 + (tid & 15) * 16, vls = AT_KB + (tid >> 2) * AT_VRS * 2 + (tid & 3) * 16;
    bf16x8 qf[8];
    { const bf16_t* qp = P + (size_t)tq * NP + C_QA + head * 128 + 8 * hh;
#pragma unroll
      for (int ks = 0; ks < 8; ++ks) qf[ks] = *(const bf16x8*)(qp + ks * 16); }
    f32x16 o[4];
#pragma unroll
    for (int db = 0; db < 4; ++db)
#pragma unroll
        for (int i = 0; i < 16; ++i) o[db][i] = 0.f;
    float mrun = -1e30f, lsum = 0.f;
    const float sc = 0.08838834764831845f * 1.4426950408889634f;
    __syncthreads();
    u32x4 krA, vrA, krB, vrB;
#pragma unroll
    for (int t0 = 0; t0 < 2; ++t0) { krA = *(const u32x4*)(kg + (size_t)(t0 * 32) * NP); vrA = *(const u32x4*)(vg + t0 * 32);
        *(u32x4*)(lds + t0 * AT_STAGE + kls) = krA; *(u32x2*)(lds + t0 * AT_STAGE + vls) = (u32x2){vrA.x, vrA.y}; *(u32x2*)(lds + t0 * AT_STAGE + vls + 8) = (u32x2){vrA.z, vrA.w}; }
    krA = *(const u32x4*)(kg + (size_t)(2 * 32) * NP); vrA = *(const u32x4*)(vg + 2 * 32);
    krB = *(const u32x4*)(kg + (size_t)(3 * 32) * NP); vrB = *(const u32x4*)(vg + 3 * 32);
    unsigned mwA = MASKT[(size_t)(b * 64) * SEQ + qpos], mwB = MASKT[(size_t)(b * 64 + 1) * SEQ + qpos];
    __syncthreads();
    int st = 0, st2 = 2;
#define AT_TILE(KT, KR, VR, MW) do { const int kt_ = (KT); \
        if (kt_ + 2 < nkt) { *(u32x4*)(lds + st2 * AT_STAGE + kls) = KR; *(u32x2*)(lds + st2 * AT_STAGE + vls) = (u32x2){VR.x, VR.y}; *(u32x2*)(lds + st2 * AT_STAGE + vls + 8) = (u32x2){VR.z, VR.w}; } \
        if (kt_ + 4 < nkt) { KR = *(const u32x4*)(kg + (size_t)((kt_ + 4) * 32) * NP); VR = *(const u32x4*)(vg + (kt_ + 4) * 32); } \
        if (kt_ < nkt_w) { \
            const unsigned mwc = MW; \
            if (kt_ + 2 < nkt_w) MW = MASKT[(size_t)(b * 64 + kt_ + 2) * SEQ + qpos]; \
            const bf16_t* Ks = (const bf16_t*)(lds + st * AT_STAGE); const bf16_t* Vs = (const bf16_t*)(lds + st * AT_STAGE + AT_KB); \
            f32x16 s; \
            _Pragma("unroll") for (int i = 0; i < 16; ++i) s[i] = 0.f; \
            _Pragma("unroll") for (int ks = 0; ks < 8; ++ks) { const bf16x8 kf = *(const bf16x8*)(Ks + r * AT_KRS + ks * 16 + 8 * hh); s = __builtin_amdgcn_mfma_f32_32x32x16_bf16(kf, qf[ks], s, 0, 0, 0); } \
            float mx = -3e38f; const unsigned mws = mwc >> (4 * hh);        \
            _Pragma("unroll") for (int i = 0; i < 16; ++i) { const bool ok = (mws >> ((i & 3) + 8 * (i >> 2))) & 1u; s[i] = ok ? s[i] : -3e38f; mx = fmaxf(mx, s[i]); } \
            mx = fmaxf(mx, __shfl_xor(mx, 32)); \
            const float mnew = fmaxf(mrun, mx * sc), alpha = exp2f(mrun - mnew); \
            const bool grew = mnew > mrun; mrun = mnew; \
            float ps = 0.f; float pv[16]; \
            _Pragma("unroll") for (int i = 0; i < 16; ++i) { const float e = exp2f(fmaf(s[i], sc, -mnew)); pv[i] = e; ps += e; }        \
            lsum = lsum * alpha + ps; \
            if (__builtin_amdgcn_ballot_w64(grew) != 0ull) { _Pragma("unroll") for (int db = 0; db < 4; ++db) _Pragma("unroll") for (int i = 0; i < 16; ++i) o[db][i] *= alpha; } \
            bf16x8 pf[2]; \
            _Pragma("unroll") for (int s2 = 0; s2 < 2; ++s2) { u32x4 wv; wv.x = pk2(pv[8 * s2 + 0], pv[8 * s2 + 1]); wv.y = pk2(pv[8 * s2 + 2], pv[8 * s2 + 3]); wv.z = pk2(pv[8 * s2 + 4], pv[8 * s2 + 5]); wv.w = pk2(pv[8 * s2 + 6], pv[8 * s2 + 7]); pf[s2] = __builtin_bit_cast(bf16x8, wv); } \
            _Pragma("unroll") for (int db = 0; db < 4; ++db) _Pragma("unroll") for (int s2 = 0; s2 < 2; ++s2) { const bf16_t* vp = Vs + (db * 32 + r) * AT_VRS + 16 * s2 + 4 * hh; const u32x2 lo = *(const u32x2*)vp, hi = *(const u32x2*)(vp + 8); \
                    const u32x4 wv = {lo.x, lo.y, hi.x, hi.y}; \
                    o[db] = __builtin_amdgcn_mfma_f32_32x32x16_bf16(__builtin_bit_cast(bf16x8, wv), pf[s2], o[db], 0, 0, 0); } \
        } \
        __syncthreads(); \
        st = (st == 2) ? 0 : st + 1; st2 = (st2 == 2) ? 0 : st2 + 1; } while (0)
#pragma unroll 1
    for (int kt = 0; kt < nkt; kt += 2) { AT_TILE(kt, krA, vrA, mwA); AT_TILE(kt + 1, krB, vrB, mwB); }
#undef AT_TILE
    const float l = lsum + __shfl_xor(lsum, 32), inv = 1.f / l;
    bf16_t* op = AO + (size_t)tq * 1024 + head * 128 + 4 * hh;
#pragma unroll
    for (int db = 0; db < 4; ++db)
#pragma unroll
        for (int g4 = 0; g4 < 4; ++g4) { u32x2 wv; wv.x = pk2(o[db][4 * g4] * inv, o[db][4 * g4 + 1] * inv); wv.y = pk2(o[db][4 * g4 + 2] * inv, o[db][4 * g4 + 3] * inv);
            *(u32x2*)(op + db * 32 + 8 * g4) = wv; }
}
__device__ __forceinline__ void phase_attn(const Params& p, unsigned char* lds, int vb, int vG) {
    const int G = vG;
    for (int rd = 0;; ++rd) {
        const int base = rd * G; if (base >= 512) break;
        const int pos = (rd & 1) ? (G - 1 - vb) : vb; const int i = base + pos; if (i >= 512) continue;
        attn_item(p, lds, (i >> 3) & 7, i & 7, 7 - (i >> 6));
    }
}
__device__ __forceinline__ void phase_attn_queue(const Params& p, unsigned char* lds, unsigned* qhead) {
    volatile LAS int* slot = (volatile LAS int*)((LAS unsigned char*)lds + LDS_BYTES - 32);
    for (;;) {
        __syncthreads();
        if (threadIdx.x == 0) slot[0] = (int)__hip_atomic_fetch_add(qhead, 1u, __ATOMIC_RELAXED, __HIP_MEMORY_SCOPE_AGENT);
        __syncthreads();
        const int i = slot[0]; if (i >= 512) break;
        attn_item(p, lds, (i >> 3) & 7, i & 7, 7 - (i >> 6));
    }
}
__device__ __forceinline__ void phase_uv(const Params& p) {
    const int tid = threadIdx.x, wave = tid >> 6, lane = tid & 63;
    const int gw = blockIdx.x * NWAVES + wave, NGW = gridDim.x * NWAVES;
    for (int it = gw; it < 2 * 16384; it += NGW) {
        const int tbl = it >> 14, row = it & 16383;
        const float* src = (tbl ? p.in[15] : p.in[14]) + (size_t)row * 2048 + 32 * lane;
        unsigned char* dst = p.ws + (tbl ? WS_V8 : WS_U8); float* isc = (float*)(p.ws + (tbl ? WS_ISV : WS_ISU));
        f32x4 v[8]; float am = 0.f;
#pragma unroll
        for (int j = 0; j < 8; ++j) { v[j] = *(const f32x4*)(src + 4 * j); am = fmaxf(am, fmaxf(fmaxf(fabsf(v[j][0]), fabsf(v[j][1])), fmaxf(fabsf(v[j][2]), fabsf(v[j][3])))); }
#pragma unroll
        for (int o = 1; o < 64; o <<= 1) am = fmaxf(am, __shfl_xor(am, o));
        am = fmaxf(am, 1e-30f); const float sc = 256.f / am;
        unsigned wq[8];
#pragma unroll
        for (int j = 0; j < 8; ++j) { int pk = 0; pk = __builtin_amdgcn_cvt_pk_fp8_f32(v[j][0] * sc, v[j][1] * sc, pk, false); pk = __builtin_amdgcn_cvt_pk_fp8_f32(v[j][2] * sc, v[j][3] * sc, pk, true); wq[j] = (unsigned)pk; }
        unsigned char* d = dst + (size_t)(lane >> 2) * (2u << 20) + (size_t)row * 128 + (lane & 3) * 32;
        *(u32x4*)d = (u32x4){wq[0], wq[1], wq[2], wq[3]}; *(u32x4*)(d + 16) = (u32x4){wq[4], wq[5], wq[6], wq[7]};
        if (lane == 0) isc[row] = am * (1.f / 256.f);
    }
}

#define INS16(v, x) do { _Pragma("unroll") for (int _j = 15; _j >= 1; --_j) v[_j] = __builtin_amdgcn_fmed3f(v[_j - 1], v[_j], (x)); v[0] = fmaxf(v[0], (x)); } while (0)
__device__ __forceinline__ void peer_half_top16(const bf16_t* QP, const bf16_t* kb0  , int pitch, int tok, int p, int hf, int r, int hh, float (&v)[16]) {
    bf16x8 qf[8];
    { const bf16_t* qp = QP + (size_t)tok * D + p * 256 + hf * 128 + 8 * hh;
#pragma unroll
      for (int ks = 0; ks < 8; ++ks) qf[ks] = *(const bf16x8*)(qp + ks * 16); }
#pragma unroll
    for (int k = 0; k < 16; ++k) v[k] = -3.0e38f;
    const bf16_t* kb = kb0 + r * pitch + 8 * hh;
#pragma unroll 1
    for (int nb = 0; nb < 4; ++nb) {
        f32x16 acc;
#pragma unroll
        for (int i = 0; i < 16; ++i) acc[i] = 0.f;
#pragma unroll
        for (int ks = 0; ks < 8; ++ks) { const bf16x8 kf = *(const bf16x8*)(kb + (nb * 32) * pitch + ks * 16); acc = __builtin_amdgcn_mfma_f32_32x32x16_bf16(kf, qf[ks], acc, 0, 0, 0); }
#pragma unroll
        for (int i = 0; i < 16; ++i) { const unsigned xi = (unsigned)(nb * 32 + (i & 3) + 8 * (i >> 2) + 4 * hh); const float x = __uint_as_float((__float_as_uint(acc[i]) & ~0x7fu) | xi); INS16(v, x); }
    }
    float ov[16];
#pragma unroll
    for (int k = 0; k < 16; ++k) ov[k] = __shfl_xor(v[k], 32);
#pragma unroll
    for (int k = 0; k < 16; ++k) INS16(v, ov[k]);
}
constexpr int PK_RS = 136;
#define GAS __attribute__((address_space(1)))
__device__ __attribute__((noinline)) void phase_peer_topk_ni(const GAS bf16_t* QPg, const GAS bf16_t* KEYSg, GAS int* EIDXg, GAS float* EGATEg, LAS unsigned char* ldsl) {
    const bf16_t* QP = (const bf16_t*)QPg; const bf16_t* KEYS = (const bf16_t*)KEYSg; int* EIDX = (int*)EIDXg; float* EGATE = (float*)EGATEg; unsigned char* lds = (unsigned char*)ldsl;
    const int tid = threadIdx.x, wave = __builtin_amdgcn_readfirstlane(tid >> 6), lane = tid & 63, r = lane & 31, hh = lane >> 5;
    bf16_t* KL = (bf16_t*)lds;
    const int G = gridDim.x, hd = blockIdx.x & 7;
    __syncthreads();
    for (int i = tid; i < 2 * 128 * 16; i += NTHREADS) { const int row = i >> 4, ch = i & 15;
        *(u32x4*)(KL + row * PK_RS + ch * 8) = *(const u32x4*)(KEYS + (size_t)(hd * 256 + row) * 128 + ch * 8); }
    __syncthreads();
    for (int tile = blockIdx.x >> 3; tile < 64; tile += (G + 7) / 8) {
        const int tok = tile * 256 + wave * 32 + r;
        float va[16], vb[16];
        peer_half_top16(QP, KL, PK_RS, tok, hd, 0, r, hh, va);
        peer_half_top16(QP, KL + 128 * PK_RS, PK_RS, tok, hd, 1, r, hh, vb);
        float bv[16];
#pragma unroll
        for (int k = 0; k < 16; ++k) bv[k] = -3.0e38f;
#pragma unroll
        for (int a = 0; a < 16; ++a)
#pragma unroll
            for (int b2 = 0; b2 < 16; ++b2) if ((a + 1) * (b2 + 1) <= 16) { const float x = va[a] + vb[b2]; INS16(bv, x); }
        float se = 0.f;
#pragma unroll
        for (int k = 0; k < 16; ++k) se += __expf(bv[k] - bv[0]);
        const float inv = 1.f / se, thr = bv[15], top = bv[0];
        int cnt = 0; int* ei = EIDX + (size_t)tok * 128 + hd * 16; float* eg = EGATE + (size_t)tok * 128 + hd * 16;
#pragma unroll
        for (int a = 0; a < 16; ++a)
#pragma unroll
            for (int b2 = 0; b2 < 16; ++b2) if ((a + 1) * (b2 + 1) <= 16) { const float x = va[a] + vb[b2];
                if (x >= thr && cnt < 16) { if (hh == 0) { ei[cnt] = (int)((__float_as_uint(va[a]) & 0x7fu) * 128u + (__float_as_uint(vb[b2]) & 0x7fu)); eg[cnt] = __expf(x - top) * inv; } ++cnt; } }
    }
}

typedef __bf16 bf16x2_t __attribute__((ext_vector_type(2)));
__device__ __forceinline__ float gelu_erf(float v) {
    const float av = fabsf(v), d = av * 0.2316418882f + 1.0f, t = __builtin_amdgcn_rcpf(d);
    float q = t * 0.5307027145f + (-0.7265760135f); q = q * t + 0.7107068705f; q = q * t + (-0.142248368f); q = q * t + 0.127414796f; q = q * t;
    const float e = __builtin_amdgcn_exp2f((v * v) * (-0.72134752044f));
    const float m = v * (q * e), r = v - m;
    return v < 0.f ? m : r;
}
__device__ __forceinline__ float dot2bf(unsigned a, unsigned b, float c) { return __builtin_amdgcn_fdot2_f32_bf16(__builtin_bit_cast(bf16x2_t, a), __builtin_bit_cast(bf16x2_t, b), c, false); }
__device__ __forceinline__ float dpp_f(float x, int ctrl_xor1_xor2_mirror) {
    const int v = __float_as_int(x);
    if (ctrl_xor1_xor2_mirror == 0) return __int_as_float(__builtin_amdgcn_update_dpp(0, v, 0xB1, 0xF, 0xF, true));
    if (ctrl_xor1_xor2_mirror == 1) return __int_as_float(__builtin_amdgcn_update_dpp(0, v, 0x4E, 0xF, 0xF, true));
    return __int_as_float(__builtin_amdgcn_update_dpp(0, v, 0x141, 0xF, 0xF, true));
}
typedef float f32x2v __attribute__((ext_vector_type(2)));
__device__ __forceinline__ void unpack8(const u32x4 w, float* f) { f[0] = bflo(w.x); f[1] = bfhi(w.x); f[2] = bflo(w.y); f[3] = bfhi(w.y); f[4] = bflo(w.z); f[5] = bfhi(w.z); f[6] = bflo(w.w); f[7] = bfhi(w.w); }
__device__ __forceinline__ void cvt16(const u32x4 w, float* f) {
#pragma unroll
    for (int q = 0; q < 4; ++q) { const f32x2v lo = __builtin_amdgcn_cvt_pk_f32_fp8((int)w[q], false), hi = __builtin_amdgcn_cvt_pk_f32_fp8((int)w[q], true);
        f[4 * q] = lo.x; f[4 * q + 1] = lo.y; f[4 * q + 2] = hi.x; f[4 * q + 3] = hi.y; }
}
__device__ __forceinline__ void phase_experts(const Params& p, unsigned char* lds) {
    const int tid = threadIdx.x, wave = __builtin_amdgcn_readfirstlane(tid >> 6), lane = tid & 63, rr = lane >> 3, cc = lane & 7; const bool odd = cc & 1;
    const bf16_t* H2 = (const bf16_t*)(p.ws + WS_H2); const unsigned char* U8 = p.ws + WS_U8; const unsigned char* V8 = p.ws + WS_V8;
    const float* ISU = (const float*)(p.ws + WS_ISU); const float* ISV = (const float*)(p.ws + WS_ISV);
    const int* EIDX = (const int*)(p.ws + WS_EIDX); const float* EGATE = (const float*)(p.ws + WS_EGATE);
    const float* mod = (const float*)(p.ws + WS_MOD); const float* fin = p.in[16]; float* out = p.out; const float* X1 = (const float*)(p.ws + WS_X1);
    unsigned* offs = (unsigned*)lds; float* gts = (float*)(lds + 32768); float* rstl = (float*)(lds + 65536);
    const unsigned xcc = (unsigned)__builtin_amdgcn_s_getreg((3 << 11) | 20) & 7u; const unsigned cc16 = cc * 16;
    for (int tile = blockIdx.x; tile < T / 64; tile += gridDim.x) {
        const int tok0 = tile * 64, b = tok0 >> 11;
        __syncthreads();
        for (int i = tid; i < 8192; i += NTHREADS) { const int tl = i >> 7, j = i & 127, g = j >> 3, r8 = j & 7;
            offs[(tl * 8 + r8) * 16 + g] = (unsigned)EIDX[(size_t)tok0 * 128 + i] * 128u; gts[(tl * 8 + r8) * 16 + g] = EGATE[(size_t)tok0 * 128 + i]; }
        __syncthreads();
#pragma unroll 1
        for (int half = 0; half < 2; ++half) {
            const int tlb = wave * 8 + half * 4;
            u32x4 dA[16], dB[16], hA0, hA1, hB0, hB1;
#ifndef EXP_REP_U
#define EXP_REP_U 0
#endif
#ifndef EXP_REP_V
#define EXP_REP_V 0
#endif
#define EX_SLICE(i_) ((xcc * 2u + (unsigned)(i_)) & 15u)
#define EX_LOAD(buf, TBL, i_, k_) do { const unsigned char* tb_ = (TBL) + (size_t)EX_SLICE(i_) * (2u << 20); u32x4 o4_[4]; \
    _Pragma("unroll") for (int q_ = 0; q_ < 4; ++q_) o4_[q_] = *(const u32x4*)(offs + ((tlb + (k_)) * 8 + rr) * 16 + 4 * q_); \
    _Pragma("unroll") for (int g_ = 0; g_ < 16; ++g_) buf[g_] = *(const u32x4*)(tb_ + (o4_[g_ >> 2][g_ & 3] + cc16)); } while (0)
#define EX_LOADH(h0, h1, i_, k_) do { const bf16_t* hp_ = H2 + (size_t)(tok0 + tlb + (k_)) * D + EX_SLICE(i_) * 128 + cc * 16; h0 = *(const u32x4*)hp_; h1 = *(const u32x4*)(hp_ + 8); } while (0)
#define EX_DOT16(acc, WSRC, hf) do { u32x4 w_ = WSRC; asm volatile("" : "+v"(w_.x), "+v"(w_.y), "+v"(w_.z), "+v"(w_.w), "+v"(ch_)); float f_[16]; cvt16(w_, f_); _Pragma("unroll") for (int e_ = 0; e_ < 16; ++e_) acc = fmaf(f_[e_], hf[e_], acc); ch_ = acc; } while (0)
#define EX_UCOMP(buf, h0, h1, k_) do { float hf_[16]; unpack8(h0, hf_); unpack8(h1, hf_ + 8); float ch_ = 0.f; \
    _Pragma("unroll") for (int j_ = 0; j_ < 8; ++j_) { float te_ = 0.f, to_ = 0.f; EX_DOT16(te_, buf[2 * j_], hf_); __builtin_amdgcn_sched_barrier(0); EX_DOT16(to_, buf[2 * j_ + 1], hf_); \
    const float my_ = odd ? to_ : te_, ot_ = odd ? te_ : to_; zp[k_][j_] += my_ + dpp_f(ot_, 0); asm volatile("" : "+v"(zp[k_][j_])); __builtin_amdgcn_sched_barrier(0); } } while (0)
#define SB() __builtin_amdgcn_sched_barrier(0)
            float zp[4][8];
#pragma unroll
            for (int k = 0; k < 4; ++k)
#pragma unroll
                for (int j = 0; j < 8; ++j) zp[k][j] = 0.f;
            EX_LOADH(hA0, hA1, 0, 0); EX_LOAD(dA, U8, 0, 0); SB();
#pragma unroll 1
            for (int i = 0; i < 16 * (1 + EXP_REP_U); ++i) {
                __builtin_amdgcn_s_barrier();
                EX_LOADH(hB0, hB1, i, 1); EX_LOAD(dB, U8, i, 1); SB(); EX_UCOMP(dA, hA0, hA1, 0); SB();
                EX_LOADH(hA0, hA1, i, 2); EX_LOAD(dA, U8, i, 2); SB(); EX_UCOMP(dB, hB0, hB1, 1); SB();
                EX_LOADH(hB0, hB1, i, 3); EX_LOAD(dB, U8, i, 3); SB(); EX_UCOMP(dA, hA0, hA1, 2); SB();
                if (i < 16 * (1 + EXP_REP_U) - 1) { EX_LOADH(hA0, hA1, i + 1, 0); EX_LOAD(dA, U8, i + 1, 0); } SB(); EX_UCOMP(dB, hB0, hB1, 3); SB();
            }
            if (EXP_REP_U) {
#pragma unroll
                for (int k = 0; k < 4; ++k)
#pragma unroll
                    for (int j = 0; j < 8; ++j) zp[k][j] *= 0.5f; }
            unsigned* apl = (unsigned*)(lds + 66560);
#pragma unroll
            for (int k = 0; k < 4; ++k)
#pragma unroll
                for (int j = 0; j < 8; ++j) { float z = zp[k][j]; z += dpp_f(z, 1); z += __shfl_xor(z, 4);
                    const int li = ((tlb + k) * 8 + rr) * 16 + 2 * j + (odd ? 1 : 0); const unsigned eid = offs[li] >> 7;
                    const float act = gelu_erf(z * ISU[eid]) * gts[li] * ISV[eid]; const float oth = dpp_f(act, 0);
                    apl[((tlb + k) * 8 + rr) * 8 + j] = f2bf(odd ? oth : act) | (f2bf(odd ? act : oth) << 16); }
            LDS_WAIT();
            float ssq[4] = {0.f, 0.f, 0.f, 0.f};
#define EX_VCOMP(buf, i_, k_) do { float oa_[16]; _Pragma("unroll") for (int e_ = 0; e_ < 16; ++e_) oa_[e_] = 0.f; \
    const int col_ = (int)EX_SLICE(i_) * 128 + cc * 16 + 2 * rr; const size_t xo_ = (size_t)(tok0 + tlb + (k_)) * D + col_; \
    const f32x2v x1_ = *(const f32x2v*)(X1 + xo_), g2_ = *(const f32x2v*)(mod + (size_t)b * NADA + 5 * 2048 + col_); \
    const u32x4 ap0_ = *(const u32x4*)(apl + ((tlb + (k_)) * 8 + rr) * 8), ap1_ = *(const u32x4*)(apl + ((tlb + (k_)) * 8 + rr) * 8 + 4); \
    _Pragma("unroll") for (int j_ = 0; j_ < 8; ++j_) { const unsigned pr_ = (j_ < 4) ? ap0_[j_ & 3] : ap1_[j_ & 3]; const float a0_ = bflo(pr_), a1_ = bfhi(pr_); \
        { u32x4 w_ = buf[2 * j_]; asm volatile("" : "+v"(w_.x), "+v"(w_.y), "+v"(w_.z), "+v"(w_.w), "+v"(oa_[0])); float f_[16]; cvt16(w_, f_); _Pragma("unroll") for (int e_ = 0; e_ < 16; ++e_) oa_[e_] = fmaf(a0_, f_[e_], oa_[e_]); } \
        { u32x4 w_ = buf[2 * j_ + 1]; asm volatile("" : "+v"(w_.x), "+v"(w_.y), "+v"(w_.z), "+v"(w_.w), "+v"(oa_[0])); float f_[16]; cvt16(w_, f_); _Pragma("unroll") for (int e_ = 0; e_ < 16; ++e_) oa_[e_] = fmaf(a1_, f_[e_], oa_[e_]); } } \
      \
    float b8_[8], b4_[4], b2_[2]; \
    _Pragma("unroll") for (int e_ = 0; e_ < 8; ++e_) { const bool up_ = lane & 32; const float kp_ = up_ ? oa_[e_ + 8] : oa_[e_], sd_ = up_ ? oa_[e_] : oa_[e_ + 8]; b8_[e_] = kp_ + __shfl_xor(sd_, 32); } \
    _Pragma("unroll") for (int e_ = 0; e_ < 4; ++e_) { const bool up_ = lane & 16; const float kp_ = up_ ? b8_[e_ + 4] : b8_[e_], sd_ = up_ ? b8_[e_] : b8_[e_ + 4]; b4_[e_] = kp_ + __shfl_xor(sd_, 16); } \
    _Pragma("unroll") for (int e_ = 0; e_ < 2; ++e_) { const bool up_ = lane & 8; const float kp_ = up_ ? b4_[e_ + 2] : b4_[e_], sd_ = up_ ? b4_[e_] : b4_[e_ + 2]; b2_[e_] = kp_ + __shfl_xor(sd_, 8); } \
    f32x2v y_; y_.x = x1_.x + g2_.x * b2_[0]; y_.y = x1_.y + g2_.y * b2_[1]; *(f32x2v*)(out + xo_) = y_; ssq[k_] = fmaf(y_.x, y_.x, fmaf(y_.y, y_.y, ssq[k_])); asm volatile("" : "+v"(ssq[k_])); } while (0)
#pragma unroll 1
            for (int i = 0; i < 16 * (1 + EXP_REP_V); ++i) {
                if (EXP_REP_V && i == 16) { ssq[0] = 0.f; ssq[1] = 0.f; ssq[2] = 0.f; ssq[3] = 0.f; }
                __builtin_amdgcn_s_barrier();
                EX_LOAD(dA, V8, i, 0); SB(); EX_VCOMP(dA, i, 0); SB();
                EX_LOAD(dA, V8, i, 1); SB(); EX_VCOMP(dA, i, 1); SB();
                EX_LOAD(dA, V8, i, 2); SB(); EX_VCOMP(dA, i, 2); SB();
                EX_LOAD(dA, V8, i, 3); SB(); EX_VCOMP(dA, i, 3); SB();
            }
#pragma unroll
            for (int k = 0; k < 4; ++k) { const float tot = wave_sum(ssq[k]); rstl[wave * 8 + half * 4 + k] = rsqrtf(tot * (1.f / D) + NORM_EPS); }
        }
#undef EX_SLICE
#undef EX_LOAD
#undef EX_LOADH
#undef EX_DOT16
#undef EX_UCOMP
#undef EX_VCOMP
#undef SB
        __builtin_amdgcn_fence(__ATOMIC_RELEASE, "agent"); __builtin_amdgcn_fence(__ATOMIC_ACQUIRE, "agent");
        LDS_WAIT();
        int lane2 = (int)__builtin_amdgcn_mbcnt_hi(~0u, __builtin_amdgcn_mbcnt_lo(~0u, 0u)); asm volatile("" : "+v"(lane2));
#pragma unroll 1
        for (int k = 0; k < 8; ++k) { float* xr = out + (size_t)(tok0 + wave * 8 + k) * D; const float rs = rstl[wave * 8 + k];
#pragma unroll
            for (int j = 0; j < 8; ++j) { const int col = 4 * (lane2 + 64 * j); const f32x4 v = *(const f32x4*)(xr + col), f = *(const f32x4*)(fin + col);
                f32x4 o; o[0] = v[0] * rs * f[0]; o[1] = v[1] * rs * f[1]; o[2] = v[2] * rs * f[2]; o[3] = v[3] * rs * f[3]; *(f32x4*)(xr + col) = o; } }
    }
}

#define XB_TMO      128
#define XB_XCNT(j)  (256  + 64 * (j))
#define XB_XSUB(j)  (1280 + 64 * (j))
#define XB_XGEN(j)  (2304 + 64 * (j))
#define XB_TOP      3328
#define XB_TOPGEN   3392
#define XCD_BAR_WORDS 3456
#define XB_SPIN_CAP (1u << 22)
__device__ __forceinline__ unsigned xb_ld(unsigned* p)              { return __hip_atomic_load(p, __ATOMIC_RELAXED, __HIP_MEMORY_SCOPE_AGENT); }
__device__ __forceinline__ unsigned xb_add(unsigned* p, unsigned v) { return __hip_atomic_fetch_add(p, v, __ATOMIC_RELAXED, __HIP_MEMORY_SCOPE_AGENT); }
__device__ __forceinline__ unsigned xb_xcc_id() { return (unsigned)__builtin_amdgcn_s_getreg((3 << 11) | 20) & 0xFu; }
#define XB_SPIN(cond, bar) do { unsigned _sp = 0; while (cond) { __builtin_amdgcn_s_sleep(1); \
    if ((++_sp & 255u) == 0u) { if (xb_ld(&(bar)[XB_TMO])) break; if (_sp > XB_SPIN_CAP) { atomicAdd(&(bar)[XB_TMO], 1u); break; } } } } while (0)
struct XcdBarrier { unsigned* bar; unsigned x; volatile LAS unsigned* st; };
__device__ __forceinline__ XcdBarrier xcd_barrier_post(unsigned* bar, volatile LAS unsigned* st) {
    XcdBarrier b; b.bar = bar; b.x = xb_xcc_id(); b.st = st;
    if (threadIdx.x == 0) (void)xb_add(&bar[XB_XCNT(b.x)], 1u);
    return b;
}
__device__ __forceinline__ void xcd_barrier_complete(unsigned* bar, unsigned x, unsigned& nloc, unsigned& nx) {
    const unsigned G = gridDim.x * gridDim.y * gridDim.z;
    unsigned sum, cnt, mine, sp = 0u;
    for (;;) {
        sum = 0u; cnt = 0u; mine = 0u;
#pragma unroll
        for (unsigned j = 0; j < 16; ++j) { const unsigned c = xb_ld(&bar[XB_XCNT(j)]); sum += c; cnt += (c > 0u) ? 1u : 0u; mine = (j == x) ? c : mine; }
        if (sum == G) break;
        __builtin_amdgcn_s_sleep(1);
        if ((++sp & 255u) == 0u) { if (xb_ld(&bar[XB_TMO])) break; if (sp > XB_SPIN_CAP) { atomicAdd(&bar[XB_TMO], 1u); break; } }
    }
    nloc = mine > 0u ? mine : 1u; nx = cnt > 0u ? cnt : 1u;
}
__device__ __forceinline__ void xcd_barrier(const XcdBarrier& b) {
    asm volatile("s_waitcnt vmcnt(0)" ::: "memory");
    __syncthreads();
    if (threadIdx.x == 0) {
        unsigned* bar = b.bar;
        __builtin_amdgcn_s_waitcnt(0);
        unsigned nloc = b.st[0], nx = b.st[1];
        if (nloc == 0u) { xcd_barrier_complete(bar, b.x, nloc, nx); b.st[0] = nloc; b.st[1] = nx; }
        const unsigned old = xb_add(&bar[XB_XSUB(b.x)], 1u);
        const unsigned gen = old / nloc;
        if (old + 1u == (gen + 1u) * nloc) {
            __builtin_amdgcn_fence(__ATOMIC_RELEASE, "agent");
            asm volatile("s_waitcnt vmcnt(0)" ::: "memory");
            const unsigned og = xb_add(&bar[XB_TOP], 1u);
            const unsigned tg = og / nx;
            if (og + 1u == (tg + 1u) * nx) xb_add(&bar[XB_TOPGEN], 1u);
            else XB_SPIN(xb_ld(&bar[XB_TOPGEN]) == tg, bar);
            __builtin_amdgcn_fence(__ATOMIC_ACQUIRE, "agent");
            xb_add(&bar[XB_XGEN(b.x)], 1u);
            asm volatile("s_waitcnt vmcnt(0)" ::: "memory");
        } else {
            XB_SPIN(xb_ld(&bar[XB_XGEN(b.x)]) == gen, bar);
            __builtin_amdgcn_fence(__ATOMIC_ACQUIRE, "agent");
            asm volatile("s_waitcnt vmcnt(0)" ::: "memory");
        }
    }
    __syncthreads();
}

__device__ __forceinline__ void subset_barrier(unsigned* cnt, unsigned n) {
    asm volatile("s_waitcnt vmcnt(0)" ::: "memory");
    __syncthreads();
    if (threadIdx.x == 0) {
        __builtin_amdgcn_fence(__ATOMIC_RELEASE, "agent");
        asm volatile("s_waitcnt vmcnt(0)" ::: "memory");
        __hip_atomic_fetch_add(cnt, 1u, __ATOMIC_RELAXED, __HIP_MEMORY_SCOPE_AGENT);
        unsigned sp = 0;
        while (__hip_atomic_load(cnt, __ATOMIC_RELAXED, __HIP_MEMORY_SCOPE_AGENT) < n) { __builtin_amdgcn_s_sleep(1); if (++sp > (1u << 24)) break; }
        __builtin_amdgcn_fence(__ATOMIC_ACQUIRE, "agent");
        asm volatile("s_waitcnt vmcnt(0)" ::: "memory");
    }
    __syncthreads();
}
__device__ __forceinline__ void subset_wait(unsigned* cnt, unsigned n) {
    __syncthreads();
    if (threadIdx.x == 0) {
        unsigned sp = 0;
        while (__hip_atomic_load(cnt, __ATOMIC_RELAXED, __HIP_MEMORY_SCOPE_AGENT) < n) { __builtin_amdgcn_s_sleep(2); if (++sp > (1u << 24)) break; }
        __builtin_amdgcn_fence(__ATOMIC_ACQUIRE, "agent");
        asm volatile("s_waitcnt vmcnt(0)" ::: "memory");
    }
    __syncthreads();
}
constexpr int NPHASES = 11;
__global__ void __launch_bounds__(NTHREADS, 2) mega_fwd(Params p) {
    extern __shared__ __attribute__((aligned(16))) unsigned char lds[];
    cg::grid_group grid = cg::this_grid();
    const int lo = p.ph_lo, hi = p.ph_hi;
#ifndef PHASE_MASK
#define PHASE_MASK 0x7ff
#endif
#define IN(k) (((PHASE_MASK >> (k)) & 1) && lo <= (k) && (k) < hi)
#define SEAM(k) do { if (IN(k) && IN((k) + 1)) xcd_barrier(xbar); } while (0)
    unsigned char* ws = p.ws;
    bf16_t* P = (bf16_t*)(ws + WS_P);
    bf16_t* Hb = (bf16_t*)((unsigned char*)p.out + OUT_H);
    bf16_t* WinT = (bf16_t*)((unsigned char*)p.out + OUT_WIN);
    const float* mod = (const float*)(ws + WS_MOD);
    LAS unsigned char* ldsl = (LAS unsigned char*)lds;
    volatile LAS unsigned* xst = (volatile LAS unsigned*)(ldsl + LDS_BYTES - 64);
    if (threadIdx.x < 2) xst[threadIdx.x] = 0u;
    __syncthreads();
    XcdBarrier xbar = xcd_barrier_post((unsigned*)(ws + WS_CTL) + 4096, xst);

#ifndef REPEAT_PHASE
#define REPEAT_PHASE -1
#endif
    int rep3 = 0;
#define RUNPH(k, ...) do { if (IN(k)) { __VA_ARGS__; if (REPEAT_PHASE == (k)) { grid.sync(); __VA_ARGS__; } } } while (0)
    RUNPH(0, { phase_mod(p, lds); __syncthreads(); phase_weights(p, lds); });
    SEAM(0);
    RUNPH(1, { phase_norm_rows(p.in[0], p.in[4], mod, mod + 2048, Hb, LDP); });
    SEAM(1);
    RUNPH(2, { pg8::Gemm g{Hb, WinT, nullptr, nullptr, LDP, LDP, T, NP, D}; pg8::StaticOrder<1> S; S.init(T, NP, gridDim.x, blockIdx.x);
        pg8::EpiBf16 E{P, NP, 33}; pg8::gemm_phase(ldsl, g, S, E); });
    SEAM(2);
    RUNPH(3, { const int G = gridDim.x, bx = blockIdx.x;
        unsigned* sbar = (unsigned*)(ws + WS_CTL) + 12288 + ((REPEAT_PHASE == 3) ? 64 * rep3 : 0); unsigned* qh = sbar + 16;
        if (G >= 128) { if (bx < 64) { phase_hgrn(p, lds, bx, 64); if (REPEAT_PHASE == 32) phase_hgrn(p, lds, bx, 64); subset_wait(sbar, (unsigned)(G - 64)); phase_attn_queue(p, lds, qh); }
                        else { phase_vt(p, lds, bx - 64, G - 64); phase_indexer(p, lds, bx - 64, G - 64); if (REPEAT_PHASE == 31) phase_indexer(p, lds, bx - 64, G - 64);
                               subset_barrier(sbar, (unsigned)(G - 64)); phase_attn_queue(p, lds, qh); } }
        else { phase_vt(p, lds, bx, G); phase_indexer(p, lds, bx, G); __syncthreads(); phase_hgrn(p, lds, bx, G); grid.sync(); phase_attn(p, lds, bx, G); }
        ++rep3; });
    SEAM(3);
    RUNPH(5, { pg8::Gemm g{(const bf16_t*)((unsigned char*)p.out + OUT_AO), (const bf16_t*)(ws + WS_WUA), (const bf16_t*)((unsigned char*)p.out + OUT_REC), (const bf16_t*)(ws + WS_WUB), 1024, 1024, T, D, 1024}; pg8::StaticOrder<2> S; S.init(T, D, gridDim.x, blockIdx.x);
        pg8::EpiMix E{(bf16_t*)(ws + WS_MIXED), P}; pg8::gemm_phase(ldsl, g, S, E); });
    SEAM(5);
    RUNPH(6, { pg8::Gemm g{(const bf16_t*)(ws + WS_MIXED), (const bf16_t*)(ws + WS_WOUT), nullptr, nullptr, D, D, T, D, D}; pg8::StaticOrder<1> S; S.init(T, D, gridDim.x, blockIdx.x);
        pg8::EpiX1 E{p.in[0], (float*)(ws + WS_X1), mod + 4096}; pg8::gemm_phase(ldsl, g, S, E); });
    SEAM(6);
    RUNPH(7, { phase_norm_rows((const float*)(ws + WS_X1), p.in[5], mod + 3 * 2048, mod + 4 * 2048, (bf16_t*)(ws + WS_H2), D); phase_uv(p); });
    SEAM(7);
    RUNPH(8, { pg8::Gemm g{(const bf16_t*)(ws + WS_H2), (const bf16_t*)(ws + WS_WQ), nullptr, nullptr, D, D, T, D, D}; pg8::StaticOrder<1> S; S.init(T, D, gridDim.x, blockIdx.x);
        pg8::EpiBf16 E{(bf16_t*)(ws + WS_QP), D, 1 << 30}; pg8::gemm_phase(ldsl, g, S, E); });
    SEAM(8);
    RUNPH(9, { phase_peer_topk_ni((const GAS bf16_t*)(ws + WS_QP), (const GAS bf16_t*)(ws + WS_KEYS), (GAS int*)(ws + WS_EIDX), (GAS float*)(ws + WS_EGATE), ldsl); });
    SEAM(9);
    RUNPH(10, { phase_experts(p, lds); });
    if (p.ph_hi > NPHASES) grid.sync();
#undef IN
#undef SEAM
}

#ifndef MK_N_LAUNCHES
#define MK_N_LAUNCHES 1
#endif
extern "C" void kernel_launch(void* const* d_in, const int* in_sizes, int n_in, void* d_out, int out_size, void* d_ws, size_t ws_size, hipStream_t stream) {
    static int grid = 0;
    if (grid == 0) {
        if (n_in != 17 || out_size != T * D || ws_size < WS_END) { fprintf(stderr, "kernel_launch: unexpected shapes (n_in %d out %d ws %zu)\n", n_in, out_size, ws_size); grid = -1; return; }
        int dev = 0, cus = 0, per_cu = 0;
        hipGetDevice(&dev); hipDeviceGetAttribute(&cus, hipDeviceAttributeMultiprocessorCount, dev);
        hipFuncSetAttribute((const void*)mega_fwd, hipFuncAttributeMaxDynamicSharedMemorySize, LDS_BYTES);
        hipOccupancyMaxActiveBlocksPerMultiprocessor(&per_cu, (const void*)mega_fwd, NTHREADS, LDS_BYTES);
        if (per_cu < 1) { fprintf(stderr, "kernel_launch: occupancy query says %d blocks/CU\n", per_cu); per_cu = 1; }
        (void)hipGetLastError();
        grid = cus * 1;
    }
    if (grid < 0) return;
    if (hipMemsetAsync((char*)d_ws + WS_CTL, 0, 65536, stream) != hipSuccess) { fprintf(stderr, "kernel_launch: memset failed\n"); return; }
    Params p{};
    for (int i = 0; i < 17; ++i) p.in[i] = (const float*)d_in[i];
    p.out = (float*)d_out; p.ws = (unsigned char*)d_ws;
#if MK_N_LAUNCHES == 1
    p.ph_lo = 0; p.ph_hi = NPHASES;
    void* args[] = {&p};
    hipError_t e = hipLaunchCooperativeKernel((const void*)mega_fwd, dim3(grid), dim3(NTHREADS), args, LDS_BYTES, stream);
    if (e != hipSuccess) fprintf(stderr, "cooperative launch failed: %s (grid %d)\n", hipGetErrorString(e), grid);
#else
    for (int k = 0; k < NPHASES; ++k) { p.ph_lo = k; p.ph_hi = k + 1; void* args[] = {&p};
        hipError_t e = hipLaunchCooperativeKernel((const void*)mega_fwd, dim3(grid), dim3(NTHREADS), args, LDS_BYTES, stream);
        if (e != hipSuccess) { fprintf(stderr, "launch %d failed: %s\n", k, hipGetErrorString(e)); break; } }
#endif
}
```

```cpp
#include <hip/hip_runtime.h>
#include <hip/hip_cooperative_groups.h>
#include <cstdio>
#include <cstdint>
namespace cg = cooperative_groups;

#define LAS __attribute__((address_space(3)))
typedef unsigned short bf16_t;
typedef short bf16x8 __attribute__((ext_vector_type(8)));
typedef short bf16x4 __attribute__((ext_vector_type(4)));
typedef float f32x2 __attribute__((ext_vector_type(2)));
typedef float f32x4 __attribute__((ext_vector_type(4)));
typedef float f32x16 __attribute__((ext_vector_type(16)));
typedef unsigned u32x2 __attribute__((ext_vector_type(2)));
typedef unsigned u32x4 __attribute__((ext_vector_type(4)));

constexpr int T = 16384, D = 2048, SEQ = 2048, NBATCH = 8, NP = 12544;
constexpr int C_QA = 0, C_KA = 1024, C_VA = 2048, C_QI = 3072, C_KI = 4096, C_WI = 4160, C_QB = 4352, C_FB = 5376, C_IB = 6400, C_GB = 7424, C_GA = 8448, C_GG = 10496;
constexpr int NADA = 12288;
constexpr float NORM_EPS = 1e-6f;
constexpr int NTHREADS = 512, NWAVES = 8;
constexpr int LDS_BYTES = 147456;
constexpr size_t MiB = 1u << 20;
constexpr size_t WS_CTL = 0, WS_MOD = 1 * MiB, WS_WUA = 2 * MiB, WS_WUB = 6 * MiB, WS_WOUT = 10 * MiB, WS_WQ = 18 * MiB, WS_KEYS = 26 * MiB, WS_MASK = 27 * MiB;
constexpr size_t WS_MIXED = 32 * MiB;
constexpr size_t WS_VT = 32 * MiB, WS_ORAW = 64 * MiB;
constexpr size_t WS_P = 96 * MiB;
constexpr size_t WS_H2 = 96 * MiB, WS_QP = 160 * MiB, WS_U8 = 224 * MiB, WS_V8 = 256 * MiB, WS_ISU = 26 * MiB + 512 * 1024, WS_ISV = 26 * MiB + 768 * 1024, WS_Y = 288 * MiB, WS_EIDX = 352 * MiB, WS_EGATE = 360 * MiB;
constexpr size_t WS_X1 = 368 * MiB;
constexpr size_t WS_END = 496 * MiB;
constexpr int LDP = 2048 + 64;
constexpr size_t OUT_H = 0, OUT_WIN = 68 * MiB;
constexpr size_t OUT_AO = 0, OUT_REC = 32 * MiB;

struct Params { const float* in[17]; float* out; unsigned char* ws; int ph_lo, ph_hi; };

__device__ __forceinline__ unsigned f2bf(float f) { unsigned u = __float_as_uint(f); return (u + 0x7fffu + ((u >> 16) & 1u)) >> 16; }
__device__ __forceinline__ float bf2f(unsigned b) { return __uint_as_float(b << 16); }
__device__ __forceinline__ float bflo(unsigned w) { return __uint_as_float(w << 16); }
__device__ __forceinline__ float bfhi(unsigned w) { return __uint_as_float(w & 0xffff0000u); }
__device__ __forceinline__ unsigned pk2(float lo, float hi) { unsigned r; asm volatile("v_cvt_pk_bf16_f32 %0, %1, %2" : "=v"(r) : "v"(lo), "v"(hi)); return r; }
__device__ __forceinline__ float wave_sum(float v) {
#pragma unroll
    for (int o = 1; o < 64; o <<= 1) v += __shfl_xor(v, o);
    return v;
}
__device__ __forceinline__ float sigmoidf_(float v) { return 1.f / (1.f + __expf(-v)); }
__device__ __forceinline__ float siluf_(float v) { return v / (1.f + __expf(-v)); }
#define LDS_WAIT() asm volatile("s_waitcnt lgkmcnt(0)" ::: "memory")

namespace pg8 {
constexpr int BM = 256, BK = 64, HALF = 128, HTB = HALF * BK * 2, STAGE_BYTES = 8 * HTB, NXCD = 8, WGM = 8;
__host__ __device__ __forceinline__ int lds_byte(int r, int c) { const int st = (r >> 4) * 2 + (c >> 5), rr = r & 15, cc = c & 31, ob = rr * 64 + cc * 2; return st * 1024 + (ob ^ (((ob >> 9) & 1) << 5)); }
__host__ __device__ __forceinline__ void stage_rc(int b, int& R, int& C) { const int st = b / 1024, sb = b % 1024, swz = sb ^ (((sb >> 9) & 1) << 5); R = (st >> 1) * 16 + swz / 64; C = (st & 1) * 32 + (swz % 64) / 2; }
__host__ __device__ __forceinline__ int perm32(int rho) { const int n = rho >> 4, i = rho & 15; return 8 * (i >> 2) + 4 * n + (i & 3); }

struct Unit { int pm, pn, z; };
struct Gemm { const bf16_t* A; const bf16_t* Bt; const bf16_t* A2; const bf16_t* Bt2; int lda, ldb, M, N, K; };

template <int NZ> struct StaticOrder {
    int nM, nN, nwg, G, c;
    __device__ void init(int M, int N, int G_, int c_) { nM = M / BM; nN = N / BM; nwg = nM * nN; G = G_; c = c_; }
    __device__ bool next(int i, Unit& u) const {
        const long L = (long)(i / NZ) * G + c; if (L >= nwg) return false;
        int wgid = (int)L; { const int q = nwg / NXCD, r = nwg % NXCD, xcd = wgid % NXCD, off = wgid / NXCD; wgid = (xcd < r ? xcd * (q + 1) : r * (q + 1) + (xcd - r) * q) + off; }
        const int nig = WGM * nN, gid = wgid / nig, fm = gid * WGM, gsz = (nM - fm) < WGM ? (nM - fm) : WGM;
        u.pm = fm + ((wgid % nig) % gsz); u.pn = (wgid % nig) / gsz; u.z = i % NZ; return true;
    }
};

template <class Epi, class Sched>
__device__ __forceinline__ void gemm_phase(LAS unsigned char* lds, const Gemm g, const Sched& S, const Epi& E) {
    const int tid = threadIdx.x, wid = __builtin_amdgcn_readfirstlane(tid >> 6), lane = tid & 63, wr = wid >> 2, wc = wid & 3, fr = lane & 15, fq = lane >> 4;
    const int K = g.K, nt = K / BK;
    unsigned voffA[2], voffB[2];
#pragma unroll
    for (int i = 0; i < 2; ++i) { int R, C; stage_rc(tid * 16 + i * 8192, R, C); const int Rb = Epi::PERM ? ((R & ~31) + perm32(R & 31)) : R;
        voffA[i] = (unsigned)(R * g.lda + C) * 2u; voffB[i] = (unsigned)(Rb * g.ldb + C) * 2u; }
    const size_t kstep = (size_t)(BK * 2);
    const size_t hstepA = (size_t)HALF * g.lda * 2, hstepB = (size_t)HALF * g.ldb * 2;
    const size_t tstepA = 2 * hstepA, tstepB = 2 * hstepB;
    const unsigned ldsw = (unsigned)wid * 1024u;
    const int aoff = lds_byte(wr * 64 + fr, fq * 8), boff = lds_byte(wc * 32 + fr, fq * 8);
#define PG8_SA(b, h) (((b) * 2 + (h)) * HTB)
#define PG8_SB(b, h) ((4 + (b) * 2 + (h)) * HTB)
#define PG8_STAGE(bufoff, gbase, voff) do { _Pragma("unroll") for (int _i = 0; _i < 2; ++_i) \
        __builtin_amdgcn_global_load_lds((const unsigned*)((const char*)(gbase) + (voff)[_i]), (LAS unsigned*)(lds + (bufoff) + ldsw + _i * 8192), 16, 0, 0); } while (0)
#define PG8_LDA(dst, b, h) do { _Pragma("unroll") for (int m = 0; m < 4; ++m) _Pragma("unroll") for (int k = 0; k < 2; ++k) dst[m][k] = *(const LAS bf16x8*)(lds + PG8_SA(b, h) + aoff + m * 2048 + k * 1024); } while (0)
#define PG8_LDB(dst, b, h) do { _Pragma("unroll") for (int n = 0; n < 2; ++n) _Pragma("unroll") for (int k = 0; k < 2; ++k) dst[n][k] = *(const LAS bf16x8*)(lds + PG8_SB(b, h) + boff + n * 2048 + k * 1024); } while (0)
#define PG8_MMA(ai, bj, At, Bt) do { __builtin_amdgcn_s_setprio(1); _Pragma("unroll") for (int m = 0; m < 4; ++m) _Pragma("unroll") for (int n = 0; n < 2; ++n) _Pragma("unroll") for (int k = 0; k < 2; ++k) \
        acc[ai][bj][m][n] = __builtin_amdgcn_mfma_f32_16x16x32_bf16(Bt[n][k], At[m][k], acc[ai][bj][m][n], 0, 0, 0); __builtin_amdgcn_s_setprio(0); } while (0)
#define PG8_WAIT_V(n) asm volatile("s_waitcnt vmcnt(" #n ")" ::: "memory")
#define PG8_WAIT_L(n) asm volatile("s_waitcnt lgkmcnt(" #n ")" ::: "memory")
#define PG8_BAR __builtin_amdgcn_s_barrier()
#define PG8_SCHED __builtin_amdgcn_sched_barrier(0)
#define PG8_ABASE(u) ((const char*)((u).z ? g.A2 : g.A) + (size_t)(u).pm * tstepA)
#define PG8_BBASE(u) ((const char*)((u).z ? g.Bt2 : g.Bt) + (size_t)(u).pn * tstepB)
    Unit cur, nxt; int ui = 0;
    if (!S.next(0, cur)) return;
    f32x4 acc[2][2][4][2];
#pragma unroll
    for (int a = 0; a < 2; ++a)
#pragma unroll
        for (int b = 0; b < 2; ++b)
#pragma unroll
            for (int m = 0; m < 4; ++m)
#pragma unroll
                for (int n = 0; n < 2; ++n) acc[a][b][m][n] = (f32x4){0.f, 0.f, 0.f, 0.f};
    bf16x8 At[4][2], B0[2][2], B1[2][2];
    const char* cA = PG8_ABASE(cur); const char* cB = PG8_BBASE(cur);
    PG8_STAGE(PG8_SB(0, 0), cB, voffB); PG8_STAGE(PG8_SA(0, 0), cA, voffA); PG8_STAGE(PG8_SB(0, 1), cB + hstepB, voffB); PG8_STAGE(PG8_SA(0, 1), cA + hstepA, voffA);
    if (wr == 1) PG8_BAR;
    PG8_WAIT_V(4); PG8_BAR;
    PG8_STAGE(PG8_SB(1, 0), cB + kstep, voffB); PG8_STAGE(PG8_SA(1, 0), cA + kstep, voffA); PG8_STAGE(PG8_SB(1, 1), cB + hstepB + kstep, voffB);
    PG8_WAIT_V(6); PG8_BAR;
    for (;;) {
        const bool has_next = S.next(ui + 1, nxt);
        const char* nA = has_next ? PG8_ABASE(nxt) : cA; const char* nB = has_next ? PG8_BBASE(nxt) : cB;
        for (int t = 0; t < nt; t += 2) {
            const bool last = (t == nt - 2);
            const char* a1 = cA + (size_t)(t + 1) * kstep;
            const char* a2 = last ? nA : cA + (size_t)(t + 2) * kstep; const char* b2 = last ? nB : cB + (size_t)(t + 2) * kstep;
            const char* a3 = a2 + kstep; const char* b3 = b2 + kstep;
            PG8_LDB(B0, 0, 0); PG8_SCHED; PG8_LDA(At, 0, 0); PG8_STAGE(PG8_SA(1, 1), a1 + hstepA, voffA);
            PG8_WAIT_L(8); PG8_BAR; PG8_WAIT_L(0); PG8_MMA(0, 0, At, B0); PG8_BAR; PG8_SCHED;
            PG8_LDB(B1, 0, 1); PG8_STAGE(PG8_SB(0, 0), b2, voffB);
            PG8_BAR; PG8_WAIT_L(0); PG8_MMA(0, 1, At, B1); PG8_BAR;
            PG8_LDA(At, 0, 1); PG8_STAGE(PG8_SA(0, 0), a2, voffA);
            PG8_BAR; PG8_WAIT_L(0); PG8_MMA(1, 0, At, B0); PG8_BAR; PG8_SCHED;
            PG8_STAGE(PG8_SB(0, 1), b2 + hstepB, voffB);
            PG8_WAIT_V(6); PG8_BAR; PG8_MMA(1, 1, At, B1); PG8_BAR;
            PG8_LDB(B0, 1, 0); PG8_SCHED; PG8_LDA(At, 1, 0); PG8_STAGE(PG8_SA(0, 1), a2 + hstepA, voffA);
            PG8_WAIT_L(8); PG8_BAR; PG8_WAIT_L(0); PG8_MMA(0, 0, At, B0); PG8_BAR; PG8_SCHED;
            PG8_LDB(B1, 1, 1); PG8_STAGE(PG8_SB(1, 0), b3, voffB);
            PG8_BAR; PG8_WAIT_L(0); PG8_MMA(0, 1, At, B1); PG8_BAR;
            PG8_LDA(At, 1, 1); PG8_STAGE(PG8_SA(1, 0), a3, voffA);
            PG8_BAR; PG8_WAIT_L(0); PG8_MMA(1, 0, At, B0); PG8_BAR; PG8_SCHED;
            PG8_STAGE(PG8_SB(1, 1), b3 + hstepB, voffB);
            PG8_WAIT_V(6); PG8_BAR; PG8_MMA(1, 1, At, B1); PG8_BAR;
        }
        E(acc, cur, wr, wc, fr, fq);
        if (!has_next) break;
#pragma unroll
        for (int a = 0; a < 2; ++a)
#pragma unroll
            for (int b = 0; b < 2; ++b)
#pragma unroll
                for (int m = 0; m < 4; ++m)
#pragma unroll
                    for (int n = 0; n < 2; ++n) acc[a][b][m][n] = (f32x4){0.f, 0.f, 0.f, 0.f};
        cur = nxt; cA = nA; cB = nB; ++ui;
    }
    PG8_WAIT_V(0);
    if (wr == 0) PG8_BAR;
    PG8_BAR;
#undef PG8_SA
#undef PG8_SB
#undef PG8_STAGE
#undef PG8_LDA
#undef PG8_LDB
#undef PG8_MMA
#undef PG8_WAIT_V
#undef PG8_WAIT_L
#undef PG8_BAR
#undef PG8_SCHED
#undef PG8_ABASE
#undef PG8_BBASE
}

struct EpiBf16 {
    static constexpr bool PERM = true;
    bf16_t* O; int ldc; int sig_from;
    __device__ __forceinline__ void operator()(const f32x4 (&acc)[2][2][4][2], const Unit& u, int wr, int wc, int fr, int fq) const {
        const int row0 = u.pm * BM + wr * 64 + fr, col0 = u.pn * BM + wc * 32 + 8 * fq; const bool sig = u.pn >= sig_from;
#pragma unroll
        for (int ai = 0; ai < 2; ++ai)
#pragma unroll
            for (int m = 0; m < 4; ++m) { bf16_t* rowp = O + (size_t)(row0 + ai * HALF + m * 16) * ldc + col0;
#pragma unroll
                for (int bj = 0; bj < 2; ++bj) { f32x4 v0 = acc[ai][bj][m][0], v1 = acc[ai][bj][m][1];
                    if (sig) {
#pragma unroll
                        for (int j = 0; j < 4; ++j) { v0[j] = sigmoidf_(v0[j]); v1[j] = sigmoidf_(v1[j]); } }
                    u32x4 w; w.x = pk2(v0[0], v0[1]); w.y = pk2(v0[2], v0[3]); w.z = pk2(v1[0], v1[1]); w.w = pk2(v1[2], v1[3]);
                    *(u32x4*)(rowp + bj * HALF) = w; } }
    }
};
struct EpiMix {
    static constexpr bool PERM = true;
    bf16_t* O; const bf16_t* P;
    __device__ __forceinline__ void operator()(const f32x4 (&acc)[2][2][4][2], const Unit& u, int wr, int wc, int fr, int fq) const {
        const int row0 = u.pm * BM + wr * 64 + fr, col0 = u.pn * BM + wc * 32 + 8 * fq; const int gcol = (u.z ? C_GG : C_GA);
#pragma unroll
        for (int ai = 0; ai < 2; ++ai) {
            u32x4 gw[4][2], pw[4][2];
#pragma unroll
            for (int m = 0; m < 4; ++m)
#pragma unroll
                for (int bj = 0; bj < 2; ++bj) { const size_t r = (size_t)(row0 + ai * HALF + m * 16);
                    gw[m][bj] = *(const u32x4*)(P + r * NP + gcol + col0 + bj * HALF);
                    if (u.z) pw[m][bj] = *(const u32x4*)(O + r * D + col0 + bj * HALF); else pw[m][bj] = (u32x4){0u, 0u, 0u, 0u}; }
            asm volatile("" ::: "memory");
#pragma unroll
            for (int m = 0; m < 4; ++m)
#pragma unroll
                for (int bj = 0; bj < 2; ++bj) { const size_t r = (size_t)(row0 + ai * HALF + m * 16); const f32x4 v0 = acc[ai][bj][m][0], v1 = acc[ai][bj][m][1]; const u32x4 g = gw[m][bj], q = pw[m][bj];
                    u32x4 w; w.x = pk2(fmaf(v0[0], bflo(g.x), bflo(q.x)), fmaf(v0[1], bfhi(g.x), bfhi(q.x))); w.y = pk2(fmaf(v0[2], bflo(g.y), bflo(q.y)), fmaf(v0[3], bfhi(g.y), bfhi(q.y)));
                    w.z = pk2(fmaf(v1[0], bflo(g.z), bflo(q.z)), fmaf(v1[1], bfhi(g.z), bfhi(q.z))); w.w = pk2(fmaf(v1[2], bflo(g.w), bflo(q.w)), fmaf(v1[3], bfhi(g.w), bfhi(q.w)));
                    *(u32x4*)(O + r * D + col0 + bj * HALF) = w; }
            asm volatile("" ::: "memory");
        }
    }
};
struct EpiX1 {
    static constexpr bool PERM = false;
    const float* x; float* out; const float* gate;
    __device__ __forceinline__ void operator()(const f32x4 (&acc)[2][2][4][2], const Unit& u, int wr, int wc, int fr, int fq) const {
        const int row0 = u.pm * BM + wr * 64 + fr, col0 = u.pn * BM + wc * 32 + 4 * fq; const int b = (u.pm * BM) >> 11;
        f32x4 gv[2][2];
#pragma unroll
        for (int bj = 0; bj < 2; ++bj)
#pragma unroll
            for (int n = 0; n < 2; ++n) gv[bj][n] = *(const f32x4*)(gate + (size_t)b * NADA + col0 + bj * HALF + n * 16);
#pragma unroll
        for (int ai = 0; ai < 2; ++ai) {
            f32x4 xv[4][2][2];
#pragma unroll
            for (int m = 0; m < 4; ++m)
#pragma unroll
                for (int bj = 0; bj < 2; ++bj)
#pragma unroll
                    for (int n = 0; n < 2; ++n) xv[m][bj][n] = *(const f32x4*)(x + (size_t)(row0 + ai * HALF + m * 16) * D + col0 + bj * HALF + n * 16);
            asm volatile("" ::: "memory");
#pragma unroll
            for (int m = 0; m < 4; ++m)
#pragma unroll
                for (int bj = 0; bj < 2; ++bj)
#pragma unroll
                    for (int n = 0; n < 2; ++n) *(f32x4*)(out + (size_t)(row0 + ai * HALF + m * 16) * D + col0 + bj * HALF + n * 16) = xv[m][bj][n] + gv[bj][n] * acc[ai][bj][m][n];
            asm volatile("" ::: "memory");
        }
    }
};
}

__device__ __forceinline__ void phase_mod(const Params& p, unsigned char* lds) {
    float* sc = (float*)lds;
    float* red = (float*)(lds + 65536);
    const int tid = threadIdx.x, wave = tid >> 6, lane = tid & 63;
    const float* c = p.in[1]; const float* wada = p.in[2]; const float* bada = p.in[3];
    float* mod = (float*)(p.ws + WS_MOD);
    if ((int)blockIdx.x >= 192) return;
    for (int i = tid; i < NBATCH * D; i += NTHREADS) { const int b = i >> 11, k = i & 2047; sc[k * 8 + b] = siluf_(c[i]); }
    __syncthreads();
    const int cgp = tid & 15, rg = tid >> 4;
    for (int item = blockIdx.x; item < 192; item += gridDim.x) {
        const float* w = wada + item * 64 + cgp * 4;
        float acc[8][4];
#pragma unroll
        for (int b = 0; b < 8; ++b)
#pragma unroll
            for (int j = 0; j < 4; ++j) acc[b][j] = 0.f;
#pragma unroll 1
        for (int i0 = 0; i0 < 64; i0 += 8) {
            f32x4 wvv[8];
#pragma unroll
            for (int u = 0; u < 8; ++u) wvv[u] = __builtin_nontemporal_load((const f32x4*)(w + (size_t)(rg + 32 * (i0 + u)) * NADA));
#pragma unroll
            for (int u = 0; u < 8; ++u) { const int k = rg + 32 * (i0 + u); const f32x4 wv = wvv[u];
                const f32x4 s0 = *(const f32x4*)(sc + k * 8), s1 = *(const f32x4*)(sc + k * 8 + 4);
#pragma unroll
                for (int j = 0; j < 4; ++j) { acc[0][j] += s0[0] * wv[j]; acc[1][j] += s0[1] * wv[j]; acc[2][j] += s0[2] * wv[j]; acc[3][j] += s0[3] * wv[j];
                    acc[4][j] += s1[0] * wv[j]; acc[5][j] += s1[1] * wv[j]; acc[6][j] += s1[2] * wv[j]; acc[7][j] += s1[3] * wv[j]; } } }
#pragma unroll
        for (int b = 0; b < 8; ++b)
#pragma unroll
            for (int j = 0; j < 4; ++j) { float v = acc[b][j]; v += __shfl_xor(v, 16); v += __shfl_xor(v, 32); acc[b][j] = v; }
        if (lane < 16) {
#pragma unroll
            for (int b = 0; b < 8; ++b)
#pragma unroll
                for (int j = 0; j < 4; ++j) red[(wave * 16 + cgp) * 32 + b * 4 + j] = acc[b][j]; }
        __syncthreads();
        { const int cgo = tid >> 5, b = (tid >> 2) & 7, j = tid & 3; float s = 0.f;
#pragma unroll
          for (int w8 = 0; w8 < 8; ++w8) s += red[(w8 * 16 + cgo) * 32 + (tid & 31)];
          const int col = item * 64 + cgo * 4 + j; mod[b * NADA + col] = s + bada[col]; }
        __syncthreads();
    }
}
__device__ __forceinline__ void transpose_item(const float* W, int K, int N, bf16_t* WT, int nblk, int item, int lane, float* scr, int mode, int pitch) {
    const int kb = item / nblk, nb = item % nblk, k0 = 64 * kb, n0 = 32 * nb;
    const int nd = n0 + (lane & 31); int ns = nd; bool valid = true;
    if (mode == 1) { if (nd >= C_QB) ns = nd - 176; else if (nd >= 4176) valid = false; }
    if (mode == 0 || n0 < 4160 || n0 >= C_QB) {
        const int ns0 = (mode == 1 && n0 >= C_QB) ? n0 - 176 : n0;
        f32x4 v[8];
#pragma unroll
        for (int i = 0; i < 8; ++i) v[i] = *(const f32x4*)(W + (size_t)(k0 + 8 * i + (lane >> 3)) * N + ns0 + 4 * (lane & 7));
#pragma unroll
        for (int i = 0; i < 8; ++i) { float* d = scr + (8 * i + (lane >> 3)) * 33 + 4 * (lane & 7); d[0] = v[i][0]; d[1] = v[i][1]; d[2] = v[i][2]; d[3] = v[i][3]; }
    } else {
#pragma unroll 8
        for (int i = 0; i < 32; ++i) { const int kk = 2 * i + (lane >> 5); scr[kk * 33 + (lane & 31)] = valid ? W[(size_t)(k0 + kk) * N + ns] : 0.f; }
    }
    LDS_WAIT();
    const int c = lane & 7;
#pragma unroll
    for (int j = 0; j < 4; ++j) { const int n = (lane >> 3) + 8 * j; const float* s = scr + (8 * c) * 33 + n;
        u32x4 o; o.x = pk2(s[0 * 33], s[1 * 33]); o.y = pk2(s[2 * 33], s[3 * 33]); o.z = pk2(s[4 * 33], s[5 * 33]); o.w = pk2(s[6 * 33], s[7 * 33]);
        *(u32x4*)(WT + (size_t)(n0 + n) * pitch + k0 + 8 * c) = o; }
    LDS_WAIT();
}
__device__ __forceinline__ void phase_weights(const Params& p, unsigned char* lds) {
    const int tid = threadIdx.x, wave = tid >> 6, lane = tid & 63;
    float* scr = (float*)(lds + wave * 16384);
    const int vb = ((int)blockIdx.x + (int)gridDim.x - 192 % (int)gridDim.x) % (int)gridDim.x;
    const int gw = vb * NWAVES + wave, NGW = gridDim.x * NWAVES;
    constexpr int I_IN = 32 * (NP / 32), I_UA = 16 * 64, I_UB = 16 * 64, I_O = 32 * 64, I_Q = 32 * 64;
    constexpr int NITEMS = I_IN + I_UA + I_UB + I_O + I_Q;
    bf16_t* win_t = (bf16_t*)((unsigned char*)p.out + OUT_WIN);
    for (int it = gw; it < NITEMS; it += NGW) {
        int r = it;
        if (r < I_IN) { transpose_item(p.in[6], 2048, 12368, win_t, NP / 32, r, lane, scr, 1, LDP); continue; } r -= I_IN;
        if (r < I_UA) { transpose_item(p.in[9], 1024, 2048, (bf16_t*)(p.ws + WS_WUA), 64, r, lane, scr, 0, 1024); continue; } r -= I_UA;
        if (r < I_UB) { transpose_item(p.in[10], 1024, 2048, (bf16_t*)(p.ws + WS_WUB), 64, r, lane, scr, 0, 1024); continue; } r -= I_UB;
        if (r < I_O) { transpose_item(p.in[11], 2048, 2048, (bf16_t*)(p.ws + WS_WOUT), 64, r, lane, scr, 0, 2048); continue; } r -= I_O;
        transpose_item(p.in[12], 2048, 2048, (bf16_t*)(p.ws + WS_WQ), 64, r, lane, scr, 0, 2048);
    }
    { const float* ks = p.in[13]; bf16_t* kd = (bf16_t*)(p.ws + WS_KEYS);
      for (int i = (blockIdx.x * NTHREADS + tid) * 4; i < 8 * 2 * 128 * 128; i += gridDim.x * NTHREADS * 4) { const f32x4 v = *(const f32x4*)(ks + i); u32x2 o; o.x = pk2(v[0], v[1]); o.y = pk2(v[2], v[3]); *(u32x2*)(kd + i) = o; } }
}

__device__ __forceinline__ void phase_norm_rows(const float* src, const float* gain, const float* shift, const float* scale, bf16_t* dst, int pitch) {
    const int tid = threadIdx.x, wave = tid >> 6, lane = tid & 63;
    const int gw = blockIdx.x * NWAVES + wave, NGW = gridDim.x * NWAVES;
    for (int row = gw; row < T; row += NGW) {
        const int b = row >> 11; const f32x4* xr = (const f32x4*)(src + (size_t)row * D) + lane;
        f32x4 v[8]; float ss = 0.f;
#pragma unroll
        for (int j = 0; j < 8; ++j) { v[j] = xr[64 * j]; ss += (v[j][0] * v[j][0] + v[j][1] * v[j][1]) + (v[j][2] * v[j][2] + v[j][3] * v[j][3]); }
        const float rstd = rsqrtf(wave_sum(ss) * (1.f / D) + NORM_EPS);
        u32x2* o8 = (u32x2*)(dst + (size_t)row * pitch) + lane;
#pragma unroll
        for (int j = 0; j < 8; ++j) { const int col = 4 * (lane + 64 * j);
            const f32x4 g = *(const f32x4*)(gain + col), sh = *(const f32x4*)(shift + (size_t)b * NADA + col), sc = *(const f32x4*)(scale + (size_t)b * NADA + col);
            f32x4 h;
#pragma unroll
            for (int e = 0; e < 4; ++e) h[e] = v[j][e] * rstd * g[e] * (1.f + sc[e]) + sh[e];
            u32x2 w; w.x = pk2(h[0], h[1]); w.y = pk2(h[2], h[3]); o8[64 * j] = w; }
    }
}

__device__ __forceinline__ void phase_vt(const Params& p, unsigned char* lds, int vb, int vG) {
    const int tid = threadIdx.x, wave = tid >> 6, lane = tid & 63;
    bf16_t* tile = (bf16_t*)(lds + wave * 16384);
    const bf16_t* P = (const bf16_t*)(p.ws + WS_P); bf16_t* VT = (bf16_t*)(p.ws + WS_VT);
    const int gw = vb * NWAVES + wave, NGW = vG * NWAVES;
    for (int it = gw; it < 8 * 8 * 32 * 2; it += NGW) {
        const int dh = it & 1, kt = (it >> 1) & 31, h = (it >> 6) & 7, b = it >> 9;
        const int k0 = kt * 64, d0 = dh * 64;
#pragma unroll
        for (int i = 0; i < 8; ++i) { const int key = i * 8 + (lane >> 3), dc = lane & 7;
            const u32x4 v = *(const u32x4*)(P + (size_t)(b * SEQ + k0 + key) * NP + C_VA + h * 128 + d0 + dc * 8);
            bf16_t* t = tile + (dc * 8) * 72 + key;
            t[0 * 72] = (bf16_t)(v.x & 0xffff); t[1 * 72] = (bf16_t)(v.x >> 16); t[2 * 72] = (bf16_t)(v.y & 0xffff); t[3 * 72] = (bf16_t)(v.y >> 16);
            t[4 * 72] = (bf16_t)(v.z & 0xffff); t[5 * 72] = (bf16_t)(v.z >> 16); t[6 * 72] = (bf16_t)(v.w & 0xffff); t[7 * 72] = (bf16_t)(v.w >> 16); }
        LDS_WAIT();
#pragma unroll
        for (int i = 0; i < 8; ++i) { const int d = i * 8 + (lane >> 3), kc = lane & 7;
            const u32x4 v = *(const u32x4*)(tile + d * 72 + kc * 8);
            *(u32x4*)(VT + ((size_t)((b * 8 + h) * 128 + d0 + d)) * SEQ + k0 + kc * 8) = v; }
        LDS_WAIT();
    }
}

__device__ __forceinline__ unsigned ord_key(float s) { const unsigned u = __float_as_uint(s); return (u & 0x80000000u) ? ~u : (u | 0x80000000u); }
__device__ __forceinline__ int half_sum(int v) {
    v += __builtin_amdgcn_update_dpp(0, v, 0xB1, 0xF, 0xF, true);
    v += __builtin_amdgcn_update_dpp(0, v, 0x4E, 0xF, 0xF, true);
    v += __builtin_amdgcn_update_dpp(0, v, 0x141, 0xF, 0xF, true);
    v += __builtin_amdgcn_update_dpp(0, v, 0x140, 0xF, 0xF, true);
    v += __shfl_xor(v, 16);
    return v;
}
constexpr int IX_RS = 72, IX_STAGE = 32 * IX_RS * 2;
__device__ __forceinline__ void indexer_item(const Params& p, unsigned char* lds, int b, int c, int grp) {
    const int tid = threadIdx.x, w = __builtin_amdgcn_readfirstlane(tid >> 6), lane = tid & 63, r = lane & 31, hh = lane >> 5;
    const bf16_t* P = (const bf16_t*)(p.ws + WS_P); unsigned* MASK = (unsigned*)(p.ws + WS_MASK);
    const int pair = grp * 8 + w, q0 = b * SEQ + c * 64 + 2 * pair;
    bf16x8 af[4];
    { const int query = q0 + ((r >> 2) & 1), head = (r & 3) + 4 * (r >> 3);
      const bf16_t* qp = P + (size_t)query * NP + C_QI + head * 64 + 8 * hh;
#pragma unroll
      for (int ks = 0; ks < 4; ++ks) af[ks] = *(const bf16x8*)(qp + ks * 16); }
    float wv[16];
    { const u32x4 w0 = *(const u32x4*)(P + (size_t)(q0 + hh) * NP + C_WI), w1 = *(const u32x4*)(P + (size_t)(q0 + hh) * NP + C_WI + 8);
      wv[0] = bflo(w0.x); wv[1] = bfhi(w0.x); wv[2] = bflo(w0.y); wv[3] = bfhi(w0.y); wv[4] = bflo(w0.z); wv[5] = bfhi(w0.z); wv[6] = bflo(w0.w); wv[7] = bfhi(w0.w);
      wv[8] = bflo(w1.x); wv[9] = bfhi(w1.x); wv[10] = bflo(w1.y); wv[11] = bfhi(w1.y); wv[12] = bflo(w1.z); wv[13] = bfhi(w1.z); wv[14] = bflo(w1.w); wv[15] = bfhi(w1.w); }
    const int nkt = 2 * (c + 1);
    const bool ldr = tid < 256;
    const bf16_t* kg = P + (size_t)(b * SEQ + ((tid >> 3) & 31)) * NP + C_KI + (tid & 7) * 8;
    const int kls = ((tid >> 3) & 31) * IX_RS * 2 + (tid & 7) * 16;
    u32x4 kr = {0u, 0u, 0u, 0u};
    __syncthreads();
    if (ldr) { *(u32x4*)(lds + kls) = *(const u32x4*)kg; *(u32x4*)(lds + IX_STAGE + kls) = *(const u32x4*)(kg + (size_t)32 * NP); }
    if (ldr && 2 < nkt) kr = *(const u32x4*)(kg + (size_t)64 * NP);
    __syncthreads();
    unsigned kv[64];
#pragma unroll
    for (int kt = 0; kt < 64; ++kt) {
        kv[kt] = 0u;
        if (kt < nkt) {
            if (ldr && kt + 2 < nkt) *(u32x4*)(lds + ((kt + 2) % 3) * IX_STAGE + kls) = kr;
            if (ldr && kt + 3 < nkt) kr = *(const u32x4*)(kg + (size_t)((kt + 3) * 32) * NP);
            const bf16_t* Ks = (const bf16_t*)(lds + (kt % 3) * IX_STAGE);
            f32x16 acc;
#pragma unroll
            for (int i = 0; i < 16; ++i) acc[i] = 0.f;
#pragma unroll
            for (int ks = 0; ks < 4; ++ks) { const bf16x8 bfr = *(const bf16x8*)(Ks + r * IX_RS + ks * 16 + 8 * hh); acc = __builtin_amdgcn_mfma_f32_32x32x16_bf16(af[ks], bfr, acc, 0, 0, 0); }
            float sc = 0.f;
#pragma unroll
            for (int i = 0; i < 16; ++i) sc += wv[i] * fmaxf(acc[i], 0.f);
            kv[kt] = ord_key(sc);
            __syncthreads();
        }
    }
    unsigned thr = 0u;
    if (nkt > 8) {
        int cur = 1 << 20;
        for (int bit = 31; bit >= 0; --bit) {
            const unsigned cand = thr | (1u << bit); int cnt = 0;
#pragma unroll
            for (int kt = 0; kt < 32; ++kt) cnt += (kv[kt] >= cand) ? 1 : 0;
            if (nkt > 32) {
#pragma unroll
                for (int kt = 32; kt < 64; ++kt) cnt += (kv[kt] >= cand) ? 1 : 0; }
            cnt = half_sum(cnt);
            if (cnt >= 256) { thr = cand; cur = cnt; }
            if (__builtin_amdgcn_ballot_w64(cur != 256) == 0ull) break;
        }
    }
    int cge = 0;
#pragma unroll
    for (int kt = 0; kt < 64; ++kt) cge += (kv[kt] >= thr && kv[kt] != 0u) ? 1 : 0;
    cge = half_sum(cge);
    const bool ties = (thr != 0u) && (cge > 256);
    unsigned m0 = 0u, m1 = 0u;
    if (__builtin_amdgcn_ballot_w64(ties) == 0ull) {
#pragma unroll
        for (int kt = 0; kt < 64; ++kt) { const unsigned long long bm = __builtin_amdgcn_ballot_w64(kv[kt] >= thr && kv[kt] != 0u);
            if (lane == kt) { m0 = (unsigned)bm; m1 = (unsigned)(bm >> 32); } }
    } else {
        int cgt = 0;
#pragma unroll
        for (int kt = 0; kt < 64; ++kt) cgt += (kv[kt] > thr) ? 1 : 0;
        cgt = half_sum(cgt);
        const int need = ties ? (256 - cgt) : (1 << 30); int run = 0;
#pragma unroll
        for (int kt = 0; kt < 64; ++kt) { const bool tie = ties && (kv[kt] == thr); const unsigned long long tb = __builtin_amdgcn_ballot_w64(tie);
            const unsigned th = hh ? (unsigned)(tb >> 32) : (unsigned)tb; const int rank = run + __builtin_popcount(th & ((1u << r) - 1u));
            const bool sel = ties ? ((kv[kt] > thr) || (tie && rank < need)) : (kv[kt] >= thr && kv[kt] != 0u);
            run += __builtin_popcount(th);
            const unsigned long long bm = __builtin_amdgcn_ballot_w64(sel);
            if (lane == kt) { m0 = (unsigned)bm; m1 = (unsigned)(bm >> 32); } }
    }
    { const int qpos = c * 64 + 2 * pair; unsigned* mt = MASK + ((size_t)(b * 64 + lane)) * SEQ + qpos; mt[0] = m0; mt[1] = m1; }
}
__device__ __forceinline__ void phase_indexer(const Params& p, unsigned char* lds, int vb, int vG) {
    const int G = vG;
    for (int rd = 0;; ++rd) {
        const int base = rd * G; if (base >= 1024) break;
        const int pos = (rd & 1) ? (G - 1 - vb) : vb; const int i = base + pos; if (i >= 1024) continue;
        indexer_item(p, lds, (i >> 2) & 7, 31 - (i >> 5), i & 3);
    }
}

#ifndef HG_REP_A
#define HG_REP_A 0
#endif
#ifndef HG_REP_B
#define HG_REP_B 0
#endif
constexpr int HG_RS = 136, HG_TS = 72, HG_SS = 136;
constexpr int HG_QT = 0, HG_QH = 17408, HG_KT = 34816, HG_KHT = 52224, HG_VT = 70656, HG_ST = 89088, HG_DEC = 123904, HG_SSQ = 124416, HG_OT = 125440;
__device__ __forceinline__ void hgrn_item(const Params& p, unsigned char* lds, int item) {
    const int tid = threadIdx.x, w = __builtin_amdgcn_readfirstlane(tid >> 6), lane = tid & 63, r = lane & 31, hh = lane >> 5;
    const int b = item >> 3, h = item & 7;
    const bf16_t* P = (const bf16_t*)(p.ws + WS_P); bf16_t* REC = (bf16_t*)((unsigned char*)p.out + OUT_REC);
    bf16_t* QT = (bf16_t*)(lds + HG_QT); bf16_t* QH = (bf16_t*)(lds + HG_QH); bf16_t* KT = (bf16_t*)(lds + HG_KT); bf16_t* KHT = (bf16_t*)(lds + HG_KHT); bf16_t* VT = (bf16_t*)(lds + HG_VT);
    bf16_t* ST = (bf16_t*)(lds + HG_ST); float* DEC = (float*)(lds + HG_DEC); float* SSQ = (float*)(lds + HG_SSQ); bf16_t* OT = (bf16_t*)(lds + HG_OT);
    const int seg = lane >> 4, dl = lane & 15, d = 16 * w + dl;
    const float lb = sigmoidf_(p.in[7][h * 128 + d] - p.in[7][1024 + h * 128 + d]);
    const int tb = w & 1, eb = w >> 1, sdb = w & 3, seb0 = 2 * (w >> 2);
    const int ot_t = tid >> 3, ot_c = tid & 7;
    float gn[16];
#pragma unroll
    for (int j = 0; j < 4; ++j) { const f32x4 g4 = *(const f32x4*)(p.in[8] + 16 * ot_c + 4 * j); gn[4 * j] = g4[0]; gn[4 * j + 1] = g4[1]; gn[4 * j + 2] = g4[2]; gn[4 * j + 3] = g4[3]; }
    f32x16 S0, S1;
#pragma unroll
    for (int i = 0; i < 16; ++i) { S0[i] = 0.f; S1[i] = 0.f; }
    __syncthreads();
    for (int i = tid; i < 128 * HG_SS / 2; i += NTHREADS) ((unsigned*)ST)[i] = 0u;
    unsigned short rq[16], rf[16], ri[16];
    { const bf16_t* src = P + (size_t)(b * SEQ + 16 * seg) * NP + h * 128 + d;
#pragma unroll
      for (int i = 0; i < 16; ++i) { rq[i] = src[(size_t)i * NP + C_QB]; rf[i] = src[(size_t)i * NP + C_FB]; ri[i] = src[(size_t)i * NP + C_IB]; } }
#pragma unroll 1
    for (int n = 0; n < 32; ++n) {
#pragma unroll 1
        for (int repa = 0; repa <= HG_REP_A; ++repa) {
            float lf[16], kk[16];
            float run = 0.f;
#pragma unroll
            for (int i = 0; i < 16; ++i) { const float f = lb + (1.f - lb) * sigmoidf_(bf2f(rf[i])); kk[i] = 1.f - f; run += __logf(f); lf[i] = run; }
            const float p0 = __shfl(run, dl), p1 = __shfl(run, 16 + dl), p2 = __shfl(run, 32 + dl), p3 = __shfl(run, 48 + dl);
            const float off = (seg > 0 ? p0 : 0.f) + (seg > 1 ? p1 : 0.f) + (seg > 2 ? p2 : 0.f), bL = (p0 + p1) + (p2 + p3), bref = p0 + p1;
            const float eref = __expf(fmaxf(bref, -80.f)), elref = __expf(fmaxf(bL - bref, -80.f));
            unsigned kh[8], vv[8];
#pragma unroll
            for (int i = 0; i < 16; ++i) { const float bt = off + lf[i]; const float qs = siluf_(bf2f(rq[i]));
                const float e1 = __expf(__builtin_amdgcn_fmed3f(bt - bref, -80.f, 80.f)), e2 = e1 * eref, e3 = __builtin_amdgcn_rcpf(e1), e4 = e3 * elref;
                const int t = 16 * seg + i;
                QT[t * HG_RS + d] = (bf16_t)f2bf(qs * e1); QH[t * HG_RS + d] = (bf16_t)f2bf(qs * e2); KT[t * HG_RS + d] = (bf16_t)f2bf(kk[i] * e3);
                const unsigned khv = f2bf(kk[i] * e4);
                if (i & 1) { kh[i >> 1] |= khv << 16; vv[i >> 1] |= (unsigned)ri[i] << 16; } else { kh[i >> 1] = khv; vv[i >> 1] = (unsigned)ri[i]; } }
            *(u32x4*)(KHT + d * HG_TS + 16 * seg) = (u32x4){kh[0], kh[1], kh[2], kh[3]}; *(u32x4*)(KHT + d * HG_TS + 16 * seg + 8) = (u32x4){kh[4], kh[5], kh[6], kh[7]};
            *(u32x4*)(VT + d * HG_TS + 16 * seg) = (u32x4){vv[0], vv[1], vv[2], vv[3]}; *(u32x4*)(VT + d * HG_TS + 16 * seg + 8) = (u32x4){vv[4], vv[5], vv[6], vv[7]};
            if (seg == 0) DEC[d] = eref * elref;
        }
        __syncthreads();
        if (n < 31) { const bf16_t* src = P + (size_t)(b * SEQ + (n + 1) * 64 + 16 * seg) * NP + h * 128 + d;
#pragma unroll
            for (int i = 0; i < 16; ++i) { rq[i] = src[(size_t)i * NP + C_QB]; rf[i] = src[(size_t)i * NP + C_FB]; ri[i] = src[(size_t)i * NP + C_IB]; } }
        const u32x4 gb0 = *(const u32x4*)(P + (size_t)(b * SEQ + n * 64 + ot_t) * NP + C_GB + h * 128 + 16 * ot_c), gb1 = *(const u32x4*)(P + (size_t)(b * SEQ + n * 64 + ot_t) * NP + C_GB + h * 128 + 16 * ot_c + 8);
        f32x16 X0, X1, o;
#pragma unroll 1
        for (int repb = 0; repb <= HG_REP_B; ++repb) {
#pragma unroll
        for (int i = 0; i < 16; ++i) { X0[i] = 0.f; X1[i] = 0.f; o[i] = 0.f; }
#pragma unroll
        for (int ks = 0; ks < 8; ++ks) { const bf16x8 bq = *(const bf16x8*)(QT + (32 * tb + r) * HG_RS + 16 * ks + 8 * hh);
            const bf16x8 a0 = *(const bf16x8*)(KT + r * HG_RS + 16 * ks + 8 * hh); X0 = __builtin_amdgcn_mfma_f32_32x32x16_bf16(a0, bq, X0, 0, 0, 0);
            if (tb == 1) { const bf16x8 a1 = *(const bf16x8*)(KT + (32 + r) * HG_RS + 16 * ks + 8 * hh); X1 = __builtin_amdgcn_mfma_f32_32x32x16_bf16(a1, bq, X1, 0, 0, 0); } }
#pragma unroll
        for (int i = 0; i < 16; ++i) { const bool keep = ((i & 3) + 8 * (i >> 2) + 4 * hh) <= r; if (tb == 0) X0[i] = keep ? X0[i] : 0.f; else X1[i] = keep ? X1[i] : 0.f; }
#pragma unroll
        for (int sb = 0; sb < 2; ++sb) { if (sb <= tb) {
#pragma unroll
            for (int s2 = 0; s2 < 2; ++s2) { u32x4 aw;
                if (sb == 0) { aw.x = pk2(X0[8 * s2], X0[8 * s2 + 1]); aw.y = pk2(X0[8 * s2 + 2], X0[8 * s2 + 3]); aw.z = pk2(X0[8 * s2 + 4], X0[8 * s2 + 5]); aw.w = pk2(X0[8 * s2 + 6], X0[8 * s2 + 7]); }
                else { aw.x = pk2(X1[8 * s2], X1[8 * s2 + 1]); aw.y = pk2(X1[8 * s2 + 2], X1[8 * s2 + 3]); aw.z = pk2(X1[8 * s2 + 4], X1[8 * s2 + 5]); aw.w = pk2(X1[8 * s2 + 6], X1[8 * s2 + 7]); }
                const bf16_t* vp = VT + (32 * eb + r) * HG_TS + 32 * sb + 16 * s2 + 4 * hh;
                const u32x2 lo = *(const u32x2*)vp, hi = *(const u32x2*)(vp + 8); const u32x4 bw = {lo.x, lo.y, hi.x, hi.y};
                o = __builtin_amdgcn_mfma_f32_32x32x16_bf16(__builtin_bit_cast(bf16x8, aw), __builtin_bit_cast(bf16x8, bw), o, 0, 0, 0); } } }
#pragma unroll
        for (int ks = 0; ks < 8; ++ks) { const bf16x8 aq = *(const bf16x8*)(QH + (32 * tb + r) * HG_RS + 16 * ks + 8 * hh), bs = *(const bf16x8*)(ST + (32 * eb + r) * HG_SS + 16 * ks + 8 * hh);
            o = __builtin_amdgcn_mfma_f32_32x32x16_bf16(aq, bs, o, 0, 0, 0); }
        { float a8[8], a4[4], a2[2], a1;
#pragma unroll
          for (int i = 0; i < 8; ++i) { const float lo = o[i] * o[i], hi = o[i + 8] * o[i + 8]; const bool up = lane & 16; const float keep = up ? hi : lo, send = up ? lo : hi; a8[i] = keep + __shfl_xor(send, 16); }
#pragma unroll
          for (int i = 0; i < 4; ++i) { const bool up = lane & 8; const float keep = up ? a8[i + 4] : a8[i], send = up ? a8[i] : a8[i + 4]; a4[i] = keep + __shfl_xor(send, 8); }
#pragma unroll
          for (int i = 0; i < 2; ++i) { const bool up = lane & 4; const float keep = up ? a4[i + 2] : a4[i], send = up ? a4[i] : a4[i + 2]; a2[i] = keep + __shfl_xor(send, 4); }
          { const bool up = lane & 2; const float keep = up ? a2[1] : a2[0], send = up ? a2[0] : a2[1]; a1 = keep + __shfl_xor(send, 2); }
          a1 += __shfl_xor(a1, 1);
          const int ri2 = (lane >> 1) & 15;
          if ((lane & 1) == 0) SSQ[(32 * tb + (ri2 & 3) + 8 * (ri2 >> 2) + 4 * hh) * 4 + eb] = a1; }
#pragma unroll
        for (int i = 0; i < 16; ++i) OT[(32 * tb + (i & 3) + 8 * (i >> 2) + 4 * hh) * HG_RS + 32 * eb + r] = (bf16_t)f2bf(o[i]);
        }
        { float dc[16];
#pragma unroll
          for (int g4 = 0; g4 < 4; ++g4) { const f32x4 dv = *(const f32x4*)(DEC + 32 * sdb + 8 * g4 + 4 * hh); dc[4 * g4] = dv[0]; dc[4 * g4 + 1] = dv[1]; dc[4 * g4 + 2] = dv[2]; dc[4 * g4 + 3] = dv[3]; }
#pragma unroll
          for (int i = 0; i < 16; ++i) { S0[i] *= dc[i]; S1[i] *= dc[i]; }
#pragma unroll
          for (int ss = 0; ss < 4; ++ss) { const bf16x8 a = *(const bf16x8*)(KHT + (32 * sdb + r) * HG_TS + 16 * ss + 8 * hh);
              const bf16x8 b0 = *(const bf16x8*)(VT + (32 * seb0 + r) * HG_TS + 16 * ss + 8 * hh), b1 = *(const bf16x8*)(VT + (32 * (seb0 + 1) + r) * HG_TS + 16 * ss + 8 * hh);
              S0 = __builtin_amdgcn_mfma_f32_32x32x16_bf16(a, b0, S0, 0, 0, 0); S1 = __builtin_amdgcn_mfma_f32_32x32x16_bf16(a, b1, S1, 0, 0, 0); } }
        __syncthreads();
#pragma unroll
        for (int g4 = 0; g4 < 4; ++g4) { const int d0 = 32 * sdb + 8 * g4 + 4 * hh;
            *(u32x2*)(ST + (32 * seb0 + r) * HG_SS + d0) = (u32x2){pk2(S0[4 * g4], S0[4 * g4 + 1]), pk2(S0[4 * g4 + 2], S0[4 * g4 + 3])};
            *(u32x2*)(ST + (32 * (seb0 + 1) + r) * HG_SS + d0) = (u32x2){pk2(S1[4 * g4], S1[4 * g4 + 1]), pk2(S1[4 * g4 + 2], S1[4 * g4 + 3])}; }
        { const f32x4 q4 = *(const f32x4*)(SSQ + ot_t * 4); const float rstd = rsqrtf(((q4[0] + q4[1]) + (q4[2] + q4[3])) * (1.f / 128.f) + NORM_EPS);
          const u32x4 o0 = *(const u32x4*)(OT + ot_t * HG_RS + 16 * ot_c), o1 = *(const u32x4*)(OT + ot_t * HG_RS + 16 * ot_c + 8);
          const unsigned ow[8] = {o0.x, o0.y, o0.z, o0.w, o1.x, o1.y, o1.z, o1.w}, gwv[8] = {gb0.x, gb0.y, gb0.z, gb0.w, gb1.x, gb1.y, gb1.z, gb1.w};
          unsigned rw[8];
#pragma unroll
          for (int j = 0; j < 8; ++j) rw[j] = pk2(bflo(ow[j]) * rstd * gn[2 * j] * siluf_(bflo(gwv[j])), bfhi(ow[j]) * rstd * gn[2 * j + 1] * siluf_(bfhi(gwv[j])));
          bf16_t* dst = REC + (size_t)(b * SEQ + n * 64 + ot_t) * 1024 + h * 128 + 16 * ot_c;
          *(u32x4*)dst = (u32x4){rw[0], rw[1], rw[2], rw[3]}; *(u32x4*)(dst + 8) = (u32x4){rw[4], rw[5], rw[6], rw[7]}; }
    }
}
__device__ __forceinline__ void phase_hgrn(const Params& p, unsigned char* lds, int vb, int vG) {
    for (int it = vb; it < 64; it += vG) hgrn_item(p, lds, it);
}

constexpr int AT_KRS = 136, AT_VRS = 36, AT_KB = 32 * AT_KRS * 2, AT_VB = 128 * AT_VRS * 2, AT_STAGE = AT_KB + AT_VB;
__device__ __forceinline__ void attn_item(const Params& p, unsigned char* lds, int b, int head, int cq) {
    const int tid = threadIdx.x, w = __builtin_amdgcn_readfirstlane(tid >> 6), lane = tid & 63, r = lane & 31, hh = lane >> 5;
    const bf16_t* P = (const bf16_t*)(p.ws + WS_P); const bf16_t* VT = (const bf16_t*)(p.ws + WS_VT); const unsigned* MASKT = (const unsigned*)(p.ws + WS_MASK);
    bf16_t* AO = (bf16_t*)((unsigned char*)p.out + OUT_AO);
    const int c = 4 * cq + (w >> 1), qpos = c * 64 + (w & 1) * 32 + r, tq = b * SEQ + qpos;
    const int nkt_w = 2 * (c + 1), nkt = 8 * (cq + 1);
    const bf16_t* kg = P + (size_t)(b * SEQ + (tid >> 4)) * NP + C_KA + head * 128 + (tid & 15) * 8;
    const bf16_t* vg = VT + (size_t)((b * 8 + head) * 128 + (tid >> 2)) * SEQ + (tid & 3) * 8;
    const int kls = (tid >> 4) * AT_KRS * 2 + (tid & 15) * 16, vls = AT_KB + (tid >> 2) * AT_VRS * 2 + (tid & 3) * 16;
    bf16x8 qf[8];
    { const bf16_t* qp = P + (size_t)tq * NP + C_QA + head * 128 + 8 * hh;
#pragma unroll
      for (int ks = 0; ks < 8; ++ks) qf[ks] = *(const bf16x8*)(qp + ks * 16); }
    f32x16 o[4];
#pragma unroll
    for (int db = 0; db < 4; ++db)
#pragma unroll
        for (int i = 0; i < 16; ++i) o[db][i] = 0.f;
    float mrun = -1e30f, lsum = 0.f;
    const float sc = 0.08838834764831845f * 1.4426950408889634f;
    __syncthreads();
    u32x4 krA, vrA, krB, vrB;
#pragma unroll
    for (int t0 = 0; t0 < 2; ++t0) { krA = *(const u32x4*)(kg + (size_t)(t0 * 32) * NP); vrA = *(const u32x4*)(vg + t0 * 32);
        *(u32x4*)(lds + t0 * AT_STAGE + kls) = krA; *(u32x2*)(lds + t0 * AT_STAGE + vls) = (u32x2){vrA.x, vrA.y}; *(u32x2*)(lds + t0 * AT_STAGE + vls + 8) = (u32x2){vrA.z, vrA.w}; }
    krA = *(const u32x4*)(kg + (size_t)(2 * 32) * NP); vrA = *(const u32x4*)(vg + 2 * 32);
    krB = *(const u32x4*)(kg + (size_t)(3 * 32) * NP); vrB = *(const u32x4*)(vg + 3 * 32);
    unsigned mwA = MASKT[(size_t)(b * 64) * SEQ + qpos], mwB = MASKT[(size_t)(b * 64 + 1) * SEQ + qpos];
    __syncthreads();
    int st = 0, st2 = 2;
#define AT_TILE(KT, KR, VR, MW) do { const int kt_ = (KT); \
        if (kt_ + 2 < nkt) { *(u32x4*)(lds + st2 * AT_STAGE + kls) = KR; *(u32x2*)(lds + st2 * AT_STAGE + vls) = (u32x2){VR.x, VR.y}; *(u32x2*)(lds + st2 * AT_STAGE + vls + 8) = (u32x2){VR.z, VR.w}; } \
        if (kt_ + 4 < nkt) { KR = *(const u32x4*)(kg + (size_t)((kt_ + 4) * 32) * NP); VR = *(const u32x4*)(vg + (kt_ + 4) * 32); } \
        if (kt_ < nkt_w) { \
            const unsigned mwc = MW; \
            if (kt_ + 2 < nkt_w) MW = MASKT[(size_t)(b * 64 + kt_ + 2) * SEQ + qpos]; \
            const bf16_t* Ks = (const bf16_t*)(lds + st * AT_STAGE); const bf16_t* Vs = (const bf16_t*)(lds + st * AT_STAGE + AT_KB); \
            f32x16 s; \
            _Pragma("unroll") for (int i = 0; i < 16; ++i) s[i] = 0.f; \
            { bf16x8 kf[8];        \
              _Pragma("unroll") for (int ks = 0; ks < 8; ++ks) kf[ks] = *(const bf16x8*)(Ks + r * AT_KRS + ks * 16 + 8 * hh); \
              __builtin_amdgcn_sched_barrier(0); \
              _Pragma("unroll") for (int ks = 0; ks < 8; ++ks) s = __builtin_amdgcn_mfma_f32_32x32x16_bf16(kf[ks], qf[ks], s, 0, 0, 0); } \
            float mx = -3e38f; const unsigned mws = mwc >> (4 * hh);        \
            _Pragma("unroll") for (int i = 0; i < 16; ++i) { const bool ok = (mws >> ((i & 3) + 8 * (i >> 2))) & 1u; s[i] = ok ? s[i] : -3e38f; mx = fmaxf(mx, s[i]); } \
            mx = fmaxf(mx, __shfl_xor(mx, 32)); \
            const float mnew = fmaxf(mrun, mx * sc), alpha = exp2f(mrun - mnew); \
            const bool grew = mnew > mrun; mrun = mnew; \
            float ps = 0.f; float pv[16]; \
            _Pragma("unroll") for (int i = 0; i < 16; ++i) { const float e = exp2f(fmaf(s[i], sc, -mnew)); pv[i] = e; ps += e; }        \
            lsum = lsum * alpha + ps; \
            if (__builtin_amdgcn_ballot_w64(grew) != 0ull) { _Pragma("unroll") for (int db = 0; db < 4; ++db) _Pragma("unroll") for (int i = 0; i < 16; ++i) o[db][i] *= alpha; } \
            bf16x8 pf[2]; \
            _Pragma("unroll") for (int s2 = 0; s2 < 2; ++s2) { u32x4 wv; wv.x = pk2(pv[8 * s2 + 0], pv[8 * s2 + 1]); wv.y = pk2(pv[8 * s2 + 2], pv[8 * s2 + 3]); wv.z = pk2(pv[8 * s2 + 4], pv[8 * s2 + 5]); wv.w = pk2(pv[8 * s2 + 6], pv[8 * s2 + 7]); pf[s2] = __builtin_bit_cast(bf16x8, wv); } \
            { u32x4 vf[4][2]; \
              _Pragma("unroll") for (int db = 0; db < 4; ++db) _Pragma("unroll") for (int s2 = 0; s2 < 2; ++s2) { const bf16_t* vp = Vs + (db * 32 + r) * AT_VRS + 16 * s2 + 4 * hh; const u32x2 lo = *(const u32x2*)vp, hi = *(const u32x2*)(vp + 8); \
                    vf[db][s2] = (u32x4){lo.x, lo.y, hi.x, hi.y}; } \
              __builtin_amdgcn_sched_barrier(0); \
              _Pragma("unroll") for (int db = 0; db < 4; ++db) _Pragma("unroll") for (int s2 = 0; s2 < 2; ++s2) o[db] = __builtin_amdgcn_mfma_f32_32x32x16_bf16(__builtin_bit_cast(bf16x8, vf[db][s2]), pf[s2], o[db], 0, 0, 0); } \
        } \
        __syncthreads(); \
        st = (st == 2) ? 0 : st + 1; st2 = (st2 == 2) ? 0 : st2 + 1; } while (0)
#pragma unroll 1
    for (int kt = 0; kt < nkt; kt += 2) { AT_TILE(kt, krA, vrA, mwA); AT_TILE(kt + 1, krB, vrB, mwB); }
#undef AT_TILE
    const float l = lsum + __shfl_xor(lsum, 32), inv = 1.f / l;
    bf16_t* op = AO + (size_t)tq * 1024 + head * 128 + 4 * hh;
#pragma unroll
    for (int db = 0; db < 4; ++db)
#pragma unroll
        for (int g4 = 0; g4 < 4; ++g4) { u32x2 wv; wv.x = pk2(o[db][4 * g4] * inv, o[db][4 * g4 + 1] * inv); wv.y = pk2(o[db][4 * g4 + 2] * inv, o[db][4 * g4 + 3] * inv);
            *(u32x2*)(op + db * 32 + 8 * g4) = wv; }
}
__device__ __forceinline__ void phase_attn(const Params& p, unsigned char* lds, int vb, int vG) {
    const int G = vG;
    for (int rd = 0;; ++rd) {
        const int base = rd * G; if (base >= 512) break;
        const int pos = (rd & 1) ? (G - 1 - vb) : vb; const int i = base + pos; if (i >= 512) continue;
        attn_item(p, lds, (i >> 3) & 7, i & 7, 7 - (i >> 6));
    }
}
__device__ __forceinline__ void phase_attn_queue(const Params& p, unsigned char* lds, unsigned* qhead) {
    volatile LAS int* slot = (volatile LAS int*)((LAS unsigned char*)lds + LDS_BYTES - 32);
    for (;;) {
        __syncthreads();
        if (threadIdx.x == 0) slot[0] = (int)__hip_atomic_fetch_add(qhead, 1u, __ATOMIC_RELAXED, __HIP_MEMORY_SCOPE_AGENT);
        __syncthreads();
        const int i = slot[0]; if (i >= 512) break;
        attn_item(p, lds, (i >> 3) & 7, i & 7, 7 - (i >> 6));
    }
}
__device__ __forceinline__ void phase_uv(const Params& p) {
    const int tid = threadIdx.x, wave = tid >> 6, lane = tid & 63;
    const int gw = blockIdx.x * NWAVES + wave, NGW = gridDim.x * NWAVES;
    for (int it = gw; it < 2 * 16384; it += NGW) {
        const int tbl = it >> 14, row = it & 16383;
        const float* src = (tbl ? p.in[15] : p.in[14]) + (size_t)row * 2048 + 32 * lane;
        unsigned char* dst = p.ws + (tbl ? WS_V8 : WS_U8); float* isc = (float*)(p.ws + (tbl ? WS_ISV : WS_ISU));
        f32x4 v[8]; float am = 0.f;
#pragma unroll
        for (int j = 0; j < 8; ++j) { v[j] = *(const f32x4*)(src + 4 * j); am = fmaxf(am, fmaxf(fmaxf(fabsf(v[j][0]), fabsf(v[j][1])), fmaxf(fabsf(v[j][2]), fabsf(v[j][3])))); }
#pragma unroll
        for (int o = 1; o < 64; o <<= 1) am = fmaxf(am, __shfl_xor(am, o));
        am = fmaxf(am, 1e-30f); const float sc = 256.f / am;
        unsigned wq[8];
#pragma unroll
        for (int j = 0; j < 8; ++j) { int pk = 0; pk = __builtin_amdgcn_cvt_pk_fp8_f32(v[j][0] * sc, v[j][1] * sc, pk, false); pk = __builtin_amdgcn_cvt_pk_fp8_f32(v[j][2] * sc, v[j][3] * sc, pk, true); wq[j] = (unsigned)pk; }
        unsigned char* d = dst + (size_t)(lane >> 2) * (2u << 20) + (size_t)row * 128 + (lane & 3) * 32;
        *(u32x4*)d = (u32x4){wq[0], wq[1], wq[2], wq[3]}; *(u32x4*)(d + 16) = (u32x4){wq[4], wq[5], wq[6], wq[7]};
        if (lane == 0) isc[row] = am * (1.f / 256.f);
    }
}

#define INS16(v, x) do { _Pragma("unroll") for (int _j = 15; _j >= 1; --_j) v[_j] = __builtin_amdgcn_fmed3f(v[_j - 1], v[_j], (x)); v[0] = fmaxf(v[0], (x)); } while (0)
__device__ __forceinline__ void peer_half_top16(const bf16_t* QP, const bf16_t* kb0  , int pitch, int tok, int p, int hf, int r, int hh, float (&v)[16]) {
    bf16x8 qf[8];
    { const bf16_t* qp = QP + (size_t)tok * D + p * 256 + hf * 128 + 8 * hh;
#pragma unroll
      for (int ks = 0; ks < 8; ++ks) qf[ks] = *(const bf16x8*)(qp + ks * 16); }
#pragma unroll
    for (int k = 0; k < 16; ++k) v[k] = -3.0e38f;
    const bf16_t* kb = kb0 + r * pitch + 8 * hh;
#pragma unroll 1
    for (int nb = 0; nb < 4; ++nb) {
        f32x16 acc;
#pragma unroll
        for (int i = 0; i < 16; ++i) acc[i] = 0.f;
#pragma unroll
        for (int ks = 0; ks < 8; ++ks) { const bf16x8 kf = *(const bf16x8*)(kb + (nb * 32) * pitch + ks * 16); acc = __builtin_amdgcn_mfma_f32_32x32x16_bf16(kf, qf[ks], acc, 0, 0, 0); }
#pragma unroll
        for (int i = 0; i < 16; ++i) { const unsigned xi = (unsigned)(nb * 32 + (i & 3) + 8 * (i >> 2) + 4 * hh); const float x = __uint_as_float((__float_as_uint(acc[i]) & ~0x7fu) | xi); INS16(v, x); }
    }
    float ov[16];
#pragma unroll
    for (int k = 0; k < 16; ++k) ov[k] = __shfl_xor(v[k], 32);
#pragma unroll
    for (int k = 0; k < 16; ++k) INS16(v, ov[k]);
}
constexpr int PK_RS = 136;
#define GAS __attribute__((address_space(1)))
__device__ __attribute__((noinline)) void phase_peer_topk_ni(const GAS bf16_t* QPg, const GAS bf16_t* KEYSg, GAS int* EIDXg, GAS float* EGATEg, LAS unsigned char* ldsl) {
    const bf16_t* QP = (const bf16_t*)QPg; const bf16_t* KEYS = (const bf16_t*)KEYSg; int* EIDX = (int*)EIDXg; float* EGATE = (float*)EGATEg; unsigned char* lds = (unsigned char*)ldsl;
    const int tid = threadIdx.x, wave = __builtin_amdgcn_readfirstlane(tid >> 6), lane = tid & 63, r = lane & 31, hh = lane >> 5;
    bf16_t* KL = (bf16_t*)lds;
    const int G = gridDim.x, hd = blockIdx.x & 7;
    __syncthreads();
    for (int i = tid; i < 2 * 128 * 16; i += NTHREADS) { const int row = i >> 4, ch = i & 15;
        *(u32x4*)(KL + row * PK_RS + ch * 8) = *(const u32x4*)(KEYS + (size_t)(hd * 256 + row) * 128 + ch * 8); }
    __syncthreads();
    for (int tile = blockIdx.x >> 3; tile < 64; tile += (G + 7) / 8) {
        const int tok = tile * 256 + wave * 32 + r;
        float va[16], vb[16];
        peer_half_top16(QP, KL, PK_RS, tok, hd, 0, r, hh, va);
        peer_half_top16(QP, KL + 128 * PK_RS, PK_RS, tok, hd, 1, r, hh, vb);
        float bv[16];
#pragma unroll
        for (int k = 0; k < 16; ++k) bv[k] = -3.0e38f;
#pragma unroll
        for (int a = 0; a < 16; ++a)
#pragma unroll
            for (int b2 = 0; b2 < 16; ++b2) if ((a + 1) * (b2 + 1) <= 16) { const float x = va[a] + vb[b2]; INS16(bv, x); }
        float se = 0.f;
#pragma unroll
        for (int k = 0; k < 16; ++k) se += __expf(bv[k] - bv[0]);
        const float inv = 1.f / se, thr = bv[15], top = bv[0];
        int cnt = 0; int* ei = EIDX + (size_t)tok * 128 + hd * 16; float* eg = EGATE + (size_t)tok * 128 + hd * 16;
#pragma unroll
        for (int a = 0; a < 16; ++a)
#pragma unroll
            for (int b2 = 0; b2 < 16; ++b2) if ((a + 1) * (b2 + 1) <= 16) { const float x = va[a] + vb[b2];
                if (x >= thr && cnt < 16) { if (hh == 0) { ei[cnt] = (int)((__float_as_uint(va[a]) & 0x7fu) * 128u + (__float_as_uint(vb[b2]) & 0x7fu)); eg[cnt] = __expf(x - top) * inv; } ++cnt; } }
    }
}

typedef __bf16 bf16x2_t __attribute__((ext_vector_type(2)));
__device__ __forceinline__ float gelu_erf(float v) {
    const float av = fabsf(v), d = av * 0.2316418882f + 1.0f, t = __builtin_amdgcn_rcpf(d);
    float q = t * 0.5307027145f + (-0.7265760135f); q = q * t + 0.7107068705f; q = q * t + (-0.142248368f); q = q * t + 0.127414796f; q = q * t;
    const float e = __builtin_amdgcn_exp2f((v * v) * (-0.72134752044f));
    const float m = v * (q * e), r = v - m;
    return v < 0.f ? m : r;
}
__device__ __forceinline__ float dot2bf(unsigned a, unsigned b, float c) { return __builtin_amdgcn_fdot2_f32_bf16(__builtin_bit_cast(bf16x2_t, a), __builtin_bit_cast(bf16x2_t, b), c, false); }
__device__ __forceinline__ float dpp_f(float x, int ctrl_xor1_xor2_mirror) {
    const int v = __float_as_int(x);
    if (ctrl_xor1_xor2_mirror == 0) return __int_as_float(__builtin_amdgcn_update_dpp(0, v, 0xB1, 0xF, 0xF, true));
    if (ctrl_xor1_xor2_mirror == 1) return __int_as_float(__builtin_amdgcn_update_dpp(0, v, 0x4E, 0xF, 0xF, true));
    return __int_as_float(__builtin_amdgcn_update_dpp(0, v, 0x141, 0xF, 0xF, true));
}
typedef float f32x2v __attribute__((ext_vector_type(2)));
__device__ __forceinline__ void unpack8(const u32x4 w, float* f) { f[0] = bflo(w.x); f[1] = bfhi(w.x); f[2] = bflo(w.y); f[3] = bfhi(w.y); f[4] = bflo(w.z); f[5] = bfhi(w.z); f[6] = bflo(w.w); f[7] = bfhi(w.w); }
__device__ __forceinline__ void cvt16(const u32x4 w, float* f) {
#pragma unroll
    for (int q = 0; q < 4; ++q) { const f32x2v lo = __builtin_amdgcn_cvt_pk_f32_fp8((int)w[q], false), hi = __builtin_amdgcn_cvt_pk_f32_fp8((int)w[q], true);
        f[4 * q] = lo.x; f[4 * q + 1] = lo.y; f[4 * q + 2] = hi.x; f[4 * q + 3] = hi.y; }
}
__device__ __forceinline__ void phase_experts(const Params& p, unsigned char* lds) {
    const int tid = threadIdx.x, wave = __builtin_amdgcn_readfirstlane(tid >> 6), lane = tid & 63, rr = lane >> 3, cc = lane & 7; const bool odd = cc & 1;
    const bf16_t* H2 = (const bf16_t*)(p.ws + WS_H2); const unsigned char* U8 = p.ws + WS_U8; const unsigned char* V8 = p.ws + WS_V8;
    const float* ISU = (const float*)(p.ws + WS_ISU); const float* ISV = (const float*)(p.ws + WS_ISV);
    const int* EIDX = (const int*)(p.ws + WS_EIDX); const float* EGATE = (const float*)(p.ws + WS_EGATE);
    const float* mod = (const float*)(p.ws + WS_MOD); const float* fin = p.in[16]; float* out = p.out; const float* X1 = (const float*)(p.ws + WS_X1);
    unsigned* offs = (unsigned*)lds; float* gts = (float*)(lds + 32768); float* rstl = (float*)(lds + 65536);
    const unsigned xcc = (unsigned)__builtin_amdgcn_s_getreg((3 << 11) | 20) & 7u; const unsigned cc16 = cc * 16;
    for (int tile = blockIdx.x; tile < T / 64; tile += gridDim.x) {
        const int tok0 = tile * 64, b = tok0 >> 11;
        __syncthreads();
        for (int i = tid; i < 8192; i += NTHREADS) { const int tl = i >> 7, j = i & 127, g = j >> 3, r8 = j & 7;
            offs[(tl * 8 + r8) * 16 + g] = (unsigned)EIDX[(size_t)tok0 * 128 + i] * 128u; gts[(tl * 8 + r8) * 16 + g] = EGATE[(size_t)tok0 * 128 + i]; }
        __syncthreads();
#pragma unroll 1
        for (int half = 0; half < 2; ++half) {
            const int tlb = wave * 8 + half * 4;
            u32x4 dA[16], dB[16], hA0, hA1, hB0, hB1;
#ifndef EXP_REP_U
#define EXP_REP_U 0
#endif
#ifndef EXP_REP_V
#define EXP_REP_V 0
#endif
#define EX_SLICE(i_) ((xcc * 2u + (unsigned)(i_)) & 15u)
#define EX_LOAD(buf, TBL, i_, k_) do { const unsigned char* tb_ = (TBL) + (size_t)EX_SLICE(i_) * (2u << 20); u32x4 o4_[4]; \
    _Pragma("unroll") for (int q_ = 0; q_ < 4; ++q_) o4_[q_] = *(const u32x4*)(offs + ((tlb + (k_)) * 8 + rr) * 16 + 4 * q_); \
    _Pragma("unroll") for (int g_ = 0; g_ < 16; ++g_) buf[g_] = *(const u32x4*)(tb_ + (o4_[g_ >> 2][g_ & 3] + cc16)); } while (0)
#define EX_LOADH(h0, h1, i_, k_) do { const bf16_t* hp_ = H2 + (size_t)(tok0 + tlb + (k_)) * D + EX_SLICE(i_) * 128 + cc * 16; h0 = *(const u32x4*)hp_; h1 = *(const u32x4*)(hp_ + 8); } while (0)
#define EX_DOT16(acc, WSRC, hf) do { u32x4 w_ = WSRC; asm volatile("" : "+v"(w_.x), "+v"(w_.y), "+v"(w_.z), "+v"(w_.w), "+v"(ch_)); float f_[16]; cvt16(w_, f_); _Pragma("unroll") for (int e_ = 0; e_ < 16; ++e_) acc = fmaf(f_[e_], hf[e_], acc); ch_ = acc; } while (0)
#define EX_UCOMP(buf, h0, h1, k_) do { float hf_[16]; unpack8(h0, hf_); unpack8(h1, hf_ + 8); float ch_ = 0.f; \
    _Pragma("unroll") for (int j_ = 0; j_ < 8; ++j_) { float te_ = 0.f, to_ = 0.f; EX_DOT16(te_, buf[2 * j_], hf_); __builtin_amdgcn_sched_barrier(0); EX_DOT16(to_, buf[2 * j_ + 1], hf_); \
    const float my_ = odd ? to_ : te_, ot_ = odd ? te_ : to_; zp[k_][j_] += my_ + dpp_f(ot_, 0); asm volatile("" : "+v"(zp[k_][j_])); __builtin_amdgcn_sched_barrier(0); } } while (0)
#define SB() __builtin_amdgcn_sched_barrier(0)
            float zp[4][8];
#pragma unroll
            for (int k = 0; k < 4; ++k)
#pragma unroll
                for (int j = 0; j < 8; ++j) zp[k][j] = 0.f;
            EX_LOADH(hA0, hA1, 0, 0); EX_LOAD(dA, U8, 0, 0); SB();
#pragma unroll 1
            for (int i = 0; i < 16 * (1 + EXP_REP_U); ++i) {
                __builtin_amdgcn_s_barrier();
                EX_LOADH(hB0, hB1, i, 1); EX_LOAD(dB, U8, i, 1); SB(); EX_UCOMP(dA, hA0, hA1, 0); SB();
                EX_LOADH(hA0, hA1, i, 2); EX_LOAD(dA, U8, i, 2); SB(); EX_UCOMP(dB, hB0, hB1, 1); SB();
                EX_LOADH(hB0, hB1, i, 3); EX_LOAD(dB, U8, i, 3); SB(); EX_UCOMP(dA, hA0, hA1, 2); SB();
                if (i < 16 * (1 + EXP_REP_U) - 1) { EX_LOADH(hA0, hA1, i + 1, 0); EX_LOAD(dA, U8, i + 1, 0); } SB(); EX_UCOMP(dB, hB0, hB1, 3); SB();
            }
            if (EXP_REP_U) {
#pragma unroll
                for (int k = 0; k < 4; ++k)
#pragma unroll
                    for (int j = 0; j < 8; ++j) zp[k][j] *= 0.5f; }
            unsigned* apl = (unsigned*)(lds + 66560);
#pragma unroll
            for (int k = 0; k < 4; ++k)
#pragma unroll
                for (int j = 0; j < 8; ++j) { float z = zp[k][j]; z += dpp_f(z, 1); z += __shfl_xor(z, 4);
                    const int li = ((tlb + k) * 8 + rr) * 16 + 2 * j + (odd ? 1 : 0); const unsigned eid = offs[li] >> 7;
                    const float act = gelu_erf(z * ISU[eid]) * gts[li] * ISV[eid]; const float oth = dpp_f(act, 0);
                    apl[((tlb + k) * 8 + rr) * 8 + j] = f2bf(odd ? oth : act) | (f2bf(odd ? act : oth) << 16); }
            LDS_WAIT();
            float ssq[4] = {0.f, 0.f, 0.f, 0.f};
#define EX_VCOMP(buf, i_, k_) do { float oa_[16]; _Pragma("unroll") for (int e_ = 0; e_ < 16; ++e_) oa_[e_] = 0.f; \
    const int col_ = (int)EX_SLICE(i_) * 128 + cc * 16 + 2 * rr; const size_t xo_ = (size_t)(tok0 + tlb + (k_)) * D + col_; \
    const f32x2v x1_ = *(const f32x2v*)(X1 + xo_), g2_ = *(const f32x2v*)(mod + (size_t)b * NADA + 5 * 2048 + col_); \
    const u32x4 ap0_ = *(const u32x4*)(apl + ((tlb + (k_)) * 8 + rr) * 8), ap1_ = *(const u32x4*)(apl + ((tlb + (k_)) * 8 + rr) * 8 + 4); \
    _Pragma("unroll") for (int j_ = 0; j_ < 8; ++j_) { const unsigned pr_ = (j_ < 4) ? ap0_[j_ & 3] : ap1_[j_ & 3]; const float a0_ = bflo(pr_), a1_ = bfhi(pr_); \
        { u32x4 w_ = buf[2 * j_]; asm volatile("" : "+v"(w_.x), "+v"(w_.y), "+v"(w_.z), "+v"(w_.w), "+v"(oa_[0])); float f_[16]; cvt16(w_, f_); _Pragma("unroll") for (int e_ = 0; e_ < 16; ++e_) oa_[e_] = fmaf(a0_, f_[e_], oa_[e_]); } \
        { u32x4 w_ = buf[2 * j_ + 1]; asm volatile("" : "+v"(w_.x), "+v"(w_.y), "+v"(w_.z), "+v"(w_.w), "+v"(oa_[0])); float f_[16]; cvt16(w_, f_); _Pragma("unroll") for (int e_ = 0; e_ < 16; ++e_) oa_[e_] = fmaf(a1_, f_[e_], oa_[e_]); } } \
      \
    float b8_[8], b4_[4], b2_[2]; \
    _Pragma("unroll") for (int e_ = 0; e_ < 8; ++e_) { const bool up_ = lane & 32; const float kp_ = up_ ? oa_[e_ + 8] : oa_[e_], sd_ = up_ ? oa_[e_] : oa_[e_ + 8]; b8_[e_] = kp_ + __shfl_xor(sd_, 32); } \
    _Pragma("unroll") for (int e_ = 0; e_ < 4; ++e_) { const bool up_ = lane & 16; const float kp_ = up_ ? b8_[e_ + 4] : b8_[e_], sd_ = up_ ? b8_[e_] : b8_[e_ + 4]; b4_[e_] = kp_ + __shfl_xor(sd_, 16); } \
    _Pragma("unroll") for (int e_ = 0; e_ < 2; ++e_) { const bool up_ = lane & 8; const float kp_ = up_ ? b4_[e_ + 2] : b4_[e_], sd_ = up_ ? b4_[e_] : b4_[e_ + 2]; b2_[e_] = kp_ + __shfl_xor(sd_, 8); } \
    f32x2v y_; y_.x = x1_.x + g2_.x * b2_[0]; y_.y = x1_.y + g2_.y * b2_[1]; *(f32x2v*)(out + xo_) = y_; ssq[k_] = fmaf(y_.x, y_.x, fmaf(y_.y, y_.y, ssq[k_])); asm volatile("" : "+v"(ssq[k_])); } while (0)
#pragma unroll 1
            for (int i = 0; i < 16 * (1 + EXP_REP_V); ++i) {
                if (EXP_REP_V && i == 16) { ssq[0] = 0.f; ssq[1] = 0.f; ssq[2] = 0.f; ssq[3] = 0.f; }
                __builtin_amdgcn_s_barrier();
                EX_LOAD(dA, V8, i, 0); SB(); EX_VCOMP(dA, i, 0); SB();
                EX_LOAD(dA, V8, i, 1); SB(); EX_VCOMP(dA, i, 1); SB();
                EX_LOAD(dA, V8, i, 2); SB(); EX_VCOMP(dA, i, 2); SB();
                EX_LOAD(dA, V8, i, 3); SB(); EX_VCOMP(dA, i, 3); SB();
            }
#pragma unroll
            for (int k = 0; k < 4; ++k) { const float tot = wave_sum(ssq[k]); rstl[wave * 8 + half * 4 + k] = rsqrtf(tot * (1.f / D) + NORM_EPS); }
        }
#undef EX_SLICE
#undef EX_LOAD
#undef EX_LOADH
#undef EX_DOT16
#undef EX_UCOMP
#undef EX_VCOMP
#undef SB
        __builtin_amdgcn_fence(__ATOMIC_RELEASE, "agent"); __builtin_amdgcn_fence(__ATOMIC_ACQUIRE, "agent");
        LDS_WAIT();
        int lane2 = (int)__builtin_amdgcn_mbcnt_hi(~0u, __builtin_amdgcn_mbcnt_lo(~0u, 0u)); asm volatile("" : "+v"(lane2));
#pragma unroll 1
        for (int k = 0; k < 8; ++k) { float* xr = out + (size_t)(tok0 + wave * 8 + k) * D; const float rs = rstl[wave * 8 + k];
#pragma unroll
            for (int j = 0; j < 8; ++j) { const int col = 4 * (lane2 + 64 * j); const f32x4 v = *(const f32x4*)(xr + col), f = *(const f32x4*)(fin + col);
                f32x4 o; o[0] = v[0] * rs * f[0]; o[1] = v[1] * rs * f[1]; o[2] = v[2] * rs * f[2]; o[3] = v[3] * rs * f[3]; *(f32x4*)(xr + col) = o; } }
    }
}

#define XB_TMO      128
#define XB_XCNT(j)  (256  + 64 * (j))
#define XB_XSUB(j)  (1280 + 64 * (j))
#define XB_XGEN(j)  (2304 + 64 * (j))
#define XB_TOP      3328
#define XB_TOPGEN   3392
#define XCD_BAR_WORDS 3456
#define XB_SPIN_CAP (1u << 22)
__device__ __forceinline__ unsigned xb_ld(unsigned* p)              { return __hip_atomic_load(p, __ATOMIC_RELAXED, __HIP_MEMORY_SCOPE_AGENT); }
__device__ __forceinline__ unsigned xb_add(unsigned* p, unsigned v) { return __hip_atomic_fetch_add(p, v, __ATOMIC_RELAXED, __HIP_MEMORY_SCOPE_AGENT); }
__device__ __forceinline__ unsigned xb_xcc_id() { return (unsigned)__builtin_amdgcn_s_getreg((3 << 11) | 20) & 0xFu; }
#define XB_SPIN(cond, bar) do { unsigned _sp = 0; while (cond) { __builtin_amdgcn_s_sleep(1); \
    if ((++_sp & 255u) == 0u) { if (xb_ld(&(bar)[XB_TMO])) break; if (_sp > XB_SPIN_CAP) { atomicAdd(&(bar)[XB_TMO], 1u); break; } } } } while (0)
struct XcdBarrier { unsigned* bar; unsigned x; volatile LAS unsigned* st; };
__device__ __forceinline__ XcdBarrier xcd_barrier_post(unsigned* bar, volatile LAS unsigned* st) {
    XcdBarrier b; b.bar = bar; b.x = xb_xcc_id(); b.st = st;
    if (threadIdx.x == 0) (void)xb_add(&bar[XB_XCNT(b.x)], 1u);
    return b;
}
__device__ __forceinline__ void xcd_barrier_complete(unsigned* bar, unsigned x, unsigned& nloc, unsigned& nx) {
    const unsigned G = gridDim.x * gridDim.y * gridDim.z;
    unsigned sum, cnt, mine, sp = 0u;
    for (;;) {
        sum = 0u; cnt = 0u; mine = 0u;
#pragma unroll
        for (unsigned j = 0; j < 16; ++j) { const unsigned c = xb_ld(&bar[XB_XCNT(j)]); sum += c; cnt += (c > 0u) ? 1u : 0u; mine = (j == x) ? c : mine; }
        if (sum == G) break;
        __builtin_amdgcn_s_sleep(1);
        if ((++sp & 255u) == 0u) { if (xb_ld(&bar[XB_TMO])) break; if (sp > XB_SPIN_CAP) { atomicAdd(&bar[XB_TMO], 1u); break; } }
    }
    nloc = mine > 0u ? mine : 1u; nx = cnt > 0u ? cnt : 1u;
}
__device__ __forceinline__ void xcd_barrier(const XcdBarrier& b) {
    asm volatile("s_waitcnt vmcnt(0)" ::: "memory");
    __syncthreads();
    if (threadIdx.x == 0) {
        unsigned* bar = b.bar;
        __builtin_amdgcn_s_waitcnt(0);
        unsigned nloc = b.st[0], nx = b.st[1];
        if (nloc == 0u) { xcd_barrier_complete(bar, b.x, nloc, nx); b.st[0] = nloc; b.st[1] = nx; }
        const unsigned old = xb_add(&bar[XB_XSUB(b.x)], 1u);
        const unsigned gen = old / nloc;
        if (old + 1u == (gen + 1u) * nloc) {
            __builtin_amdgcn_fence(__ATOMIC_RELEASE, "agent");
            asm volatile("s_waitcnt vmcnt(0)" ::: "memory");
            const unsigned og = xb_add(&bar[XB_TOP], 1u);
            const unsigned tg = og / nx;
            if (og + 1u == (tg + 1u) * nx) xb_add(&bar[XB_TOPGEN], 1u);
            else XB_SPIN(xb_ld(&bar[XB_TOPGEN]) == tg, bar);
            __builtin_amdgcn_fence(__ATOMIC_ACQUIRE, "agent");
            xb_add(&bar[XB_XGEN(b.x)], 1u);
            asm volatile("s_waitcnt vmcnt(0)" ::: "memory");
        } else {
            XB_SPIN(xb_ld(&bar[XB_XGEN(b.x)]) == gen, bar);
            __builtin_amdgcn_fence(__ATOMIC_ACQUIRE, "agent");
            asm volatile("s_waitcnt vmcnt(0)" ::: "memory");
        }
    }
    __syncthreads();
}

__device__ __forceinline__ void subset_barrier(unsigned* cnt, unsigned n) {
    asm volatile("s_waitcnt vmcnt(0)" ::: "memory");
    __syncthreads();
    if (threadIdx.x == 0) {
        __builtin_amdgcn_fence(__ATOMIC_RELEASE, "agent");
        asm volatile("s_waitcnt vmcnt(0)" ::: "memory");
        __hip_atomic_fetch_add(cnt, 1u, __ATOMIC_RELAXED, __HIP_MEMORY_SCOPE_AGENT);
        unsigned sp = 0;
        while (__hip_atomic_load(cnt, __ATOMIC_RELAXED, __HIP_MEMORY_SCOPE_AGENT) < n) { __builtin_amdgcn_s_sleep(1); if (++sp > (1u << 24)) break; }
        __builtin_amdgcn_fence(__ATOMIC_ACQUIRE, "agent");
        asm volatile("s_waitcnt vmcnt(0)" ::: "memory");
    }
    __syncthreads();
}
__device__ __forceinline__ void subset_wait(unsigned* cnt, unsigned n) {
    __syncthreads();
    if (threadIdx.x == 0) {
        unsigned sp = 0;
        while (__hip_atomic_load(cnt, __ATOMIC_RELAXED, __HIP_MEMORY_SCOPE_AGENT) < n) { __builtin_amdgcn_s_sleep(2); if (++sp > (1u << 24)) break; }
        __builtin_amdgcn_fence(__ATOMIC_ACQUIRE, "agent");
        asm volatile("s_waitcnt vmcnt(0)" ::: "memory");
    }
    __syncthreads();
}
constexpr int NPHASES = 11;
__global__ void __launch_bounds__(NTHREADS, 2) mega_fwd(Params p) {
    extern __shared__ __attribute__((aligned(16))) unsigned char lds[];
    cg::grid_group grid = cg::this_grid();
    const int lo = p.ph_lo, hi = p.ph_hi;
#ifndef PHASE_MASK
#define PHASE_MASK 0x7ff
#endif
#define IN(k) (((PHASE_MASK >> (k)) & 1) && lo <= (k) && (k) < hi)
#define SEAM(k) do { if (IN(k) && IN((k) + 1)) xcd_barrier(xbar); } while (0)
    unsigned char* ws = p.ws;
    bf16_t* P = (bf16_t*)(ws + WS_P);
    bf16_t* Hb = (bf16_t*)((unsigned char*)p.out + OUT_H);
    bf16_t* WinT = (bf16_t*)((unsigned char*)p.out + OUT_WIN);
    const float* mod = (const float*)(ws + WS_MOD);
    LAS unsigned char* ldsl = (LAS unsigned char*)lds;
    volatile LAS unsigned* xst = (volatile LAS unsigned*)(ldsl + LDS_BYTES - 64);
    if (threadIdx.x < 2) xst[threadIdx.x] = 0u;
    __syncthreads();
    XcdBarrier xbar = xcd_barrier_post((unsigned*)(ws + WS_CTL) + 4096, xst);

#ifndef REPEAT_PHASE
#define REPEAT_PHASE -1
#endif
    int rep3 = 0;
#define RUNPH(k, ...) do { if (IN(k)) { __VA_ARGS__; if (REPEAT_PHASE == (k)) { grid.sync(); __VA_ARGS__; } } } while (0)
    RUNPH(0, { phase_mod(p, lds); __syncthreads(); phase_weights(p, lds); });
    SEAM(0);
    RUNPH(1, { phase_norm_rows(p.in[0], p.in[4], mod, mod + 2048, Hb, LDP); });
    SEAM(1);
    RUNPH(2, { pg8::Gemm g{Hb, WinT, nullptr, nullptr, LDP, LDP, T, NP, D}; pg8::StaticOrder<1> S; S.init(T, NP, gridDim.x, blockIdx.x);
        pg8::EpiBf16 E{P, NP, 33}; pg8::gemm_phase(ldsl, g, S, E); });
    SEAM(2);
    RUNPH(3, { const int G = gridDim.x, bx = blockIdx.x;
        unsigned* sbar = (unsigned*)(ws + WS_CTL) + 12288 + ((REPEAT_PHASE == 3) ? 64 * rep3 : 0); unsigned* qh = sbar + 16;
        if (G >= 128) { if (bx < 64) { phase_hgrn(p, lds, bx, 64); if (REPEAT_PHASE == 32) phase_hgrn(p, lds, bx, 64); subset_wait(sbar, (unsigned)(G - 64)); phase_attn_queue(p, lds, qh); }
                        else { phase_vt(p, lds, bx - 64, G - 64); phase_indexer(p, lds, bx - 64, G - 64); if (REPEAT_PHASE == 31) phase_indexer(p, lds, bx - 64, G - 64);
                               subset_barrier(sbar, (unsigned)(G - 64)); phase_attn_queue(p, lds, qh); } }
        else { phase_vt(p, lds, bx, G); phase_indexer(p, lds, bx, G); __syncthreads(); phase_hgrn(p, lds, bx, G); grid.sync(); phase_attn(p, lds, bx, G); }
        ++rep3; });
    SEAM(3);
    RUNPH(5, { pg8::Gemm g{(const bf16_t*)((unsigned char*)p.out + OUT_AO), (const bf16_t*)(ws + WS_WUA), (const bf16_t*)((unsigned char*)p.out + OUT_REC), (const bf16_t*)(ws + WS_WUB), 1024, 1024, T, D, 1024}; pg8::StaticOrder<2> S; S.init(T, D, gridDim.x, blockIdx.x);
        pg8::EpiMix E{(bf16_t*)(ws + WS_MIXED), P}; pg8::gemm_phase(ldsl, g, S, E); });
    SEAM(5);
    RUNPH(6, { pg8::Gemm g{(const bf16_t*)(ws + WS_MIXED), (const bf16_t*)(ws + WS_WOUT), nullptr, nullptr, D, D, T, D, D}; pg8::StaticOrder<1> S; S.init(T, D, gridDim.x, blockIdx.x);
        pg8::EpiX1 E{p.in[0], (float*)(ws + WS_X1), mod + 4096}; pg8::gemm_phase(ldsl, g, S, E); });
    SEAM(6);
    RUNPH(7, { phase_norm_rows((const float*)(ws + WS_X1), p.in[5], mod + 3 * 2048, mod + 4 * 2048, (bf16_t*)(ws + WS_H2), D); phase_uv(p); });
    SEAM(7);
    RUNPH(8, { pg8::Gemm g{(const bf16_t*)(ws + WS_H2), (const bf16_t*)(ws + WS_WQ), nullptr, nullptr, D, D, T, D, D}; pg8::StaticOrder<1> S; S.init(T, D, gridDim.x, blockIdx.x);
        pg8::EpiBf16 E{(bf16_t*)(ws + WS_QP), D, 1 << 30}; pg8::gemm_phase(ldsl, g, S, E); });
    SEAM(8);
    RUNPH(9, { phase_peer_topk_ni((const GAS bf16_t*)(ws + WS_QP), (const GAS bf16_t*)(ws + WS_KEYS), (GAS int*)(ws + WS_EIDX), (GAS float*)(ws + WS_EGATE), ldsl); });
    SEAM(9);
    RUNPH(10, { phase_experts(p, lds); });
    if (p.ph_hi > NPHASES) grid.sync();
#undef IN
#undef SEAM
}

#ifndef MK_N_LAUNCHES
#define MK_N_LAUNCHES 1
#endif
extern "C" void kernel_launch(void* const* d_in, const int* in_sizes, int n_in, void* d_out, int out_size, void* d_ws, size_t ws_size, hipStream_t stream) {
    static int grid = 0;
    if (grid == 0) {
        if (n_in != 17 || out_size != T * D || ws_size < WS_END) { fprintf(stderr, "kernel_launch: unexpected shapes (n_in %d out %d ws %zu)\n", n_in, out_size, ws_size); grid = -1; return; }
        int dev = 0, cus = 0, per_cu = 0;
        hipGetDevice(&dev); hipDeviceGetAttribute(&cus, hipDeviceAttributeMultiprocessorCount, dev);
        hipFuncSetAttribute((const void*)mega_fwd, hipFuncAttributeMaxDynamicSharedMemorySize, LDS_BYTES);
        hipOccupancyMaxActiveBlocksPerMultiprocessor(&per_cu, (const void*)mega_fwd, NTHREADS, LDS_BYTES);
        if (per_cu < 1) { fprintf(stderr, "kernel_launch: occupancy query says %d blocks/CU\n", per_cu); per_cu = 1; }
        (void)hipGetLastError();
        grid = cus * 1;
    }
    if (grid < 0) return;
    if (hipMemsetAsync((char*)d_ws + WS_CTL, 0, 65536, stream) != hipSuccess) { fprintf(stderr, "kernel_launch: memset failed\n"); return; }
    Params p{};
    for (int i = 0; i < 17; ++i) p.in[i] = (const float*)d_in[i];
    p.out = (float*)d_out; p.ws = (unsigned char*)d_ws;
#if MK_N_LAUNCHES == 1
    p.ph_lo = 0; p.ph_hi = NPHASES;
    void* args[] = {&p};
    hipError_t e = hipLaunchCooperativeKernel((const void*)mega_fwd, dim3(grid), dim3(NTHREADS), args, LDS_BYTES, stream);
    if (e != hipSuccess) fprintf(stderr, "cooperative launch failed: %s (grid %d)\n", hipGetErrorString(e), grid);
#else
    for (int k = 0; k < NPHASES; ++k) { p.ph_lo = k; p.ph_hi = k + 1; void* args[] = {&p};
        hipError_t e = hipLaunchCooperativeKernel((const void*)mega_fwd, dim3(grid), dim3(NTHREADS), args, LDS_BYTES, stream);
        if (e != hipSuccess) { fprintf(stderr, "launch %d failed: %s\n", k, hipGetErrorString(e)); break; } }
#endif
}
```

```cpp
#include <hip/hip_runtime.h>
#include <hip/hip_cooperative_groups.h>
#include <cstdio>
#include <cstdint>
namespace cg = cooperative_groups;

#define LAS __attribute__((address_space(3)))
typedef unsigned short bf16_t;
typedef short bf16x8 __attribute__((ext_vector_type(8)));
typedef short bf16x4 __attribute__((ext_vector_type(4)));
typedef float f32x2 __attribute__((ext_vector_type(2)));
typedef float f32x4 __attribute__((ext_vector_type(4)));
typedef float f32x16 __attribute__((ext_vector_type(16)));
typedef unsigned u32x2 __attribute__((ext_vector_type(2)));
typedef unsigned u32x4 __attribute__((ext_vector_type(4)));

constexpr int T = 16384, D = 2048, SEQ = 2048, NBATCH = 8, NP = 12544;
constexpr int C_QA = 0, C_KA = 1024, C_VA = 2048, C_QI = 3072, C_KI = 4096, C_WI = 4160, C_QB = 4352, C_FB = 5376, C_IB = 6400, C_GB = 7424, C_GA = 8448, C_GG = 10496;
constexpr int NADA = 12288;
constexpr float NORM_EPS = 1e-6f;
constexpr int NTHREADS = 512, NWAVES = 8;
constexpr int LDS_BYTES = 147456;
constexpr size_t MiB = 1u << 20;
constexpr size_t WS_CTL = 0, WS_MOD = 1 * MiB, WS_WUA = 2 * MiB, WS_WUB = 6 * MiB, WS_WOUT = 10 * MiB, WS_WQ = 18 * MiB, WS_KEYS = 26 * MiB, WS_MASK = 27 * MiB;
constexpr size_t WS_MIXED = 32 * MiB;
constexpr size_t WS_VT = 32 * MiB, WS_ORAW = 64 * MiB;
constexpr size_t WS_P = 96 * MiB;
constexpr size_t WS_H2 = 96 * MiB, WS_QP = 160 * MiB, WS_U8 = 224 * MiB, WS_V8 = 256 * MiB, WS_ISU = 26 * MiB + 512 * 1024, WS_ISV = 26 * MiB + 768 * 1024, WS_Y = 288 * MiB, WS_EIDX = 352 * MiB, WS_EGATE = 360 * MiB;
constexpr size_t WS_X1 = 368 * MiB;
constexpr size_t WS_END = 560 * MiB;
constexpr int LDP = 2048 + 64;
constexpr size_t OUT_H = 0, OUT_WIN = 68 * MiB;
constexpr size_t WS_AO = 496 * MiB, WS_REC = 528 * MiB;

struct Params { const float* in[17]; float* out; unsigned char* ws; int ph_lo, ph_hi; };

__device__ __forceinline__ unsigned f2bf(float f) { unsigned u = __float_as_uint(f); return (u + 0x7fffu + ((u >> 16) & 1u)) >> 16; }
__device__ __forceinline__ float bf2f(unsigned b) { return __uint_as_float(b << 16); }
__device__ __forceinline__ float bflo(unsigned w) { return __uint_as_float(w << 16); }
__device__ __forceinline__ float bfhi(unsigned w) { return __uint_as_float(w & 0xffff0000u); }
__device__ __forceinline__ unsigned pk2(float lo, float hi) { unsigned r; asm volatile("v_cvt_pk_bf16_f32 %0, %1, %2" : "=v"(r) : "v"(lo), "v"(hi)); return r; }
__device__ __forceinline__ float wave_sum(float v) {
#pragma unroll
    for (int o = 1; o < 64; o <<= 1) v += __shfl_xor(v, o);
    return v;
}
__device__ __forceinline__ float sigmoidf_(float v) { return 1.f / (1.f + __expf(-v)); }
__device__ __forceinline__ float siluf_(float v) { return v / (1.f + __expf(-v)); }
#define LDS_WAIT() asm volatile("s_waitcnt lgkmcnt(0)" ::: "memory")

namespace pg8 {
constexpr int BM = 256, BK = 64, HALF = 128, HTB = HALF * BK * 2, STAGE_BYTES = 8 * HTB, NXCD = 8, WGM = 8;
__host__ __device__ __forceinline__ int lds_byte(int r, int c) { const int st = (r >> 4) * 2 + (c >> 5), rr = r & 15, cc = c & 31, ob = rr * 64 + cc * 2; return st * 1024 + (ob ^ (((ob >> 9) & 1) << 5)); }
__host__ __device__ __forceinline__ void stage_rc(int b, int& R, int& C) { const int st = b / 1024, sb = b % 1024, swz = sb ^ (((sb >> 9) & 1) << 5); R = (st >> 1) * 16 + swz / 64; C = (st & 1) * 32 + (swz % 64) / 2; }
__host__ __device__ __forceinline__ int perm32(int rho) { const int n = rho >> 4, i = rho & 15; return 8 * (i >> 2) + 4 * n + (i & 3); }

struct Unit { int pm, pn, z; };
struct Gemm { const bf16_t* A; const bf16_t* Bt; const bf16_t* A2; const bf16_t* Bt2; int lda, ldb, M, N, K; };

template <int NZ> struct StaticOrder {
    int nM, nN, nwg, G, c, pn0;
    __device__ void init(int M, int N, int G_, int c_, int pn0_ = 0) { nM = M / BM; nN = N / BM; nwg = nM * nN; G = G_; c = c_; pn0 = pn0_; }
    __device__ bool next(int i, Unit& u) const {
        const long L = (long)(i / NZ) * G + c; if (L >= nwg) return false;
        int wgid = (int)L; { const int q = nwg / NXCD, r = nwg % NXCD, xcd = wgid % NXCD, off = wgid / NXCD; wgid = (xcd < r ? xcd * (q + 1) : r * (q + 1) + (xcd - r) * q) + off; }
        const int nig = WGM * nN, gid = wgid / nig, fm = gid * WGM, gsz = (nM - fm) < WGM ? (nM - fm) : WGM;
        u.pm = fm + ((wgid % nig) % gsz); u.pn = pn0 + (wgid % nig) / gsz; u.z = i % NZ; return true;
    }
};

template <class Epi, class Sched>
__device__ __forceinline__ void gemm_phase(LAS unsigned char* lds, const Gemm g, const Sched& S, const Epi& E) {
    const int tid = threadIdx.x, wid = __builtin_amdgcn_readfirstlane(tid >> 6), lane = tid & 63, wr = wid >> 2, wc = wid & 3, fr = lane & 15, fq = lane >> 4;
    const int K = g.K, nt = K / BK;
    unsigned voffA[2], voffB[2];
#pragma unroll
    for (int i = 0; i < 2; ++i) { int R, C; stage_rc(tid * 16 + i * 8192, R, C); const int Rb = Epi::PERM ? ((R & ~31) + perm32(R & 31)) : R;
        voffA[i] = (unsigned)(R * g.lda + C) * 2u; voffB[i] = (unsigned)(Rb * g.ldb + C) * 2u; }
    const size_t kstep = (size_t)(BK * 2);
    const size_t hstepA = (size_t)HALF * g.lda * 2, hstepB = (size_t)HALF * g.ldb * 2;
    const size_t tstepA = 2 * hstepA, tstepB = 2 * hstepB;
    const unsigned ldsw = (unsigned)wid * 1024u;
    const int aoff = lds_byte(wr * 64 + fr, fq * 8), boff = lds_byte(wc * 32 + fr, fq * 8);
#define PG8_SA(b, h) (((b) * 2 + (h)) * HTB)
#define PG8_SB(b, h) ((4 + (b) * 2 + (h)) * HTB)
#define PG8_STAGE(bufoff, gbase, voff) do { _Pragma("unroll") for (int _i = 0; _i < 2; ++_i) \
        __builtin_amdgcn_global_load_lds((const unsigned*)((const char*)(gbase) + (voff)[_i]), (LAS unsigned*)(lds + (bufoff) + ldsw + _i * 8192), 16, 0, 0); } while (0)
#define PG8_LDA(dst, b, h) do { _Pragma("unroll") for (int m = 0; m < 4; ++m) _Pragma("unroll") for (int k = 0; k < 2; ++k) dst[m][k] = *(const LAS bf16x8*)(lds + PG8_SA(b, h) + aoff + m * 2048 + k * 1024); } while (0)
#define PG8_LDB(dst, b, h) do { _Pragma("unroll") for (int n = 0; n < 2; ++n) _Pragma("unroll") for (int k = 0; k < 2; ++k) dst[n][k] = *(const LAS bf16x8*)(lds + PG8_SB(b, h) + boff + n * 2048 + k * 1024); } while (0)
#define PG8_MMA(ai, bj, At, Bt) do { __builtin_amdgcn_s_setprio(1); _Pragma("unroll") for (int m = 0; m < 4; ++m) _Pragma("unroll") for (int n = 0; n < 2; ++n) _Pragma("unroll") for (int k = 0; k < 2; ++k) \
        acc[ai][bj][m][n] = __builtin_amdgcn_mfma_f32_16x16x32_bf16(Bt[n][k], At[m][k], acc[ai][bj][m][n], 0, 0, 0); __builtin_amdgcn_s_setprio(0); } while (0)
#define PG8_WAIT_V(n) asm volatile("s_waitcnt vmcnt(" #n ")" ::: "memory")
#define PG8_WAIT_L(n) asm volatile("s_waitcnt lgkmcnt(" #n ")" ::: "memory")
#define PG8_BAR __builtin_amdgcn_s_barrier()
#define PG8_SCHED __builtin_amdgcn_sched_barrier(0)
#define PG8_ABASE(u) ((const char*)((u).z ? g.A2 : g.A) + (size_t)(u).pm * tstepA)
#define PG8_BBASE(u) ((const char*)((u).z ? g.Bt2 : g.Bt) + (size_t)(u).pn * tstepB)
    Unit cur, nxt; int ui = 0;
    if (!S.next(0, cur)) return;
    f32x4 acc[2][2][4][2];
#pragma unroll
    for (int a = 0; a < 2; ++a)
#pragma unroll
        for (int b = 0; b < 2; ++b)
#pragma unroll
            for (int m = 0; m < 4; ++m)
#pragma unroll
                for (int n = 0; n < 2; ++n) acc[a][b][m][n] = (f32x4){0.f, 0.f, 0.f, 0.f};
    bf16x8 At[4][2], B0[2][2], B1[2][2];
    const char* cA = PG8_ABASE(cur); const char* cB = PG8_BBASE(cur);
    PG8_STAGE(PG8_SB(0, 0), cB, voffB); PG8_STAGE(PG8_SA(0, 0), cA, voffA); PG8_STAGE(PG8_SB(0, 1), cB + hstepB, voffB); PG8_STAGE(PG8_SA(0, 1), cA + hstepA, voffA);
    if (wr == 1) PG8_BAR;
    PG8_WAIT_V(4); PG8_BAR;
    PG8_STAGE(PG8_SB(1, 0), cB + kstep, voffB); PG8_STAGE(PG8_SA(1, 0), cA + kstep, voffA); PG8_STAGE(PG8_SB(1, 1), cB + hstepB + kstep, voffB);
    PG8_WAIT_V(6); PG8_BAR;
    for (;;) {
        const bool has_next = S.next(ui + 1, nxt);
        const char* nA = has_next ? PG8_ABASE(nxt) : cA; const char* nB = has_next ? PG8_BBASE(nxt) : cB;
        for (int t = 0; t < nt; t += 2) {
            const bool last = (t == nt - 2);
            const char* a1 = cA + (size_t)(t + 1) * kstep;
            const char* a2 = last ? nA : cA + (size_t)(t + 2) * kstep; const char* b2 = last ? nB : cB + (size_t)(t + 2) * kstep;
            const char* a3 = a2 + kstep; const char* b3 = b2 + kstep;
            PG8_LDB(B0, 0, 0); PG8_SCHED; PG8_LDA(At, 0, 0); PG8_STAGE(PG8_SA(1, 1), a1 + hstepA, voffA);
            PG8_WAIT_L(8); PG8_BAR; PG8_WAIT_L(0); PG8_MMA(0, 0, At, B0); PG8_BAR; PG8_SCHED;
            PG8_LDB(B1, 0, 1); PG8_STAGE(PG8_SB(0, 0), b2, voffB);
            PG8_BAR; PG8_WAIT_L(0); PG8_MMA(0, 1, At, B1); PG8_BAR;
            PG8_LDA(At, 0, 1); PG8_STAGE(PG8_SA(0, 0), a2, voffA);
            PG8_BAR; PG8_WAIT_L(0); PG8_MMA(1, 0, At, B0); PG8_BAR; PG8_SCHED;
            PG8_STAGE(PG8_SB(0, 1), b2 + hstepB, voffB);
            PG8_WAIT_V(6); PG8_BAR; PG8_MMA(1, 1, At, B1); PG8_BAR;
            PG8_LDB(B0, 1, 0); PG8_SCHED; PG8_LDA(At, 1, 0); PG8_STAGE(PG8_SA(0, 1), a2 + hstepA, voffA);
            PG8_WAIT_L(8); PG8_BAR; PG8_WAIT_L(0); PG8_MMA(0, 0, At, B0); PG8_BAR; PG8_SCHED;
            PG8_LDB(B1, 1, 1); PG8_STAGE(PG8_SB(1, 0), b3, voffB);
            PG8_BAR; PG8_WAIT_L(0); PG8_MMA(0, 1, At, B1); PG8_BAR;
            PG8_LDA(At, 1, 1); PG8_STAGE(PG8_SA(1, 0), a3, voffA);
            PG8_BAR; PG8_WAIT_L(0); PG8_MMA(1, 0, At, B0); PG8_BAR; PG8_SCHED;
            PG8_STAGE(PG8_SB(1, 1), b3 + hstepB, voffB);
            PG8_WAIT_V(6); PG8_BAR; PG8_MMA(1, 1, At, B1); PG8_BAR;
        }
        E(acc, cur, wr, wc, fr, fq);
        if (!has_next) break;
#pragma unroll
        for (int a = 0; a < 2; ++a)
#pragma unroll
            for (int b = 0; b < 2; ++b)
#pragma unroll
                for (int m = 0; m < 4; ++m)
#pragma unroll
                    for (int n = 0; n < 2; ++n) acc[a][b][m][n] = (f32x4){0.f, 0.f, 0.f, 0.f};
        cur = nxt; cA = nA; cB = nB; ++ui;
    }
    PG8_WAIT_V(0);
    if (wr == 0) PG8_BAR;
    PG8_BAR;
#undef PG8_SA
#undef PG8_SB
#undef PG8_STAGE
#undef PG8_LDA
#undef PG8_LDB
#undef PG8_MMA
#undef PG8_WAIT_V
#undef PG8_WAIT_L
#undef PG8_BAR
#undef PG8_SCHED
#undef PG8_ABASE
#undef PG8_BBASE
}

struct EpiBf16 {
    static constexpr bool PERM = true;
    bf16_t* O; int ldc; int sig_from;
    __device__ __forceinline__ void operator()(const f32x4 (&acc)[2][2][4][2], const Unit& u, int wr, int wc, int fr, int fq) const {
        const int row0 = u.pm * BM + wr * 64 + fr, col0 = u.pn * BM + wc * 32 + 8 * fq; const bool sig = u.pn >= sig_from;
#pragma unroll
        for (int ai = 0; ai < 2; ++ai)
#pragma unroll
            for (int m = 0; m < 4; ++m) { bf16_t* rowp = O + (size_t)(row0 + ai * HALF + m * 16) * ldc + col0;
#pragma unroll
                for (int bj = 0; bj < 2; ++bj) { f32x4 v0 = acc[ai][bj][m][0], v1 = acc[ai][bj][m][1];
                    if (sig) {
#pragma unroll
                        for (int j = 0; j < 4; ++j) { v0[j] = sigmoidf_(v0[j]); v1[j] = sigmoidf_(v1[j]); } }
                    u32x4 w; w.x = pk2(v0[0], v0[1]); w.y = pk2(v0[2], v0[3]); w.z = pk2(v1[0], v1[1]); w.w = pk2(v1[2], v1[3]);
                    *(u32x4*)(rowp + bj * HALF) = w; } }
    }
};
struct EpiMix {
    static constexpr bool PERM = true;
    bf16_t* O; const bf16_t* P;
    __device__ __forceinline__ void operator()(const f32x4 (&acc)[2][2][4][2], const Unit& u, int wr, int wc, int fr, int fq) const {
        const int row0 = u.pm * BM + wr * 64 + fr, col0 = u.pn * BM + wc * 32 + 8 * fq; const int gcol = (u.z ? C_GG : C_GA);
#pragma unroll
        for (int ai = 0; ai < 2; ++ai) {
            u32x4 gw[4][2], pw[4][2];
#pragma unroll
            for (int m = 0; m < 4; ++m)
#pragma unroll
                for (int bj = 0; bj < 2; ++bj) { const size_t r = (size_t)(row0 + ai * HALF + m * 16);
                    gw[m][bj] = *(const u32x4*)(P + r * NP + gcol + col0 + bj * HALF);
                    if (u.z) pw[m][bj] = *(const u32x4*)(O + r * D + col0 + bj * HALF); else pw[m][bj] = (u32x4){0u, 0u, 0u, 0u}; }
            asm volatile("" ::: "memory");
#pragma unroll
            for (int m = 0; m < 4; ++m)
#pragma unroll
                for (int bj = 0; bj < 2; ++bj) { const size_t r = (size_t)(row0 + ai * HALF + m * 16); const f32x4 v0 = acc[ai][bj][m][0], v1 = acc[ai][bj][m][1]; const u32x4 g = gw[m][bj], q = pw[m][bj];
                    u32x4 w; w.x = pk2(fmaf(v0[0], bflo(g.x), bflo(q.x)), fmaf(v0[1], bfhi(g.x), bfhi(q.x))); w.y = pk2(fmaf(v0[2], bflo(g.y), bflo(q.y)), fmaf(v0[3], bfhi(g.y), bfhi(q.y)));
                    w.z = pk2(fmaf(v1[0], bflo(g.z), bflo(q.z)), fmaf(v1[1], bfhi(g.z), bfhi(q.z))); w.w = pk2(fmaf(v1[2], bflo(g.w), bflo(q.w)), fmaf(v1[3], bfhi(g.w), bfhi(q.w)));
                    *(u32x4*)(O + r * D + col0 + bj * HALF) = w; }
            asm volatile("" ::: "memory");
        }
    }
};
struct EpiX1 {
    static constexpr bool PERM = false;
    const float* x; float* out; const float* gate;
    __device__ __forceinline__ void operator()(const f32x4 (&acc)[2][2][4][2], const Unit& u, int wr, int wc, int fr, int fq) const {
        const int row0 = u.pm * BM + wr * 64 + fr, col0 = u.pn * BM + wc * 32 + 4 * fq; const int b = (u.pm * BM) >> 11;
        f32x4 gv[2][2];
#pragma unroll
        for (int bj = 0; bj < 2; ++bj)
#pragma unroll
            for (int n = 0; n < 2; ++n) gv[bj][n] = *(const f32x4*)(gate + (size_t)b * NADA + col0 + bj * HALF + n * 16);
#pragma unroll
        for (int ai = 0; ai < 2; ++ai) {
            f32x4 xv[4][2][2];
#pragma unroll
            for (int m = 0; m < 4; ++m)
#pragma unroll
                for (int bj = 0; bj < 2; ++bj)
#pragma unroll
                    for (int n = 0; n < 2; ++n) xv[m][bj][n] = *(const f32x4*)(x + (size_t)(row0 + ai * HALF + m * 16) * D + col0 + bj * HALF + n * 16);
            asm volatile("" ::: "memory");
#pragma unroll
            for (int m = 0; m < 4; ++m)
#pragma unroll
                for (int bj = 0; bj < 2; ++bj)
#pragma unroll
                    for (int n = 0; n < 2; ++n) *(f32x4*)(out + (size_t)(row0 + ai * HALF + m * 16) * D + col0 + bj * HALF + n * 16) = xv[m][bj][n] + gv[bj][n] * acc[ai][bj][m][n];
            asm volatile("" ::: "memory");
        }
    }
};
}

__device__ __forceinline__ void phase_mod(const Params& p, unsigned char* lds) {
    float* sc = (float*)lds;
    float* red = (float*)(lds + 65536);
    const int tid = threadIdx.x, wave = tid >> 6, lane = tid & 63;
    const float* c = p.in[1]; const float* wada = p.in[2]; const float* bada = p.in[3];
    float* mod = (float*)(p.ws + WS_MOD);
    if ((int)blockIdx.x >= 192) return;
    for (int i = tid; i < NBATCH * D; i += NTHREADS) { const int b = i >> 11, k = i & 2047; sc[k * 8 + b] = siluf_(c[i]); }
    __syncthreads();
    const int cgp = tid & 15, rg = tid >> 4;
    for (int item = blockIdx.x; item < 192; item += gridDim.x) {
        const float* w = wada + item * 64 + cgp * 4;
        float acc[8][4];
#pragma unroll
        for (int b = 0; b < 8; ++b)
#pragma unroll
            for (int j = 0; j < 4; ++j) acc[b][j] = 0.f;
#pragma unroll 1
        for (int i0 = 0; i0 < 64; i0 += 8) {
            f32x4 wvv[8];
#pragma unroll
            for (int u = 0; u < 8; ++u) wvv[u] = __builtin_nontemporal_load((const f32x4*)(w + (size_t)(rg + 32 * (i0 + u)) * NADA));
#pragma unroll
            for (int u = 0; u < 8; ++u) { const int k = rg + 32 * (i0 + u); const f32x4 wv = wvv[u];
                const f32x4 s0 = *(const f32x4*)(sc + k * 8), s1 = *(const f32x4*)(sc + k * 8 + 4);
#pragma unroll
                for (int j = 0; j < 4; ++j) { acc[0][j] += s0[0] * wv[j]; acc[1][j] += s0[1] * wv[j]; acc[2][j] += s0[2] * wv[j]; acc[3][j] += s0[3] * wv[j];
                    acc[4][j] += s1[0] * wv[j]; acc[5][j] += s1[1] * wv[j]; acc[6][j] += s1[2] * wv[j]; acc[7][j] += s1[3] * wv[j]; } } }
#pragma unroll
        for (int b = 0; b < 8; ++b)
#pragma unroll
            for (int j = 0; j < 4; ++j) { float v = acc[b][j]; v += __shfl_xor(v, 16); v += __shfl_xor(v, 32); acc[b][j] = v; }
        if (lane < 16) {
#pragma unroll
            for (int b = 0; b < 8; ++b)
#pragma unroll
                for (int j = 0; j < 4; ++j) red[(wave * 16 + cgp) * 32 + b * 4 + j] = acc[b][j]; }
        __syncthreads();
        { const int cgo = tid >> 5, b = (tid >> 2) & 7, j = tid & 3; float s = 0.f;
#pragma unroll
          for (int w8 = 0; w8 < 8; ++w8) s += red[(w8 * 16 + cgo) * 32 + (tid & 31)];
          const int col = item * 64 + cgo * 4 + j; mod[b * NADA + col] = s + bada[col]; }
        __syncthreads();
    }
}
__device__ __forceinline__ void transpose_item(const float* W, int K, int N, bf16_t* WT, int nblk, int item, int lane, float* scr, int mode, int pitch) {
    const int kb = item / nblk, nb = item % nblk, k0 = 64 * kb, n0 = 32 * nb;
    const int nd = n0 + (lane & 31); int ns = nd; bool valid = true;
    if (mode == 1) { if (nd >= C_QB) ns = nd - 176; else if (nd >= 4176) valid = false; }
    if (mode == 0 || n0 < 4160 || n0 >= C_QB) {
        const int ns0 = (mode == 1 && n0 >= C_QB) ? n0 - 176 : n0;
        f32x4 v[8];
#pragma unroll
        for (int i = 0; i < 8; ++i) v[i] = *(const f32x4*)(W + (size_t)(k0 + 8 * i + (lane >> 3)) * N + ns0 + 4 * (lane & 7));
#pragma unroll
        for (int i = 0; i < 8; ++i) { float* d = scr + (8 * i + (lane >> 3)) * 33 + 4 * (lane & 7); d[0] = v[i][0]; d[1] = v[i][1]; d[2] = v[i][2]; d[3] = v[i][3]; }
    } else {
#pragma unroll 8
        for (int i = 0; i < 32; ++i) { const int kk = 2 * i + (lane >> 5); scr[kk * 33 + (lane & 31)] = valid ? W[(size_t)(k0 + kk) * N + ns] : 0.f; }
    }
    LDS_WAIT();
    const int c = lane & 7;
#pragma unroll
    for (int j = 0; j < 4; ++j) { const int n = (lane >> 3) + 8 * j; const float* s = scr + (8 * c) * 33 + n;
        u32x4 o; o.x = pk2(s[0 * 33], s[1 * 33]); o.y = pk2(s[2 * 33], s[3 * 33]); o.z = pk2(s[4 * 33], s[5 * 33]); o.w = pk2(s[6 * 33], s[7 * 33]);
        *(u32x4*)(WT + (size_t)(n0 + n) * pitch + k0 + 8 * c) = o; }
    LDS_WAIT();
}
__device__ __forceinline__ void phase_weights(const Params& p, unsigned char* lds) {
    const int tid = threadIdx.x, wave = tid >> 6, lane = tid & 63;
    float* scr = (float*)(lds + wave * 16384);
    const int vb = ((int)blockIdx.x + (int)gridDim.x - 192 % (int)gridDim.x) % (int)gridDim.x;
    const int gw = vb * NWAVES + wave, NGW = gridDim.x * NWAVES;
    constexpr int I_IN = 32 * (NP / 32), I_UA = 16 * 64, I_UB = 16 * 64, I_O = 32 * 64, I_Q = 32 * 64;
    constexpr int NITEMS = I_IN + I_UA + I_UB + I_O + I_Q;
    bf16_t* win_t = (bf16_t*)((unsigned char*)p.out + OUT_WIN);
    for (int it = gw; it < NITEMS; it += NGW) {
        int r = it;
        if (r < I_IN) { transpose_item(p.in[6], 2048, 12368, win_t, NP / 32, r, lane, scr, 1, LDP); continue; } r -= I_IN;
        if (r < I_UA) { transpose_item(p.in[9], 1024, 2048, (bf16_t*)(p.ws + WS_WUA), 64, r, lane, scr, 0, 1024); continue; } r -= I_UA;
        if (r < I_UB) { transpose_item(p.in[10], 1024, 2048, (bf16_t*)(p.ws + WS_WUB), 64, r, lane, scr, 0, 1024); continue; } r -= I_UB;
        if (r < I_O) { transpose_item(p.in[11], 2048, 2048, (bf16_t*)(p.ws + WS_WOUT), 64, r, lane, scr, 0, 2048); continue; } r -= I_O;
        transpose_item(p.in[12], 2048, 2048, (bf16_t*)(p.ws + WS_WQ), 64, r, lane, scr, 0, 2048);
    }
    { const float* ks = p.in[13]; bf16_t* kd = (bf16_t*)(p.ws + WS_KEYS);
      for (int i = (blockIdx.x * NTHREADS + tid) * 4; i < 8 * 2 * 128 * 128; i += gridDim.x * NTHREADS * 4) { const f32x4 v = *(const f32x4*)(ks + i); u32x2 o; o.x = pk2(v[0], v[1]); o.y = pk2(v[2], v[3]); *(u32x2*)(kd + i) = o; } }
}

__device__ __forceinline__ void phase_norm_rows(const float* src, const float* gain, const float* shift, const float* scale, bf16_t* dst, int pitch) {
    const int tid = threadIdx.x, wave = tid >> 6, lane = tid & 63;
    const int gw = blockIdx.x * NWAVES + wave, NGW = gridDim.x * NWAVES;
    for (int row = gw; row < T; row += NGW) {
        const int b = row >> 11; const f32x4* xr = (const f32x4*)(src + (size_t)row * D) + lane;
        f32x4 v[8]; float ss = 0.f;
#pragma unroll
        for (int j = 0; j < 8; ++j) { v[j] = xr[64 * j]; ss += (v[j][0] * v[j][0] + v[j][1] * v[j][1]) + (v[j][2] * v[j][2] + v[j][3] * v[j][3]); }
        const float rstd = rsqrtf(wave_sum(ss) * (1.f / D) + NORM_EPS);
        u32x2* o8 = (u32x2*)(dst + (size_t)row * pitch) + lane;
#pragma unroll
        for (int j = 0; j < 8; ++j) { const int col = 4 * (lane + 64 * j);
            const f32x4 g = *(const f32x4*)(gain + col), sh = *(const f32x4*)(shift + (size_t)b * NADA + col), sc = *(const f32x4*)(scale + (size_t)b * NADA + col);
            f32x4 h;
#pragma unroll
            for (int e = 0; e < 4; ++e) h[e] = v[j][e] * rstd * g[e] * (1.f + sc[e]) + sh[e];
            u32x2 w; w.x = pk2(h[0], h[1]); w.y = pk2(h[2], h[3]); o8[64 * j] = w; }
    }
}

__device__ __forceinline__ void phase_vt(const Params& p, unsigned char* lds, int vb, int vG) {
    const int tid = threadIdx.x, wave = tid >> 6, lane = tid & 63;
    bf16_t* tile = (bf16_t*)(lds + wave * 16384);
    const bf16_t* P = (const bf16_t*)(p.ws + WS_P); bf16_t* VT = (bf16_t*)(p.ws + WS_VT);
    const int gw = vb * NWAVES + wave, NGW = vG * NWAVES;
    for (int it = gw; it < 8 * 8 * 32 * 2; it += NGW) {
        const int dh = it & 1, kt = (it >> 1) & 31, h = (it >> 6) & 7, b = it >> 9;
        const int k0 = kt * 64, d0 = dh * 64;
#pragma unroll
        for (int i = 0; i < 8; ++i) { const int key = i * 8 + (lane >> 3), dc = lane & 7;
            const u32x4 v = *(const u32x4*)(P + (size_t)(b * SEQ + k0 + key) * NP + C_VA + h * 128 + d0 + dc * 8);
            bf16_t* t = tile + (dc * 8) * 72 + key;
            t[0 * 72] = (bf16_t)(v.x & 0xffff); t[1 * 72] = (bf16_t)(v.x >> 16); t[2 * 72] = (bf16_t)(v.y & 0xffff); t[3 * 72] = (bf16_t)(v.y >> 16);
            t[4 * 72] = (bf16_t)(v.z & 0xffff); t[5 * 72] = (bf16_t)(v.z >> 16); t[6 * 72] = (bf16_t)(v.w & 0xffff); t[7 * 72] = (bf16_t)(v.w >> 16); }
        LDS_WAIT();
#pragma unroll
        for (int i = 0; i < 8; ++i) { const int d = i * 8 + (lane >> 3), kc = lane & 7;
            const u32x4 v = *(const u32x4*)(tile + d * 72 + kc * 8);
            *(u32x4*)(VT + ((size_t)((b * 8 + h) * 128 + d0 + d)) * SEQ + k0 + kc * 8) = v; }
        LDS_WAIT();
    }
}

__device__ __forceinline__ unsigned ord_key(float s) { const unsigned u = __float_as_uint(s); return (u & 0x80000000u) ? ~u : (u | 0x80000000u); }
__device__ __forceinline__ int half_sum(int v) {
    v += __builtin_amdgcn_update_dpp(0, v, 0xB1, 0xF, 0xF, true);
    v += __builtin_amdgcn_update_dpp(0, v, 0x4E, 0xF, 0xF, true);
    v += __builtin_amdgcn_update_dpp(0, v, 0x141, 0xF, 0xF, true);
    v += __builtin_amdgcn_update_dpp(0, v, 0x140, 0xF, 0xF, true);
    v += __shfl_xor(v, 16);
    return v;
}
constexpr int IX_RS = 72, IX_STAGE = 32 * IX_RS * 2;
__device__ __forceinline__ void indexer_item(const Params& p, unsigned char* lds, int b, int c, int grp) {
    const int tid = threadIdx.x, w = __builtin_amdgcn_readfirstlane(tid >> 6), lane = tid & 63, r = lane & 31, hh = lane >> 5;
    const bf16_t* P = (const bf16_t*)(p.ws + WS_P); unsigned* MASK = (unsigned*)(p.ws + WS_MASK);
    const int pair = grp * 8 + w, q0 = b * SEQ + c * 64 + 2 * pair;
    bf16x8 af[4];
    { const int query = q0 + ((r >> 2) & 1), head = (r & 3) + 4 * (r >> 3);
      const bf16_t* qp = P + (size_t)query * NP + C_QI + head * 64 + 8 * hh;
#pragma unroll
      for (int ks = 0; ks < 4; ++ks) af[ks] = *(const bf16x8*)(qp + ks * 16); }
    float wv[16];
    { const u32x4 w0 = *(const u32x4*)(P + (size_t)(q0 + hh) * NP + C_WI), w1 = *(const u32x4*)(P + (size_t)(q0 + hh) * NP + C_WI + 8);
      wv[0] = bflo(w0.x); wv[1] = bfhi(w0.x); wv[2] = bflo(w0.y); wv[3] = bfhi(w0.y); wv[4] = bflo(w0.z); wv[5] = bfhi(w0.z); wv[6] = bflo(w0.w); wv[7] = bfhi(w0.w);
      wv[8] = bflo(w1.x); wv[9] = bfhi(w1.x); wv[10] = bflo(w1.y); wv[11] = bfhi(w1.y); wv[12] = bflo(w1.z); wv[13] = bfhi(w1.z); wv[14] = bflo(w1.w); wv[15] = bfhi(w1.w); }
    const int nkt = 2 * (c + 1);
    const bool ldr = tid < 256;
    const bf16_t* kg = P + (size_t)(b * SEQ + ((tid >> 3) & 31)) * NP + C_KI + (tid & 7) * 8;
    const int kls = ((tid >> 3) & 31) * IX_RS * 2 + (tid & 7) * 16;
    u32x4 kr = {0u, 0u, 0u, 0u};
    __syncthreads();
    if (ldr) { *(u32x4*)(lds + kls) = *(const u32x4*)kg; *(u32x4*)(lds + IX_STAGE + kls) = *(const u32x4*)(kg + (size_t)32 * NP); }
    if (ldr && 2 < nkt) kr = *(const u32x4*)(kg + (size_t)64 * NP);
    __syncthreads();
    unsigned kv[64];
#pragma unroll
    for (int kt = 0; kt < 64; ++kt) {
        kv[kt] = 0u;
        if (kt < nkt) {
            if (ldr && kt + 2 < nkt) *(u32x4*)(lds + ((kt + 2) % 3) * IX_STAGE + kls) = kr;
            if (ldr && kt + 3 < nkt) kr = *(const u32x4*)(kg + (size_t)((kt + 3) * 32) * NP);
            const bf16_t* Ks = (const bf16_t*)(lds + (kt % 3) * IX_STAGE);
            f32x16 acc;
#pragma unroll
            for (int i = 0; i < 16; ++i) acc[i] = 0.f;
#pragma unroll
            for (int ks = 0; ks < 4; ++ks) { const bf16x8 bfr = *(const bf16x8*)(Ks + r * IX_RS + ks * 16 + 8 * hh); acc = __builtin_amdgcn_mfma_f32_32x32x16_bf16(af[ks], bfr, acc, 0, 0, 0); }
            float sc = 0.f;
#pragma unroll
            for (int i = 0; i < 16; ++i) sc += wv[i] * fmaxf(acc[i], 0.f);
            kv[kt] = ord_key(sc);
            __syncthreads();
        }
    }
    unsigned thr = 0u;
    if (nkt > 8) {
        int cur = 1 << 20;
        for (int bit = 31; bit >= 0; --bit) {
            const unsigned cand = thr | (1u << bit); int cnt = 0;
#pragma unroll
            for (int kt = 0; kt < 32; ++kt) cnt += (kv[kt] >= cand) ? 1 : 0;
            if (nkt > 32) {
#pragma unroll
                for (int kt = 32; kt < 64; ++kt) cnt += (kv[kt] >= cand) ? 1 : 0; }
            cnt = half_sum(cnt);
            if (cnt >= 256) { thr = cand; cur = cnt; }
            if (__builtin_amdgcn_ballot_w64(cur != 256) == 0ull) break;
        }
    }
    int cge = 0;
#pragma unroll
    for (int kt = 0; kt < 64; ++kt) cge += (kv[kt] >= thr && kv[kt] != 0u) ? 1 : 0;
    cge = half_sum(cge);
    const bool ties = (thr != 0u) && (cge > 256);
    unsigned m0 = 0u, m1 = 0u;
    if (__builtin_amdgcn_ballot_w64(ties) == 0ull) {
#pragma unroll
        for (int kt = 0; kt < 64; ++kt) { const unsigned long long bm = __builtin_amdgcn_ballot_w64(kv[kt] >= thr && kv[kt] != 0u);
            if (lane == kt) { m0 = (unsigned)bm; m1 = (unsigned)(bm >> 32); } }
    } else {
        int cgt = 0;
#pragma unroll
        for (int kt = 0; kt < 64; ++kt) cgt += (kv[kt] > thr) ? 1 : 0;
        cgt = half_sum(cgt);
        const int need = ties ? (256 - cgt) : (1 << 30); int run = 0;
#pragma unroll
        for (int kt = 0; kt < 64; ++kt) { const bool tie = ties && (kv[kt] == thr); const unsigned long long tb = __builtin_amdgcn_ballot_w64(tie);
            const unsigned th = hh ? (unsigned)(tb >> 32) : (unsigned)tb; const int rank = run + __builtin_popcount(th & ((1u << r) - 1u));
            const bool sel = ties ? ((kv[kt] > thr) || (tie && rank < need)) : (kv[kt] >= thr && kv[kt] != 0u);
            run += __builtin_popcount(th);
            const unsigned long long bm = __builtin_amdgcn_ballot_w64(sel);
            if (lane == kt) { m0 = (unsigned)bm; m1 = (unsigned)(bm >> 32); } }
    }
    { const int qpos = c * 64 + 2 * pair; unsigned* mt = MASK + ((size_t)(b * 64 + lane)) * SEQ + qpos; mt[0] = m0; mt[1] = m1; }
}
__device__ __forceinline__ void phase_indexer(const Params& p, unsigned char* lds, int vb, int vG) {
    const int G = vG;
    for (int rd = 0;; ++rd) {
        const int base = rd * G; if (base >= 1024) break;
        const int pos = (rd & 1) ? (G - 1 - vb) : vb; const int i = base + pos; if (i >= 1024) continue;
        indexer_item(p, lds, (i >> 2) & 7, 31 - (i >> 5), i & 3);
    }
}

#ifndef HG_REP_A
#define HG_REP_A 0
#endif
#ifndef HG_REP_B
#define HG_REP_B 0
#endif
constexpr int HG_RS = 136, HG_TS = 72, HG_SS = 136;
constexpr int HG_QT = 0, HG_QH = 17408, HG_KT = 34816, HG_KHT = 52224, HG_VT = 70656, HG_ST = 89088, HG_DEC = 123904, HG_SSQ = 124416, HG_OT = 125440;
__device__ __forceinline__ void hgrn_item(const Params& p, unsigned char* lds, int item) {
    const int tid = threadIdx.x, w = __builtin_amdgcn_readfirstlane(tid >> 6), lane = tid & 63, r = lane & 31, hh = lane >> 5;
    const int b = item >> 3, h = item & 7;
    const bf16_t* P = (const bf16_t*)(p.ws + WS_P); bf16_t* REC = (bf16_t*)(p.ws + WS_REC);
    bf16_t* QT = (bf16_t*)(lds + HG_QT); bf16_t* QH = (bf16_t*)(lds + HG_QH); bf16_t* KT = (bf16_t*)(lds + HG_KT); bf16_t* KHT = (bf16_t*)(lds + HG_KHT); bf16_t* VT = (bf16_t*)(lds + HG_VT);
    bf16_t* ST = (bf16_t*)(lds + HG_ST); float* DEC = (float*)(lds + HG_DEC); float* SSQ = (float*)(lds + HG_SSQ); bf16_t* OT = (bf16_t*)(lds + HG_OT);
    const int seg = lane >> 4, dl = lane & 15, d = 16 * w + dl;
    const float lb = sigmoidf_(p.in[7][h * 128 + d] - p.in[7][1024 + h * 128 + d]);
    const int tb = w & 1, eb = w >> 1, sdb = w & 3, seb0 = 2 * (w >> 2);
    const int ot_t = tid >> 3, ot_c = tid & 7;
    float gn[16];
#pragma unroll
    for (int j = 0; j < 4; ++j) { const f32x4 g4 = *(const f32x4*)(p.in[8] + 16 * ot_c + 4 * j); gn[4 * j] = g4[0]; gn[4 * j + 1] = g4[1]; gn[4 * j + 2] = g4[2]; gn[4 * j + 3] = g4[3]; }
    f32x16 S0, S1;
#pragma unroll
    for (int i = 0; i < 16; ++i) { S0[i] = 0.f; S1[i] = 0.f; }
    __syncthreads();
    for (int i = tid; i < 128 * HG_SS / 2; i += NTHREADS) ((unsigned*)ST)[i] = 0u;
    unsigned short rq[16], rf[16], ri[16];
    { const bf16_t* src = P + (size_t)(b * SEQ + 16 * seg) * NP + h * 128 + d;
#pragma unroll
      for (int i = 0; i < 16; ++i) { rq[i] = src[(size_t)i * NP + C_QB]; rf[i] = src[(size_t)i * NP + C_FB]; ri[i] = src[(size_t)i * NP + C_IB]; } }
#pragma unroll 1
    for (int n = 0; n < 32; ++n) {
#pragma unroll 1
        for (int repa = 0; repa <= HG_REP_A; ++repa) {
            float lf[16], kk[16];
            float run = 0.f;
#pragma unroll
            for (int i = 0; i < 16; ++i) { const float f = lb + (1.f - lb) * sigmoidf_(bf2f(rf[i])); kk[i] = 1.f - f; run += __logf(f); lf[i] = run; }
            const float p0 = __shfl(run, dl), p1 = __shfl(run, 16 + dl), p2 = __shfl(run, 32 + dl), p3 = __shfl(run, 48 + dl);
            const float off = (seg > 0 ? p0 : 0.f) + (seg > 1 ? p1 : 0.f) + (seg > 2 ? p2 : 0.f), bL = (p0 + p1) + (p2 + p3), bref = p0 + p1;
            const float eref = __expf(fmaxf(bref, -80.f)), elref = __expf(fmaxf(bL - bref, -80.f));
            unsigned kh[8], vv[8];
#pragma unroll
            for (int i = 0; i < 16; ++i) { const float bt = off + lf[i]; const float qs = siluf_(bf2f(rq[i]));
                const float e1 = __expf(__builtin_amdgcn_fmed3f(bt - bref, -80.f, 80.f)), e2 = e1 * eref, e3 = __builtin_amdgcn_rcpf(e1), e4 = e3 * elref;
                const int t = 16 * seg + i;
                QT[t * HG_RS + d] = (bf16_t)f2bf(qs * e1); QH[t * HG_RS + d] = (bf16_t)f2bf(qs * e2); KT[t * HG_RS + d] = (bf16_t)f2bf(kk[i] * e3);
                const unsigned khv = f2bf(kk[i] * e4);
                if (i & 1) { kh[i >> 1] |= khv << 16; vv[i >> 1] |= (unsigned)ri[i] << 16; } else { kh[i >> 1] = khv; vv[i >> 1] = (unsigned)ri[i]; } }
            *(u32x4*)(KHT + d * HG_TS + 16 * seg) = (u32x4){kh[0], kh[1], kh[2], kh[3]}; *(u32x4*)(KHT + d * HG_TS + 16 * seg + 8) = (u32x4){kh[4], kh[5], kh[6], kh[7]};
            *(u32x4*)(VT + d * HG_TS + 16 * seg) = (u32x4){vv[0], vv[1], vv[2], vv[3]}; *(u32x4*)(VT + d * HG_TS + 16 * seg + 8) = (u32x4){vv[4], vv[5], vv[6], vv[7]};
            if (seg == 0) DEC[d] = eref * elref;
        }
        __syncthreads();
        if (n < 31) { const bf16_t* src = P + (size_t)(b * SEQ + (n + 1) * 64 + 16 * seg) * NP + h * 128 + d;
#pragma unroll
            for (int i = 0; i < 16; ++i) { rq[i] = src[(size_t)i * NP + C_QB]; rf[i] = src[(size_t)i * NP + C_FB]; ri[i] = src[(size_t)i * NP + C_IB]; } }
        const u32x4 gb0 = *(const u32x4*)(P + (size_t)(b * SEQ + n * 64 + ot_t) * NP + C_GB + h * 128 + 16 * ot_c), gb1 = *(const u32x4*)(P + (size_t)(b * SEQ + n * 64 + ot_t) * NP + C_GB + h * 128 + 16 * ot_c + 8);
        f32x16 X0, X1, o;
#pragma unroll 1
        for (int repb = 0; repb <= HG_REP_B; ++repb) {
#pragma unroll
        for (int i = 0; i < 16; ++i) { X0[i] = 0.f; X1[i] = 0.f; o[i] = 0.f; }
#pragma unroll
        for (int ks = 0; ks < 8; ++ks) { const bf16x8 bq = *(const bf16x8*)(QT + (32 * tb + r) * HG_RS + 16 * ks + 8 * hh);
            const bf16x8 a0 = *(const bf16x8*)(KT + r * HG_RS + 16 * ks + 8 * hh); X0 = __builtin_amdgcn_mfma_f32_32x32x16_bf16(a0, bq, X0, 0, 0, 0);
            if (tb == 1) { const bf16x8 a1 = *(const bf16x8*)(KT + (32 + r) * HG_RS + 16 * ks + 8 * hh); X1 = __builtin_amdgcn_mfma_f32_32x32x16_bf16(a1, bq, X1, 0, 0, 0); } }
#pragma unroll
        for (int i = 0; i < 16; ++i) { const bool keep = ((i & 3) + 8 * (i >> 2) + 4 * hh) <= r; if (tb == 0) X0[i] = keep ? X0[i] : 0.f; else X1[i] = keep ? X1[i] : 0.f; }
#pragma unroll
        for (int sb = 0; sb < 2; ++sb) { if (sb <= tb) {
#pragma unroll
            for (int s2 = 0; s2 < 2; ++s2) { u32x4 aw;
                if (sb == 0) { aw.x = pk2(X0[8 * s2], X0[8 * s2 + 1]); aw.y = pk2(X0[8 * s2 + 2], X0[8 * s2 + 3]); aw.z = pk2(X0[8 * s2 + 4], X0[8 * s2 + 5]); aw.w = pk2(X0[8 * s2 + 6], X0[8 * s2 + 7]); }
                else { aw.x = pk2(X1[8 * s2], X1[8 * s2 + 1]); aw.y = pk2(X1[8 * s2 + 2], X1[8 * s2 + 3]); aw.z = pk2(X1[8 * s2 + 4], X1[8 * s2 + 5]); aw.w = pk2(X1[8 * s2 + 6], X1[8 * s2 + 7]); }
                const bf16_t* vp = VT + (32 * eb + r) * HG_TS + 32 * sb + 16 * s2 + 4 * hh;
                const u32x2 lo = *(const u32x2*)vp, hi = *(const u32x2*)(vp + 8); const u32x4 bw = {lo.x, lo.y, hi.x, hi.y};
                o = __builtin_amdgcn_mfma_f32_32x32x16_bf16(__builtin_bit_cast(bf16x8, aw), __builtin_bit_cast(bf16x8, bw), o, 0, 0, 0); } } }
#pragma unroll
        for (int ks = 0; ks < 8; ++ks) { const bf16x8 aq = *(const bf16x8*)(QH + (32 * tb + r) * HG_RS + 16 * ks + 8 * hh), bs = *(const bf16x8*)(ST + (32 * eb + r) * HG_SS + 16 * ks + 8 * hh);
            o = __builtin_amdgcn_mfma_f32_32x32x16_bf16(aq, bs, o, 0, 0, 0); }
        { float a8[8], a4[4], a2[2], a1;
#pragma unroll
          for (int i = 0; i < 8; ++i) { const float lo = o[i] * o[i], hi = o[i + 8] * o[i + 8]; const bool up = lane & 16; const float keep = up ? hi : lo, send = up ? lo : hi; a8[i] = keep + __shfl_xor(send, 16); }
#pragma unroll
          for (int i = 0; i < 4; ++i) { const bool up = lane & 8; const float keep = up ? a8[i + 4] : a8[i], send = up ? a8[i] : a8[i + 4]; a4[i] = keep + __shfl_xor(send, 8); }
#pragma unroll
          for (int i = 0; i < 2; ++i) { const bool up = lane & 4; const float keep = up ? a4[i + 2] : a4[i], send = up ? a4[i] : a4[i + 2]; a2[i] = keep + __shfl_xor(send, 4); }
          { const bool up = lane & 2; const float keep = up ? a2[1] : a2[0], send = up ? a2[0] : a2[1]; a1 = keep + __shfl_xor(send, 2); }
          a1 += __shfl_xor(a1, 1);
          const int ri2 = (lane >> 1) & 15;
          if ((lane & 1) == 0) SSQ[(32 * tb + (ri2 & 3) + 8 * (ri2 >> 2) + 4 * hh) * 4 + eb] = a1; }
#pragma unroll
        for (int i = 0; i < 16; ++i) OT[(32 * tb + (i & 3) + 8 * (i >> 2) + 4 * hh) * HG_RS + 32 * eb + r] = (bf16_t)f2bf(o[i]);
        }
        { float dc[16];
#pragma unroll
          for (int g4 = 0; g4 < 4; ++g4) { const f32x4 dv = *(const f32x4*)(DEC + 32 * sdb + 8 * g4 + 4 * hh); dc[4 * g4] = dv[0]; dc[4 * g4 + 1] = dv[1]; dc[4 * g4 + 2] = dv[2]; dc[4 * g4 + 3] = dv[3]; }
#pragma unroll
          for (int i = 0; i < 16; ++i) { S0[i] *= dc[i]; S1[i] *= dc[i]; }
#pragma unroll
          for (int ss = 0; ss < 4; ++ss) { const bf16x8 a = *(const bf16x8*)(KHT + (32 * sdb + r) * HG_TS + 16 * ss + 8 * hh);
              const bf16x8 b0 = *(const bf16x8*)(VT + (32 * seb0 + r) * HG_TS + 16 * ss + 8 * hh), b1 = *(const bf16x8*)(VT + (32 * (seb0 + 1) + r) * HG_TS + 16 * ss + 8 * hh);
              S0 = __builtin_amdgcn_mfma_f32_32x32x16_bf16(a, b0, S0, 0, 0, 0); S1 = __builtin_amdgcn_mfma_f32_32x32x16_bf16(a, b1, S1, 0, 0, 0); } }
        __syncthreads();
#pragma unroll
        for (int g4 = 0; g4 < 4; ++g4) { const int d0 = 32 * sdb + 8 * g4 + 4 * hh;
            *(u32x2*)(ST + (32 * seb0 + r) * HG_SS + d0) = (u32x2){pk2(S0[4 * g4], S0[4 * g4 + 1]), pk2(S0[4 * g4 + 2], S0[4 * g4 + 3])};
            *(u32x2*)(ST + (32 * (seb0 + 1) + r) * HG_SS + d0) = (u32x2){pk2(S1[4 * g4], S1[4 * g4 + 1]), pk2(S1[4 * g4 + 2], S1[4 * g4 + 3])}; }
        { const f32x4 q4 = *(const f32x4*)(SSQ + ot_t * 4); const float rstd = rsqrtf(((q4[0] + q4[1]) + (q4[2] + q4[3])) * (1.f / 128.f) + NORM_EPS);
          const u32x4 o0 = *(const u32x4*)(OT + ot_t * HG_RS + 16 * ot_c), o1 = *(const u32x4*)(OT + ot_t * HG_RS + 16 * ot_c + 8);
          const unsigned ow[8] = {o0.x, o0.y, o0.z, o0.w, o1.x, o1.y, o1.z, o1.w}, gwv[8] = {gb0.x, gb0.y, gb0.z, gb0.w, gb1.x, gb1.y, gb1.z, gb1.w};
          unsigned rw[8];
#pragma unroll
          for (int j = 0; j < 8; ++j) rw[j] = pk2(bflo(ow[j]) * rstd * gn[2 * j] * siluf_(bflo(gwv[j])), bfhi(ow[j]) * rstd * gn[2 * j + 1] * siluf_(bfhi(gwv[j])));
          bf16_t* dst = REC + (size_t)(b * SEQ + n * 64 + ot_t) * 1024 + h * 128 + 16 * ot_c;
          *(u32x4*)dst = (u32x4){rw[0], rw[1], rw[2], rw[3]}; *(u32x4*)(dst + 8) = (u32x4){rw[4], rw[5], rw[6], rw[7]}; }
    }
}
__device__ __forceinline__ void phase_hgrn(const Params& p, unsigned char* lds, int vb, int vG) {
    for (int it = vb; it < 64; it += vG) hgrn_item(p, lds, it);
}

constexpr int AT_KRS = 136, AT_VRS = 36, AT_KB = 32 * AT_KRS * 2, AT_VB = 128 * AT_VRS * 2, AT_STAGE = AT_KB + AT_VB;
__device__ __forceinline__ void attn_item(const Params& p, unsigned char* lds, int b, int head, int cq) {
    const int tid = threadIdx.x, w = __builtin_amdgcn_readfirstlane(tid >> 6), lane = tid & 63, r = lane & 31, hh = lane >> 5;
    const bf16_t* P = (const bf16_t*)(p.ws + WS_P); const bf16_t* VT = (const bf16_t*)(p.ws + WS_VT); const unsigned* MASKT = (const unsigned*)(p.ws + WS_MASK);
    bf16_t* AO = (bf16_t*)(p.ws + WS_AO);
    const int c = 4 * cq + (w >> 1), qpos = c * 64 + (w & 1) * 32 + r, tq = b * SEQ + qpos;
    const int nkt_w = 2 * (c + 1), nkt = 8 * (cq + 1);
    const bf16_t* kg = P + (size_t)(b * SEQ + (tid >> 4)) * NP + C_KA + head * 128 + (tid & 15) * 8;
    const bf16_t* vg = VT + (size_t)((b * 8 + head) * 128 + (tid >> 2)) * SEQ + (tid & 3) * 8;
    const int kls = (tid >> 4) * AT_KRS * 2 + (tid & 15) * 16, vls = AT_KB + (tid >> 2) * AT_VRS * 2 + (tid & 3) * 16;
    bf16x8 qf[8];
    { const bf16_t* qp = P + (size_t)tq * NP + C_QA + head * 128 + 8 * hh;
#pragma unroll
      for (int ks = 0; ks < 8; ++ks) qf[ks] = *(const bf16x8*)(qp + ks * 16); }
    f32x16 o[4];
#pragma unroll
    for (int db = 0; db < 4; ++db)
#pragma unroll
        for (int i = 0; i < 16; ++i) o[db][i] = 0.f;
    float mrun = -1e30f, lsum = 0.f;
    const float sc = 0.08838834764831845f * 1.4426950408889634f;
    __syncthreads();
    u32x4 krA, vrA, krB, vrB;
#pragma unroll
    for (int t0 = 0; t0 < 2; ++t0) { krA = *(const u32x4*)(kg + (size_t)(t0 * 32) * NP); vrA = *(const u32x4*)(vg + t0 * 32);
        *(u32x4*)(lds + t0 * AT_STAGE + kls) = krA; *(u32x2*)(lds + t0 * AT_STAGE + vls) = (u32x2){vrA.x, vrA.y}; *(u32x2*)(lds + t0 * AT_STAGE + vls + 8) = (u32x2){vrA.z, vrA.w}; }
    krA = *(const u32x4*)(kg + (size_t)(2 * 32) * NP); vrA = *(const u32x4*)(vg + 2 * 32);
    krB = *(const u32x4*)(kg + (size_t)(3 * 32) * NP); vrB = *(const u32x4*)(vg + 3 * 32);
    unsigned mwA = MASKT[(size_t)(b * 64) * SEQ + qpos], mwB = MASKT[(size_t)(b * 64 + 1) * SEQ + qpos];
    __syncthreads();
    int st = 0, st2 = 2;
#define AT_TILE(KT, KR, VR, MW) do { const int kt_ = (KT); \
        if (kt_ + 2 < nkt) { *(u32x4*)(lds + st2 * AT_STAGE + kls) = KR; *(u32x2*)(lds + st2 * AT_STAGE + vls) = (u32x2){VR.x, VR.y}; *(u32x2*)(lds + st2 * AT_STAGE + vls + 8) = (u32x2){VR.z, VR.w}; } \
        if (kt_ + 4 < nkt) { KR = *(const u32x4*)(kg + (size_t)((kt_ + 4) * 32) * NP); VR = *(const u32x4*)(vg + (kt_ + 4) * 32); } \
        if (kt_ < nkt_w) { \
            const unsigned mwc = MW; \
            if (kt_ + 2 < nkt_w) MW = MASKT[(size_t)(b * 64 + kt_ + 2) * SEQ + qpos]; \
            const bf16_t* Ks = (const bf16_t*)(lds + st * AT_STAGE); const bf16_t* Vs = (const bf16_t*)(lds + st * AT_STAGE + AT_KB); \
            f32x16 s; \
            _Pragma("unroll") for (int i = 0; i < 16; ++i) s[i] = 0.f; \
            { bf16x8 kf[8];        \
              _Pragma("unroll") for (int ks = 0; ks < 8; ++ks) kf[ks] = *(const bf16x8*)(Ks + r * AT_KRS + ks * 16 + 8 * hh); \
              __builtin_amdgcn_sched_barrier(0); \
              _Pragma("unroll") for (int ks = 0; ks < 8; ++ks) s = __builtin_amdgcn_mfma_f32_32x32x16_bf16(kf[ks], qf[ks], s, 0, 0, 0); } \
            float mx = -3e38f; const unsigned mws = mwc >> (4 * hh);        \
            _Pragma("unroll") for (int i = 0; i < 16; ++i) { const bool ok = (mws >> ((i & 3) + 8 * (i >> 2))) & 1u; s[i] = ok ? s[i] : -3e38f; mx = fmaxf(mx, s[i]); } \
            mx = fmaxf(mx, __shfl_xor(mx, 32)); \
            const float mnew = fmaxf(mrun, mx * sc), alpha = exp2f(mrun - mnew); \
            const bool grew = mnew > mrun; mrun = mnew; \
            float ps = 0.f; float pv[16]; \
            _Pragma("unroll") for (int i = 0; i < 16; ++i) { const float e = exp2f(fmaf(s[i], sc, -mnew)); pv[i] = e; ps += e; }        \
            lsum = lsum * alpha + ps; \
            if (__builtin_amdgcn_ballot_w64(grew) != 0ull) { _Pragma("unroll") for (int db = 0; db < 4; ++db) _Pragma("unroll") for (int i = 0; i < 16; ++i) o[db][i] *= alpha; } \
            bf16x8 pf[2]; \
            _Pragma("unroll") for (int s2 = 0; s2 < 2; ++s2) { u32x4 wv; wv.x = pk2(pv[8 * s2 + 0], pv[8 * s2 + 1]); wv.y = pk2(pv[8 * s2 + 2], pv[8 * s2 + 3]); wv.z = pk2(pv[8 * s2 + 4], pv[8 * s2 + 5]); wv.w = pk2(pv[8 * s2 + 6], pv[8 * s2 + 7]); pf[s2] = __builtin_bit_cast(bf16x8, wv); } \
            { u32x4 vf[4][2]; \
              _Pragma("unroll") for (int db = 0; db < 4; ++db) _Pragma("unroll") for (int s2 = 0; s2 < 2; ++s2) { const bf16_t* vp = Vs + (db * 32 + r) * AT_VRS + 16 * s2 + 4 * hh; const u32x2 lo = *(const u32x2*)vp, hi = *(const u32x2*)(vp + 8); \
                    vf[db][s2] = (u32x4){lo.x, lo.y, hi.x, hi.y}; } \
              __builtin_amdgcn_sched_barrier(0); \
              _Pragma("unroll") for (int db = 0; db < 4; ++db) _Pragma("unroll") for (int s2 = 0; s2 < 2; ++s2) o[db] = __builtin_amdgcn_mfma_f32_32x32x16_bf16(__builtin_bit_cast(bf16x8, vf[db][s2]), pf[s2], o[db], 0, 0, 0); } \
        } \
        __syncthreads(); \
        st = (st == 2) ? 0 : st + 1; st2 = (st2 == 2) ? 0 : st2 + 1; } while (0)
#pragma unroll 1
    for (int kt = 0; kt < nkt; kt += 2) { AT_TILE(kt, krA, vrA, mwA); AT_TILE(kt + 1, krB, vrB, mwB); }
#undef AT_TILE
    const float l = lsum + __shfl_xor(lsum, 32), inv = 1.f / l;
    bf16_t* op = AO + (size_t)tq * 1024 + head * 128 + 4 * hh;
#pragma unroll
    for (int db = 0; db < 4; ++db)
#pragma unroll
        for (int g4 = 0; g4 < 4; ++g4) { u32x2 wv; wv.x = pk2(o[db][4 * g4] * inv, o[db][4 * g4 + 1] * inv); wv.y = pk2(o[db][4 * g4 + 2] * inv, o[db][4 * g4 + 3] * inv);
            *(u32x2*)(op + db * 32 + 8 * g4) = wv; }
}
__device__ __forceinline__ void phase_attn(const Params& p, unsigned char* lds, int vb, int vG) {
    const int G = vG;
    for (int rd = 0;; ++rd) {
        const int base = rd * G; if (base >= 512) break;
        const int pos = (rd & 1) ? (G - 1 - vb) : vb; const int i = base + pos; if (i >= 512) continue;
        attn_item(p, lds, (i >> 3) & 7, i & 7, 7 - (i >> 6));
    }
}
__device__ __forceinline__ void phase_attn_queue(const Params& p, unsigned char* lds, unsigned* qhead) {
    volatile LAS int* slot = (volatile LAS int*)((LAS unsigned char*)lds + LDS_BYTES - 32);
    for (;;) {
        __syncthreads();
        if (threadIdx.x == 0) slot[0] = (int)__hip_atomic_fetch_add(qhead, 1u, __ATOMIC_RELAXED, __HIP_MEMORY_SCOPE_AGENT);
        __syncthreads();
        const int i = slot[0]; if (i >= 512) break;
        attn_item(p, lds, (i >> 3) & 7, i & 7, 7 - (i >> 6));
    }
}
__device__ __forceinline__ int queue_pop(unsigned* head, unsigned char* lds) {
    volatile LAS int* slot = (volatile LAS int*)((LAS unsigned char*)lds + LDS_BYTES - 32);
    __syncthreads();
    if (threadIdx.x == 0) slot[0] = (int)__hip_atomic_fetch_add(head, 1u, __ATOMIC_RELAXED, __HIP_MEMORY_SCOPE_AGENT);
    __syncthreads();
    return slot[0];
}
__device__ __forceinline__ void phase_uv(const Params& p) {
    const int tid = threadIdx.x, wave = tid >> 6, lane = tid & 63;
    const int gw = blockIdx.x * NWAVES + wave, NGW = gridDim.x * NWAVES;
    for (int it = gw; it < 2 * 16384; it += NGW) {
        const int tbl = it >> 14, row = it & 16383;
        const float* src = (tbl ? p.in[15] : p.in[14]) + (size_t)row * 2048 + 32 * lane;
        unsigned char* dst = p.ws + (tbl ? WS_V8 : WS_U8); float* isc = (float*)(p.ws + (tbl ? WS_ISV : WS_ISU));
        f32x4 v[8]; float am = 0.f;
#pragma unroll
        for (int j = 0; j < 8; ++j) { v[j] = *(const f32x4*)(src + 4 * j); am = fmaxf(am, fmaxf(fmaxf(fabsf(v[j][0]), fabsf(v[j][1])), fmaxf(fabsf(v[j][2]), fabsf(v[j][3])))); }
#pragma unroll
        for (int o = 1; o < 64; o <<= 1) am = fmaxf(am, __shfl_xor(am, o));
        am = fmaxf(am, 1e-30f); const float sc = 256.f / am;
        unsigned wq[8];
#pragma unroll
        for (int j = 0; j < 8; ++j) { int pk = 0; pk = __builtin_amdgcn_cvt_pk_fp8_f32(v[j][0] * sc, v[j][1] * sc, pk, false); pk = __builtin_amdgcn_cvt_pk_fp8_f32(v[j][2] * sc, v[j][3] * sc, pk, true); wq[j] = (unsigned)pk; }
        unsigned char* d = dst + (size_t)(lane >> 2) * (2u << 20) + (size_t)row * 128 + (lane & 3) * 32;
        *(u32x4*)d = (u32x4){wq[0], wq[1], wq[2], wq[3]}; *(u32x4*)(d + 16) = (u32x4){wq[4], wq[5], wq[6], wq[7]};
        if (lane == 0) isc[row] = am * (1.f / 256.f);
    }
}

#define INS16(v, x) do { _Pragma("unroll") for (int _j = 15; _j >= 1; --_j) v[_j] = __builtin_amdgcn_fmed3f(v[_j - 1], v[_j], (x)); v[0] = fmaxf(v[0], (x)); } while (0)
__device__ __forceinline__ void peer_half_top16(const bf16_t* QP, const bf16_t* kb0  , int pitch, int tok, int p, int hf, int r, int hh, float (&v)[16]) {
    bf16x8 qf[8];
    { const bf16_t* qp = QP + (size_t)tok * D + p * 256 + hf * 128 + 8 * hh;
#pragma unroll
      for (int ks = 0; ks < 8; ++ks) qf[ks] = *(const bf16x8*)(qp + ks * 16); }
#pragma unroll
    for (int k = 0; k < 16; ++k) v[k] = -3.0e38f;
    const bf16_t* kb = kb0 + r * pitch + 8 * hh;
#pragma unroll 1
    for (int nb = 0; nb < 4; ++nb) {
        f32x16 acc;
#pragma unroll
        for (int i = 0; i < 16; ++i) acc[i] = 0.f;
#pragma unroll
        for (int ks = 0; ks < 8; ++ks) { const bf16x8 kf = *(const bf16x8*)(kb + (nb * 32) * pitch + ks * 16); acc = __builtin_amdgcn_mfma_f32_32x32x16_bf16(kf, qf[ks], acc, 0, 0, 0); }
#pragma unroll
        for (int i = 0; i < 16; ++i) { const unsigned xi = (unsigned)(nb * 32 + (i & 3) + 8 * (i >> 2) + 4 * hh); const float x = __uint_as_float((__float_as_uint(acc[i]) & ~0x7fu) | xi); INS16(v, x); }
    }
    float ov[16];
#pragma unroll
    for (int k = 0; k < 16; ++k) ov[k] = __shfl_xor(v[k], 32);
#pragma unroll
    for (int k = 0; k < 16; ++k) INS16(v, ov[k]);
}
constexpr int PK_RS = 136;
#define GAS __attribute__((address_space(1)))
__device__ __attribute__((noinline)) void phase_peer_topk_ni(const GAS bf16_t* QPg, const GAS bf16_t* KEYSg, GAS int* EIDXg, GAS float* EGATEg, LAS unsigned char* ldsl) {
    const bf16_t* QP = (const bf16_t*)QPg; const bf16_t* KEYS = (const bf16_t*)KEYSg; int* EIDX = (int*)EIDXg; float* EGATE = (float*)EGATEg; unsigned char* lds = (unsigned char*)ldsl;
    const int tid = threadIdx.x, wave = __builtin_amdgcn_readfirstlane(tid >> 6), lane = tid & 63, r = lane & 31, hh = lane >> 5;
    bf16_t* KL = (bf16_t*)lds;
    const int G = gridDim.x, hd = blockIdx.x & 7;
    __syncthreads();
    for (int i = tid; i < 2 * 128 * 16; i += NTHREADS) { const int row = i >> 4, ch = i & 15;
        *(u32x4*)(KL + row * PK_RS + ch * 8) = *(const u32x4*)(KEYS + (size_t)(hd * 256 + row) * 128 + ch * 8); }
    __syncthreads();
    for (int tile = blockIdx.x >> 3; tile < 64; tile += (G + 7) / 8) {
        const int tok = tile * 256 + wave * 32 + r;
        float va[16], vb[16];
        peer_half_top16(QP, KL, PK_RS, tok, hd, 0, r, hh, va);
        peer_half_top16(QP, KL + 128 * PK_RS, PK_RS, tok, hd, 1, r, hh, vb);
        float bv[16];
#pragma unroll
        for (int k = 0; k < 16; ++k) bv[k] = -3.0e38f;
#pragma unroll
        for (int a = 0; a < 16; ++a)
#pragma unroll
            for (int b2 = 0; b2 < 16; ++b2) if ((a + 1) * (b2 + 1) <= 16) { const float x = va[a] + vb[b2]; INS16(bv, x); }
        float se = 0.f;
#pragma unroll
        for (int k = 0; k < 16; ++k) se += __expf(bv[k] - bv[0]);
        const float inv = 1.f / se, thr = bv[15], top = bv[0];
        int cnt = 0; int* ei = EIDX + (size_t)tok * 128 + hd * 16; float* eg = EGATE + (size_t)tok * 128 + hd * 16;
#pragma unroll
        for (int a = 0; a < 16; ++a)
#pragma unroll
            for (int b2 = 0; b2 < 16; ++b2) if ((a + 1) * (b2 + 1) <= 16) { const float x = va[a] + vb[b2];
                if (x >= thr && cnt < 16) { if (hh == 0) { ei[cnt] = (int)((__float_as_uint(va[a]) & 0x7fu) * 128u + (__float_as_uint(vb[b2]) & 0x7fu)); eg[cnt] = __expf(x - top) * inv; } ++cnt; } }
    }
}

typedef __bf16 bf16x2_t __attribute__((ext_vector_type(2)));
__device__ __forceinline__ float gelu_erf(float v) {
    const float av = fabsf(v), d = av * 0.2316418882f + 1.0f, t = __builtin_amdgcn_rcpf(d);
    float q = t * 0.5307027145f + (-0.7265760135f); q = q * t + 0.7107068705f; q = q * t + (-0.142248368f); q = q * t + 0.127414796f; q = q * t;
    const float e = __builtin_amdgcn_exp2f((v * v) * (-0.72134752044f));
    const float m = v * (q * e), r = v - m;
    return v < 0.f ? m : r;
}
__device__ __forceinline__ float dot2bf(unsigned a, unsigned b, float c) { return __builtin_amdgcn_fdot2_f32_bf16(__builtin_bit_cast(bf16x2_t, a), __builtin_bit_cast(bf16x2_t, b), c, false); }
__device__ __forceinline__ float dpp_f(float x, int ctrl_xor1_xor2_mirror) {
    const int v = __float_as_int(x);
    if (ctrl_xor1_xor2_mirror == 0) return __int_as_float(__builtin_amdgcn_update_dpp(0, v, 0xB1, 0xF, 0xF, true));
    if (ctrl_xor1_xor2_mirror == 1) return __int_as_float(__builtin_amdgcn_update_dpp(0, v, 0x4E, 0xF, 0xF, true));
    return __int_as_float(__builtin_amdgcn_update_dpp(0, v, 0x141, 0xF, 0xF, true));
}
typedef float f32x2v __attribute__((ext_vector_type(2)));
__device__ __forceinline__ void unpack8(const u32x4 w, float* f) { f[0] = bflo(w.x); f[1] = bfhi(w.x); f[2] = bflo(w.y); f[3] = bfhi(w.y); f[4] = bflo(w.z); f[5] = bfhi(w.z); f[6] = bflo(w.w); f[7] = bfhi(w.w); }
__device__ __forceinline__ void cvt16(const u32x4 w, float* f) {
#pragma unroll
    for (int q = 0; q < 4; ++q) { const f32x2v lo = __builtin_amdgcn_cvt_pk_f32_fp8((int)w[q], false), hi = __builtin_amdgcn_cvt_pk_f32_fp8((int)w[q], true);
        f[4 * q] = lo.x; f[4 * q + 1] = lo.y; f[4 * q + 2] = hi.x; f[4 * q + 3] = hi.y; }
}
__device__ __forceinline__ void phase_experts(const Params& p, unsigned char* lds) {
    const int tid = threadIdx.x, wave = __builtin_amdgcn_readfirstlane(tid >> 6), lane = tid & 63, rr = lane >> 3, cc = lane & 7; const bool odd = cc & 1;
    const bf16_t* H2 = (const bf16_t*)(p.ws + WS_H2); const unsigned char* U8 = p.ws + WS_U8; const unsigned char* V8 = p.ws + WS_V8;
    const float* ISU = (const float*)(p.ws + WS_ISU); const float* ISV = (const float*)(p.ws + WS_ISV);
    const int* EIDX = (const int*)(p.ws + WS_EIDX); const float* EGATE = (const float*)(p.ws + WS_EGATE);
    const float* mod = (const float*)(p.ws + WS_MOD); const float* fin = p.in[16]; float* out = p.out; const float* X1 = (const float*)(p.ws + WS_X1);
    unsigned* offs = (unsigned*)lds; float* gts = (float*)(lds + 32768); float* rstl = (float*)(lds + 65536);
    const unsigned xcc = (unsigned)__builtin_amdgcn_s_getreg((3 << 11) | 20) & 7u; const unsigned cc16 = cc * 16;
    for (int tile = blockIdx.x; tile < T / 64; tile += gridDim.x) {
        const int tok0 = tile * 64, b = tok0 >> 11;
        __syncthreads();
        for (int i = tid; i < 8192; i += NTHREADS) { const int tl = i >> 7, j = i & 127, g = j >> 3, r8 = j & 7;
            offs[(tl * 8 + r8) * 16 + g] = (unsigned)EIDX[(size_t)tok0 * 128 + i] * 128u; gts[(tl * 8 + r8) * 16 + g] = EGATE[(size_t)tok0 * 128 + i]; }
        __syncthreads();
#pragma unroll 1
        for (int half = 0; half < 2; ++half) {
            const int tlb = wave * 8 + half * 4;
            u32x4 dA[16], dB[16], hA0, hA1, hB0, hB1;
#ifndef EXP_REP_U
#define EXP_REP_U 0
#endif
#ifndef EXP_REP_V
#define EXP_REP_V 0
#endif
#define EX_SLICE(i_) ((xcc * 2u + (unsigned)(i_)) & 15u)
#define EX_LOAD(buf, TBL, i_, k_) do { const unsigned char* tb_ = (TBL) + (size_t)EX_SLICE(i_) * (2u << 20); u32x4 o4_[4]; \
    _Pragma("unroll") for (int q_ = 0; q_ < 4; ++q_) o4_[q_] = *(const u32x4*)(offs + ((tlb + (k_)) * 8 + rr) * 16 + 4 * q_); \
    _Pragma("unroll") for (int g_ = 0; g_ < 16; ++g_) buf[g_] = *(const u32x4*)(tb_ + (o4_[g_ >> 2][g_ & 3] + cc16)); } while (0)
#define EX_LOADH(h0, h1, i_, k_) do { const bf16_t* hp_ = H2 + (size_t)(tok0 + tlb + (k_)) * D + EX_SLICE(i_) * 128 + cc * 16; h0 = *(const u32x4*)hp_; h1 = *(const u32x4*)(hp_ + 8); } while (0)
#define EX_DOT16(acc, WSRC, hf) do { u32x4 w_ = WSRC; asm volatile("" : "+v"(w_.x), "+v"(w_.y), "+v"(w_.z), "+v"(w_.w), "+v"(ch_)); float f_[16]; cvt16(w_, f_); _Pragma("unroll") for (int e_ = 0; e_ < 16; ++e_) acc = fmaf(f_[e_], hf[e_], acc); ch_ = acc; } while (0)
#define EX_UCOMP(buf, h0, h1, k_) do { float hf_[16]; unpack8(h0, hf_); unpack8(h1, hf_ + 8); float ch_ = 0.f; \
    _Pragma("unroll") for (int j_ = 0; j_ < 8; ++j_) { float te_ = 0.f, to_ = 0.f; EX_DOT16(te_, buf[2 * j_], hf_); __builtin_amdgcn_sched_barrier(0); EX_DOT16(to_, buf[2 * j_ + 1], hf_); \
    const float my_ = odd ? to_ : te_, ot_ = odd ? te_ : to_; zp[k_][j_] += my_ + dpp_f(ot_, 0); asm volatile("" : "+v"(zp[k_][j_])); __builtin_amdgcn_sched_barrier(0); } } while (0)
#define SB() __builtin_amdgcn_sched_barrier(0)
            float zp[4][8];
#pragma unroll
            for (int k = 0; k < 4; ++k)
#pragma unroll
                for (int j = 0; j < 8; ++j) zp[k][j] = 0.f;
            EX_LOADH(hA0, hA1, 0, 0); EX_LOAD(dA, U8, 0, 0); SB();
#pragma unroll 1
            for (int i = 0; i < 16 * (1 + EXP_REP_U); ++i) {
                __builtin_amdgcn_s_barrier();
                EX_LOADH(hB0, hB1, i, 1); EX_LOAD(dB, U8, i, 1); SB(); EX_UCOMP(dA, hA0, hA1, 0); SB();
                EX_LOADH(hA0, hA1, i, 2); EX_LOAD(dA, U8, i, 2); SB(); EX_UCOMP(dB, hB0, hB1, 1); SB();
                EX_LOADH(hB0, hB1, i, 3); EX_LOAD(dB, U8, i, 3); SB(); EX_UCOMP(dA, hA0, hA1, 2); SB();
                if (i < 16 * (1 + EXP_REP_U) - 1) { EX_LOADH(hA0, hA1, i + 1, 0); EX_LOAD(dA, U8, i + 1, 0); } SB(); EX_UCOMP(dB, hB0, hB1, 3); SB();
            }
            if (EXP_REP_U) {
#pragma unroll
                for (int k = 0; k < 4; ++k)
#pragma unroll
                    for (int j = 0; j < 8; ++j) zp[k][j] *= 0.5f; }
            unsigned* apl = (unsigned*)(lds + 66560);
#pragma unroll
            for (int k = 0; k < 4; ++k)
#pragma unroll
                for (int j = 0; j < 8; ++j) { float z = zp[k][j]; z += dpp_f(z, 1); z += __shfl_xor(z, 4);
                    const int li = ((tlb + k) * 8 + rr) * 16 + 2 * j + (odd ? 1 : 0); const unsigned eid = offs[li] >> 7;
                    const float act = gelu_erf(z * ISU[eid]) * gts[li] * ISV[eid]; const float oth = dpp_f(act, 0);
                    apl[((tlb + k) * 8 + rr) * 8 + j] = f2bf(odd ? oth : act) | (f2bf(odd ? act : oth) << 16); }
            LDS_WAIT();
            float ssq[4] = {0.f, 0.f, 0.f, 0.f};
#define EX_VCOMP(buf, i_, k_) do { float oa_[16]; _Pragma("unroll") for (int e_ = 0; e_ < 16; ++e_) oa_[e_] = 0.f; \
    const int col_ = (int)EX_SLICE(i_) * 128 + cc * 16 + 2 * rr; const size_t xo_ = (size_t)(tok0 + tlb + (k_)) * D + col_; \
    const f32x2v x1_ = *(const f32x2v*)(X1 + xo_), g2_ = *(const f32x2v*)(mod + (size_t)b * NADA + 5 * 2048 + col_); \
    const u32x4 ap0_ = *(const u32x4*)(apl + ((tlb + (k_)) * 8 + rr) * 8), ap1_ = *(const u32x4*)(apl + ((tlb + (k_)) * 8 + rr) * 8 + 4); \
    _Pragma("unroll") for (int j_ = 0; j_ < 8; ++j_) { const unsigned pr_ = (j_ < 4) ? ap0_[j_ & 3] : ap1_[j_ & 3]; const float a0_ = bflo(pr_), a1_ = bfhi(pr_); \
        { u32x4 w_ = buf[2 * j_]; asm volatile("" : "+v"(w_.x), "+v"(w_.y), "+v"(w_.z), "+v"(w_.w), "+v"(oa_[0])); float f_[16]; cvt16(w_, f_); _Pragma("unroll") for (int e_ = 0; e_ < 16; ++e_) oa_[e_] = fmaf(a0_, f_[e_], oa_[e_]); } \
        { u32x4 w_ = buf[2 * j_ + 1]; asm volatile("" : "+v"(w_.x), "+v"(w_.y), "+v"(w_.z), "+v"(w_.w), "+v"(oa_[0])); float f_[16]; cvt16(w_, f_); _Pragma("unroll") for (int e_ = 0; e_ < 16; ++e_) oa_[e_] = fmaf(a1_, f_[e_], oa_[e_]); } } \
      \
    float b8_[8], b4_[4], b2_[2]; \
    _Pragma("unroll") for (int e_ = 0; e_ < 8; ++e_) { const bool up_ = lane & 32; const float kp_ = up_ ? oa_[e_ + 8] : oa_[e_], sd_ = up_ ? oa_[e_] : oa_[e_ + 8]; b8_[e_] = kp_ + __shfl_xor(sd_, 32); } \
    _Pragma("unroll") for (int e_ = 0; e_ < 4; ++e_) { const bool up_ = lane & 16; const float kp_ = up_ ? b8_[e_ + 4] : b8_[e_], sd_ = up_ ? b8_[e_] : b8_[e_ + 4]; b4_[e_] = kp_ + __shfl_xor(sd_, 16); } \
    _Pragma("unroll") for (int e_ = 0; e_ < 2; ++e_) { const bool up_ = lane & 8; const float kp_ = up_ ? b4_[e_ + 2] : b4_[e_], sd_ = up_ ? b4_[e_] : b4_[e_ + 2]; b2_[e_] = kp_ + __shfl_xor(sd_, 8); } \
    f32x2v y_; y_.x = x1_.x + g2_.x * b2_[0]; y_.y = x1_.y + g2_.y * b2_[1]; *(f32x2v*)(out + xo_) = y_; ssq[k_] = fmaf(y_.x, y_.x, fmaf(y_.y, y_.y, ssq[k_])); asm volatile("" : "+v"(ssq[k_])); } while (0)
#pragma unroll 1
            for (int i = 0; i < 16 * (1 + EXP_REP_V); ++i) {
                if (EXP_REP_V && i == 16) { ssq[0] = 0.f; ssq[1] = 0.f; ssq[2] = 0.f; ssq[3] = 0.f; }
                __builtin_amdgcn_s_barrier();
                EX_LOAD(dA, V8, i, 0); SB(); EX_VCOMP(dA, i, 0); SB();
                EX_LOAD(dA, V8, i, 1); SB(); EX_VCOMP(dA, i, 1); SB();
                EX_LOAD(dA, V8, i, 2); SB(); EX_VCOMP(dA, i, 2); SB();
                EX_LOAD(dA, V8, i, 3); SB(); EX_VCOMP(dA, i, 3); SB();
            }
#pragma unroll
            for (int k = 0; k < 4; ++k) { const float tot = wave_sum(ssq[k]); rstl[wave * 8 + half * 4 + k] = rsqrtf(tot * (1.f / D) + NORM_EPS); }
        }
#undef EX_SLICE
#undef EX_LOAD
#undef EX_LOADH
#undef EX_DOT16
#undef EX_UCOMP
#undef EX_VCOMP
#undef SB
        __builtin_amdgcn_fence(__ATOMIC_RELEASE, "agent"); __builtin_amdgcn_fence(__ATOMIC_ACQUIRE, "agent");
        LDS_WAIT();
        int lane2 = (int)__builtin_amdgcn_mbcnt_hi(~0u, __builtin_amdgcn_mbcnt_lo(~0u, 0u)); asm volatile("" : "+v"(lane2));
#pragma unroll 1
        for (int k = 0; k < 8; ++k) { float* xr = out + (size_t)(tok0 + wave * 8 + k) * D; const float rs = rstl[wave * 8 + k];
#pragma unroll
            for (int j = 0; j < 8; ++j) { const int col = 4 * (lane2 + 64 * j); const f32x4 v = *(const f32x4*)(xr + col), f = *(const f32x4*)(fin + col);
                f32x4 o; o[0] = v[0] * rs * f[0]; o[1] = v[1] * rs * f[1]; o[2] = v[2] * rs * f[2]; o[3] = v[3] * rs * f[3]; *(f32x4*)(xr + col) = o; } }
    }
}

#define XB_TMO      128
#define XB_XCNT(j)  (256  + 64 * (j))
#define XB_XSUB(j)  (1280 + 64 * (j))
#define XB_XGEN(j)  (2304 + 64 * (j))
#define XB_TOP      3328
#define XB_TOPGEN   3392
#define XCD_BAR_WORDS 3456
#define XB_SPIN_CAP (1u << 22)
__device__ __forceinline__ unsigned xb_ld(unsigned* p)              { return __hip_atomic_load(p, __ATOMIC_RELAXED, __HIP_MEMORY_SCOPE_AGENT); }
__device__ __forceinline__ unsigned xb_add(unsigned* p, unsigned v) { return __hip_atomic_fetch_add(p, v, __ATOMIC_RELAXED, __HIP_MEMORY_SCOPE_AGENT); }
__device__ __forceinline__ unsigned xb_xcc_id() { return (unsigned)__builtin_amdgcn_s_getreg((3 << 11) | 20) & 0xFu; }
#define XB_SPIN(cond, bar) do { unsigned _sp = 0; while (cond) { __builtin_amdgcn_s_sleep(1); \
    if ((++_sp & 255u) == 0u) { if (xb_ld(&(bar)[XB_TMO])) break; if (_sp > XB_SPIN_CAP) { atomicAdd(&(bar)[XB_TMO], 1u); break; } } } } while (0)
struct XcdBarrier { unsigned* bar; unsigned x; volatile LAS unsigned* st; };
__device__ __forceinline__ XcdBarrier xcd_barrier_post(unsigned* bar, volatile LAS unsigned* st) {
    XcdBarrier b; b.bar = bar; b.x = xb_xcc_id(); b.st = st;
    if (threadIdx.x == 0) (void)xb_add(&bar[XB_XCNT(b.x)], 1u);
    return b;
}
__device__ __forceinline__ void xcd_barrier_complete(unsigned* bar, unsigned x, unsigned& nloc, unsigned& nx) {
    const unsigned G = gridDim.x * gridDim.y * gridDim.z;
    unsigned sum, cnt, mine, sp = 0u;
    for (;;) {
        sum = 0u; cnt = 0u; mine = 0u;
#pragma unroll
        for (unsigned j = 0; j < 16; ++j) { const unsigned c = xb_ld(&bar[XB_XCNT(j)]); sum += c; cnt += (c > 0u) ? 1u : 0u; mine = (j == x) ? c : mine; }
        if (sum == G) break;
        __builtin_amdgcn_s_sleep(1);
        if ((++sp & 255u) == 0u) { if (xb_ld(&bar[XB_TMO])) break; if (sp > XB_SPIN_CAP) { atomicAdd(&bar[XB_TMO], 1u); break; } }
    }
    nloc = mine > 0u ? mine : 1u; nx = cnt > 0u ? cnt : 1u;
}
__device__ __forceinline__ void xcd_barrier(const XcdBarrier& b) {
    asm volatile("s_waitcnt vmcnt(0)" ::: "memory");
    __syncthreads();
    if (threadIdx.x == 0) {
        unsigned* bar = b.bar;
        __builtin_amdgcn_s_waitcnt(0);
        unsigned nloc = b.st[0], nx = b.st[1];
        if (nloc == 0u) { xcd_barrier_complete(bar, b.x, nloc, nx); b.st[0] = nloc; b.st[1] = nx; }
        const unsigned old = xb_add(&bar[XB_XSUB(b.x)], 1u);
        const unsigned gen = old / nloc;
        if (old + 1u == (gen + 1u) * nloc) {
            __builtin_amdgcn_fence(__ATOMIC_RELEASE, "agent");
            asm volatile("s_waitcnt vmcnt(0)" ::: "memory");
            const unsigned og = xb_add(&bar[XB_TOP], 1u);
            const unsigned tg = og / nx;
            if (og + 1u == (tg + 1u) * nx) xb_add(&bar[XB_TOPGEN], 1u);
            else XB_SPIN(xb_ld(&bar[XB_TOPGEN]) == tg, bar);
            __builtin_amdgcn_fence(__ATOMIC_ACQUIRE, "agent");
            xb_add(&bar[XB_XGEN(b.x)], 1u);
            asm volatile("s_waitcnt vmcnt(0)" ::: "memory");
        } else {
            XB_SPIN(xb_ld(&bar[XB_XGEN(b.x)]) == gen, bar);
            __builtin_amdgcn_fence(__ATOMIC_ACQUIRE, "agent");
            asm volatile("s_waitcnt vmcnt(0)" ::: "memory");
        }
    }
    __syncthreads();
}

__device__ __forceinline__ void subset_barrier(unsigned* cnt, unsigned n) {
    asm volatile("s_waitcnt vmcnt(0)" ::: "memory");
    __syncthreads();
    if (threadIdx.x == 0) {
        __builtin_amdgcn_fence(__ATOMIC_RELEASE, "agent");
        asm volatile("s_waitcnt vmcnt(0)" ::: "memory");
        __hip_atomic_fetch_add(cnt, 1u, __ATOMIC_RELAXED, __HIP_MEMORY_SCOPE_AGENT);
        unsigned sp = 0;
        while (__hip_atomic_load(cnt, __ATOMIC_RELAXED, __HIP_MEMORY_SCOPE_AGENT) < n) { __builtin_amdgcn_s_sleep(1); if (++sp > (1u << 24)) break; }
        __builtin_amdgcn_fence(__ATOMIC_ACQUIRE, "agent");
        asm volatile("s_waitcnt vmcnt(0)" ::: "memory");
    }
    __syncthreads();
}
__device__ __forceinline__ void subset_wait(unsigned* cnt, unsigned n) {
    __syncthreads();
    if (threadIdx.x == 0) {
        unsigned sp = 0;
        while (__hip_atomic_load(cnt, __ATOMIC_RELAXED, __HIP_MEMORY_SCOPE_AGENT) < n) { __builtin_amdgcn_s_sleep(2); if (++sp > (1u << 24)) break; }
        __builtin_amdgcn_fence(__ATOMIC_ACQUIRE, "agent");
        asm volatile("s_waitcnt vmcnt(0)" ::: "memory");
    }
    __syncthreads();
}
constexpr int NPHASES = 11;
__global__ void __launch_bounds__(NTHREADS, 2) mega_fwd(Params p) {
    extern __shared__ __attribute__((aligned(16))) unsigned char lds[];
    cg::grid_group grid = cg::this_grid();
    const int lo = p.ph_lo, hi = p.ph_hi;
#ifndef PHASE_MASK
#define PHASE_MASK 0x7ff
#endif
#define IN(k) (((PHASE_MASK >> (k)) & 1) && lo <= (k) && (k) < hi)
#define SEAM(k) do { if (IN(k) && IN((k) + 1)) xcd_barrier(xbar); } while (0)
    unsigned char* ws = p.ws;
    bf16_t* P = (bf16_t*)(ws + WS_P);
    bf16_t* Hb = (bf16_t*)((unsigned char*)p.out + OUT_H);
    bf16_t* WinT = (bf16_t*)((unsigned char*)p.out + OUT_WIN);
    const float* mod = (const float*)(ws + WS_MOD);
    LAS unsigned char* ldsl = (LAS unsigned char*)lds;
    volatile LAS unsigned* xst = (volatile LAS unsigned*)(ldsl + LDS_BYTES - 64);
    if (threadIdx.x < 2) xst[threadIdx.x] = 0u;
    __syncthreads();
    XcdBarrier xbar = xcd_barrier_post((unsigned*)(ws + WS_CTL) + 4096, xst);

#ifndef REPEAT_PHASE
#define REPEAT_PHASE -1
#endif
    int rep3 = 0;
#define RUNPH(k, ...) do { if (IN(k)) { __VA_ARGS__; if (REPEAT_PHASE == (k)) { grid.sync(); __VA_ARGS__; } } } while (0)
    RUNPH(0, { phase_mod(p, lds); __syncthreads(); phase_weights(p, lds); });
    SEAM(0);
    RUNPH(1, { phase_norm_rows(p.in[0], p.in[4], mod, mod + 2048, Hb, LDP); });
    SEAM(1);
    RUNPH(2, { pg8::Gemm g{Hb, WinT, nullptr, nullptr, LDP, LDP, T, 36 * 256, D}; pg8::StaticOrder<1> S; S.init(T, 36 * 256, gridDim.x, blockIdx.x);
        pg8::EpiBf16 E{P, NP, 33}; pg8::gemm_phase(ldsl, g, S, E); });
    SEAM(2);
    if (IN(3)) { const int G = gridDim.x, bx = blockIdx.x;
        { pg8::Gemm g{Hb, WinT, nullptr, nullptr, LDP, LDP, T, 13 * 256, D}; pg8::StaticOrder<1> S; S.init(T, 13 * 256, G, bx, 36);
          pg8::EpiBf16 E{P, NP, 33}; pg8::gemm_phase(ldsl, g, S, E); }
        unsigned* sbar = (unsigned*)(ws + WS_CTL) + 12288; unsigned* q_at = sbar + 64; unsigned* q_vt = sbar + 128; unsigned* q_ix = sbar + 192;
        if (G >= 128) {
            const unsigned nsub = (unsigned)(G - 64);
            if (bx >= G - 64) { phase_hgrn(p, lds, bx - (G - 64), 64); subset_wait(sbar, nsub); }
            else {
                for (;;) { const int i = queue_pop(q_vt, lds); if (i >= 512) break; phase_vt(p, lds, i, 1 << 27); }
                for (;;) { const int i = queue_pop(q_ix, lds); if (i >= 1024) break; indexer_item(p, lds, (i >> 2) & 7, 31 - (i >> 5), i & 3); }
                subset_barrier(sbar, nsub);
            }
            phase_attn_queue(p, lds, q_at);
        } else { phase_vt(p, lds, bx, G); phase_indexer(p, lds, bx, G); __syncthreads(); phase_hgrn(p, lds, bx, G); grid.sync(); phase_attn(p, lds, bx, G); }
    }
    SEAM(3);
    RUNPH(5, { pg8::Gemm g{(const bf16_t*)(ws + WS_AO), (const bf16_t*)(ws + WS_WUA), (const bf16_t*)(ws + WS_REC), (const bf16_t*)(ws + WS_WUB), 1024, 1024, T, D, 1024}; pg8::StaticOrder<2> S; S.init(T, D, gridDim.x, blockIdx.x);
        pg8::EpiMix E{(bf16_t*)(ws + WS_MIXED), P}; pg8::gemm_phase(ldsl, g, S, E); });
    SEAM(5);
    RUNPH(6, { pg8::Gemm g{(const bf16_t*)(ws + WS_MIXED), (const bf16_t*)(ws + WS_WOUT), nullptr, nullptr, D, D, T, D, D}; pg8::StaticOrder<1> S; S.init(T, D, gridDim.x, blockIdx.x);
        pg8::EpiX1 E{p.in[0], (float*)(ws + WS_X1), mod + 4096}; pg8::gemm_phase(ldsl, g, S, E); });
    SEAM(6);
    RUNPH(7, { phase_norm_rows((const float*)(ws + WS_X1), p.in[5], mod + 3 * 2048, mod + 4 * 2048, (bf16_t*)(ws + WS_H2), D); phase_uv(p); });
    SEAM(7);
    RUNPH(8, { pg8::Gemm g{(const bf16_t*)(ws + WS_H2), (const bf16_t*)(ws + WS_WQ), nullptr, nullptr, D, D, T, D, D}; pg8::StaticOrder<1> S; S.init(T, D, gridDim.x, blockIdx.x);
        pg8::EpiBf16 E{(bf16_t*)(ws + WS_QP), D, 1 << 30}; pg8::gemm_phase(ldsl, g, S, E); });
    SEAM(8);
    RUNPH(9, { phase_peer_topk_ni((const GAS bf16_t*)(ws + WS_QP), (const GAS bf16_t*)(ws + WS_KEYS), (GAS int*)(ws + WS_EIDX), (GAS float*)(ws + WS_EGATE), ldsl); });
    SEAM(9);
    RUNPH(10, { phase_experts(p, lds); });
    if (p.ph_hi > NPHASES) grid.sync();
#undef IN
#undef SEAM
}

#ifndef MK_N_LAUNCHES
#define MK_N_LAUNCHES 1
#endif
extern "C" void kernel_launch(void* const* d_in, const int* in_sizes, int n_in, void* d_out, int out_size, void* d_ws, size_t ws_size, hipStream_t stream) {
    static int grid = 0;
    if (grid == 0) {
        if (n_in != 17 || out_size != T * D || ws_size < WS_END) { fprintf(stderr, "kernel_launch: unexpected shapes (n_in %d out %d ws %zu)\n", n_in, out_size, ws_size); grid = -1; return; }
        int dev = 0, cus = 0, per_cu = 0;
        hipGetDevice(&dev); hipDeviceGetAttribute(&cus, hipDeviceAttributeMultiprocessorCount, dev);
        hipFuncSetAttribute((const void*)mega_fwd, hipFuncAttributeMaxDynamicSharedMemorySize, LDS_BYTES);
        hipOccupancyMaxActiveBlocksPerMultiprocessor(&per_cu, (const void*)mega_fwd, NTHREADS, LDS_BYTES);
        if (per_cu < 1) { fprintf(stderr, "kernel_launch: occupancy query says %d blocks/CU\n", per_cu); per_cu = 1; }
        (void)hipGetLastError();
        grid = cus * 1;
    }
    if (grid < 0) return;
    if (hipMemsetAsync((char*)d_ws + WS_CTL, 0, 65536, stream) != hipSuccess) { fprintf(stderr, "kernel_launch: memset failed\n"); return; }
    Params p{};
    for (int i = 0; i < 17; ++i) p.in[i] = (const float*)d_in[i];
    p.out = (float*)d_out; p.ws = (unsigned char*)d_ws;
#if MK_N_LAUNCHES == 1
    p.ph_lo = 0; p.ph_hi = NPHASES;
    void* args[] = {&p};
    hipError_t e = hipLaunchCooperativeKernel((const void*)mega_fwd, dim3(grid), dim3(NTHREADS), args, LDS_BYTES, stream);
    if (e != hipSuccess) fprintf(stderr, "cooperative launch failed: %s (grid %d)\n", hipGetErrorString(e), grid);
#else
    for (int k = 0; k < NPHASES; ++k) { p.ph_lo = k; p.ph_hi = k + 1; void* args[] = {&p};
        hipError_t e = hipLaunchCooperativeKernel((const void*)mega_fwd, dim3(grid), dim3(NTHREADS), args, LDS_BYTES, stream);
        if (e != hipSuccess) { fprintf(stderr, "launch %d failed: %s\n", k, hipGetErrorString(e)); break; } }
#endif
}
```

```cpp
#include <hip/hip_runtime.h>
#include <hip/hip_cooperative_groups.h>
#include <cstdio>
#include <cstdint>
namespace cg = cooperative_groups;

#define LAS __attribute__((address_space(3)))
typedef unsigned short bf16_t;
typedef short bf16x8 __attribute__((ext_vector_type(8)));
typedef short bf16x4 __attribute__((ext_vector_type(4)));
typedef float f32x2 __attribute__((ext_vector_type(2)));
typedef float f32x4 __attribute__((ext_vector_type(4)));
typedef float f32x16 __attribute__((ext_vector_type(16)));
typedef unsigned u32x2 __attribute__((ext_vector_type(2)));
typedef unsigned u32x4 __attribute__((ext_vector_type(4)));

constexpr int T = 16384, D = 2048, SEQ = 2048, NBATCH = 8, NP = 12544;
constexpr int C_QA = 0, C_KA = 1024, C_VA = 2048, C_QI = 3072, C_KI = 4096, C_WI = 4160, C_QB = 4352, C_FB = 5376, C_IB = 6400, C_GB = 7424, C_GA = 8448, C_GG = 10496;
constexpr int NADA = 12288;
constexpr float NORM_EPS = 1e-6f;
constexpr int NTHREADS = 512, NWAVES = 8;
constexpr int LDS_BYTES = 147456;
constexpr size_t MiB = 1u << 20;
constexpr size_t WS_CTL = 0, WS_MOD = 1 * MiB, WS_WUA = 2 * MiB, WS_WUB = 6 * MiB, WS_WOUT = 10 * MiB, WS_WQ = 18 * MiB, WS_KEYS = 26 * MiB, WS_MASK = 27 * MiB;
constexpr size_t WS_MIXED = 32 * MiB;
constexpr size_t WS_VT = 32 * MiB, WS_ORAW = 64 * MiB;
constexpr size_t WS_P = 96 * MiB;
constexpr size_t WS_H2 = 96 * MiB, WS_QP = 160 * MiB, WS_U8 = 224 * MiB, WS_V8 = 256 * MiB, WS_ISU = 26 * MiB + 512 * 1024, WS_ISV = 26 * MiB + 768 * 1024, WS_Y = 288 * MiB, WS_EIDX = 352 * MiB, WS_EGATE = 360 * MiB;
constexpr size_t WS_X1 = 368 * MiB;
constexpr size_t WS_END = 496 * MiB;
constexpr int LDP = 2048 + 64;
constexpr size_t OUT_H = 0, OUT_WIN = 68 * MiB;
constexpr size_t OUT_AO = 0, OUT_REC = 32 * MiB;

struct Params { const float* in[17]; float* out; unsigned char* ws; int ph_lo, ph_hi; };

__device__ __forceinline__ unsigned f2bf(float f) { unsigned u = __float_as_uint(f); return (u + 0x7fffu + ((u >> 16) & 1u)) >> 16; }
__device__ __forceinline__ float bf2f(unsigned b) { return __uint_as_float(b << 16); }
__device__ __forceinline__ float bflo(unsigned w) { return __uint_as_float(w << 16); }
__device__ __forceinline__ float bfhi(unsigned w) { return __uint_as_float(w & 0xffff0000u); }
__device__ __forceinline__ unsigned pk2(float lo, float hi) { unsigned r; asm volatile("v_cvt_pk_bf16_f32 %0, %1, %2" : "=v"(r) : "v"(lo), "v"(hi)); return r; }
__device__ __forceinline__ float wave_sum(float v) {
#pragma unroll
    for (int o = 1; o < 64; o <<= 1) v += __shfl_xor(v, o);
    return v;
}
__device__ __forceinline__ float sigmoidf_(float v) { return 1.f / (1.f + __expf(-v)); }
__device__ __forceinline__ float siluf_(float v) { return v / (1.f + __expf(-v)); }
#define LDS_WAIT() asm volatile("s_waitcnt lgkmcnt(0)" ::: "memory")

namespace pg8 {
constexpr int BM = 256, BK = 64, HALF = 128, HTB = HALF * BK * 2, STAGE_BYTES = 8 * HTB, NXCD = 8, WGM = 8;
__host__ __device__ __forceinline__ int lds_byte(int r, int c) { const int st = (r >> 4) * 2 + (c >> 5), rr = r & 15, cc = c & 31, ob = rr * 64 + cc * 2; return st * 1024 + (ob ^ (((ob >> 9) & 1) << 5)); }
__host__ __device__ __forceinline__ void stage_rc(int b, int& R, int& C) { const int st = b / 1024, sb = b % 1024, swz = sb ^ (((sb >> 9) & 1) << 5); R = (st >> 1) * 16 + swz / 64; C = (st & 1) * 32 + (swz % 64) / 2; }
__host__ __device__ __forceinline__ int perm32(int rho) { const int n = rho >> 4, i = rho & 15; return 8 * (i >> 2) + 4 * n + (i & 3); }

struct Unit { int pm, pn, z; };
struct Gemm { const bf16_t* A; const bf16_t* Bt; const bf16_t* A2; const bf16_t* Bt2; int lda, ldb, M, N, K; };

template <int NZ> struct StaticOrder {
    int nM, nN, nwg, G, c;
    __device__ void init(int M, int N, int G_, int c_) { nM = M / BM; nN = N / BM; nwg = nM * nN; G = G_; c = c_; }
    __device__ bool next(int i, Unit& u) const {
        const long L = (long)(i / NZ) * G + c; if (L >= nwg) return false;
        int wgid = (int)L; { const int q = nwg / NXCD, r = nwg % NXCD, xcd = wgid % NXCD, off = wgid / NXCD; wgid = (xcd < r ? xcd * (q + 1) : r * (q + 1) + (xcd - r) * q) + off; }
        const int nig = WGM * nN, gid = wgid / nig, fm = gid * WGM, gsz = (nM - fm) < WGM ? (nM - fm) : WGM;
        u.pm = fm + ((wgid % nig) % gsz); u.pn = (wgid % nig) / gsz; u.z = i % NZ; return true;
    }
};

template <class Epi, class Sched>
__device__ __forceinline__ void gemm_phase(LAS unsigned char* lds, const Gemm g, const Sched& S, const Epi& E) {
    const int tid = threadIdx.x, wid = __builtin_amdgcn_readfirstlane(tid >> 6), lane = tid & 63, wr = wid >> 2, wc = wid & 3, fr = lane & 15, fq = lane >> 4;
    const int K = g.K, nt = K / BK;
    unsigned voffA[2], voffB[2];
#pragma unroll
    for (int i = 0; i < 2; ++i) { int R, C; stage_rc(tid * 16 + i * 8192, R, C); const int Rb = Epi::PERM ? ((R & ~31) + perm32(R & 31)) : R;
        voffA[i] = (unsigned)(R * g.lda + C) * 2u; voffB[i] = (unsigned)(Rb * g.ldb + C) * 2u; }
    const size_t kstep = (size_t)(BK * 2);
    const size_t hstepA = (size_t)HALF * g.lda * 2, hstepB = (size_t)HALF * g.ldb * 2;
    const size_t tstepA = 2 * hstepA, tstepB = 2 * hstepB;
    const unsigned ldsw = (unsigned)wid * 1024u;
    const int aoff = lds_byte(wr * 64 + fr, fq * 8), boff = lds_byte(wc * 32 + fr, fq * 8);
#define PG8_SA(b, h) (((b) * 2 + (h)) * HTB)
#define PG8_SB(b, h) ((4 + (b) * 2 + (h)) * HTB)
#define PG8_STAGE(bufoff, gbase, voff) do { _Pragma("unroll") for (int _i = 0; _i < 2; ++_i) \
        __builtin_amdgcn_global_load_lds((const unsigned*)((const char*)(gbase) + (voff)[_i]), (LAS unsigned*)(lds + (bufoff) + ldsw + _i * 8192), 16, 0, 0); } while (0)
#define PG8_LDA(dst, b, h) do { _Pragma("unroll") for (int m = 0; m < 4; ++m) _Pragma("unroll") for (int k = 0; k < 2; ++k) dst[m][k] = *(const LAS bf16x8*)(lds + PG8_SA(b, h) + aoff + m * 2048 + k * 1024); } while (0)
#define PG8_LDB(dst, b, h) do { _Pragma("unroll") for (int n = 0; n < 2; ++n) _Pragma("unroll") for (int k = 0; k < 2; ++k) dst[n][k] = *(const LAS bf16x8*)(lds + PG8_SB(b, h) + boff + n * 2048 + k * 1024); } while (0)
#define PG8_MMA(ai, bj, At, Bt) do { __builtin_amdgcn_s_setprio(1); _Pragma("unroll") for (int m = 0; m < 4; ++m) _Pragma("unroll") for (int n = 0; n < 2; ++n) _Pragma("unroll") for (int k = 0; k < 2; ++k) \
        acc[ai][bj][m][n] = __builtin_amdgcn_mfma_f32_16x16x32_bf16(Bt[n][k], At[m][k], acc[ai][bj][m][n], 0, 0, 0); __builtin_amdgcn_s_setprio(0); } while (0)
#define PG8_WAIT_V(n) asm volatile("s_waitcnt vmcnt(" #n ")" ::: "memory")
#define PG8_WAIT_L(n) asm volatile("s_waitcnt lgkmcnt(" #n ")" ::: "memory")
#define PG8_BAR __builtin_amdgcn_s_barrier()
#define PG8_SCHED __builtin_amdgcn_sched_barrier(0)
#define PG8_ABASE(u) ((const char*)((u).z ? g.A2 : g.A) + (size_t)(u).pm * tstepA)
#define PG8_BBASE(u) ((const char*)((u).z ? g.Bt2 : g.Bt) + (size_t)(u).pn * tstepB)
    Unit cur, nxt; int ui = 0;
    if (!S.next(0, cur)) return;
    f32x4 acc[2][2][4][2];
#pragma unroll
    for (int a = 0; a < 2; ++a)
#pragma unroll
        for (int b = 0; b < 2; ++b)
#pragma unroll
            for (int m = 0; m < 4; ++m)
#pragma unroll
                for (int n = 0; n < 2; ++n) acc[a][b][m][n] = (f32x4){0.f, 0.f, 0.f, 0.f};
    bf16x8 At[4][2], B0[2][2], B1[2][2];
    const char* cA = PG8_ABASE(cur); const char* cB = PG8_BBASE(cur);
    PG8_STAGE(PG8_SB(0, 0), cB, voffB); PG8_STAGE(PG8_SA(0, 0), cA, voffA); PG8_STAGE(PG8_SB(0, 1), cB + hstepB, voffB); PG8_STAGE(PG8_SA(0, 1), cA + hstepA, voffA);
    if (wr == 1) PG8_BAR;
    PG8_WAIT_V(4); PG8_BAR;
    PG8_STAGE(PG8_SB(1, 0), cB + kstep, voffB); PG8_STAGE(PG8_SA(1, 0), cA + kstep, voffA); PG8_STAGE(PG8_SB(1, 1), cB + hstepB + kstep, voffB);
    PG8_WAIT_V(6); PG8_BAR;
    for (;;) {
        const bool has_next = S.next(ui + 1, nxt);
        const char* nA = has_next ? PG8_ABASE(nxt) : cA; const char* nB = has_next ? PG8_BBASE(nxt) : cB;
        for (int t = 0; t < nt; t += 2) {
            const bool last = (t == nt - 2);
            const char* a1 = cA + (size_t)(t + 1) * kstep;
            const char* a2 = last ? nA : cA + (size_t)(t + 2) * kstep; const char* b2 = last ? nB : cB + (size_t)(t + 2) * kstep;
            const char* a3 = a2 + kstep; const char* b3 = b2 + kstep;
            PG8_LDB(B0, 0, 0); PG8_SCHED; PG8_LDA(At, 0, 0); PG8_STAGE(PG8_SA(1, 1), a1 + hstepA, voffA);
            PG8_WAIT_L(8); PG8_BAR; PG8_WAIT_L(0); PG8_MMA(0, 0, At, B0); PG8_BAR; PG8_SCHED;
            PG8_LDB(B1, 0, 1); PG8_STAGE(PG8_SB(0, 0), b2, voffB);
            PG8_BAR; PG8_WAIT_L(0); PG8_MMA(0, 1, At, B1); PG8_BAR;
            PG8_LDA(At, 0, 1); PG8_STAGE(PG8_SA(0, 0), a2, voffA);
            PG8_BAR; PG8_WAIT_L(0); PG8_MMA(1, 0, At, B0); PG8_BAR; PG8_SCHED;
            PG8_STAGE(PG8_SB(0, 1), b2 + hstepB, voffB);
            PG8_WAIT_V(6); PG8_BAR; PG8_MMA(1, 1, At, B1); PG8_BAR;
            PG8_LDB(B0, 1, 0); PG8_SCHED; PG8_LDA(At, 1, 0); PG8_STAGE(PG8_SA(0, 1), a2 + hstepA, voffA);
            PG8_WAIT_L(8); PG8_BAR; PG8_WAIT_L(0); PG8_MMA(0, 0, At, B0); PG8_BAR; PG8_SCHED;
            PG8_LDB(B1, 1, 1); PG8_STAGE(PG8_SB(1, 0), b3, voffB);
            PG8_BAR; PG8_WAIT_L(0); PG8_MMA(0, 1, At, B1); PG8_BAR;
            PG8_LDA(At, 1, 1); PG8_STAGE(PG8_SA(1, 0), a3, voffA);
            PG8_BAR; PG8_WAIT_L(0); PG8_MMA(1, 0, At, B0); PG8_BAR; PG8_SCHED;
            PG8_STAGE(PG8_SB(1, 1), b3 + hstepB, voffB);
            PG8_WAIT_V(6); PG8_BAR; PG8_MMA(1, 1, At, B1); PG8_BAR;
        }
        E(acc, cur, wr, wc, fr, fq);
        if (!has_next) break;
#pragma unroll
        for (int a = 0; a < 2; ++a)
#pragma unroll
            for (int b = 0; b < 2; ++b)
#pragma unroll
                for (int m = 0; m < 4; ++m)
#pragma unroll
                    for (int n = 0; n < 2; ++n) acc[a][b][m][n] = (f32x4){0.f, 0.f, 0.f, 0.f};
        cur = nxt; cA = nA; cB = nB; ++ui;
    }
    PG8_WAIT_V(0);
    if (wr == 0) PG8_BAR;
    PG8_BAR;
#undef PG8_SA
#undef PG8_SB
#undef PG8_STAGE
#undef PG8_LDA
#undef PG8_LDB
#undef PG8_MMA
#undef PG8_WAIT_V
#undef PG8_WAIT_L
#undef PG8_BAR
#undef PG8_SCHED
#undef PG8_ABASE
#undef PG8_BBASE
}

struct EpiBf16 {
    static constexpr bool PERM = true;
    bf16_t* O; int ldc; int sig_from;
    __device__ __forceinline__ void operator()(const f32x4 (&acc)[2][2][4][2], const Unit& u, int wr, int wc, int fr, int fq) const {
        const int row0 = u.pm * BM + wr * 64 + fr, col0 = u.pn * BM + wc * 32 + 8 * fq; const bool sig = u.pn >= sig_from;
#pragma unroll
        for (int ai = 0; ai < 2; ++ai)
#pragma unroll
            for (int m = 0; m < 4; ++m) { bf16_t* rowp = O + (size_t)(row0 + ai * HALF + m * 16) * ldc + col0;
#pragma unroll
                for (int bj = 0; bj < 2; ++bj) { f32x4 v0 = acc[ai][bj][m][0], v1 = acc[ai][bj][m][1];
                    if (sig) {
#pragma unroll
                        for (int j = 0; j < 4; ++j) { v0[j] = sigmoidf_(v0[j]); v1[j] = sigmoidf_(v1[j]); } }
                    u32x4 w; w.x = pk2(v0[0], v0[1]); w.y = pk2(v0[2], v0[3]); w.z = pk2(v1[0], v1[1]); w.w = pk2(v1[2], v1[3]);
                    *(u32x4*)(rowp + bj * HALF) = w; } }
    }
};
struct EpiMix {
    static constexpr bool PERM = true;
    bf16_t* O; const bf16_t* P;
    __device__ __forceinline__ void operator()(const f32x4 (&acc)[2][2][4][2], const Unit& u, int wr, int wc, int fr, int fq) const {
        const int row0 = u.pm * BM + wr * 64 + fr, col0 = u.pn * BM + wc * 32 + 8 * fq; const int gcol = (u.z ? C_GG : C_GA);
#pragma unroll
        for (int ai = 0; ai < 2; ++ai) {
            u32x4 gw[4][2], pw[4][2];
#pragma unroll
            for (int m = 0; m < 4; ++m)
#pragma unroll
                for (int bj = 0; bj < 2; ++bj) { const size_t r = (size_t)(row0 + ai * HALF + m * 16);
                    gw[m][bj] = *(const u32x4*)(P + r * NP + gcol + col0 + bj * HALF);
                    if (u.z) pw[m][bj] = *(const u32x4*)(O + r * D + col0 + bj * HALF); else pw[m][bj] = (u32x4){0u, 0u, 0u, 0u}; }
            asm volatile("" ::: "memory");
#pragma unroll
            for (int m = 0; m < 4; ++m)
#pragma unroll
                for (int bj = 0; bj < 2; ++bj) { const size_t r = (size_t)(row0 + ai * HALF + m * 16); const f32x4 v0 = acc[ai][bj][m][0], v1 = acc[ai][bj][m][1]; const u32x4 g = gw[m][bj], q = pw[m][bj];
                    u32x4 w; w.x = pk2(fmaf(v0[0], bflo(g.x), bflo(q.x)), fmaf(v0[1], bfhi(g.x), bfhi(q.x))); w.y = pk2(fmaf(v0[2], bflo(g.y), bflo(q.y)), fmaf(v0[3], bfhi(g.y), bfhi(q.y)));
                    w.z = pk2(fmaf(v1[0], bflo(g.z), bflo(q.z)), fmaf(v1[1], bfhi(g.z), bfhi(q.z))); w.w = pk2(fmaf(v1[2], bflo(g.w), bflo(q.w)), fmaf(v1[3], bfhi(g.w), bfhi(q.w)));
                    *(u32x4*)(O + r * D + col0 + bj * HALF) = w; }
            asm volatile("" ::: "memory");
        }
    }
};
struct EpiX1 {
    static constexpr bool PERM = false;
    const float* x; float* out; const float* gate;
    __device__ __forceinline__ void operator()(const f32x4 (&acc)[2][2][4][2], const Unit& u, int wr, int wc, int fr, int fq) const {
        const int row0 = u.pm * BM + wr * 64 + fr, col0 = u.pn * BM + wc * 32 + 4 * fq; const int b = (u.pm * BM) >> 11;
        f32x4 gv[2][2];
#pragma unroll
        for (int bj = 0; bj < 2; ++bj)
#pragma unroll
            for (int n = 0; n < 2; ++n) gv[bj][n] = *(const f32x4*)(gate + (size_t)b * NADA + col0 + bj * HALF + n * 16);
#pragma unroll
        for (int ai = 0; ai < 2; ++ai) {
            f32x4 xv[4][2][2];
#pragma unroll
            for (int m = 0; m < 4; ++m)
#pragma unroll
                for (int bj = 0; bj < 2; ++bj)
#pragma unroll
                    for (int n = 0; n < 2; ++n) xv[m][bj][n] = *(const f32x4*)(x + (size_t)(row0 + ai * HALF + m * 16) * D + col0 + bj * HALF + n * 16);
            asm volatile("" ::: "memory");
#pragma unroll
            for (int m = 0; m < 4; ++m)
#pragma unroll
                for (int bj = 0; bj < 2; ++bj)
#pragma unroll
                    for (int n = 0; n < 2; ++n) *(f32x4*)(out + (size_t)(row0 + ai * HALF + m * 16) * D + col0 + bj * HALF + n * 16) = xv[m][bj][n] + gv[bj][n] * acc[ai][bj][m][n];
            asm volatile("" ::: "memory");
        }
    }
};
}

__device__ __forceinline__ void phase_mod(const Params& p, unsigned char* lds) {
    float* sc = (float*)lds;
    float* red = (float*)(lds + 65536);
    const int tid = threadIdx.x, wave = tid >> 6, lane = tid & 63;
    const float* c = p.in[1]; const float* wada = p.in[2]; const float* bada = p.in[3];
    float* mod = (float*)(p.ws + WS_MOD);
    if ((int)blockIdx.x >= 192) return;
    for (int i = tid; i < NBATCH * D; i += NTHREADS) { const int b = i >> 11, k = i & 2047; sc[k * 8 + b] = siluf_(c[i]); }
    __syncthreads();
    const int cgp = tid & 15, rg = tid >> 4;
    for (int item = blockIdx.x; item < 192; item += gridDim.x) {
        const float* w = wada + item * 64 + cgp * 4;
        float acc[8][4];
#pragma unroll
        for (int b = 0; b < 8; ++b)
#pragma unroll
            for (int j = 0; j < 4; ++j) acc[b][j] = 0.f;
#pragma unroll 1
        for (int i0 = 0; i0 < 64; i0 += 8) {
            f32x4 wvv[8];
#pragma unroll
            for (int u = 0; u < 8; ++u) wvv[u] = __builtin_nontemporal_load((const f32x4*)(w + (size_t)(rg + 32 * (i0 + u)) * NADA));
#pragma unroll
            for (int u = 0; u < 8; ++u) { const int k = rg + 32 * (i0 + u); const f32x4 wv = wvv[u];
                const f32x4 s0 = *(const f32x4*)(sc + k * 8), s1 = *(const f32x4*)(sc + k * 8 + 4);
#pragma unroll
                for (int j = 0; j < 4; ++j) { acc[0][j] += s0[0] * wv[j]; acc[1][j] += s0[1] * wv[j]; acc[2][j] += s0[2] * wv[j]; acc[3][j] += s0[3] * wv[j];
                    acc[4][j] += s1[0] * wv[j]; acc[5][j] += s1[1] * wv[j]; acc[6][j] += s1[2] * wv[j]; acc[7][j] += s1[3] * wv[j]; } } }
#pragma unroll
        for (int b = 0; b < 8; ++b)
#pragma unroll
            for (int j = 0; j < 4; ++j) { float v = acc[b][j]; v += __shfl_xor(v, 16); v += __shfl_xor(v, 32); acc[b][j] = v; }
        if (lane < 16) {
#pragma unroll
            for (int b = 0; b < 8; ++b)
#pragma unroll
                for (int j = 0; j < 4; ++j) red[(wave * 16 + cgp) * 32 + b * 4 + j] = acc[b][j]; }
        __syncthreads();
        { const int cgo = tid >> 5, b = (tid >> 2) & 7, j = tid & 3; float s = 0.f;
#pragma unroll
          for (int w8 = 0; w8 < 8; ++w8) s += red[(w8 * 16 + cgo) * 32 + (tid & 31)];
          const int col = item * 64 + cgo * 4 + j; mod[b * NADA + col] = s + bada[col]; }
        __syncthreads();
    }
}
__device__ __forceinline__ void transpose_item(const float* W, int K, int N, bf16_t* WT, int nblk, int item, int lane, float* scr, int mode, int pitch) {
    const int kb = item / nblk, nb = item % nblk, k0 = 64 * kb, n0 = 32 * nb;
    const int nd = n0 + (lane & 31); int ns = nd; bool valid = true;
    if (mode == 1) { if (nd >= C_QB) ns = nd - 176; else if (nd >= 4176) valid = false; }
    if (mode == 0 || n0 < 4160 || n0 >= C_QB) {
        const int ns0 = (mode == 1 && n0 >= C_QB) ? n0 - 176 : n0;
        f32x4 v[8];
#pragma unroll
        for (int i = 0; i < 8; ++i) v[i] = *(const f32x4*)(W + (size_t)(k0 + 8 * i + (lane >> 3)) * N + ns0 + 4 * (lane & 7));
#pragma unroll
        for (int i = 0; i < 8; ++i) { float* d = scr + (8 * i + (lane >> 3)) * 33 + 4 * (lane & 7); d[0] = v[i][0]; d[1] = v[i][1]; d[2] = v[i][2]; d[3] = v[i][3]; }
    } else {
#pragma unroll 8
        for (int i = 0; i < 32; ++i) { const int kk = 2 * i + (lane >> 5); scr[kk * 33 + (lane & 31)] = valid ? W[(size_t)(k0 + kk) * N + ns] : 0.f; }
    }
    LDS_WAIT();
    const int c = lane & 7;
#pragma unroll
    for (int j = 0; j < 4; ++j) { const int n = (lane >> 3) + 8 * j; const float* s = scr + (8 * c) * 33 + n;
        u32x4 o; o.x = pk2(s[0 * 33], s[1 * 33]); o.y = pk2(s[2 * 33], s[3 * 33]); o.z = pk2(s[4 * 33], s[5 * 33]); o.w = pk2(s[6 * 33], s[7 * 33]);
        *(u32x4*)(WT + (size_t)(n0 + n) * pitch + k0 + 8 * c) = o; }
    LDS_WAIT();
}
__device__ __forceinline__ void phase_weights(const Params& p, unsigned char* lds) {
    const int tid = threadIdx.x, wave = tid >> 6, lane = tid & 63;
    float* scr = (float*)(lds + wave * 16384);
    const int vb = ((int)blockIdx.x + (int)gridDim.x - 192 % (int)gridDim.x) % (int)gridDim.x;
    const int gw = vb * NWAVES + wave, NGW = gridDim.x * NWAVES;
    constexpr int I_IN = 32 * (NP / 32), I_UA = 16 * 64, I_UB = 16 * 64, I_O = 32 * 64, I_Q = 32 * 64;
    constexpr int NITEMS = I_IN + I_UA + I_UB + I_O + I_Q;
    bf16_t* win_t = (bf16_t*)((unsigned char*)p.out + OUT_WIN);
    for (int it = gw; it < NITEMS; it += NGW) {
        int r = it;
        if (r < I_IN) { transpose_item(p.in[6], 2048, 12368, win_t, NP / 32, r, lane, scr, 1, LDP); continue; } r -= I_IN;
        if (r < I_UA) { transpose_item(p.in[9], 1024, 2048, (bf16_t*)(p.ws + WS_WUA), 64, r, lane, scr, 0, 1024); continue; } r -= I_UA;
        if (r < I_UB) { transpose_item(p.in[10], 1024, 2048, (bf16_t*)(p.ws + WS_WUB), 64, r, lane, scr, 0, 1024); continue; } r -= I_UB;
        if (r < I_O) { transpose_item(p.in[11], 2048, 2048, (bf16_t*)(p.ws + WS_WOUT), 64, r, lane, scr, 0, 2048); continue; } r -= I_O;
        transpose_item(p.in[12], 2048, 2048, (bf16_t*)(p.ws + WS_WQ), 64, r, lane, scr, 0, 2048);
    }
    { const float* ks = p.in[13]; bf16_t* kd = (bf16_t*)(p.ws + WS_KEYS);
      for (int i = (blockIdx.x * NTHREADS + tid) * 4; i < 8 * 2 * 128 * 128; i += gridDim.x * NTHREADS * 4) { const f32x4 v = *(const f32x4*)(ks + i); u32x2 o; o.x = pk2(v[0], v[1]); o.y = pk2(v[2], v[3]); *(u32x2*)(kd + i) = o; } }
}

__device__ __forceinline__ void phase_norm_rows(const float* src, const float* gain, const float* shift, const float* scale, bf16_t* dst, int pitch) {
    const int tid = threadIdx.x, wave = tid >> 6, lane = tid & 63;
    const int gw = blockIdx.x * NWAVES + wave, NGW = gridDim.x * NWAVES;
    for (int row = gw; row < T; row += NGW) {
        const int b = row >> 11; const f32x4* xr = (const f32x4*)(src + (size_t)row * D) + lane;
        f32x4 v[8]; float ss = 0.f;
#pragma unroll
        for (int j = 0; j < 8; ++j) { v[j] = xr[64 * j]; ss += (v[j][0] * v[j][0] + v[j][1] * v[j][1]) + (v[j][2] * v[j][2] + v[j][3] * v[j][3]); }
        const float rstd = rsqrtf(wave_sum(ss) * (1.f / D) + NORM_EPS);
        u32x2* o8 = (u32x2*)(dst + (size_t)row * pitch) + lane;
#pragma unroll
        for (int j = 0; j < 8; ++j) { const int col = 4 * (lane + 64 * j);
            const f32x4 g = *(const f32x4*)(gain + col), sh = *(const f32x4*)(shift + (size_t)b * NADA + col), sc = *(const f32x4*)(scale + (size_t)b * NADA + col);
            f32x4 h;
#pragma unroll
            for (int e = 0; e < 4; ++e) h[e] = v[j][e] * rstd * g[e] * (1.f + sc[e]) + sh[e];
            u32x2 w; w.x = pk2(h[0], h[1]); w.y = pk2(h[2], h[3]); o8[64 * j] = w; }
    }
}

__device__ __forceinline__ void phase_vt(const Params& p, unsigned char* lds, int vb, int vG) {
    const int tid = threadIdx.x, wave = tid >> 6, lane = tid & 63;
    bf16_t* tile = (bf16_t*)(lds + wave * 16384);
    const bf16_t* P = (const bf16_t*)(p.ws + WS_P); bf16_t* VT = (bf16_t*)(p.ws + WS_VT);
    const int gw = vb * NWAVES + wave, NGW = vG * NWAVES;
    for (int it = gw; it < 8 * 8 * 32 * 2; it += NGW) {
        const int dh = it & 1, kt = (it >> 1) & 31, h = (it >> 6) & 7, b = it >> 9;
        const int k0 = kt * 64, d0 = dh * 64;
#pragma unroll
        for (int i = 0; i < 8; ++i) { const int key = i * 8 + (lane >> 3), dc = lane & 7;
            const u32x4 v = *(const u32x4*)(P + (size_t)(b * SEQ + k0 + key) * NP + C_VA + h * 128 + d0 + dc * 8);
            bf16_t* t = tile + (dc * 8) * 72 + key;
            t[0 * 72] = (bf16_t)(v.x & 0xffff); t[1 * 72] = (bf16_t)(v.x >> 16); t[2 * 72] = (bf16_t)(v.y & 0xffff); t[3 * 72] = (bf16_t)(v.y >> 16);
            t[4 * 72] = (bf16_t)(v.z & 0xffff); t[5 * 72] = (bf16_t)(v.z >> 16); t[6 * 72] = (bf16_t)(v.w & 0xffff); t[7 * 72] = (bf16_t)(v.w >> 16); }
        LDS_WAIT();
#pragma unroll
        for (int i = 0; i < 8; ++i) { const int d = i * 8 + (lane >> 3), kc = lane & 7;
            const u32x4 v = *(const u32x4*)(tile + d * 72 + kc * 8);
            *(u32x4*)(VT + ((size_t)((b * 8 + h) * 128 + d0 + d)) * SEQ + k0 + kc * 8) = v; }
        LDS_WAIT();
    }
}

__device__ __forceinline__ unsigned ord_key(float s) { const unsigned u = __float_as_uint(s); return (u & 0x80000000u) ? ~u : (u | 0x80000000u); }
__device__ __forceinline__ int half_sum(int v) {
    v += __builtin_amdgcn_update_dpp(0, v, 0xB1, 0xF, 0xF, true);
    v += __builtin_amdgcn_update_dpp(0, v, 0x4E, 0xF, 0xF, true);
    v += __builtin_amdgcn_update_dpp(0, v, 0x141, 0xF, 0xF, true);
    v += __builtin_amdgcn_update_dpp(0, v, 0x140, 0xF, 0xF, true);
    v += __shfl_xor(v, 16);
    return v;
}
constexpr int IX_RS = 72, IX_STAGE = 32 * IX_RS * 2;
__device__ __forceinline__ void indexer_item(const Params& p, unsigned char* lds, int b, int c, int grp) {
    const int tid = threadIdx.x, w = __builtin_amdgcn_readfirstlane(tid >> 6), lane = tid & 63, r = lane & 31, hh = lane >> 5;
    const bf16_t* P = (const bf16_t*)(p.ws + WS_P); unsigned* MASK = (unsigned*)(p.ws + WS_MASK);
    const int pair = grp * 8 + w, q0 = b * SEQ + c * 64 + 2 * pair;
    bf16x8 af[4];
    { const int query = q0 + ((r >> 2) & 1), head = (r & 3) + 4 * (r >> 3);
      const bf16_t* qp = P + (size_t)query * NP + C_QI + head * 64 + 8 * hh;
#pragma unroll
      for (int ks = 0; ks < 4; ++ks) af[ks] = *(const bf16x8*)(qp + ks * 16); }
    float wv[16];
    { const u32x4 w0 = *(const u32x4*)(P + (size_t)(q0 + hh) * NP + C_WI), w1 = *(const u32x4*)(P + (size_t)(q0 + hh) * NP + C_WI + 8);
      wv[0] = bflo(w0.x); wv[1] = bfhi(w0.x); wv[2] = bflo(w0.y); wv[3] = bfhi(w0.y); wv[4] = bflo(w0.z); wv[5] = bfhi(w0.z); wv[6] = bflo(w0.w); wv[7] = bfhi(w0.w);
      wv[8] = bflo(w1.x); wv[9] = bfhi(w1.x); wv[10] = bflo(w1.y); wv[11] = bfhi(w1.y); wv[12] = bflo(w1.z); wv[13] = bfhi(w1.z); wv[14] = bflo(w1.w); wv[15] = bfhi(w1.w); }
    const int nkt = 2 * (c + 1);
    const bool ldr = tid < 256;
    const bf16_t* kg = P + (size_t)(b * SEQ + ((tid >> 3) & 31)) * NP + C_KI + (tid & 7) * 8;
    const int kls = ((tid >> 3) & 31) * IX_RS * 2 + (tid & 7) * 16;
    u32x4 kr = {0u, 0u, 0u, 0u};
    __syncthreads();
    if (ldr) { *(u32x4*)(lds + kls) = *(const u32x4*)kg; *(u32x4*)(lds + IX_STAGE + kls) = *(const u32x4*)(kg + (size_t)32 * NP); }
    if (ldr && 2 < nkt) kr = *(const u32x4*)(kg + (size_t)64 * NP);
    __syncthreads();
    unsigned kv[64];
#pragma unroll
    for (int kt = 0; kt < 64; ++kt) {
        kv[kt] = 0u;
        if (kt < nkt) {
            if (ldr && kt + 2 < nkt) *(u32x4*)(lds + ((kt + 2) % 3) * IX_STAGE + kls) = kr;
            if (ldr && kt + 3 < nkt) kr = *(const u32x4*)(kg + (size_t)((kt + 3) * 32) * NP);
            const bf16_t* Ks = (const bf16_t*)(lds + (kt % 3) * IX_STAGE);
            f32x16 acc;
#pragma unroll
            for (int i = 0; i < 16; ++i) acc[i] = 0.f;
#pragma unroll
            for (int ks = 0; ks < 4; ++ks) { const bf16x8 bfr = *(const bf16x8*)(Ks + r * IX_RS + ks * 16 + 8 * hh); acc = __builtin_amdgcn_mfma_f32_32x32x16_bf16(af[ks], bfr, acc, 0, 0, 0); }
            float sc = 0.f;
#pragma unroll
            for (int i = 0; i < 16; ++i) sc += wv[i] * fmaxf(acc[i], 0.f);
            kv[kt] = ord_key(sc);
            __syncthreads();
        }
    }
    unsigned thr = 0u;
    if (nkt > 8) {
        int cur = 1 << 20;
        for (int bit = 31; bit >= 0; --bit) {
            const unsigned cand = thr | (1u << bit); int cnt = 0;
#pragma unroll
            for (int kt = 0; kt < 32; ++kt) cnt += (kv[kt] >= cand) ? 1 : 0;
            if (nkt > 32) {
#pragma unroll
                for (int kt = 32; kt < 64; ++kt) cnt += (kv[kt] >= cand) ? 1 : 0; }
            cnt = half_sum(cnt);
            if (cnt >= 256) { thr = cand; cur = cnt; }
            if (__builtin_amdgcn_ballot_w64(cur != 256) == 0ull) break;
        }
    }
    int cge = 0;
#pragma unroll
    for (int kt = 0; kt < 64; ++kt) cge += (kv[kt] >= thr && kv[kt] != 0u) ? 1 : 0;
    cge = half_sum(cge);
    const bool ties = (thr != 0u) && (cge > 256);
    unsigned m0 = 0u, m1 = 0u;
    if (__builtin_amdgcn_ballot_w64(ties) == 0ull) {
#pragma unroll
        for (int kt = 0; kt < 64; ++kt) { const unsigned long long bm = __builtin_amdgcn_ballot_w64(kv[kt] >= thr && kv[kt] != 0u);
            if (lane == kt) { m0 = (unsigned)bm; m1 = (unsigned)(bm >> 32); } }
    } else {
        int cgt = 0;
#pragma unroll
        for (int kt = 0; kt < 64; ++kt) cgt += (kv[kt] > thr) ? 1 : 0;
        cgt = half_sum(cgt);
        const int need = ties ? (256 - cgt) : (1 << 30); int run = 0;
#pragma unroll
        for (int kt = 0; kt < 64; ++kt) { const bool tie = ties && (kv[kt] == thr); const unsigned long long tb = __builtin_amdgcn_ballot_w64(tie);
            const unsigned th = hh ? (unsigned)(tb >> 32) : (unsigned)tb; const int rank = run + __builtin_popcount(th & ((1u << r) - 1u));
            const bool sel = ties ? ((kv[kt] > thr) || (tie && rank < need)) : (kv[kt] >= thr && kv[kt] != 0u);
            run += __builtin_popcount(th);
            const unsigned long long bm = __builtin_amdgcn_ballot_w64(sel);
            if (lane == kt) { m0 = (unsigned)bm; m1 = (unsigned)(bm >> 32); } }
    }
    { const int qpos = c * 64 + 2 * pair; unsigned* mt = MASK + ((size_t)(b * 64 + lane)) * SEQ + qpos; mt[0] = m0; mt[1] = m1; }
}
__device__ __forceinline__ void phase_indexer(const Params& p, unsigned char* lds, int vb, int vG) {
    const int G = vG;
    for (int rd = 0;; ++rd) {
        const int base = rd * G; if (base >= 1024) break;
        const int pos = (rd & 1) ? (G - 1 - vb) : vb; const int i = base + pos; if (i >= 1024) continue;
        indexer_item(p, lds, (i >> 2) & 7, 31 - (i >> 5), i & 3);
    }
}

#ifndef HG_REP_A
#define HG_REP_A 0
#endif
#ifndef HG_REP_B
#define HG_REP_B 0
#endif
constexpr int HG_RS = 136, HG_TS = 72, HG_SS = 136;
constexpr int HG_QT = 0, HG_QH = 17408, HG_KT = 34816, HG_KHT = 52224, HG_VT = 70656, HG_ST = 89088, HG_DEC = 123904, HG_SSQ = 124416, HG_OT = 125440;
__device__ __forceinline__ void hgrn_item(const Params& p, unsigned char* lds, int item) {
    const int tid = threadIdx.x, w = __builtin_amdgcn_readfirstlane(tid >> 6), lane = tid & 63, r = lane & 31, hh = lane >> 5;
    const int b = item >> 3, h = item & 7;
    const bf16_t* P = (const bf16_t*)(p.ws + WS_P); bf16_t* REC = (bf16_t*)((unsigned char*)p.out + OUT_REC);
    bf16_t* QT = (bf16_t*)(lds + HG_QT); bf16_t* QH = (bf16_t*)(lds + HG_QH); bf16_t* KT = (bf16_t*)(lds + HG_KT); bf16_t* KHT = (bf16_t*)(lds + HG_KHT); bf16_t* VT = (bf16_t*)(lds + HG_VT);
    bf16_t* ST = (bf16_t*)(lds + HG_ST); float* DEC = (float*)(lds + HG_DEC); float* SSQ = (float*)(lds + HG_SSQ); bf16_t* OT = (bf16_t*)(lds + HG_OT);
    const int seg = lane >> 4, dl = lane & 15, d = 16 * w + dl;
    const float lb = sigmoidf_(p.in[7][h * 128 + d] - p.in[7][1024 + h * 128 + d]);
    const int tb = w & 1, eb = w >> 1, sdb = w & 3, seb0 = 2 * (w >> 2);
    const int ot_t = tid >> 3, ot_c = tid & 7;
    float gn[16];
#pragma unroll
    for (int j = 0; j < 4; ++j) { const f32x4 g4 = *(const f32x4*)(p.in[8] + 16 * ot_c + 4 * j); gn[4 * j] = g4[0]; gn[4 * j + 1] = g4[1]; gn[4 * j + 2] = g4[2]; gn[4 * j + 3] = g4[3]; }
    f32x16 S0, S1;
#pragma unroll
    for (int i = 0; i < 16; ++i) { S0[i] = 0.f; S1[i] = 0.f; }
    __syncthreads();
    for (int i = tid; i < 128 * HG_SS / 2; i += NTHREADS) ((unsigned*)ST)[i] = 0u;
    unsigned short rq[16], rf[16], ri[16];
    { const bf16_t* src = P + (size_t)(b * SEQ + 16 * seg) * NP + h * 128 + d;
#pragma unroll
      for (int i = 0; i < 16; ++i) { rq[i] = src[(size_t)i * NP + C_QB]; rf[i] = src[(size_t)i * NP + C_FB]; ri[i] = src[(size_t)i * NP + C_IB]; } }
#pragma unroll 1
    for (int n = 0; n < 32; ++n) {
#pragma unroll 1
        for (int repa = 0; repa <= HG_REP_A; ++repa) {
            float lf[16], kk[16];
            float run = 0.f;
#pragma unroll
            for (int i = 0; i < 16; ++i) { const float f = lb + (1.f - lb) * sigmoidf_(bf2f(rf[i])); kk[i] = 1.f - f; run += __logf(f); lf[i] = run; }
            const float p0 = __shfl(run, dl), p1 = __shfl(run, 16 + dl), p2 = __shfl(run, 32 + dl), p3 = __shfl(run, 48 + dl);
            const float off = (seg > 0 ? p0 : 0.f) + (seg > 1 ? p1 : 0.f) + (seg > 2 ? p2 : 0.f), bL = (p0 + p1) + (p2 + p3), bref = p0 + p1;
            const float eref = __expf(fmaxf(bref, -80.f)), elref = __expf(fmaxf(bL - bref, -80.f));
            unsigned kh[8], vv[8];
#pragma unroll
            for (int i = 0; i < 16; ++i) { const float bt = off + lf[i]; const float qs = siluf_(bf2f(rq[i]));
                const float e1 = __expf(__builtin_amdgcn_fmed3f(bt - bref, -80.f, 80.f)), e2 = e1 * eref, e3 = __builtin_amdgcn_rcpf(e1), e4 = e3 * elref;
                const int t = 16 * seg + i;
                QT[t * HG_RS + d] = (bf16_t)f2bf(qs * e1); QH[t * HG_RS + d] = (bf16_t)f2bf(qs * e2); KT[t * HG_RS + d] = (bf16_t)f2bf(kk[i] * e3);
                const unsigned khv = f2bf(kk[i] * e4);
                if (i & 1) { kh[i >> 1] |= khv << 16; vv[i >> 1] |= (unsigned)ri[i] << 16; } else { kh[i >> 1] = khv; vv[i >> 1] = (unsigned)ri[i]; } }
            *(u32x4*)(KHT + d * HG_TS + 16 * seg) = (u32x4){kh[0], kh[1], kh[2], kh[3]}; *(u32x4*)(KHT + d * HG_TS + 16 * seg + 8) = (u32x4){kh[4], kh[5], kh[6], kh[7]};
            *(u32x4*)(VT + d * HG_TS + 16 * seg) = (u32x4){vv[0], vv[1], vv[2], vv[3]}; *(u32x4*)(VT + d * HG_TS + 16 * seg + 8) = (u32x4){vv[4], vv[5], vv[6], vv[7]};
            if (seg == 0) DEC[d] = eref * elref;
        }
        __syncthreads();
        if (n < 31) { const bf16_t* src = P + (size_t)(b * SEQ + (n + 1) * 64 + 16 * seg) * NP + h * 128 + d;
#pragma unroll
            for (int i = 0; i < 16; ++i) { rq[i] = src[(size_t)i * NP + C_QB]; rf[i] = src[(size_t)i * NP + C_FB]; ri[i] = src[(size_t)i * NP + C_IB]; } }
        const u32x4 gb0 = *(const u32x4*)(P + (size_t)(b * SEQ + n * 64 + ot_t) * NP + C_GB + h * 128 + 16 * ot_c), gb1 = *(const u32x4*)(P + (size_t)(b * SEQ + n * 64 + ot_t) * NP + C_GB + h * 128 + 16 * ot_c + 8);
        f32x16 X0, X1, o;
#pragma unroll 1
        for (int repb = 0; repb <= HG_REP_B; ++repb) {
#pragma unroll
        for (int i = 0; i < 16; ++i) { X0[i] = 0.f; X1[i] = 0.f; o[i] = 0.f; }
#pragma unroll
        for (int ks = 0; ks < 8; ++ks) { const bf16x8 bq = *(const bf16x8*)(QT + (32 * tb + r) * HG_RS + 16 * ks + 8 * hh);
            const bf16x8 a0 = *(const bf16x8*)(KT + r * HG_RS + 16 * ks + 8 * hh); X0 = __builtin_amdgcn_mfma_f32_32x32x16_bf16(a0, bq, X0, 0, 0, 0);
            if (tb == 1) { const bf16x8 a1 = *(const bf16x8*)(KT + (32 + r) * HG_RS + 16 * ks + 8 * hh); X1 = __builtin_amdgcn_mfma_f32_32x32x16_bf16(a1, bq, X1, 0, 0, 0); } }
#pragma unroll
        for (int i = 0; i < 16; ++i) { const bool keep = ((i & 3) + 8 * (i >> 2) + 4 * hh) <= r; if (tb == 0) X0[i] = keep ? X0[i] : 0.f; else X1[i] = keep ? X1[i] : 0.f; }
#pragma unroll
        for (int sb = 0; sb < 2; ++sb) { if (sb <= tb) {
#pragma unroll
            for (int s2 = 0; s2 < 2; ++s2) { u32x4 aw;
                if (sb == 0) { aw.x = pk2(X0[8 * s2], X0[8 * s2 + 1]); aw.y = pk2(X0[8 * s2 + 2], X0[8 * s2 + 3]); aw.z = pk2(X0[8 * s2 + 4], X0[8 * s2 + 5]); aw.w = pk2(X0[8 * s2 + 6], X0[8 * s2 + 7]); }
                else { aw.x = pk2(X1[8 * s2], X1[8 * s2 + 1]); aw.y = pk2(X1[8 * s2 + 2], X1[8 * s2 + 3]); aw.z = pk2(X1[8 * s2 + 4], X1[8 * s2 + 5]); aw.w = pk2(X1[8 * s2 + 6], X1[8 * s2 + 7]); }
                const bf16_t* vp = VT + (32 * eb + r) * HG_TS + 32 * sb + 16 * s2 + 4 * hh;
                const u32x2 lo = *(const u32x2*)vp, hi = *(const u32x2*)(vp + 8); const u32x4 bw = {lo.x, lo.y, hi.x, hi.y};
                o = __builtin_amdgcn_mfma_f32_32x32x16_bf16(__builtin_bit_cast(bf16x8, aw), __builtin_bit_cast(bf16x8, bw), o, 0, 0, 0); } } }
#pragma unroll
        for (int ks = 0; ks < 8; ++ks) { const bf16x8 aq = *(const bf16x8*)(QH + (32 * tb + r) * HG_RS + 16 * ks + 8 * hh), bs = *(const bf16x8*)(ST + (32 * eb + r) * HG_SS + 16 * ks + 8 * hh);
            o = __builtin_amdgcn_mfma_f32_32x32x16_bf16(aq, bs, o, 0, 0, 0); }
        { float a8[8], a4[4], a2[2], a1;
#pragma unroll
          for (int i = 0; i < 8; ++i) { const float lo = o[i] * o[i], hi = o[i + 8] * o[i + 8]; const bool up = lane & 16; const float keep = up ? hi : lo, send = up ? lo : hi; a8[i] = keep + __shfl_xor(send, 16); }
#pragma unroll
          for (int i = 0; i < 4; ++i) { const bool up = lane & 8; const float keep = up ? a8[i + 4] : a8[i], send = up ? a8[i] : a8[i + 4]; a4[i] = keep + __shfl_xor(send, 8); }
#pragma unroll
          for (int i = 0; i < 2; ++i) { const bool up = lane & 4; const float keep = up ? a4[i + 2] : a4[i], send = up ? a4[i] : a4[i + 2]; a2[i] = keep + __shfl_xor(send, 4); }
          { const bool up = lane & 2; const float keep = up ? a2[1] : a2[0], send = up ? a2[0] : a2[1]; a1 = keep + __shfl_xor(send, 2); }
          a1 += __shfl_xor(a1, 1);
          const int ri2 = (lane >> 1) & 15;
          if ((lane & 1) == 0) SSQ[(32 * tb + (ri2 & 3) + 8 * (ri2 >> 2) + 4 * hh) * 4 + eb] = a1; }
#pragma unroll
        for (int i = 0; i < 16; ++i) OT[(32 * tb + (i & 3) + 8 * (i >> 2) + 4 * hh) * HG_RS + 32 * eb + r] = (bf16_t)f2bf(o[i]);
        }
        { float dc[16];
#pragma unroll
          for (int g4 = 0; g4 < 4; ++g4) { const f32x4 dv = *(const f32x4*)(DEC + 32 * sdb + 8 * g4 + 4 * hh); dc[4 * g4] = dv[0]; dc[4 * g4 + 1] = dv[1]; dc[4 * g4 + 2] = dv[2]; dc[4 * g4 + 3] = dv[3]; }
#pragma unroll
          for (int i = 0; i < 16; ++i) { S0[i] *= dc[i]; S1[i] *= dc[i]; }
#pragma unroll
          for (int ss = 0; ss < 4; ++ss) { const bf16x8 a = *(const bf16x8*)(KHT + (32 * sdb + r) * HG_TS + 16 * ss + 8 * hh);
              const bf16x8 b0 = *(const bf16x8*)(VT + (32 * seb0 + r) * HG_TS + 16 * ss + 8 * hh), b1 = *(const bf16x8*)(VT + (32 * (seb0 + 1) + r) * HG_TS + 16 * ss + 8 * hh);
              S0 = __builtin_amdgcn_mfma_f32_32x32x16_bf16(a, b0, S0, 0, 0, 0); S1 = __builtin_amdgcn_mfma_f32_32x32x16_bf16(a, b1, S1, 0, 0, 0); } }
        __syncthreads();
#pragma unroll
        for (int g4 = 0; g4 < 4; ++g4) { const int d0 = 32 * sdb + 8 * g4 + 4 * hh;
            *(u32x2*)(ST + (32 * seb0 + r) * HG_SS + d0) = (u32x2){pk2(S0[4 * g4], S0[4 * g4 + 1]), pk2(S0[4 * g4 + 2], S0[4 * g4 + 3])};
            *(u32x2*)(ST + (32 * (seb0 + 1) + r) * HG_SS + d0) = (u32x2){pk2(S1[4 * g4], S1[4 * g4 + 1]), pk2(S1[4 * g4 + 2], S1[4 * g4 + 3])}; }
        { const f32x4 q4 = *(const f32x4*)(SSQ + ot_t * 4); const float rstd = rsqrtf(((q4[0] + q4[1]) + (q4[2] + q4[3])) * (1.f / 128.f) + NORM_EPS);
          const u32x4 o0 = *(const u32x4*)(OT + ot_t * HG_RS + 16 * ot_c), o1 = *(const u32x4*)(OT + ot_t * HG_RS + 16 * ot_c + 8);
          const unsigned ow[8] = {o0.x, o0.y, o0.z, o0.w, o1.x, o1.y, o1.z, o1.w}, gwv[8] = {gb0.x, gb0.y, gb0.z, gb0.w, gb1.x, gb1.y, gb1.z, gb1.w};
          unsigned rw[8];
#pragma unroll
          for (int j = 0; j < 8; ++j) rw[j] = pk2(bflo(ow[j]) * rstd * gn[2 * j] * siluf_(bflo(gwv[j])), bfhi(ow[j]) * rstd * gn[2 * j + 1] * siluf_(bfhi(gwv[j])));
          bf16_t* dst = REC + (size_t)(b * SEQ + n * 64 + ot_t) * 1024 + h * 128 + 16 * ot_c;
          *(u32x4*)dst = (u32x4){rw[0], rw[1], rw[2], rw[3]}; *(u32x4*)(dst + 8) = (u32x4){rw[4], rw[5], rw[6], rw[7]}; }
    }
}
__device__ __forceinline__ void phase_hgrn(const Params& p, unsigned char* lds, int vb, int vG) {
    for (int it = vb; it < 64; it += vG) hgrn_item(p, lds, it);
}

constexpr int AT_KRS = 136, AT_VRS = 36, AT_KB = 32 * AT_KRS * 2, AT_VB = 128 * AT_VRS * 2, AT_STAGE = AT_KB + AT_VB;
__device__ __forceinline__ void attn_item(const Params& p, unsigned char* lds, int b, int head, int cq) {
    const int tid = threadIdx.x, w = __builtin_amdgcn_readfirstlane(tid >> 6), lane = tid & 63, r = lane & 31, hh = lane >> 5;
    const bf16_t* P = (const bf16_t*)(p.ws + WS_P); const bf16_t* VT = (const bf16_t*)(p.ws + WS_VT); const unsigned* MASKT = (const unsigned*)(p.ws + WS_MASK);
    bf16_t* AO = (bf16_t*)((unsigned char*)p.out + OUT_AO);
    const int c = 4 * cq + (w >> 1), qpos = c * 64 + (w & 1) * 32 + r, tq = b * SEQ + qpos;
    const int nkt_w = 2 * (c + 1), nkt = 8 * (cq + 1);
    const bf16_t* kg = P + (size_t)(b * SEQ + (tid >> 4)) * NP + C_KA + head * 128 + (tid & 15) * 8;
    const bf16_t* vg = VT + (size_t)((b * 8 + head) * 128 + (tid >> 2)) * SEQ + (tid & 3) * 8;
    const int kls = (tid >> 4) * AT_KRS * 2 + (tid & 15) * 16, vls = AT_KB + (tid >> 2) * AT_VRS * 2 + (tid & 3) * 16;
    bf16x8 qf[8];
    { const bf16_t* qp = P + (size_t)tq * NP + C_QA + head * 128 + 8 * hh;
#pragma unroll
      for (int ks = 0; ks < 8; ++ks) qf[ks] = *(const bf16x8*)(qp + ks * 16); }
    f32x16 o[4];
#pragma unroll
    for (int db = 0; db < 4; ++db)
#pragma unroll
        for (int i = 0; i < 16; ++i) o[db][i] = 0.f;
    float mrun = -1e30f, lsum = 0.f;
    const float sc = 0.08838834764831845f * 1.4426950408889634f;
    __syncthreads();
    u32x4 krA, vrA, krB, vrB;
#pragma unroll
    for (int t0 = 0; t0 < 2; ++t0) { krA = *(const u32x4*)(kg + (size_t)(t0 * 32) * NP); vrA = *(const u32x4*)(vg + t0 * 32);
        *(u32x4*)(lds + t0 * AT_STAGE + kls) = krA; *(u32x2*)(lds + t0 * AT_STAGE + vls) = (u32x2){vrA.x, vrA.y}; *(u32x2*)(lds + t0 * AT_STAGE + vls + 8) = (u32x2){vrA.z, vrA.w}; }
    krA = *(const u32x4*)(kg + (size_t)(2 * 32) * NP); vrA = *(const u32x4*)(vg + 2 * 32);
    krB = *(const u32x4*)(kg + (size_t)(3 * 32) * NP); vrB = *(const u32x4*)(vg + 3 * 32);
    unsigned mwA = MASKT[(size_t)(b * 64) * SEQ + qpos], mwB = MASKT[(size_t)(b * 64 + 1) * SEQ + qpos];
    __syncthreads();
    int st = 0, st2 = 2;
#define AT_TILE(KT, KR, VR, MW) do { const int kt_ = (KT); \
        if (kt_ + 2 < nkt) { *(u32x4*)(lds + st2 * AT_STAGE + kls) = KR; *(u32x2*)(lds + st2 * AT_STAGE + vls) = (u32x2){VR.x, VR.y}; *(u32x2*)(lds + st2 * AT_STAGE + vls + 8) = (u32x2){VR.z, VR.w}; } \
        if (kt_ + 4 < nkt) { KR = *(const u32x4*)(kg + (size_t)((kt_ + 4) * 32) * NP); VR = *(const u32x4*)(vg + (kt_ + 4) * 32); } \
        if (kt_ < nkt_w) { \
            const unsigned mwc = MW; \
            if (kt_ + 2 < nkt_w) MW = MASKT[(size_t)(b * 64 + kt_ + 2) * SEQ + qpos]; \
            const bf16_t* Ks = (const bf16_t*)(lds + st * AT_STAGE); const bf16_t* Vs = (const bf16_t*)(lds + st * AT_STAGE + AT_KB); \
            f32x16 s; \
            _Pragma("unroll") for (int i = 0; i < 16; ++i) s[i] = 0.f; \
            { bf16x8 kf[8];        \
              _Pragma("unroll") for (int ks = 0; ks < 8; ++ks) kf[ks] = *(const bf16x8*)(Ks + r * AT_KRS + ks * 16 + 8 * hh); \
              __builtin_amdgcn_sched_barrier(0); \
              _Pragma("unroll") for (int ks = 0; ks < 8; ++ks) s = __builtin_amdgcn_mfma_f32_32x32x16_bf16(kf[ks], qf[ks], s, 0, 0, 0); } \
            float mx = -3e38f; const unsigned mws = mwc >> (4 * hh);        \
            _Pragma("unroll") for (int i = 0; i < 16; ++i) { const bool ok = (mws >> ((i & 3) + 8 * (i >> 2))) & 1u; s[i] = ok ? s[i] : -3e38f; mx = fmaxf(mx, s[i]); } \
            mx = fmaxf(mx, __shfl_xor(mx, 32)); \
            const float mnew = fmaxf(mrun, mx * sc), alpha = exp2f(mrun - mnew); \
            const bool grew = mnew > mrun; mrun = mnew; \
            float ps = 0.f; float pv[16]; \
            _Pragma("unroll") for (int i = 0; i < 16; ++i) { const float e = exp2f(fmaf(s[i], sc, -mnew)); pv[i] = e; ps += e; }        \
            lsum = lsum * alpha + ps; \
            if (__builtin_amdgcn_ballot_w64(grew) != 0ull) { _Pragma("unroll") for (int db = 0; db < 4; ++db) _Pragma("unroll") for (int i = 0; i < 16; ++i) o[db][i] *= alpha; } \
            bf16x8 pf[2]; \
            _Pragma("unroll") for (int s2 = 0; s2 < 2; ++s2) { u32x4 wv; wv.x = pk2(pv[8 * s2 + 0], pv[8 * s2 + 1]); wv.y = pk2(pv[8 * s2 + 2], pv[8 * s2 + 3]); wv.z = pk2(pv[8 * s2 + 4], pv[8 * s2 + 5]); wv.w = pk2(pv[8 * s2 + 6], pv[8 * s2 + 7]); pf[s2] = __builtin_bit_cast(bf16x8, wv); } \
            { u32x4 vf[4][2]; \
              _Pragma("unroll") for (int db = 0; db < 4; ++db) _Pragma("unroll") for (int s2 = 0; s2 < 2; ++s2) { const bf16_t* vp = Vs + (db * 32 + r) * AT_VRS + 16 * s2 + 4 * hh; const u32x2 lo = *(const u32x2*)vp, hi = *(const u32x2*)(vp + 8); \
                    vf[db][s2] = (u32x4){lo.x, lo.y, hi.x, hi.y}; } \
              __builtin_amdgcn_sched_barrier(0); \
              _Pragma("unroll") for (int db = 0; db < 4; ++db) _Pragma("unroll") for (int s2 = 0; s2 < 2; ++s2) o[db] = __builtin_amdgcn_mfma_f32_32x32x16_bf16(__builtin_bit_cast(bf16x8, vf[db][s2]), pf[s2], o[db], 0, 0, 0); } \
        } \
        __syncthreads(); \
        st = (st == 2) ? 0 : st + 1; st2 = (st2 == 2) ? 0 : st2 + 1; } while (0)
#pragma unroll 1
    for (int kt = 0; kt < nkt; kt += 2) { AT_TILE(kt, krA, vrA, mwA); AT_TILE(kt + 1, krB, vrB, mwB); }
#undef AT_TILE
    const float l = lsum + __shfl_xor(lsum, 32), inv = 1.f / l;
    bf16_t* op = AO + (size_t)tq * 1024 + head * 128 + 4 * hh;
#pragma unroll
    for (int db = 0; db < 4; ++db)
#pragma unroll
        for (int g4 = 0; g4 < 4; ++g4) { u32x2 wv; wv.x = pk2(o[db][4 * g4] * inv, o[db][4 * g4 + 1] * inv); wv.y = pk2(o[db][4 * g4 + 2] * inv, o[db][4 * g4 + 3] * inv);
            *(u32x2*)(op + db * 32 + 8 * g4) = wv; }
}
__device__ __forceinline__ void phase_attn(const Params& p, unsigned char* lds, int vb, int vG) {
    const int G = vG;
    for (int rd = 0;; ++rd) {
        const int base = rd * G; if (base >= 512) break;
        const int pos = (rd & 1) ? (G - 1 - vb) : vb; const int i = base + pos; if (i >= 512) continue;
        attn_item(p, lds, (i >> 3) & 7, i & 7, 7 - (i >> 6));
    }
}
__device__ __forceinline__ void phase_attn_queue(const Params& p, unsigned char* lds, unsigned* qhead) {
    volatile LAS int* slot = (volatile LAS int*)((LAS unsigned char*)lds + LDS_BYTES - 32);
    for (;;) {
        __syncthreads();
        if (threadIdx.x == 0) slot[0] = (int)__hip_atomic_fetch_add(qhead, 1u, __ATOMIC_RELAXED, __HIP_MEMORY_SCOPE_AGENT);
        __syncthreads();
        const int i = slot[0]; if (i >= 512) break;
        attn_item(p, lds, (i >> 3) & 7, i & 7, 7 - (i >> 6));
    }
}
__device__ __forceinline__ void phase_uv(const Params& p) {
    const int tid = threadIdx.x, wave = tid >> 6, lane = tid & 63;
    const int gw = blockIdx.x * NWAVES + wave, NGW = gridDim.x * NWAVES;
    for (int it = gw; it < 2 * 16384; it += NGW) {
        const int tbl = it >> 14, row = it & 16383;
        const float* src = (tbl ? p.in[15] : p.in[14]) + (size_t)row * 2048 + 32 * lane;
        unsigned char* dst = p.ws + (tbl ? WS_V8 : WS_U8); float* isc = (float*)(p.ws + (tbl ? WS_ISV : WS_ISU));
        f32x4 v[8]; float am = 0.f;
#pragma unroll
        for (int j = 0; j < 8; ++j) { v[j] = *(const f32x4*)(src + 4 * j); am = fmaxf(am, fmaxf(fmaxf(fabsf(v[j][0]), fabsf(v[j][1])), fmaxf(fabsf(v[j][2]), fabsf(v[j][3])))); }
#pragma unroll
        for (int o = 1; o < 64; o <<= 1) am = fmaxf(am, __shfl_xor(am, o));
        am = fmaxf(am, 1e-30f); const float sc = 256.f / am;
        unsigned wq[8];
#pragma unroll
        for (int j = 0; j < 8; ++j) { int pk = 0; pk = __builtin_amdgcn_cvt_pk_fp8_f32(v[j][0] * sc, v[j][1] * sc, pk, false); pk = __builtin_amdgcn_cvt_pk_fp8_f32(v[j][2] * sc, v[j][3] * sc, pk, true); wq[j] = (unsigned)pk; }
        unsigned char* d = dst + (size_t)(lane >> 2) * (2u << 20) + (size_t)row * 128 + (lane & 3) * 32;
        *(u32x4*)d = (u32x4){wq[0], wq[1], wq[2], wq[3]}; *(u32x4*)(d + 16) = (u32x4){wq[4], wq[5], wq[6], wq[7]};
        if (lane == 0) isc[row] = am * (1.f / 256.f);
    }
}

#define INS16(v, x) do { _Pragma("unroll") for (int _j = 15; _j >= 1; --_j) v[_j] = __builtin_amdgcn_fmed3f(v[_j - 1], v[_j], (x)); v[0] = fmaxf(v[0], (x)); } while (0)
__device__ __forceinline__ void peer_half_top16(const bf16_t* QP, const bf16_t* kb0  , int pitch, int tok, int p, int hf, int r, int hh, float (&v)[16]) {
    bf16x8 qf[8];
    { const bf16_t* qp = QP + (size_t)tok * D + p * 256 + hf * 128 + 8 * hh;
#pragma unroll
      for (int ks = 0; ks < 8; ++ks) qf[ks] = *(const bf16x8*)(qp + ks * 16); }
#pragma unroll
    for (int k = 0; k < 16; ++k) v[k] = -3.0e38f;
    const bf16_t* kb = kb0 + r * pitch + 8 * hh;
#pragma unroll 1
    for (int nb = 0; nb < 4; ++nb) {
        f32x16 acc;
#pragma unroll
        for (int i = 0; i < 16; ++i) acc[i] = 0.f;
#pragma unroll
        for (int ks = 0; ks < 8; ++ks) { const bf16x8 kf = *(const bf16x8*)(kb + (nb * 32) * pitch + ks * 16); acc = __builtin_amdgcn_mfma_f32_32x32x16_bf16(kf, qf[ks], acc, 0, 0, 0); }
#pragma unroll
        for (int i = 0; i < 16; ++i) { const unsigned xi = (unsigned)(nb * 32 + (i & 3) + 8 * (i >> 2) + 4 * hh); const float x = __uint_as_float((__float_as_uint(acc[i]) & ~0x7fu) | xi); INS16(v, x); }
    }
    float ov[16];
#pragma unroll
    for (int k = 0; k < 16; ++k) ov[k] = __shfl_xor(v[k], 32);
#pragma unroll
    for (int k = 0; k < 16; ++k) INS16(v, ov[k]);
}
constexpr int PK_RS = 136;
#define GAS __attribute__((address_space(1)))
__device__ __attribute__((noinline)) void phase_peer_topk_ni(const GAS bf16_t* QPg, const GAS bf16_t* KEYSg, GAS int* EIDXg, GAS float* EGATEg, LAS unsigned char* ldsl) {
    const bf16_t* QP = (const bf16_t*)QPg; const bf16_t* KEYS = (const bf16_t*)KEYSg; int* EIDX = (int*)EIDXg; float* EGATE = (float*)EGATEg; unsigned char* lds = (unsigned char*)ldsl;
    const int tid = threadIdx.x, wave = __builtin_amdgcn_readfirstlane(tid >> 6), lane = tid & 63, r = lane & 31, hh = lane >> 5;
    bf16_t* KL = (bf16_t*)lds;
    const int G = gridDim.x, hd = blockIdx.x & 7;
    __syncthreads();
    for (int i = tid; i < 2 * 128 * 16; i += NTHREADS) { const int row = i >> 4, ch = i & 15;
        *(u32x4*)(KL + row * PK_RS + ch * 8) = *(const u32x4*)(KEYS + (size_t)(hd * 256 + row) * 128 + ch * 8); }
    __syncthreads();
    for (int tile = blockIdx.x >> 3; tile < 64; tile += (G + 7) / 8) {
        const int tok = tile * 256 + wave * 32 + r;
        float va[16], vb[16];
        peer_half_top16(QP, KL, PK_RS, tok, hd, 0, r, hh, va);
        peer_half_top16(QP, KL + 128 * PK_RS, PK_RS, tok, hd, 1, r, hh, vb);
        float bv[16];
#pragma unroll
        for (int k = 0; k < 16; ++k) bv[k] = -3.0e38f;
#pragma unroll
        for (int a = 0; a < 16; ++a)
#pragma unroll
            for (int b2 = 0; b2 < 16; ++b2) if ((a + 1) * (b2 + 1) <= 16) { const float x = va[a] + vb[b2]; INS16(bv, x); }
        float se = 0.f;
#pragma unroll
        for (int k = 0; k < 16; ++k) se += __expf(bv[k] - bv[0]);
        const float inv = 1.f / se, thr = bv[15], top = bv[0];
        int cnt = 0; int* ei = EIDX + (size_t)tok * 128 + hd * 16; float* eg = EGATE + (size_t)tok * 128 + hd * 16;
#pragma unroll
        for (int a = 0; a < 16; ++a)
#pragma unroll
            for (int b2 = 0; b2 < 16; ++b2) if ((a + 1) * (b2 + 1) <= 16) { const float x = va[a] + vb[b2];
                if (x >= thr && cnt < 16) { if (hh == 0) { ei[cnt] = (int)((__float_as_uint(va[a]) & 0x7fu) * 128u + (__float_as_uint(vb[b2]) & 0x7fu)); eg[cnt] = __expf(x - top) * inv; } ++cnt; } }
    }
}

typedef __bf16 bf16x2_t __attribute__((ext_vector_type(2)));
__device__ __forceinline__ float gelu_erf(float v) {
    const float av = fabsf(v), d = av * 0.2316418882f + 1.0f, t = __builtin_amdgcn_rcpf(d);
    float q = t * 0.5307027145f + (-0.7265760135f); q = q * t + 0.7107068705f; q = q * t + (-0.142248368f); q = q * t + 0.127414796f; q = q * t;
    const float e = __builtin_amdgcn_exp2f((v * v) * (-0.72134752044f));
    const float m = v * (q * e), r = v - m;
    return v < 0.f ? m : r;
}
__device__ __forceinline__ float dot2bf(unsigned a, unsigned b, float c) { return __builtin_amdgcn_fdot2_f32_bf16(__builtin_bit_cast(bf16x2_t, a), __builtin_bit_cast(bf16x2_t, b), c, false); }
__device__ __forceinline__ float dpp_f(float x, int ctrl_xor1_xor2_mirror) {
    const int v = __float_as_int(x);
    if (ctrl_xor1_xor2_mirror == 0) return __int_as_float(__builtin_amdgcn_update_dpp(0, v, 0xB1, 0xF, 0xF, true));
    if (ctrl_xor1_xor2_mirror == 1) return __int_as_float(__builtin_amdgcn_update_dpp(0, v, 0x4E, 0xF, 0xF, true));
    return __int_as_float(__builtin_amdgcn_update_dpp(0, v, 0x141, 0xF, 0xF, true));
}
typedef float f32x2v __attribute__((ext_vector_type(2)));
__device__ __forceinline__ void unpack8(const u32x4 w, float* f) { f[0] = bflo(w.x); f[1] = bfhi(w.x); f[2] = bflo(w.y); f[3] = bfhi(w.y); f[4] = bflo(w.z); f[5] = bfhi(w.z); f[6] = bflo(w.w); f[7] = bfhi(w.w); }
__device__ __forceinline__ void cvt16(const u32x4 w, float* f) {
#pragma unroll
    for (int q = 0; q < 4; ++q) { const f32x2v lo = __builtin_amdgcn_cvt_pk_f32_fp8((int)w[q], false), hi = __builtin_amdgcn_cvt_pk_f32_fp8((int)w[q], true);
        f[4 * q] = lo.x; f[4 * q + 1] = lo.y; f[4 * q + 2] = hi.x; f[4 * q + 3] = hi.y; }
}
__device__ __forceinline__ void phase_experts(const Params& p, unsigned char* lds) {
    const int tid = threadIdx.x, wave = __builtin_amdgcn_readfirstlane(tid >> 6), lane = tid & 63, rr = lane >> 3, cc = lane & 7; const bool odd = cc & 1;
    const bf16_t* H2 = (const bf16_t*)(p.ws + WS_H2); const unsigned char* U8 = p.ws + WS_U8; const unsigned char* V8 = p.ws + WS_V8;
    const float* ISU = (const float*)(p.ws + WS_ISU); const float* ISV = (const float*)(p.ws + WS_ISV);
    const int* EIDX = (const int*)(p.ws + WS_EIDX); const float* EGATE = (const float*)(p.ws + WS_EGATE);
    const float* mod = (const float*)(p.ws + WS_MOD); const float* fin = p.in[16]; float* out = p.out; const float* X1 = (const float*)(p.ws + WS_X1);
    unsigned* offs = (unsigned*)lds; float* gts = (float*)(lds + 32768); float* rstl = (float*)(lds + 65536);
    const unsigned xcc = (unsigned)__builtin_amdgcn_s_getreg((3 << 11) | 20) & 7u; const unsigned cc16 = cc * 16;
    for (int tile = blockIdx.x; tile < T / 64; tile += gridDim.x) {
        const int tok0 = tile * 64, b = tok0 >> 11;
        __syncthreads();
        for (int i = tid; i < 8192; i += NTHREADS) { const int tl = i >> 7, j = i & 127, g = j >> 3, r8 = j & 7;
            offs[(tl * 8 + r8) * 16 + g] = (unsigned)EIDX[(size_t)tok0 * 128 + i] * 128u; gts[(tl * 8 + r8) * 16 + g] = EGATE[(size_t)tok0 * 128 + i]; }
        __syncthreads();
#pragma unroll 1
        for (int half = 0; half < 2; ++half) {
            const int tlb = wave * 8 + half * 4;
            u32x4 dA[16], dB[16], hA0, hA1, hB0, hB1;
#ifndef EXP_REP_U
#define EXP_REP_U 0
#endif
#ifndef EXP_REP_V
#define EXP_REP_V 0
#endif
#define EX_SLICE(i_) ((xcc * 2u + (unsigned)(i_)) & 15u)
#define EX_LOAD(buf, TBL, i_, k_) do { const unsigned char* tb_ = (TBL) + (size_t)EX_SLICE(i_) * (2u << 20); u32x4 o4_[4]; \
    _Pragma("unroll") for (int q_ = 0; q_ < 4; ++q_) o4_[q_] = *(const u32x4*)(offs + ((tlb + (k_)) * 8 + rr) * 16 + 4 * q_); \
    _Pragma("unroll") for (int g_ = 0; g_ < 16; ++g_) buf[g_] = *(const u32x4*)(tb_ + (o4_[g_ >> 2][g_ & 3] + cc16)); } while (0)
#define EX_LOADH(h0, h1, i_, k_) do { const bf16_t* hp_ = H2 + (size_t)(tok0 + tlb + (k_)) * D + EX_SLICE(i_) * 128 + cc * 16; h0 = *(const u32x4*)hp_; h1 = *(const u32x4*)(hp_ + 8); } while (0)
#define EX_DOT16(acc, WSRC, hf) do { u32x4 w_ = WSRC; asm volatile("" : "+v"(w_.x), "+v"(w_.y), "+v"(w_.z), "+v"(w_.w), "+v"(ch_)); f32x2v a2_; \
    _Pragma("unroll") for (int q_ = 0; q_ < 4; ++q_) { const f32x2v lo_ = __builtin_amdgcn_cvt_pk_f32_fp8((int)w_[q_], false), hi_ = __builtin_amdgcn_cvt_pk_f32_fp8((int)w_[q_], true); \
        f32x2v h0_, h1_; h0_.x = hf[4 * q_]; h0_.y = hf[4 * q_ + 1]; h1_.x = hf[4 * q_ + 2]; h1_.y = hf[4 * q_ + 3]; \
        if (q_ == 0) a2_ = lo_ * h0_; else a2_ = __builtin_elementwise_fma(lo_, h0_, a2_); a2_ = __builtin_elementwise_fma(hi_, h1_, a2_); } \
    acc = a2_.x + a2_.y; ch_ = acc; } while (0)
#define EX_UCOMP(buf, h0, h1, k_) do { float hf_[16]; unpack8(h0, hf_); unpack8(h1, hf_ + 8); float ch_ = 0.f; \
    _Pragma("unroll") for (int j_ = 0; j_ < 8; ++j_) { float te_ = 0.f, to_ = 0.f; EX_DOT16(te_, buf[2 * j_], hf_); __builtin_amdgcn_sched_barrier(0); EX_DOT16(to_, buf[2 * j_ + 1], hf_); \
    const float my_ = odd ? to_ : te_, ot_ = odd ? te_ : to_; zp[k_][j_] += my_ + dpp_f(ot_, 0); asm volatile("" : "+v"(zp[k_][j_])); __builtin_amdgcn_sched_barrier(0); } } while (0)
#define SB() __builtin_amdgcn_sched_barrier(0)
            float zp[4][8];
#pragma unroll
            for (int k = 0; k < 4; ++k)
#pragma unroll
                for (int j = 0; j < 8; ++j) zp[k][j] = 0.f;
            EX_LOADH(hA0, hA1, 0, 0); EX_LOAD(dA, U8, 0, 0); SB();
#pragma unroll 1
            for (int i = 0; i < 16 * (1 + EXP_REP_U); ++i) {
                __builtin_amdgcn_s_barrier();
                EX_LOADH(hB0, hB1, i, 1); EX_LOAD(dB, U8, i, 1); SB(); EX_UCOMP(dA, hA0, hA1, 0); SB();
                EX_LOADH(hA0, hA1, i, 2); EX_LOAD(dA, U8, i, 2); SB(); EX_UCOMP(dB, hB0, hB1, 1); SB();
                EX_LOADH(hB0, hB1, i, 3); EX_LOAD(dB, U8, i, 3); SB(); EX_UCOMP(dA, hA0, hA1, 2); SB();
                if (i < 16 * (1 + EXP_REP_U) - 1) { EX_LOADH(hA0, hA1, i + 1, 0); EX_LOAD(dA, U8, i + 1, 0); } SB(); EX_UCOMP(dB, hB0, hB1, 3); SB();
            }
            if (EXP_REP_U) {
#pragma unroll
                for (int k = 0; k < 4; ++k)
#pragma unroll
                    for (int j = 0; j < 8; ++j) zp[k][j] *= 0.5f; }
            unsigned* apl = (unsigned*)(lds + 66560);
#pragma unroll
            for (int k = 0; k < 4; ++k)
#pragma unroll
                for (int j = 0; j < 8; ++j) { float z = zp[k][j]; z += dpp_f(z, 1); z += __shfl_xor(z, 4);
                    const int li = ((tlb + k) * 8 + rr) * 16 + 2 * j + (odd ? 1 : 0); const unsigned eid = offs[li] >> 7;
                    const float act = gelu_erf(z * ISU[eid]) * gts[li] * ISV[eid]; const float oth = dpp_f(act, 0);
                    apl[((tlb + k) * 8 + rr) * 8 + j] = f2bf(odd ? oth : act) | (f2bf(odd ? act : oth) << 16); }
            LDS_WAIT();
            float ssq[4] = {0.f, 0.f, 0.f, 0.f};
#define EX_VCOMP(buf, i_, k_) do { float oa_[16]; _Pragma("unroll") for (int e_ = 0; e_ < 16; ++e_) oa_[e_] = 0.f; \
    const int col_ = (int)EX_SLICE(i_) * 128 + cc * 16 + 2 * rr; const size_t xo_ = (size_t)(tok0 + tlb + (k_)) * D + col_; \
    const f32x2v x1_ = *(const f32x2v*)(X1 + xo_), g2_ = *(const f32x2v*)(mod + (size_t)b * NADA + 5 * 2048 + col_); \
    const u32x4 ap0_ = *(const u32x4*)(apl + ((tlb + (k_)) * 8 + rr) * 8), ap1_ = *(const u32x4*)(apl + ((tlb + (k_)) * 8 + rr) * 8 + 4); \
    _Pragma("unroll") for (int j_ = 0; j_ < 8; ++j_) { const unsigned pr_ = (j_ < 4) ? ap0_[j_ & 3] : ap1_[j_ & 3]; const float a0_ = bflo(pr_), a1_ = bfhi(pr_); \
        { u32x4 w_ = buf[2 * j_]; asm volatile("" : "+v"(w_.x), "+v"(w_.y), "+v"(w_.z), "+v"(w_.w), "+v"(oa_[0])); float f_[16]; cvt16(w_, f_); _Pragma("unroll") for (int e_ = 0; e_ < 16; ++e_) oa_[e_] = fmaf(a0_, f_[e_], oa_[e_]); } \
        { u32x4 w_ = buf[2 * j_ + 1]; asm volatile("" : "+v"(w_.x), "+v"(w_.y), "+v"(w_.z), "+v"(w_.w), "+v"(oa_[0])); float f_[16]; cvt16(w_, f_); _Pragma("unroll") for (int e_ = 0; e_ < 16; ++e_) oa_[e_] = fmaf(a1_, f_[e_], oa_[e_]); } } \
      \
    float b8_[8], b4_[4], b2_[2]; \
    _Pragma("unroll") for (int e_ = 0; e_ < 8; ++e_) { const bool up_ = lane & 32; const float kp_ = up_ ? oa_[e_ + 8] : oa_[e_], sd_ = up_ ? oa_[e_] : oa_[e_ + 8]; b8_[e_] = kp_ + __shfl_xor(sd_, 32); } \
    _Pragma("unroll") for (int e_ = 0; e_ < 4; ++e_) { const bool up_ = lane & 16; const float kp_ = up_ ? b8_[e_ + 4] : b8_[e_], sd_ = up_ ? b8_[e_] : b8_[e_ + 4]; b4_[e_] = kp_ + __shfl_xor(sd_, 16); } \
    _Pragma("unroll") for (int e_ = 0; e_ < 2; ++e_) { const bool up_ = lane & 8; const float kp_ = up_ ? b4_[e_ + 2] : b4_[e_], sd_ = up_ ? b4_[e_] : b4_[e_ + 2]; b2_[e_] = kp_ + __shfl_xor(sd_, 8); } \
    f32x2v y_; y_.x = x1_.x + g2_.x * b2_[0]; y_.y = x1_.y + g2_.y * b2_[1]; *(f32x2v*)(out + xo_) = y_; ssq[k_] = fmaf(y_.x, y_.x, fmaf(y_.y, y_.y, ssq[k_])); asm volatile("" : "+v"(ssq[k_])); } while (0)
#pragma unroll 1
            for (int i = 0; i < 16 * (1 + EXP_REP_V); ++i) {
                if (EXP_REP_V && i == 16) { ssq[0] = 0.f; ssq[1] = 0.f; ssq[2] = 0.f; ssq[3] = 0.f; }
                __builtin_amdgcn_s_barrier();
                EX_LOAD(dA, V8, i, 0); SB(); EX_VCOMP(dA, i, 0); SB();
                EX_LOAD(dA, V8, i, 1); SB(); EX_VCOMP(dA, i, 1); SB();
                EX_LOAD(dA, V8, i, 2); SB(); EX_VCOMP(dA, i, 2); SB();
                EX_LOAD(dA, V8, i, 3); SB(); EX_VCOMP(dA, i, 3); SB();
            }
#pragma unroll
            for (int k = 0; k < 4; ++k) { const float tot = wave_sum(ssq[k]); rstl[wave * 8 + half * 4 + k] = rsqrtf(tot * (1.f / D) + NORM_EPS); }
        }
#undef EX_SLICE
#undef EX_LOAD
#undef EX_LOADH
#undef EX_DOT16
#undef EX_UCOMP
#undef EX_VCOMP
#undef SB
        __builtin_amdgcn_fence(__ATOMIC_RELEASE, "agent"); __builtin_amdgcn_fence(__ATOMIC_ACQUIRE, "agent");
        LDS_WAIT();
        int lane2 = (int)__builtin_amdgcn_mbcnt_hi(~0u, __builtin_amdgcn_mbcnt_lo(~0u, 0u)); asm volatile("" : "+v"(lane2));
#pragma unroll 1
        for (int k = 0; k < 8; ++k) { float* xr = out + (size_t)(tok0 + wave * 8 + k) * D; const float rs = rstl[wave * 8 + k];
#pragma unroll
            for (int j = 0; j < 8; ++j) { const int col = 4 * (lane2 + 64 * j); const f32x4 v = *(const f32x4*)(xr + col), f = *(const f32x4*)(fin + col);
                f32x4 o; o[0] = v[0] * rs * f[0]; o[1] = v[1] * rs * f[1]; o[2] = v[2] * rs * f[2]; o[3] = v[3] * rs * f[3]; *(f32x4*)(xr + col) = o; } }
    }
}

#define XB_TMO      128
#define XB_XCNT(j)  (256  + 64 * (j))
#define XB_XSUB(j)  (1280 + 64 * (j))
#define XB_XGEN(j)  (2304 + 64 * (j))
#define XB_TOP      3328
#define XB_TOPGEN   3392
#define XCD_BAR_WORDS 3456
#define XB_SPIN_CAP (1u << 22)
__device__ __forceinline__ unsigned xb_ld(unsigned* p)              { return __hip_atomic_load(p, __ATOMIC_RELAXED, __HIP_MEMORY_SCOPE_AGENT); }
__device__ __forceinline__ unsigned xb_add(unsigned* p, unsigned v) { return __hip_atomic_fetch_add(p, v, __ATOMIC_RELAXED, __HIP_MEMORY_SCOPE_AGENT); }
__device__ __forceinline__ unsigned xb_xcc_id() { return (unsigned)__builtin_amdgcn_s_getreg((3 << 11) | 20) & 0xFu; }
#define XB_SPIN(cond, bar) do { unsigned _sp = 0; while (cond) { __builtin_amdgcn_s_sleep(1); \
    if ((++_sp & 255u) == 0u) { if (xb_ld(&(bar)[XB_TMO])) break; if (_sp > XB_SPIN_CAP) { atomicAdd(&(bar)[XB_TMO], 1u); break; } } } } while (0)
struct XcdBarrier { unsigned* bar; unsigned x; volatile LAS unsigned* st; };
__device__ __forceinline__ XcdBarrier xcd_barrier_post(unsigned* bar, volatile LAS unsigned* st) {
    XcdBarrier b; b.bar = bar; b.x = xb_xcc_id(); b.st = st;
    if (threadIdx.x == 0) (void)xb_add(&bar[XB_XCNT(b.x)], 1u);
    return b;
}
__device__ __forceinline__ void xcd_barrier_complete(unsigned* bar, unsigned x, unsigned& nloc, unsigned& nx) {
    const unsigned G = gridDim.x * gridDim.y * gridDim.z;
    unsigned sum, cnt, mine, sp = 0u;
    for (;;) {
        sum = 0u; cnt = 0u; mine = 0u;
#pragma unroll
        for (unsigned j = 0; j < 16; ++j) { const unsigned c = xb_ld(&bar[XB_XCNT(j)]); sum += c; cnt += (c > 0u) ? 1u : 0u; mine = (j == x) ? c : mine; }
        if (sum == G) break;
        __builtin_amdgcn_s_sleep(1);
        if ((++sp & 255u) == 0u) { if (xb_ld(&bar[XB_TMO])) break; if (sp > XB_SPIN_CAP) { atomicAdd(&bar[XB_TMO], 1u); break; } }
    }
    nloc = mine > 0u ? mine : 1u; nx = cnt > 0u ? cnt : 1u;
}
__device__ __forceinline__ void xcd_barrier(const XcdBarrier& b) {
    asm volatile("s_waitcnt vmcnt(0)" ::: "memory");
    __syncthreads();
    if (threadIdx.x == 0) {
        unsigned* bar = b.bar;
        __builtin_amdgcn_s_waitcnt(0);
        unsigned nloc = b.st[0], nx = b.st[1];
        if (nloc == 0u) { xcd_barrier_complete(bar, b.x, nloc, nx); b.st[0] = nloc; b.st[1] = nx; }
        const unsigned old = xb_add(&bar[XB_XSUB(b.x)], 1u);
        const unsigned gen = old / nloc;
        if (old + 1u == (gen + 1u) * nloc) {
            __builtin_amdgcn_fence(__ATOMIC_RELEASE, "agent");
            asm volatile("s_waitcnt vmcnt(0)" ::: "memory");
            const unsigned og = xb_add(&bar[XB_TOP], 1u);
            const unsigned tg = og / nx;
            if (og + 1u == (tg + 1u) * nx) xb_add(&bar[XB_TOPGEN], 1u);
            else XB_SPIN(xb_ld(&bar[XB_TOPGEN]) == tg, bar);
            __builtin_amdgcn_fence(__ATOMIC_ACQUIRE, "agent");
            xb_add(&bar[XB_XGEN(b.x)], 1u);
            asm volatile("s_waitcnt vmcnt(0)" ::: "memory");
        } else {
            XB_SPIN(xb_ld(&bar[XB_XGEN(b.x)]) == gen, bar);
            __builtin_amdgcn_fence(__ATOMIC_ACQUIRE, "agent");
            asm volatile("s_waitcnt vmcnt(0)" ::: "memory");
        }
    }
    __syncthreads();
}

__device__ __forceinline__ void subset_barrier(unsigned* cnt, unsigned n) {
    asm volatile("s_waitcnt vmcnt(0)" ::: "memory");
    __syncthreads();
    if (threadIdx.x == 0) {
        __builtin_amdgcn_fence(__ATOMIC_RELEASE, "agent");
        asm volatile("s_waitcnt vmcnt(0)" ::: "memory");
        __hip_atomic_fetch_add(cnt, 1u, __ATOMIC_RELAXED, __HIP_MEMORY_SCOPE_AGENT);
        unsigned sp = 0;
        while (__hip_atomic_load(cnt, __ATOMIC_RELAXED, __HIP_MEMORY_SCOPE_AGENT) < n) { __builtin_amdgcn_s_sleep(1); if (++sp > (1u << 24)) break; }
        __builtin_amdgcn_fence(__ATOMIC_ACQUIRE, "agent");
        asm volatile("s_waitcnt vmcnt(0)" ::: "memory");
    }
    __syncthreads();
}
__device__ __forceinline__ void subset_wait(unsigned* cnt, unsigned n) {
    __syncthreads();
    if (threadIdx.x == 0) {
        unsigned sp = 0;
        while (__hip_atomic_load(cnt, __ATOMIC_RELAXED, __HIP_MEMORY_SCOPE_AGENT) < n) { __builtin_amdgcn_s_sleep(2); if (++sp > (1u << 24)) break; }
        __builtin_amdgcn_fence(__ATOMIC_ACQUIRE, "agent");
        asm volatile("s_waitcnt vmcnt(0)" ::: "memory");
    }
    __syncthreads();
}
constexpr int NPHASES = 11;
__global__ void __launch_bounds__(NTHREADS, 2) mega_fwd(Params p) {
    extern __shared__ __attribute__((aligned(16))) unsigned char lds[];
    cg::grid_group grid = cg::this_grid();
    const int lo = p.ph_lo, hi = p.ph_hi;
#ifndef PHASE_MASK
#define PHASE_MASK 0x7ff
#endif
#define IN(k) (((PHASE_MASK >> (k)) & 1) && lo <= (k) && (k) < hi)
#define SEAM(k) do { if (IN(k) && IN((k) + 1)) xcd_barrier(xbar); } while (0)
    unsigned char* ws = p.ws;
    bf16_t* P = (bf16_t*)(ws + WS_P);
    bf16_t* Hb = (bf16_t*)((unsigned char*)p.out + OUT_H);
    bf16_t* WinT = (bf16_t*)((unsigned char*)p.out + OUT_WIN);
    const float* mod = (const float*)(ws + WS_MOD);
    LAS unsigned char* ldsl = (LAS unsigned char*)lds;
    volatile LAS unsigned* xst = (volatile LAS unsigned*)(ldsl + LDS_BYTES - 64);
    if (threadIdx.x < 2) xst[threadIdx.x] = 0u;
    __syncthreads();
    XcdBarrier xbar = xcd_barrier_post((unsigned*)(ws + WS_CTL) + 4096, xst);

#ifndef REPEAT_PHASE
#define REPEAT_PHASE -1
#endif
    int rep3 = 0;
#define RUNPH(k, ...) do { if (IN(k)) { __VA_ARGS__; if (REPEAT_PHASE == (k)) { grid.sync(); __VA_ARGS__; } } } while (0)
    RUNPH(0, { phase_mod(p, lds); __syncthreads(); phase_weights(p, lds); });
    SEAM(0);
    RUNPH(1, { phase_norm_rows(p.in[0], p.in[4], mod, mod + 2048, Hb, LDP); });
    SEAM(1);
    RUNPH(2, { pg8::Gemm g{Hb, WinT, nullptr, nullptr, LDP, LDP, T, NP, D}; pg8::StaticOrder<1> S; S.init(T, NP, gridDim.x, blockIdx.x);
        pg8::EpiBf16 E{P, NP, 33}; pg8::gemm_phase(ldsl, g, S, E); });
    SEAM(2);
    RUNPH(3, { const int G = gridDim.x, bx = blockIdx.x;
        unsigned* sbar = (unsigned*)(ws + WS_CTL) + 12288 + ((REPEAT_PHASE == 3) ? 64 * rep3 : 0); unsigned* qh = sbar + 16;
        if (G >= 128) { if (bx < 64) { phase_hgrn(p, lds, bx, 64); if (REPEAT_PHASE == 32) phase_hgrn(p, lds, bx, 64); subset_wait(sbar, (unsigned)(G - 64)); phase_attn_queue(p, lds, qh); }
                        else { phase_vt(p, lds, bx - 64, G - 64); phase_indexer(p, lds, bx - 64, G - 64); if (REPEAT_PHASE == 31) phase_indexer(p, lds, bx - 64, G - 64);
                               subset_barrier(sbar, (unsigned)(G - 64)); phase_attn_queue(p, lds, qh); } }
        else { phase_vt(p, lds, bx, G); phase_indexer(p, lds, bx, G); __syncthreads(); phase_hgrn(p, lds, bx, G); grid.sync(); phase_attn(p, lds, bx, G); }
        ++rep3; });
    SEAM(3);
    RUNPH(5, { pg8::Gemm g{(const bf16_t*)((unsigned char*)p.out + OUT_AO), (const bf16_t*)(ws + WS_WUA), (const bf16_t*)((unsigned char*)p.out + OUT_REC), (const bf16_t*)(ws + WS_WUB), 1024, 1024, T, D, 1024}; pg8::StaticOrder<2> S; S.init(T, D, gridDim.x, blockIdx.x);
        pg8::EpiMix E{(bf16_t*)(ws + WS_MIXED), P}; pg8::gemm_phase(ldsl, g, S, E); });
    SEAM(5);
    RUNPH(6, { pg8::Gemm g{(const bf16_t*)(ws + WS_MIXED), (const bf16_t*)(ws + WS_WOUT), nullptr, nullptr, D, D, T, D, D}; pg8::StaticOrder<1> S; S.init(T, D, gridDim.x, blockIdx.x);
        pg8::EpiX1 E{p.in[0], (float*)(ws + WS_X1), mod + 4096}; pg8::gemm_phase(ldsl, g, S, E); });
    SEAM(6);
    RUNPH(7, { phase_norm_rows((const float*)(ws + WS_X1), p.in[5], mod + 3 * 2048, mod + 4 * 2048, (bf16_t*)(ws + WS_H2), D); phase_uv(p); });
    SEAM(7);
    RUNPH(8, { pg8::Gemm g{(const bf16_t*)(ws + WS_H2), (const bf16_t*)(ws + WS_WQ), nullptr, nullptr, D, D, T, D, D}; pg8::StaticOrder<1> S; S.init(T, D, gridDim.x, blockIdx.x);
        pg8::EpiBf16 E{(bf16_t*)(ws + WS_QP), D, 1 << 30}; pg8::gemm_phase(ldsl, g, S, E); });
    SEAM(8);
    RUNPH(9, { phase_peer_topk_ni((const GAS bf16_t*)(ws + WS_QP), (const GAS bf16_t*)(ws + WS_KEYS), (GAS int*)(ws + WS_EIDX), (GAS float*)(ws + WS_EGATE), ldsl); });
    SEAM(9);
    RUNPH(10, { phase_experts(p, lds); });
    if (p.ph_hi > NPHASES) grid.sync();
#undef IN
#undef SEAM
}

#ifndef MK_N_LAUNCHES
#define MK_N_LAUNCHES 1
#endif
extern "C" void kernel_launch(void* const* d_in, const int* in_sizes, int n_in, void* d_out, int out_size, void* d_ws, size_t ws_size, hipStream_t stream) {
    static int grid = 0;
    if (grid == 0) {
        if (n_in != 17 || out_size != T * D || ws_size < WS_END) { fprintf(stderr, "kernel_launch: unexpected shapes (n_in %d out %d ws %zu)\n", n_in, out_size, ws_size); grid = -1; return; }
        int dev = 0, cus = 0, per_cu = 0;
        hipGetDevice(&dev); hipDeviceGetAttribute(&cus, hipDeviceAttributeMultiprocessorCount, dev);
        hipFuncSetAttribute((const void*)mega_fwd, hipFuncAttributeMaxDynamicSharedMemorySize, LDS_BYTES);
        hipOccupancyMaxActiveBlocksPerMultiprocessor(&per_cu, (const void*)mega_fwd, NTHREADS, LDS_BYTES);
        if (per_cu < 1) { fprintf(stderr, "kernel_launch: occupancy query says %d blocks/CU\n", per_cu); per_cu = 1; }
        (void)hipGetLastError();
        grid = cus * 1;
    }
    if (grid < 0) return;
    if (hipMemsetAsync((char*)d_ws + WS_CTL, 0, 65536, stream) != hipSuccess) { fprintf(stderr, "kernel_launch: memset failed\n"); return; }
    Params p{};
    for (int i = 0; i < 17; ++i) p.in[i] = (const float*)d_in[i];
    p.out = (float*)d_out; p.ws = (unsigned char*)d_ws;
#if MK_N_LAUNCHES == 1
    p.ph_lo = 0; p.ph_hi = NPHASES;
    void* args[] = {&p};
    hipError_t e = hipLaunchCooperativeKernel((const void*)mega_fwd, dim3(grid), dim3(NTHREADS), args, LDS_BYTES, stream);
    if (e != hipSuccess) fprintf(stderr, "cooperative launch failed: %s (grid %d)\n", hipGetErrorString(e), grid);
#else
    for (int k = 0; k < NPHASES; ++k) { p.ph_lo = k; p.ph_hi = k + 1; void* args[] = {&p};
        hipError_t e = hipLaunchCooperativeKernel((const void*)mega_fwd, dim3(grid), dim3(NTHREADS), args, LDS_BYTES, stream);
        if (e != hipSuccess) { fprintf(stderr, "launch %d failed: %s\n", k, hipGetErrorString(e)); break; } }
#endif
}
```

```cpp
#include <hip/hip_runtime.h>
#include <hip/hip_cooperative_groups.h>
#include <cstdio>
#include <cstdint>
namespace cg = cooperative_groups;

#define LAS __attribute__((address_space(3)))
typedef unsigned short bf16_t;
typedef short bf16x8 __attribute__((ext_vector_type(8)));
typedef short bf16x4 __attribute__((ext_vector_type(4)));
typedef float f32x2 __attribute__((ext_vector_type(2)));
typedef float f32x4 __attribute__((ext_vector_type(4)));
typedef float f32x16 __attribute__((ext_vector_type(16)));
typedef unsigned u32x2 __attribute__((ext_vector_type(2)));
typedef unsigned u32x4 __attribute__((ext_vector_type(4)));

constexpr int T = 16384, D = 2048, SEQ = 2048, NBATCH = 8, NP = 12544;
constexpr int C_QA = 0, C_KA = 1024, C_VA = 2048, C_QI = 3072, C_KI = 4096, C_WI = 4160, C_QB = 4352, C_FB = 5376, C_IB = 6400, C_GB = 7424, C_GA = 8448, C_GG = 10496;
constexpr int NADA = 12288;
constexpr float NORM_EPS = 1e-6f;
constexpr int NTHREADS = 512, NWAVES = 8;
constexpr int LDS_BYTES = 147456;
constexpr size_t MiB = 1u << 20;
constexpr size_t WS_CTL = 0, WS_MOD = 1 * MiB, WS_WUA = 2 * MiB, WS_WUB = 6 * MiB, WS_WOUT = 10 * MiB, WS_WQ = 18 * MiB, WS_KEYS = 26 * MiB, WS_MASK = 27 * MiB;
constexpr size_t WS_MIXED = 32 * MiB;
constexpr size_t WS_VT = 32 * MiB, WS_ORAW = 64 * MiB;
constexpr size_t WS_P = 96 * MiB;
constexpr size_t WS_H2 = 96 * MiB, WS_QP = 160 * MiB, WS_U8 = 224 * MiB, WS_V8 = 256 * MiB, WS_ISU = 26 * MiB + 512 * 1024, WS_ISV = 26 * MiB + 768 * 1024, WS_ISH = 26 * MiB + 896 * 1024, WS_H8 = 288 * MiB, WS_EIDX = 352 * MiB, WS_EGATE = 360 * MiB;
constexpr size_t WS_X1 = 368 * MiB;
constexpr size_t WS_END = 496 * MiB;
constexpr int LDP = 2048 + 64;
constexpr size_t OUT_H = 0, OUT_WIN = 68 * MiB;
constexpr size_t OUT_AO = 0, OUT_REC = 32 * MiB;

struct Params { const float* in[17]; float* out; unsigned char* ws; int ph_lo, ph_hi; };

__device__ __forceinline__ unsigned f2bf(float f) { unsigned u = __float_as_uint(f); return (u + 0x7fffu + ((u >> 16) & 1u)) >> 16; }
__device__ __forceinline__ float bf2f(unsigned b) { return __uint_as_float(b << 16); }
__device__ __forceinline__ float bflo(unsigned w) { return __uint_as_float(w << 16); }
__device__ __forceinline__ float bfhi(unsigned w) { return __uint_as_float(w & 0xffff0000u); }
__device__ __forceinline__ unsigned pk2(float lo, float hi) { unsigned r; asm volatile("v_cvt_pk_bf16_f32 %0, %1, %2" : "=v"(r) : "v"(lo), "v"(hi)); return r; }
__device__ __forceinline__ float wave_sum(float v) {
#pragma unroll
    for (int o = 1; o < 64; o <<= 1) v += __shfl_xor(v, o);
    return v;
}
__device__ __forceinline__ float sigmoidf_(float v) { return 1.f / (1.f + __expf(-v)); }
__device__ __forceinline__ float siluf_(float v) { return v / (1.f + __expf(-v)); }
#define LDS_WAIT() asm volatile("s_waitcnt lgkmcnt(0)" ::: "memory")

namespace pg8 {
constexpr int BM = 256, BK = 64, HALF = 128, HTB = HALF * BK * 2, STAGE_BYTES = 8 * HTB, NXCD = 8, WGM = 8;
__host__ __device__ __forceinline__ int lds_byte(int r, int c) { const int st = (r >> 4) * 2 + (c >> 5), rr = r & 15, cc = c & 31, ob = rr * 64 + cc * 2; return st * 1024 + (ob ^ (((ob >> 9) & 1) << 5)); }
__host__ __device__ __forceinline__ void stage_rc(int b, int& R, int& C) { const int st = b / 1024, sb = b % 1024, swz = sb ^ (((sb >> 9) & 1) << 5); R = (st >> 1) * 16 + swz / 64; C = (st & 1) * 32 + (swz % 64) / 2; }
__host__ __device__ __forceinline__ int perm32(int rho) { const int n = rho >> 4, i = rho & 15; return 8 * (i >> 2) + 4 * n + (i & 3); }

struct Unit { int pm, pn, z; };
struct Gemm { const bf16_t* A; const bf16_t* Bt; const bf16_t* A2; const bf16_t* Bt2; int lda, ldb, M, N, K; };

template <int NZ> struct StaticOrder {
    int nM, nN, nwg, G, c;
    __device__ void init(int M, int N, int G_, int c_) { nM = M / BM; nN = N / BM; nwg = nM * nN; G = G_; c = c_; }
    __device__ bool next(int i, Unit& u) const {
        const long L = (long)(i / NZ) * G + c; if (L >= nwg) return false;
        int wgid = (int)L; { const int q = nwg / NXCD, r = nwg % NXCD, xcd = wgid % NXCD, off = wgid / NXCD; wgid = (xcd < r ? xcd * (q + 1) : r * (q + 1) + (xcd - r) * q) + off; }
        const int nig = WGM * nN, gid = wgid / nig, fm = gid * WGM, gsz = (nM - fm) < WGM ? (nM - fm) : WGM;
        u.pm = fm + ((wgid % nig) % gsz); u.pn = (wgid % nig) / gsz; u.z = i % NZ; return true;
    }
};

struct ProbeOrder { StaticOrder<1> S; int mm, mn;
    __device__ bool next(int i, Unit& u) const { const bool r = S.next(i, u); u.pm &= mm; u.pn &= mn; return r; } };
template <class Epi, class Sched>
__device__ __forceinline__ void gemm_phase(LAS unsigned char* lds, const Gemm g, const Sched& S, const Epi& E) {
    const int tid = threadIdx.x, wid = __builtin_amdgcn_readfirstlane(tid >> 6), lane = tid & 63, wr = wid >> 2, wc = wid & 3, fr = lane & 15, fq = lane >> 4;
    const int K = g.K, nt = K / BK;
    unsigned voffA[2], voffB[2];
#pragma unroll
    for (int i = 0; i < 2; ++i) { int R, C; stage_rc(tid * 16 + i * 8192, R, C); const int Rb = Epi::PERM ? ((R & ~31) + perm32(R & 31)) : R;
        voffA[i] = (unsigned)(R * g.lda + C) * 2u; voffB[i] = (unsigned)(Rb * g.ldb + C) * 2u; }
    const size_t kstep = (size_t)(BK * 2);
    const size_t hstepA = (size_t)HALF * g.lda * 2, hstepB = (size_t)HALF * g.ldb * 2;
    const size_t tstepA = 2 * hstepA, tstepB = 2 * hstepB;
    const unsigned ldsw = (unsigned)wid * 1024u;
    const int aoff = lds_byte(wr * 64 + fr, fq * 8), boff = lds_byte(wc * 32 + fr, fq * 8);
#define PG8_SA(b, h) (((b) * 2 + (h)) * HTB)
#define PG8_SB(b, h) ((4 + (b) * 2 + (h)) * HTB)
#define PG8_STAGE(bufoff, gbase, voff) do { _Pragma("unroll") for (int _i = 0; _i < 2; ++_i) \
        __builtin_amdgcn_global_load_lds((const unsigned*)((const char*)(gbase) + (voff)[_i]), (LAS unsigned*)(lds + (bufoff) + ldsw + _i * 8192), 16, 0, 0); } while (0)
#define PG8_LDA(dst, b, h) do { _Pragma("unroll") for (int m = 0; m < 4; ++m) _Pragma("unroll") for (int k = 0; k < 2; ++k) dst[m][k] = *(const LAS bf16x8*)(lds + PG8_SA(b, h) + aoff + m * 2048 + k * 1024); } while (0)
#define PG8_LDB(dst, b, h) do { _Pragma("unroll") for (int n = 0; n < 2; ++n) _Pragma("unroll") for (int k = 0; k < 2; ++k) dst[n][k] = *(const LAS bf16x8*)(lds + PG8_SB(b, h) + boff + n * 2048 + k * 1024); } while (0)
#define PG8_MMA(ai, bj, At, Bt) do { __builtin_amdgcn_s_setprio(1); _Pragma("unroll") for (int m = 0; m < 4; ++m) _Pragma("unroll") for (int n = 0; n < 2; ++n) _Pragma("unroll") for (int k = 0; k < 2; ++k) \
        acc[ai][bj][m][n] = __builtin_amdgcn_mfma_f32_16x16x32_bf16(Bt[n][k], At[m][k], acc[ai][bj][m][n], 0, 0, 0); __builtin_amdgcn_s_setprio(0); } while (0)
#define PG8_WAIT_V(n) asm volatile("s_waitcnt vmcnt(" #n ")" ::: "memory")
#define PG8_WAIT_L(n) asm volatile("s_waitcnt lgkmcnt(" #n ")" ::: "memory")
#define PG8_BAR __builtin_amdgcn_s_barrier()
#define PG8_SCHED __builtin_amdgcn_sched_barrier(0)
#define PG8_ABASE(u) ((const char*)((u).z ? g.A2 : g.A) + (size_t)(u).pm * tstepA)
#define PG8_BBASE(u) ((const char*)((u).z ? g.Bt2 : g.Bt) + (size_t)(u).pn * tstepB)
    Unit cur, nxt; int ui = 0;
    if (!S.next(0, cur)) return;
    f32x4 acc[2][2][4][2];
#pragma unroll
    for (int a = 0; a < 2; ++a)
#pragma unroll
        for (int b = 0; b < 2; ++b)
#pragma unroll
            for (int m = 0; m < 4; ++m)
#pragma unroll
                for (int n = 0; n < 2; ++n) acc[a][b][m][n] = (f32x4){0.f, 0.f, 0.f, 0.f};
    bf16x8 At[4][2], B0[2][2], B1[2][2];
    const char* cA = PG8_ABASE(cur); const char* cB = PG8_BBASE(cur);
    PG8_STAGE(PG8_SB(0, 0), cB, voffB); PG8_STAGE(PG8_SA(0, 0), cA, voffA); PG8_STAGE(PG8_SB(0, 1), cB + hstepB, voffB); PG8_STAGE(PG8_SA(0, 1), cA + hstepA, voffA);
    if (wr == 1) PG8_BAR;
    PG8_WAIT_V(4); PG8_BAR;
    PG8_STAGE(PG8_SB(1, 0), cB + kstep, voffB); PG8_STAGE(PG8_SA(1, 0), cA + kstep, voffA); PG8_STAGE(PG8_SB(1, 1), cB + hstepB + kstep, voffB);
    PG8_WAIT_V(6); PG8_BAR;
    for (;;) {
        const bool has_next = S.next(ui + 1, nxt);
        const char* nA = has_next ? PG8_ABASE(nxt) : cA; const char* nB = has_next ? PG8_BBASE(nxt) : cB;
        for (int t = 0; t < nt; t += 2) {
            const bool last = (t == nt - 2);
            const char* a1 = cA + (size_t)(t + 1) * kstep;
            const char* a2 = last ? nA : cA + (size_t)(t + 2) * kstep; const char* b2 = last ? nB : cB + (size_t)(t + 2) * kstep;
            const char* a3 = a2 + kstep; const char* b3 = b2 + kstep;
            PG8_LDB(B0, 0, 0); PG8_SCHED; PG8_LDA(At, 0, 0); PG8_STAGE(PG8_SA(1, 1), a1 + hstepA, voffA);
            PG8_WAIT_L(8); PG8_BAR; PG8_WAIT_L(0); PG8_MMA(0, 0, At, B0); PG8_BAR; PG8_SCHED;
            PG8_LDB(B1, 0, 1); PG8_STAGE(PG8_SB(0, 0), b2, voffB);
            PG8_BAR; PG8_WAIT_L(0); PG8_MMA(0, 1, At, B1); PG8_BAR;
            PG8_LDA(At, 0, 1); PG8_STAGE(PG8_SA(0, 0), a2, voffA);
            PG8_BAR; PG8_WAIT_L(0); PG8_MMA(1, 0, At, B0); PG8_BAR; PG8_SCHED;
            PG8_STAGE(PG8_SB(0, 1), b2 + hstepB, voffB);
            PG8_WAIT_V(6); PG8_BAR; PG8_MMA(1, 1, At, B1); PG8_BAR;
            PG8_LDB(B0, 1, 0); PG8_SCHED; PG8_LDA(At, 1, 0); PG8_STAGE(PG8_SA(0, 1), a2 + hstepA, voffA);
            PG8_WAIT_L(8); PG8_BAR; PG8_WAIT_L(0); PG8_MMA(0, 0, At, B0); PG8_BAR; PG8_SCHED;
            PG8_LDB(B1, 1, 1); PG8_STAGE(PG8_SB(1, 0), b3, voffB);
            PG8_BAR; PG8_WAIT_L(0); PG8_MMA(0, 1, At, B1); PG8_BAR;
            PG8_LDA(At, 1, 1); PG8_STAGE(PG8_SA(1, 0), a3, voffA);
            PG8_BAR; PG8_WAIT_L(0); PG8_MMA(1, 0, At, B0); PG8_BAR; PG8_SCHED;
            PG8_STAGE(PG8_SB(1, 1), b3 + hstepB, voffB);
            PG8_WAIT_V(6); PG8_BAR; PG8_MMA(1, 1, At, B1); PG8_BAR;
        }
        E(acc, cur, wr, wc, fr, fq);
        if (!has_next) break;
        if (!(Epi::CHAIN && cur.z == 0)) {
#pragma unroll
        for (int a = 0; a < 2; ++a)
#pragma unroll
            for (int b = 0; b < 2; ++b)
#pragma unroll
                for (int m = 0; m < 4; ++m)
#pragma unroll
                    for (int n = 0; n < 2; ++n) acc[a][b][m][n] = (f32x4){0.f, 0.f, 0.f, 0.f}; }
        cur = nxt; cA = nA; cB = nB; ++ui;
    }
    PG8_WAIT_V(0);
    if (wr == 0) PG8_BAR;
    PG8_BAR;
#undef PG8_SA
#undef PG8_SB
#undef PG8_STAGE
#undef PG8_LDA
#undef PG8_LDB
#undef PG8_MMA
#undef PG8_WAIT_V
#undef PG8_WAIT_L
#undef PG8_BAR
#undef PG8_SCHED
#undef PG8_ABASE
#undef PG8_BBASE
}

struct EpiBf16 {
    static constexpr bool PERM = true; static constexpr bool CHAIN = false;
    bf16_t* O; int ldc; int sig_from;
    __device__ __forceinline__ void operator()(const f32x4 (&acc)[2][2][4][2], const Unit& u, int wr, int wc, int fr, int fq) const {
        const int row0 = u.pm * BM + wr * 64 + fr, col0 = u.pn * BM + wc * 32 + 8 * fq; const bool sig = u.pn >= sig_from;
#pragma unroll
        for (int ai = 0; ai < 2; ++ai)
#pragma unroll
            for (int m = 0; m < 4; ++m) { bf16_t* rowp = O + (size_t)(row0 + ai * HALF + m * 16) * ldc + col0;
#pragma unroll
                for (int bj = 0; bj < 2; ++bj) { f32x4 v0 = acc[ai][bj][m][0], v1 = acc[ai][bj][m][1];
                    if (sig) {
#pragma unroll
                        for (int j = 0; j < 4; ++j) { v0[j] = sigmoidf_(v0[j]); v1[j] = sigmoidf_(v1[j]); } }
                    u32x4 w; w.x = pk2(v0[0], v0[1]); w.y = pk2(v0[2], v0[3]); w.z = pk2(v1[0], v1[1]); w.w = pk2(v1[2], v1[3]);
                    *(u32x4*)(rowp + bj * HALF) = w; } }
    }
};
struct EpiSkip {
    static constexpr bool PERM = true; static constexpr bool CHAIN = false;
    EpiBf16 E; bool on;
    __device__ __forceinline__ void operator()(const f32x4 (&acc)[2][2][4][2], const Unit& u, int wr, int wc, int fr, int fq) const { if (on) E(acc, u, wr, wc, fr, fq); }
};
struct EpiMix {
    static constexpr bool PERM = true; static constexpr bool CHAIN = true;
    bf16_t* O; const bf16_t* P;
    __device__ __forceinline__ void operator()(f32x4 (&acc)[2][2][4][2], const Unit& u, int wr, int wc, int fr, int fq) const {
        const int row0 = u.pm * BM + wr * 64 + fr, col0 = u.pn * BM + wc * 32 + 8 * fq;
#pragma unroll
        for (int ai = 0; ai < 2; ++ai) {
            u32x4 gw[4][2], pw[4][2];
#pragma unroll
            for (int m = 0; m < 4; ++m)
#pragma unroll
                for (int bj = 0; bj < 2; ++bj) { const size_t r = (size_t)(row0 + ai * HALF + m * 16);
                    gw[m][bj] = *(const u32x4*)(P + r * NP + C_GG + col0 + bj * HALF);
                    if (u.z == 0) pw[m][bj] = *(const u32x4*)(P + r * NP + C_GA + col0 + bj * HALF); else pw[m][bj] = (u32x4){0u, 0u, 0u, 0u}; }
            asm volatile("" ::: "memory");
#pragma unroll
            for (int m = 0; m < 4; ++m)
#pragma unroll
                for (int bj = 0; bj < 2; ++bj) { const u32x4 g = gw[m][bj], q = pw[m][bj];
                    if (u.z == 0) {
#pragma unroll
                        for (int n = 0; n < 2; ++n)
#pragma unroll
                            for (int e = 0; e < 4; ++e) { const unsigned gb = g[2 * n + (e >> 1)], ga = q[2 * n + (e >> 1)]; const float fb = (e & 1) ? bfhi(gb) : bflo(gb), fa = (e & 1) ? bfhi(ga) : bflo(ga);
                                acc[ai][bj][m][n][e] *= fa * __builtin_amdgcn_rcpf(fmaxf(fb, 1e-20f)); }
                    } else { const size_t r = (size_t)(row0 + ai * HALF + m * 16); const f32x4 v0 = acc[ai][bj][m][0], v1 = acc[ai][bj][m][1];
                        u32x4 w; w.x = pk2(v0[0] * bflo(g.x), v0[1] * bfhi(g.x)); w.y = pk2(v0[2] * bflo(g.y), v0[3] * bfhi(g.y));
                        w.z = pk2(v1[0] * bflo(g.z), v1[1] * bfhi(g.z)); w.w = pk2(v1[2] * bflo(g.w), v1[3] * bfhi(g.w));
                        *(u32x4*)(O + r * D + col0 + bj * HALF) = w; } }
            asm volatile("" ::: "memory");
        }
    }
};
struct EpiX1 {
    static constexpr bool PERM = false; static constexpr bool CHAIN = false;
    const float* x; float* out; const float* gate;
    __device__ __forceinline__ void operator()(const f32x4 (&acc)[2][2][4][2], const Unit& u, int wr, int wc, int fr, int fq) const {
        const int row0 = u.pm * BM + wr * 64 + fr, col0 = u.pn * BM + wc * 32 + 4 * fq; const int b = (u.pm * BM) >> 11;
        f32x4 gv[2][2];
#pragma unroll
        for (int bj = 0; bj < 2; ++bj)
#pragma unroll
            for (int n = 0; n < 2; ++n) gv[bj][n] = *(const f32x4*)(gate + (size_t)b * NADA + col0 + bj * HALF + n * 16);
#pragma unroll
        for (int ai = 0; ai < 2; ++ai) {
            f32x4 xv[4][2][2];
#pragma unroll
            for (int m = 0; m < 4; ++m)
#pragma unroll
                for (int bj = 0; bj < 2; ++bj)
#pragma unroll
                    for (int n = 0; n < 2; ++n) xv[m][bj][n] = *(const f32x4*)(x + (size_t)(row0 + ai * HALF + m * 16) * D + col0 + bj * HALF + n * 16);
            asm volatile("" ::: "memory");
#pragma unroll
            for (int m = 0; m < 4; ++m)
#pragma unroll
                for (int bj = 0; bj < 2; ++bj)
#pragma unroll
                    for (int n = 0; n < 2; ++n) *(f32x4*)(out + (size_t)(row0 + ai * HALF + m * 16) * D + col0 + bj * HALF + n * 16) = xv[m][bj][n] + gv[bj][n] * acc[ai][bj][m][n];
            asm volatile("" ::: "memory");
        }
    }
};
}

__device__ __forceinline__ void phase_mod(const Params& p, unsigned char* lds) {
    float* sc = (float*)lds;
    float* red = (float*)(lds + 65536);
    const int tid = threadIdx.x, wave = tid >> 6, lane = tid & 63;
    const float* c = p.in[1]; const float* wada = p.in[2]; const float* bada = p.in[3];
    float* mod = (float*)(p.ws + WS_MOD);
    if ((int)blockIdx.x >= 192) return;
    for (int i = tid; i < NBATCH * D; i += NTHREADS) { const int b = i >> 11, k = i & 2047; sc[k * 8 + b] = siluf_(c[i]); }
    __syncthreads();
    const int cgp = tid & 15, rg = tid >> 4;
    for (int item = blockIdx.x; item < 192; item += gridDim.x) {
        const float* w = wada + item * 64 + cgp * 4;
        float acc[8][4];
#pragma unroll
        for (int b = 0; b < 8; ++b)
#pragma unroll
            for (int j = 0; j < 4; ++j) acc[b][j] = 0.f;
#pragma unroll 1
        for (int i0 = 0; i0 < 64; i0 += 8) {
            f32x4 wvv[8];
#pragma unroll
            for (int u = 0; u < 8; ++u) wvv[u] = __builtin_nontemporal_load((const f32x4*)(w + (size_t)(rg + 32 * (i0 + u)) * NADA));
#pragma unroll
            for (int u = 0; u < 8; ++u) { const int k = rg + 32 * (i0 + u); const f32x4 wv = wvv[u];
                const f32x4 s0 = *(const f32x4*)(sc + k * 8), s1 = *(const f32x4*)(sc + k * 8 + 4);
#pragma unroll
                for (int j = 0; j < 4; ++j) { acc[0][j] += s0[0] * wv[j]; acc[1][j] += s0[1] * wv[j]; acc[2][j] += s0[2] * wv[j]; acc[3][j] += s0[3] * wv[j];
                    acc[4][j] += s1[0] * wv[j]; acc[5][j] += s1[1] * wv[j]; acc[6][j] += s1[2] * wv[j]; acc[7][j] += s1[3] * wv[j]; } } }
#pragma unroll
        for (int b = 0; b < 8; ++b)
#pragma unroll
            for (int j = 0; j < 4; ++j) { float v = acc[b][j]; v += __shfl_xor(v, 16); v += __shfl_xor(v, 32); acc[b][j] = v; }
        if (lane < 16) {
#pragma unroll
            for (int b = 0; b < 8; ++b)
#pragma unroll
                for (int j = 0; j < 4; ++j) red[(wave * 16 + cgp) * 32 + b * 4 + j] = acc[b][j]; }
        __syncthreads();
        { const int cgo = tid >> 5, b = (tid >> 2) & 7, j = tid & 3; float s = 0.f;
#pragma unroll
          for (int w8 = 0; w8 < 8; ++w8) s += red[(w8 * 16 + cgo) * 32 + (tid & 31)];
          const int col = item * 64 + cgo * 4 + j; mod[b * NADA + col] = s + bada[col]; }
        __syncthreads();
    }
}
__device__ __forceinline__ void transpose_item(const float* W, int K, int N, bf16_t* WT, int nblk, int item, int lane, float* scr, int mode, int pitch) {
    const int kb = item / nblk, nb = item % nblk, k0 = 64 * kb, n0 = 32 * nb;
    const int nd = n0 + (lane & 31); int ns = nd; bool valid = true;
    if (mode == 1) { if (nd >= C_QB) ns = nd - 176; else if (nd >= 4176) valid = false; }
    if (mode == 0 || n0 < 4160 || n0 >= C_QB) {
        const int ns0 = (mode == 1 && n0 >= C_QB) ? n0 - 176 : n0;
        f32x4 v[8];
#pragma unroll
        for (int i = 0; i < 8; ++i) v[i] = *(const f32x4*)(W + (size_t)(k0 + 8 * i + (lane >> 3)) * N + ns0 + 4 * (lane & 7));
#pragma unroll
        for (int i = 0; i < 8; ++i) { float* d = scr + (8 * i + (lane >> 3)) * 33 + 4 * (lane & 7); d[0] = v[i][0]; d[1] = v[i][1]; d[2] = v[i][2]; d[3] = v[i][3]; }
    } else {
#pragma unroll 8
        for (int i = 0; i < 32; ++i) { const int kk = 2 * i + (lane >> 5); scr[kk * 33 + (lane & 31)] = valid ? W[(size_t)(k0 + kk) * N + ns] : 0.f; }
    }
    LDS_WAIT();
    const int c = lane & 7;
#pragma unroll
    for (int j = 0; j < 4; ++j) { const int n = (lane >> 3) + 8 * j; const float* s = scr + (8 * c) * 33 + n;
        u32x4 o; o.x = pk2(s[0 * 33], s[1 * 33]); o.y = pk2(s[2 * 33], s[3 * 33]); o.z = pk2(s[4 * 33], s[5 * 33]); o.w = pk2(s[6 * 33], s[7 * 33]);
        *(u32x4*)(WT + (size_t)(n0 + n) * pitch + k0 + 8 * c) = o; }
    LDS_WAIT();
}
__device__ __forceinline__ void phase_weights(const Params& p, unsigned char* lds) {
    const int tid = threadIdx.x, wave = tid >> 6, lane = tid & 63;
    float* scr = (float*)(lds + wave * 16384);
    const int vb = ((int)blockIdx.x + (int)gridDim.x - 192 % (int)gridDim.x) % (int)gridDim.x;
    const int gw = vb * NWAVES + wave, NGW = gridDim.x * NWAVES;
    constexpr int I_IN = 32 * (NP / 32), I_UA = 16 * 64, I_UB = 16 * 64, I_O = 32 * 64, I_Q = 32 * 64;
    constexpr int NITEMS = I_IN + I_UA + I_UB + I_O + I_Q;
    bf16_t* win_t = (bf16_t*)((unsigned char*)p.out + OUT_WIN);
    for (int it = gw; it < NITEMS; it += NGW) {
        int r = it;
        if (r < I_IN) { transpose_item(p.in[6], 2048, 12368, win_t, NP / 32, r, lane, scr, 1, LDP); continue; } r -= I_IN;
        if (r < I_UA) { transpose_item(p.in[9], 1024, 2048, (bf16_t*)(p.ws + WS_WUA), 64, r, lane, scr, 0, 1024); continue; } r -= I_UA;
        if (r < I_UB) { transpose_item(p.in[10], 1024, 2048, (bf16_t*)(p.ws + WS_WUB), 64, r, lane, scr, 0, 1024); continue; } r -= I_UB;
        if (r < I_O) { transpose_item(p.in[11], 2048, 2048, (bf16_t*)(p.ws + WS_WOUT), 64, r, lane, scr, 0, 2048); continue; } r -= I_O;
        transpose_item(p.in[12], 2048, 2048, (bf16_t*)(p.ws + WS_WQ), 64, r, lane, scr, 0, 2048);
    }
    { const float* ks = p.in[13]; bf16_t* kd = (bf16_t*)(p.ws + WS_KEYS);
      for (int i = (blockIdx.x * NTHREADS + tid) * 4; i < 8 * 2 * 128 * 128; i += gridDim.x * NTHREADS * 4) { const f32x4 v = *(const f32x4*)(ks + i); u32x2 o; o.x = pk2(v[0], v[1]); o.y = pk2(v[2], v[3]); *(u32x2*)(kd + i) = o; } }
}

__device__ __forceinline__ unsigned pack_i8x4(float a, float b, float c, float d) {
    const unsigned ia = (unsigned)__float2int_rn(a) & 0xffu, ib = (unsigned)__float2int_rn(b) & 0xffu, ic = (unsigned)__float2int_rn(c) & 0xffu, id = (unsigned)__float2int_rn(d);
    return ia | (ib << 8) | (ic << 16) | (id << 24);
}
__device__ __forceinline__ void phase_norm_rows(const float* src, const float* gain, const float* shift, const float* scale, bf16_t* dst, int pitch, unsigned char* h8 = nullptr, float* ish = nullptr) {
    const int tid = threadIdx.x, wave = tid >> 6, lane = tid & 63;
    const int gw = blockIdx.x * NWAVES + wave, NGW = gridDim.x * NWAVES;
#define NR_LOAD(v, row_) do { const f32x4* xr_ = (const f32x4*)(src + (size_t)(row_) * D) + lane; _Pragma("unroll") for (int j = 0; j < 8; ++j) v[j] = xr_[64 * j]; } while (0)
#define NR_PROC(v, row_) do { const int rw_ = (row_); float ss = 0.f; \
        _Pragma("unroll") for (int j = 0; j < 8; ++j) ss += (v[j][0] * v[j][0] + v[j][1] * v[j][1]) + (v[j][2] * v[j][2] + v[j][3] * v[j][3]); \
        const float rstd = rsqrtf(wave_sum(ss) * (1.f / D) + NORM_EPS); \
        u32x2* o8 = (u32x2*)(dst + (size_t)rw_ * pitch) + lane; \
        _Pragma("unroll") for (int j = 0; j < 8; ++j) { f32x4 h; \
            _Pragma("unroll") for (int e = 0; e < 4; ++e) h[e] = v[j][e] * rstd * A[j][e] + B[j][e]; \
            u32x2 w; w.x = pk2(h[0], h[1]); w.y = pk2(h[2], h[3]); o8[64 * j] = w; v[j] = h; } \
        if (h8) {        \
            float am = 0.f; \
            _Pragma("unroll") for (int j = 0; j < 8; ++j) am = fmaxf(am, fmaxf(fmaxf(fabsf(v[j][0]), fabsf(v[j][1])), fmaxf(fabsf(v[j][2]), fabsf(v[j][3])))); \
            _Pragma("unroll") for (int o = 1; o < 64; o <<= 1) am = fmaxf(am, __shfl_xor(am, o)); \
            am = fmaxf(am, 1e-30f); const float q = 127.f / am; \
            _Pragma("unroll") for (int j = 0; j < 8; ++j) *(unsigned*)(h8 + (size_t)rw_ * D + 4 * (lane + 64 * j)) = pack_i8x4(v[j][0] * q, v[j][1] * q, v[j][2] * q, v[j][3] * q); \
            if (lane == 0) ish[rw_] = am * (1.f / 127.f); } } while (0)
    for (int base = gw * 8; base < T; base += NGW * 8) {
        const int b = base >> 11; f32x4 A[8], B[8], va[8], vb[8];
        NR_LOAD(va, base);
#pragma unroll
        for (int j = 0; j < 8; ++j) { const int col = 4 * (lane + 64 * j);
            const f32x4 g = *(const f32x4*)(gain + col), sc = *(const f32x4*)(scale + (size_t)b * NADA + col); B[j] = *(const f32x4*)(shift + (size_t)b * NADA + col);
#pragma unroll
            for (int e = 0; e < 4; ++e) A[j][e] = g[e] * (1.f + sc[e]); }
#pragma unroll
        for (int k = 0; k < 8; k += 2) {
            NR_LOAD(vb, base + k + 1); __builtin_amdgcn_sched_barrier(0); NR_PROC(va, base + k); __builtin_amdgcn_sched_barrier(0);
            if (k + 2 < 8) NR_LOAD(va, base + k + 2); __builtin_amdgcn_sched_barrier(0); NR_PROC(vb, base + k + 1); __builtin_amdgcn_sched_barrier(0);
        }
    }
#undef NR_LOAD
#undef NR_PROC
}

__device__ __forceinline__ void phase_vt(const Params& p, unsigned char* lds, int vb, int vG) {
    const int tid = threadIdx.x, wave = tid >> 6, lane = tid & 63;
    bf16_t* tile = (bf16_t*)(lds + wave * 16384);
    const bf16_t* P = (const bf16_t*)(p.ws + WS_P); bf16_t* VT = (bf16_t*)(p.ws + WS_VT);
    const int gw = vb * NWAVES + wave, NGW = vG * NWAVES;
    for (int it = gw; it < 8 * 8 * 32 * 2; it += NGW) {
        const int dh = it & 1, kt = (it >> 1) & 31, h = (it >> 6) & 7, b = it >> 9;
        const int k0 = kt * 64, d0 = dh * 64;
#pragma unroll
        for (int i = 0; i < 8; ++i) { const int key = i * 8 + (lane >> 3), dc = lane & 7;
            const u32x4 v = *(const u32x4*)(P + (size_t)(b * SEQ + k0 + key) * NP + C_VA + h * 128 + d0 + dc * 8);
            bf16_t* t = tile + (dc * 8) * 72 + key;
            t[0 * 72] = (bf16_t)(v.x & 0xffff); t[1 * 72] = (bf16_t)(v.x >> 16); t[2 * 72] = (bf16_t)(v.y & 0xffff); t[3 * 72] = (bf16_t)(v.y >> 16);
            t[4 * 72] = (bf16_t)(v.z & 0xffff); t[5 * 72] = (bf16_t)(v.z >> 16); t[6 * 72] = (bf16_t)(v.w & 0xffff); t[7 * 72] = (bf16_t)(v.w >> 16); }
        LDS_WAIT();
#pragma unroll
        for (int i = 0; i < 8; ++i) { const int d = i * 8 + (lane >> 3), kc = lane & 7;
            const u32x4 v = *(const u32x4*)(tile + d * 72 + kc * 8);
            *(u32x4*)(VT + ((size_t)((b * 8 + h) * 128 + d0 + d)) * SEQ + k0 + kc * 8) = v; }
        LDS_WAIT();
    }
}

__device__ __forceinline__ unsigned ord_key(float s) { const unsigned u = __float_as_uint(s); return (u & 0x80000000u) ? ~u : (u | 0x80000000u); }
__device__ __forceinline__ int half_sum(int v) {
    v += __builtin_amdgcn_update_dpp(0, v, 0xB1, 0xF, 0xF, true);
    v += __builtin_amdgcn_update_dpp(0, v, 0x4E, 0xF, 0xF, true);
    v += __builtin_amdgcn_update_dpp(0, v, 0x141, 0xF, 0xF, true);
    v += __builtin_amdgcn_update_dpp(0, v, 0x140, 0xF, 0xF, true);
    v += __shfl_xor(v, 16);
    return v;
}
constexpr int IX_RS = 72, IX_STAGE = 32 * IX_RS * 2;
__device__ __forceinline__ void indexer_item(const Params& p, unsigned char* lds, int b, int c, int grp) {
    const int tid = threadIdx.x, w = __builtin_amdgcn_readfirstlane(tid >> 6), lane = tid & 63, r = lane & 31, hh = lane >> 5;
    const bf16_t* P = (const bf16_t*)(p.ws + WS_P); unsigned* MASK = (unsigned*)(p.ws + WS_MASK);
    const int pair = grp * 8 + w, q0 = b * SEQ + c * 64 + 2 * pair;
    bf16x8 af[4];
    { const int query = q0 + ((r >> 2) & 1), head = (r & 3) + 4 * (r >> 3);
      const bf16_t* qp = P + (size_t)query * NP + C_QI + head * 64 + 8 * hh;
#pragma unroll
      for (int ks = 0; ks < 4; ++ks) af[ks] = *(const bf16x8*)(qp + ks * 16); }
    float wv[16];
    { const u32x4 w0 = *(const u32x4*)(P + (size_t)(q0 + hh) * NP + C_WI), w1 = *(const u32x4*)(P + (size_t)(q0 + hh) * NP + C_WI + 8);
      wv[0] = bflo(w0.x); wv[1] = bfhi(w0.x); wv[2] = bflo(w0.y); wv[3] = bfhi(w0.y); wv[4] = bflo(w0.z); wv[5] = bfhi(w0.z); wv[6] = bflo(w0.w); wv[7] = bfhi(w0.w);
      wv[8] = bflo(w1.x); wv[9] = bfhi(w1.x); wv[10] = bflo(w1.y); wv[11] = bfhi(w1.y); wv[12] = bflo(w1.z); wv[13] = bfhi(w1.z); wv[14] = bflo(w1.w); wv[15] = bfhi(w1.w); }
    const int nkt = 2 * (c + 1);
    const bool ldr = tid < 256;
    const bf16_t* kg = P + (size_t)(b * SEQ + ((tid >> 3) & 31)) * NP + C_KI + (tid & 7) * 8;
    const int kls = ((tid >> 3) & 31) * IX_RS * 2 + (tid & 7) * 16;
    u32x4 kr = {0u, 0u, 0u, 0u};
    __syncthreads();
    if (ldr) { *(u32x4*)(lds + kls) = *(const u32x4*)kg; *(u32x4*)(lds + IX_STAGE + kls) = *(const u32x4*)(kg + (size_t)32 * NP); }
    if (ldr && 2 < nkt) kr = *(const u32x4*)(kg + (size_t)64 * NP);
    __syncthreads();
    unsigned kv[64];
#pragma unroll
    for (int kt = 0; kt < 64; ++kt) {
        kv[kt] = 0u;
        if (kt < nkt) {
            if (ldr && kt + 2 < nkt) *(u32x4*)(lds + ((kt + 2) % 3) * IX_STAGE + kls) = kr;
            if (ldr && kt + 3 < nkt) kr = *(const u32x4*)(kg + (size_t)((kt + 3) * 32) * NP);
            const bf16_t* Ks = (const bf16_t*)(lds + (kt % 3) * IX_STAGE);
            f32x16 acc;
#pragma unroll
            for (int i = 0; i < 16; ++i) acc[i] = 0.f;
#pragma unroll
            for (int ks = 0; ks < 4; ++ks) { const bf16x8 bfr = *(const bf16x8*)(Ks + r * IX_RS + ks * 16 + 8 * hh); acc = __builtin_amdgcn_mfma_f32_32x32x16_bf16(af[ks], bfr, acc, 0, 0, 0); }
            float sc = 0.f;
#pragma unroll
            for (int i = 0; i < 16; ++i) sc += wv[i] * fmaxf(acc[i], 0.f);
            kv[kt] = ord_key(sc);
            __syncthreads();
        }
    }
    unsigned thr = 0u;
    if (nkt > 8) {
        int cur = 1 << 20;
        for (int bit = 31; bit >= 0; --bit) {
            const unsigned cand = thr | (1u << bit); int cnt = 0;
#pragma unroll
            for (int kt = 0; kt < 32; ++kt) cnt += (kv[kt] >= cand) ? 1 : 0;
            if (nkt > 32) {
#pragma unroll
                for (int kt = 32; kt < 64; ++kt) cnt += (kv[kt] >= cand) ? 1 : 0; }
            cnt = half_sum(cnt);
            if (cnt >= 256) { thr = cand; cur = cnt; }
            if (__builtin_amdgcn_ballot_w64(cur != 256) == 0ull) break;
        }
    }
    int cge = 0;
#pragma unroll
    for (int kt = 0; kt < 64; ++kt) cge += (kv[kt] >= thr && kv[kt] != 0u) ? 1 : 0;
    cge = half_sum(cge);
    const bool ties = (thr != 0u) && (cge > 256);
    unsigned m0 = 0u, m1 = 0u;
    if (__builtin_amdgcn_ballot_w64(ties) == 0ull) {
#pragma unroll
        for (int kt = 0; kt < 64; ++kt) { const unsigned long long bm = __builtin_amdgcn_ballot_w64(kv[kt] >= thr && kv[kt] != 0u);
            if (lane == kt) { m0 = (unsigned)bm; m1 = (unsigned)(bm >> 32); } }
    } else {
        int cgt = 0;
#pragma unroll
        for (int kt = 0; kt < 64; ++kt) cgt += (kv[kt] > thr) ? 1 : 0;
        cgt = half_sum(cgt);
        const int need = ties ? (256 - cgt) : (1 << 30); int run = 0;
#pragma unroll
        for (int kt = 0; kt < 64; ++kt) { const bool tie = ties && (kv[kt] == thr); const unsigned long long tb = __builtin_amdgcn_ballot_w64(tie);
            const unsigned th = hh ? (unsigned)(tb >> 32) : (unsigned)tb; const int rank = run + __builtin_popcount(th & ((1u << r) - 1u));
            const bool sel = ties ? ((kv[kt] > thr) || (tie && rank < need)) : (kv[kt] >= thr && kv[kt] != 0u);
            run += __builtin_popcount(th);
            const unsigned long long bm = __builtin_amdgcn_ballot_w64(sel);
            if (lane == kt) { m0 = (unsigned)bm; m1 = (unsigned)(bm >> 32); } }
    }
    { const int qpos = c * 64 + 2 * pair; unsigned* mt = MASK + ((size_t)(b * 64 + lane)) * SEQ + qpos; mt[0] = m0; mt[1] = m1; }
}
__device__ __forceinline__ void phase_indexer(const Params& p, unsigned char* lds, int vb, int vG) {
    const int G = vG;
    for (int rd = 0;; ++rd) {
        const int base = rd * G; if (base >= 1024) break;
        const int pos = (rd & 1) ? (G - 1 - vb) : vb; const int i = base + pos; if (i >= 1024) continue;
        indexer_item(p, lds, (i >> 2) & 7, 31 - (i >> 5), i & 3);
    }
}

#ifndef HG_REP_A
#define HG_REP_A 0
#endif
#ifndef HG_REP_B
#define HG_REP_B 0
#endif
constexpr int HG_RS = 136, HG_TS = 72, HG_SS = 136;
constexpr int HG_QT = 0, HG_QH = 17408, HG_KT = 34816, HG_KHT = 52224, HG_VT = 70656, HG_ST = 89088, HG_DEC = 123904, HG_SSQ = 124416, HG_OT = 125440;
__device__ __forceinline__ void hgrn_item(const Params& p, unsigned char* lds, int item) {
    const int tid = threadIdx.x, w = __builtin_amdgcn_readfirstlane(tid >> 6), lane = tid & 63, r = lane & 31, hh = lane >> 5;
    const int b = item >> 3, h = item & 7;
    const bf16_t* P = (const bf16_t*)(p.ws + WS_P); bf16_t* REC = (bf16_t*)((unsigned char*)p.out + OUT_REC);
    bf16_t* QT = (bf16_t*)(lds + HG_QT); bf16_t* QH = (bf16_t*)(lds + HG_QH); bf16_t* KT = (bf16_t*)(lds + HG_KT); bf16_t* KHT = (bf16_t*)(lds + HG_KHT); bf16_t* VT = (bf16_t*)(lds + HG_VT);
    bf16_t* ST = (bf16_t*)(lds + HG_ST); float* DEC = (float*)(lds + HG_DEC); float* SSQ = (float*)(lds + HG_SSQ); bf16_t* OT = (bf16_t*)(lds + HG_OT);
    const int seg = lane >> 4, dl = lane & 15, d = 16 * w + dl;
    const float lb = sigmoidf_(p.in[7][h * 128 + d] - p.in[7][1024 + h * 128 + d]);
    const int tb = w & 1, eb = w >> 1, sdb = w & 3, seb0 = 2 * (w >> 2);
    const int ot_t = tid >> 3, ot_c = tid & 7;
    float gn[16];
#pragma unroll
    for (int j = 0; j < 4; ++j) { const f32x4 g4 = *(const f32x4*)(p.in[8] + 16 * ot_c + 4 * j); gn[4 * j] = g4[0]; gn[4 * j + 1] = g4[1]; gn[4 * j + 2] = g4[2]; gn[4 * j + 3] = g4[3]; }
    f32x16 S0, S1;
#pragma unroll
    for (int i = 0; i < 16; ++i) { S0[i] = 0.f; S1[i] = 0.f; }
    __syncthreads();
    for (int i = tid; i < 128 * HG_SS / 2; i += NTHREADS) ((unsigned*)ST)[i] = 0u;
    unsigned short rq[16], rf[16], ri[16];
    { const bf16_t* src = P + (size_t)(b * SEQ + 16 * seg) * NP + h * 128 + d;
#pragma unroll
      for (int i = 0; i < 16; ++i) { rq[i] = src[(size_t)i * NP + C_QB]; rf[i] = src[(size_t)i * NP + C_FB]; ri[i] = src[(size_t)i * NP + C_IB]; } }
#pragma unroll 1
    for (int n = 0; n < 32; ++n) {
#pragma unroll 1
        for (int repa = 0; repa <= HG_REP_A; ++repa) {
            float lf[16], kk[16];
            float run = 0.f;
#pragma unroll
            for (int i = 0; i < 16; ++i) { const float f = lb + (1.f - lb) * sigmoidf_(bf2f(rf[i])); kk[i] = 1.f - f; run += __logf(f); lf[i] = run; }
            const float p0 = __shfl(run, dl), p1 = __shfl(run, 16 + dl), p2 = __shfl(run, 32 + dl), p3 = __shfl(run, 48 + dl);
            const float off = (seg > 0 ? p0 : 0.f) + (seg > 1 ? p1 : 0.f) + (seg > 2 ? p2 : 0.f), bL = (p0 + p1) + (p2 + p3), bref = p0 + p1;
            const float eref = __expf(fmaxf(bref, -80.f)), elref = __expf(fmaxf(bL - bref, -80.f));
            unsigned kh[8], vv[8];
#pragma unroll
            for (int i = 0; i < 16; ++i) { const float bt = off + lf[i]; const float qs = siluf_(bf2f(rq[i]));
                const float e1 = __expf(__builtin_amdgcn_fmed3f(bt - bref, -80.f, 80.f)), e2 = e1 * eref, e3 = __builtin_amdgcn_rcpf(e1), e4 = e3 * elref;
                const int t = 16 * seg + i;
                QT[t * HG_RS + d] = (bf16_t)f2bf(qs * e1); QH[t * HG_RS + d] = (bf16_t)f2bf(qs * e2); KT[t * HG_RS + d] = (bf16_t)f2bf(kk[i] * e3);
                const unsigned khv = f2bf(kk[i] * e4);
                if (i & 1) { kh[i >> 1] |= khv << 16; vv[i >> 1] |= (unsigned)ri[i] << 16; } else { kh[i >> 1] = khv; vv[i >> 1] = (unsigned)ri[i]; } }
            *(u32x4*)(KHT + d * HG_TS + 16 * seg) = (u32x4){kh[0], kh[1], kh[2], kh[3]}; *(u32x4*)(KHT + d * HG_TS + 16 * seg + 8) = (u32x4){kh[4], kh[5], kh[6], kh[7]};
            *(u32x4*)(VT + d * HG_TS + 16 * seg) = (u32x4){vv[0], vv[1], vv[2], vv[3]}; *(u32x4*)(VT + d * HG_TS + 16 * seg + 8) = (u32x4){vv[4], vv[5], vv[6], vv[7]};
            if (seg == 0) DEC[d] = eref * elref;
        }
        __syncthreads();
        if (n < 31) { const bf16_t* src = P + (size_t)(b * SEQ + (n + 1) * 64 + 16 * seg) * NP + h * 128 + d;
#pragma unroll
            for (int i = 0; i < 16; ++i) { rq[i] = src[(size_t)i * NP + C_QB]; rf[i] = src[(size_t)i * NP + C_FB]; ri[i] = src[(size_t)i * NP + C_IB]; } }
        const u32x4 gb0 = *(const u32x4*)(P + (size_t)(b * SEQ + n * 64 + ot_t) * NP + C_GB + h * 128 + 16 * ot_c), gb1 = *(const u32x4*)(P + (size_t)(b * SEQ + n * 64 + ot_t) * NP + C_GB + h * 128 + 16 * ot_c + 8);
        f32x16 X0, X1, o;
#pragma unroll 1
        for (int repb = 0; repb <= HG_REP_B; ++repb) {
#pragma unroll
        for (int i = 0; i < 16; ++i) { X0[i] = 0.f; X1[i] = 0.f; o[i] = 0.f; }
#pragma unroll
        for (int ks = 0; ks < 8; ++ks) { const bf16x8 bq = *(const bf16x8*)(QT + (32 * tb + r) * HG_RS + 16 * ks + 8 * hh);
            const bf16x8 a0 = *(const bf16x8*)(KT + r * HG_RS + 16 * ks + 8 * hh); X0 = __builtin_amdgcn_mfma_f32_32x32x16_bf16(a0, bq, X0, 0, 0, 0);
            if (tb == 1) { const bf16x8 a1 = *(const bf16x8*)(KT + (32 + r) * HG_RS + 16 * ks + 8 * hh); X1 = __builtin_amdgcn_mfma_f32_32x32x16_bf16(a1, bq, X1, 0, 0, 0); } }
#pragma unroll
        for (int i = 0; i < 16; ++i) { const bool keep = ((i & 3) + 8 * (i >> 2) + 4 * hh) <= r; if (tb == 0) X0[i] = keep ? X0[i] : 0.f; else X1[i] = keep ? X1[i] : 0.f; }
#pragma unroll
        for (int sb = 0; sb < 2; ++sb) { if (sb <= tb) {
#pragma unroll
            for (int s2 = 0; s2 < 2; ++s2) { u32x4 aw;
                if (sb == 0) { aw.x = pk2(X0[8 * s2], X0[8 * s2 + 1]); aw.y = pk2(X0[8 * s2 + 2], X0[8 * s2 + 3]); aw.z = pk2(X0[8 * s2 + 4], X0[8 * s2 + 5]); aw.w = pk2(X0[8 * s2 + 6], X0[8 * s2 + 7]); }
                else { aw.x = pk2(X1[8 * s2], X1[8 * s2 + 1]); aw.y = pk2(X1[8 * s2 + 2], X1[8 * s2 + 3]); aw.z = pk2(X1[8 * s2 + 4], X1[8 * s2 + 5]); aw.w = pk2(X1[8 * s2 + 6], X1[8 * s2 + 7]); }
                const bf16_t* vp = VT + (32 * eb + r) * HG_TS + 32 * sb + 16 * s2 + 4 * hh;
                const u32x2 lo = *(const u32x2*)vp, hi = *(const u32x2*)(vp + 8); const u32x4 bw = {lo.x, lo.y, hi.x, hi.y};
                o = __builtin_amdgcn_mfma_f32_32x32x16_bf16(__builtin_bit_cast(bf16x8, aw), __builtin_bit_cast(bf16x8, bw), o, 0, 0, 0); } } }
#pragma unroll
        for (int ks = 0; ks < 8; ++ks) { const bf16x8 aq = *(const bf16x8*)(QH + (32 * tb + r) * HG_RS + 16 * ks + 8 * hh), bs = *(const bf16x8*)(ST + (32 * eb + r) * HG_SS + 16 * ks + 8 * hh);
            o = __builtin_amdgcn_mfma_f32_32x32x16_bf16(aq, bs, o, 0, 0, 0); }
        { float a8[8], a4[4], a2[2], a1;
#pragma unroll
          for (int i = 0; i < 8; ++i) { const float lo = o[i] * o[i], hi = o[i + 8] * o[i + 8]; const bool up = lane & 16; const float keep = up ? hi : lo, send = up ? lo : hi; a8[i] = keep + __shfl_xor(send, 16); }
#pragma unroll
          for (int i = 0; i < 4; ++i) { const bool up = lane & 8; const float keep = up ? a8[i + 4] : a8[i], send = up ? a8[i] : a8[i + 4]; a4[i] = keep + __shfl_xor(send, 8); }
#pragma unroll
          for (int i = 0; i < 2; ++i) { const bool up = lane & 4; const float keep = up ? a4[i + 2] : a4[i], send = up ? a4[i] : a4[i + 2]; a2[i] = keep + __shfl_xor(send, 4); }
          { const bool up = lane & 2; const float keep = up ? a2[1] : a2[0], send = up ? a2[0] : a2[1]; a1 = keep + __shfl_xor(send, 2); }
          a1 += __shfl_xor(a1, 1);
          const int ri2 = (lane >> 1) & 15;
          if ((lane & 1) == 0) SSQ[(32 * tb + (ri2 & 3) + 8 * (ri2 >> 2) + 4 * hh) * 4 + eb] = a1; }
#pragma unroll
        for (int i = 0; i < 16; ++i) OT[(32 * tb + (i & 3) + 8 * (i >> 2) + 4 * hh) * HG_RS + 32 * eb + r] = (bf16_t)f2bf(o[i]);
        }
        { float dc[16];
#pragma unroll
          for (int g4 = 0; g4 < 4; ++g4) { const f32x4 dv = *(const f32x4*)(DEC + 32 * sdb + 8 * g4 + 4 * hh); dc[4 * g4] = dv[0]; dc[4 * g4 + 1] = dv[1]; dc[4 * g4 + 2] = dv[2]; dc[4 * g4 + 3] = dv[3]; }
#pragma unroll
          for (int i = 0; i < 16; ++i) { S0[i] *= dc[i]; S1[i] *= dc[i]; }
#pragma unroll
          for (int ss = 0; ss < 4; ++ss) { const bf16x8 a = *(const bf16x8*)(KHT + (32 * sdb + r) * HG_TS + 16 * ss + 8 * hh);
              const bf16x8 b0 = *(const bf16x8*)(VT + (32 * seb0 + r) * HG_TS + 16 * ss + 8 * hh), b1 = *(const bf16x8*)(VT + (32 * (seb0 + 1) + r) * HG_TS + 16 * ss + 8 * hh);
              S0 = __builtin_amdgcn_mfma_f32_32x32x16_bf16(a, b0, S0, 0, 0, 0); S1 = __builtin_amdgcn_mfma_f32_32x32x16_bf16(a, b1, S1, 0, 0, 0); } }
        __syncthreads();
#pragma unroll
        for (int g4 = 0; g4 < 4; ++g4) { const int d0 = 32 * sdb + 8 * g4 + 4 * hh;
            *(u32x2*)(ST + (32 * seb0 + r) * HG_SS + d0) = (u32x2){pk2(S0[4 * g4], S0[4 * g4 + 1]), pk2(S0[4 * g4 + 2], S0[4 * g4 + 3])};
            *(u32x2*)(ST + (32 * (seb0 + 1) + r) * HG_SS + d0) = (u32x2){pk2(S1[4 * g4], S1[4 * g4 + 1]), pk2(S1[4 * g4 + 2], S1[4 * g4 + 3])}; }
        { const f32x4 q4 = *(const f32x4*)(SSQ + ot_t * 4); const float rstd = rsqrtf(((q4[0] + q4[1]) + (q4[2] + q4[3])) * (1.f / 128.f) + NORM_EPS);
          const u32x4 o0 = *(const u32x4*)(OT + ot_t * HG_RS + 16 * ot_c), o1 = *(const u32x4*)(OT + ot_t * HG_RS + 16 * ot_c + 8);
          const unsigned ow[8] = {o0.x, o0.y, o0.z, o0.w, o1.x, o1.y, o1.z, o1.w}, gwv[8] = {gb0.x, gb0.y, gb0.z, gb0.w, gb1.x, gb1.y, gb1.z, gb1.w};
          unsigned rw[8];
#pragma unroll
          for (int j = 0; j < 8; ++j) rw[j] = pk2(bflo(ow[j]) * rstd * gn[2 * j] * siluf_(bflo(gwv[j])), bfhi(ow[j]) * rstd * gn[2 * j + 1] * siluf_(bfhi(gwv[j])));
          bf16_t* dst = REC + (size_t)(b * SEQ + n * 64 + ot_t) * 1024 + h * 128 + 16 * ot_c;
          *(u32x4*)dst = (u32x4){rw[0], rw[1], rw[2], rw[3]}; *(u32x4*)(dst + 8) = (u32x4){rw[4], rw[5], rw[6], rw[7]}; }
    }
}
__device__ __forceinline__ void phase_hgrn(const Params& p, unsigned char* lds, int vb, int vG) {
    for (int it = vb; it < 64; it += vG) hgrn_item(p, lds, it);
}

constexpr int AT_KRS = 136, AT_VRS = 36, AT_KB = 32 * AT_KRS * 2, AT_VB = 128 * AT_VRS * 2, AT_STAGE = AT_KB + AT_VB;
__device__ __forceinline__ void attn_item(const Params& p, unsigned char* lds, int b, int head, int cq) {
    const int tid = threadIdx.x, w = __builtin_amdgcn_readfirstlane(tid >> 6), lane = tid & 63, r = lane & 31, hh = lane >> 5;
    const bf16_t* P = (const bf16_t*)(p.ws + WS_P); const bf16_t* VT = (const bf16_t*)(p.ws + WS_VT); const unsigned* MASKT = (const unsigned*)(p.ws + WS_MASK);
    bf16_t* AO = (bf16_t*)((unsigned char*)p.out + OUT_AO);
    const int c = 4 * cq + (w >> 1), qpos = c * 64 + (w & 1) * 32 + r, tq = b * SEQ + qpos;
    const int nkt_w = 2 * (c + 1), nkt = 8 * (cq + 1);
    const bf16_t* kg = P + (size_t)(b * SEQ + (tid >> 4)) * NP + C_KA + head * 128 + (tid & 15) * 8;
    const bf16_t* vg = VT + (size_t)((b * 8 + head) * 128 + (tid >> 2)) * SEQ + (tid & 3) * 8;
    const int kls = (tid >> 4) * AT_KRS * 2 + (tid & 15) * 16, vls = AT_KB + (tid >> 2) * AT_VRS * 2 + (tid & 3) * 16;
    bf16x8 qf[8];
    { const bf16_t* qp = P + (size_t)tq * NP + C_QA + head * 128 + 8 * hh;
#pragma unroll
      for (int ks = 0; ks < 8; ++ks) qf[ks] = *(const bf16x8*)(qp + ks * 16); }
    f32x16 o[4];
#pragma unroll
    for (int db = 0; db < 4; ++db)
#pragma unroll
        for (int i = 0; i < 16; ++i) o[db][i] = 0.f;
    float mrun = -1e30f, lsum = 0.f;
    const float sc = 0.08838834764831845f * 1.4426950408889634f;
    __syncthreads();
    u32x4 krA, vrA, krB, vrB;
#pragma unroll
    for (int t0 = 0; t0 < 2; ++t0) { krA = *(const u32x4*)(kg + (size_t)(t0 * 32) * NP); vrA = *(const u32x4*)(vg + t0 * 32);
        *(u32x4*)(lds + t0 * AT_STAGE + kls) = krA; *(u32x2*)(lds + t0 * AT_STAGE + vls) = (u32x2){vrA.x, vrA.y}; *(u32x2*)(lds + t0 * AT_STAGE + vls + 8) = (u32x2){vrA.z, vrA.w}; }
    krA = *(const u32x4*)(kg + (size_t)(2 * 32) * NP); vrA = *(const u32x4*)(vg + 2 * 32);
    krB = *(const u32x4*)(kg + (size_t)(3 * 32) * NP); vrB = *(const u32x4*)(vg + 3 * 32);
    unsigned mwA = MASKT[(size_t)(b * 64) * SEQ + qpos], mwB = MASKT[(size_t)(b * 64 + 1) * SEQ + qpos];
    __syncthreads();
    int st = 0, st2 = 2;
#define AT_TILE(KT, KR, VR, MW) do { const int kt_ = (KT); \
        if (kt_ + 2 < nkt) { *(u32x4*)(lds + st2 * AT_STAGE + kls) = KR; *(u32x2*)(lds + st2 * AT_STAGE + vls) = (u32x2){VR.x, VR.y}; *(u32x2*)(lds + st2 * AT_STAGE + vls + 8) = (u32x2){VR.z, VR.w}; } \
        if (kt_ + 4 < nkt) { KR = *(const u32x4*)(kg + (size_t)((kt_ + 4) * 32) * NP); VR = *(const u32x4*)(vg + (kt_ + 4) * 32); } \
        if (kt_ < nkt_w) { \
            const unsigned mwc = MW; \
            if (kt_ + 2 < nkt_w) MW = MASKT[(size_t)(b * 64 + kt_ + 2) * SEQ + qpos]; \
            const bf16_t* Ks = (const bf16_t*)(lds + st * AT_STAGE); const bf16_t* Vs = (const bf16_t*)(lds + st * AT_STAGE + AT_KB); \
            f32x16 s; \
            _Pragma("unroll") for (int i = 0; i < 16; ++i) s[i] = 0.f; \
            { bf16x8 kf[8];        \
              _Pragma("unroll") for (int ks = 0; ks < 8; ++ks) kf[ks] = *(const bf16x8*)(Ks + r * AT_KRS + ks * 16 + 8 * hh); \
              __builtin_amdgcn_sched_barrier(0); \
              _Pragma("unroll") for (int ks = 0; ks < 8; ++ks) s = __builtin_amdgcn_mfma_f32_32x32x16_bf16(kf[ks], qf[ks], s, 0, 0, 0); } \
            float mx = -3e38f; const unsigned mws = mwc >> (4 * hh);        \
            _Pragma("unroll") for (int i = 0; i < 16; ++i) { const bool ok = (mws >> ((i & 3) + 8 * (i >> 2))) & 1u; s[i] = ok ? s[i] : -3e38f; mx = fmaxf(mx, s[i]); } \
            mx = fmaxf(mx, __shfl_xor(mx, 32)); \
            const float mnew = fmaxf(mrun, mx * sc), alpha = exp2f(mrun - mnew); \
            const bool grew = mnew > mrun; mrun = mnew; \
            float ps = 0.f; float pv[16]; \
            _Pragma("unroll") for (int i = 0; i < 16; ++i) { const float e = exp2f(fmaf(s[i], sc, -mnew)); pv[i] = e; ps += e; }        \
            lsum = lsum * alpha + ps; \
            if (__builtin_amdgcn_ballot_w64(grew) != 0ull) { _Pragma("unroll") for (int db = 0; db < 4; ++db) _Pragma("unroll") for (int i = 0; i < 16; ++i) o[db][i] *= alpha; } \
            bf16x8 pf[2]; \
            _Pragma("unroll") for (int s2 = 0; s2 < 2; ++s2) { u32x4 wv; wv.x = pk2(pv[8 * s2 + 0], pv[8 * s2 + 1]); wv.y = pk2(pv[8 * s2 + 2], pv[8 * s2 + 3]); wv.z = pk2(pv[8 * s2 + 4], pv[8 * s2 + 5]); wv.w = pk2(pv[8 * s2 + 6], pv[8 * s2 + 7]); pf[s2] = __builtin_bit_cast(bf16x8, wv); } \
            { u32x4 vf[4][2]; \
              _Pragma("unroll") for (int db = 0; db < 4; ++db) _Pragma("unroll") for (int s2 = 0; s2 < 2; ++s2) { const bf16_t* vp = Vs + (db * 32 + r) * AT_VRS + 16 * s2 + 4 * hh; const u32x2 lo = *(const u32x2*)vp, hi = *(const u32x2*)(vp + 8); \
                    vf[db][s2] = (u32x4){lo.x, lo.y, hi.x, hi.y}; } \
              __builtin_amdgcn_sched_barrier(0); \
              _Pragma("unroll") for (int db = 0; db < 4; ++db) _Pragma("unroll") for (int s2 = 0; s2 < 2; ++s2) o[db] = __builtin_amdgcn_mfma_f32_32x32x16_bf16(__builtin_bit_cast(bf16x8, vf[db][s2]), pf[s2], o[db], 0, 0, 0); } \
        } \
        __syncthreads(); \
        st = (st == 2) ? 0 : st + 1; st2 = (st2 == 2) ? 0 : st2 + 1; } while (0)
#pragma unroll 1
    for (int kt = 0; kt < nkt; kt += 2) { AT_TILE(kt, krA, vrA, mwA); AT_TILE(kt + 1, krB, vrB, mwB); }
#undef AT_TILE
    const float l = lsum + __shfl_xor(lsum, 32), inv = 1.f / l;
    bf16_t* op = AO + (size_t)tq * 1024 + head * 128 + 4 * hh;
#pragma unroll
    for (int db = 0; db < 4; ++db)
#pragma unroll
        for (int g4 = 0; g4 < 4; ++g4) { u32x2 wv; wv.x = pk2(o[db][4 * g4] * inv, o[db][4 * g4 + 1] * inv); wv.y = pk2(o[db][4 * g4 + 2] * inv, o[db][4 * g4 + 3] * inv);
            *(u32x2*)(op + db * 32 + 8 * g4) = wv; }
}
__device__ __forceinline__ void phase_attn(const Params& p, unsigned char* lds, int vb, int vG) {
    const int G = vG;
    for (int rd = 0;; ++rd) {
        const int base = rd * G; if (base >= 512) break;
        const int pos = (rd & 1) ? (G - 1 - vb) : vb; const int i = base + pos; if (i >= 512) continue;
        attn_item(p, lds, (i >> 3) & 7, i & 7, 7 - (i >> 6));
    }
}
__device__ __forceinline__ void phase_attn_queue(const Params& p, unsigned char* lds, unsigned* qhead) {
    volatile LAS int* slot = (volatile LAS int*)((LAS unsigned char*)lds + LDS_BYTES - 32);
    for (;;) {
        __syncthreads();
        if (threadIdx.x == 0) slot[0] = (int)__hip_atomic_fetch_add(qhead, 1u, __ATOMIC_RELAXED, __HIP_MEMORY_SCOPE_AGENT);
        __syncthreads();
        const int i = slot[0]; if (i >= 512) break;
        attn_item(p, lds, (i >> 3) & 7, i & 7, 7 - (i >> 6));
    }
}
__device__ __forceinline__ void phase_uv(const Params& p) {
    const int tid = threadIdx.x, wave = tid >> 6, lane = tid & 63;
    const int gw = blockIdx.x * NWAVES + wave, NGW = gridDim.x * NWAVES, N = 2 * 16384;
#define UV_LOAD(v, it_) do { const int tb_ = (it_) >> 14, rw_ = (it_) & 16383; const float* sp_ = (tb_ ? p.in[15] : p.in[14]) + (size_t)rw_ * 2048 + 32 * lane; \
        _Pragma("unroll") for (int j = 0; j < 8; ++j) v[j] = *(const f32x4*)(sp_ + 4 * j); } while (0)
#define UV_PROC(v, it_) do { const int tbl = (it_) >> 14, row = (it_) & 16383; \
        unsigned char* dst = p.ws + (tbl ? WS_V8 : WS_U8); float* isc = (float*)(p.ws + (tbl ? WS_ISV : WS_ISU)); float am = 0.f; \
        _Pragma("unroll") for (int j = 0; j < 8; ++j) am = fmaxf(am, fmaxf(fmaxf(fabsf(v[j][0]), fabsf(v[j][1])), fmaxf(fabsf(v[j][2]), fabsf(v[j][3])))); \
        _Pragma("unroll") for (int o = 1; o < 64; o <<= 1) am = fmaxf(am, __shfl_xor(am, o)); \
        am = fmaxf(am, 1e-30f); const float sc = (tbl ? 256.f : 127.f) / am; \
        unsigned wq[8]; \
        _Pragma("unroll") for (int j = 0; j < 8; ++j) { if (tbl == 0) { wq[j] = pack_i8x4(v[j][0] * sc, v[j][1] * sc, v[j][2] * sc, v[j][3] * sc); continue; } \
            int pk = 0; pk = __builtin_amdgcn_cvt_pk_fp8_f32(v[j][0] * sc, v[j][1] * sc, pk, false); pk = __builtin_amdgcn_cvt_pk_fp8_f32(v[j][2] * sc, v[j][3] * sc, pk, true); wq[j] = (unsigned)pk; } \
        unsigned char* d = dst + (size_t)(lane >> 2) * (2u << 20) + (size_t)row * 128 + (lane & 3) * 32; \
        *(u32x4*)d = (u32x4){wq[0], wq[1], wq[2], wq[3]}; *(u32x4*)(d + 16) = (u32x4){wq[4], wq[5], wq[6], wq[7]}; \
        if (lane == 0) isc[row] = am * (tbl ? 1.f / 256.f : 1.f / 127.f); } while (0)
    f32x4 va[8];
    for (int it = gw; it < N; it += NGW) { UV_LOAD(va, it); UV_PROC(va, it); }
#undef UV_LOAD
#undef UV_PROC
}

#define INS16(v, x) do { _Pragma("unroll") for (int _j = 15; _j >= 1; --_j) v[_j] = __builtin_amdgcn_fmed3f(v[_j - 1], v[_j], (x)); v[0] = fmaxf(v[0], (x)); } while (0)
__device__ __forceinline__ void peer_half_top16(const bf16_t* QP, const bf16_t* kb0  , int pitch, int tok, int p, int hf, int r, int hh, float (&v)[16]) {
    bf16x8 qf[8];
    { const bf16_t* qp = QP + (size_t)tok * D + p * 256 + hf * 128 + 8 * hh;
#pragma unroll
      for (int ks = 0; ks < 8; ++ks) qf[ks] = *(const bf16x8*)(qp + ks * 16); }
#pragma unroll
    for (int k = 0; k < 16; ++k) v[k] = -3.0e38f;
    const bf16_t* kb = kb0 + r * pitch + 8 * hh;
#pragma unroll 1
    for (int nb = 0; nb < 4; ++nb) {
        f32x16 acc;
#pragma unroll
        for (int i = 0; i < 16; ++i) acc[i] = 0.f;
#pragma unroll
        for (int ks = 0; ks < 8; ++ks) { const bf16x8 kf = *(const bf16x8*)(kb + (nb * 32) * pitch + ks * 16); acc = __builtin_amdgcn_mfma_f32_32x32x16_bf16(kf, qf[ks], acc, 0, 0, 0); }
#pragma unroll
        for (int i = 0; i < 16; ++i) { const unsigned xi = (unsigned)(nb * 32 + (i & 3) + 8 * (i >> 2) + 4 * hh); const float x = __uint_as_float((__float_as_uint(acc[i]) & ~0x7fu) | xi); INS16(v, x); }
    }
    float ov[16];
#pragma unroll
    for (int k = 0; k < 16; ++k) ov[k] = __shfl_xor(v[k], 32);
#pragma unroll
    for (int k = 0; k < 16; ++k) INS16(v, ov[k]);
}
constexpr int PK_RS = 136;
#define GAS __attribute__((address_space(1)))
__device__ __attribute__((noinline)) void phase_peer_topk_ni(const GAS bf16_t* QPg, const GAS bf16_t* KEYSg, GAS int* EIDXg, GAS float* EGATEg, LAS unsigned char* ldsl) {
    const bf16_t* QP = (const bf16_t*)QPg; const bf16_t* KEYS = (const bf16_t*)KEYSg; int* EIDX = (int*)EIDXg; float* EGATE = (float*)EGATEg; unsigned char* lds = (unsigned char*)ldsl;
    const int tid = threadIdx.x, wave = __builtin_amdgcn_readfirstlane(tid >> 6), lane = tid & 63, r = lane & 31, hh = lane >> 5;
    bf16_t* KL = (bf16_t*)lds;
    const int G = gridDim.x, hd = blockIdx.x & 7;
    __syncthreads();
    for (int i = tid; i < 2 * 128 * 16; i += NTHREADS) { const int row = i >> 4, ch = i & 15;
        *(u32x4*)(KL + row * PK_RS + ch * 8) = *(const u32x4*)(KEYS + (size_t)(hd * 256 + row) * 128 + ch * 8); }
    __syncthreads();
    for (int tile = blockIdx.x >> 3; tile < 64; tile += (G + 7) / 8) {
        const int tok = tile * 256 + wave * 32 + r;
        float va[16], vb[16];
        peer_half_top16(QP, KL, PK_RS, tok, hd, 0, r, hh, va);
        peer_half_top16(QP, KL + 128 * PK_RS, PK_RS, tok, hd, 1, r, hh, vb);
        float bv[16];
#pragma unroll
        for (int k = 0; k < 16; ++k) bv[k] = -3.0e38f;
#pragma unroll
        for (int a = 0; a < 16; ++a)
#pragma unroll
            for (int b2 = 0; b2 < 16; ++b2) if ((a + 1) * (b2 + 1) <= 16) { const float x = va[a] + vb[b2]; INS16(bv, x); }
        float se = 0.f;
#pragma unroll
        for (int k = 0; k < 16; ++k) se += __expf(bv[k] - bv[0]);
        const float inv = 1.f / se, thr = bv[15], top = bv[0];
        int cnt = 0; int* ei = EIDX + (size_t)tok * 128 + hd * 16; float* eg = EGATE + (size_t)tok * 128 + hd * 16;
#pragma unroll
        for (int a = 0; a < 16; ++a)
#pragma unroll
            for (int b2 = 0; b2 < 16; ++b2) if ((a + 1) * (b2 + 1) <= 16) { const float x = va[a] + vb[b2];
                if (x >= thr && cnt < 16) { if (hh == 0) { ei[cnt] = (int)((__float_as_uint(va[a]) & 0x7fu) * 128u + (__float_as_uint(vb[b2]) & 0x7fu)); eg[cnt] = __expf(x - top) * inv; } ++cnt; } }
    }
}

typedef __bf16 bf16x2_t __attribute__((ext_vector_type(2)));
__device__ __forceinline__ float gelu_erf(float v) {
    const float av = fabsf(v), d = av * 0.2316418882f + 1.0f, t = __builtin_amdgcn_rcpf(d);
    float q = t * 0.5307027145f + (-0.7265760135f); q = q * t + 0.7107068705f; q = q * t + (-0.142248368f); q = q * t + 0.127414796f; q = q * t;
    const float e = __builtin_amdgcn_exp2f((v * v) * (-0.72134752044f));
    const float m = v * (q * e), r = v - m;
    return v < 0.f ? m : r;
}
__device__ __forceinline__ float dot2bf(unsigned a, unsigned b, float c) { return __builtin_amdgcn_fdot2_f32_bf16(__builtin_bit_cast(bf16x2_t, a), __builtin_bit_cast(bf16x2_t, b), c, false); }
__device__ __forceinline__ float dpp_f(float x, int ctrl_xor1_xor2_mirror) {
    const int v = __float_as_int(x);
    if (ctrl_xor1_xor2_mirror == 0) return __int_as_float(__builtin_amdgcn_update_dpp(0, v, 0xB1, 0xF, 0xF, true));
    if (ctrl_xor1_xor2_mirror == 1) return __int_as_float(__builtin_amdgcn_update_dpp(0, v, 0x4E, 0xF, 0xF, true));
    return __int_as_float(__builtin_amdgcn_update_dpp(0, v, 0x141, 0xF, 0xF, true));
}
typedef float f32x2v __attribute__((ext_vector_type(2)));
__device__ __forceinline__ void unpack8(const u32x4 w, float* f) { f[0] = bflo(w.x); f[1] = bfhi(w.x); f[2] = bflo(w.y); f[3] = bfhi(w.y); f[4] = bflo(w.z); f[5] = bfhi(w.z); f[6] = bflo(w.w); f[7] = bfhi(w.w); }
__device__ __forceinline__ void cvt16(const u32x4 w, float* f) {
#pragma unroll
    for (int q = 0; q < 4; ++q) { const f32x2v lo = __builtin_amdgcn_cvt_pk_f32_fp8((int)w[q], false), hi = __builtin_amdgcn_cvt_pk_f32_fp8((int)w[q], true);
        f[4 * q] = lo.x; f[4 * q + 1] = lo.y; f[4 * q + 2] = hi.x; f[4 * q + 3] = hi.y; }
}
__device__ __forceinline__ void phase_experts(const Params& p, unsigned char* lds) {
    const int tid = threadIdx.x, wave = __builtin_amdgcn_readfirstlane(tid >> 6), lane = tid & 63, rr = lane >> 3, cc = lane & 7; const bool odd = cc & 1;
    const unsigned char* H8 = p.ws + WS_H8; const unsigned char* U8 = p.ws + WS_U8; const unsigned char* V8 = p.ws + WS_V8;
    const float* ISU = (const float*)(p.ws + WS_ISU); const float* ISV = (const float*)(p.ws + WS_ISV); const float* ISH = (const float*)(p.ws + WS_ISH);
    const int* EIDX = (const int*)(p.ws + WS_EIDX); const float* EGATE = (const float*)(p.ws + WS_EGATE);
    const float* mod = (const float*)(p.ws + WS_MOD); const float* fin = p.in[16]; float* out = p.out; const float* X1 = (const float*)(p.ws + WS_X1); bf16_t* X2 = (bf16_t*)(p.ws + WS_H2);
    unsigned* offs = (unsigned*)lds; float* gts = (float*)(lds + 32768); float* rstl = (float*)(lds + 65536);
    const unsigned xcc = (unsigned)__builtin_amdgcn_s_getreg((3 << 11) | 20) & 7u; const unsigned cc16 = cc * 16;
    for (int tile = blockIdx.x; tile < T / 64; tile += gridDim.x) {
        const int tok0 = tile * 64, b = tok0 >> 11;
        __syncthreads();
        for (int i = tid; i < 8192; i += NTHREADS) { const int tl = i >> 7, j = i & 127, g = j >> 3, r8 = j & 7;
            offs[(tl * 8 + r8) * 16 + g] = (unsigned)EIDX[(size_t)tok0 * 128 + i] * 128u; gts[(tl * 8 + r8) * 16 + g] = EGATE[(size_t)tok0 * 128 + i]; }
        __syncthreads();
#pragma unroll 1
        for (int half = 0; half < 2; ++half) {
            const int tlb = wave * 8 + half * 4;
            u32x4 dA[16], dB[16], hA, hB;
#ifndef EXP_REP_U
#define EXP_REP_U 0
#endif
#ifndef EXP_REP_V
#define EXP_REP_V 0
#endif
#define EX_SLICE(i_) ((xcc * 2u + (unsigned)(i_)) & 15u)
#define EX_LOAD(buf, TBL, i_, k_) EX_LOADS(buf, TBL, EX_SLICE(i_), k_)
#define EX_USL(i_) ((EXP_REP_U == 3 && (i_) >= 16) ? ((xcc * 2u) & 15u) : EX_SLICE(i_))
#define EX_LOADS(buf, TBL, SL_, k_) do { const unsigned char* tb_ = (TBL) + (size_t)(SL_) * (2u << 20); u32x4 o4_[4]; \
    _Pragma("unroll") for (int q_ = 0; q_ < 4; ++q_) o4_[q_] = *(const u32x4*)(offs + ((tlb + (k_)) * 8 + rr) * 16 + 4 * q_); \
    _Pragma("unroll") for (int g_ = 0; g_ < 16; ++g_) buf[g_] = *(const u32x4*)(tb_ + (o4_[g_ >> 2][g_ & 3] + cc16)); } while (0)
#define EX_LOADH(h0, i_, k_) do { h0 = *(const u32x4*)(H8 + ((size_t)(tok0 + tlb + (k_)) * D + EX_SLICE(i_) * 128) + cc16); if (EXP_REP_U >= 2 && (i_) >= 16) { h0.x &= zmask; h0.y &= zmask; h0.z &= zmask; h0.w &= zmask; } } while (0)
#define EX_DOT16(acc, WSRC, hq) do { u32x4 w_ = WSRC; asm volatile("" : "+v"(w_.x), "+v"(w_.y), "+v"(w_.z), "+v"(w_.w), "+v"(ch_)); \
    acc = __builtin_amdgcn_sdot4((int)w_.x, (int)hq.x, 0, false); acc = __builtin_amdgcn_sdot4((int)w_.y, (int)hq.y, acc, false); \
    acc = __builtin_amdgcn_sdot4((int)w_.z, (int)hq.z, acc, false); acc = __builtin_amdgcn_sdot4((int)w_.w, (int)hq.w, acc, false); ch_ = acc; } while (0)
#define EX_UCOMP(buf, hq, k_) do { int ch_ = 0; \
    _Pragma("unroll") for (int j_ = 0; j_ < 8; ++j_) { int te_, to_; EX_DOT16(te_, buf[2 * j_], hq); EX_DOT16(to_, buf[2 * j_ + 1], hq); \
    const int my_ = odd ? to_ : te_, ot_ = odd ? te_ : to_; zp[k_][j_] += my_ + __builtin_amdgcn_update_dpp(0, ot_, 0xB1, 0xF, 0xF, true); asm volatile("" : "+v"(zp[k_][j_])); __builtin_amdgcn_sched_barrier(0); } } while (0)
#define SB() __builtin_amdgcn_sched_barrier(0)
            int zp[4][8];
#pragma unroll
            for (int k = 0; k < 4; ++k)
#pragma unroll
                for (int j = 0; j < 8; ++j) zp[k][j] = 0;
            const unsigned zmask = (p.ph_hi > 100) ? ~0u : 0u;
            EX_LOADH(hA, 0, 0); EX_LOAD(dA, U8, 0, 0); SB();
#pragma unroll 1
            for (int i = 0; i < 16 * (EXP_REP_U ? 2 : 1); ++i) {
                __builtin_amdgcn_s_barrier();
                EX_LOADH(hB, i, 1); EX_LOADS(dB, U8, EX_USL(i), 1); SB(); EX_UCOMP(dA, hA, 0); SB();
                EX_LOADH(hA, i, 2); EX_LOADS(dA, U8, EX_USL(i), 2); SB(); EX_UCOMP(dB, hB, 1); SB();
                EX_LOADH(hB, i, 3); EX_LOADS(dB, U8, EX_USL(i), 3); SB(); EX_UCOMP(dA, hA, 2); SB();
                if (i < 16 * (EXP_REP_U ? 2 : 1) - 1) { EX_LOADH(hA, i + 1, 0); EX_LOADS(dA, U8, EX_USL(i + 1), 0); } SB(); EX_UCOMP(dB, hB, 3); SB();
            }
            if (EXP_REP_U == 1) {
#pragma unroll
                for (int k = 0; k < 4; ++k)
#pragma unroll
                    for (int j = 0; j < 8; ++j) zp[k][j] /= 2; }
            unsigned* apl = (unsigned*)(lds + 66560);
#pragma unroll
            for (int k = 0; k < 4; ++k)
#pragma unroll
                for (int j = 0; j < 8; ++j) { int zi = zp[k][j]; zi += __builtin_amdgcn_update_dpp(0, zi, 0x4E, 0xF, 0xF, true); zi += __shfl_xor(zi, 4); const float z = (float)zi * ISH[tok0 + tlb + k];
                    const int li = ((tlb + k) * 8 + rr) * 16 + 2 * j + (odd ? 1 : 0); const unsigned eid = offs[li] >> 7;
                    const float act = gelu_erf(z * ISU[eid]) * gts[li] * ISV[eid]; const float oth = dpp_f(act, 0);
                    apl[((tlb + k) * 8 + rr) * 8 + j] = f2bf(odd ? oth : act) | (f2bf(odd ? act : oth) << 16); }
            LDS_WAIT();
            float ssq[4] = {0.f, 0.f, 0.f, 0.f};
#define EX_PIN8(a) asm volatile("" : "+v"(a[0]), "+v"(a[1]), "+v"(a[2]), "+v"(a[3]), "+v"(a[4]), "+v"(a[5]), "+v"(a[6]), "+v"(a[7]))
#define EX_VFMA(WSRC, av_) do { u32x4 w_ = WSRC; asm volatile("" : "+v"(w_.x), "+v"(w_.y), "+v"(w_.z), "+v"(w_.w), "+v"(oa2_[0])); \
    _Pragma("unroll") for (int q_ = 0; q_ < 4; ++q_) { const f32x2v lo_ = __builtin_amdgcn_cvt_pk_f32_fp8((int)w_[q_], false), hi_ = __builtin_amdgcn_cvt_pk_f32_fp8((int)w_[q_], true); \
        oa2_[2 * q_] = __builtin_elementwise_fma(lo_, av_, oa2_[2 * q_]); oa2_[2 * q_ + 1] = __builtin_elementwise_fma(hi_, av_, oa2_[2 * q_ + 1]); } EX_PIN8(oa2_); } while (0)
#define EX_VCOMP(buf, i_, k_) do { f32x2v oa2_[8]; _Pragma("unroll") for (int e_ = 0; e_ < 8; ++e_) oa2_[e_] = (f32x2v){0.f, 0.f}; \
    const int col_ = (int)EX_SLICE(i_) * 128 + cc * 16 + 2 * rr; const size_t xo_ = (size_t)(tok0 + tlb + (k_)) * D + col_; \
    const f32x2v x1_ = *(const f32x2v*)(X1 + xo_), g2_ = *(const f32x2v*)(mod + (size_t)b * NADA + 5 * 2048 + col_); \
    const u32x4 ap0_ = *(const u32x4*)(apl + ((tlb + (k_)) * 8 + rr) * 8), ap1_ = *(const u32x4*)(apl + ((tlb + (k_)) * 8 + rr) * 8 + 4); \
    _Pragma("unroll") for (int j_ = 0; j_ < 8; ++j_) { const unsigned pr_ = (j_ < 4) ? ap0_[j_ & 3] : ap1_[j_ & 3]; f32x2v a0_, a1_; a0_.x = bflo(pr_); a0_.y = a0_.x; a1_.x = bfhi(pr_); a1_.y = a1_.x; \
        EX_VFMA(buf[2 * j_], a0_); EX_VFMA(buf[2 * j_ + 1], a1_); __builtin_amdgcn_sched_barrier(0); } \
    float oa_[16]; _Pragma("unroll") for (int e_ = 0; e_ < 8; ++e_) { oa_[2 * e_] = oa2_[e_].x; oa_[2 * e_ + 1] = oa2_[e_].y; } \
      \
    float b8_[8], b4_[4], b2_[2]; \
    _Pragma("unroll") for (int e_ = 0; e_ < 8; ++e_) { const bool up_ = lane & 32; const float kp_ = up_ ? oa_[e_ + 8] : oa_[e_], sd_ = up_ ? oa_[e_] : oa_[e_ + 8]; b8_[e_] = kp_ + __shfl_xor(sd_, 32); } \
    _Pragma("unroll") for (int e_ = 0; e_ < 4; ++e_) { const bool up_ = lane & 16; const float kp_ = up_ ? b8_[e_ + 4] : b8_[e_], sd_ = up_ ? b8_[e_] : b8_[e_ + 4]; b4_[e_] = kp_ + __shfl_xor(sd_, 16); } \
    _Pragma("unroll") for (int e_ = 0; e_ < 2; ++e_) { const bool up_ = lane & 8; const float kp_ = up_ ? b4_[e_ + 2] : b4_[e_], sd_ = up_ ? b4_[e_] : b4_[e_ + 2]; b2_[e_] = kp_ + __shfl_xor(sd_, 8); } \
    f32x2v y_; y_.x = x1_.x + g2_.x * b2_[0]; y_.y = x1_.y + g2_.y * b2_[1]; *(unsigned*)(X2 + xo_) = pk2(y_.x, y_.y); ssq[k_] = fmaf(y_.x, y_.x, fmaf(y_.y, y_.y, ssq[k_])); asm volatile("" : "+v"(ssq[k_])); } while (0)
#pragma unroll 1
            for (int i = 0; i < 16 * (1 + EXP_REP_V); ++i) {
                if (EXP_REP_V && i == 16) { ssq[0] = 0.f; ssq[1] = 0.f; ssq[2] = 0.f; ssq[3] = 0.f; }
                __builtin_amdgcn_s_barrier();
                if (i == 0 || (EXP_REP_V && i == 16)) { EX_LOAD(dA, V8, i, 0); }
                EX_LOAD(dB, V8, i, 1); SB(); EX_VCOMP(dA, i, 0); SB();
                EX_LOAD(dA, V8, i, 2); SB(); EX_VCOMP(dB, i, 1); SB();
                EX_LOAD(dB, V8, i, 3); SB(); EX_VCOMP(dA, i, 2); SB();
                if ((i & 15) != 15) { EX_LOAD(dA, V8, i + 1, 0); } SB(); EX_VCOMP(dB, i, 3); SB();
            }
#pragma unroll
            for (int k = 0; k < 4; ++k) { const float tot = wave_sum(ssq[k]); rstl[wave * 8 + half * 4 + k] = rsqrtf(tot * (1.f / D) + NORM_EPS); }
        }
#undef EX_SLICE
#undef EX_LOAD
#undef EX_LOADH
#undef EX_DOT16
#undef EX_UCOMP
#undef EX_VCOMP
#undef SB
        __builtin_amdgcn_fence(__ATOMIC_RELEASE, "agent"); __builtin_amdgcn_fence(__ATOMIC_ACQUIRE, "agent");
        LDS_WAIT();
        int lane2 = (int)__builtin_amdgcn_mbcnt_hi(~0u, __builtin_amdgcn_mbcnt_lo(~0u, 0u)); asm volatile("" : "+v"(lane2));
        { f32x4 fv[8]; u32x2 wa[8], wb[8];
#pragma unroll
          for (int j = 0; j < 8; ++j) fv[j] = *(const f32x4*)(fin + 4 * (lane2 + 64 * j));
#define FN_LOAD(w, k_) do { const u32x2* xr_ = (const u32x2*)(X2 + (size_t)(tok0 + wave * 8 + (k_)) * D) + lane2; _Pragma("unroll") for (int j = 0; j < 8; ++j) w[j] = xr_[64 * j]; } while (0)
#define FN_PROC(w, k_) do { float* or_ = out + (size_t)(tok0 + wave * 8 + (k_)) * D + 4 * lane2; const float rs = rstl[wave * 8 + (k_)]; \
          _Pragma("unroll") for (int j = 0; j < 8; ++j) { f32x4 o; o[0] = bflo(w[j].x) * rs * fv[j][0]; o[1] = bfhi(w[j].x) * rs * fv[j][1]; o[2] = bflo(w[j].y) * rs * fv[j][2]; o[3] = bfhi(w[j].y) * rs * fv[j][3]; *(f32x4*)(or_ + 256 * j) = o; } } while (0)
          FN_LOAD(wa, 0);
#pragma unroll
          for (int k = 0; k < 8; k += 2) {
              FN_LOAD(wb, k + 1); __builtin_amdgcn_sched_barrier(0); FN_PROC(wa, k); __builtin_amdgcn_sched_barrier(0);
              if (k + 2 < 8) FN_LOAD(wa, k + 2); __builtin_amdgcn_sched_barrier(0); FN_PROC(wb, k + 1); __builtin_amdgcn_sched_barrier(0);
          }
#undef FN_LOAD
#undef FN_PROC
        }
    }
}

#define XB_TMO      128
#define XB_XCNT(j)  (256  + 64 * (j))
#define XB_XSUB(j)  (1280 + 64 * (j))
#define XB_XGEN(j)  (2304 + 64 * (j))
#define XB_TOP      3328
#define XB_TOPGEN   3392
#define XCD_BAR_WORDS 3456
#define XB_SPIN_CAP (1u << 22)
__device__ __forceinline__ unsigned xb_ld(unsigned* p)              { return __hip_atomic_load(p, __ATOMIC_RELAXED, __HIP_MEMORY_SCOPE_AGENT); }
__device__ __forceinline__ unsigned xb_add(unsigned* p, unsigned v) { return __hip_atomic_fetch_add(p, v, __ATOMIC_RELAXED, __HIP_MEMORY_SCOPE_AGENT); }
__device__ __forceinline__ unsigned xb_xcc_id() { return (unsigned)__builtin_amdgcn_s_getreg((3 << 11) | 20) & 0xFu; }
#define XB_SPIN(cond, bar) do { unsigned _sp = 0; while (cond) { __builtin_amdgcn_s_sleep(1); \
    if ((++_sp & 255u) == 0u) { if (xb_ld(&(bar)[XB_TMO])) break; if (_sp > XB_SPIN_CAP) { atomicAdd(&(bar)[XB_TMO], 1u); break; } } } } while (0)
struct XcdBarrier { unsigned* bar; unsigned x; volatile LAS unsigned* st; };
__device__ __forceinline__ XcdBarrier xcd_barrier_post(unsigned* bar, volatile LAS unsigned* st) {
    XcdBarrier b; b.bar = bar; b.x = xb_xcc_id(); b.st = st;
    if (threadIdx.x == 0) (void)xb_add(&bar[XB_XCNT(b.x)], 1u);
    return b;
}
__device__ __forceinline__ void xcd_barrier_complete(unsigned* bar, unsigned x, unsigned& nloc, unsigned& nx) {
    const unsigned G = gridDim.x * gridDim.y * gridDim.z;
    unsigned sum, cnt, mine, sp = 0u;
    for (;;) {
        sum = 0u; cnt = 0u; mine = 0u;
#pragma unroll
        for (unsigned j = 0; j < 16; ++j) { const unsigned c = xb_ld(&bar[XB_XCNT(j)]); sum += c; cnt += (c > 0u) ? 1u : 0u; mine = (j == x) ? c : mine; }
        if (sum == G) break;
        __builtin_amdgcn_s_sleep(1);
        if ((++sp & 255u) == 0u) { if (xb_ld(&bar[XB_TMO])) break; if (sp > XB_SPIN_CAP) { atomicAdd(&bar[XB_TMO], 1u); break; } }
    }
    nloc = mine > 0u ? mine : 1u; nx = cnt > 0u ? cnt : 1u;
}
__device__ __forceinline__ void xcd_barrier(const XcdBarrier& b) {
    asm volatile("s_waitcnt vmcnt(0)" ::: "memory");
    __syncthreads();
    if (threadIdx.x == 0) {
        unsigned* bar = b.bar;
        __builtin_amdgcn_s_waitcnt(0);
        unsigned nloc = b.st[0], nx = b.st[1];
        if (nloc == 0u) { xcd_barrier_complete(bar, b.x, nloc, nx); b.st[0] = nloc; b.st[1] = nx; }
        const unsigned old = xb_add(&bar[XB_XSUB(b.x)], 1u);
        const unsigned gen = old / nloc;
        if (old + 1u == (gen + 1u) * nloc) {
            __builtin_amdgcn_fence(__ATOMIC_RELEASE, "agent");
            asm volatile("s_waitcnt vmcnt(0)" ::: "memory");
            const unsigned og = xb_add(&bar[XB_TOP], 1u);
            const unsigned tg = og / nx;
            if (og + 1u == (tg + 1u) * nx) xb_add(&bar[XB_TOPGEN], 1u);
            else XB_SPIN(xb_ld(&bar[XB_TOPGEN]) == tg, bar);
            __builtin_amdgcn_fence(__ATOMIC_ACQUIRE, "agent");
            xb_add(&bar[XB_XGEN(b.x)], 1u);
            asm volatile("s_waitcnt vmcnt(0)" ::: "memory");
        } else {
            XB_SPIN(xb_ld(&bar[XB_XGEN(b.x)]) == gen, bar);
            __builtin_amdgcn_fence(__ATOMIC_ACQUIRE, "agent");
            asm volatile("s_waitcnt vmcnt(0)" ::: "memory");
        }
    }
    __syncthreads();
}

__device__ __forceinline__ void subset_barrier(unsigned* cnt, unsigned n) {
    asm volatile("s_waitcnt vmcnt(0)" ::: "memory");
    __syncthreads();
    if (threadIdx.x == 0) {
        __builtin_amdgcn_fence(__ATOMIC_RELEASE, "agent");
        asm volatile("s_waitcnt vmcnt(0)" ::: "memory");
        __hip_atomic_fetch_add(cnt, 1u, __ATOMIC_RELAXED, __HIP_MEMORY_SCOPE_AGENT);
        unsigned sp = 0;
        while (__hip_atomic_load(cnt, __ATOMIC_RELAXED, __HIP_MEMORY_SCOPE_AGENT) < n) { __builtin_amdgcn_s_sleep(1); if (++sp > (1u << 24)) break; }
        __builtin_amdgcn_fence(__ATOMIC_ACQUIRE, "agent");
        asm volatile("s_waitcnt vmcnt(0)" ::: "memory");
    }
    __syncthreads();
}
__device__ __forceinline__ void subset_wait(unsigned* cnt, unsigned n) {
    __syncthreads();
    if (threadIdx.x == 0) {
        unsigned sp = 0;
        while (__hip_atomic_load(cnt, __ATOMIC_RELAXED, __HIP_MEMORY_SCOPE_AGENT) < n) { __builtin_amdgcn_s_sleep(2); if (++sp > (1u << 24)) break; }
        __builtin_amdgcn_fence(__ATOMIC_ACQUIRE, "agent");
        asm volatile("s_waitcnt vmcnt(0)" ::: "memory");
    }
    __syncthreads();
}
constexpr int NPHASES = 11;
__global__ void __launch_bounds__(NTHREADS, 2) mega_fwd(Params p) {
    extern __shared__ __attribute__((aligned(16))) unsigned char lds[];
    cg::grid_group grid = cg::this_grid();
    const int lo = p.ph_lo, hi = p.ph_hi;
#ifndef PHASE_MASK
#define PHASE_MASK 0x7ff
#endif
#define IN(k) (((PHASE_MASK >> (k)) & 1) && lo <= (k) && (k) < hi)
#define SEAM(k) do { if (IN(k) && IN((k) + 1)) xcd_barrier(xbar); } while (0)
    unsigned char* ws = p.ws;
    bf16_t* P = (bf16_t*)(ws + WS_P);
    bf16_t* Hb = (bf16_t*)((unsigned char*)p.out + OUT_H);
    bf16_t* WinT = (bf16_t*)((unsigned char*)p.out + OUT_WIN);
    const float* mod = (const float*)(ws + WS_MOD);
    LAS unsigned char* ldsl = (LAS unsigned char*)lds;
    volatile LAS unsigned* xst = (volatile LAS unsigned*)(ldsl + LDS_BYTES - 64);
    if (threadIdx.x < 2) xst[threadIdx.x] = 0u;
    __syncthreads();
    XcdBarrier xbar = xcd_barrier_post((unsigned*)(ws + WS_CTL) + 4096, xst);

#ifndef REPEAT_PHASE
#define REPEAT_PHASE -1
#endif
    int rep3 = 0;
#define RUNPH(k, ...) do { if (IN(k)) { __VA_ARGS__; if (REPEAT_PHASE == (k)) { grid.sync(); __VA_ARGS__; } } } while (0)
    RUNPH(0, { phase_mod(p, lds); __syncthreads(); phase_weights(p, lds); });
    SEAM(0);
    RUNPH(1, { phase_norm_rows(p.in[0], p.in[4], mod, mod + 2048, Hb, LDP); });
    SEAM(1);
    RUNPH(2, { pg8::Gemm g{Hb, WinT, nullptr, nullptr, LDP, LDP, T, NP, D}; pg8::StaticOrder<1> S; S.init(T, NP, gridDim.x, blockIdx.x);
        long long pc0 = 0, pr0 = 0; if (REPEAT_PHASE == 25) { pc0 = clock64(); pr0 = wall_clock64(); }
#ifndef SKEW_TICKS
#define SKEW_TICKS 0
#endif
        if (SKEW_TICKS > 0 && gridDim.x == 256) { const int q = (blockIdx.x >> 6) & 3; const long long t0 = wall_clock64(); while (wall_clock64() - t0 < (long long)q * SKEW_TICKS) __builtin_amdgcn_s_sleep(16); }
        pg8::EpiBf16 E{P, NP, 33}; pg8::gemm_phase(ldsl, g, S, E);
        if (REPEAT_PHASE == 25 && blockIdx.x == 0) { const long long pc1 = clock64(), pr1 = wall_clock64(); const long long mhz = (pc1 - pc0) * 100 / (pr1 - pr0);
            while (wall_clock64() - pr1 < mhz * 100) __builtin_amdgcn_s_sleep(8); }
        if (REPEAT_PHASE == 21) { grid.sync(); pg8::EpiSkip E2{E, p.ph_hi > 100}; pg8::gemm_phase(ldsl, g, S, E2); }
        if (REPEAT_PHASE == 22) { grid.sync(); pg8::EpiSkip E2{E, p.ph_hi > 100}; pg8::ProbeOrder S2{S, 0, 0}; pg8::gemm_phase(ldsl, g, S2, E2); }
        if (REPEAT_PHASE == 26) { grid.sync(); pg8::ProbeOrder S2{S, 0, 0}; pg8::gemm_phase(ldsl, g, S2, E); }
        if (REPEAT_PHASE == 23) { grid.sync(); pg8::EpiSkip E2{E, p.ph_hi > 100}; pg8::ProbeOrder S2{S, 63, 0}; pg8::gemm_phase(ldsl, g, S2, E2); }
        if (REPEAT_PHASE == 24) { grid.sync(); pg8::EpiSkip E2{E, p.ph_hi > 100}; pg8::ProbeOrder S2{S, 0, 63}; pg8::gemm_phase(ldsl, g, S2, E2); } });
    SEAM(2);
    RUNPH(3, { const int G = gridDim.x, bx = blockIdx.x;
        unsigned* sbar = (unsigned*)(ws + WS_CTL) + 12288 + ((REPEAT_PHASE == 3) ? 64 * rep3 : 0); unsigned* qh = sbar + 16;
        if (G >= 128) { if (bx < 64) { phase_hgrn(p, lds, bx, 64); if (REPEAT_PHASE == 32) phase_hgrn(p, lds, bx, 64); subset_wait(sbar, (unsigned)(G - 64)); phase_attn_queue(p, lds, qh); }
                        else { phase_vt(p, lds, bx - 64, G - 64); phase_indexer(p, lds, bx - 64, G - 64); if (REPEAT_PHASE == 31) phase_indexer(p, lds, bx - 64, G - 64);
                               subset_barrier(sbar, (unsigned)(G - 64)); phase_attn_queue(p, lds, qh); } }
        else { phase_vt(p, lds, bx, G); phase_indexer(p, lds, bx, G); __syncthreads(); phase_hgrn(p, lds, bx, G); grid.sync(); phase_attn(p, lds, bx, G); }
        ++rep3; });
    SEAM(3);
    RUNPH(5, { pg8::Gemm g{(const bf16_t*)((unsigned char*)p.out + OUT_AO), (const bf16_t*)(ws + WS_WUA), (const bf16_t*)((unsigned char*)p.out + OUT_REC), (const bf16_t*)(ws + WS_WUB), 1024, 1024, T, D, 1024}; pg8::StaticOrder<2> S; S.init(T, D, gridDim.x, blockIdx.x);
        pg8::EpiMix E{(bf16_t*)(ws + WS_MIXED), P}; pg8::gemm_phase(ldsl, g, S, E); });
    SEAM(5);
    RUNPH(6, { pg8::Gemm g{(const bf16_t*)(ws + WS_MIXED), (const bf16_t*)(ws + WS_WOUT), nullptr, nullptr, D, D, T, D, D}; pg8::StaticOrder<1> S; S.init(T, D, gridDim.x, blockIdx.x);
        pg8::EpiX1 E{p.in[0], (float*)(ws + WS_X1), mod + 4096}; pg8::gemm_phase(ldsl, g, S, E); });
    SEAM(6);
    RUNPH(7, { phase_norm_rows((const float*)(ws + WS_X1), p.in[5], mod + 3 * 2048, mod + 4 * 2048, (bf16_t*)(ws + WS_H2), D, ws + WS_H8, (float*)(ws + WS_ISH)); phase_uv(p); if (REPEAT_PHASE == 71) { grid.sync(); phase_uv(p); } });
    SEAM(7);
    RUNPH(8, { pg8::Gemm g{(const bf16_t*)(ws + WS_H2), (const bf16_t*)(ws + WS_WQ), nullptr, nullptr, D, D, T, D, D}; pg8::StaticOrder<1> S; S.init(T, D, gridDim.x, blockIdx.x);
        pg8::EpiBf16 E{(bf16_t*)(ws + WS_QP), D, 1 << 30}; pg8::gemm_phase(ldsl, g, S, E); });
    SEAM(8);
    RUNPH(9, { phase_peer_topk_ni((const GAS bf16_t*)(ws + WS_QP), (const GAS bf16_t*)(ws + WS_KEYS), (GAS int*)(ws + WS_EIDX), (GAS float*)(ws + WS_EGATE), ldsl); });
    SEAM(9);
    RUNPH(10, { phase_experts(p, lds); });
    if (p.ph_hi > NPHASES) grid.sync();
#undef IN
#undef SEAM
}

#ifndef MK_N_LAUNCHES
#define MK_N_LAUNCHES 1
#endif
extern "C" void kernel_launch(void* const* d_in, const int* in_sizes, int n_in, void* d_out, int out_size, void* d_ws, size_t ws_size, hipStream_t stream) {
    static int grid = 0;
    if (grid == 0) {
        if (n_in != 17 || out_size != T * D || ws_size < WS_END) { fprintf(stderr, "kernel_launch: unexpected shapes (n_in %d out %d ws %zu)\n", n_in, out_size, ws_size); grid = -1; return; }
        int dev = 0, cus = 0, per_cu = 0;
        hipGetDevice(&dev); hipDeviceGetAttribute(&cus, hipDeviceAttributeMultiprocessorCount, dev);
        hipFuncSetAttribute((const void*)mega_fwd, hipFuncAttributeMaxDynamicSharedMemorySize, LDS_BYTES);
        hipOccupancyMaxActiveBlocksPerMultiprocessor(&per_cu, (const void*)mega_fwd, NTHREADS, LDS_BYTES);
        if (per_cu < 1) { fprintf(stderr, "kernel_launch: occupancy query says %d blocks/CU\n", per_cu); per_cu = 1; }
        (void)hipGetLastError();
        grid = cus * 1;
    }
    if (grid < 0) return;
    if (hipMemsetAsync((char*)d_ws + WS_CTL, 0, 65536, stream) != hipSuccess) { fprintf(stderr, "kernel_launch: memset failed\n"); return; }
    Params p{};
    for (int i = 0; i < 17; ++i) p.in[i] = (const float*)d_in[i];
    p.out = (float*)d_out; p.ws = (unsigned char*)d_ws;
#if MK_N_LAUNCHES == 1
    p.ph_lo = 0; p.ph_hi = NPHASES;
    void* args[] = {&p};
    hipError_t e = hipLaunchCooperativeKernel((const void*)mega_fwd, dim3(grid), dim3(NTHREADS), args, LDS_BYTES, stream);
    if (e != hipSuccess) fprintf(stderr, "cooperative launch failed: %s (grid %d)\n", hipGetErrorString(e), grid);
#else
    for (int k = 0; k < NPHASES; ++k) { p.ph_lo = k; p.ph_hi = k + 1; void* args[] = {&p};
        hipError_t e = hipLaunchCooperativeKernel((const void*)mega_fwd, dim3(grid), dim3(NTHREADS), args, LDS_BYTES, stream);
        if (e != hipSuccess) { fprintf(stderr, "launch %d failed: %s\n", k, hipGetErrorString(e)); break; } }
#endif
}
```

```cpp
#include <hip/hip_runtime.h>
#include <hip/hip_cooperative_groups.h>
#include <cstdio>
#include <cstdint>
namespace cg = cooperative_groups;

#define LAS __attribute__((address_space(3)))
typedef unsigned short bf16_t;
typedef short bf16x8 __attribute__((ext_vector_type(8)));
typedef short bf16x4 __attribute__((ext_vector_type(4)));
typedef float f32x2 __attribute__((ext_vector_type(2)));
typedef float f32x4 __attribute__((ext_vector_type(4)));
typedef float f32x16 __attribute__((ext_vector_type(16)));
typedef unsigned u32x2 __attribute__((ext_vector_type(2)));
typedef unsigned u32x4 __attribute__((ext_vector_type(4)));

constexpr int T = 16384, D = 2048, SEQ = 2048, NBATCH = 8, NP = 12544;
constexpr int C_QA = 0, C_KA = 1024, C_VA = 2048, C_QI = 3072, C_KI = 4096, C_WI = 4160, C_QB = 4352, C_FB = 5376, C_IB = 6400, C_GB = 7424, C_GA = 8448, C_GG = 10496;
constexpr int NADA = 12288;
constexpr float NORM_EPS = 1e-6f;
constexpr int NTHREADS = 512, NWAVES = 8;
constexpr int LDS_BYTES = 147456;
constexpr size_t MiB = 1u << 20;
constexpr size_t WS_CTL = 0, WS_MOD = 1 * MiB, WS_WUA = 2 * MiB, WS_WUB = 6 * MiB, WS_WOUT = 10 * MiB, WS_WQ = 18 * MiB, WS_KEYS = 26 * MiB, WS_MASK = 27 * MiB;
constexpr size_t WS_MIXED = 32 * MiB;
constexpr size_t WS_VT = 32 * MiB, WS_ORAW = 64 * MiB;
constexpr size_t WS_P = 96 * MiB;
constexpr size_t WS_H2 = 96 * MiB, WS_QP = 160 * MiB, WS_U8 = 496 * MiB, WS_V8 = 528 * MiB  , WS_ISU = 26 * MiB + 512 * 1024, WS_ISV = 26 * MiB + 768 * 1024, WS_ISH = 26 * MiB + 896 * 1024, WS_H8 = 288 * MiB, WS_EIDX = 352 * MiB, WS_EGATE = 360 * MiB;
constexpr size_t WS_X1 = 368 * MiB;
constexpr size_t WS_END = 560 * MiB;
constexpr int LDP = 2048 + 64;
constexpr size_t OUT_H = 0, OUT_WIN = 68 * MiB;
constexpr size_t OUT_AO = 0, OUT_REC = 32 * MiB;

struct Params { const float* in[17]; float* out; unsigned char* ws; int ph_lo, ph_hi; };

__device__ __forceinline__ unsigned f2bf(float f) { unsigned u = __float_as_uint(f); return (u + 0x7fffu + ((u >> 16) & 1u)) >> 16; }
__device__ __forceinline__ float bf2f(unsigned b) { return __uint_as_float(b << 16); }
__device__ __forceinline__ float bflo(unsigned w) { return __uint_as_float(w << 16); }
__device__ __forceinline__ float bfhi(unsigned w) { return __uint_as_float(w & 0xffff0000u); }
__device__ __forceinline__ unsigned pk2(float lo, float hi) { unsigned r; asm volatile("v_cvt_pk_bf16_f32 %0, %1, %2" : "=v"(r) : "v"(lo), "v"(hi)); return r; }
__device__ __forceinline__ float wave_sum(float v) {
#pragma unroll
    for (int o = 1; o < 64; o <<= 1) v += __shfl_xor(v, o);
    return v;
}
__device__ __forceinline__ float sigmoidf_(float v) { return 1.f / (1.f + __expf(-v)); }
__device__ __forceinline__ float siluf_(float v) { return v / (1.f + __expf(-v)); }
#define LDS_WAIT() asm volatile("s_waitcnt lgkmcnt(0)" ::: "memory")

namespace pg8 {
constexpr int BM = 256, BK = 64, HALF = 128, HTB = HALF * BK * 2, STAGE_BYTES = 8 * HTB, NXCD = 8, WGM = 8;
__host__ __device__ __forceinline__ int lds_byte(int r, int c) { const int st = (r >> 4) * 2 + (c >> 5), rr = r & 15, cc = c & 31, ob = rr * 64 + cc * 2; return st * 1024 + (ob ^ (((ob >> 9) & 1) << 5)); }
__host__ __device__ __forceinline__ void stage_rc(int b, int& R, int& C) { const int st = b / 1024, sb = b % 1024, swz = sb ^ (((sb >> 9) & 1) << 5); R = (st >> 1) * 16 + swz / 64; C = (st & 1) * 32 + (swz % 64) / 2; }
__host__ __device__ __forceinline__ int perm32(int rho) { const int n = rho >> 4, i = rho & 15; return 8 * (i >> 2) + 4 * n + (i & 3); }

struct Unit { int pm, pn, z; };
struct Gemm { const bf16_t* A; const bf16_t* Bt; const bf16_t* A2; const bf16_t* Bt2; int lda, ldb, M, N, K; };

template <int NZ> struct StaticOrder {
    int nM, nN, nwg, G, c;
    __device__ void init(int M, int N, int G_, int c_) { nM = M / BM; nN = N / BM; nwg = nM * nN; G = G_; c = c_; }
    __device__ bool next(int i, Unit& u) const {
        const long L = (long)(i / NZ) * G + c; if (L >= nwg) return false;
        int wgid = (int)L; { const int q = nwg / NXCD, r = nwg % NXCD, xcd = wgid % NXCD, off = wgid / NXCD; wgid = (xcd < r ? xcd * (q + 1) : r * (q + 1) + (xcd - r) * q) + off; }
        const int nig = WGM * nN, gid = wgid / nig, fm = gid * WGM, gsz = (nM - fm) < WGM ? (nM - fm) : WGM;
        u.pm = fm + ((wgid % nig) % gsz); u.pn = (wgid % nig) / gsz; u.z = i % NZ; return true;
    }
};

struct ProbeOrder { StaticOrder<1> S; int mm, mn;
    __device__ bool next(int i, Unit& u) const { const bool r = S.next(i, u); u.pm &= mm; u.pn &= mn; return r; } };
struct SideOrder { StaticOrder<1> S; int nN, c; bool fb;
    __device__ void init(int M, int N, int G_, int c_) { S.init(M, N, G_, c_); nN = N / BM; c = c_; fb = !(G_ == 256 && (M / BM) == 64 && nN == 49); }
    __device__ bool side() const { return !fb && (c >> 3) >= 30; }
    __device__ bool next(int i, Unit& u) const {
        if (fb) return S.next(i, u);
        const int xcd = c & 7, j = c >> 3; int idx;
        if (j < 30) { if (i >= 13) return false; idx = 30 * i + j; } else { if (i >= 1) return false; idx = 390 + (j - 30); }
        u.pm = xcd * WGM + (idx % WGM); u.pn = idx / WGM; u.z = 0; return true;
    }
};
template <class Epi, class Sched>
__device__ __forceinline__ void gemm_phase(LAS unsigned char* lds, const Gemm g, const Sched& S, const Epi& E) {
    const int tid = threadIdx.x, wid = __builtin_amdgcn_readfirstlane(tid >> 6), lane = tid & 63, wr = wid >> 2, wc = wid & 3, fr = lane & 15, fq = lane >> 4;
    const int K = g.K, nt = K / BK;
    unsigned voffA[2], voffB[2];
#pragma unroll
    for (int i = 0; i < 2; ++i) { int R, C; stage_rc(tid * 16 + i * 8192, R, C); const int Rb = Epi::PERM ? ((R & ~31) + perm32(R & 31)) : R;
        voffA[i] = (unsigned)(R * g.lda + C) * 2u; voffB[i] = (unsigned)(Rb * g.ldb + C) * 2u; }
    const size_t kstep = (size_t)(BK * 2);
    const size_t hstepA = (size_t)HALF * g.lda * 2, hstepB = (size_t)HALF * g.ldb * 2;
    const size_t tstepA = 2 * hstepA, tstepB = 2 * hstepB;
    const unsigned ldsw = (unsigned)wid * 1024u;
    const int aoff = lds_byte(wr * 64 + fr, fq * 8), boff = lds_byte(wc * 32 + fr, fq * 8);
#define PG8_SA(b, h) (((b) * 2 + (h)) * HTB)
#define PG8_SB(b, h) ((4 + (b) * 2 + (h)) * HTB)
#define PG8_STAGE(bufoff, gbase, voff) do { _Pragma("unroll") for (int _i = 0; _i < 2; ++_i) \
        __builtin_amdgcn_global_load_lds((const unsigned*)((const char*)(gbase) + (voff)[_i]), (LAS unsigned*)(lds + (bufoff) + ldsw + _i * 8192), 16, 0, 0); } while (0)
#define PG8_LDA(dst, b, h) do { _Pragma("unroll") for (int m = 0; m < 4; ++m) _Pragma("unroll") for (int k = 0; k < 2; ++k) dst[m][k] = *(const LAS bf16x8*)(lds + PG8_SA(b, h) + aoff + m * 2048 + k * 1024); } while (0)
#define PG8_LDB(dst, b, h) do { _Pragma("unroll") for (int n = 0; n < 2; ++n) _Pragma("unroll") for (int k = 0; k < 2; ++k) dst[n][k] = *(const LAS bf16x8*)(lds + PG8_SB(b, h) + boff + n * 2048 + k * 1024); } while (0)
#define PG8_MMA(ai, bj, At, Bt) do { __builtin_amdgcn_s_setprio(1); _Pragma("unroll") for (int m = 0; m < 4; ++m) _Pragma("unroll") for (int n = 0; n < 2; ++n) _Pragma("unroll") for (int k = 0; k < 2; ++k) \
        acc[ai][bj][m][n] = __builtin_amdgcn_mfma_f32_16x16x32_bf16(Bt[n][k], At[m][k], acc[ai][bj][m][n], 0, 0, 0); __builtin_amdgcn_s_setprio(0); } while (0)
#define PG8_WAIT_V(n) asm volatile("s_waitcnt vmcnt(" #n ")" ::: "memory")
#define PG8_WAIT_L(n) asm volatile("s_waitcnt lgkmcnt(" #n ")" ::: "memory")
#define PG8_BAR __builtin_amdgcn_s_barrier()
#define PG8_SCHED __builtin_amdgcn_sched_barrier(0)
#define PG8_ABASE(u) ((const char*)((u).z ? g.A2 : g.A) + (size_t)(u).pm * tstepA)
#define PG8_BBASE(u) ((const char*)((u).z ? g.Bt2 : g.Bt) + (size_t)(u).pn * tstepB)
    Unit cur, nxt; int ui = 0;
    if (!S.next(0, cur)) return;
    f32x4 acc[2][2][4][2];
#pragma unroll
    for (int a = 0; a < 2; ++a)
#pragma unroll
        for (int b = 0; b < 2; ++b)
#pragma unroll
            for (int m = 0; m < 4; ++m)
#pragma unroll
                for (int n = 0; n < 2; ++n) acc[a][b][m][n] = (f32x4){0.f, 0.f, 0.f, 0.f};
    bf16x8 At[4][2], B0[2][2], B1[2][2];
    const char* cA = PG8_ABASE(cur); const char* cB = PG8_BBASE(cur);
    PG8_STAGE(PG8_SB(0, 0), cB, voffB); PG8_STAGE(PG8_SA(0, 0), cA, voffA); PG8_STAGE(PG8_SB(0, 1), cB + hstepB, voffB); PG8_STAGE(PG8_SA(0, 1), cA + hstepA, voffA);
    if (wr == 1) PG8_BAR;
    PG8_WAIT_V(4); PG8_BAR;
    PG8_STAGE(PG8_SB(1, 0), cB + kstep, voffB); PG8_STAGE(PG8_SA(1, 0), cA + kstep, voffA); PG8_STAGE(PG8_SB(1, 1), cB + hstepB + kstep, voffB);
    PG8_WAIT_V(6); PG8_BAR;
    for (;;) {
        const bool has_next = S.next(ui + 1, nxt);
        const char* nA = has_next ? PG8_ABASE(nxt) : cA; const char* nB = has_next ? PG8_BBASE(nxt) : cB;
        for (int t = 0; t < nt; t += 2) {
            const bool last = (t == nt - 2);
            const char* a1 = cA + (size_t)(t + 1) * kstep;
            const char* a2 = last ? nA : cA + (size_t)(t + 2) * kstep; const char* b2 = last ? nB : cB + (size_t)(t + 2) * kstep;
            const char* a3 = a2 + kstep; const char* b3 = b2 + kstep;
            PG8_LDB(B0, 0, 0); PG8_SCHED; PG8_LDA(At, 0, 0); PG8_STAGE(PG8_SA(1, 1), a1 + hstepA, voffA);
            PG8_WAIT_L(8); PG8_BAR; PG8_WAIT_L(0); PG8_MMA(0, 0, At, B0); PG8_BAR; PG8_SCHED;
            PG8_LDB(B1, 0, 1); PG8_STAGE(PG8_SB(0, 0), b2, voffB);
            PG8_BAR; PG8_WAIT_L(0); PG8_MMA(0, 1, At, B1); PG8_BAR;
            PG8_LDA(At, 0, 1); PG8_STAGE(PG8_SA(0, 0), a2, voffA);
            PG8_BAR; PG8_WAIT_L(0); PG8_MMA(1, 0, At, B0); PG8_BAR; PG8_SCHED;
            PG8_STAGE(PG8_SB(0, 1), b2 + hstepB, voffB);
            PG8_WAIT_V(6); PG8_BAR; PG8_MMA(1, 1, At, B1); PG8_BAR;
            PG8_LDB(B0, 1, 0); PG8_SCHED; PG8_LDA(At, 1, 0); PG8_STAGE(PG8_SA(0, 1), a2 + hstepA, voffA);
            PG8_WAIT_L(8); PG8_BAR; PG8_WAIT_L(0); PG8_MMA(0, 0, At, B0); PG8_BAR; PG8_SCHED;
            PG8_LDB(B1, 1, 1); PG8_STAGE(PG8_SB(1, 0), b3, voffB);
            PG8_BAR; PG8_WAIT_L(0); PG8_MMA(0, 1, At, B1); PG8_BAR;
            PG8_LDA(At, 1, 1); PG8_STAGE(PG8_SA(1, 0), a3, voffA);
            PG8_BAR; PG8_WAIT_L(0); PG8_MMA(1, 0, At, B0); PG8_BAR; PG8_SCHED;
            PG8_STAGE(PG8_SB(1, 1), b3 + hstepB, voffB);
            PG8_WAIT_V(6); PG8_BAR; PG8_MMA(1, 1, At, B1); PG8_BAR;
        }
        E(acc, cur, wr, wc, fr, fq);
        if (!has_next) break;
        if (!(Epi::CHAIN && cur.z == 0)) {
#pragma unroll
        for (int a = 0; a < 2; ++a)
#pragma unroll
            for (int b = 0; b < 2; ++b)
#pragma unroll
                for (int m = 0; m < 4; ++m)
#pragma unroll
                    for (int n = 0; n < 2; ++n) acc[a][b][m][n] = (f32x4){0.f, 0.f, 0.f, 0.f}; }
        cur = nxt; cA = nA; cB = nB; ++ui;
    }
    PG8_WAIT_V(0);
    if (wr == 0) PG8_BAR;
    PG8_BAR;
#undef PG8_SA
#undef PG8_SB
#undef PG8_STAGE
#undef PG8_LDA
#undef PG8_LDB
#undef PG8_MMA
#undef PG8_WAIT_V
#undef PG8_WAIT_L
#undef PG8_BAR
#undef PG8_SCHED
#undef PG8_ABASE
#undef PG8_BBASE
}

struct EpiBf16 {
    static constexpr bool PERM = true; static constexpr bool CHAIN = false;
    bf16_t* O; int ldc; int sig_from;
    __device__ __forceinline__ void operator()(const f32x4 (&acc)[2][2][4][2], const Unit& u, int wr, int wc, int fr, int fq) const {
        const int row0 = u.pm * BM + wr * 64 + fr, col0 = u.pn * BM + wc * 32 + 8 * fq; const bool sig = u.pn >= sig_from;
#pragma unroll
        for (int ai = 0; ai < 2; ++ai)
#pragma unroll
            for (int m = 0; m < 4; ++m) { bf16_t* rowp = O + (size_t)(row0 + ai * HALF + m * 16) * ldc + col0;
#pragma unroll
                for (int bj = 0; bj < 2; ++bj) { f32x4 v0 = acc[ai][bj][m][0], v1 = acc[ai][bj][m][1];
                    if (sig) {
#pragma unroll
                        for (int j = 0; j < 4; ++j) { v0[j] = sigmoidf_(v0[j]); v1[j] = sigmoidf_(v1[j]); } }
                    u32x4 w; w.x = pk2(v0[0], v0[1]); w.y = pk2(v0[2], v0[3]); w.z = pk2(v1[0], v1[1]); w.w = pk2(v1[2], v1[3]);
                    *(u32x4*)(rowp + bj * HALF) = w; } }
    }
};
struct EpiSkip {
    static constexpr bool PERM = true; static constexpr bool CHAIN = false;
    EpiBf16 E; bool on;
    __device__ __forceinline__ void operator()(const f32x4 (&acc)[2][2][4][2], const Unit& u, int wr, int wc, int fr, int fq) const { if (on) E(acc, u, wr, wc, fr, fq); }
};
struct EpiMix {
    static constexpr bool PERM = true; static constexpr bool CHAIN = true;
    bf16_t* O; const bf16_t* P;
    __device__ __forceinline__ void operator()(f32x4 (&acc)[2][2][4][2], const Unit& u, int wr, int wc, int fr, int fq) const {
        const int row0 = u.pm * BM + wr * 64 + fr, col0 = u.pn * BM + wc * 32 + 8 * fq;
#pragma unroll
        for (int ai = 0; ai < 2; ++ai) {
            u32x4 gw[4][2], pw[4][2];
#pragma unroll
            for (int m = 0; m < 4; ++m)
#pragma unroll
                for (int bj = 0; bj < 2; ++bj) { const size_t r = (size_t)(row0 + ai * HALF + m * 16);
                    gw[m][bj] = *(const u32x4*)(P + r * NP + C_GG + col0 + bj * HALF);
                    if (u.z == 0) pw[m][bj] = *(const u32x4*)(P + r * NP + C_GA + col0 + bj * HALF); else pw[m][bj] = (u32x4){0u, 0u, 0u, 0u}; }
            asm volatile("" ::: "memory");
#pragma unroll
            for (int m = 0; m < 4; ++m)
#pragma unroll
                for (int bj = 0; bj < 2; ++bj) { const u32x4 g = gw[m][bj], q = pw[m][bj];
                    if (u.z == 0) {
#pragma unroll
                        for (int n = 0; n < 2; ++n)
#pragma unroll
                            for (int e = 0; e < 4; ++e) { const unsigned gb = g[2 * n + (e >> 1)], ga = q[2 * n + (e >> 1)]; const float fb = (e & 1) ? bfhi(gb) : bflo(gb), fa = (e & 1) ? bfhi(ga) : bflo(ga);
                                acc[ai][bj][m][n][e] *= fa * __builtin_amdgcn_rcpf(fmaxf(fb, 1e-20f)); }
                    } else { const size_t r = (size_t)(row0 + ai * HALF + m * 16); const f32x4 v0 = acc[ai][bj][m][0], v1 = acc[ai][bj][m][1];
                        u32x4 w; w.x = pk2(v0[0] * bflo(g.x), v0[1] * bfhi(g.x)); w.y = pk2(v0[2] * bflo(g.y), v0[3] * bfhi(g.y));
                        w.z = pk2(v1[0] * bflo(g.z), v1[1] * bfhi(g.z)); w.w = pk2(v1[2] * bflo(g.w), v1[3] * bfhi(g.w));
                        *(u32x4*)(O + r * D + col0 + bj * HALF) = w; } }
            asm volatile("" ::: "memory");
        }
    }
};
struct EpiX1 {
    static constexpr bool PERM = false; static constexpr bool CHAIN = false;
    const float* x; float* out; const float* gate;
    __device__ __forceinline__ void operator()(const f32x4 (&acc)[2][2][4][2], const Unit& u, int wr, int wc, int fr, int fq) const {
        const int row0 = u.pm * BM + wr * 64 + fr, col0 = u.pn * BM + wc * 32 + 4 * fq; const int b = (u.pm * BM) >> 11;
        f32x4 gv[2][2];
#pragma unroll
        for (int bj = 0; bj < 2; ++bj)
#pragma unroll
            for (int n = 0; n < 2; ++n) gv[bj][n] = *(const f32x4*)(gate + (size_t)b * NADA + col0 + bj * HALF + n * 16);
#pragma unroll
        for (int ai = 0; ai < 2; ++ai) {
            f32x4 xv[4][2][2];
#pragma unroll
            for (int m = 0; m < 4; ++m)
#pragma unroll
                for (int bj = 0; bj < 2; ++bj)
#pragma unroll
                    for (int n = 0; n < 2; ++n) xv[m][bj][n] = *(const f32x4*)(x + (size_t)(row0 + ai * HALF + m * 16) * D + col0 + bj * HALF + n * 16);
            asm volatile("" ::: "memory");
#pragma unroll
            for (int m = 0; m < 4; ++m)
#pragma unroll
                for (int bj = 0; bj < 2; ++bj)
#pragma unroll
                    for (int n = 0; n < 2; ++n) *(f32x4*)(out + (size_t)(row0 + ai * HALF + m * 16) * D + col0 + bj * HALF + n * 16) = xv[m][bj][n] + gv[bj][n] * acc[ai][bj][m][n];
            asm volatile("" ::: "memory");
        }
    }
};
}

__device__ __forceinline__ void phase_mod(const Params& p, unsigned char* lds) {
    float* sc = (float*)lds;
    float* red = (float*)(lds + 65536);
    const int tid = threadIdx.x, wave = tid >> 6, lane = tid & 63;
    const float* c = p.in[1]; const float* wada = p.in[2]; const float* bada = p.in[3];
    float* mod = (float*)(p.ws + WS_MOD);
    if ((int)blockIdx.x >= 192) return;
    for (int i = tid; i < NBATCH * D; i += NTHREADS) { const int b = i >> 11, k = i & 2047; sc[k * 8 + b] = siluf_(c[i]); }
    __syncthreads();
    const int cgp = tid & 15, rg = tid >> 4;
    for (int item = blockIdx.x; item < 192; item += gridDim.x) {
        const float* w = wada + item * 64 + cgp * 4;
        float acc[8][4];
#pragma unroll
        for (int b = 0; b < 8; ++b)
#pragma unroll
            for (int j = 0; j < 4; ++j) acc[b][j] = 0.f;
#pragma unroll 1
        for (int i0 = 0; i0 < 64; i0 += 8) {
            f32x4 wvv[8];
#pragma unroll
            for (int u = 0; u < 8; ++u) wvv[u] = __builtin_nontemporal_load((const f32x4*)(w + (size_t)(rg + 32 * (i0 + u)) * NADA));
#pragma unroll
            for (int u = 0; u < 8; ++u) { const int k = rg + 32 * (i0 + u); const f32x4 wv = wvv[u];
                const f32x4 s0 = *(const f32x4*)(sc + k * 8), s1 = *(const f32x4*)(sc + k * 8 + 4);
#pragma unroll
                for (int j = 0; j < 4; ++j) { acc[0][j] += s0[0] * wv[j]; acc[1][j] += s0[1] * wv[j]; acc[2][j] += s0[2] * wv[j]; acc[3][j] += s0[3] * wv[j];
                    acc[4][j] += s1[0] * wv[j]; acc[5][j] += s1[1] * wv[j]; acc[6][j] += s1[2] * wv[j]; acc[7][j] += s1[3] * wv[j]; } } }
#pragma unroll
        for (int b = 0; b < 8; ++b)
#pragma unroll
            for (int j = 0; j < 4; ++j) { float v = acc[b][j]; v += __shfl_xor(v, 16); v += __shfl_xor(v, 32); acc[b][j] = v; }
        if (lane < 16) {
#pragma unroll
            for (int b = 0; b < 8; ++b)
#pragma unroll
                for (int j = 0; j < 4; ++j) red[(wave * 16 + cgp) * 32 + b * 4 + j] = acc[b][j]; }
        __syncthreads();
        { const int cgo = tid >> 5, b = (tid >> 2) & 7, j = tid & 3; float s = 0.f;
#pragma unroll
          for (int w8 = 0; w8 < 8; ++w8) s += red[(w8 * 16 + cgo) * 32 + (tid & 31)];
          const int col = item * 64 + cgo * 4 + j; mod[b * NADA + col] = s + bada[col]; }
        __syncthreads();
    }
}
__device__ __forceinline__ void transpose_item(const float* W, int K, int N, bf16_t* WT, int nblk, int item, int lane, float* scr, int mode, int pitch) {
    const int kb = item / nblk, nb = item % nblk, k0 = 64 * kb, n0 = 32 * nb;
    const int nd = n0 + (lane & 31); int ns = nd; bool valid = true;
    if (mode == 1) { if (nd >= C_QB) ns = nd - 176; else if (nd >= 4176) valid = false; }
    if (mode == 0 || n0 < 4160 || n0 >= C_QB) {
        const int ns0 = (mode == 1 && n0 >= C_QB) ? n0 - 176 : n0;
        f32x4 v[8];
#pragma unroll
        for (int i = 0; i < 8; ++i) v[i] = *(const f32x4*)(W + (size_t)(k0 + 8 * i + (lane >> 3)) * N + ns0 + 4 * (lane & 7));
#pragma unroll
        for (int i = 0; i < 8; ++i) { float* d = scr + (8 * i + (lane >> 3)) * 33 + 4 * (lane & 7); d[0] = v[i][0]; d[1] = v[i][1]; d[2] = v[i][2]; d[3] = v[i][3]; }
    } else {
#pragma unroll 8
        for (int i = 0; i < 32; ++i) { const int kk = 2 * i + (lane >> 5); scr[kk * 33 + (lane & 31)] = valid ? W[(size_t)(k0 + kk) * N + ns] : 0.f; }
    }
    LDS_WAIT();
    const int c = lane & 7;
#pragma unroll
    for (int j = 0; j < 4; ++j) { const int n = (lane >> 3) + 8 * j; const float* s = scr + (8 * c) * 33 + n;
        u32x4 o; o.x = pk2(s[0 * 33], s[1 * 33]); o.y = pk2(s[2 * 33], s[3 * 33]); o.z = pk2(s[4 * 33], s[5 * 33]); o.w = pk2(s[6 * 33], s[7 * 33]);
        *(u32x4*)(WT + (size_t)(n0 + n) * pitch + k0 + 8 * c) = o; }
    LDS_WAIT();
}
__device__ __forceinline__ void phase_weights(const Params& p, unsigned char* lds) {
    const int tid = threadIdx.x, wave = tid >> 6, lane = tid & 63;
    float* scr = (float*)(lds + wave * 16384);
    const int vb = ((int)blockIdx.x + (int)gridDim.x - 192 % (int)gridDim.x) % (int)gridDim.x;
    const int gw = vb * NWAVES + wave, NGW = gridDim.x * NWAVES;
    constexpr int I_IN = 32 * (NP / 32), I_UA = 16 * 64, I_UB = 16 * 64, I_O = 32 * 64, I_Q = 32 * 64;
    constexpr int NITEMS = I_IN + I_UA + I_UB + I_O + I_Q;
    bf16_t* win_t = (bf16_t*)((unsigned char*)p.out + OUT_WIN);
    for (int it = gw; it < NITEMS; it += NGW) {
        int r = it;
        if (r < I_IN) { transpose_item(p.in[6], 2048, 12368, win_t, NP / 32, r, lane, scr, 1, LDP); continue; } r -= I_IN;
        if (r < I_UA) { transpose_item(p.in[9], 1024, 2048, (bf16_t*)(p.ws + WS_WUA), 64, r, lane, scr, 0, 1024); continue; } r -= I_UA;
        if (r < I_UB) { transpose_item(p.in[10], 1024, 2048, (bf16_t*)(p.ws + WS_WUB), 64, r, lane, scr, 0, 1024); continue; } r -= I_UB;
        if (r < I_O) { transpose_item(p.in[11], 2048, 2048, (bf16_t*)(p.ws + WS_WOUT), 64, r, lane, scr, 0, 2048); continue; } r -= I_O;
        transpose_item(p.in[12], 2048, 2048, (bf16_t*)(p.ws + WS_WQ), 64, r, lane, scr, 0, 2048);
    }
    { const float* ks = p.in[13]; bf16_t* kd = (bf16_t*)(p.ws + WS_KEYS);
      for (int i = (blockIdx.x * NTHREADS + tid) * 4; i < 8 * 2 * 128 * 128; i += gridDim.x * NTHREADS * 4) { const f32x4 v = *(const f32x4*)(ks + i); u32x2 o; o.x = pk2(v[0], v[1]); o.y = pk2(v[2], v[3]); *(u32x2*)(kd + i) = o; } }
}

__device__ __forceinline__ unsigned pack_i8x4(float a, float b, float c, float d) {
    const unsigned ia = (unsigned)__float2int_rn(a) & 0xffu, ib = (unsigned)__float2int_rn(b) & 0xffu, ic = (unsigned)__float2int_rn(c) & 0xffu, id = (unsigned)__float2int_rn(d);
    return ia | (ib << 8) | (ic << 16) | (id << 24);
}
__device__ __forceinline__ void phase_norm_rows(const float* src, const float* gain, const float* shift, const float* scale, bf16_t* dst, int pitch, unsigned char* h8 = nullptr, float* ish = nullptr) {
    const int tid = threadIdx.x, wave = tid >> 6, lane = tid & 63;
    const int gw = blockIdx.x * NWAVES + wave, NGW = gridDim.x * NWAVES;
#define NR_LOAD(v, row_) do { const f32x4* xr_ = (const f32x4*)(src + (size_t)(row_) * D) + lane; _Pragma("unroll") for (int j = 0; j < 8; ++j) v[j] = xr_[64 * j]; } while (0)
#define NR_PROC(v, row_) do { const int rw_ = (row_); float ss = 0.f; \
        _Pragma("unroll") for (int j = 0; j < 8; ++j) ss += (v[j][0] * v[j][0] + v[j][1] * v[j][1]) + (v[j][2] * v[j][2] + v[j][3] * v[j][3]); \
        const float rstd = rsqrtf(wave_sum(ss) * (1.f / D) + NORM_EPS); \
        u32x2* o8 = (u32x2*)(dst + (size_t)rw_ * pitch) + lane; \
        _Pragma("unroll") for (int j = 0; j < 8; ++j) { f32x4 h; \
            _Pragma("unroll") for (int e = 0; e < 4; ++e) h[e] = v[j][e] * rstd * A[j][e] + B[j][e]; \
            u32x2 w; w.x = pk2(h[0], h[1]); w.y = pk2(h[2], h[3]); o8[64 * j] = w; v[j] = h; } \
        if (h8) {        \
            float am = 0.f; \
            _Pragma("unroll") for (int j = 0; j < 8; ++j) am = fmaxf(am, fmaxf(fmaxf(fabsf(v[j][0]), fabsf(v[j][1])), fmaxf(fabsf(v[j][2]), fabsf(v[j][3])))); \
            _Pragma("unroll") for (int o = 1; o < 64; o <<= 1) am = fmaxf(am, __shfl_xor(am, o)); \
            am = fmaxf(am, 1e-30f); const float q = 127.f / am; \
            _Pragma("unroll") for (int j = 0; j < 8; ++j) *(unsigned*)(h8 + (size_t)rw_ * D + 4 * (lane + 64 * j)) = pack_i8x4(v[j][0] * q, v[j][1] * q, v[j][2] * q, v[j][3] * q); \
            if (lane == 0) ish[rw_] = am * (1.f / 127.f); } } while (0)
    for (int base = gw * 8; base < T; base += NGW * 8) {
        const int b = base >> 11; f32x4 A[8], B[8], va[8], vb[8];
        NR_LOAD(va, base);
#pragma unroll
        for (int j = 0; j < 8; ++j) { const int col = 4 * (lane + 64 * j);
            const f32x4 g = *(const f32x4*)(gain + col), sc = *(const f32x4*)(scale + (size_t)b * NADA + col); B[j] = *(const f32x4*)(shift + (size_t)b * NADA + col);
#pragma unroll
            for (int e = 0; e < 4; ++e) A[j][e] = g[e] * (1.f + sc[e]); }
#pragma unroll
        for (int k = 0; k < 8; k += 2) {
            NR_LOAD(vb, base + k + 1); __builtin_amdgcn_sched_barrier(0); NR_PROC(va, base + k); __builtin_amdgcn_sched_barrier(0);
            if (k + 2 < 8) NR_LOAD(va, base + k + 2); __builtin_amdgcn_sched_barrier(0); NR_PROC(vb, base + k + 1); __builtin_amdgcn_sched_barrier(0);
        }
    }
#undef NR_LOAD
#undef NR_PROC
}

__device__ __forceinline__ void phase_vt(const Params& p, unsigned char* lds, int vb, int vG) {
    const int tid = threadIdx.x, wave = tid >> 6, lane = tid & 63;
    bf16_t* tile = (bf16_t*)(lds + wave * 16384);
    const bf16_t* P = (const bf16_t*)(p.ws + WS_P); bf16_t* VT = (bf16_t*)(p.ws + WS_VT);
    const int gw = vb * NWAVES + wave, NGW = vG * NWAVES;
    for (int it = gw; it < 8 * 8 * 32 * 2; it += NGW) {
        const int dh = it & 1, kt = (it >> 1) & 31, h = (it >> 6) & 7, b = it >> 9;
        const int k0 = kt * 64, d0 = dh * 64;
#pragma unroll
        for (int i = 0; i < 8; ++i) { const int key = i * 8 + (lane >> 3), dc = lane & 7;
            const u32x4 v = *(const u32x4*)(P + (size_t)(b * SEQ + k0 + key) * NP + C_VA + h * 128 + d0 + dc * 8);
            bf16_t* t = tile + (dc * 8) * 72 + key;
            t[0 * 72] = (bf16_t)(v.x & 0xffff); t[1 * 72] = (bf16_t)(v.x >> 16); t[2 * 72] = (bf16_t)(v.y & 0xffff); t[3 * 72] = (bf16_t)(v.y >> 16);
            t[4 * 72] = (bf16_t)(v.z & 0xffff); t[5 * 72] = (bf16_t)(v.z >> 16); t[6 * 72] = (bf16_t)(v.w & 0xffff); t[7 * 72] = (bf16_t)(v.w >> 16); }
        LDS_WAIT();
#pragma unroll
        for (int i = 0; i < 8; ++i) { const int d = i * 8 + (lane >> 3), kc = lane & 7;
            const u32x4 v = *(const u32x4*)(tile + d * 72 + kc * 8);
            *(u32x4*)(VT + ((size_t)((b * 8 + h) * 128 + d0 + d)) * SEQ + k0 + kc * 8) = v; }
        LDS_WAIT();
    }
}

__device__ __forceinline__ unsigned ord_key(float s) { const unsigned u = __float_as_uint(s); return (u & 0x80000000u) ? ~u : (u | 0x80000000u); }
__device__ __forceinline__ int half_sum(int v) {
    v += __builtin_amdgcn_update_dpp(0, v, 0xB1, 0xF, 0xF, true);
    v += __builtin_amdgcn_update_dpp(0, v, 0x4E, 0xF, 0xF, true);
    v += __builtin_amdgcn_update_dpp(0, v, 0x141, 0xF, 0xF, true);
    v += __builtin_amdgcn_update_dpp(0, v, 0x140, 0xF, 0xF, true);
    v += __shfl_xor(v, 16);
    return v;
}
constexpr int IX_RS = 72, IX_STAGE = 32 * IX_RS * 2;
__device__ __forceinline__ void indexer_item(const Params& p, unsigned char* lds, int b, int c, int grp) {
    const int tid = threadIdx.x, w = __builtin_amdgcn_readfirstlane(tid >> 6), lane = tid & 63, r = lane & 31, hh = lane >> 5;
    const bf16_t* P = (const bf16_t*)(p.ws + WS_P); unsigned* MASK = (unsigned*)(p.ws + WS_MASK);
    const int pair = grp * 8 + w, q0 = b * SEQ + c * 64 + 2 * pair;
    bf16x8 af[4];
    { const int query = q0 + ((r >> 2) & 1), head = (r & 3) + 4 * (r >> 3);
      const bf16_t* qp = P + (size_t)query * NP + C_QI + head * 64 + 8 * hh;
#pragma unroll
      for (int ks = 0; ks < 4; ++ks) af[ks] = *(const bf16x8*)(qp + ks * 16); }
    float wv[16];
    { const u32x4 w0 = *(const u32x4*)(P + (size_t)(q0 + hh) * NP + C_WI), w1 = *(const u32x4*)(P + (size_t)(q0 + hh) * NP + C_WI + 8);
      wv[0] = bflo(w0.x); wv[1] = bfhi(w0.x); wv[2] = bflo(w0.y); wv[3] = bfhi(w0.y); wv[4] = bflo(w0.z); wv[5] = bfhi(w0.z); wv[6] = bflo(w0.w); wv[7] = bfhi(w0.w);
      wv[8] = bflo(w1.x); wv[9] = bfhi(w1.x); wv[10] = bflo(w1.y); wv[11] = bfhi(w1.y); wv[12] = bflo(w1.z); wv[13] = bfhi(w1.z); wv[14] = bflo(w1.w); wv[15] = bfhi(w1.w); }
    const int nkt = 2 * (c + 1);
    const bool ldr = tid < 256;
    const bf16_t* kg = P + (size_t)(b * SEQ + ((tid >> 3) & 31)) * NP + C_KI + (tid & 7) * 8;
    const int kls = ((tid >> 3) & 31) * IX_RS * 2 + (tid & 7) * 16;
    u32x4 kr = {0u, 0u, 0u, 0u};
    __syncthreads();
    if (ldr) { *(u32x4*)(lds + kls) = *(const u32x4*)kg; *(u32x4*)(lds + IX_STAGE + kls) = *(const u32x4*)(kg + (size_t)32 * NP); }
    if (ldr && 2 < nkt) kr = *(const u32x4*)(kg + (size_t)64 * NP);
    __syncthreads();
    unsigned kv[64];
#pragma unroll
    for (int kt = 0; kt < 64; ++kt) {
        kv[kt] = 0u;
        if (kt < nkt) {
            if (ldr && kt + 2 < nkt) *(u32x4*)(lds + ((kt + 2) % 3) * IX_STAGE + kls) = kr;
            if (ldr && kt + 3 < nkt) kr = *(const u32x4*)(kg + (size_t)((kt + 3) * 32) * NP);
            const bf16_t* Ks = (const bf16_t*)(lds + (kt % 3) * IX_STAGE);
            f32x16 acc;
#pragma unroll
            for (int i = 0; i < 16; ++i) acc[i] = 0.f;
#pragma unroll
            for (int ks = 0; ks < 4; ++ks) { const bf16x8 bfr = *(const bf16x8*)(Ks + r * IX_RS + ks * 16 + 8 * hh); acc = __builtin_amdgcn_mfma_f32_32x32x16_bf16(af[ks], bfr, acc, 0, 0, 0); }
            float sc = 0.f;
#pragma unroll
            for (int i = 0; i < 16; ++i) sc += wv[i] * fmaxf(acc[i], 0.f);
            kv[kt] = ord_key(sc);
            __syncthreads();
        }
    }
    unsigned thr = 0u;
    if (nkt > 8) {
        int cur = 1 << 20;
        for (int bit = 31; bit >= 0; --bit) {
            const unsigned cand = thr | (1u << bit); int cnt = 0;
#pragma unroll
            for (int kt = 0; kt < 32; ++kt) cnt += (kv[kt] >= cand) ? 1 : 0;
            if (nkt > 32) {
#pragma unroll
                for (int kt = 32; kt < 64; ++kt) cnt += (kv[kt] >= cand) ? 1 : 0; }
            cnt = half_sum(cnt);
            if (cnt >= 256) { thr = cand; cur = cnt; }
            if (__builtin_amdgcn_ballot_w64(cur != 256) == 0ull) break;
        }
    }
    int cge = 0;
#pragma unroll
    for (int kt = 0; kt < 64; ++kt) cge += (kv[kt] >= thr && kv[kt] != 0u) ? 1 : 0;
    cge = half_sum(cge);
    const bool ties = (thr != 0u) && (cge > 256);
    unsigned m0 = 0u, m1 = 0u;
    if (__builtin_amdgcn_ballot_w64(ties) == 0ull) {
#pragma unroll
        for (int kt = 0; kt < 64; ++kt) { const unsigned long long bm = __builtin_amdgcn_ballot_w64(kv[kt] >= thr && kv[kt] != 0u);
            if (lane == kt) { m0 = (unsigned)bm; m1 = (unsigned)(bm >> 32); } }
    } else {
        int cgt = 0;
#pragma unroll
        for (int kt = 0; kt < 64; ++kt) cgt += (kv[kt] > thr) ? 1 : 0;
        cgt = half_sum(cgt);
        const int need = ties ? (256 - cgt) : (1 << 30); int run = 0;
#pragma unroll
        for (int kt = 0; kt < 64; ++kt) { const bool tie = ties && (kv[kt] == thr); const unsigned long long tb = __builtin_amdgcn_ballot_w64(tie);
            const unsigned th = hh ? (unsigned)(tb >> 32) : (unsigned)tb; const int rank = run + __builtin_popcount(th & ((1u << r) - 1u));
            const bool sel = ties ? ((kv[kt] > thr) || (tie && rank < need)) : (kv[kt] >= thr && kv[kt] != 0u);
            run += __builtin_popcount(th);
            const unsigned long long bm = __builtin_amdgcn_ballot_w64(sel);
            if (lane == kt) { m0 = (unsigned)bm; m1 = (unsigned)(bm >> 32); } }
    }
    { const int qpos = c * 64 + 2 * pair; unsigned* mt = MASK + ((size_t)(b * 64 + lane)) * SEQ + qpos; mt[0] = m0; mt[1] = m1; }
}
__device__ __forceinline__ void phase_indexer(const Params& p, unsigned char* lds, int vb, int vG) {
    const int G = vG;
    for (int rd = 0;; ++rd) {
        const int base = rd * G; if (base >= 1024) break;
        const int pos = (rd & 1) ? (G - 1 - vb) : vb; const int i = base + pos; if (i >= 1024) continue;
        indexer_item(p, lds, (i >> 2) & 7, 31 - (i >> 5), i & 3);
    }
}

#ifndef HG_REP_A
#define HG_REP_A 0
#endif
#ifndef HG_REP_B
#define HG_REP_B 0
#endif
constexpr int HG_RS = 136, HG_TS = 72, HG_SS = 136;
constexpr int HG_QT = 0, HG_QH = 17408, HG_KT = 34816, HG_KHT = 52224, HG_VT = 70656, HG_ST = 89088, HG_DEC = 123904, HG_SSQ = 124416, HG_OT = 125440;
__device__ __forceinline__ void hgrn_item(const Params& p, unsigned char* lds, int item) {
    const int tid = threadIdx.x, w = __builtin_amdgcn_readfirstlane(tid >> 6), lane = tid & 63, r = lane & 31, hh = lane >> 5;
    const int b = item >> 3, h = item & 7;
    const bf16_t* P = (const bf16_t*)(p.ws + WS_P); bf16_t* REC = (bf16_t*)((unsigned char*)p.out + OUT_REC);
    bf16_t* QT = (bf16_t*)(lds + HG_QT); bf16_t* QH = (bf16_t*)(lds + HG_QH); bf16_t* KT = (bf16_t*)(lds + HG_KT); bf16_t* KHT = (bf16_t*)(lds + HG_KHT); bf16_t* VT = (bf16_t*)(lds + HG_VT);
    bf16_t* ST = (bf16_t*)(lds + HG_ST); float* DEC = (float*)(lds + HG_DEC); float* SSQ = (float*)(lds + HG_SSQ); bf16_t* OT = (bf16_t*)(lds + HG_OT);
    const int seg = lane >> 4, dl = lane & 15, d = 16 * w + dl;
    const float lb = sigmoidf_(p.in[7][h * 128 + d] - p.in[7][1024 + h * 128 + d]);
    const int tb = w & 1, eb = w >> 1, sdb = w & 3, seb0 = 2 * (w >> 2);
    const int ot_t = tid >> 3, ot_c = tid & 7;
    float gn[16];
#pragma unroll
    for (int j = 0; j < 4; ++j) { const f32x4 g4 = *(const f32x4*)(p.in[8] + 16 * ot_c + 4 * j); gn[4 * j] = g4[0]; gn[4 * j + 1] = g4[1]; gn[4 * j + 2] = g4[2]; gn[4 * j + 3] = g4[3]; }
    f32x16 S0, S1;
#pragma unroll
    for (int i = 0; i < 16; ++i) { S0[i] = 0.f; S1[i] = 0.f; }
    __syncthreads();
    for (int i = tid; i < 128 * HG_SS / 2; i += NTHREADS) ((unsigned*)ST)[i] = 0u;
    unsigned short rq[16], rf[16], ri[16];
    { const bf16_t* src = P + (size_t)(b * SEQ + 16 * seg) * NP + h * 128 + d;
#pragma unroll
      for (int i = 0; i < 16; ++i) { rq[i] = src[(size_t)i * NP + C_QB]; rf[i] = src[(size_t)i * NP + C_FB]; ri[i] = src[(size_t)i * NP + C_IB]; } }
#pragma unroll 1
    for (int n = 0; n < 32; ++n) {
#pragma unroll 1
        for (int repa = 0; repa <= HG_REP_A; ++repa) {
            float lf[16], kk[16];
            float run = 0.f;
#pragma unroll
            for (int i = 0; i < 16; ++i) { const float f = lb + (1.f - lb) * sigmoidf_(bf2f(rf[i])); kk[i] = 1.f - f; run += __logf(f); lf[i] = run; }
            const float p0 = __shfl(run, dl), p1 = __shfl(run, 16 + dl), p2 = __shfl(run, 32 + dl), p3 = __shfl(run, 48 + dl);
            const float off = (seg > 0 ? p0 : 0.f) + (seg > 1 ? p1 : 0.f) + (seg > 2 ? p2 : 0.f), bL = (p0 + p1) + (p2 + p3), bref = p0 + p1;
            const float eref = __expf(fmaxf(bref, -80.f)), elref = __expf(fmaxf(bL - bref, -80.f));
            unsigned kh[8], vv[8];
#pragma unroll
            for (int i = 0; i < 16; ++i) { const float bt = off + lf[i]; const float qs = siluf_(bf2f(rq[i]));
                const float e1 = __expf(__builtin_amdgcn_fmed3f(bt - bref, -80.f, 80.f)), e2 = e1 * eref, e3 = __builtin_amdgcn_rcpf(e1), e4 = e3 * elref;
                const int t = 16 * seg + i;
                QT[t * HG_RS + d] = (bf16_t)f2bf(qs * e1); QH[t * HG_RS + d] = (bf16_t)f2bf(qs * e2); KT[t * HG_RS + d] = (bf16_t)f2bf(kk[i] * e3);
                const unsigned khv = f2bf(kk[i] * e4);
                if (i & 1) { kh[i >> 1] |= khv << 16; vv[i >> 1] |= (unsigned)ri[i] << 16; } else { kh[i >> 1] = khv; vv[i >> 1] = (unsigned)ri[i]; } }
            *(u32x4*)(KHT + d * HG_TS + 16 * seg) = (u32x4){kh[0], kh[1], kh[2], kh[3]}; *(u32x4*)(KHT + d * HG_TS + 16 * seg + 8) = (u32x4){kh[4], kh[5], kh[6], kh[7]};
            *(u32x4*)(VT + d * HG_TS + 16 * seg) = (u32x4){vv[0], vv[1], vv[2], vv[3]}; *(u32x4*)(VT + d * HG_TS + 16 * seg + 8) = (u32x4){vv[4], vv[5], vv[6], vv[7]};
            if (seg == 0) DEC[d] = eref * elref;
        }
        __syncthreads();
        if (n < 31) { const bf16_t* src = P + (size_t)(b * SEQ + (n + 1) * 64 + 16 * seg) * NP + h * 128 + d;
#pragma unroll
            for (int i = 0; i < 16; ++i) { rq[i] = src[(size_t)i * NP + C_QB]; rf[i] = src[(size_t)i * NP + C_FB]; ri[i] = src[(size_t)i * NP + C_IB]; } }
        const u32x4 gb0 = *(const u32x4*)(P + (size_t)(b * SEQ + n * 64 + ot_t) * NP + C_GB + h * 128 + 16 * ot_c), gb1 = *(const u32x4*)(P + (size_t)(b * SEQ + n * 64 + ot_t) * NP + C_GB + h * 128 + 16 * ot_c + 8);
        f32x16 X0, X1, o;
#pragma unroll 1
        for (int repb = 0; repb <= HG_REP_B; ++repb) {
#pragma unroll
        for (int i = 0; i < 16; ++i) { X0[i] = 0.f; X1[i] = 0.f; o[i] = 0.f; }
#pragma unroll
        for (int ks = 0; ks < 8; ++ks) { const bf16x8 bq = *(const bf16x8*)(QT + (32 * tb + r) * HG_RS + 16 * ks + 8 * hh);
            const bf16x8 a0 = *(const bf16x8*)(KT + r * HG_RS + 16 * ks + 8 * hh); X0 = __builtin_amdgcn_mfma_f32_32x32x16_bf16(a0, bq, X0, 0, 0, 0);
            if (tb == 1) { const bf16x8 a1 = *(const bf16x8*)(KT + (32 + r) * HG_RS + 16 * ks + 8 * hh); X1 = __builtin_amdgcn_mfma_f32_32x32x16_bf16(a1, bq, X1, 0, 0, 0); } }
#pragma unroll
        for (int i = 0; i < 16; ++i) { const bool keep = ((i & 3) + 8 * (i >> 2) + 4 * hh) <= r; if (tb == 0) X0[i] = keep ? X0[i] : 0.f; else X1[i] = keep ? X1[i] : 0.f; }
#pragma unroll
        for (int sb = 0; sb < 2; ++sb) { if (sb <= tb) {
#pragma unroll
            for (int s2 = 0; s2 < 2; ++s2) { u32x4 aw;
                if (sb == 0) { aw.x = pk2(X0[8 * s2], X0[8 * s2 + 1]); aw.y = pk2(X0[8 * s2 + 2], X0[8 * s2 + 3]); aw.z = pk2(X0[8 * s2 + 4], X0[8 * s2 + 5]); aw.w = pk2(X0[8 * s2 + 6], X0[8 * s2 + 7]); }
                else { aw.x = pk2(X1[8 * s2], X1[8 * s2 + 1]); aw.y = pk2(X1[8 * s2 + 2], X1[8 * s2 + 3]); aw.z = pk2(X1[8 * s2 + 4], X1[8 * s2 + 5]); aw.w = pk2(X1[8 * s2 + 6], X1[8 * s2 + 7]); }
                const bf16_t* vp = VT + (32 * eb + r) * HG_TS + 32 * sb + 16 * s2 + 4 * hh;
                const u32x2 lo = *(const u32x2*)vp, hi = *(const u32x2*)(vp + 8); const u32x4 bw = {lo.x, lo.y, hi.x, hi.y};
                o = __builtin_amdgcn_mfma_f32_32x32x16_bf16(__builtin_bit_cast(bf16x8, aw), __builtin_bit_cast(bf16x8, bw), o, 0, 0, 0); } } }
#pragma unroll
        for (int ks = 0; ks < 8; ++ks) { const bf16x8 aq = *(const bf16x8*)(QH + (32 * tb + r) * HG_RS + 16 * ks + 8 * hh), bs = *(const bf16x8*)(ST + (32 * eb + r) * HG_SS + 16 * ks + 8 * hh);
            o = __builtin_amdgcn_mfma_f32_32x32x16_bf16(aq, bs, o, 0, 0, 0); }
        { float a8[8], a4[4], a2[2], a1;
#pragma unroll
          for (int i = 0; i < 8; ++i) { const float lo = o[i] * o[i], hi = o[i + 8] * o[i + 8]; const bool up = lane & 16; const float keep = up ? hi : lo, send = up ? lo : hi; a8[i] = keep + __shfl_xor(send, 16); }
#pragma unroll
          for (int i = 0; i < 4; ++i) { const bool up = lane & 8; const float keep = up ? a8[i + 4] : a8[i], send = up ? a8[i] : a8[i + 4]; a4[i] = keep + __shfl_xor(send, 8); }
#pragma unroll
          for (int i = 0; i < 2; ++i) { const bool up = lane & 4; const float keep = up ? a4[i + 2] : a4[i], send = up ? a4[i] : a4[i + 2]; a2[i] = keep + __shfl_xor(send, 4); }
          { const bool up = lane & 2; const float keep = up ? a2[1] : a2[0], send = up ? a2[0] : a2[1]; a1 = keep + __shfl_xor(send, 2); }
          a1 += __shfl_xor(a1, 1);
          const int ri2 = (lane >> 1) & 15;
          if ((lane & 1) == 0) SSQ[(32 * tb + (ri2 & 3) + 8 * (ri2 >> 2) + 4 * hh) * 4 + eb] = a1; }
#pragma unroll
        for (int i = 0; i < 16; ++i) OT[(32 * tb + (i & 3) + 8 * (i >> 2) + 4 * hh) * HG_RS + 32 * eb + r] = (bf16_t)f2bf(o[i]);
        }
        { float dc[16];
#pragma unroll
          for (int g4 = 0; g4 < 4; ++g4) { const f32x4 dv = *(const f32x4*)(DEC + 32 * sdb + 8 * g4 + 4 * hh); dc[4 * g4] = dv[0]; dc[4 * g4 + 1] = dv[1]; dc[4 * g4 + 2] = dv[2]; dc[4 * g4 + 3] = dv[3]; }
#pragma unroll
          for (int i = 0; i < 16; ++i) { S0[i] *= dc[i]; S1[i] *= dc[i]; }
#pragma unroll
          for (int ss = 0; ss < 4; ++ss) { const bf16x8 a = *(const bf16x8*)(KHT + (32 * sdb + r) * HG_TS + 16 * ss + 8 * hh);
              const bf16x8 b0 = *(const bf16x8*)(VT + (32 * seb0 + r) * HG_TS + 16 * ss + 8 * hh), b1 = *(const bf16x8*)(VT + (32 * (seb0 + 1) + r) * HG_TS + 16 * ss + 8 * hh);
              S0 = __builtin_amdgcn_mfma_f32_32x32x16_bf16(a, b0, S0, 0, 0, 0); S1 = __builtin_amdgcn_mfma_f32_32x32x16_bf16(a, b1, S1, 0, 0, 0); } }
        __syncthreads();
#pragma unroll
        for (int g4 = 0; g4 < 4; ++g4) { const int d0 = 32 * sdb + 8 * g4 + 4 * hh;
            *(u32x2*)(ST + (32 * seb0 + r) * HG_SS + d0) = (u32x2){pk2(S0[4 * g4], S0[4 * g4 + 1]), pk2(S0[4 * g4 + 2], S0[4 * g4 + 3])};
            *(u32x2*)(ST + (32 * (seb0 + 1) + r) * HG_SS + d0) = (u32x2){pk2(S1[4 * g4], S1[4 * g4 + 1]), pk2(S1[4 * g4 + 2], S1[4 * g4 + 3])}; }
        { const f32x4 q4 = *(const f32x4*)(SSQ + ot_t * 4); const float rstd = rsqrtf(((q4[0] + q4[1]) + (q4[2] + q4[3])) * (1.f / 128.f) + NORM_EPS);
          const u32x4 o0 = *(const u32x4*)(OT + ot_t * HG_RS + 16 * ot_c), o1 = *(const u32x4*)(OT + ot_t * HG_RS + 16 * ot_c + 8);
          const unsigned ow[8] = {o0.x, o0.y, o0.z, o0.w, o1.x, o1.y, o1.z, o1.w}, gwv[8] = {gb0.x, gb0.y, gb0.z, gb0.w, gb1.x, gb1.y, gb1.z, gb1.w};
          unsigned rw[8];
#pragma unroll
          for (int j = 0; j < 8; ++j) rw[j] = pk2(bflo(ow[j]) * rstd * gn[2 * j] * siluf_(bflo(gwv[j])), bfhi(ow[j]) * rstd * gn[2 * j + 1] * siluf_(bfhi(gwv[j])));
          bf16_t* dst = REC + (size_t)(b * SEQ + n * 64 + ot_t) * 1024 + h * 128 + 16 * ot_c;
          *(u32x4*)dst = (u32x4){rw[0], rw[1], rw[2], rw[3]}; *(u32x4*)(dst + 8) = (u32x4){rw[4], rw[5], rw[6], rw[7]}; }
    }
}
__device__ __forceinline__ void phase_hgrn(const Params& p, unsigned char* lds, int vb, int vG) {
    for (int it = vb; it < 64; it += vG) hgrn_item(p, lds, it);
}

constexpr int AT_KRS = 136, AT_VRS = 36, AT_KB = 32 * AT_KRS * 2, AT_VB = 128 * AT_VRS * 2, AT_STAGE = AT_KB + AT_VB;
__device__ __forceinline__ void attn_item(const Params& p, unsigned char* lds, int b, int head, int cq) {
    const int tid = threadIdx.x, w = __builtin_amdgcn_readfirstlane(tid >> 6), lane = tid & 63, r = lane & 31, hh = lane >> 5;
    const bf16_t* P = (const bf16_t*)(p.ws + WS_P); const bf16_t* VT = (const bf16_t*)(p.ws + WS_VT); const unsigned* MASKT = (const unsigned*)(p.ws + WS_MASK);
    bf16_t* AO = (bf16_t*)((unsigned char*)p.out + OUT_AO);
    const int c = 4 * cq + (w >> 1), qpos = c * 64 + (w & 1) * 32 + r, tq = b * SEQ + qpos;
    const int nkt_w = 2 * (c + 1), nkt = 8 * (cq + 1);
    const bf16_t* kg = P + (size_t)(b * SEQ + (tid >> 4)) * NP + C_KA + head * 128 + (tid & 15) * 8;
    const bf16_t* vg = VT + (size_t)((b * 8 + head) * 128 + (tid >> 2)) * SEQ + (tid & 3) * 8;
    const int kls = (tid >> 4) * AT_KRS * 2 + (tid & 15) * 16, vls = AT_KB + (tid >> 2) * AT_VRS * 2 + (tid & 3) * 16;
    bf16x8 qf[8];
    { const bf16_t* qp = P + (size_t)tq * NP + C_QA + head * 128 + 8 * hh;
#pragma unroll
      for (int ks = 0; ks < 8; ++ks) qf[ks] = *(const bf16x8*)(qp + ks * 16); }
    f32x16 o[4];
#pragma unroll
    for (int db = 0; db < 4; ++db)
#pragma unroll
        for (int i = 0; i < 16; ++i) o[db][i] = 0.f;
    float mrun = -1e30f, lsum = 0.f;
    const float sc = 0.08838834764831845f * 1.4426950408889634f;
    __syncthreads();
    u32x4 krA, vrA, krB, vrB;
#pragma unroll
    for (int t0 = 0; t0 < 2; ++t0) { krA = *(const u32x4*)(kg + (size_t)(t0 * 32) * NP); vrA = *(const u32x4*)(vg + t0 * 32);
        *(u32x4*)(lds + t0 * AT_STAGE + kls) = krA; *(u32x2*)(lds + t0 * AT_STAGE + vls) = (u32x2){vrA.x, vrA.y}; *(u32x2*)(lds + t0 * AT_STAGE + vls + 8) = (u32x2){vrA.z, vrA.w}; }
    krA = *(const u32x4*)(kg + (size_t)(2 * 32) * NP); vrA = *(const u32x4*)(vg + 2 * 32);
    krB = *(const u32x4*)(kg + (size_t)(3 * 32) * NP); vrB = *(const u32x4*)(vg + 3 * 32);
    unsigned mwA = MASKT[(size_t)(b * 64) * SEQ + qpos], mwB = MASKT[(size_t)(b * 64 + 1) * SEQ + qpos];
    __syncthreads();
    int st = 0, st2 = 2;
#define AT_TILE(KT, KR, VR, MW) do { const int kt_ = (KT); \
        if (kt_ + 2 < nkt) { *(u32x4*)(lds + st2 * AT_STAGE + kls) = KR; *(u32x2*)(lds + st2 * AT_STAGE + vls) = (u32x2){VR.x, VR.y}; *(u32x2*)(lds + st2 * AT_STAGE + vls + 8) = (u32x2){VR.z, VR.w}; } \
        if (kt_ + 4 < nkt) { KR = *(const u32x4*)(kg + (size_t)((kt_ + 4) * 32) * NP); VR = *(const u32x4*)(vg + (kt_ + 4) * 32); } \
        if (kt_ < nkt_w) { \
            const unsigned mwc = MW; \
            if (kt_ + 2 < nkt_w) MW = MASKT[(size_t)(b * 64 + kt_ + 2) * SEQ + qpos]; \
            const bf16_t* Ks = (const bf16_t*)(lds + st * AT_STAGE); const bf16_t* Vs = (const bf16_t*)(lds + st * AT_STAGE + AT_KB); \
            f32x16 s; \
            _Pragma("unroll") for (int i = 0; i < 16; ++i) s[i] = 0.f; \
            { bf16x8 kf[8];        \
              _Pragma("unroll") for (int ks = 0; ks < 8; ++ks) kf[ks] = *(const bf16x8*)(Ks + r * AT_KRS + ks * 16 + 8 * hh); \
              __builtin_amdgcn_sched_barrier(0); \
              _Pragma("unroll") for (int ks = 0; ks < 8; ++ks) s = __builtin_amdgcn_mfma_f32_32x32x16_bf16(kf[ks], qf[ks], s, 0, 0, 0); } \
            float mx = -3e38f; const unsigned mws = mwc >> (4 * hh);        \
            _Pragma("unroll") for (int i = 0; i < 16; ++i) { const bool ok = (mws >> ((i & 3) + 8 * (i >> 2))) & 1u; s[i] = ok ? s[i] : -3e38f; mx = fmaxf(mx, s[i]); } \
            mx = fmaxf(mx, __shfl_xor(mx, 32)); \
            const float mnew = fmaxf(mrun, mx * sc), alpha = exp2f(mrun - mnew); \
            const bool grew = mnew > mrun; mrun = mnew; \
            float ps = 0.f; float pv[16]; \
            _Pragma("unroll") for (int i = 0; i < 16; ++i) { const float e = exp2f(fmaf(s[i], sc, -mnew)); pv[i] = e; ps += e; }        \
            lsum = lsum * alpha + ps; \
            if (__builtin_amdgcn_ballot_w64(grew) != 0ull) { _Pragma("unroll") for (int db = 0; db < 4; ++db) _Pragma("unroll") for (int i = 0; i < 16; ++i) o[db][i] *= alpha; } \
            bf16x8 pf[2]; \
            _Pragma("unroll") for (int s2 = 0; s2 < 2; ++s2) { u32x4 wv; wv.x = pk2(pv[8 * s2 + 0], pv[8 * s2 + 1]); wv.y = pk2(pv[8 * s2 + 2], pv[8 * s2 + 3]); wv.z = pk2(pv[8 * s2 + 4], pv[8 * s2 + 5]); wv.w = pk2(pv[8 * s2 + 6], pv[8 * s2 + 7]); pf[s2] = __builtin_bit_cast(bf16x8, wv); } \
            { u32x4 vf[4][2]; \
              _Pragma("unroll") for (int db = 0; db < 4; ++db) _Pragma("unroll") for (int s2 = 0; s2 < 2; ++s2) { const bf16_t* vp = Vs + (db * 32 + r) * AT_VRS + 16 * s2 + 4 * hh; const u32x2 lo = *(const u32x2*)vp, hi = *(const u32x2*)(vp + 8); \
                    vf[db][s2] = (u32x4){lo.x, lo.y, hi.x, hi.y}; } \
              __builtin_amdgcn_sched_barrier(0); \
              _Pragma("unroll") for (int db = 0; db < 4; ++db) _Pragma("unroll") for (int s2 = 0; s2 < 2; ++s2) o[db] = __builtin_amdgcn_mfma_f32_32x32x16_bf16(__builtin_bit_cast(bf16x8, vf[db][s2]), pf[s2], o[db], 0, 0, 0); } \
        } \
        __syncthreads(); \
        st = (st == 2) ? 0 : st + 1; st2 = (st2 == 2) ? 0 : st2 + 1; } while (0)
#pragma unroll 1
    for (int kt = 0; kt < nkt; kt += 2) { AT_TILE(kt, krA, vrA, mwA); AT_TILE(kt + 1, krB, vrB, mwB); }
#undef AT_TILE
    const float l = lsum + __shfl_xor(lsum, 32), inv = 1.f / l;
    bf16_t* op = AO + (size_t)tq * 1024 + head * 128 + 4 * hh;
#pragma unroll
    for (int db = 0; db < 4; ++db)
#pragma unroll
        for (int g4 = 0; g4 < 4; ++g4) { u32x2 wv; wv.x = pk2(o[db][4 * g4] * inv, o[db][4 * g4 + 1] * inv); wv.y = pk2(o[db][4 * g4 + 2] * inv, o[db][4 * g4 + 3] * inv);
            *(u32x2*)(op + db * 32 + 8 * g4) = wv; }
}
__device__ __forceinline__ void phase_attn(const Params& p, unsigned char* lds, int vb, int vG) {
    const int G = vG;
    for (int rd = 0;; ++rd) {
        const int base = rd * G; if (base >= 512) break;
        const int pos = (rd & 1) ? (G - 1 - vb) : vb; const int i = base + pos; if (i >= 512) continue;
        attn_item(p, lds, (i >> 3) & 7, i & 7, 7 - (i >> 6));
    }
}
__device__ __forceinline__ void phase_attn_queue(const Params& p, unsigned char* lds, unsigned* qhead) {
    volatile LAS int* slot = (volatile LAS int*)((LAS unsigned char*)lds + LDS_BYTES - 32);
    for (;;) {
        __syncthreads();
        if (threadIdx.x == 0) slot[0] = (int)__hip_atomic_fetch_add(qhead, 1u, __ATOMIC_RELAXED, __HIP_MEMORY_SCOPE_AGENT);
        __syncthreads();
        const int i = slot[0]; if (i >= 512) break;
        attn_item(p, lds, (i >> 3) & 7, i & 7, 7 - (i >> 6));
    }
}
#ifndef UV_SIDE_ROWS
#define UV_SIDE_ROWS 24576
#endif
__device__ __forceinline__ void phase_uv(const Params& p, int sb, int sG, int lo, int N) {
    const int tid = threadIdx.x, wave = tid >> 6, lane = tid & 63;
    const int gw = sb * NWAVES + wave, NGW = sG * NWAVES;
#define UV_LOAD(v, it_) do { const int tb_ = (it_) >> 14, rw_ = (it_) & 16383; const float* sp_ = (tb_ ? p.in[15] : p.in[14]) + (size_t)rw_ * 2048 + 4 * lane; \
        _Pragma("unroll") for (int j = 0; j < 8; ++j) v[j] = *(const f32x4*)(sp_ + 256 * j); } while (0)
#define UV_PROC(v, it_) do { const int tbl = (it_) >> 14, row = (it_) & 16383; \
        unsigned char* dst = p.ws + (tbl ? WS_V8 : WS_U8); float* isc = (float*)(p.ws + (tbl ? WS_ISV : WS_ISU)); float am = 0.f; \
        _Pragma("unroll") for (int j = 0; j < 8; ++j) am = fmaxf(am, fmaxf(fmaxf(fabsf(v[j][0]), fabsf(v[j][1])), fmaxf(fabsf(v[j][2]), fabsf(v[j][3])))); \
        _Pragma("unroll") for (int o = 1; o < 64; o <<= 1) am = fmaxf(am, __shfl_xor(am, o)); \
        am = fmaxf(am, 1e-30f); const float sc = (tbl ? 256.f : 127.f) / am; \
        unsigned wq[8]; \
        _Pragma("unroll") for (int j = 0; j < 8; ++j) { if (tbl == 0) { wq[j] = pack_i8x4(v[j][0] * sc, v[j][1] * sc, v[j][2] * sc, v[j][3] * sc); continue; } \
            int pk = 0; pk = __builtin_amdgcn_cvt_pk_fp8_f32(v[j][0] * sc, v[j][1] * sc, pk, false); pk = __builtin_amdgcn_cvt_pk_fp8_f32(v[j][2] * sc, v[j][3] * sc, pk, true); wq[j] = (unsigned)pk; } \
        unsigned char* d = dst + (size_t)(lane >> 5) * (2u << 20) + (size_t)row * 128 + (lane & 31) * 4;        \
        _Pragma("unroll") for (int j = 0; j < 8; ++j) *(unsigned*)(d + (size_t)j * (4u << 20)) = wq[j]; \
        if (lane == 0) isc[row] = am * (tbl ? 1.f / 256.f : 1.f / 127.f); } while (0)
    f32x4 vv[4][8]; int it = lo + gw;
    for (; it + 31 * NGW < N; it += 32 * NGW) {
        UV_LOAD(vv[0], it); UV_LOAD(vv[1], it + NGW); UV_LOAD(vv[2], it + 2 * NGW);
#pragma unroll
        for (int k = 0; k < 32; ++k) {
            if (k + 3 < 32) UV_LOAD(vv[(k + 3) & 3], it + (k + 3) * NGW);
            __builtin_amdgcn_sched_barrier(0); UV_PROC(vv[k & 3], it + k * NGW); __builtin_amdgcn_sched_barrier(0);
        }
    }
    f32x4 (&va)[8] = vv[0];
    for (; it < N; it += NGW) { UV_LOAD(va, it); UV_PROC(va, it); }
#undef UV_LOAD
#undef UV_PROC
}

#define INS16(v, x) do { _Pragma("unroll") for (int _j = 15; _j >= 1; --_j) v[_j] = __builtin_amdgcn_fmed3f(v[_j - 1], v[_j], (x)); v[0] = fmaxf(v[0], (x)); } while (0)
__device__ __forceinline__ void peer_half_top16(const bf16_t* QP, const bf16_t* kb0  , int pitch, int tok, int p, int hf, int r, int hh, float (&v)[16]) {
    bf16x8 qf[8];
    { const bf16_t* qp = QP + (size_t)tok * D + p * 256 + hf * 128 + 8 * hh;
#pragma unroll
      for (int ks = 0; ks < 8; ++ks) qf[ks] = *(const bf16x8*)(qp + ks * 16); }
#pragma unroll
    for (int k = 0; k < 16; ++k) v[k] = -3.0e38f;
    const bf16_t* kb = kb0 + r * pitch + 8 * hh;
#pragma unroll 1
    for (int nb = 0; nb < 4; ++nb) {
        f32x16 acc;
#pragma unroll
        for (int i = 0; i < 16; ++i) acc[i] = 0.f;
#pragma unroll
        for (int ks = 0; ks < 8; ++ks) { const bf16x8 kf = *(const bf16x8*)(kb + (nb * 32) * pitch + ks * 16); acc = __builtin_amdgcn_mfma_f32_32x32x16_bf16(kf, qf[ks], acc, 0, 0, 0); }
#pragma unroll
        for (int i = 0; i < 16; ++i) { const unsigned xi = (unsigned)(nb * 32 + (i & 3) + 8 * (i >> 2) + 4 * hh); const float x = __uint_as_float((__float_as_uint(acc[i]) & ~0x7fu) | xi); INS16(v, x); }
    }
    float ov[16];
#pragma unroll
    for (int k = 0; k < 16; ++k) ov[k] = __shfl_xor(v[k], 32);
#pragma unroll
    for (int k = 0; k < 16; ++k) INS16(v, ov[k]);
}
constexpr int PK_RS = 136;
#define GAS __attribute__((address_space(1)))
__device__ __attribute__((noinline)) void phase_peer_topk_ni(const GAS bf16_t* QPg, const GAS bf16_t* KEYSg, GAS int* EIDXg, GAS float* EGATEg, LAS unsigned char* ldsl) {
    const bf16_t* QP = (const bf16_t*)QPg; const bf16_t* KEYS = (const bf16_t*)KEYSg; int* EIDX = (int*)EIDXg; float* EGATE = (float*)EGATEg; unsigned char* lds = (unsigned char*)ldsl;
    const int tid = threadIdx.x, wave = __builtin_amdgcn_readfirstlane(tid >> 6), lane = tid & 63, r = lane & 31, hh = lane >> 5;
    bf16_t* KL = (bf16_t*)lds;
    const int G = gridDim.x, hd = blockIdx.x & 7;
    __syncthreads();
    for (int i = tid; i < 2 * 128 * 16; i += NTHREADS) { const int row = i >> 4, ch = i & 15;
        *(u32x4*)(KL + row * PK_RS + ch * 8) = *(const u32x4*)(KEYS + (size_t)(hd * 256 + row) * 128 + ch * 8); }
    __syncthreads();
    for (int tile = blockIdx.x >> 3; tile < 64; tile += (G + 7) / 8) {
        const int tok = tile * 256 + wave * 32 + r;
        float va[16], vb[16];
        peer_half_top16(QP, KL, PK_RS, tok, hd, 0, r, hh, va);
        peer_half_top16(QP, KL + 128 * PK_RS, PK_RS, tok, hd, 1, r, hh, vb);
        float bv[16];
#pragma unroll
        for (int k = 0; k < 16; ++k) bv[k] = -3.0e38f;
#pragma unroll
        for (int a = 0; a < 16; ++a)
#pragma unroll
            for (int b2 = 0; b2 < 16; ++b2) if ((a + 1) * (b2 + 1) <= 16) { const float x = va[a] + vb[b2]; INS16(bv, x); }
        float se = 0.f;
#pragma unroll
        for (int k = 0; k < 16; ++k) se += __expf(bv[k] - bv[0]);
        const float inv = 1.f / se, thr = bv[15], top = bv[0];
        int cnt = 0; int* ei = EIDX + (size_t)tok * 128 + hd * 16; float* eg = EGATE + (size_t)tok * 128 + hd * 16;
#pragma unroll
        for (int a = 0; a < 16; ++a)
#pragma unroll
            for (int b2 = 0; b2 < 16; ++b2) if ((a + 1) * (b2 + 1) <= 16) { const float x = va[a] + vb[b2];
                if (x >= thr && cnt < 16) { if (hh == 0) { ei[cnt] = (int)((__float_as_uint(va[a]) & 0x7fu) * 128u + (__float_as_uint(vb[b2]) & 0x7fu)); eg[cnt] = __expf(x - top) * inv; } ++cnt; } }
    }
}

typedef __bf16 bf16x2_t __attribute__((ext_vector_type(2)));
__device__ __forceinline__ float gelu_erf(float v) {
    const float av = fabsf(v), d = av * 0.2316418882f + 1.0f, t = __builtin_amdgcn_rcpf(d);
    float q = t * 0.5307027145f + (-0.7265760135f); q = q * t + 0.7107068705f; q = q * t + (-0.142248368f); q = q * t + 0.127414796f; q = q * t;
    const float e = __builtin_amdgcn_exp2f((v * v) * (-0.72134752044f));
    const float m = v * (q * e), r = v - m;
    return v < 0.f ? m : r;
}
__device__ __forceinline__ float dot2bf(unsigned a, unsigned b, float c) { return __builtin_amdgcn_fdot2_f32_bf16(__builtin_bit_cast(bf16x2_t, a), __builtin_bit_cast(bf16x2_t, b), c, false); }
__device__ __forceinline__ float dpp_f(float x, int ctrl_xor1_xor2_mirror) {
    const int v = __float_as_int(x);
    if (ctrl_xor1_xor2_mirror == 0) return __int_as_float(__builtin_amdgcn_update_dpp(0, v, 0xB1, 0xF, 0xF, true));
    if (ctrl_xor1_xor2_mirror == 1) return __int_as_float(__builtin_amdgcn_update_dpp(0, v, 0x4E, 0xF, 0xF, true));
    return __int_as_float(__builtin_amdgcn_update_dpp(0, v, 0x141, 0xF, 0xF, true));
}
typedef float f32x2v __attribute__((ext_vector_type(2)));
__device__ __forceinline__ void unpack8(const u32x4 w, float* f) { f[0] = bflo(w.x); f[1] = bfhi(w.x); f[2] = bflo(w.y); f[3] = bfhi(w.y); f[4] = bflo(w.z); f[5] = bfhi(w.z); f[6] = bflo(w.w); f[7] = bfhi(w.w); }
__device__ __forceinline__ void cvt16(const u32x4 w, float* f) {
#pragma unroll
    for (int q = 0; q < 4; ++q) { const f32x2v lo = __builtin_amdgcn_cvt_pk_f32_fp8((int)w[q], false), hi = __builtin_amdgcn_cvt_pk_f32_fp8((int)w[q], true);
        f[4 * q] = lo.x; f[4 * q + 1] = lo.y; f[4 * q + 2] = hi.x; f[4 * q + 3] = hi.y; }
}
__device__ __forceinline__ void phase_experts(const Params& p, unsigned char* lds) {
    const int tid = threadIdx.x, wave = __builtin_amdgcn_readfirstlane(tid >> 6), lane = tid & 63, rr = lane >> 3, cc = lane & 7; const bool odd = cc & 1;
    const unsigned char* H8 = p.ws + WS_H8; const unsigned char* U8 = p.ws + WS_U8; const unsigned char* V8 = p.ws + WS_V8;
    const float* ISU = (const float*)(p.ws + WS_ISU); const float* ISV = (const float*)(p.ws + WS_ISV); const float* ISH = (const float*)(p.ws + WS_ISH);
    const int* EIDX = (const int*)(p.ws + WS_EIDX); const float* EGATE = (const float*)(p.ws + WS_EGATE);
    const float* mod = (const float*)(p.ws + WS_MOD); const float* fin = p.in[16]; float* out = p.out; const float* X1 = (const float*)(p.ws + WS_X1);
    unsigned* offs = (unsigned*)lds; float* gts = (float*)(lds + 32768); float* rstl = (float*)(lds + 65536);
    const unsigned xcc = (unsigned)__builtin_amdgcn_s_getreg((3 << 11) | 20) & 7u; const unsigned cc16 = cc * 16;
    for (int tile = blockIdx.x; tile < T / 64; tile += gridDim.x) {
        const int tok0 = tile * 64, b = tok0 >> 11;
        __syncthreads();
        for (int i = tid; i < 8192; i += NTHREADS) { const int tl = i >> 7, j = i & 127, g = j >> 3, r8 = j & 7;
            offs[(tl * 8 + r8) * 16 + g] = (unsigned)EIDX[(size_t)tok0 * 128 + i] * 128u; gts[(tl * 8 + r8) * 16 + g] = EGATE[(size_t)tok0 * 128 + i]; }
        __syncthreads();
#pragma unroll 1
        for (int half = 0; half < 2; ++half) {
            const int tlb = wave * 8 + half * 4;
            u32x4 dA[16], dB[16], hA, hB;
#ifndef EXP_REP_U
#define EXP_REP_U 0
#endif
#ifndef EXP_REP_V
#define EXP_REP_V 0
#endif
#define EX_SLICE(i_) ((xcc * 2u + (unsigned)(i_)) & 15u)
#define EX_LOAD(buf, TBL, i_, k_) EX_LOADS(buf, TBL, EX_SLICE(i_), k_)
#define EX_USL(i_) ((EXP_REP_U == 3 && (i_) >= 16) ? ((xcc * 2u) & 15u) : EX_SLICE(i_))
#define EX_LOADS(buf, TBL, SL_, k_) do { const unsigned char* tb_ = (TBL) + (size_t)(SL_) * (2u << 20); u32x4 o4_[4]; \
    _Pragma("unroll") for (int q_ = 0; q_ < 4; ++q_) o4_[q_] = *(const u32x4*)(offs + ((tlb + (k_)) * 8 + rr) * 16 + 4 * q_); \
    _Pragma("unroll") for (int g_ = 0; g_ < 16; ++g_) buf[g_] = *(const u32x4*)(tb_ + (o4_[g_ >> 2][g_ & 3] + cc16)); } while (0)
#define EX_LOADH(h0, i_, k_) do { h0 = *(const u32x4*)(H8 + ((size_t)(tok0 + tlb + (k_)) * D + EX_SLICE(i_) * 128) + cc16); if (EXP_REP_U >= 2 && (i_) >= 16) { h0.x &= zmask; h0.y &= zmask; h0.z &= zmask; h0.w &= zmask; } } while (0)
#define EX_DOT16(acc, WSRC, hq) do { u32x4 w_ = WSRC; asm volatile("" : "+v"(w_.x), "+v"(w_.y), "+v"(w_.z), "+v"(w_.w), "+v"(ch_)); \
    acc = __builtin_amdgcn_sdot4((int)w_.x, (int)hq.x, 0, false); acc = __builtin_amdgcn_sdot4((int)w_.y, (int)hq.y, acc, false); \
    acc = __builtin_amdgcn_sdot4((int)w_.z, (int)hq.z, acc, false); acc = __builtin_amdgcn_sdot4((int)w_.w, (int)hq.w, acc, false); ch_ = acc; } while (0)
#define EX_UCOMP(buf, hq, k_) do { int ch_ = 0; \
    _Pragma("unroll") for (int j_ = 0; j_ < 8; ++j_) { int te_, to_; EX_DOT16(te_, buf[2 * j_], hq); EX_DOT16(to_, buf[2 * j_ + 1], hq); \
    const int my_ = odd ? to_ : te_, ot_ = odd ? te_ : to_; zp[k_][j_] += my_ + __builtin_amdgcn_update_dpp(0, ot_, 0xB1, 0xF, 0xF, true); asm volatile("" : "+v"(zp[k_][j_])); __builtin_amdgcn_sched_barrier(0); } } while (0)
#define SB() __builtin_amdgcn_sched_barrier(0)
            int zp[4][8];
#pragma unroll
            for (int k = 0; k < 4; ++k)
#pragma unroll
                for (int j = 0; j < 8; ++j) zp[k][j] = 0;
            const unsigned zmask = (p.ph_hi > 100) ? ~0u : 0u;
            EX_LOADH(hA, 0, 0); EX_LOAD(dA, U8, 0, 0); SB();
#pragma unroll 1
            for (int i = 0; i < 16 * (EXP_REP_U ? 2 : 1); ++i) {
                __builtin_amdgcn_s_barrier();
                EX_LOADH(hB, i, 1); EX_LOADS(dB, U8, EX_USL(i), 1); SB(); EX_UCOMP(dA, hA, 0); SB();
                EX_LOADH(hA, i, 2); EX_LOADS(dA, U8, EX_USL(i), 2); SB(); EX_UCOMP(dB, hB, 1); SB();
                EX_LOADH(hB, i, 3); EX_LOADS(dB, U8, EX_USL(i), 3); SB(); EX_UCOMP(dA, hA, 2); SB();
                if (i < 16 * (EXP_REP_U ? 2 : 1) - 1) { EX_LOADH(hA, i + 1, 0); EX_LOADS(dA, U8, EX_USL(i + 1), 0); } SB(); EX_UCOMP(dB, hB, 3); SB();
            }
            if (EXP_REP_U == 1) {
#pragma unroll
                for (int k = 0; k < 4; ++k)
#pragma unroll
                    for (int j = 0; j < 8; ++j) zp[k][j] /= 2; }
            unsigned* apl = (unsigned*)(lds + 66560);
#pragma unroll
            for (int k = 0; k < 4; ++k)
#pragma unroll
                for (int j = 0; j < 8; ++j) { int zi = zp[k][j]; zi += __builtin_amdgcn_update_dpp(0, zi, 0x4E, 0xF, 0xF, true); zi += __shfl_xor(zi, 4); const float z = (float)zi * ISH[tok0 + tlb + k];
                    const int li = ((tlb + k) * 8 + rr) * 16 + 2 * j + (odd ? 1 : 0); const unsigned eid = offs[li] >> 7;
                    const float act = gelu_erf(z * ISU[eid]) * gts[li] * ISV[eid]; const float oth = dpp_f(act, 0);
                    apl[((tlb + k) * 8 + rr) * 8 + j] = f2bf(odd ? oth : act) | (f2bf(odd ? act : oth) << 16); }
            LDS_WAIT();
            float ssq[4] = {0.f, 0.f, 0.f, 0.f};
#define EX_PIN8(a) asm volatile("" : "+v"(a[0]), "+v"(a[1]), "+v"(a[2]), "+v"(a[3]), "+v"(a[4]), "+v"(a[5]), "+v"(a[6]), "+v"(a[7]))
#define EX_VFMA(WSRC, av_) do { u32x4 w_ = WSRC; asm volatile("" : "+v"(w_.x), "+v"(w_.y), "+v"(w_.z), "+v"(w_.w), "+v"(oa2_[0])); \
    _Pragma("unroll") for (int q_ = 0; q_ < 4; ++q_) { const f32x2v lo_ = __builtin_amdgcn_cvt_pk_f32_fp8((int)w_[q_], false), hi_ = __builtin_amdgcn_cvt_pk_f32_fp8((int)w_[q_], true); \
        oa2_[2 * q_] = __builtin_elementwise_fma(lo_, av_, oa2_[2 * q_]); oa2_[2 * q_ + 1] = __builtin_elementwise_fma(hi_, av_, oa2_[2 * q_ + 1]); } EX_PIN8(oa2_); } while (0)
#define EX_VCOMP(buf, i_, k_) do { f32x2v oa2_[8]; _Pragma("unroll") for (int e_ = 0; e_ < 8; ++e_) oa2_[e_] = (f32x2v){0.f, 0.f}; \
    const int col_ = (int)EX_SLICE(i_) * 128 + cc * 16 + 2 * rr; const size_t xo_ = (size_t)(tok0 + tlb + (k_)) * D + col_; \
    const f32x2v x1_ = *(const f32x2v*)(X1 + xo_), g2_ = *(const f32x2v*)(mod + (size_t)b * NADA + 5 * 2048 + col_); \
    const u32x4 ap0_ = *(const u32x4*)(apl + ((tlb + (k_)) * 8 + rr) * 8), ap1_ = *(const u32x4*)(apl + ((tlb + (k_)) * 8 + rr) * 8 + 4); \
    _Pragma("unroll") for (int j_ = 0; j_ < 8; ++j_) { const unsigned pr_ = (j_ < 4) ? ap0_[j_ & 3] : ap1_[j_ & 3]; f32x2v a0_, a1_; a0_.x = bflo(pr_); a0_.y = a0_.x; a1_.x = bfhi(pr_); a1_.y = a1_.x; \
        EX_VFMA(buf[2 * j_], a0_); EX_VFMA(buf[2 * j_ + 1], a1_); __builtin_amdgcn_sched_barrier(0); } \
    float oa_[16]; _Pragma("unroll") for (int e_ = 0; e_ < 8; ++e_) { oa_[2 * e_] = oa2_[e_].x; oa_[2 * e_ + 1] = oa2_[e_].y; } \
      \
    float b8_[8], b4_[4], b2_[2]; \
    _Pragma("unroll") for (int e_ = 0; e_ < 8; ++e_) { const bool up_ = lane & 32; const float kp_ = up_ ? oa_[e_ + 8] : oa_[e_], sd_ = up_ ? oa_[e_] : oa_[e_ + 8]; b8_[e_] = kp_ + __shfl_xor(sd_, 32); } \
    _Pragma("unroll") for (int e_ = 0; e_ < 4; ++e_) { const bool up_ = lane & 16; const float kp_ = up_ ? b8_[e_ + 4] : b8_[e_], sd_ = up_ ? b8_[e_] : b8_[e_ + 4]; b4_[e_] = kp_ + __shfl_xor(sd_, 16); } \
    _Pragma("unroll") for (int e_ = 0; e_ < 2; ++e_) { const bool up_ = lane & 8; const float kp_ = up_ ? b4_[e_ + 2] : b4_[e_], sd_ = up_ ? b4_[e_] : b4_[e_ + 2]; b2_[e_] = kp_ + __shfl_xor(sd_, 8); } \
    f32x2v y_; y_.x = x1_.x + g2_.x * b2_[0]; y_.y = x1_.y + g2_.y * b2_[1]; *(f32x2v*)(out + xo_) = y_; ssq[k_] = fmaf(y_.x, y_.x, fmaf(y_.y, y_.y, ssq[k_])); asm volatile("" : "+v"(ssq[k_])); } while (0)
#pragma unroll 1
            for (int i = 0; i < 16 * (1 + EXP_REP_V); ++i) {
                if (EXP_REP_V && i == 16) { ssq[0] = 0.f; ssq[1] = 0.f; ssq[2] = 0.f; ssq[3] = 0.f; }
                __builtin_amdgcn_s_barrier();
                if (i == 0 || (EXP_REP_V && i == 16)) { EX_LOAD(dA, V8, i, 0); }
                EX_LOAD(dB, V8, i, 1); SB(); EX_VCOMP(dA, i, 0); SB();
                EX_LOAD(dA, V8, i, 2); SB(); EX_VCOMP(dB, i, 1); SB();
                EX_LOAD(dB, V8, i, 3); SB(); EX_VCOMP(dA, i, 2); SB();
                if ((i & 15) != 15) { EX_LOAD(dA, V8, i + 1, 0); } SB(); EX_VCOMP(dB, i, 3); SB();
            }
#pragma unroll
            for (int k = 0; k < 4; ++k) { const float tot = wave_sum(ssq[k]); rstl[wave * 8 + half * 4 + k] = rsqrtf(tot * (1.f / D) + NORM_EPS); }
        }
#undef EX_SLICE
#undef EX_LOAD
#undef EX_LOADH
#undef EX_DOT16
#undef EX_UCOMP
#undef EX_VCOMP
#undef SB
        __builtin_amdgcn_fence(__ATOMIC_RELEASE, "agent"); __builtin_amdgcn_fence(__ATOMIC_ACQUIRE, "agent");
        LDS_WAIT();
        int lane2 = (int)__builtin_amdgcn_mbcnt_hi(~0u, __builtin_amdgcn_mbcnt_lo(~0u, 0u)); asm volatile("" : "+v"(lane2));
#pragma unroll 1
        for (int k = 0; k < 8; ++k) { float* xr = out + (size_t)(tok0 + wave * 8 + k) * D; const float rs = rstl[wave * 8 + k];
#pragma unroll
            for (int j = 0; j < 8; ++j) { const int col = 4 * (lane2 + 64 * j); const f32x4 v = *(const f32x4*)(xr + col), f = *(const f32x4*)(fin + col);
                f32x4 o; o[0] = v[0] * rs * f[0]; o[1] = v[1] * rs * f[1]; o[2] = v[2] * rs * f[2]; o[3] = v[3] * rs * f[3]; *(f32x4*)(xr + col) = o; } }
    }
}

#define XB_TMO      128
#define XB_XCNT(j)  (256  + 64 * (j))
#define XB_XSUB(j)  (1280 + 64 * (j))
#define XB_XGEN(j)  (2304 + 64 * (j))
#define XB_TOP      3328
#define XB_TOPGEN   3392
#define XCD_BAR_WORDS 3456
#define XB_SPIN_CAP (1u << 22)
__device__ __forceinline__ unsigned xb_ld(unsigned* p)              { return __hip_atomic_load(p, __ATOMIC_RELAXED, __HIP_MEMORY_SCOPE_AGENT); }
__device__ __forceinline__ unsigned xb_add(unsigned* p, unsigned v) { return __hip_atomic_fetch_add(p, v, __ATOMIC_RELAXED, __HIP_MEMORY_SCOPE_AGENT); }
__device__ __forceinline__ unsigned xb_xcc_id() { return (unsigned)__builtin_amdgcn_s_getreg((3 << 11) | 20) & 0xFu; }
#define XB_SPIN(cond, bar) do { unsigned _sp = 0; while (cond) { __builtin_amdgcn_s_sleep(1); \
    if ((++_sp & 255u) == 0u) { if (xb_ld(&(bar)[XB_TMO])) break; if (_sp > XB_SPIN_CAP) { atomicAdd(&(bar)[XB_TMO], 1u); break; } } } } while (0)
struct XcdBarrier { unsigned* bar; unsigned x; volatile LAS unsigned* st; };
__device__ __forceinline__ XcdBarrier xcd_barrier_post(unsigned* bar, volatile LAS unsigned* st) {
    XcdBarrier b; b.bar = bar; b.x = xb_xcc_id(); b.st = st;
    if (threadIdx.x == 0) (void)xb_add(&bar[XB_XCNT(b.x)], 1u);
    return b;
}
__device__ __forceinline__ void xcd_barrier_complete(unsigned* bar, unsigned x, unsigned& nloc, unsigned& nx) {
    const unsigned G = gridDim.x * gridDim.y * gridDim.z;
    unsigned sum, cnt, mine, sp = 0u;
    for (;;) {
        sum = 0u; cnt = 0u; mine = 0u;
#pragma unroll
        for (unsigned j = 0; j < 16; ++j) { const unsigned c = xb_ld(&bar[XB_XCNT(j)]); sum += c; cnt += (c > 0u) ? 1u : 0u; mine = (j == x) ? c : mine; }
        if (sum == G) break;
        __builtin_amdgcn_s_sleep(1);
        if ((++sp & 255u) == 0u) { if (xb_ld(&bar[XB_TMO])) break; if (sp > XB_SPIN_CAP) { atomicAdd(&bar[XB_TMO], 1u); break; } }
    }
    nloc = mine > 0u ? mine : 1u; nx = cnt > 0u ? cnt : 1u;
}
__device__ __forceinline__ void xcd_barrier(const XcdBarrier& b) {
    asm volatile("s_waitcnt vmcnt(0)" ::: "memory");
    __syncthreads();
    if (threadIdx.x == 0) {
        unsigned* bar = b.bar;
        __builtin_amdgcn_s_waitcnt(0);
        unsigned nloc = b.st[0], nx = b.st[1];
        if (nloc == 0u) { xcd_barrier_complete(bar, b.x, nloc, nx); b.st[0] = nloc; b.st[1] = nx; }
        const unsigned old = xb_add(&bar[XB_XSUB(b.x)], 1u);
        const unsigned gen = old / nloc;
        if (old + 1u == (gen + 1u) * nloc) {
            __builtin_amdgcn_fence(__ATOMIC_RELEASE, "agent");
            asm volatile("s_waitcnt vmcnt(0)" ::: "memory");
            const unsigned og = xb_add(&bar[XB_TOP], 1u);
            const unsigned tg = og / nx;
            if (og + 1u == (tg + 1u) * nx) xb_add(&bar[XB_TOPGEN], 1u);
            else XB_SPIN(xb_ld(&bar[XB_TOPGEN]) == tg, bar);
            __builtin_amdgcn_fence(__ATOMIC_ACQUIRE, "agent");
            xb_add(&bar[XB_XGEN(b.x)], 1u);
            asm volatile("s_waitcnt vmcnt(0)" ::: "memory");
        } else {
            XB_SPIN(xb_ld(&bar[XB_XGEN(b.x)]) == gen, bar);
            __builtin_amdgcn_fence(__ATOMIC_ACQUIRE, "agent");
            asm volatile("s_waitcnt vmcnt(0)" ::: "memory");
        }
    }
    __syncthreads();
}

__device__ __forceinline__ void subset_barrier(unsigned* cnt, unsigned n) {
    asm volatile("s_waitcnt vmcnt(0)" ::: "memory");
    __syncthreads();
    if (threadIdx.x == 0) {
        __builtin_amdgcn_fence(__ATOMIC_RELEASE, "agent");
        asm volatile("s_waitcnt vmcnt(0)" ::: "memory");
        __hip_atomic_fetch_add(cnt, 1u, __ATOMIC_RELAXED, __HIP_MEMORY_SCOPE_AGENT);
        unsigned sp = 0;
        while (__hip_atomic_load(cnt, __ATOMIC_RELAXED, __HIP_MEMORY_SCOPE_AGENT) < n) { __builtin_amdgcn_s_sleep(1); if (++sp > (1u << 24)) break; }
        __builtin_amdgcn_fence(__ATOMIC_ACQUIRE, "agent");
        asm volatile("s_waitcnt vmcnt(0)" ::: "memory");
    }
    __syncthreads();
}
__device__ __forceinline__ void subset_wait(unsigned* cnt, unsigned n) {
    __syncthreads();
    if (threadIdx.x == 0) {
        unsigned sp = 0;
        while (__hip_atomic_load(cnt, __ATOMIC_RELAXED, __HIP_MEMORY_SCOPE_AGENT) < n) { __builtin_amdgcn_s_sleep(2); if (++sp > (1u << 24)) break; }
        __builtin_amdgcn_fence(__ATOMIC_ACQUIRE, "agent");
        asm volatile("s_waitcnt vmcnt(0)" ::: "memory");
    }
    __syncthreads();
}
constexpr int NPHASES = 11;
__global__ void __launch_bounds__(NTHREADS, 2) mega_fwd(Params p) {
    extern __shared__ __attribute__((aligned(16))) unsigned char lds[];
    cg::grid_group grid = cg::this_grid();
    const int lo = p.ph_lo, hi = p.ph_hi;
#ifndef PHASE_MASK
#define PHASE_MASK 0x7ff
#endif
#define IN(k) (((PHASE_MASK >> (k)) & 1) && lo <= (k) && (k) < hi)
#define SEAM(k) do { if (IN(k) && IN((k) + 1)) xcd_barrier(xbar); } while (0)
    unsigned char* ws = p.ws;
    bf16_t* P = (bf16_t*)(ws + WS_P);
    bf16_t* Hb = (bf16_t*)((unsigned char*)p.out + OUT_H);
    bf16_t* WinT = (bf16_t*)((unsigned char*)p.out + OUT_WIN);
    const float* mod = (const float*)(ws + WS_MOD);
    LAS unsigned char* ldsl = (LAS unsigned char*)lds;
    volatile LAS unsigned* xst = (volatile LAS unsigned*)(ldsl + LDS_BYTES - 64);
    if (threadIdx.x < 2) xst[threadIdx.x] = 0u;
    __syncthreads();
    XcdBarrier xbar = xcd_barrier_post((unsigned*)(ws + WS_CTL) + 4096, xst);

#ifndef REPEAT_PHASE
#define REPEAT_PHASE -1
#endif
    int rep3 = 0;
#define RUNPH(k, ...) do { if (IN(k)) { __VA_ARGS__; if (REPEAT_PHASE == (k)) { grid.sync(); __VA_ARGS__; } } } while (0)
    RUNPH(0, { phase_mod(p, lds); __syncthreads(); phase_weights(p, lds); });
    SEAM(0);
    RUNPH(1, { phase_norm_rows(p.in[0], p.in[4], mod, mod + 2048, Hb, LDP); });
    SEAM(1);
    RUNPH(2, { pg8::Gemm g{Hb, WinT, nullptr, nullptr, LDP, LDP, T, NP, D}; pg8::SideOrder S; S.init(T, NP, gridDim.x, blockIdx.x);
        if (S.side()) phase_uv(p, (int)(blockIdx.x & 7) * 2 + ((int)(blockIdx.x >> 3) - 30), 16, 0, UV_SIDE_ROWS);
        long long pc0 = 0, pr0 = 0; if (REPEAT_PHASE == 25) { pc0 = clock64(); pr0 = wall_clock64(); }
#ifndef SKEW_TICKS
#define SKEW_TICKS 0
#endif
        if (SKEW_TICKS > 0 && gridDim.x == 256) { const int q = (blockIdx.x >> 6) & 3; const long long t0 = wall_clock64(); while (wall_clock64() - t0 < (long long)q * SKEW_TICKS) __builtin_amdgcn_s_sleep(16); }
        pg8::EpiBf16 E{P, NP, 33}; pg8::gemm_phase(ldsl, g, S, E);
        if (REPEAT_PHASE == 25 && blockIdx.x == 0) { const long long pc1 = clock64(), pr1 = wall_clock64(); const long long mhz = (pc1 - pc0) * 100 / (pr1 - pr0);
            while (wall_clock64() - pr1 < mhz * 100) __builtin_amdgcn_s_sleep(8); }
        if (REPEAT_PHASE == 21) { grid.sync(); pg8::EpiSkip E2{E, p.ph_hi > 100}; pg8::gemm_phase(ldsl, g, S, E2); }
        if (REPEAT_PHASE == 22) { grid.sync(); pg8::EpiSkip E2{E, p.ph_hi > 100}; pg8::ProbeOrder S2{S.S, 0, 0}; pg8::gemm_phase(ldsl, g, S2, E2); }
        if (REPEAT_PHASE == 26) { grid.sync(); pg8::ProbeOrder S2{S.S, 0, 0}; pg8::gemm_phase(ldsl, g, S2, E); }
        if (REPEAT_PHASE == 23) { grid.sync(); pg8::EpiSkip E2{E, p.ph_hi > 100}; pg8::ProbeOrder S2{S.S, 63, 0}; pg8::gemm_phase(ldsl, g, S2, E2); }
        if (REPEAT_PHASE == 24) { grid.sync(); pg8::EpiSkip E2{E, p.ph_hi > 100}; pg8::ProbeOrder S2{S.S, 0, 63}; pg8::gemm_phase(ldsl, g, S2, E2); } });
    SEAM(2);
    RUNPH(3, { const int G = gridDim.x, bx = blockIdx.x;
        unsigned* sbar = (unsigned*)(ws + WS_CTL) + 12288 + ((REPEAT_PHASE == 3) ? 64 * rep3 : 0); unsigned* qh = sbar + 16;
        if (G >= 128) { if (bx < 64) { phase_hgrn(p, lds, bx, 64); if (REPEAT_PHASE == 32) phase_hgrn(p, lds, bx, 64); subset_wait(sbar, (unsigned)(G - 64)); phase_attn_queue(p, lds, qh); }
                        else { phase_vt(p, lds, bx - 64, G - 64); phase_indexer(p, lds, bx - 64, G - 64); if (REPEAT_PHASE == 31) phase_indexer(p, lds, bx - 64, G - 64);
                               subset_barrier(sbar, (unsigned)(G - 64)); phase_attn_queue(p, lds, qh); } }
        else { phase_vt(p, lds, bx, G); phase_indexer(p, lds, bx, G); __syncthreads(); phase_hgrn(p, lds, bx, G); grid.sync(); phase_attn(p, lds, bx, G); }
        ++rep3; });
    SEAM(3);
    RUNPH(5, { pg8::Gemm g{(const bf16_t*)((unsigned char*)p.out + OUT_AO), (const bf16_t*)(ws + WS_WUA), (const bf16_t*)((unsigned char*)p.out + OUT_REC), (const bf16_t*)(ws + WS_WUB), 1024, 1024, T, D, 1024}; pg8::StaticOrder<2> S; S.init(T, D, gridDim.x, blockIdx.x);
        pg8::EpiMix E{(bf16_t*)(ws + WS_MIXED), P}; pg8::gemm_phase(ldsl, g, S, E); });
    SEAM(5);
    RUNPH(6, { pg8::Gemm g{(const bf16_t*)(ws + WS_MIXED), (const bf16_t*)(ws + WS_WOUT), nullptr, nullptr, D, D, T, D, D}; pg8::StaticOrder<1> S; S.init(T, D, gridDim.x, blockIdx.x);
        pg8::EpiX1 E{p.in[0], (float*)(ws + WS_X1), mod + 4096}; pg8::gemm_phase(ldsl, g, S, E); });
    SEAM(6);
    RUNPH(7, { const int S7_LO = (gridDim.x == 256) ? UV_SIDE_ROWS : 0;
        phase_norm_rows((const float*)(ws + WS_X1), p.in[5], mod + 3 * 2048, mod + 4 * 2048, (bf16_t*)(ws + WS_H2), D, ws + WS_H8, (float*)(ws + WS_ISH)); phase_uv(p, blockIdx.x, gridDim.x, S7_LO, 32768); });
    SEAM(7);
    RUNPH(8, { pg8::Gemm g{(const bf16_t*)(ws + WS_H2), (const bf16_t*)(ws + WS_WQ), nullptr, nullptr, D, D, T, D, D}; pg8::StaticOrder<1> S; S.init(T, D, gridDim.x, blockIdx.x);
        pg8::EpiBf16 E{(bf16_t*)(ws + WS_QP), D, 1 << 30}; pg8::gemm_phase(ldsl, g, S, E); });
    SEAM(8);
    RUNPH(9, { phase_peer_topk_ni((const GAS bf16_t*)(ws + WS_QP), (const GAS bf16_t*)(ws + WS_KEYS), (GAS int*)(ws + WS_EIDX), (GAS float*)(ws + WS_EGATE), ldsl); });
    SEAM(9);
    RUNPH(10, { phase_experts(p, lds); });
    if (p.ph_hi > NPHASES) grid.sync();
#undef IN
#undef SEAM
}

#ifndef MK_N_LAUNCHES
#define MK_N_LAUNCHES 1
#endif
extern "C" void kernel_launch(void* const* d_in, const int* in_sizes, int n_in, void* d_out, int out_size, void* d_ws, size_t ws_size, hipStream_t stream) {
    static int grid = 0;
    if (grid == 0) {
        if (n_in != 17 || out_size != T * D || ws_size < WS_END) { fprintf(stderr, "kernel_launch: unexpected shapes (n_in %d out %d ws %zu)\n", n_in, out_size, ws_size); grid = -1; return; }
        int dev = 0, cus = 0, per_cu = 0;
        hipGetDevice(&dev); hipDeviceGetAttribute(&cus, hipDeviceAttributeMultiprocessorCount, dev);
        hipFuncSetAttribute((const void*)mega_fwd, hipFuncAttributeMaxDynamicSharedMemorySize, LDS_BYTES);
        hipOccupancyMaxActiveBlocksPerMultiprocessor(&per_cu, (const void*)mega_fwd, NTHREADS, LDS_BYTES);
        if (per_cu < 1) { fprintf(stderr, "kernel_launch: occupancy query says %d blocks/CU\n", per_cu); per_cu = 1; }
        (void)hipGetLastError();
        grid = cus * 1;
    }
    if (grid < 0) return;
    if (hipMemsetAsync((char*)d_ws + WS_CTL, 0, 65536, stream) != hipSuccess) { fprintf(stderr, "kernel_launch: memset failed\n"); return; }
    Params p{};
    for (int i = 0; i < 17; ++i) p.in[i] = (const float*)d_in[i];
    p.out = (float*)d_out; p.ws = (unsigned char*)d_ws;
#if MK_N_LAUNCHES == 1
    p.ph_lo = 0; p.ph_hi = NPHASES;
    void* args[] = {&p};
    hipError_t e = hipLaunchCooperativeKernel((const void*)mega_fwd, dim3(grid), dim3(NTHREADS), args, LDS_BYTES, stream);
    if (e != hipSuccess) fprintf(stderr, "cooperative launch failed: %s (grid %d)\n", hipGetErrorString(e), grid);
#else
    for (int k = 0; k < NPHASES; ++k) { p.ph_lo = k; p.ph_hi = k + 1; void* args[] = {&p};
        hipError_t e = hipLaunchCooperativeKernel((const void*)mega_fwd, dim3(grid), dim3(NTHREADS), args, LDS_BYTES, stream);
        if (e != hipSuccess) { fprintf(stderr, "launch %d failed: %s\n", k, hipGetErrorString(e)); break; } }
#endif
}
```
